# Optimizing an MI355X kernel written in HIP

```python
import jax
import jax.numpy as jnp
from jax import lax
import numpy as np


D_MODEL = 1024
BATCH = 8
SEQ = 2048
DEPTH = 4

GRID_W = 64
HEAD_DIM = 64
ATT_HEADS = 8
ATT_KV_HEADS = 2
ATT_WIDTH = ATT_HEADS * HEAD_DIM
KV_WIDTH = ATT_KV_HEADS * HEAD_DIM
Q_BLOCK = 128
ROPE_THETA = 10000.0
LRU_WIDTH = D_MODEL // 4
LRU_BLOCKS = 4
LRU_BLOCK_DIM = LRU_WIDTH // LRU_BLOCKS
CONV_WIDTH = 4
LRU_C = 8.0
MLSTM_HEADS = 4
MLSTM_DIM = 64
MLSTM_WIDTH = MLSTM_HEADS * MLSTM_DIM
MLSTM_CHUNK = 128
D_MIX = ATT_WIDTH + LRU_WIDTH + MLSTM_WIDTH
IN_SPLITS = (ATT_WIDTH, KV_WIDTH, KV_WIDTH, LRU_WIDTH, LRU_WIDTH, MLSTM_WIDTH, MLSTM_WIDTH, MLSTM_WIDTH, MLSTM_WIDTH, 4 * MLSTM_HEADS)
D_IN = sum(IN_SPLITS)
N_EXPERTS = 16
CAPACITY_FACTOR = 2
D_EXPERT = 2 * D_MODEL
EPS = 1e-6

kernel_name = 'hybrid_head_group_encoder_ec_moe'

F32 = jnp.float32


def rms_norm(x, g):
    xf = x.astype(F32)
    y = xf * lax.rsqrt(jnp.mean(xf * xf, axis=-1, keepdims=True) + EPS)
    return (y * g.astype(F32)).astype(x.dtype)


def split_columns(p):
    idx = [int(i) for i in np.cumsum(np.array(IN_SPLITS))[:-1]]
    return jnp.split(p, idx, axis=-1)


def axial_rope_tables(seq_len):
    rows = seq_len // GRID_W
    t = jnp.arange(rows * GRID_W)
    row = (t // GRID_W).astype(F32)
    col = (t % GRID_W).astype(F32)
    n_freq = HEAD_DIM // 4
    inv = 1.0 / (ROPE_THETA ** (jnp.arange(n_freq, dtype=F32) / n_freq))
    ang = jnp.concatenate([row[:, None] * inv, col[:, None] * inv], axis=-1)
    return jnp.cos(ang), jnp.sin(ang)


def apply_rope(x, cos, sin):
    half = HEAD_DIM // 2
    x1, x2 = x[..., :half], x[..., half:]
    return jnp.concatenate([x1 * cos - x2 * sin, x2 * cos + x1 * sin], axis=-1)


def axial_gqa_attention(q, k, v, q_g, k_g):
    B, S, _ = q.shape
    dt = q.dtype
    q = rms_norm(q.reshape(B, S, ATT_HEADS, HEAD_DIM), q_g)
    k = rms_norm(k.reshape(B, S, ATT_KV_HEADS, HEAD_DIM), k_g)
    v = v.reshape(B, S, ATT_KV_HEADS, HEAD_DIM)
    cos, sin = axial_rope_tables(S)
    cos, sin = cos[:, None, :], sin[:, None, :]
    q = apply_rope(q.astype(F32), cos, sin).astype(dt)
    k = apply_rope(k.astype(F32), cos, sin).astype(dt)
    grp = ATT_HEADS // ATT_KV_HEADS
    qb = q.reshape(B, S // Q_BLOCK, Q_BLOCK, ATT_KV_HEADS, grp, HEAD_DIM)
    qb = jnp.moveaxis(qb, 1, 0)
    scale = HEAD_DIM ** -0.5

    def one_block(qblk):
        s = jnp.einsum('bqhgd,bkhd->bhgqk', qblk, k).astype(F32) * scale
        p = jax.nn.softmax(s, axis=-1).astype(v.dtype)
        return jnp.einsum('bhgqk,bkhd->bqhgd', p, v)

    o = lax.map(one_block, qb)
    return jnp.moveaxis(o, 0, 1).reshape(B, S, ATT_WIDTH)


def centred_depthwise_conv(x, w, b):
    S = x.shape[1]
    left = CONV_WIDTH // 2
    xp = jnp.pad(x, ((0, 0), (left, CONV_WIDTH - 1 - left), (0, 0)))
    y = b
    for j in range(CONV_WIDTH):
        y = y + xp[:, j:j + S, :] * w[j]
    return y


def block_diag_linear(x, w, b):
    B, S, C = x.shape
    xb = x.reshape(B, S, LRU_BLOCKS, LRU_BLOCK_DIM)
    return jnp.einsum('bsnd,nde->bsne', xb, w).reshape(B, S, C) + b


def linear_scan(a, u):
    def comb(l, r):
        al, ul = l
        ar, ur = r
        return al * ar, ar * ul + ur
    _, h = lax.associative_scan(comb, (a, u), axis=1)
    return h


def rglru_direction(xc, wa, ba, wx, bx, lam, reverse):
    if reverse:
        xc = jnp.flip(xc, axis=1)
    r = jax.nn.sigmoid(block_diag_linear(xc, wa, ba).astype(F32))
    i = jax.nn.sigmoid(block_diag_linear(xc, wx, bx).astype(F32))
    log_a = -LRU_C * r * jax.nn.softplus(-lam.astype(F32))
    u = jnp.sqrt(-jnp.expm1(2.0 * log_a)) * (i * xc.astype(F32))
    h = linear_scan(jnp.exp(log_a), u)
    if reverse:
        h = jnp.flip(h, axis=1)
    return h


def rglru_mixer(xb, gate, conv_w, conv_b, wa, ba, wx, bx, lam):
    xc = centred_depthwise_conv(xb, conv_w, conv_b)
    h = rglru_direction(xc, wa[0], ba[0], wx[0], bx[0], lam[0], False) \
        + rglru_direction(xc, wa[1], ba[1], wx[1], bx[1], lam[1], True)
    return h.astype(xb.dtype) * jax.nn.gelu(gate)


def mlstm_chunkwise(q, k, v, i_pre, f_pre):
    B, H, S, D = q.shape
    L = MLSTM_CHUNK
    NC = S // L
    qc = q.reshape(B, H, NC, L, D)
    kc = k.reshape(B, H, NC, L, D) * (D ** -0.5)
    vc = v.reshape(B, H, NC, L, D)
    ig = i_pre.reshape(B, H, NC, L)
    bcum = jnp.cumsum(jax.nn.log_sigmoid(f_pre).reshape(B, H, NC, L), axis=-1)
    mask = jnp.tril(jnp.ones((L, L), dtype=bool))
    log_d = jnp.where(mask, bcum[..., :, None] - bcum[..., None, :] + ig[..., None, :], -jnp.inf)
    g = bcum[..., -1]
    log_w_end = g[..., None] - bcum + ig
    m_loc = jnp.max(log_w_end, axis=-1)
    w_end = jnp.exp(log_w_end - m_loc[..., None])
    c_loc = jnp.einsum('bhcl,bhcld,bhcle->bhcde', w_end, vc, kc)
    n_loc = jnp.einsum('bhcl,bhcle->bhce', w_end, kc)

    def step(carry, inp):
        c_st, n_st, m_st = carry
        c_l, n_l, m_l, g_c = inp
        m_new = jnp.maximum(g_c + m_st, m_l)
        a = jnp.exp(g_c + m_st - m_new)
        bb = jnp.exp(m_l - m_new)
        c_new = a[..., None, None] * c_st + bb[..., None, None] * c_l
        n_new = a[..., None] * n_st + bb[..., None] * n_l
        return (c_new, n_new, m_new), (c_st, n_st, m_st)

    init = (jnp.zeros((B, H, D, D), F32), jnp.zeros((B, H, D), F32), jnp.zeros((B, H), F32))
    xs = (jnp.moveaxis(c_loc, 2, 0), jnp.moveaxis(n_loc, 2, 0), jnp.moveaxis(m_loc, 2, 0), jnp.moveaxis(g, 2, 0))
    _, (c_prev, n_prev, m_prev) = lax.scan(step, init, xs)
    c_prev = jnp.moveaxis(c_prev, 0, 2)
    n_prev = jnp.moveaxis(n_prev, 0, 2)
    m_prev = jnp.moveaxis(m_prev, 0, 2)

    log_inter = bcum + m_prev[..., None]
    m_out = jnp.maximum(jnp.max(log_d, axis=-1), log_inter)
    s = jnp.einsum('bhcid,bhcjd->bhcij', qc, kc) * jnp.exp(log_d - m_out[..., None])
    inter = jnp.exp(log_inter - m_out)
    num = jnp.einsum('bhcij,bhcjd->bhcid', s, vc) + inter[..., None] * jnp.einsum('bhcde,bhcie->bhcid', c_prev, qc)
    den = jnp.sum(s, axis=-1) + inter * jnp.einsum('bhce,bhcie->bhci', n_prev, qc)
    h = num / jnp.maximum(jnp.abs(den), jnp.exp(-m_out))[..., None]
    return h.reshape(B, H, S, D)


def mlstm_mixer(q, k, v, o_pre, gates, f_bias, head_g):
    B, S, _ = q.shape
    dt = q.dtype

    def heads(t):
        return t.reshape(B, S, MLSTM_HEADS, MLSTM_DIM).transpose(0, 2, 1, 3).astype(F32)

    qh, kh, vh = heads(q), heads(k), heads(v)
    gt = gates.astype(F32).reshape(B, S, 4, MLSTM_HEADS).transpose(2, 0, 3, 1)
    fb = f_bias.astype(F32)
    h_fw = mlstm_chunkwise(qh, kh, vh, gt[0], gt[1] + fb[0][None, :, None])
    flip = lambda t: jnp.flip(t, axis=2)
    h_bw = jnp.flip(mlstm_chunkwise(flip(qh), flip(kh), flip(vh), jnp.flip(gt[2], axis=-1),
                                    jnp.flip(gt[3] + fb[1][None, :, None], axis=-1)), axis=2)
    h = rms_norm((h_fw + h_bw).transpose(0, 2, 1, 3), head_g)
    return h.reshape(B, S, MLSTM_WIDTH).astype(dt) * jax.nn.sigmoid(o_pre)


def expert_choice_moe(h, w_router, w_gate, w_up, w_down):
    B, S, D = h.shape
    cap = CAPACITY_FACTOR * S // N_EXPERTS
    aff = jax.nn.softmax(jnp.einsum('bsd,de->bse', h, w_router).astype(F32), axis=-1)
    gate, idx = lax.top_k(jnp.swapaxes(aff, 1, 2), cap)
    xg = jax.vmap(lambda hb, ib: hb[ib])(h, idx)
    a = jnp.einsum('becd,edf->becf', xg, w_gate)
    u = jnp.einsum('becd,edf->becf', xg, w_up)
    y = jnp.einsum('becf,efd->becd', jax.nn.silu(a) * u, w_down) * gate[..., None].astype(h.dtype)
    return jax.vmap(lambda yb, ib: jnp.zeros((S, D), yb.dtype).at[ib.reshape(-1)].add(yb.reshape(-1, D)))(y, idx)


def setup_inputs(seed: int = 0) -> dict:
    key = jax.random.key(seed)
    ks = jax.random.split(key, 24)
    nrm = lambda k, shape, s: jax.random.normal(k, shape, F32) * s
    gain = lambda k, shape: 1.0 + 0.02 * jax.random.normal(k, shape, F32)
    u = jax.random.uniform(ks[11], (DEPTH, 2, LRU_WIDTH), F32, 0.9, 0.999)
    a0 = u ** (1.0 / LRU_C)
    lam = jnp.log(a0) - jnp.log1p(-a0)
    f_bias = jnp.broadcast_to(jnp.linspace(3.0, 6.0, MLSTM_HEADS), (DEPTH, 2, MLSTM_HEADS)) \
        + 0.1 * jax.random.normal(ks[12], (DEPTH, 2, MLSTM_HEADS), F32)
    return {
        'x': jax.random.normal(ks[0], (BATCH, SEQ, D_MODEL), F32),
        'norm1_g': gain(ks[1], (DEPTH, D_MODEL)),
        'w_in': nrm(ks[2], (DEPTH, D_MODEL, D_IN), D_MODEL ** -0.5),
        'q_norm_g': gain(ks[3], (DEPTH, HEAD_DIM)),
        'k_norm_g': gain(ks[4], (DEPTH, HEAD_DIM)),
        'conv_w': nrm(ks[5], (DEPTH, CONV_WIDTH, LRU_WIDTH), CONV_WIDTH ** -0.5),
        'conv_b': nrm(ks[6], (DEPTH, LRU_WIDTH), 0.02),
        'lru_wa': nrm(ks[7], (DEPTH, 2, LRU_BLOCKS, LRU_BLOCK_DIM, LRU_BLOCK_DIM), LRU_BLOCK_DIM ** -0.5),
        'lru_ba': nrm(ks[8], (DEPTH, 2, LRU_WIDTH), 0.02),
        'lru_wx': nrm(ks[9], (DEPTH, 2, LRU_BLOCKS, LRU_BLOCK_DIM, LRU_BLOCK_DIM), LRU_BLOCK_DIM ** -0.5),
        'lru_bx': nrm(ks[10], (DEPTH, 2, LRU_WIDTH), 0.02),
        'lru_lambda': lam,
        'mlstm_f_bias': f_bias,
        'mlstm_norm_g': gain(ks[13], (DEPTH, MLSTM_HEADS, MLSTM_DIM)),
        'att_out_g': gain(ks[14], (DEPTH, ATT_WIDTH)),
        'lru_out_g': gain(ks[15], (DEPTH, LRU_WIDTH)),
        'w_out': nrm(ks[16], (DEPTH, D_MIX, D_MODEL), D_MIX ** -0.5),
        'norm2_g': gain(ks[17], (DEPTH, D_MODEL)),
        'w_router': nrm(ks[18], (DEPTH, D_MODEL, N_EXPERTS), D_MODEL ** -0.5),
        'w_expert_gate': nrm(ks[19], (DEPTH, N_EXPERTS, D_MODEL, D_EXPERT), D_MODEL ** -0.5),
        'w_expert_up': nrm(ks[20], (DEPTH, N_EXPERTS, D_MODEL, D_EXPERT), D_MODEL ** -0.5),
        'w_expert_down': nrm(ks[21], (DEPTH, N_EXPERTS, D_EXPERT, D_MODEL), D_EXPERT ** -0.5),
    }


def reference(x, norm1_g, w_in, q_norm_g, k_norm_g, conv_w, conv_b, lru_wa, lru_ba, lru_wx, lru_bx,
              lru_lambda, mlstm_f_bias, mlstm_norm_g, att_out_g, lru_out_g, w_out, norm2_g, w_router,
              w_expert_gate, w_expert_up, w_expert_down):
    for l in range(DEPTH):
        h = rms_norm(x, norm1_g[l])
        aq, ak, av, lx, lg, mq, mk, mv, mo, mg = split_columns(h @ w_in[l])
        y_att = axial_gqa_attention(aq, ak, av, q_norm_g[l], k_norm_g[l])
        y_lru = rglru_mixer(lx, lg, conv_w[l], conv_b[l], lru_wa[l], lru_ba[l], lru_wx[l], lru_bx[l], lru_lambda[l])
        y_mls = mlstm_mixer(mq, mk, mv, mo, mg, mlstm_f_bias[l], mlstm_norm_g[l])
        y = jnp.concatenate([rms_norm(y_att, att_out_g[l]), rms_norm(y_lru, lru_out_g[l]), y_mls], axis=-1)
        x = x + y @ w_out[l]
        h2 = rms_norm(x, norm2_g[l])
        x = x + expert_choice_moe(h2, w_router[l], w_expert_gate[l], w_expert_up[l], w_expert_down[l])
    return x
```

```cpp
#include <hip/hip_runtime.h>
#include <hip/hip_bf16.h>
#include <cstdio>
#include <cstdint>
#include <cmath>
__device__ __forceinline__ int ltid() { int t = threadIdx.x; asm volatile("" : "+v"(t)); return t; }
__device__ __forceinline__ int lbid() { int t = blockIdx.x; asm volatile("" : "+s"(t)); return t; }
namespace pg8 {
#define PG8_LAS __attribute__((address_space(3)))
typedef unsigned short bf16_t;
typedef short bf16x8 __attribute__((ext_vector_type(8)));
typedef float f32x4 __attribute__((ext_vector_type(4)));
typedef unsigned u32x4 __attribute__((ext_vector_type(4)));
constexpr int BM = 256, BK = 64, HALF = 128, HTB = HALF * BK * 2  , STAGE_BYTES = 8 * HTB, NXCD = 8, WGM = 8;

__host__ __device__ __forceinline__ int lds_byte(int r, int c) { const int st = (r >> 4) * 2 + (c >> 5), rr = r & 15, cc = c & 31, ob = rr * 64 + cc * 2; return st * 1024 + (ob ^ (((ob >> 9) & 1) << 5)); }
__host__ __device__ __forceinline__ void stage_rc(int b, int& R, int& C) { const int st = b / 1024, sb = b % 1024, swz = sb ^ (((sb >> 9) & 1) << 5); R = (st >> 1) * 16 + swz / 64; C = (st & 1) * 32 + (swz % 64) / 2; }
__host__ __device__ __forceinline__ int perm32(int rho) { const int n = rho >> 4, i = rho & 15; return 8 * (i >> 2) + 4 * n + (i & 3); }

struct Unit { int pm, pn; };
struct Gemm { const bf16_t* A; const bf16_t* Bt; int M, N, K; };

struct StaticOrder {
    int nM, nN, nwg, G, c;
    __host__ __device__ void init(int M, int N, int G_, int c_) { nM = M / BM; nN = N / BM; nwg = nM * nN; G = G_; c = c_; }
    __host__ __device__ bool next(int i, Unit& u) const {
        const long L = (long)i * G + c; if (L >= nwg) return false;
        int wgid = (int)L; { const int q = nwg / NXCD, r = nwg % NXCD, xcd = wgid % NXCD, off = wgid / NXCD; wgid = (xcd < r ? xcd * (q + 1) : r * (q + 1) + (xcd - r) * q) + off; }
        const int nig = WGM * nN, gid = wgid / nig, fm = gid * WGM, gsz = (nM - fm) < WGM ? (nM - fm) : WGM;
        u.pm = fm + ((wgid % nig) % gsz); u.pn = (wgid % nig) / gsz; return true;
    }
    __device__ __forceinline__ void a_ready(const Unit&) const {}
    __device__ __forceinline__ void done(const Unit&) const {}
};

__device__ __forceinline__ unsigned cvt_pk_bf16(float lo, float hi) { unsigned r; asm volatile("v_cvt_pk_bf16_f32 %0, %1, %2" : "=v"(r) : "v"(lo), "v"(hi)); return r; }
typedef float f32x2 __attribute__((ext_vector_type(2)));
__device__ __forceinline__ f32x2 gelu_pk(f32x2 v) {
    const f32x2 av = __builtin_elementwise_abs(v), d = av * 0.2316418882f + 1.0f;
    f32x2 t; t.x = __builtin_amdgcn_rcpf(d.x); t.y = __builtin_amdgcn_rcpf(d.y);
    f32x2 q = t * 0.5307027145f + (-0.7265760135f); q = q * t + 0.7107068705f; q = q * t + (-0.142248368f); q = q * t + 0.127414796f; q = q * t;
    const f32x2 s = (v * v) * (-0.72134752044f);
    f32x2 e; e.x = __builtin_amdgcn_exp2f(s.x); e.y = __builtin_amdgcn_exp2f(s.y);
    const f32x2 m = v * (q * e), r = v - m;
    f32x2 o; o.x = v.x < 0.f ? m.x : r.x; o.y = v.y < 0.f ? m.y : r.y; return o;
}

template <int ACT  > struct EpiBf16 {
    static constexpr bool PERM = true, AFTER_DRAIN = false; static_assert(ACT == 0 || ACT == 1, "EpiBf16: ACT is 0 (none) or 1 (gelu_pk)");
    bf16_t* O; int ldc; const float* bias; int split_cols; size_t split_stride; float scale0;
    __device__ __forceinline__ void operator()(const f32x4 (&acc)[2][2][4][2], const Unit& u, int wr, int wc, int fr, int fq) const {
        const int row0 = u.pm * BM + wr * 64 + fr; int colt = u.pn * BM; bf16_t* base = O;
        float sc = 1.f; if (split_cols) { const int t = colt / split_cols; base += (size_t)t * split_stride; colt -= t * split_cols; if (t == 0) sc = scale0; }
        const int col0 = colt + wc * 32 + 8 * fq, bcol0 = u.pn * BM + wc * 32 + 8 * fq;
        f32x4 bv[2][2];
#pragma unroll
        for (int bj = 0; bj < 2; ++bj)
#pragma unroll
            for (int n = 0; n < 2; ++n) bv[bj][n] = bias ? *(const f32x4*)(bias + bcol0 + bj * HALF + 4 * n) : (f32x4){0.f, 0.f, 0.f, 0.f};
#pragma unroll
        for (int ai = 0; ai < 2; ++ai)
#pragma unroll
            for (int m = 0; m < 4; ++m) { bf16_t* rowp = base + (size_t)(row0 + ai * HALF + m * 16) * ldc + col0;
#pragma unroll
                for (int bj = 0; bj < 2; ++bj) { f32x4 v0 = acc[ai][bj][m][0] + bv[bj][0], v1 = acc[ai][bj][m][1] + bv[bj][1];
                    if (ACT == 1) { f32x2 a = gelu_pk((f32x2){v0[0], v0[1]}), b = gelu_pk((f32x2){v0[2], v0[3]}), c = gelu_pk((f32x2){v1[0], v1[1]}), d = gelu_pk((f32x2){v1[2], v1[3]});
                        v0 = (f32x4){a.x, a.y, b.x, b.y}; v1 = (f32x4){c.x, c.y, d.x, d.y}; }
                    v0 = v0 * sc; v1 = v1 * sc; u32x4 w; w.x = cvt_pk_bf16(v0[0], v0[1]); w.y = cvt_pk_bf16(v0[2], v0[3]); w.z = cvt_pk_bf16(v1[0], v1[1]); w.w = cvt_pk_bf16(v1[2], v1[3]);
                    *(u32x4*)(rowp + bj * HALF) = w; } }
    }
};

struct EpiResidF32 {
    static constexpr bool PERM = false, AFTER_DRAIN = false;
    const float* base; float* C; int ldc;
    __device__ __forceinline__ void operator()(const f32x4 (&acc)[2][2][4][2], const Unit& u, int wr, int wc, int fr, int fq) const {
        const int row0 = u.pm * BM + wr * 64 + fr, col0 = u.pn * BM + wc * 32 + 4 * fq;
#pragma unroll
        for (int ai = 0; ai < 2; ++ai)
#pragma unroll
            for (int m = 0; m < 4; ++m) { const size_t off = (size_t)(row0 + ai * HALF + m * 16) * ldc + col0;
#pragma unroll
                for (int bj = 0; bj < 2; ++bj)
#pragma unroll
                    for (int n = 0; n < 2; ++n) { const f32x4 b = *(const f32x4*)(base + off + bj * HALF + n * 16); *(f32x4*)(C + off + bj * HALF + n * 16) = acc[ai][bj][m][n] + b; } }
    }
};
__device__ __forceinline__ float silu_f(float x) { return x * __builtin_amdgcn_rcpf(1.0f + __builtin_amdgcn_exp2f(-1.4426950408889634f * x)); }
struct EpiSwiGLU {
    static constexpr bool PERM = true, AFTER_DRAIN = false;
    bf16_t* O; int ldc;
    __device__ __forceinline__ void operator()(const f32x4 (&acc)[2][2][4][2], const Unit& u, int wr, int wc, int fr, int fq) const {
        const int row0 = u.pm * BM + wr * 64 + fr, col0 = (u.pn & 15) * HALF + wc * 32 + 8 * fq;
#pragma unroll
        for (int ai = 0; ai < 2; ++ai)
#pragma unroll
            for (int m = 0; m < 4; ++m) { bf16_t* rowp = O + (size_t)(row0 + ai * HALF + m * 16) * ldc + col0;
                const f32x4 g0 = acc[ai][0][m][0], g1 = acc[ai][0][m][1], u0 = acc[ai][1][m][0], u1 = acc[ai][1][m][1];
                u32x4 w; w.x = cvt_pk_bf16(silu_f(g0[0]) * u0[0], silu_f(g0[1]) * u0[1]); w.y = cvt_pk_bf16(silu_f(g0[2]) * u0[2], silu_f(g0[3]) * u0[3]);
                w.z = cvt_pk_bf16(silu_f(g1[0]) * u1[0], silu_f(g1[1]) * u1[1]); w.w = cvt_pk_bf16(silu_f(g1[2]) * u1[2], silu_f(g1[3]) * u1[3]);
                *(u32x4*)rowp = w; }
    }
};
struct EpiScaleBf16 {
    static constexpr bool PERM = true, AFTER_DRAIN = false;
    bf16_t* O; int ldc; const float* rowscale;
    __device__ __forceinline__ void operator()(const f32x4 (&acc)[2][2][4][2], const Unit& u, int wr, int wc, int fr, int fq) const {
        const int row0 = u.pm * BM + wr * 64 + fr, col0 = (u.pn & 3) * BM + wc * 32 + 8 * fq;
#pragma unroll
        for (int ai = 0; ai < 2; ++ai)
#pragma unroll
            for (int m = 0; m < 4; ++m) { const int row = row0 + ai * HALF + m * 16; const float s = rowscale[row]; bf16_t* rowp = O + (size_t)row * ldc + col0;
#pragma unroll
                for (int bj = 0; bj < 2; ++bj) { const f32x4 v0 = acc[ai][bj][m][0] * s, v1 = acc[ai][bj][m][1] * s;
                    u32x4 w; w.x = cvt_pk_bf16(v0[0], v0[1]); w.y = cvt_pk_bf16(v0[2], v0[3]); w.z = cvt_pk_bf16(v1[0], v1[1]); w.w = cvt_pk_bf16(v1[2], v1[3]);
                    *(u32x4*)(rowp + bj * HALF) = w; } }
    }
};
struct Moe1Order {
    int G, c;
    __device__ __forceinline__ bool next(int i, Unit& u) const {
        const int L = i * G + c; if (L >= 2048) return false;
        const int e = L >> 7, r = L & 127; u.pm = e * 8 + ((r >> 3) & 7); u.pn = e * 16 + 2 * (r & 7) + (r >> 6); return true;
    }
    __device__ __forceinline__ void a_ready(const Unit&) const {}
    __device__ __forceinline__ void done(const Unit&) const {}
};
struct Moe2Order {
    int G, c;
    __device__ __forceinline__ bool next(int i, Unit& u) const {
        const int L = i * G + c; if (L >= 512) return false;
        const int q = L & 7, Lp = L >> 3, e = 8 * (Lp >> 5) + q, k = Lp & 31; u.pm = e * 8 + (k & 7); u.pn = e * 4 + (k >> 3); return true;
    }
    __device__ __forceinline__ void a_ready(const Unit&) const {}
    __device__ __forceinline__ void done(const Unit&) const {}
};
template <class Epi, class Sched, bool ALIGN_EPI = false, bool SP2 = false>
__device__ __forceinline__ void gemm_phase(PG8_LAS unsigned char* lds, const Gemm g, const Sched& S, const Epi& E) {
    const int tid = ltid(), wid = __builtin_amdgcn_readfirstlane(tid >> 6), lane = tid & 63, wr = wid >> 2, wc = wid & 3, fr = lane & 15, fq = lane >> 4;
    const int K = g.K, nt = K / BK;
    unsigned voffA[2], voffB[2];
#pragma unroll
    for (int i = 0; i < 2; ++i) { int R, C; stage_rc(tid * 16 + i * 8192, R, C); const int Rb = Epi::PERM ? ((R & ~31) + perm32(R & 31)) : R;
        voffA[i] = (unsigned)(R * K + C) * 2u; voffB[i] = (unsigned)(Rb * K + C) * 2u; }
    const size_t kstep = (size_t)(BK * 2);
    const size_t hstep = (size_t)HALF * K * 2;
    const size_t tstep = 2 * hstep;
    const unsigned ldsw = (unsigned)wid * 1024u;
    const int aoff = lds_byte(wr * 64 + fr, fq * 8), boff = lds_byte(wc * 32 + fr, fq * 8);
#define PG8_SA(b, h) (((b) * 2 + (h)) * HTB)
#define PG8_SB(b, h) ((4 + (b) * 2 + (h)) * HTB)
#define PG8_STAGE(bufoff, gbase, voff) do { _Pragma("unroll") for (int _i = 0; _i < 2; ++_i) \
        __builtin_amdgcn_global_load_lds((const unsigned*)((const char*)(gbase) + (voff)[_i]), (PG8_LAS unsigned*)(lds + (bufoff) + ldsw + _i * 8192), 16, 0, 0); } while (0)
#define PG8_LDA(dst, b, h) do { _Pragma("unroll") for (int m = 0; m < 4; ++m) _Pragma("unroll") for (int k = 0; k < 2; ++k) dst[m][k] = *(const PG8_LAS bf16x8*)(lds + PG8_SA(b, h) + aoff + m * 2048 + k * 1024); } while (0)
#define PG8_LDB(dst, b, h) do { _Pragma("unroll") for (int n = 0; n < 2; ++n) _Pragma("unroll") for (int k = 0; k < 2; ++k) dst[n][k] = *(const PG8_LAS bf16x8*)(lds + PG8_SB(b, h) + boff + n * 2048 + k * 1024); } while (0)
#define PG8_MMA(ai, bj, At, Bt) do { __builtin_amdgcn_s_setprio(1); _Pragma("unroll") for (int m = 0; m < 4; ++m) _Pragma("unroll") for (int n = 0; n < 2; ++n) _Pragma("unroll") for (int k = 0; k < 2; ++k) \
        acc[ai][bj][m][n] = __builtin_amdgcn_mfma_f32_16x16x32_bf16(Bt[n][k], At[m][k], acc[ai][bj][m][n], 0, 0, 0); __builtin_amdgcn_s_setprio(0); } while (0)
#define PG8_WAIT_V(n) asm volatile("s_waitcnt vmcnt(" #n ")" ::: "memory")
#define PG8_WAIT_L(n) asm volatile("s_waitcnt lgkmcnt(" #n ")" ::: "memory")
#define PG8_BAR __builtin_amdgcn_s_barrier()
#define PG8_SCHED __builtin_amdgcn_sched_barrier(0)
    Unit cur, nxt; int ui = 0;
    if (!S.next(0, cur)) return;
    f32x4 acc[2][2][4][2];
#pragma unroll
    for (int a = 0; a < 2; ++a)
#pragma unroll
        for (int b = 0; b < 2; ++b)
#pragma unroll
            for (int m = 0; m < 4; ++m)
#pragma unroll
                for (int n = 0; n < 2; ++n) acc[a][b][m][n] = (f32x4){0.f, 0.f, 0.f, 0.f};
    bf16x8 At[4][2], B0[2][2], B1[2][2];
    const char* cA = (const char*)g.A + (size_t)cur.pm * tstep; const char* cB = (const char*)g.Bt + (size_t)cur.pn * tstep;
    S.a_ready(cur);
    if constexpr (SP2) {
        PG8_STAGE(PG8_SB(0, 0), cB, voffB); PG8_STAGE(PG8_SB(0, 1), cB + hstep, voffB); PG8_STAGE(PG8_SA(0, 0), cA, voffA); PG8_STAGE(PG8_SA(0, 1), cA + hstep, voffA);
        if (wr == 1) PG8_BAR;
        PG8_WAIT_V(2); PG8_BAR;
        PG8_STAGE(PG8_SB(1, 0), cB + kstep, voffB); PG8_STAGE(PG8_SA(1, 0), cA + kstep, voffA); PG8_STAGE(PG8_SB(1, 1), cB + hstep + kstep, voffB);
        PG8_WAIT_V(6); PG8_BAR;
    } else {
        PG8_STAGE(PG8_SB(0, 0), cB, voffB); PG8_STAGE(PG8_SA(0, 0), cA, voffA); PG8_STAGE(PG8_SB(0, 1), cB + hstep, voffB); PG8_STAGE(PG8_SA(0, 1), cA + hstep, voffA);
        if (wr == 1) PG8_BAR;
        PG8_WAIT_V(4); PG8_BAR;
        PG8_STAGE(PG8_SB(1, 0), cB + kstep, voffB); PG8_STAGE(PG8_SA(1, 0), cA + kstep, voffA); PG8_STAGE(PG8_SB(1, 1), cB + hstep + kstep, voffB);
        PG8_WAIT_V(6); PG8_BAR;
    }
    for (;;) {
        const bool has_next = S.next(ui + 1, nxt);
        const char* nA = has_next ? (const char*)g.A + (size_t)nxt.pm * tstep : cA; const char* nB = has_next ? (const char*)g.Bt + (size_t)nxt.pn * tstep : cB;
        for (int t = 0; t < nt; t += 2) {
            const bool last = (t == nt - 2);
            const char* a1 = cA + (size_t)(t + 1) * kstep;
            const char* a2 = last ? nA : cA + (size_t)(t + 2) * kstep; const char* b2 = last ? nB : cB + (size_t)(t + 2) * kstep;
            const char* a3 = a2 + kstep; const char* b3 = b2 + kstep;
            if (last && has_next) S.a_ready(nxt);
            if constexpr (SP2) {
            PG8_LDB(B0, 0, 0); PG8_LDB(B1, 0, 1); PG8_SCHED; PG8_LDA(At, 0, 0); PG8_STAGE(PG8_SA(1, 1), a1 + hstep, voffA);
            PG8_WAIT_V(8); PG8_WAIT_L(0); PG8_BAR; PG8_MMA(0, 0, At, B0); PG8_MMA(0, 1, At, B1); PG8_BAR; PG8_SCHED;
            PG8_LDA(At, 0, 1); PG8_STAGE(PG8_SB(0, 0), b2, voffB); PG8_STAGE(PG8_SB(0, 1), b2 + hstep, voffB); PG8_STAGE(PG8_SA(0, 0), a2, voffA);
            PG8_WAIT_V(8); PG8_WAIT_L(0); PG8_BAR; PG8_MMA(1, 0, At, B0); PG8_MMA(1, 1, At, B1); PG8_BAR; PG8_SCHED;
            PG8_LDB(B0, 1, 0); PG8_LDB(B1, 1, 1); PG8_SCHED; PG8_LDA(At, 1, 0); PG8_STAGE(PG8_SA(0, 1), a2 + hstep, voffA);
            PG8_WAIT_V(8); PG8_WAIT_L(0); PG8_BAR; PG8_MMA(0, 0, At, B0); PG8_MMA(0, 1, At, B1); PG8_BAR; PG8_SCHED;
            PG8_LDA(At, 1, 1); PG8_STAGE(PG8_SB(1, 0), b3, voffB); PG8_STAGE(PG8_SB(1, 1), b3 + hstep, voffB); PG8_STAGE(PG8_SA(1, 0), a3, voffA);
            PG8_WAIT_V(8); PG8_WAIT_L(0); PG8_BAR; PG8_MMA(1, 0, At, B0); PG8_MMA(1, 1, At, B1); PG8_BAR; PG8_SCHED;
            } else {
            PG8_LDB(B0, 0, 0); PG8_SCHED; PG8_LDA(At, 0, 0); PG8_STAGE(PG8_SA(1, 1), a1 + hstep, voffA);
            PG8_WAIT_L(8); PG8_BAR; PG8_WAIT_L(0); PG8_MMA(0, 0, At, B0); PG8_BAR; PG8_SCHED;
            PG8_LDB(B1, 0, 1); PG8_STAGE(PG8_SB(0, 0), b2, voffB);
            PG8_BAR; PG8_WAIT_L(0); PG8_MMA(0, 1, At, B1); PG8_BAR;
            PG8_LDA(At, 0, 1); PG8_STAGE(PG8_SA(0, 0), a2, voffA);
            PG8_BAR; PG8_WAIT_L(0); PG8_MMA(1, 0, At, B0); PG8_BAR; PG8_SCHED;
            PG8_STAGE(PG8_SB(0, 1), b2 + hstep, voffB);
            PG8_WAIT_V(6); PG8_BAR; PG8_MMA(1, 1, At, B1); PG8_BAR;
            PG8_LDB(B0, 1, 0); PG8_SCHED; PG8_LDA(At, 1, 0); PG8_STAGE(PG8_SA(0, 1), a2 + hstep, voffA);
            PG8_WAIT_L(8); PG8_BAR; PG8_WAIT_L(0); PG8_MMA(0, 0, At, B0); PG8_BAR; PG8_SCHED;
            PG8_LDB(B1, 1, 1); PG8_STAGE(PG8_SB(1, 0), b3, voffB);
            PG8_BAR; PG8_WAIT_L(0); PG8_MMA(0, 1, At, B1); PG8_BAR;
            PG8_LDA(At, 1, 1); PG8_STAGE(PG8_SA(1, 0), a3, voffA);
            PG8_BAR; PG8_WAIT_L(0); PG8_MMA(1, 0, At, B0); PG8_BAR; PG8_SCHED;
            PG8_STAGE(PG8_SB(1, 1), b3 + hstep, voffB);
            PG8_WAIT_V(6); PG8_BAR; PG8_MMA(1, 1, At, B1); PG8_BAR;
            }
        }
        if constexpr (ALIGN_EPI) { if (wr == 0) PG8_BAR; }
        if constexpr (!Epi::AFTER_DRAIN) { E(acc, cur, wr, wc, fr, fq); S.done(cur); }
        if (!has_next) break;
#pragma unroll
        for (int a = 0; a < 2; ++a)
#pragma unroll
            for (int b = 0; b < 2; ++b)
#pragma unroll
                for (int m = 0; m < 4; ++m)
#pragma unroll
                    for (int n = 0; n < 2; ++n) acc[a][b][m][n] = (f32x4){0.f, 0.f, 0.f, 0.f};
        cur = nxt; cA = nA; cB = nB; ++ui;
        if constexpr (ALIGN_EPI) { if (wr == 1) PG8_BAR; }
    }
    PG8_WAIT_V(0);
    if constexpr (!ALIGN_EPI) { if (wr == 0) PG8_BAR; }
    PG8_BAR;
    if constexpr (Epi::AFTER_DRAIN) { E.fused(acc, cur, wr, wc, fr, fq, lds, wid, lane); S.done(cur); }
#undef PG8_SA
#undef PG8_SB
#undef PG8_STAGE
#undef PG8_LDA
#undef PG8_LDB
#undef PG8_MMA
#undef PG8_WAIT_V
#undef PG8_WAIT_L
#undef PG8_BAR
#undef PG8_SCHED
}
}

namespace attn_body {
using bf16=__hip_bfloat16;
using bf16x8=__attribute__((ext_vector_type(8)))short;
using s16x4=__attribute__((ext_vector_type(4)))short;
using f32x16=__attribute__((ext_vector_type(16)))float;
using u32x4=__attribute__((ext_vector_type(4)))unsigned;
constexpr int BATCH=8,NHEAD=8,NKV=2,SEQ=2048,D=64,PQ=2304,PO=1024;
constexpr int NW=8,QBLK=32,QB=QBLK*NW,KVBLK=64,NQB=SEQ/QB;
constexpr int ATTN_UNIT_ROWS=QB;
__device__ __forceinline__ int crow(int r,int hi){return (r&3)+8*(r>>2)+4*hi;}
#define SBAR() __builtin_amdgcn_sched_barrier(0)
__device__ __forceinline__ void cmask(f32x16&p0,f32x16&p1,int jb,int qrel,int hi){
  const float NEG=-INFINITY; int kb=64*jb+4*hi;
  #pragma unroll
  for(int r=0;r<16;++r){int kv=kb+(r&3)+8*(r>>2); if(kv>qrel)p0[r]=NEG; if(kv+32>qrel)p1[r]=NEG;}
}

constexpr int NSLOT=3, SLOTB=8192;
constexpr int LDS_K=0, LDS_V=NSLOT*SLOTB, LDS_WS=2*NSLOT*SLOTB, LDS_OST=LDS_WS+NW*64*4, LDS_BYTES=LDS_OST+NW*4096;
constexpr float C2=0.125f*1.4426950408889634f;
__device__ __forceinline__ void glds16(const void*gsrc,unsigned lds_dst){unsigned keep;
  asm volatile("s_mov_b32 %0, m0\n\ts_mov_b32 m0, %2\n\ts_nop 0\n\tglobal_load_lds_dwordx4 %1, off\n\ts_mov_b32 m0, %0":"=&s"(keep):"v"(gsrc),"s"(lds_dst):"memory");}
__device__ __forceinline__ float max3f(float a,float b,float c){float r;asm("v_max3_f32 %0, %1, %2, %3":"=v"(r):"v"(a),"v"(b),"v"(c));return r;}
__device__ __forceinline__ float max2f(float a,float b){float r;asm("v_max_f32_e32 %0, %1, %2":"=v"(r):"v"(a),"v"(b));return r;}
__device__ __forceinline__ float fadd_s(float a,float b){float r;asm("v_add_f32_e32 %0, %1, %2":"=v"(r):"v"(a),"v"(b));return r;}
__device__ __forceinline__ float fsub_s(float a,float b){float r;asm("v_sub_f32_e32 %0, %1, %2":"=v"(r):"v"(a),"v"(b));return r;}
typedef float f32x2_t __attribute__((ext_vector_type(2))); typedef __bf16 bf16x2_t __attribute__((ext_vector_type(2)));
__device__ __forceinline__ unsigned cvtpk_s(float lo,float hi){f32x2_t v={lo,hi};bf16x2_t b=__builtin_convertvector(v,bf16x2_t);return __builtin_bit_cast(unsigned,b);}
#define WAIT_BAR(N) asm volatile("s_waitcnt vmcnt(" #N ") lgkmcnt(0)\n\ts_barrier":::"memory")

__device__ __forceinline__ void qkt(f32x16&p0,f32x16&p1,const char*Kslot,const bf16x8*qr,const f32x16&negm,int r32,int hi){
  const char*kb=Kslot+hi*1024+r32*16;
  #pragma unroll
  for(int d0=0;d0<4;++d0){
    const bf16x8 b0=*reinterpret_cast<const bf16x8*>(kb+d0*2048);
    const bf16x8 b1=*reinterpret_cast<const bf16x8*>(kb+d0*2048+512);
    if(d0==0){p0=__builtin_amdgcn_mfma_f32_32x32x16_bf16(b0,qr[0],negm,0,0,0);p1=__builtin_amdgcn_mfma_f32_32x32x16_bf16(b1,qr[0],negm,0,0,0);}
    else{p0=__builtin_amdgcn_mfma_f32_32x32x16_bf16(b0,qr[d0],p0,0,0,0);p1=__builtin_amdgcn_mfma_f32_32x32x16_bf16(b1,qr[d0],p1,0,0,0);}}
}
typedef __attribute__((address_space(3))) const char* lds_cptr;
typedef short v4i16_t __attribute__((ext_vector_type(4)));
__device__ __forceinline__ void kload8(bf16x8*kf,lds_cptr kp){
  kf[0]=*(const __attribute__((address_space(3))) bf16x8*)(kp);      kf[1]=*(const __attribute__((address_space(3))) bf16x8*)(kp+512);
  kf[2]=*(const __attribute__((address_space(3))) bf16x8*)(kp+2048); kf[3]=*(const __attribute__((address_space(3))) bf16x8*)(kp+2560);
  kf[4]=*(const __attribute__((address_space(3))) bf16x8*)(kp+4096); kf[5]=*(const __attribute__((address_space(3))) bf16x8*)(kp+4608);
  kf[6]=*(const __attribute__((address_space(3))) bf16x8*)(kp+6144); kf[7]=*(const __attribute__((address_space(3))) bf16x8*)(kp+6656);
}
__device__ __forceinline__ void kload2(bf16x8*kf,lds_cptr kp,int j){ kf[2*j]=*(const __attribute__((address_space(3))) bf16x8*)(kp+j*2048); kf[2*j+1]=*(const __attribute__((address_space(3))) bf16x8*)(kp+j*2048+512); }
__device__ __forceinline__ s16x4 vtr(lds_cptr p){ return __builtin_bit_cast(s16x4,__builtin_amdgcn_ds_read_tr16_b64_v4i16((__attribute__((address_space(3))) v4i16_t*)p)); }
__device__ __forceinline__ float rowmax(const f32x16&p0,const f32x16&p1){
  float a=max3f(p0[0],p0[1],p1[0]),b=max3f(p0[2],p0[3],p1[1]);a=max3f(a,p1[2],p1[3]);
  #pragma unroll
  for(int r=4;r<16;r+=4){a=max3f(a,p0[r],p0[r+1]);b=max3f(b,p0[r+2],p0[r+3]);a=max3f(a,p1[r],p1[r+1]);b=max3f(b,p1[r+2],p1[r+3]);}
  const float m=max2f(a,b);
  auto rr=__builtin_amdgcn_permlane32_swap(__float_as_uint(m),__float_as_uint(m),false,false);
  return max2f(__uint_as_float(rr[0]),__uint_as_float(rr[1]));
}
__device__ __forceinline__ void pv(f32x16*o,int vb,bf16x8 pa0,bf16x8 pa1,bf16x8 pa2,bf16x8 pa3){
  #pragma unroll
  for(int d0=0;d0<2;++d0){s16x4 lo[4],hi[4];
    #pragma unroll
    for(int ks=0;ks<4;++ks){
      asm volatile("ds_read_b64_tr_b16 %0,%1 offset:%c2":"=&v"(lo[ks]):"v"(vb),"i"(d0*4096+ks*1024):"memory");
      asm volatile("ds_read_b64_tr_b16 %0,%1 offset:%c2":"=&v"(hi[ks]):"v"(vb),"i"(d0*4096+ks*1024+512):"memory");}
    asm volatile("s_waitcnt lgkmcnt(0)":::"memory");SBAR();
    #define PK(k) (bf16x8){lo[k][0],lo[k][1],lo[k][2],lo[k][3],hi[k][0],hi[k][1],hi[k][2],hi[k][3]}
    o[d0]=__builtin_amdgcn_mfma_f32_32x32x16_bf16(pa0,PK(0),o[d0],0,0,0);
    o[d0]=__builtin_amdgcn_mfma_f32_32x32x16_bf16(pa1,PK(1),o[d0],0,0,0);
    o[d0]=__builtin_amdgcn_mfma_f32_32x32x16_bf16(pa2,PK(2),o[d0],0,0,0);
    o[d0]=__builtin_amdgcn_mfma_f32_32x32x16_bf16(pa3,PK(3),o[d0],0,0,0);
    #undef PK
  }
}

#ifndef ATTN_STORE16
#define ATTN_STORE16(p,v) (*(u32x4*)(p)=(v))
#endif
template<int THRL> __device__ __forceinline__ void attn_unit(int b,int h,int qb,const bf16*Q,const bf16*__restrict__ K,const bf16*__restrict__ V,bf16*O,char*shm){
  const int tid=ltid(),lane=tid&63,r32=lane&31,hi=lane>>5; const int wid=__builtin_amdgcn_readfirstlane(tid>>6);
  const long rowbase=(long)b*SEQ; const int q0=qb*QB;
  const bf16*Qw=Q+(rowbase+q0+wid*QBLK)*PQ+h*D;
  const bf16*Kh=K+rowbase*PQ+(h>>2)*D,*Vh=V+rowbase*PQ+(h>>2)*D;
  const unsigned lds0=(unsigned)(uintptr_t)shm;
  float*wsf=(float*)(shm+LDS_WS)+wid*64;
  const bf16*ksrc=Kh+(long)lane*PQ+wid*8;
  const bf16*vsrc=Vh+(long)(16*(wid&3)+(lane>>2))*PQ+(wid>>2)*32+(lane&3)*8;
  const unsigned kdst=lds0+LDS_K+wid*1024, vdst=lds0+LDS_V+wid*1024;
  #define DMA_K(t,slot) glds16(ksrc+(long)(t)*KVBLK*PQ,(unsigned)__builtin_amdgcn_readfirstlane(kdst+(slot)))
  #define DMA_V(t,slot) glds16(vsrc+(long)(t)*KVBLK*PQ,(unsigned)__builtin_amdgcn_readfirstlane(vdst+(slot)))
  const int vb0=(int)(lds0+LDS_V)+((lane>>4)&1)*32+(lane&3)*8+(4*hi+((lane&15)>>2))*64;
  const char*Kbase=shm+LDS_K; bf16x8 kf[8];
  const lds_cptr shm3=(lds_cptr)shm; const lds_cptr kp0=shm3+LDS_K+hi*1024+r32*16; const lds_cptr vp0=shm3+LDS_V+((lane>>4)&1)*32+(lane&3)*8+(4*hi+((lane&15)>>2))*64;
  const int NT=SEQ/KVBLK;
  DMA_K(0,0);DMA_V(0,0);DMA_K(1,SLOTB);
  bf16x8 qr[4];
  #pragma unroll
  for(int d0=0;d0<4;++d0)qr[d0]=*reinterpret_cast<const bf16x8*>(&Qw[(long)r32*PQ+d0*16+hi*8]);
  float mhat=0.f,l_reg=0.f;f32x16 o[2];o[0]=f32x16{};o[1]=f32x16{};f32x16 negm=f32x16{};asm volatile("":"+v"(negm));
  const int qrel=wid*QBLK+r32;
  #define CMASK(P0,P1,t) do{}while(0)
  bool resc=false;
  #define START(P0,P1) do{ const float rm=rowmax(P0,P1); resc=false; \
    { const float dl=rm; mhat=fadd_s(mhat,dl); \
      _Pragma("unroll") for(int r=0;r<16;++r){P0[r]=fsub_s(P0[r],dl);P1[r]=fsub_s(P1[r],dl);} \
      _Pragma("unroll") for(int r=0;r<16;++r)negm[r]=-mhat; asm volatile("":"+v"(negm)); } \
    _Pragma("unroll") for(int r=0;r<16;++r)P0[r]=__builtin_amdgcn_exp2f(P0[r]); }while(0)
  #define RESC() do{ if(resc){ asm volatile("s_waitcnt lgkmcnt(0)":::"memory"); \
      _Pragma("unroll") for(int d_=0;d_<2;++d_) _Pragma("unroll") for(int r=0;r<16;++r)o[d_][r]*=wsf[crow(r,hi)]; } }while(0)
  f32x16 pA0,pA1,pB0,pB1;
  int sl_prev=0,sl_cur=0,sl_next=SLOTB;
  #define ROT() do{sl_prev=sl_cur;sl_cur=sl_next;sl_next=(sl_next==(NSLOT-1)*SLOTB)?0:sl_next+SLOTB;}while(0)
  DMA_K(2,2*SLOTB);
  WAIT_BAR(3);
  qkt(pA0,pA1,Kbase,qr,negm,r32,hi);asm volatile("s_nop 15\n\ts_nop 7":"+v"(pA0),"+v"(pA1));CMASK(pA0,pA1,0);
  START(pA0,pA1);
  _Pragma("unroll") for(int r=0;r<16;++r)pA1[r]=__builtin_amdgcn_exp2f(pA1[r]);
  WAIT_BAR(0);
  DMA_K(3,0);DMA_V(1,SLOTB);
  ROT();
  kload8(kf,kp0+sl_cur);
  WAIT_BAR(2);
  s16x4 vlo[8],vhi[8]; u32x4 pw0,pw1,pw2,pw3;
  #define PKW(P,B) cvtpk_s(P[B],P[B+1])
  #define PAF(k) __builtin_bit_cast(bf16x8,pw##k)
  #define VFR(i) (bf16x8){vlo[i][0],vlo[i][1],vlo[i][2],vlo[i][3],vhi[i][0],vhi[i][1],vhi[i][2],vhi[i][3]}
  #define PIN(x) asm volatile("":"+v"(x))
  #define MX3(a,b,c) __builtin_fmaxf(__builtin_fmaxf((a),(b)),(c))
  #define GAPA(MF,A0,A1,A2,A3,W0,W1,PW) do{ MF; sacc+=A0; sacc+=A1; sacc+=A2; sacc+=A3; PIN(sacc); W0; W1; PIN(PW); SBAR(); }while(0)
  #define EX(v) __builtin_amdgcn_exp2f(v)
  #define GAPB(MF,X,B) do{ MF; X[B]=EX(X[B]); X[B+1]=EX(X[B+1]); X[B+2]=EX(X[B+2]); X[B+3]=EX(X[B+3]); PIN(X); SBAR(); }while(0)
  #define VRD(i) do{ vlo[i]=vtr(vp_+(((i)>>2)*4096+((i)&3)*1024)); vhi[i]=vtr(vp_+(((i)>>2)*4096+((i)&3)*1024+512)); }while(0)
  #define KRD(G,j) do{ if(G){ kload2(kf,kp0+sl_next,j); SBAR(); } }while(0)
  #define STEP(C0,C1,P0,P1,t,GK,GV,GL) do{ SBAR(); \
    const lds_cptr vp_=vp0+sl_prev; \
    VRD(0); SBAR(); float sacc=(P0[0]+P0[1]); \
    GAPA(C0=__builtin_amdgcn_mfma_f32_32x32x16_bf16(kf[0],qr[0],negm,0,0,0), P0[2],P0[3],P0[4],P0[5],     pw0[0]=PKW(P0,0), pw0[1]=PKW(P0,2), pw0); \
    VRD(4); SBAR(); GAPA(C1=__builtin_amdgcn_mfma_f32_32x32x16_bf16(kf[1],qr[0],negm,0,0,0), P0[6],P0[7],P0[8],P0[9],     pw0[2]=PKW(P0,4), pw0[3]=PKW(P0,6), pw0); \
    VRD(1); SBAR(); GAPA(C0=__builtin_amdgcn_mfma_f32_32x32x16_bf16(kf[2],qr[1],C0,0,0,0),   P0[10],P0[11],P0[12],P0[13], pw1[0]=PKW(P0,8), pw1[1]=PKW(P0,10), pw1); \
    VRD(5); SBAR(); GAPA(C1=__builtin_amdgcn_mfma_f32_32x32x16_bf16(kf[3],qr[1],C1,0,0,0),   P0[14],P0[15],P1[0],P1[1],   pw1[2]=PKW(P0,12),pw1[3]=PKW(P0,14), pw1); \
    VRD(2); SBAR(); GAPA(C0=__builtin_amdgcn_mfma_f32_32x32x16_bf16(kf[4],qr[2],C0,0,0,0),   P1[2],P1[3],P1[4],P1[5],     pw2[0]=PKW(P1,0), pw2[1]=PKW(P1,2), pw2); \
    VRD(6); SBAR(); GAPA(C1=__builtin_amdgcn_mfma_f32_32x32x16_bf16(kf[5],qr[2],C1,0,0,0),   P1[6],P1[7],P1[8],P1[9],     pw2[2]=PKW(P1,4), pw2[3]=PKW(P1,6), pw2); \
    VRD(3); SBAR(); GAPA(C0=__builtin_amdgcn_mfma_f32_32x32x16_bf16(kf[6],qr[3],C0,0,0,0),   P1[10],P1[11],P1[12],P1[13], pw3[0]=PKW(P1,8), pw3[1]=PKW(P1,10), pw3); \
    VRD(7); SBAR(); GAPA(C1=__builtin_amdgcn_mfma_f32_32x32x16_bf16(kf[7],qr[3],C1,0,0,0),   P1[14],P1[15],0.f,0.f,       pw3[2]=PKW(P1,12),pw3[3]=PKW(P1,14), pw3); \
    l_reg+=sacc; \
    if(GK){DMA_K((t)+3,sl_cur);} if(GV){DMA_V((t)+1,sl_next);} \
    CMASK(C0,C1,t); \
    { float a=MX3(C0[0],C0[1],C1[0]),b=MX3(C0[2],C0[3],C1[1]); a=MX3(a,C1[2],C1[3]); \
      _Pragma("unroll") for(int r=4;r<16;r+=4){a=MX3(a,C0[r],C0[r+1]);b=MX3(b,C0[r+2],C0[r+3]);a=MX3(a,C1[r],C1[r+1]);b=MX3(b,C1[r+2],C1[r+3]);} \
      float rm=__builtin_fmaxf(a,b); { auto rr=__builtin_amdgcn_permlane32_swap(__float_as_uint(rm),__float_as_uint(rm),false,false); rm=__builtin_fmaxf(__uint_as_float(rr[0]),__uint_as_float(rr[1])); } \
      resc=false; \
      if(__builtin_expect(__any(rm>(float)THRL),0)){ const float dl=__builtin_fmaxf(rm,0.f); mhat+=dl; \
        _Pragma("unroll") for(int r=0;r<16;++r){C0[r]-=dl;C1[r]-=dl;} \
        _Pragma("unroll") for(int r=0;r<16;++r)negm[r]=-mhat; asm volatile("":"+v"(negm)); \
        const float f=__builtin_amdgcn_exp2f(-dl); l_reg*=f; if(hi==0)wsf[r32]=f; resc=true; } } \
    SBAR(); \
    GAPB(o[0]=__builtin_amdgcn_mfma_f32_32x32x16_bf16(PAF(0),VFR(0),o[0],0,0,0), C0,0); \
    GAPB(o[1]=__builtin_amdgcn_mfma_f32_32x32x16_bf16(PAF(0),VFR(4),o[1],0,0,0), C0,4); \
    KRD(GL,0); GAPB(o[0]=__builtin_amdgcn_mfma_f32_32x32x16_bf16(PAF(1),VFR(1),o[0],0,0,0), C0,8); \
    KRD(GL,1); GAPB(o[1]=__builtin_amdgcn_mfma_f32_32x32x16_bf16(PAF(1),VFR(5),o[1],0,0,0), C0,12); \
    KRD(GL,2); GAPB(o[0]=__builtin_amdgcn_mfma_f32_32x32x16_bf16(PAF(2),VFR(2),o[0],0,0,0), C1,0); \
    KRD(GL,3); GAPB(o[1]=__builtin_amdgcn_mfma_f32_32x32x16_bf16(PAF(2),VFR(6),o[1],0,0,0), C1,4); \
    GAPB(o[0]=__builtin_amdgcn_mfma_f32_32x32x16_bf16(PAF(3),VFR(3),o[0],0,0,0), C1,8); \
    GAPB(o[1]=__builtin_amdgcn_mfma_f32_32x32x16_bf16(PAF(3),VFR(7),o[1],0,0,0), C1,12); \
    }while(0)
  int t=1;
  #undef CMASK
  #define CMASK(P0,P1,t) do{}while(0)
  for(;t+5<NT;t+=2){
    STEP(pB0,pB1,pA0,pA1,t,true,true,true);     WAIT_BAR(2); RESC(); ROT();
    STEP(pA0,pA1,pB0,pB1,t+1,true,true,true);   WAIT_BAR(2); RESC(); ROT();
  }
  #undef CMASK
  #define CMASK(P0,P1,t) do{}while(0)
  #define ENDW(tt) do{ if((tt)+3<NT){WAIT_BAR(2);} else if((tt)+2<NT){WAIT_BAR(1);} else {WAIT_BAR(0);} }while(0)
  for(;t+1<NT;t+=2){
    STEP(pB0,pB1,pA0,pA1,t,(t+3<NT),(t+1<NT),(t+1<NT));       ENDW(t);   RESC(); ROT();
    STEP(pA0,pA1,pB0,pB1,t+1,(t+4<NT),(t+2<NT),(t+2<NT));     ENDW(t+1); RESC(); ROT();
  }
  STEP(pB0,pB1,pA0,pA1,NT-1,false,false,false); RESC();
  { float sacc=pB0[0]+pB0[1]; _Pragma("unroll") for(int r=2;r<16;++r)sacc+=pB0[r]; _Pragma("unroll") for(int r=0;r<16;++r)sacc+=pB1[r]; l_reg+=sacc;
    pw0=(u32x4){PKW(pB0,0),PKW(pB0,2),PKW(pB0,4),PKW(pB0,6)};pw1=(u32x4){PKW(pB0,8),PKW(pB0,10),PKW(pB0,12),PKW(pB0,14)};pw2=(u32x4){PKW(pB1,0),PKW(pB1,2),PKW(pB1,4),PKW(pB1,6)};pw3=(u32x4){PKW(pB1,8),PKW(pB1,10),PKW(pB1,12),PKW(pB1,14)};
    SBAR(); pv(o,vb0+sl_cur,PAF(0),PAF(1),PAF(2),PAF(3)); }
  #undef PKW
  #undef PAF
  #undef VFR
  #undef PIN
  #undef MX3
  #undef GAPA
  #undef GAPB
  #undef EX
  #undef VRD
  #undef KRD
  #undef STEP
  #undef ENDW
  {auto rr=__builtin_amdgcn_permlane32_swap(__float_as_uint(l_reg),__float_as_uint(l_reg),false,false);l_reg=__uint_as_float(rr[0])+__uint_as_float(rr[1]);}
  if(hi==0)wsf[32+r32]=l_reg;asm volatile("s_waitcnt lgkmcnt(0)":::"memory");
  float rli[16];
  #pragma unroll
  for(int r=0;r<16;++r)rli[r]=__builtin_amdgcn_rcpf(wsf[32+crow(r,hi)]);
  bf16*Ow=O+(rowbase+q0+wid*QBLK)*PO+h*D;
  { bf16*stg=(bf16*)(shm+LDS_OST)+wid*2048;
    #pragma unroll
    for(int r=0;r<16;++r){const int orow=crow(r,hi);
      #pragma unroll
      for(int d0=0;d0<2;++d0)stg[orow*64+d0*32+r32]=__float2bfloat16(o[d0][r]*rli[r]);}
    asm volatile("s_waitcnt lgkmcnt(0)":::"memory");
    #pragma unroll
    for(int i=0;i<4;++i){const int row=i*8+(lane>>3),ch=lane&7; const u32x4 v=*(const u32x4*)(stg+row*64+ch*8); ATTN_STORE16(Ow+(long)row*PO+ch*8,v);} }
  asm volatile("s_waitcnt lgkmcnt(0)\n\ts_barrier":::"memory");
  #undef DMA_K
  #undef DMA_V
  #undef CMASK
  #undef START
  #undef RESC
  #undef ROT
}
constexpr int ATTN_LDS_BYTES=LDS_BYTES;
struct AttnTensors { const bf16* Q; const bf16* K; const bf16* V; bf16* O; };
struct AttnUnit { int b; int h; int qb; };
struct StaticOrder {
  int vcu, G;
  __device__ __forceinline__ explicit StaticOrder(int grid,int block):vcu((grid%8==0)?(block%8)*(grid/8)+block/8:block),G(grid){}
  __device__ __forceinline__ bool next(int i,AttnUnit&u)const{ const int L=i*G+vcu; if(L>=BATCH*NHEAD*(SEQ/QB))return false; const int grp=L>>5,r=L&31; u.b=grp>>1; u.h=(grp&1)*4+(r>>3); u.qb=r&7; return true; }
  __device__ __forceinline__ void a_ready(const AttnUnit&)const{}
  __device__ __forceinline__ void done(const AttnUnit&)const{}
};
template<class Sched,int THRL=8> __device__ __forceinline__ void attn_phase(char*lds,const AttnTensors&T,const Sched&S){
  AttnUnit u;
  for(int i=0;S.next(i,u);++i){ S.a_ready(u); attn_unit<THRL>(u.b,u.h,u.qb,T.Q,T.K,T.V,T.O,lds); S.done(u); }
}
#undef SBAR
#undef WAIT_BAR
}


#define GAS __attribute__((address_space(1)))
#define LAS __attribute__((address_space(3)))
typedef unsigned short bf16;
typedef unsigned v4u __attribute__((ext_vector_type(4)));
typedef float f32x4 __attribute__((ext_vector_type(4)));
typedef short bf16x8 __attribute__((ext_vector_type(8)));
typedef GAS unsigned gu32;
typedef GAS unsigned long long gu64;
#define RLX_AGENT __ATOMIC_RELAXED, __HIP_MEMORY_SCOPE_AGENT
#define LDS_WAIT() asm volatile("s_waitcnt lgkmcnt(0)" ::: "memory")
#define VM_WAIT() asm volatile("s_waitcnt vmcnt(0)" ::: "memory")
__device__ __forceinline__ unsigned long long rt() { return __builtin_amdgcn_s_memrealtime(); }
__device__ __forceinline__ unsigned f2bf(float f) { unsigned u = __builtin_bit_cast(unsigned, f); return (u + 0x7fffu + ((u >> 16) & 1u)) >> 16; }
__device__ __forceinline__ unsigned pk2(float lo, float hi) { return f2bf(lo) | (f2bf(hi) << 16); }

#define XB_TMO      128
#define XB_XCNT(j)  (256  + 64 * (j))
#define XB_XSUB(j)  (1280 + 64 * (j))
#define XB_XGEN(j)  (2304 + 64 * (j))
#define XB_TOP      3328
#define XB_TOPGEN   3392
#define XCD_BAR_WORDS 3456
#define XB_SPIN_CAP (1u << 18)

__device__ __forceinline__ unsigned xb_ld(unsigned* p)              { return __hip_atomic_load(p, __ATOMIC_RELAXED, __HIP_MEMORY_SCOPE_AGENT); }
__device__ __forceinline__ unsigned xb_add(unsigned* p, unsigned v) { return __hip_atomic_fetch_add(p, v, __ATOMIC_RELAXED, __HIP_MEMORY_SCOPE_AGENT); }
__device__ __forceinline__ unsigned xb_xcc_id() { return (unsigned)__builtin_amdgcn_s_getreg((3 << 11) | 20) & 0xFu; }
#define XB_SPIN(cond, bar) do { unsigned _sp = 0; while (cond) { __builtin_amdgcn_s_sleep(1); \
    if ((++_sp & 255u) == 0u) { if (xb_ld(&(bar)[XB_TMO])) break; if (_sp > XB_SPIN_CAP) { atomicAdd(&(bar)[XB_TMO], 1u); break; } } } } while (0)

struct XcdBarrier {
    unsigned* bar; unsigned x;
    volatile LAS unsigned* st;
};

__device__ __forceinline__ XcdBarrier xcd_barrier_post(unsigned* bar, volatile LAS unsigned* st) {
    XcdBarrier b; b.bar = bar; b.x = xb_xcc_id(); b.st = st;
    if (threadIdx.x == 0) (void)xb_add(&bar[XB_XCNT(b.x)], 1u);
    return b;
}
__device__ __forceinline__ void xcd_barrier_complete(unsigned* bar, unsigned x, unsigned& nloc, unsigned& nx) {
    const unsigned G = gridDim.x * gridDim.y * gridDim.z;
    unsigned sum, cnt, mine, sp = 0u;
    for (;;) {
        sum = 0u; cnt = 0u; mine = 0u;
#pragma unroll
        for (unsigned j = 0; j < 16; ++j) { const unsigned c = xb_ld(&bar[XB_XCNT(j)]); sum += c; cnt += (c > 0u) ? 1u : 0u; mine = (j == x) ? c : mine; }
        if (sum == G) break;
        __builtin_amdgcn_s_sleep(1);
        if ((++sp & 255u) == 0u) { if (xb_ld(&bar[XB_TMO])) break; if (sp > XB_SPIN_CAP) { atomicAdd(&bar[XB_TMO], 1u); break; } }
    }
    nloc = mine > 0u ? mine : 1u; nx = cnt > 0u ? cnt : 1u;
}

__device__ __forceinline__ void xcd_barrier(const XcdBarrier& b) {
    asm volatile("s_waitcnt vmcnt(0)" ::: "memory");
    __syncthreads();
    if (threadIdx.x == 0) {
        unsigned* bar = b.bar;
        __builtin_amdgcn_s_waitcnt(0);
        unsigned nloc = b.st[0], nx = b.st[1];
        if (nloc == 0u) { xcd_barrier_complete(bar, b.x, nloc, nx); b.st[0] = nloc; b.st[1] = nx; }
        const unsigned old = xb_add(&bar[XB_XSUB(b.x)], 1u);
        const unsigned gen = old / nloc;
        if (old + 1u == (gen + 1u) * nloc) {
            __builtin_amdgcn_fence(__ATOMIC_RELEASE, "agent");
            asm volatile("s_waitcnt vmcnt(0)" ::: "memory");
            const unsigned og = xb_add(&bar[XB_TOP], 1u);
            const unsigned tg = og / nx;
            if (og + 1u == (tg + 1u) * nx) xb_add(&bar[XB_TOPGEN], 1u);
            else XB_SPIN(xb_ld(&bar[XB_TOPGEN]) == tg, bar);
            __builtin_amdgcn_fence(__ATOMIC_ACQUIRE, "agent");
            xb_add(&bar[XB_XGEN(b.x)], 1u);
            asm volatile("s_waitcnt vmcnt(0)" ::: "memory");
        } else {
            XB_SPIN(xb_ld(&bar[XB_XGEN(b.x)]) == gen, bar);
            __builtin_amdgcn_fence(__ATOMIC_ACQUIRE, "agent");
            asm volatile("s_waitcnt vmcnt(0)" ::: "memory");
        }
    }
    __syncthreads();
}

constexpr int NWAVES = 8, NTHR = 512;
constexpr int DM = 1024, NB = 8, SEQ = 2048, DEPTH = 4, M = NB * SEQ;
constexpr int DIN = 2320, NPROJ = 2304;
constexpr int C_Q = 0, C_K = 512, C_V = 640, C_LX = 768, C_LG = 1024, C_MQ = 1280, C_MK = 1536, C_MV = 1792, C_MO = 2048;
constexpr int NE = 16, CAP = 256, DE = 2048, NSLOT = NB * CAP;
constexpr float EPS = 1e-6f;
constexpr int NPH = 1 + 10 * DEPTH;

constexpr size_t MiB = 1u << 20;
constexpr size_t WS_CTL = 0, CTL_ZERO_BYTES = 1 * MiB;
constexpr size_t WS_ROPE = 1 * MiB;
constexpr size_t WS_LRUW = 2 * MiB;
constexpr size_t WS_WIN = 4 * MiB;
constexpr size_t WS_WOUT = 22 * MiB;
constexpr size_t WS_WGU = 32 * MiB;
constexpr size_t WS_WDN = 544 * MiB;
constexpr size_t WS_H = 800 * MiB;
constexpr size_t WS_PROJ = 832 * MiB;
constexpr size_t WS_Y = 904 * MiB;
constexpr size_t WS_MG = 936 * MiB;
constexpr size_t WS_AFF = 937 * MiB;
constexpr size_t WS_SEL = 938 * MiB;
constexpr size_t WS_IDX = 939 * MiB;
constexpr size_t WS_GATE = WS_IDX + 128 * 1024;
constexpr size_t WS_LH = 940 * MiB;
constexpr size_t WS_CP = 956 * MiB;
constexpr size_t WS_CARRY = 972 * MiB;
constexpr size_t WS_CLOC = 974 * MiB;
constexpr size_t WS_NLOC = 990 * MiB;
constexpr size_t WS_MLOC = WS_NLOC + 512 * 1024;
constexpr size_t WS_XG = 992 * MiB;
constexpr size_t WS_HID = 1056 * MiB;
constexpr size_t WS_YE = 1184 * MiB;
constexpr size_t WS_END = 1248 * MiB;
constexpr int CW_BAR = 4096;

constexpr int RING_OFF = 0, RING_BYTES = 143360;
constexpr int MISC_OFF = RING_BYTES;
constexpr int LDS_BYTES = 147456;

typedef unsigned u32x2 __attribute__((ext_vector_type(2)));
__device__ __forceinline__ float bf2f(unsigned short v) { return __uint_as_float(((unsigned)v) << 16); }
__device__ __forceinline__ float bflo(unsigned v) { return __uint_as_float(v << 16); }
__device__ __forceinline__ float bfhi(unsigned v) { return __uint_as_float(v & 0xffff0000u); }
__device__ __forceinline__ float wave_sum(float v) {
#pragma unroll
    for (int o = 1; o < 64; o <<= 1) v += __shfl_xor(v, o);
    return v;
}
__device__ __forceinline__ float wave_max(float v) {
#pragma unroll
    for (int o = 1; o < 64; o <<= 1) v = fmaxf(v, __shfl_xor(v, o));
    return v;
}
__device__ __forceinline__ float sigmoid_f(float x) { return 1.0f / (1.0f + expf(-x)); }
__device__ __forceinline__ float logsig_f(float x) { return fminf(x, 0.f) - log1pf(expf(-fabsf(x))); }
__device__ __forceinline__ float gelu_tanh_f(float x) { const float u = 0.7978845608028654f * (x + 0.044715f * x * x * x); return 0.5f * x * (1.0f + tanhf(u)); }
#define MFMA16(a, b, c) __builtin_amdgcn_mfma_f32_16x16x32_bf16((a), (b), (c), 0, 0, 0)
#define WG_SYNC() __syncthreads()

struct Args { const float* in[22]; float* out; unsigned char* ws; int ph_lo, ph_hi, li, pad; };
enum { I_X = 0, I_N1G, I_WIN, I_QG, I_KG, I_CW, I_CB, I_WA, I_BA, I_WX, I_BX, I_LAM, I_FB, I_MNG, I_AOG, I_LOG, I_WOUT, I_N2G, I_WR, I_WG, I_WU, I_WD };

__device__ __forceinline__ void cvt_item(const float* __restrict__ src, int N, int k0, int n0, bf16* dst, int Kd, LAS float* scr, int lane) {
#pragma unroll 16
    for (int i = 0; i < 64; ++i) scr[i * 65 + lane] = src[(size_t)(k0 + i) * N + n0 + lane];
    LDS_WAIT(); asm volatile("" ::: "memory");
    const int c = lane >> 3, nn = lane & 7;
#pragma unroll
    for (int j = 0; j < 8; ++j) { const int n = nn + 8 * j; const LAS float* s = scr + (8 * c) * 65 + n;
        v4u o; o.x = pk2(s[0], s[65]); o.y = pk2(s[130], s[195]); o.z = pk2(s[260], s[325]); o.w = pk2(s[390], s[455]);
        *(GAS v4u*)(dst + (size_t)n * Kd + 8 * c) = o; }
    LDS_WAIT(); asm volatile("" ::: "memory");
}
__device__ __forceinline__ void p0_weights(const Args& a, LAS unsigned char* lds, int tid, int lane, int wave, int G, int bid) {
    unsigned char* ws = a.ws;
    LAS float* scr = (LAS float*)(lds + RING_OFF + wave * 16640);
    const int gw = bid * NWAVES + wave, NGW = G * NWAVES;
    constexpr int I_IN = 16 * 36, I_OUT = 16 * 16, I_EXP = 1536, PER_LAYER = I_IN + I_OUT + NE * I_EXP, NITEMS = DEPTH * PER_LAYER;
    for (int it = gw; it < NITEMS; it += NGW) {
        const int l = it / PER_LAYER; int r = it - l * PER_LAYER;
        if (r < I_IN) { const int kb = r / 36, nb = r - kb * 36;
            cvt_item(a.in[I_WIN] + (size_t)l * DM * DIN, DIN, 64 * kb, 64 * nb, (bf16*)(ws + WS_WIN) + ((size_t)l * NPROJ + 64 * nb) * DM + 64 * kb, DM, scr, lane); continue; }
        r -= I_IN;
        if (r < I_OUT) { const int kb = r >> 4, nb = r & 15;
            cvt_item(a.in[I_WOUT] + (size_t)l * DM * DM, DM, 64 * kb, 64 * nb, (bf16*)(ws + WS_WOUT) + ((size_t)l * DM + 64 * nb) * DM + 64 * kb, DM, scr, lane); continue; }
        r -= I_OUT;
        const int e = r / I_EXP; int r2 = r - e * I_EXP; const size_t le = (size_t)l * NE + e;
        if (r2 < 1024) { const int up = r2 >> 9; r2 &= 511; const int kb = r2 >> 5, nb = r2 & 31, n0 = 64 * nb, drow = 256 * (n0 >> 7) + (n0 & 127) + 128 * up;
            cvt_item(a.in[up ? I_WU : I_WG] + le * DM * DE, DE, 64 * kb, n0, (bf16*)(ws + WS_WGU) + (le * 4096 + drow) * DM + 64 * kb, DM, scr, lane); continue; }
        r2 -= 1024; { const int kb = r2 >> 4, nb = r2 & 15;
            cvt_item(a.in[I_WD] + le * DE * DM, DM, 64 * kb, 64 * nb, (bf16*)(ws + WS_WDN) + (le * DM + 64 * nb) * DE + 64 * kb, DE, scr, lane); }
    }
    const int gt = bid * NTHR + tid, GT = G * NTHR;
    bf16* lw = (bf16*)(ws + WS_LRUW);
    for (int i = gt; i < DEPTH * 2 * 2 * 4 * 4096; i += GT) { const int d = i & 63, e = (i >> 6) & 63, n = (i >> 12) & 3, gate = (i >> 14) & 1, dir = (i >> 15) & 1, l = i >> 16;
        const float* src = a.in[gate ? I_WX : I_WA]; lw[i] = (bf16)f2bf(src[((((size_t)l * 2 + dir) * 4 + n) * 64 + d) * 64 + e]); }
    float* rc = (float*)(ws + WS_ROPE); float* rs = rc + SEQ * 32;
    for (int i = gt; i < SEQ * 32; i += GT) { const int s = i >> 5, j = i & 31, f = j & 15; const float pos = (float)((j < 16) ? (s >> 6) : (s & 63));
        const float inv = 1.0f / powf(10000.0f, (float)f * (1.0f / 16.0f)); const float ang = pos * inv; rc[i] = cosf(ang); rs[i] = sinf(ang); }
}

template <int MODE>
__device__ __forceinline__ void row_pass(const float* xin, float* xout, const float* gain, const float* WT  , int sk, bf16* H, float* O16, const int* SEL, const bf16* YE,
                                         LAS unsigned char* lds, int tid, int lane, int wave, int G, int bid) {
    constexpr int WLS = 1028;
    LAS float* wl = (LAS float*)(lds + RING_OFF);
    if (MODE != 3) { for (int i = tid; i < 16 * DM; i += NTHR) { const int k = i >> 4, jj = i & 15; wl[jj * WLS + k] = WT[(size_t)k * sk + jj]; } }
    WG_SYNC();
    const int gw = bid * NWAVES + wave, NGW = G * NWAVES;
    for (int m = gw; m < M; m += NGW) {
        asm volatile("" ::: "memory");
        f32x4 v[4];
#pragma unroll
        for (int j = 0; j < 4; ++j) v[j] = *((const f32x4*)(xin + (size_t)m * DM) + 64 * j + lane);
        if (MODE >= 2) {
            const int b = m >> 11;
            for (int e = 0; e < NE; ++e) { const int s = __builtin_amdgcn_readfirstlane(SEL[(size_t)m * NE + e]);
                if (s >= 0) { const bf16* yr = YE + ((size_t)e * NSLOT + b * CAP + s) * DM;
#pragma unroll
                    for (int j = 0; j < 4; ++j) { const u32x2 q = *((const u32x2*)yr + 64 * j + lane); v[j][0] += bflo(q.x); v[j][1] += bfhi(q.x); v[j][2] += bflo(q.y); v[j][3] += bfhi(q.y); } } }
#pragma unroll
            for (int j = 0; j < 4; ++j) *((f32x4*)(xout + (size_t)m * DM) + 64 * j + lane) = v[j];
        }
        if (MODE == 3) continue;
        float ss = 0.f;
#pragma unroll
        for (int j = 0; j < 4; ++j) ss += (v[j][0] * v[j][0] + v[j][1] * v[j][1]) + (v[j][2] * v[j][2] + v[j][3] * v[j][3]);
        ss = wave_sum(ss);
        const float rstd = 1.0f / sqrtf(ss * (1.0f / DM) + EPS);
#pragma unroll
        for (int j = 0; j < 4; ++j) { const f32x4 gq = *((const f32x4*)gain + 64 * j + lane); v[j] = v[j] * rstd * gq;
            u32x2 o; o.x = pk2(v[j][0], v[j][1]); o.y = pk2(v[j][2], v[j][3]); *((u32x2*)(H + (size_t)m * DM) + 64 * j + lane) = o; }
        float p[16];
#pragma unroll
        for (int jj = 0; jj < 16; ++jj) { float acc = 0.f;
#pragma unroll
            for (int j = 0; j < 4; ++j) { const f32x4 w = *((LAS f32x4*)(wl + jj * WLS) + 64 * j + lane); acc += (v[j][0] * w[0] + v[j][1] * w[1]) + (v[j][2] * w[2] + v[j][3] * w[3]); }
            p[jj] = wave_sum(acc); }
        if (MODE == 1) {
            float mx = p[0];
#pragma unroll
            for (int jj = 1; jj < 16; ++jj) mx = fmaxf(mx, p[jj]);
            float sum = 0.f;
#pragma unroll
            for (int jj = 0; jj < 16; ++jj) { p[jj] = expf(p[jj] - mx); sum += p[jj]; }
            float mine = 0.f;
#pragma unroll
            for (int jj = 0; jj < 16; ++jj) mine = (lane == jj) ? p[jj] : mine;
            if (lane < 16) O16[(((size_t)(m >> 11) * NE + lane) << 11) + (m & 2047)] = mine / sum;
        } else {
            float mine = 0.f;
#pragma unroll
            for (int jj = 0; jj < 16; ++jj) mine = (lane == jj) ? p[jj] : mine;
            if (lane < 16) O16[(size_t)m * 16 + lane] = mine;
        }
    }
}

__device__ __forceinline__ void rope_pass(const Args& a, int l, int lane, int wave, int G, int bid) {
    bf16* PROJ = (bf16*)(a.ws + WS_PROJ); const float* rc = (const float*)(a.ws + WS_ROPE); const float* rs = rc + SEQ * 32;
    const float* qg = a.in[I_QG] + l * 64; const float* kg = a.in[I_KG] + l * 64;
    const int gw = bid * NWAVES + wave, NGW = G * NWAVES, j = lane & 31;
    const float qg1 = qg[j], qg2 = qg[32 + j], kg1 = kg[j], kg2 = kg[32 + j];
    for (int m = gw; m < M; m += NGW) {
        bf16* row = PROJ + (size_t)m * NPROJ; const int s = m & 2047;
        const float cs = rc[s * 32 + j], sn = rs[s * 32 + j];
#pragma unroll
        for (int it = 0; it < 5; ++it) { const int hh = 2 * it + (lane >> 5);
            const float x1 = bf2f(row[hh * 64 + j]), x2 = bf2f(row[hh * 64 + 32 + j]);
            float ss = x1 * x1 + x2 * x2;
#pragma unroll
            for (int o = 1; o < 32; o <<= 1) ss += __shfl_xor(ss, o);
            const float rstd = 1.0f / sqrtf(ss * (1.0f / 64.0f) + EPS);
            const float n1 = x1 * rstd * (it < 4 ? qg1 : kg1), n2 = x2 * rstd * (it < 4 ? qg2 : kg2);
            float o1 = n1 * cs - n2 * sn, o2 = n2 * cs + n1 * sn;
            if (it < 4) { o1 *= attn_body::C2; o2 *= attn_body::C2; }
            row[hh * 64 + j] = (bf16)f2bf(o1); row[hh * 64 + 32 + j] = (bf16)f2bf(o2); }
    }
}

constexpr int XS = 260;
__device__ __forceinline__ void lru_a_unit(const Args& a, int l, int unit, LAS unsigned char* lds, int tid, int lane, int wave) {
    const int b = unit >> 6, c32 = unit & 63, t0 = c32 * 32; const size_t m0 = (size_t)b * SEQ + t0;
    LAS float* XC = (LAS float*)(lds + RING_OFF); LAS float* AA = XC + 32 * XS; LAS float* UU = AA + 32 * XS;
    const bf16* PROJ = (const bf16*)(a.ws + WS_PROJ);
    {
        const int ch2 = tid & 127, rg = tid >> 7, ch = 2 * ch2;
        float x0[11], x1[11];
#pragma unroll
        for (int i = 0; i < 11; ++i) { const int s = t0 + rg * 8 - 2 + i; unsigned v = 0u;
            if (s >= 0 && s < SEQ) v = *(const unsigned*)(PROJ + ((size_t)b * SEQ + s) * NPROJ + C_LX + ch);
            x0[i] = bflo(v); x1[i] = bfhi(v); }
        const float* cw = a.in[I_CW] + (size_t)l * 4 * 256; const float* cb = a.in[I_CB] + (size_t)l * 256;
        float w0[4], w1[4];
#pragma unroll
        for (int j = 0; j < 4; ++j) { w0[j] = cw[j * 256 + ch]; w1[j] = cw[j * 256 + ch + 1]; }
        const float b0 = cb[ch], b1 = cb[ch + 1];
#pragma unroll
        for (int r = 0; r < 8; ++r) { float y0 = b0, y1 = b1;
#pragma unroll
            for (int j = 0; j < 4; ++j) { y0 += x0[r + j] * w0[j]; y1 += x1[r + j] * w1[j]; }
            XC[(rg * 8 + r) * XS + ch] = y0; XC[(rg * 8 + r) * XS + ch + 1] = y1; }
    }
    WG_SYNC();
    const int n = wave >> 1, hh = wave & 1, li = lane & 15, g = lane >> 4;
    bf16* LH = (bf16*)(a.ws + WS_LH); bf16* CPb = (bf16*)(a.ws + WS_CP); float* CARRY = (float*)(a.ws + WS_CARRY);
    for (int dir = 0; dir < 2; ++dir) {
        {
            f32x4 accA[2][2], accX[2][2];
#pragma unroll
            for (int i = 0; i < 2; ++i)
#pragma unroll
                for (int j = 0; j < 2; ++j) { accA[i][j] = (f32x4){0.f, 0.f, 0.f, 0.f}; accX[i][j] = (f32x4){0.f, 0.f, 0.f, 0.f}; }
            const bf16* WA = (const bf16*)(a.ws + WS_LRUW) + ((((size_t)l * 2 + dir) * 2 + 0) * 4 + n) * 4096;
            const bf16* WX = (const bf16*)(a.ws + WS_LRUW) + ((((size_t)l * 2 + dir) * 2 + 1) * 4 + n) * 4096;
#pragma unroll
            for (int ks = 0; ks < 2; ++ks) {
                bf16x8 af[2];
#pragma unroll
                for (int mt = 0; mt < 2; ++mt) { const LAS float* p = XC + (16 * mt + li) * XS + 64 * n + 32 * ks + 8 * g;
                    const f32x4 q0 = *(const LAS f32x4*)p, q1 = *(const LAS f32x4*)(p + 4);
                    v4u pk; pk.x = pk2(q0[0], q0[1]); pk.y = pk2(q0[2], q0[3]); pk.z = pk2(q1[0], q1[1]); pk.w = pk2(q1[2], q1[3]); af[mt] = __builtin_bit_cast(bf16x8, pk); }
#pragma unroll
                for (int nt = 0; nt < 2; ++nt) { const int ep = 32 * hh + 16 * nt + li;
                    const bf16x8 ba = *(const bf16x8*)(WA + ep * 64 + 32 * ks + 8 * g), bx = *(const bf16x8*)(WX + ep * 64 + 32 * ks + 8 * g);
#pragma unroll
                    for (int mt = 0; mt < 2; ++mt) { accA[mt][nt] = MFMA16(af[mt], ba, accA[mt][nt]); accX[mt][nt] = MFMA16(af[mt], bx, accX[mt][nt]); } }
            }
#pragma unroll
            for (int nt = 0; nt < 2; ++nt) { const int ch = 64 * n + 32 * hh + 16 * nt + li; const size_t pi = ((size_t)l * 2 + dir) * 256 + ch;
                const float bav = a.in[I_BA][pi], bxv = a.in[I_BX][pi], lam = a.in[I_LAM][pi];
                const float sp = fmaxf(-lam, 0.f) + log1pf(expf(-fabsf(lam)));
#pragma unroll
                for (int mt = 0; mt < 2; ++mt)
#pragma unroll
                    for (int r = 0; r < 4; ++r) { const int t = 16 * mt + 4 * g + r;
                        const float rg_ = sigmoid_f(accA[mt][nt][r] + bav), ig_ = sigmoid_f(accX[mt][nt][r] + bxv);
                        const float la = -8.0f * rg_ * sp; const float av = expf(la);
                        const float uv = sqrtf(-expm1f(2.0f * la)) * (ig_ * XC[t * XS + ch]);
                        AA[t * XS + ch] = av; UU[t * XS + ch] = uv; } }
        }
        WG_SYNC();
        if (tid < 256) { const int ch = tid; float h = 0.f, cp = 1.f;
            bf16* lh = LH + ((size_t)dir * M + m0) * 256 + ch; bf16* cpo = CPb + ((size_t)dir * M + m0) * 256 + ch;
            for (int q = 0; q < 32; ++q) { const int t = dir ? 31 - q : q; const float av = AA[t * XS + ch], uv = UU[t * XS + ch];
                h = av * h + uv; cp *= av; lh[(size_t)t * 256] = (bf16)f2bf(h); cpo[(size_t)t * 256] = (bf16)f2bf(cp); }
            float* cr = CARRY + ((((size_t)dir * NB + b) * 64 + c32) * 2) * 256 + ch; cr[0] = cp; cr[256] = h; }
        WG_SYNC();
    }
}

__device__ __forceinline__ void lru_b_unit(const Args& a, int l, int unit, LAS unsigned char* lds, int tid, int lane, int wave) {
    const int b = unit >> 6, c32 = unit & 63; const size_t m0 = (size_t)b * SEQ + c32 * 32;
    LAS float* CIN = (LAS float*)(lds + RING_OFF);
    const float* CARRY = (const float*)(a.ws + WS_CARRY);
    { const int dir = tid >> 8, ch = tid & 255; const float* cr = CARRY + (((size_t)dir * NB + b) * 64) * 512 + ch; float cin = 0.f;
      if (dir == 0) { for (int k = 0; k < c32; ++k) cin = cr[(size_t)k * 512] * cin + cr[(size_t)k * 512 + 256]; }
      else { for (int k = 63; k > c32; --k) cin = cr[(size_t)k * 512] * cin + cr[(size_t)k * 512 + 256]; }
      CIN[tid] = cin; }
    WG_SYNC();
    const bf16* LH = (const bf16*)(a.ws + WS_LH); const bf16* CPb = (const bf16*)(a.ws + WS_CP); const bf16* PROJ = (const bf16*)(a.ws + WS_PROJ); bf16* Y = (bf16*)(a.ws + WS_Y);
    const f32x4 cf = *(const LAS f32x4*)(CIN + 4 * lane), cb = *(const LAS f32x4*)(CIN + 256 + 4 * lane);
    const f32x4 og = *(const f32x4*)(a.in[I_LOG] + (size_t)l * 256 + 4 * lane);
#pragma unroll
    for (int q = 0; q < 4; ++q) { const size_t m = m0 + wave * 4 + q;
        const u32x2 lf = *(const u32x2*)(LH + m * 256 + 4 * lane), pf = *(const u32x2*)(CPb + m * 256 + 4 * lane);
        const u32x2 lb = *(const u32x2*)(LH + ((size_t)M + m) * 256 + 4 * lane), pb = *(const u32x2*)(CPb + ((size_t)M + m) * 256 + 4 * lane);
        const u32x2 gt = *(const u32x2*)(PROJ + m * NPROJ + C_LG + 4 * lane);
        f32x4 h;
        h[0] = (bflo(lf.x) + bflo(pf.x) * cf[0]) + (bflo(lb.x) + bflo(pb.x) * cb[0]);
        h[1] = (bfhi(lf.x) + bfhi(pf.x) * cf[1]) + (bfhi(lb.x) + bfhi(pb.x) * cb[1]);
        h[2] = (bflo(lf.y) + bflo(pf.y) * cf[2]) + (bflo(lb.y) + bflo(pb.y) * cb[2]);
        h[3] = (bfhi(lf.y) + bfhi(pf.y) * cf[3]) + (bfhi(lb.y) + bfhi(pb.y) * cb[3]);
        h[0] *= gelu_tanh_f(bflo(gt.x)); h[1] *= gelu_tanh_f(bfhi(gt.x)); h[2] *= gelu_tanh_f(bflo(gt.y)); h[3] *= gelu_tanh_f(bfhi(gt.y));
        const float ss = wave_sum((h[0] * h[0] + h[1] * h[1]) + (h[2] * h[2] + h[3] * h[3]));
        const float rstd = 1.0f / sqrtf(ss * (1.0f / 256.0f) + EPS);
        u32x2 o; o.x = pk2(h[0] * rstd * og[0], h[1] * rstd * og[1]); o.y = pk2(h[2] * rstd * og[2], h[3] * rstd * og[3]);
        *(u32x2*)(Y + m * DM + 512 + 4 * lane) = o; }
    WG_SYNC();
}

__device__ __forceinline__ void mls_gates(const Args& a, int l, size_t m0, int hd, LAS float* GL, int tid) {
    if (tid < 128) { const float* r = (const float*)(a.ws + WS_MG) + (m0 + tid) * 16; const float* fb = a.in[I_FB] + (size_t)l * 8;
        GL[tid] = logsig_f(r[4 + hd] + fb[hd]); GL[128 + tid] = logsig_f(r[12 + hd] + fb[4 + hd]); GL[256 + tid] = r[hd]; GL[384 + tid] = r[8 + hd]; }
    WG_SYNC();
    if (tid == 0) { float acc = 0.f; for (int j = 0; j < 128; ++j) { acc += GL[j]; GL[512 + j] = acc; } }
    if (tid == 64) { float acc = 0.f; for (int j = 127; j >= 0; --j) { acc += GL[128 + j]; GL[640 + j] = acc; } }
    WG_SYNC();
}
constexpr int TS = 136;
constexpr int QS_ = 72;

__device__ __forceinline__ void mls_a_unit(const Args& a, int l, int unit, LAS unsigned char* lds, int tid, int lane, int wave) {
    const int c = unit & 15, hd = (unit >> 4) & 3, b = unit >> 6; const size_t m0 = (size_t)b * SEQ + c * 128;
    LAS float* GL = (LAS float*)(lds + RING_OFF);
    LAS float* WW = GL + 768;
    LAS bf16* VT = (LAS bf16*)(lds + RING_OFF + 4096); LAS bf16* KF = VT + 64 * TS; LAS bf16* KB = KF + 64 * TS;
    mls_gates(a, l, m0, hd, GL, tid);
    float* MLOC = (float*)(a.ws + WS_MLOC); float* NLOC = (float*)(a.ws + WS_NLOC); float* CLOC = (float*)(a.ws + WS_CLOC);
    const size_t sbase = ((size_t)b * 4 + hd) * 2;
    if (wave < 2) { const int dir = wave; const float gtot = dir ? GL[640] : GL[512 + 127]; const LAS float* Bc = GL + 512 + 128 * dir; const LAS float* IG = GL + 256 + 128 * dir;
        const float lw0 = gtot - Bc[lane] + IG[lane], lw1 = gtot - Bc[lane + 64] + IG[lane + 64];
        const float mx = wave_max(fmaxf(lw0, lw1));
        WW[dir * 128 + lane] = expf(lw0 - mx); WW[dir * 128 + lane + 64] = expf(lw1 - mx);
        if (lane == 0) { float* o = MLOC + ((sbase + dir) * 16 + c) * 2; o[0] = mx; o[1] = gtot; } }
    WG_SYNC();
    { const int j = tid & 127, part = tid >> 7; const bf16* PROJ = (const bf16*)(a.ws + WS_PROJ);
      const bf16* kp = PROJ + (m0 + j) * NPROJ + C_MK + hd * 64 + 16 * part; const bf16* vp = PROJ + (m0 + j) * NPROJ + C_MV + hd * 64 + 16 * part;
      const v4u k0 = *(const v4u*)kp, k1 = *(const v4u*)(kp + 8), v0 = *(const v4u*)vp, v1 = *(const v4u*)(vp + 8);
      const float wf = WW[j] * 0.125f, wb = WW[128 + j] * 0.125f;
      const unsigned kk[8] = {k0.x, k0.y, k0.z, k0.w, k1.x, k1.y, k1.z, k1.w}; const unsigned vv[8] = {v0.x, v0.y, v0.z, v0.w, v1.x, v1.y, v1.z, v1.w};
#pragma unroll
      for (int q = 0; q < 8; ++q) { const int e0 = 16 * part + 2 * q; const float ka = bflo(kk[q]), kb = bfhi(kk[q]);
          KF[e0 * TS + j] = (bf16)f2bf(ka * wf); KF[(e0 + 1) * TS + j] = (bf16)f2bf(kb * wf);
          KB[e0 * TS + j] = (bf16)f2bf(ka * wb); KB[(e0 + 1) * TS + j] = (bf16)f2bf(kb * wb);
          VT[e0 * TS + j] = (bf16)(vv[q] & 0xffffu); VT[(e0 + 1) * TS + j] = (bf16)(vv[q] >> 16); } }
    WG_SYNC();
    if (tid < 128) { const int dir = tid >> 6, e = tid & 63; const LAS bf16* kr = (dir ? KB : KF) + e * TS; float s = 0.f;
        for (int j = 0; j < 128; ++j) s += bf2f(kr[j]);
        NLOC[((sbase + dir) * 16 + c) * 64 + e] = s; }
    { const int dir = wave >> 2, mt = wave & 3, li = lane & 15, g = lane >> 4; const LAS bf16* KD = dir ? KB : KF;
      f32x4 acc[4];
#pragma unroll
      for (int nt = 0; nt < 4; ++nt) acc[nt] = (f32x4){0.f, 0.f, 0.f, 0.f};
#pragma unroll
      for (int ks = 0; ks < 4; ++ks) { const bf16x8 af = *(const LAS bf16x8*)(VT + (16 * mt + li) * TS + 32 * ks + 8 * g);
#pragma unroll
          for (int nt = 0; nt < 4; ++nt) { const bf16x8 bfv = *(const LAS bf16x8*)(KD + (16 * nt + li) * TS + 32 * ks + 8 * g); acc[nt] = MFMA16(af, bfv, acc[nt]); } }
      float* co = CLOC + ((sbase + dir) * 16 + c) * 4096;
#pragma unroll
      for (int nt = 0; nt < 4; ++nt)
#pragma unroll
          for (int r = 0; r < 4; ++r) co[(16 * mt + 4 * g + r) * 64 + 16 * nt + li] = acc[nt][r]; }
    WG_SYNC();
}

template <int DIR>
__device__ __forceinline__ void mls_dir(f32x4 (&hacc)[4], const LAS bf16* QS, const LAS bf16* KS, const LAS bf16* VT, const LAS bf16* CP, const LAS float* AJ, const LAS float* MM,
                                        const LAS float* INTER, const LAS float* FLOOR, const LAS float* NP, LAS float* rowbuf, int w, int lane) {
    const int li = lane & 15, g = lane >> 4, i = 16 * w + li;
    bf16x8 qf[2];
#pragma unroll
    for (int ks = 0; ks < 2; ++ks) qf[ks] = *(const LAS bf16x8*)(QS + i * QS_ + 32 * ks + 8 * g);
    const float mmi = MM[i];
    float den = 0.f;
    f32x4 out[4];
#pragma unroll
    for (int dt = 0; dt < 4; ++dt) out[dt] = (f32x4){0.f, 0.f, 0.f, 0.f};
#pragma unroll
    for (int kp = 0; kp < 4; ++kp) {
        const bool need = (DIR == 0) ? (2 * kp <= w) : (2 * kp + 1 >= w);
        if (need) {
            f32x4 s0 = (f32x4){0.f, 0.f, 0.f, 0.f}, s1 = (f32x4){0.f, 0.f, 0.f, 0.f};
#pragma unroll
            for (int ks = 0; ks < 2; ++ks) { const bf16x8 k0 = *(const LAS bf16x8*)(KS + (32 * kp + li) * QS_ + 32 * ks + 8 * g), k1 = *(const LAS bf16x8*)(KS + (32 * kp + 16 + li) * QS_ + 32 * ks + 8 * g);
                s0 = MFMA16(k0, qf[ks], s0); s1 = MFMA16(k1, qf[ks], s1); }
            float p[8];
#pragma unroll
            for (int r = 0; r < 4; ++r) { const int j0 = 32 * kp + 4 * g + r, j1 = j0 + 16;
                const bool v0 = (DIR == 0) ? (j0 <= i) : (j0 >= i), v1 = (DIR == 0) ? (j1 <= i) : (j1 >= i);
                const float a0 = v0 ? (AJ[j0] - mmi) : -INFINITY, a1 = v1 ? (AJ[j1] - mmi) : -INFINITY;
                p[r] = s0[r] * 0.125f * expf(a0); p[4 + r] = s1[r] * 0.125f * expf(a1); den += p[r] + p[4 + r]; }
            v4u pk; pk.x = pk2(p[0], p[1]); pk.y = pk2(p[2], p[3]); pk.z = pk2(p[4], p[5]); pk.w = pk2(p[6], p[7]);
            const bf16x8 pf = __builtin_bit_cast(bf16x8, pk);
#pragma unroll
            for (int dt = 0; dt < 4; ++dt) { const LAS bf16* vr = VT + (16 * dt + li) * TS + 32 * kp + 4 * g;
                const u32x2 lo = *(const LAS u32x2*)vr, hi = *(const LAS u32x2*)(vr + 16);
                v4u vk; vk.x = lo.x; vk.y = lo.y; vk.z = hi.x; vk.w = hi.y;
                out[dt] = MFMA16(pf, __builtin_bit_cast(bf16x8, vk), out[dt]); }
        }
    }
    f32x4 qc[4];
#pragma unroll
    for (int dt = 0; dt < 4; ++dt) { qc[dt] = (f32x4){0.f, 0.f, 0.f, 0.f};
#pragma unroll
        for (int ks = 0; ks < 2; ++ks) { const bf16x8 cf = *(const LAS bf16x8*)(CP + (16 * dt + li) * QS_ + 32 * ks + 8 * g); qc[dt] = MFMA16(qf[ks], cf, qc[dt]); } }
    float nq = 0.f;
#pragma unroll
    for (int q = 0; q < 16; ++q) nq += NP[16 * g + q] * bf2f(QS[i * QS_ + 16 * g + q]);
    den += __shfl_xor(den, 16); den += __shfl_xor(den, 32); nq += __shfl_xor(nq, 16); nq += __shfl_xor(nq, 32);
    const float inter = INTER[i]; const float dn = fmaxf(fabsf(den + inter * nq), FLOOR[i]);
    asm volatile("s_waitcnt lgkmcnt(0)" ::: "memory");
    if (g == 0) { rowbuf[li] = inter; rowbuf[16 + li] = 1.0f / dn; }
    asm volatile("s_waitcnt lgkmcnt(0)" ::: "memory");
#pragma unroll
    for (int r = 0; r < 4; ++r) { const float it = rowbuf[4 * g + r], inv = rowbuf[16 + 4 * g + r];
#pragma unroll
        for (int dt = 0; dt < 4; ++dt) hacc[dt][r] += (out[dt][r] + it * qc[dt][r]) * inv; }
    asm volatile("s_waitcnt lgkmcnt(0)" ::: "memory");
}
__device__ __forceinline__ void mls_b_unit(const Args& a, int l, int unit, LAS unsigned char* lds, int tid, int lane, int wave) {
    const int c = unit & 15, hd = (unit >> 4) & 3, b = unit >> 6; const size_t m0 = (size_t)b * SEQ + c * 128;
    LAS float* GL = (LAS float*)(lds + RING_OFF);
    LAS float* AJ = GL + 768;
    LAS float* MMx = AJ + 256;
    LAS float* INT_ = MMx + 256;
    LAS float* FLR = INT_ + 256;
    LAS float* NP = FLR + 256;
    LAS float* COEF = NP + 128;
    LAS float* ROWB = COEF + 32;
    LAS bf16* QS = (LAS bf16*)(lds + RING_OFF + 16384); LAS bf16* KS = QS + 128 * QS_; LAS bf16* VT = KS + 128 * QS_; LAS bf16* CF = VT + 64 * TS; LAS bf16* CB = CF + 64 * QS_;
    mls_gates(a, l, m0, hd, GL, tid);
    const float* MLOC = (const float*)(a.ws + WS_MLOC); const float* NLOC = (const float*)(a.ws + WS_NLOC); const float* CLOC = (const float*)(a.ws + WS_CLOC);
    const size_t sbase = ((size_t)b * 4 + hd) * 2;
    if (tid == 0) {
        float m = 0.f; const float* ml = MLOC + (sbase + 0) * 32;
        for (int k = 0; k < c; ++k) { const float mlk = ml[2 * k], gk = ml[2 * k + 1]; const float mn = fmaxf(gk + m, mlk); const float fa = expf(gk + m - mn), fb = expf(mlk - mn);
            for (int k2 = 0; k2 < k; ++k2) COEF[k2] *= fa; COEF[k] = fb; m = mn; }
        float run = -INFINITY;
        for (int j = 0; j < 128; ++j) { const float aj = GL[256 + j] - GL[512 + j]; AJ[j] = aj; run = fmaxf(run, aj); const float mm = fmaxf(run, m);
            MMx[j] = mm; INT_[j] = expf(m - mm); FLR[j] = expf(-(GL[512 + j] + mm)); }
    }
    if (tid == 64) {
        float m = 0.f; const float* ml = MLOC + (sbase + 1) * 32;
        for (int k = 15; k > c; --k) { const float mlk = ml[2 * k], gk = ml[2 * k + 1]; const float mn = fmaxf(gk + m, mlk); const float fa = expf(gk + m - mn), fb = expf(mlk - mn);
            for (int k2 = 15; k2 > k; --k2) COEF[16 + k2] *= fa; COEF[16 + k] = fb; m = mn; }
        float run = -INFINITY;
        for (int j = 127; j >= 0; --j) { const float aj = GL[384 + j] - GL[640 + j]; AJ[128 + j] = aj; run = fmaxf(run, aj); const float mm = fmaxf(run, m);
            MMx[128 + j] = mm; INT_[128 + j] = expf(m - mm); FLR[128 + j] = expf(-(GL[640 + j] + mm)); }
    }
    {
        const int j = tid >> 2, q4 = tid & 3; const bf16* PROJ = (const bf16*)(a.ws + WS_PROJ); const bf16* rp = PROJ + (m0 + j) * NPROJ + hd * 64 + 16 * q4;
        const v4u q0 = *(const v4u*)(rp + C_MQ), q1 = *(const v4u*)(rp + C_MQ + 8), k0 = *(const v4u*)(rp + C_MK), k1 = *(const v4u*)(rp + C_MK + 8), v0 = *(const v4u*)(rp + C_MV), v1 = *(const v4u*)(rp + C_MV + 8);
        *(LAS v4u*)(QS + j * QS_ + 16 * q4) = q0; *(LAS v4u*)(QS + j * QS_ + 16 * q4 + 8) = q1;
        *(LAS v4u*)(KS + j * QS_ + 16 * q4) = k0; *(LAS v4u*)(KS + j * QS_ + 16 * q4 + 8) = k1;
        const unsigned vv[8] = {v0.x, v0.y, v0.z, v0.w, v1.x, v1.y, v1.z, v1.w};
#pragma unroll
        for (int q = 0; q < 8; ++q) { const int d0 = 16 * q4 + 2 * q; VT[d0 * TS + j] = (bf16)(vv[q] & 0xffffu); VT[(d0 + 1) * TS + j] = (bf16)(vv[q] >> 16); }
    }
    WG_SYNC();
    {
        const int idx = tid * 8;
#pragma unroll
        for (int dir = 0; dir < 2; ++dir) { f32x4 s0 = (f32x4){0.f, 0.f, 0.f, 0.f}, s1 = (f32x4){0.f, 0.f, 0.f, 0.f};
            const int klo = dir ? c + 1 : 0, khi = dir ? 16 : c;
            for (int k = klo; k < khi; ++k) { const float cf = COEF[16 * dir + k]; const float* src = CLOC + ((sbase + dir) * 16 + k) * 4096 + idx;
                s0 += cf * *(const f32x4*)src; s1 += cf * *(const f32x4*)(src + 4); }
            v4u pk; pk.x = pk2(s0[0], s0[1]); pk.y = pk2(s0[2], s0[3]); pk.z = pk2(s1[0], s1[1]); pk.w = pk2(s1[2], s1[3]);
            *(LAS v4u*)((dir ? CB : CF) + (idx >> 6) * QS_ + (idx & 63)) = pk; }
        if (tid < 128) { const int dir = tid >> 6, e = tid & 63; const int klo = dir ? c + 1 : 0, khi = dir ? 16 : c; float s = 0.f;
            for (int k = klo; k < khi; ++k) s += COEF[16 * dir + k] * NLOC[((sbase + dir) * 16 + k) * 64 + e];
            NP[tid] = s; }
    }
    WG_SYNC();
    f32x4 hacc[4];
#pragma unroll
    for (int dt = 0; dt < 4; ++dt) hacc[dt] = (f32x4){0.f, 0.f, 0.f, 0.f};
    mls_dir<0>(hacc, QS, KS, VT, CF, AJ, MMx, INT_, FLR, NP, ROWB + wave * 32, wave, lane);
    mls_dir<1>(hacc, QS, KS, VT, CB, AJ + 128, MMx + 128, INT_ + 128, FLR + 128, NP + 64, ROWB + wave * 32, wave, lane);
    {
        const int li = lane & 15, g = lane >> 4; const bf16* PROJ = (const bf16*)(a.ws + WS_PROJ); bf16* Y = (bf16*)(a.ws + WS_Y);
        const float* hg = a.in[I_MNG] + ((size_t)l * 4 + hd) * 64;
#pragma unroll
        for (int r = 0; r < 4; ++r) { float ss = (hacc[0][r] * hacc[0][r] + hacc[1][r] * hacc[1][r]) + (hacc[2][r] * hacc[2][r] + hacc[3][r] * hacc[3][r]);
#pragma unroll
            for (int o = 1; o < 16; o <<= 1) ss += __shfl_xor(ss, o);
            const float rstd = 1.0f / sqrtf(ss * (1.0f / 64.0f) + EPS); const size_t m = m0 + 16 * wave + 4 * g + r;
#pragma unroll
            for (int dt = 0; dt < 4; ++dt) { const int d = 16 * dt + li; const float o = bf2f(PROJ[m * NPROJ + C_MO + hd * 64 + d]);
                Y[m * DM + 768 + hd * 64 + d] = (bf16)f2bf(hacc[dt][r] * rstd * hg[d] * sigmoid_f(o)); } }
    }
    WG_SYNC();
}

__device__ __forceinline__ void attnorm_pass(const Args& a, int l, int lane, int wave, int G, int bid) {
    bf16* Y = (bf16*)(a.ws + WS_Y); const float* gq = a.in[I_AOG] + (size_t)l * 512 + 8 * lane;
    const f32x4 g0 = *(const f32x4*)gq, g1 = *(const f32x4*)(gq + 4);
    const int gw = bid * NWAVES + wave, NGW = G * NWAVES;
    for (int m = gw; m < M; m += NGW) { v4u* p = (v4u*)(Y + (size_t)m * DM + 8 * lane); const v4u q = *p;
        float x[8] = {bflo(q.x), bfhi(q.x), bflo(q.y), bfhi(q.y), bflo(q.z), bfhi(q.z), bflo(q.w), bfhi(q.w)};
        float ss = 0.f;
#pragma unroll
        for (int i = 0; i < 8; ++i) ss += x[i] * x[i];
        ss = wave_sum(ss); const float rstd = 1.0f / sqrtf(ss * (1.0f / 512.0f) + EPS);
        v4u o; o.x = pk2(x[0] * rstd * g0[0], x[1] * rstd * g0[1]); o.y = pk2(x[2] * rstd * g0[2], x[3] * rstd * g0[3]);
        o.z = pk2(x[4] * rstd * g1[0], x[5] * rstd * g1[1]); o.w = pk2(x[6] * rstd * g1[2], x[7] * rstd * g1[3]); *p = o; }
}

__device__ __forceinline__ void topk_item(const Args& a, int item, LAS unsigned char* lds, int tid, int lane, int wave) {
    const int unit = item & 127, half = item >> 7, b = unit >> 4, e = unit & 15;
    LAS unsigned long long* KEY = (LAS unsigned long long*)(lds + RING_OFF);
    LAS short* RANK = (LAS short*)(lds + RING_OFF + 16384);
    const float* aff = (const float*)(a.ws + WS_AFF) + ((size_t)b * NE + e) * SEQ;
    for (int s = tid; s < SEQ; s += NTHR) { KEY[s] = ((unsigned long long)__float_as_uint(aff[s]) << 32) | (unsigned)(SEQ - 1 - s); RANK[s] = (short)-1; }
    WG_SYNC();
    for (int k = 2; k <= SEQ; k <<= 1)
        for (int j = k >> 1; j > 0; j >>= 1) {
#pragma unroll
            for (int q = 0; q < 2; ++q) { const int t = tid + q * NTHR; const int i = ((t & ~(j - 1)) << 1) | (t & (j - 1));
                const unsigned long long x = KEY[i], y = KEY[i + j]; const bool up = (i & k) == 0;
                if (up ? (x < y) : (x > y)) { KEY[i] = y; KEY[i + j] = x; } }
            WG_SYNC();
        }
    if (tid < CAP) RANK[SEQ - 1 - (int)(unsigned)(KEY[tid] & 0xffffffffull)] = (short)tid;
    WG_SYNC();
    int* SEL = (int*)(a.ws + WS_SEL); int* IDX = (int*)(a.ws + WS_IDX); float* GATE = (float*)(a.ws + WS_GATE);
    for (int s = half * 1024 + tid; s < half * 1024 + 1024; s += NTHR) SEL[((size_t)b * SEQ + s) * NE + e] = (int)RANK[s];
    if (tid < 128) { const int t = half * 128 + tid; const unsigned long long kv = KEY[t]; const int s = SEQ - 1 - (int)(unsigned)(kv & 0xffffffffull);
        IDX[e * NSLOT + b * CAP + t] = b * SEQ + s; GATE[e * NSLOT + b * CAP + t] = __uint_as_float((unsigned)(kv >> 32)); }
    const bf16* H = (const bf16*)(a.ws + WS_H); bf16* XG = (bf16*)(a.ws + WS_XG);
    for (int q = 0; q < 16; ++q) { const int t = half * 128 + wave * 16 + q; const int s = SEQ - 1 - (int)(unsigned)(KEY[t] & 0xffffffffull);
        const v4u* src = (const v4u*)(H + ((size_t)b * SEQ + s) * DM); v4u* dst = (v4u*)(XG + ((size_t)e * NSLOT + b * CAP + t) * DM);
        dst[lane] = src[lane]; dst[64 + lane] = src[64 + lane]; }
    WG_SYNC();
}

#ifndef MK_PER_PHASE
#define MK_PER_PHASE 0
#endif
__global__ void __launch_bounds__(NTHR, 2) hybrid_fwd(Args args) {
    extern __shared__ __attribute__((aligned(16))) unsigned char lds_raw[];
    LAS unsigned char* lds = (LAS unsigned char*)lds_raw;
    volatile LAS unsigned* MISC = (volatile LAS unsigned*)(lds + MISC_OFF);
    const int tid0 = threadIdx.x, G = gridDim.x;
    unsigned char* ws = args.ws;
#define PHASE_IDS() const int tid = ltid(), lane = tid & 63, wave = __builtin_amdgcn_readfirstlane(tid >> 6), bid = lbid(); (void)lane; (void)wave; (void)bid
    gu32* ctl = (gu32*)(ws + WS_CTL);
    for (int u = tid0; u < (LDS_BYTES - MISC_OFF) / 4; u += NTHR) ((LAS unsigned*)(lds + MISC_OFF))[u] = 0u;
    __syncthreads();
    XcdBarrier bar; bar.bar = (unsigned*)(ctl + CW_BAR); bar.x = 0; bar.st = nullptr;
    if (!MK_PER_PHASE) bar = xcd_barrier_post((unsigned*)(ctl + CW_BAR), MISC + 8);
#define GRID_BAR() do { if (!MK_PER_PHASE) xcd_barrier(bar); } while (0)
    const int lo = args.ph_lo, hi = args.ph_hi;
#ifndef PT_MASK
#define PT_MASK 0x7ff
#endif
#define PT_ON(j) (((PT_MASK) >> (j)) & 1)
#define IN(k) (lo <= (k) && (k) < hi)
#define BOTH(k) (IN(k) && IN((k) + 1))

    bf16* Hb = (bf16*)(ws + WS_H); bf16* PROJ = (bf16*)(ws + WS_PROJ); bf16* Yb = (bf16*)(ws + WS_Y);
    float* MG = (float*)(ws + WS_MG); float* AFF = (float*)(ws + WS_AFF); int* SEL = (int*)(ws + WS_SEL);
    bf16* XG = (bf16*)(ws + WS_XG); bf16* HID = (bf16*)(ws + WS_HID); bf16* YE = (bf16*)(ws + WS_YE);

    if (PT_ON(0) && IN(0)) { PHASE_IDS();
        p0_weights(args, lds, tid, lane, wave, G, bid);
        WG_SYNC();
        row_pass<0>(args.in[I_X], nullptr, args.in[I_N1G], args.in[I_WIN] + NPROJ, DIN, Hb, MG, nullptr, nullptr, lds, tid, lane, wave, G, bid);
        if (BOTH(0)) GRID_BAR();
    }
    for (int l = 0; l < DEPTH; ++l) {
        const int pb = 1 + 10 * l;
        if (PT_ON(1) && IN(pb + 0)) { PHASE_IDS();
            pg8::Gemm g{Hb, (const bf16*)(ws + WS_WIN) + (size_t)l * NPROJ * DM, M, NPROJ, DM}; pg8::StaticOrder S; S.init(M, NPROJ, G, bid);
            pg8::EpiBf16<0> E{PROJ, NPROJ, nullptr, 0, 0, 1.f};
            pg8::gemm_phase<pg8::EpiBf16<0>, pg8::StaticOrder, true, true>(lds + RING_OFF, g, S, E);
            if (BOTH(pb + 0)) GRID_BAR();
        }
        if (PT_ON(2) && IN(pb + 1)) { PHASE_IDS();
            rope_pass(args, l, lane, wave, G, bid);
            for (int u = bid; u < 512; u += G) lru_a_unit(args, l, u, lds, tid, lane, wave);
            for (int u = bid; u < 512; u += G) mls_a_unit(args, l, u, lds, tid, lane, wave);
            if (BOTH(pb + 1)) GRID_BAR();
        }
        if (PT_ON(3) && IN(pb + 2)) { PHASE_IDS();
            const attn_body::AttnTensors AT{(const attn_body::bf16*)(PROJ + C_Q), (const attn_body::bf16*)(PROJ + C_K), (const attn_body::bf16*)(PROJ + C_V), (attn_body::bf16*)Yb};
            const attn_body::StaticOrder S(G, bid);
#ifndef P3_PARTS
#define P3_PARTS 7
#endif
            if (P3_PARTS & 1) attn_body::attn_phase<attn_body::StaticOrder>((char*)lds_raw + RING_OFF, AT, S);
            WG_SYNC();
            if (P3_PARTS & 2) for (int u = bid; u < 512; u += G) mls_b_unit(args, l, u, lds, tid, lane, wave);
            if (P3_PARTS & 4) for (int u = bid; u < 512; u += G) lru_b_unit(args, l, u, lds, tid, lane, wave);
            if (BOTH(pb + 2)) GRID_BAR();
        }
        if (PT_ON(4) && IN(pb + 3)) { PHASE_IDS(); attnorm_pass(args, l, lane, wave, G, bid); if (BOTH(pb + 3)) GRID_BAR(); }
        if (PT_ON(5) && IN(pb + 4)) { PHASE_IDS();
            pg8::Gemm g{Yb, (const bf16*)(ws + WS_WOUT) + (size_t)l * DM * DM, M, DM, DM}; pg8::StaticOrder S; S.init(M, DM, G, bid);
            pg8::EpiResidF32 E{l == 0 ? args.in[I_X] : args.out, args.out, DM};
            pg8::gemm_phase<pg8::EpiResidF32, pg8::StaticOrder, false, true>(lds + RING_OFF, g, S, E);
            if (BOTH(pb + 4)) GRID_BAR();
        }
        if (PT_ON(6) && IN(pb + 5)) { PHASE_IDS();
            row_pass<1>(args.out, nullptr, args.in[I_N2G] + (size_t)l * DM, args.in[I_WR] + (size_t)l * DM * NE, NE, Hb, AFF, nullptr, nullptr, lds, tid, lane, wave, G, bid);
            if (BOTH(pb + 5)) GRID_BAR();
        }
        if (PT_ON(7) && IN(pb + 6)) { PHASE_IDS(); for (int it = bid; it < 256; it += G) topk_item(args, it, lds, tid, lane, wave); if (BOTH(pb + 6)) GRID_BAR(); }
        if (PT_ON(8) && IN(pb + 7)) { PHASE_IDS();
            pg8::Gemm g{XG, (const bf16*)(ws + WS_WGU) + (size_t)l * NE * 4096 * DM, NE * NSLOT, NE * 4096, DM}; pg8::Moe1Order S{G, bid};
            pg8::EpiSwiGLU E{HID, DE};
            pg8::gemm_phase<pg8::EpiSwiGLU, pg8::Moe1Order, true, true>(lds + RING_OFF, g, S, E);
            if (BOTH(pb + 7)) GRID_BAR();
        }
        if (PT_ON(9) && IN(pb + 8)) { PHASE_IDS();
            pg8::Gemm g{HID, (const bf16*)(ws + WS_WDN) + (size_t)l * NE * DM * DE, NE * NSLOT, NE * DM, DE}; pg8::Moe2Order S{G, bid};
            pg8::EpiScaleBf16 E{YE, DM, (const float*)(ws + WS_GATE)};
            pg8::gemm_phase<pg8::EpiScaleBf16, pg8::Moe2Order, true, true>(lds + RING_OFF, g, S, E);
            if (BOTH(pb + 8)) GRID_BAR();
        }
        if (PT_ON(10) && IN(pb + 9)) { PHASE_IDS();
            if (l + 1 < DEPTH) row_pass<2>(args.out, args.out, args.in[I_N1G] + (size_t)(l + 1) * DM, args.in[I_WIN] + (size_t)(l + 1) * DM * DIN + NPROJ, DIN, Hb, MG, SEL, YE, lds, tid, lane, wave, G, bid);
            else row_pass<3>(args.out, args.out, nullptr, nullptr, 0, nullptr, nullptr, SEL, YE, lds, tid, lane, wave, G, bid);
            if (BOTH(pb + 9)) GRID_BAR();
        }
    }
#undef IN
#undef BOTH
#undef GRID_BAR
}

extern "C" void kernel_launch(void* const* d_in, const int* in_sizes, int n_in, void* d_out, int out_size, void* d_ws, size_t ws_size, hipStream_t stream) {
    static int grid = 0;
    if (grid == 0) {
        if (n_in != 22 || in_sizes[0] != M * DM || out_size != M * DM || ws_size < WS_END) { fprintf(stderr, "kernel_launch: unexpected shapes (n_in %d, in0 %d, out %d, ws %zu); nothing launched\n", n_in, n_in > 0 ? in_sizes[0] : -1, out_size, ws_size); grid = -1; return; }
        int dev = 0, cus = 0, per_cu = 0;
        if (hipGetDevice(&dev) != hipSuccess || hipDeviceGetAttribute(&cus, hipDeviceAttributeMultiprocessorCount, dev) != hipSuccess) { grid = -1; return; }
        if (hipFuncSetAttribute((const void*)hybrid_fwd, hipFuncAttributeMaxDynamicSharedMemorySize, LDS_BYTES) != hipSuccess) { fprintf(stderr, "kernel_launch: hipFuncSetAttribute failed\n"); grid = -1; return; }
        if (hipOccupancyMaxActiveBlocksPerMultiprocessor(&per_cu, (const void*)hybrid_fwd, NTHR, LDS_BYTES) != hipSuccess || per_cu < 1) { fprintf(stderr, "kernel_launch: occupancy query says %d\n", per_cu); }
        (void)hipGetLastError();
        grid = cus;
    }
    if (grid < 0) return;
    if (hipMemsetAsync((char*)d_ws + WS_CTL, 0, CTL_ZERO_BYTES, stream) != hipSuccess) return;
    Args a{};
    for (int i = 0; i < 22; ++i) a.in[i] = (const float*)d_in[i];
    a.out = (float*)d_out; a.ws = (unsigned char*)d_ws; a.pad = 0;
#if MK_PER_PHASE
    for (int p = 0; p < NPH; ++p) { a.ph_lo = p; a.ph_hi = p + 1; a.li = p; hipLaunchKernelGGL(hybrid_fwd, dim3(grid), dim3(NTHR), LDS_BYTES, stream, a); }
#else
    a.ph_lo = 0; a.ph_hi = NPH; a.li = 0;
    hipLaunchKernelGGL(hybrid_fwd, dim3(grid), dim3(NTHR), LDS_BYTES, stream, a);
#endif
    const hipError_t le = hipPeekAtLastError();
    if (le != hipSuccess) fprintf(stderr, "kernel_launch: launch failed: %s\n", hipGetErrorName(le));
}
```

```cpp
#include <hip/hip_runtime.h>
#include <hip/hip_bf16.h>
#include <cstdio>
#include <cstdint>
#include <cmath>
__device__ __forceinline__ int ltid() { int t = threadIdx.x; asm volatile("" : "+v"(t)); return t; }
__device__ __forceinline__ int lbid() { int t = blockIdx.x; asm volatile("" : "+s"(t)); return t; }
namespace pg8 {
#define PG8_LAS __attribute__((address_space(3)))
typedef unsigned short bf16_t;
typedef short bf16x8 __attribute__((ext_vector_type(8)));
typedef float f32x4 __attribute__((ext_vector_type(4)));
typedef unsigned u32x4 __attribute__((ext_vector_type(4)));
constexpr int BM = 256, BK = 64, HALF = 128, HTB = HALF * BK * 2  , STAGE_BYTES = 8 * HTB, NXCD = 8, WGM = 8;

__host__ __device__ __forceinline__ int lds_byte(int r, int c) { const int st = (r >> 4) * 2 + (c >> 5), rr = r & 15, cc = c & 31, ob = rr * 64 + cc * 2; return st * 1024 + (ob ^ (((ob >> 9) & 1) << 5)); }
__host__ __device__ __forceinline__ void stage_rc(int b, int& R, int& C) { const int st = b / 1024, sb = b % 1024, swz = sb ^ (((sb >> 9) & 1) << 5); R = (st >> 1) * 16 + swz / 64; C = (st & 1) * 32 + (swz % 64) / 2; }
__host__ __device__ __forceinline__ int perm32(int rho) { const int n = rho >> 4, i = rho & 15; return 8 * (i >> 2) + 4 * n + (i & 3); }

struct Unit { int pm, pn; };
struct Gemm { const bf16_t* A; const bf16_t* Bt; int M, N, K; };

struct StaticOrder {
    int nM, nN, nwg, G, c;
    __host__ __device__ void init(int M, int N, int G_, int c_) { nM = M / BM; nN = N / BM; nwg = nM * nN; G = G_; c = c_; }
    __host__ __device__ bool next(int i, Unit& u) const {
        const long L = (long)i * G + c; if (L >= nwg) return false;
        int wgid = (int)L; { const int q = nwg / NXCD, r = nwg % NXCD, xcd = wgid % NXCD, off = wgid / NXCD; wgid = (xcd < r ? xcd * (q + 1) : r * (q + 1) + (xcd - r) * q) + off; }
        const int nig = WGM * nN, gid = wgid / nig, fm = gid * WGM, gsz = (nM - fm) < WGM ? (nM - fm) : WGM;
        u.pm = fm + ((wgid % nig) % gsz); u.pn = (wgid % nig) / gsz; return true;
    }
    __device__ __forceinline__ void a_ready(const Unit&) const {}
    __device__ __forceinline__ void done(const Unit&) const {}
};

__device__ __forceinline__ unsigned cvt_pk_bf16(float lo, float hi) { unsigned r; asm volatile("v_cvt_pk_bf16_f32 %0, %1, %2" : "=v"(r) : "v"(lo), "v"(hi)); return r; }
typedef float f32x2 __attribute__((ext_vector_type(2)));
__device__ __forceinline__ f32x2 gelu_pk(f32x2 v) {
    const f32x2 av = __builtin_elementwise_abs(v), d = av * 0.2316418882f + 1.0f;
    f32x2 t; t.x = __builtin_amdgcn_rcpf(d.x); t.y = __builtin_amdgcn_rcpf(d.y);
    f32x2 q = t * 0.5307027145f + (-0.7265760135f); q = q * t + 0.7107068705f; q = q * t + (-0.142248368f); q = q * t + 0.127414796f; q = q * t;
    const f32x2 s = (v * v) * (-0.72134752044f);
    f32x2 e; e.x = __builtin_amdgcn_exp2f(s.x); e.y = __builtin_amdgcn_exp2f(s.y);
    const f32x2 m = v * (q * e), r = v - m;
    f32x2 o; o.x = v.x < 0.f ? m.x : r.x; o.y = v.y < 0.f ? m.y : r.y; return o;
}

template <int ACT  > struct EpiBf16 {
    static constexpr bool PERM = true, AFTER_DRAIN = false; static_assert(ACT == 0 || ACT == 1, "EpiBf16: ACT is 0 (none) or 1 (gelu_pk)");
    bf16_t* O; int ldc; const float* bias; int split_cols; size_t split_stride; float scale0;
    __device__ __forceinline__ void operator()(const f32x4 (&acc)[2][2][4][2], const Unit& u, int wr, int wc, int fr, int fq) const {
        const int row0 = u.pm * BM + wr * 64 + fr; int colt = u.pn * BM; bf16_t* base = O;
        float sc = 1.f; if (split_cols) { const int t = colt / split_cols; base += (size_t)t * split_stride; colt -= t * split_cols; if (t == 0) sc = scale0; }
        const int col0 = colt + wc * 32 + 8 * fq, bcol0 = u.pn * BM + wc * 32 + 8 * fq;
        f32x4 bv[2][2];
#pragma unroll
        for (int bj = 0; bj < 2; ++bj)
#pragma unroll
            for (int n = 0; n < 2; ++n) bv[bj][n] = bias ? *(const f32x4*)(bias + bcol0 + bj * HALF + 4 * n) : (f32x4){0.f, 0.f, 0.f, 0.f};
#pragma unroll
        for (int ai = 0; ai < 2; ++ai)
#pragma unroll
            for (int m = 0; m < 4; ++m) { bf16_t* rowp = base + (size_t)(row0 + ai * HALF + m * 16) * ldc + col0;
#pragma unroll
                for (int bj = 0; bj < 2; ++bj) { f32x4 v0 = acc[ai][bj][m][0] + bv[bj][0], v1 = acc[ai][bj][m][1] + bv[bj][1];
                    if (ACT == 1) { f32x2 a = gelu_pk((f32x2){v0[0], v0[1]}), b = gelu_pk((f32x2){v0[2], v0[3]}), c = gelu_pk((f32x2){v1[0], v1[1]}), d = gelu_pk((f32x2){v1[2], v1[3]});
                        v0 = (f32x4){a.x, a.y, b.x, b.y}; v1 = (f32x4){c.x, c.y, d.x, d.y}; }
                    v0 = v0 * sc; v1 = v1 * sc; u32x4 w; w.x = cvt_pk_bf16(v0[0], v0[1]); w.y = cvt_pk_bf16(v0[2], v0[3]); w.z = cvt_pk_bf16(v1[0], v1[1]); w.w = cvt_pk_bf16(v1[2], v1[3]);
                    *(u32x4*)(rowp + bj * HALF) = w; } }
    }
};

struct EpiResidF32 {
    static constexpr bool PERM = false, AFTER_DRAIN = false;
    const float* base; float* C; int ldc;
    __device__ __forceinline__ void operator()(const f32x4 (&acc)[2][2][4][2], const Unit& u, int wr, int wc, int fr, int fq) const {
        const int row0 = u.pm * BM + wr * 64 + fr, col0 = u.pn * BM + wc * 32 + 4 * fq;
#pragma unroll
        for (int ai = 0; ai < 2; ++ai)
#pragma unroll
            for (int m = 0; m < 4; ++m) { const size_t off = (size_t)(row0 + ai * HALF + m * 16) * ldc + col0;
#pragma unroll
                for (int bj = 0; bj < 2; ++bj)
#pragma unroll
                    for (int n = 0; n < 2; ++n) { const f32x4 b = *(const f32x4*)(base + off + bj * HALF + n * 16); *(f32x4*)(C + off + bj * HALF + n * 16) = acc[ai][bj][m][n] + b; } }
    }
};
__device__ __forceinline__ float silu_f(float x) { return x * __builtin_amdgcn_rcpf(1.0f + __builtin_amdgcn_exp2f(-1.4426950408889634f * x)); }
struct EpiSwiGLU {
    static constexpr bool PERM = true, AFTER_DRAIN = false;
    bf16_t* O; int ldc;
    __device__ __forceinline__ void operator()(const f32x4 (&acc)[2][2][4][2], const Unit& u, int wr, int wc, int fr, int fq) const {
        const int row0 = u.pm * BM + wr * 64 + fr, col0 = (u.pn & 15) * HALF + wc * 32 + 8 * fq;
#pragma unroll
        for (int ai = 0; ai < 2; ++ai)
#pragma unroll
            for (int m = 0; m < 4; ++m) { bf16_t* rowp = O + (size_t)(row0 + ai * HALF + m * 16) * ldc + col0;
                const f32x4 g0 = acc[ai][0][m][0], g1 = acc[ai][0][m][1], u0 = acc[ai][1][m][0], u1 = acc[ai][1][m][1];
                u32x4 w; w.x = cvt_pk_bf16(silu_f(g0[0]) * u0[0], silu_f(g0[1]) * u0[1]); w.y = cvt_pk_bf16(silu_f(g0[2]) * u0[2], silu_f(g0[3]) * u0[3]);
                w.z = cvt_pk_bf16(silu_f(g1[0]) * u1[0], silu_f(g1[1]) * u1[1]); w.w = cvt_pk_bf16(silu_f(g1[2]) * u1[2], silu_f(g1[3]) * u1[3]);
                *(u32x4*)rowp = w; }
    }
};
struct EpiScaleBf16 {
    static constexpr bool PERM = true, AFTER_DRAIN = false;
    bf16_t* O; int ldc; const float* rowscale;
    __device__ __forceinline__ void operator()(const f32x4 (&acc)[2][2][4][2], const Unit& u, int wr, int wc, int fr, int fq) const {
        const int row0 = u.pm * BM + wr * 64 + fr, col0 = (u.pn & 3) * BM + wc * 32 + 8 * fq;
#pragma unroll
        for (int ai = 0; ai < 2; ++ai)
#pragma unroll
            for (int m = 0; m < 4; ++m) { const int row = row0 + ai * HALF + m * 16; const float s = rowscale[row]; bf16_t* rowp = O + (size_t)row * ldc + col0;
#pragma unroll
                for (int bj = 0; bj < 2; ++bj) { const f32x4 v0 = acc[ai][bj][m][0] * s, v1 = acc[ai][bj][m][1] * s;
                    u32x4 w; w.x = cvt_pk_bf16(v0[0], v0[1]); w.y = cvt_pk_bf16(v0[2], v0[3]); w.z = cvt_pk_bf16(v1[0], v1[1]); w.w = cvt_pk_bf16(v1[2], v1[3]);
                    *(u32x4*)(rowp + bj * HALF) = w; } }
    }
};
struct Moe1Order {
    int G, c;
    __device__ __forceinline__ bool next(int i, Unit& u) const {
        const int L = i * G + c; if (L >= 2048) return false;
        const int e = L >> 7, r = L & 127; u.pm = e * 8 + ((r >> 3) & 7); u.pn = e * 16 + 2 * (r & 7) + (r >> 6); return true;
    }
    __device__ __forceinline__ void a_ready(const Unit&) const {}
    __device__ __forceinline__ void done(const Unit&) const {}
};
struct Moe2Order {
    int G, c;
    __device__ __forceinline__ bool next(int i, Unit& u) const {
        const int L = i * G + c; if (L >= 512) return false;
        const int q = L & 7, Lp = L >> 3, e = 8 * (Lp >> 5) + q, k = Lp & 31; u.pm = e * 8 + (k & 7); u.pn = e * 4 + (k >> 3); return true;
    }
    __device__ __forceinline__ void a_ready(const Unit&) const {}
    __device__ __forceinline__ void done(const Unit&) const {}
};
template <class Epi, class Sched, bool ALIGN_EPI = false, bool SP2 = false>
__device__ __forceinline__ void gemm_phase(PG8_LAS unsigned char* lds, const Gemm g, const Sched& S, const Epi& E) {
    const int tid = ltid(), wid = __builtin_amdgcn_readfirstlane(tid >> 6), lane = tid & 63, wr = wid >> 2, wc = wid & 3, fr = lane & 15, fq = lane >> 4;
    const int K = g.K, nt = K / BK;
    unsigned voffA[2], voffB[2];
#pragma unroll
    for (int i = 0; i < 2; ++i) { int R, C; stage_rc(tid * 16 + i * 8192, R, C); const int Rb = Epi::PERM ? ((R & ~31) + perm32(R & 31)) : R;
        voffA[i] = (unsigned)(R * K + C) * 2u; voffB[i] = (unsigned)(Rb * K + C) * 2u; }
    const size_t kstep = (size_t)(BK * 2);
    const size_t hstep = (size_t)HALF * K * 2;
    const size_t tstep = 2 * hstep;
    const unsigned ldsw = (unsigned)wid * 1024u;
    const int aoff = lds_byte(wr * 64 + fr, fq * 8), boff = lds_byte(wc * 32 + fr, fq * 8);
#define PG8_SA(b, h) (((b) * 2 + (h)) * HTB)
#define PG8_SB(b, h) ((4 + (b) * 2 + (h)) * HTB)
#define PG8_STAGE(bufoff, gbase, voff) do { _Pragma("unroll") for (int _i = 0; _i < 2; ++_i) \
        __builtin_amdgcn_global_load_lds((const unsigned*)((const char*)(gbase) + (voff)[_i]), (PG8_LAS unsigned*)(lds + (bufoff) + ldsw + _i * 8192), 16, 0, 0); } while (0)
#define PG8_LDA(dst, b, h) do { _Pragma("unroll") for (int m = 0; m < 4; ++m) _Pragma("unroll") for (int k = 0; k < 2; ++k) dst[m][k] = *(const PG8_LAS bf16x8*)(lds + PG8_SA(b, h) + aoff + m * 2048 + k * 1024); } while (0)
#define PG8_LDB(dst, b, h) do { _Pragma("unroll") for (int n = 0; n < 2; ++n) _Pragma("unroll") for (int k = 0; k < 2; ++k) dst[n][k] = *(const PG8_LAS bf16x8*)(lds + PG8_SB(b, h) + boff + n * 2048 + k * 1024); } while (0)
#define PG8_MMA(ai, bj, At, Bt) do { __builtin_amdgcn_s_setprio(1); _Pragma("unroll") for (int m = 0; m < 4; ++m) _Pragma("unroll") for (int n = 0; n < 2; ++n) _Pragma("unroll") for (int k = 0; k < 2; ++k) \
        acc[ai][bj][m][n] = __builtin_amdgcn_mfma_f32_16x16x32_bf16(Bt[n][k], At[m][k], acc[ai][bj][m][n], 0, 0, 0); __builtin_amdgcn_s_setprio(0); } while (0)
#define PG8_WAIT_V(n) asm volatile("s_waitcnt vmcnt(" #n ")" ::: "memory")
#define PG8_WAIT_L(n) asm volatile("s_waitcnt lgkmcnt(" #n ")" ::: "memory")
#define PG8_BAR __builtin_amdgcn_s_barrier()
#define PG8_SCHED __builtin_amdgcn_sched_barrier(0)
    Unit cur, nxt; int ui = 0;
    if (!S.next(0, cur)) return;
    f32x4 acc[2][2][4][2];
#pragma unroll
    for (int a = 0; a < 2; ++a)
#pragma unroll
        for (int b = 0; b < 2; ++b)
#pragma unroll
            for (int m = 0; m < 4; ++m)
#pragma unroll
                for (int n = 0; n < 2; ++n) acc[a][b][m][n] = (f32x4){0.f, 0.f, 0.f, 0.f};
    bf16x8 At[4][2], B0[2][2], B1[2][2];
    const char* cA = (const char*)g.A + (size_t)cur.pm * tstep; const char* cB = (const char*)g.Bt + (size_t)cur.pn * tstep;
    S.a_ready(cur);
    if constexpr (SP2) {
        PG8_STAGE(PG8_SB(0, 0), cB, voffB); PG8_STAGE(PG8_SB(0, 1), cB + hstep, voffB); PG8_STAGE(PG8_SA(0, 0), cA, voffA); PG8_STAGE(PG8_SA(0, 1), cA + hstep, voffA);
        if (wr == 1) PG8_BAR;
        PG8_WAIT_V(2); PG8_BAR;
        PG8_STAGE(PG8_SB(1, 0), cB + kstep, voffB); PG8_STAGE(PG8_SA(1, 0), cA + kstep, voffA); PG8_STAGE(PG8_SB(1, 1), cB + hstep + kstep, voffB);
        PG8_WAIT_V(6); PG8_BAR;
    } else {
        PG8_STAGE(PG8_SB(0, 0), cB, voffB); PG8_STAGE(PG8_SA(0, 0), cA, voffA); PG8_STAGE(PG8_SB(0, 1), cB + hstep, voffB); PG8_STAGE(PG8_SA(0, 1), cA + hstep, voffA);
        if (wr == 1) PG8_BAR;
        PG8_WAIT_V(4); PG8_BAR;
        PG8_STAGE(PG8_SB(1, 0), cB + kstep, voffB); PG8_STAGE(PG8_SA(1, 0), cA + kstep, voffA); PG8_STAGE(PG8_SB(1, 1), cB + hstep + kstep, voffB);
        PG8_WAIT_V(6); PG8_BAR;
    }
    for (;;) {
        const bool has_next = S.next(ui + 1, nxt);
        const char* nA = has_next ? (const char*)g.A + (size_t)nxt.pm * tstep : cA; const char* nB = has_next ? (const char*)g.Bt + (size_t)nxt.pn * tstep : cB;
        for (int t = 0; t < nt; t += 2) {
            const bool last = (t == nt - 2);
            const char* a1 = cA + (size_t)(t + 1) * kstep;
            const char* a2 = last ? nA : cA + (size_t)(t + 2) * kstep; const char* b2 = last ? nB : cB + (size_t)(t + 2) * kstep;
            const char* a3 = a2 + kstep; const char* b3 = b2 + kstep;
            if (last && has_next) S.a_ready(nxt);
            if constexpr (SP2) {
            PG8_LDB(B0, 0, 0); PG8_LDB(B1, 0, 1); PG8_SCHED; PG8_LDA(At, 0, 0); PG8_STAGE(PG8_SA(1, 1), a1 + hstep, voffA);
            PG8_WAIT_V(8); PG8_WAIT_L(0); PG8_BAR; PG8_MMA(0, 0, At, B0); PG8_MMA(0, 1, At, B1); PG8_BAR; PG8_SCHED;
            PG8_LDA(At, 0, 1); PG8_STAGE(PG8_SB(0, 0), b2, voffB); PG8_STAGE(PG8_SB(0, 1), b2 + hstep, voffB); PG8_STAGE(PG8_SA(0, 0), a2, voffA);
            PG8_WAIT_V(8); PG8_WAIT_L(0); PG8_BAR; PG8_MMA(1, 0, At, B0); PG8_MMA(1, 1, At, B1); PG8_BAR; PG8_SCHED;
            PG8_LDB(B0, 1, 0); PG8_LDB(B1, 1, 1); PG8_SCHED; PG8_LDA(At, 1, 0); PG8_STAGE(PG8_SA(0, 1), a2 + hstep, voffA);
            PG8_WAIT_V(8); PG8_WAIT_L(0); PG8_BAR; PG8_MMA(0, 0, At, B0); PG8_MMA(0, 1, At, B1); PG8_BAR; PG8_SCHED;
            PG8_LDA(At, 1, 1); PG8_STAGE(PG8_SB(1, 0), b3, voffB); PG8_STAGE(PG8_SB(1, 1), b3 + hstep, voffB); PG8_STAGE(PG8_SA(1, 0), a3, voffA);
            PG8_WAIT_V(8); PG8_WAIT_L(0); PG8_BAR; PG8_MMA(1, 0, At, B0); PG8_MMA(1, 1, At, B1); PG8_BAR; PG8_SCHED;
            } else {
            PG8_LDB(B0, 0, 0); PG8_SCHED; PG8_LDA(At, 0, 0); PG8_STAGE(PG8_SA(1, 1), a1 + hstep, voffA);
            PG8_WAIT_L(8); PG8_BAR; PG8_WAIT_L(0); PG8_MMA(0, 0, At, B0); PG8_BAR; PG8_SCHED;
            PG8_LDB(B1, 0, 1); PG8_STAGE(PG8_SB(0, 0), b2, voffB);
            PG8_BAR; PG8_WAIT_L(0); PG8_MMA(0, 1, At, B1); PG8_BAR;
            PG8_LDA(At, 0, 1); PG8_STAGE(PG8_SA(0, 0), a2, voffA);
            PG8_BAR; PG8_WAIT_L(0); PG8_MMA(1, 0, At, B0); PG8_BAR; PG8_SCHED;
            PG8_STAGE(PG8_SB(0, 1), b2 + hstep, voffB);
            PG8_WAIT_V(6); PG8_BAR; PG8_MMA(1, 1, At, B1); PG8_BAR;
            PG8_LDB(B0, 1, 0); PG8_SCHED; PG8_LDA(At, 1, 0); PG8_STAGE(PG8_SA(0, 1), a2 + hstep, voffA);
            PG8_WAIT_L(8); PG8_BAR; PG8_WAIT_L(0); PG8_MMA(0, 0, At, B0); PG8_BAR; PG8_SCHED;
            PG8_LDB(B1, 1, 1); PG8_STAGE(PG8_SB(1, 0), b3, voffB);
            PG8_BAR; PG8_WAIT_L(0); PG8_MMA(0, 1, At, B1); PG8_BAR;
            PG8_LDA(At, 1, 1); PG8_STAGE(PG8_SA(1, 0), a3, voffA);
            PG8_BAR; PG8_WAIT_L(0); PG8_MMA(1, 0, At, B0); PG8_BAR; PG8_SCHED;
            PG8_STAGE(PG8_SB(1, 1), b3 + hstep, voffB);
            PG8_WAIT_V(6); PG8_BAR; PG8_MMA(1, 1, At, B1); PG8_BAR;
            }
        }
        if constexpr (ALIGN_EPI) { if (wr == 0) PG8_BAR; }
        if constexpr (!Epi::AFTER_DRAIN) { E(acc, cur, wr, wc, fr, fq); S.done(cur); }
        if (!has_next) break;
#pragma unroll
        for (int a = 0; a < 2; ++a)
#pragma unroll
            for (int b = 0; b < 2; ++b)
#pragma unroll
                for (int m = 0; m < 4; ++m)
#pragma unroll
                    for (int n = 0; n < 2; ++n) acc[a][b][m][n] = (f32x4){0.f, 0.f, 0.f, 0.f};
        cur = nxt; cA = nA; cB = nB; ++ui;
        if constexpr (ALIGN_EPI) { if (wr == 1) PG8_BAR; }
    }
    PG8_WAIT_V(0);
    if constexpr (!ALIGN_EPI) { if (wr == 0) PG8_BAR; }
    PG8_BAR;
    if constexpr (Epi::AFTER_DRAIN) { E.fused(acc, cur, wr, wc, fr, fq, lds, wid, lane); S.done(cur); }
#undef PG8_SA
#undef PG8_SB
#undef PG8_STAGE
#undef PG8_LDA
#undef PG8_LDB
#undef PG8_MMA
#undef PG8_WAIT_V
#undef PG8_WAIT_L
#undef PG8_BAR
#undef PG8_SCHED
}
}

namespace attn_body {
using bf16=__hip_bfloat16;
using bf16x8=__attribute__((ext_vector_type(8)))short;
using s16x4=__attribute__((ext_vector_type(4)))short;
using f32x16=__attribute__((ext_vector_type(16)))float;
using u32x4=__attribute__((ext_vector_type(4)))unsigned;
constexpr int BATCH=8,NHEAD=8,NKV=2,SEQ=2048,D=64,PQ=2304,PO=1024;
constexpr int NW=8,QBLK=32,QB=QBLK*NW,KVBLK=64,NQB=SEQ/QB;
constexpr int ATTN_UNIT_ROWS=QB;
__device__ __forceinline__ int crow(int r,int hi){return (r&3)+8*(r>>2)+4*hi;}
#define SBAR() __builtin_amdgcn_sched_barrier(0)
__device__ __forceinline__ void cmask(f32x16&p0,f32x16&p1,int jb,int qrel,int hi){
  const float NEG=-INFINITY; int kb=64*jb+4*hi;
  #pragma unroll
  for(int r=0;r<16;++r){int kv=kb+(r&3)+8*(r>>2); if(kv>qrel)p0[r]=NEG; if(kv+32>qrel)p1[r]=NEG;}
}

constexpr int NSLOT=3, SLOTB=8192;
constexpr int LDS_K=0, LDS_V=NSLOT*SLOTB, LDS_WS=2*NSLOT*SLOTB, LDS_OST=LDS_WS+NW*64*4, LDS_BYTES=LDS_OST+NW*4096;
constexpr float C2=0.125f*1.4426950408889634f;
__device__ __forceinline__ void glds16(const void*gsrc,unsigned lds_dst){unsigned keep;
  asm volatile("s_mov_b32 %0, m0\n\ts_mov_b32 m0, %2\n\ts_nop 0\n\tglobal_load_lds_dwordx4 %1, off\n\ts_mov_b32 m0, %0":"=&s"(keep):"v"(gsrc),"s"(lds_dst):"memory");}
__device__ __forceinline__ float max3f(float a,float b,float c){float r;asm("v_max3_f32 %0, %1, %2, %3":"=v"(r):"v"(a),"v"(b),"v"(c));return r;}
__device__ __forceinline__ float max2f(float a,float b){float r;asm("v_max_f32_e32 %0, %1, %2":"=v"(r):"v"(a),"v"(b));return r;}
__device__ __forceinline__ float fadd_s(float a,float b){float r;asm("v_add_f32_e32 %0, %1, %2":"=v"(r):"v"(a),"v"(b));return r;}
__device__ __forceinline__ float fsub_s(float a,float b){float r;asm("v_sub_f32_e32 %0, %1, %2":"=v"(r):"v"(a),"v"(b));return r;}
typedef float f32x2_t __attribute__((ext_vector_type(2))); typedef __bf16 bf16x2_t __attribute__((ext_vector_type(2)));
__device__ __forceinline__ unsigned cvtpk_s(float lo,float hi){f32x2_t v={lo,hi};bf16x2_t b=__builtin_convertvector(v,bf16x2_t);return __builtin_bit_cast(unsigned,b);}
#define WAIT_BAR(N) asm volatile("s_waitcnt vmcnt(" #N ") lgkmcnt(0)\n\ts_barrier":::"memory")

__device__ __forceinline__ void qkt(f32x16&p0,f32x16&p1,const char*Kslot,const bf16x8*qr,const f32x16&negm,int r32,int hi){
  const char*kb=Kslot+hi*1024+r32*16;
  #pragma unroll
  for(int d0=0;d0<4;++d0){
    const bf16x8 b0=*reinterpret_cast<const bf16x8*>(kb+d0*2048);
    const bf16x8 b1=*reinterpret_cast<const bf16x8*>(kb+d0*2048+512);
    if(d0==0){p0=__builtin_amdgcn_mfma_f32_32x32x16_bf16(b0,qr[0],negm,0,0,0);p1=__builtin_amdgcn_mfma_f32_32x32x16_bf16(b1,qr[0],negm,0,0,0);}
    else{p0=__builtin_amdgcn_mfma_f32_32x32x16_bf16(b0,qr[d0],p0,0,0,0);p1=__builtin_amdgcn_mfma_f32_32x32x16_bf16(b1,qr[d0],p1,0,0,0);}}
}
typedef __attribute__((address_space(3))) const char* lds_cptr;
typedef short v4i16_t __attribute__((ext_vector_type(4)));
__device__ __forceinline__ void kload8(bf16x8*kf,lds_cptr kp){
  kf[0]=*(const __attribute__((address_space(3))) bf16x8*)(kp);      kf[1]=*(const __attribute__((address_space(3))) bf16x8*)(kp+512);
  kf[2]=*(const __attribute__((address_space(3))) bf16x8*)(kp+2048); kf[3]=*(const __attribute__((address_space(3))) bf16x8*)(kp+2560);
  kf[4]=*(const __attribute__((address_space(3))) bf16x8*)(kp+4096); kf[5]=*(const __attribute__((address_space(3))) bf16x8*)(kp+4608);
  kf[6]=*(const __attribute__((address_space(3))) bf16x8*)(kp+6144); kf[7]=*(const __attribute__((address_space(3))) bf16x8*)(kp+6656);
}
__device__ __forceinline__ void kload2(bf16x8*kf,lds_cptr kp,int j){ kf[2*j]=*(const __attribute__((address_space(3))) bf16x8*)(kp+j*2048); kf[2*j+1]=*(const __attribute__((address_space(3))) bf16x8*)(kp+j*2048+512); }
__device__ __forceinline__ s16x4 vtr(lds_cptr p){ return __builtin_bit_cast(s16x4,__builtin_amdgcn_ds_read_tr16_b64_v4i16((__attribute__((address_space(3))) v4i16_t*)p)); }
__device__ __forceinline__ float rowmax(const f32x16&p0,const f32x16&p1){
  float a=max3f(p0[0],p0[1],p1[0]),b=max3f(p0[2],p0[3],p1[1]);a=max3f(a,p1[2],p1[3]);
  #pragma unroll
  for(int r=4;r<16;r+=4){a=max3f(a,p0[r],p0[r+1]);b=max3f(b,p0[r+2],p0[r+3]);a=max3f(a,p1[r],p1[r+1]);b=max3f(b,p1[r+2],p1[r+3]);}
  const float m=max2f(a,b);
  auto rr=__builtin_amdgcn_permlane32_swap(__float_as_uint(m),__float_as_uint(m),false,false);
  return max2f(__uint_as_float(rr[0]),__uint_as_float(rr[1]));
}
__device__ __forceinline__ void pv(f32x16*o,int vb,bf16x8 pa0,bf16x8 pa1,bf16x8 pa2,bf16x8 pa3){
  #pragma unroll
  for(int d0=0;d0<2;++d0){s16x4 lo[4],hi[4];
    #pragma unroll
    for(int ks=0;ks<4;++ks){
      asm volatile("ds_read_b64_tr_b16 %0,%1 offset:%c2":"=&v"(lo[ks]):"v"(vb),"i"(d0*4096+ks*1024):"memory");
      asm volatile("ds_read_b64_tr_b16 %0,%1 offset:%c2":"=&v"(hi[ks]):"v"(vb),"i"(d0*4096+ks*1024+512):"memory");}
    asm volatile("s_waitcnt lgkmcnt(0)":::"memory");SBAR();
    #define PK(k) (bf16x8){lo[k][0],lo[k][1],lo[k][2],lo[k][3],hi[k][0],hi[k][1],hi[k][2],hi[k][3]}
    o[d0]=__builtin_amdgcn_mfma_f32_32x32x16_bf16(pa0,PK(0),o[d0],0,0,0);
    o[d0]=__builtin_amdgcn_mfma_f32_32x32x16_bf16(pa1,PK(1),o[d0],0,0,0);
    o[d0]=__builtin_amdgcn_mfma_f32_32x32x16_bf16(pa2,PK(2),o[d0],0,0,0);
    o[d0]=__builtin_amdgcn_mfma_f32_32x32x16_bf16(pa3,PK(3),o[d0],0,0,0);
    #undef PK
  }
}

#ifndef ATTN_STORE16
#define ATTN_STORE16(p,v) (*(u32x4*)(p)=(v))
#endif
template<int THRL> __device__ __forceinline__ void attn_unit(int b,int h,int qb,const bf16*Q,const bf16*__restrict__ K,const bf16*__restrict__ V,bf16*O,char*shm){
  const int tid=ltid(),lane=tid&63,r32=lane&31,hi=lane>>5; const int wid=__builtin_amdgcn_readfirstlane(tid>>6);
  const long rowbase=(long)b*SEQ; const int q0=qb*QB;
  const bf16*Qw=Q+(rowbase+q0+wid*QBLK)*PQ+h*D;
  const bf16*Kh=K+rowbase*PQ+(h>>2)*D,*Vh=V+rowbase*PQ+(h>>2)*D;
  const unsigned lds0=(unsigned)(uintptr_t)shm;
  float*wsf=(float*)(shm+LDS_WS)+wid*64;
  const bf16*ksrc=Kh+(long)lane*PQ+wid*8;
  const bf16*vsrc=Vh+(long)(16*(wid&3)+(lane>>2))*PQ+(wid>>2)*32+(lane&3)*8;
  const unsigned kdst=lds0+LDS_K+wid*1024, vdst=lds0+LDS_V+wid*1024;
  #define DMA_K(t,slot) glds16(ksrc+(long)(t)*KVBLK*PQ,(unsigned)__builtin_amdgcn_readfirstlane(kdst+(slot)))
  #define DMA_V(t,slot) glds16(vsrc+(long)(t)*KVBLK*PQ,(unsigned)__builtin_amdgcn_readfirstlane(vdst+(slot)))
  const int vb0=(int)(lds0+LDS_V)+((lane>>4)&1)*32+(lane&3)*8+(4*hi+((lane&15)>>2))*64;
  const char*Kbase=shm+LDS_K; bf16x8 kf[8];
  const lds_cptr shm3=(lds_cptr)shm; const lds_cptr kp0=shm3+LDS_K+hi*1024+r32*16; const lds_cptr vp0=shm3+LDS_V+((lane>>4)&1)*32+(lane&3)*8+(4*hi+((lane&15)>>2))*64;
  const int NT=SEQ/KVBLK;
  DMA_K(0,0);DMA_V(0,0);DMA_K(1,SLOTB);
  bf16x8 qr[4];
  #pragma unroll
  for(int d0=0;d0<4;++d0)qr[d0]=*reinterpret_cast<const bf16x8*>(&Qw[(long)r32*PQ+d0*16+hi*8]);
  float mhat=0.f,l_reg=0.f;f32x16 o[2];o[0]=f32x16{};o[1]=f32x16{};f32x16 negm=f32x16{};asm volatile("":"+v"(negm));
  const int qrel=wid*QBLK+r32;
  #define CMASK(P0,P1,t) do{}while(0)
  bool resc=false;
  #define START(P0,P1) do{ const float rm=rowmax(P0,P1); resc=false; \
    { const float dl=rm; mhat=fadd_s(mhat,dl); \
      _Pragma("unroll") for(int r=0;r<16;++r){P0[r]=fsub_s(P0[r],dl);P1[r]=fsub_s(P1[r],dl);} \
      _Pragma("unroll") for(int r=0;r<16;++r)negm[r]=-mhat; asm volatile("":"+v"(negm)); } \
    _Pragma("unroll") for(int r=0;r<16;++r)P0[r]=__builtin_amdgcn_exp2f(P0[r]); }while(0)
  #define RESC() do{ if(resc){ asm volatile("s_waitcnt lgkmcnt(0)":::"memory"); \
      _Pragma("unroll") for(int d_=0;d_<2;++d_) _Pragma("unroll") for(int r=0;r<16;++r)o[d_][r]*=wsf[crow(r,hi)]; } }while(0)
  f32x16 pA0,pA1,pB0,pB1;
  int sl_prev=0,sl_cur=0,sl_next=SLOTB;
  #define ROT() do{sl_prev=sl_cur;sl_cur=sl_next;sl_next=(sl_next==(NSLOT-1)*SLOTB)?0:sl_next+SLOTB;}while(0)
  DMA_K(2,2*SLOTB);
  WAIT_BAR(3);
  qkt(pA0,pA1,Kbase,qr,negm,r32,hi);asm volatile("s_nop 15\n\ts_nop 7":"+v"(pA0),"+v"(pA1));CMASK(pA0,pA1,0);
  START(pA0,pA1);
  _Pragma("unroll") for(int r=0;r<16;++r)pA1[r]=__builtin_amdgcn_exp2f(pA1[r]);
  WAIT_BAR(0);
  DMA_K(3,0);DMA_V(1,SLOTB);
  ROT();
  kload8(kf,kp0+sl_cur);
  WAIT_BAR(2);
  s16x4 vlo[8],vhi[8]; u32x4 pw0,pw1,pw2,pw3;
  #define PKW(P,B) cvtpk_s(P[B],P[B+1])
  #define PAF(k) __builtin_bit_cast(bf16x8,pw##k)
  #define VFR(i) (bf16x8){vlo[i][0],vlo[i][1],vlo[i][2],vlo[i][3],vhi[i][0],vhi[i][1],vhi[i][2],vhi[i][3]}
  #define PIN(x) asm volatile("":"+v"(x))
  #define MX3(a,b,c) __builtin_fmaxf(__builtin_fmaxf((a),(b)),(c))
  #define GAPA(MF,A0,A1,A2,A3,W0,W1,PW) do{ MF; sacc+=A0; sacc+=A1; sacc+=A2; sacc+=A3; PIN(sacc); W0; W1; PIN(PW); SBAR(); }while(0)
  #define EX(v) __builtin_amdgcn_exp2f(v)
  #define GAPB(MF,X,B) do{ MF; X[B]=EX(X[B]); X[B+1]=EX(X[B+1]); X[B+2]=EX(X[B+2]); X[B+3]=EX(X[B+3]); PIN(X); SBAR(); }while(0)
  #define VRD(i) do{ vlo[i]=vtr(vp_+(((i)>>2)*4096+((i)&3)*1024)); vhi[i]=vtr(vp_+(((i)>>2)*4096+((i)&3)*1024+512)); }while(0)
  #define KRD(G,j) do{ if(G){ kload2(kf,kp0+sl_next,j); SBAR(); } }while(0)
  #define STEP(C0,C1,P0,P1,t,GK,GV,GL) do{ SBAR(); \
    const lds_cptr vp_=vp0+sl_prev; \
    VRD(0); SBAR(); float sacc=(P0[0]+P0[1]); \
    GAPA(C0=__builtin_amdgcn_mfma_f32_32x32x16_bf16(kf[0],qr[0],negm,0,0,0), P0[2],P0[3],P0[4],P0[5],     pw0[0]=PKW(P0,0), pw0[1]=PKW(P0,2), pw0); \
    VRD(4); SBAR(); GAPA(C1=__builtin_amdgcn_mfma_f32_32x32x16_bf16(kf[1],qr[0],negm,0,0,0), P0[6],P0[7],P0[8],P0[9],     pw0[2]=PKW(P0,4), pw0[3]=PKW(P0,6), pw0); \
    VRD(1); SBAR(); GAPA(C0=__builtin_amdgcn_mfma_f32_32x32x16_bf16(kf[2],qr[1],C0,0,0,0),   P0[10],P0[11],P0[12],P0[13], pw1[0]=PKW(P0,8), pw1[1]=PKW(P0,10), pw1); \
    VRD(5); SBAR(); GAPA(C1=__builtin_amdgcn_mfma_f32_32x32x16_bf16(kf[3],qr[1],C1,0,0,0),   P0[14],P0[15],P1[0],P1[1],   pw1[2]=PKW(P0,12),pw1[3]=PKW(P0,14), pw1); \
    VRD(2); SBAR(); GAPA(C0=__builtin_amdgcn_mfma_f32_32x32x16_bf16(kf[4],qr[2],C0,0,0,0),   P1[2],P1[3],P1[4],P1[5],     pw2[0]=PKW(P1,0), pw2[1]=PKW(P1,2), pw2); \
    VRD(6); SBAR(); GAPA(C1=__builtin_amdgcn_mfma_f32_32x32x16_bf16(kf[5],qr[2],C1,0,0,0),   P1[6],P1[7],P1[8],P1[9],     pw2[2]=PKW(P1,4), pw2[3]=PKW(P1,6), pw2); \
    VRD(3); SBAR(); GAPA(C0=__builtin_amdgcn_mfma_f32_32x32x16_bf16(kf[6],qr[3],C0,0,0,0),   P1[10],P1[11],P1[12],P1[13], pw3[0]=PKW(P1,8), pw3[1]=PKW(P1,10), pw3); \
    VRD(7); SBAR(); GAPA(C1=__builtin_amdgcn_mfma_f32_32x32x16_bf16(kf[7],qr[3],C1,0,0,0),   P1[14],P1[15],0.f,0.f,       pw3[2]=PKW(P1,12),pw3[3]=PKW(P1,14), pw3); \
    l_reg+=sacc; \
    if(GK){DMA_K((t)+3,sl_cur);} if(GV){DMA_V((t)+1,sl_next);} \
    CMASK(C0,C1,t); \
    { float a=MX3(C0[0],C0[1],C1[0]),b=MX3(C0[2],C0[3],C1[1]); a=MX3(a,C1[2],C1[3]); \
      _Pragma("unroll") for(int r=4;r<16;r+=4){a=MX3(a,C0[r],C0[r+1]);b=MX3(b,C0[r+2],C0[r+3]);a=MX3(a,C1[r],C1[r+1]);b=MX3(b,C1[r+2],C1[r+3]);} \
      float rm=__builtin_fmaxf(a,b); { auto rr=__builtin_amdgcn_permlane32_swap(__float_as_uint(rm),__float_as_uint(rm),false,false); rm=__builtin_fmaxf(__uint_as_float(rr[0]),__uint_as_float(rr[1])); } \
      resc=false; \
      if(__builtin_expect(__any(rm>(float)THRL),0)){ const float dl=__builtin_fmaxf(rm,0.f); mhat+=dl; \
        _Pragma("unroll") for(int r=0;r<16;++r){C0[r]-=dl;C1[r]-=dl;} \
        _Pragma("unroll") for(int r=0;r<16;++r)negm[r]=-mhat; asm volatile("":"+v"(negm)); \
        const float f=__builtin_amdgcn_exp2f(-dl); l_reg*=f; if(hi==0)wsf[r32]=f; resc=true; } } \
    SBAR(); \
    GAPB(o[0]=__builtin_amdgcn_mfma_f32_32x32x16_bf16(PAF(0),VFR(0),o[0],0,0,0), C0,0); \
    GAPB(o[1]=__builtin_amdgcn_mfma_f32_32x32x16_bf16(PAF(0),VFR(4),o[1],0,0,0), C0,4); \
    KRD(GL,0); GAPB(o[0]=__builtin_amdgcn_mfma_f32_32x32x16_bf16(PAF(1),VFR(1),o[0],0,0,0), C0,8); \
    KRD(GL,1); GAPB(o[1]=__builtin_amdgcn_mfma_f32_32x32x16_bf16(PAF(1),VFR(5),o[1],0,0,0), C0,12); \
    KRD(GL,2); GAPB(o[0]=__builtin_amdgcn_mfma_f32_32x32x16_bf16(PAF(2),VFR(2),o[0],0,0,0), C1,0); \
    KRD(GL,3); GAPB(o[1]=__builtin_amdgcn_mfma_f32_32x32x16_bf16(PAF(2),VFR(6),o[1],0,0,0), C1,4); \
    GAPB(o[0]=__builtin_amdgcn_mfma_f32_32x32x16_bf16(PAF(3),VFR(3),o[0],0,0,0), C1,8); \
    GAPB(o[1]=__builtin_amdgcn_mfma_f32_32x32x16_bf16(PAF(3),VFR(7),o[1],0,0,0), C1,12); \
    }while(0)
  int t=1;
  #undef CMASK
  #define CMASK(P0,P1,t) do{}while(0)
  for(;t+5<NT;t+=2){
    STEP(pB0,pB1,pA0,pA1,t,true,true,true);     WAIT_BAR(2); RESC(); ROT();
    STEP(pA0,pA1,pB0,pB1,t+1,true,true,true);   WAIT_BAR(2); RESC(); ROT();
  }
  #undef CMASK
  #define CMASK(P0,P1,t) do{}while(0)
  #define ENDW(tt) do{ if((tt)+3<NT){WAIT_BAR(2);} else if((tt)+2<NT){WAIT_BAR(1);} else {WAIT_BAR(0);} }while(0)
  for(;t+1<NT;t+=2){
    STEP(pB0,pB1,pA0,pA1,t,(t+3<NT),(t+1<NT),(t+1<NT));       ENDW(t);   RESC(); ROT();
    STEP(pA0,pA1,pB0,pB1,t+1,(t+4<NT),(t+2<NT),(t+2<NT));     ENDW(t+1); RESC(); ROT();
  }
  STEP(pB0,pB1,pA0,pA1,NT-1,false,false,false); RESC();
  { float sacc=pB0[0]+pB0[1]; _Pragma("unroll") for(int r=2;r<16;++r)sacc+=pB0[r]; _Pragma("unroll") for(int r=0;r<16;++r)sacc+=pB1[r]; l_reg+=sacc;
    pw0=(u32x4){PKW(pB0,0),PKW(pB0,2),PKW(pB0,4),PKW(pB0,6)};pw1=(u32x4){PKW(pB0,8),PKW(pB0,10),PKW(pB0,12),PKW(pB0,14)};pw2=(u32x4){PKW(pB1,0),PKW(pB1,2),PKW(pB1,4),PKW(pB1,6)};pw3=(u32x4){PKW(pB1,8),PKW(pB1,10),PKW(pB1,12),PKW(pB1,14)};
    SBAR(); pv(o,vb0+sl_cur,PAF(0),PAF(1),PAF(2),PAF(3)); }
  #undef PKW
  #undef PAF
  #undef VFR
  #undef PIN
  #undef MX3
  #undef GAPA
  #undef GAPB
  #undef EX
  #undef VRD
  #undef KRD
  #undef STEP
  #undef ENDW
  {auto rr=__builtin_amdgcn_permlane32_swap(__float_as_uint(l_reg),__float_as_uint(l_reg),false,false);l_reg=__uint_as_float(rr[0])+__uint_as_float(rr[1]);}
  if(hi==0)wsf[32+r32]=l_reg;asm volatile("s_waitcnt lgkmcnt(0)":::"memory");
  float rli[16];
  #pragma unroll
  for(int r=0;r<16;++r)rli[r]=__builtin_amdgcn_rcpf(wsf[32+crow(r,hi)]);
  bf16*Ow=O+(rowbase+q0+wid*QBLK)*PO+h*D;
  { bf16*stg=(bf16*)(shm+LDS_OST)+wid*2048;
    #pragma unroll
    for(int r=0;r<16;++r){const int orow=crow(r,hi);
      #pragma unroll
      for(int d0=0;d0<2;++d0)stg[orow*64+d0*32+r32]=__float2bfloat16(o[d0][r]*rli[r]);}
    asm volatile("s_waitcnt lgkmcnt(0)":::"memory");
    #pragma unroll
    for(int i=0;i<4;++i){const int row=i*8+(lane>>3),ch=lane&7; const u32x4 v=*(const u32x4*)(stg+row*64+ch*8); ATTN_STORE16(Ow+(long)row*PO+ch*8,v);} }
  asm volatile("s_waitcnt lgkmcnt(0)\n\ts_barrier":::"memory");
  #undef DMA_K
  #undef DMA_V
  #undef CMASK
  #undef START
  #undef RESC
  #undef ROT
}
constexpr int ATTN_LDS_BYTES=LDS_BYTES;
struct AttnTensors { const bf16* Q; const bf16* K; const bf16* V; bf16* O; };
struct AttnUnit { int b; int h; int qb; };
struct StaticOrder {
  int vcu, G;
  __device__ __forceinline__ explicit StaticOrder(int grid,int block):vcu((grid%8==0)?(block%8)*(grid/8)+block/8:block),G(grid){}
  __device__ __forceinline__ bool next(int i,AttnUnit&u)const{ const int L=i*G+vcu; if(L>=BATCH*NHEAD*(SEQ/QB))return false; const int grp=L>>5,r=L&31; u.b=grp>>1; u.h=(grp&1)*4+(r>>3); u.qb=r&7; return true; }
  __device__ __forceinline__ void a_ready(const AttnUnit&)const{}
  __device__ __forceinline__ void done(const AttnUnit&)const{}
};
template<class Sched,int THRL=8> __device__ __forceinline__ void attn_phase(char*lds,const AttnTensors&T,const Sched&S){
  AttnUnit u;
  for(int i=0;S.next(i,u);++i){ S.a_ready(u); attn_unit<THRL>(u.b,u.h,u.qb,T.Q,T.K,T.V,T.O,lds); S.done(u); }
}
#undef SBAR
#undef WAIT_BAR
}


#define GAS __attribute__((address_space(1)))
#define LAS __attribute__((address_space(3)))
typedef unsigned short bf16;
typedef unsigned v4u __attribute__((ext_vector_type(4)));
typedef float f32x4 __attribute__((ext_vector_type(4)));
typedef short bf16x8 __attribute__((ext_vector_type(8)));
typedef GAS unsigned gu32;
typedef GAS unsigned long long gu64;
#define RLX_AGENT __ATOMIC_RELAXED, __HIP_MEMORY_SCOPE_AGENT
#define LDS_WAIT() asm volatile("s_waitcnt lgkmcnt(0)" ::: "memory")
#define VM_WAIT() asm volatile("s_waitcnt vmcnt(0)" ::: "memory")
__device__ __forceinline__ unsigned long long rt() { return __builtin_amdgcn_s_memrealtime(); }
__device__ __forceinline__ unsigned f2bf(float f) { unsigned u = __builtin_bit_cast(unsigned, f); return (u + 0x7fffu + ((u >> 16) & 1u)) >> 16; }
__device__ __forceinline__ unsigned pk2(float lo, float hi) { return f2bf(lo) | (f2bf(hi) << 16); }

#define XB_TMO      128
#define XB_XCNT(j)  (256  + 64 * (j))
#define XB_XSUB(j)  (1280 + 64 * (j))
#define XB_XGEN(j)  (2304 + 64 * (j))
#define XB_TOP      3328
#define XB_TOPGEN   3392
#define XCD_BAR_WORDS 3456
#define XB_SPIN_CAP (1u << 18)

__device__ __forceinline__ unsigned xb_ld(unsigned* p)              { return __hip_atomic_load(p, __ATOMIC_RELAXED, __HIP_MEMORY_SCOPE_AGENT); }
__device__ __forceinline__ unsigned xb_add(unsigned* p, unsigned v) { return __hip_atomic_fetch_add(p, v, __ATOMIC_RELAXED, __HIP_MEMORY_SCOPE_AGENT); }
__device__ __forceinline__ unsigned xb_xcc_id() { return (unsigned)__builtin_amdgcn_s_getreg((3 << 11) | 20) & 0xFu; }
#define XB_SPIN(cond, bar) do { unsigned _sp = 0; while (cond) { __builtin_amdgcn_s_sleep(1); \
    if ((++_sp & 255u) == 0u) { if (xb_ld(&(bar)[XB_TMO])) break; if (_sp > XB_SPIN_CAP) { atomicAdd(&(bar)[XB_TMO], 1u); break; } } } } while (0)

struct XcdBarrier {
    unsigned* bar; unsigned x;
    volatile LAS unsigned* st;
};

__device__ __forceinline__ XcdBarrier xcd_barrier_post(unsigned* bar, volatile LAS unsigned* st) {
    XcdBarrier b; b.bar = bar; b.x = xb_xcc_id(); b.st = st;
    if (threadIdx.x == 0) (void)xb_add(&bar[XB_XCNT(b.x)], 1u);
    return b;
}
__device__ __forceinline__ void xcd_barrier_complete(unsigned* bar, unsigned x, unsigned& nloc, unsigned& nx) {
    const unsigned G = gridDim.x * gridDim.y * gridDim.z;
    unsigned sum, cnt, mine, sp = 0u;
    for (;;) {
        sum = 0u; cnt = 0u; mine = 0u;
#pragma unroll
        for (unsigned j = 0; j < 16; ++j) { const unsigned c = xb_ld(&bar[XB_XCNT(j)]); sum += c; cnt += (c > 0u) ? 1u : 0u; mine = (j == x) ? c : mine; }
        if (sum == G) break;
        __builtin_amdgcn_s_sleep(1);
        if ((++sp & 255u) == 0u) { if (xb_ld(&bar[XB_TMO])) break; if (sp > XB_SPIN_CAP) { atomicAdd(&bar[XB_TMO], 1u); break; } }
    }
    nloc = mine > 0u ? mine : 1u; nx = cnt > 0u ? cnt : 1u;
}

__device__ __forceinline__ void xcd_barrier(const XcdBarrier& b) {
    asm volatile("s_waitcnt vmcnt(0)" ::: "memory");
    __syncthreads();
    if (threadIdx.x == 0) {
        unsigned* bar = b.bar;
        __builtin_amdgcn_s_waitcnt(0);
        unsigned nloc = b.st[0], nx = b.st[1];
        if (nloc == 0u) { xcd_barrier_complete(bar, b.x, nloc, nx); b.st[0] = nloc; b.st[1] = nx; }
        const unsigned old = xb_add(&bar[XB_XSUB(b.x)], 1u);
        const unsigned gen = old / nloc;
        if (old + 1u == (gen + 1u) * nloc) {
            __builtin_amdgcn_fence(__ATOMIC_RELEASE, "agent");
            asm volatile("s_waitcnt vmcnt(0)" ::: "memory");
            const unsigned og = xb_add(&bar[XB_TOP], 1u);
            const unsigned tg = og / nx;
            if (og + 1u == (tg + 1u) * nx) xb_add(&bar[XB_TOPGEN], 1u);
            else XB_SPIN(xb_ld(&bar[XB_TOPGEN]) == tg, bar);
            __builtin_amdgcn_fence(__ATOMIC_ACQUIRE, "agent");
            xb_add(&bar[XB_XGEN(b.x)], 1u);
            asm volatile("s_waitcnt vmcnt(0)" ::: "memory");
        } else {
            XB_SPIN(xb_ld(&bar[XB_XGEN(b.x)]) == gen, bar);
            __builtin_amdgcn_fence(__ATOMIC_ACQUIRE, "agent");
            asm volatile("s_waitcnt vmcnt(0)" ::: "memory");
        }
    }
    __syncthreads();
}

constexpr int NWAVES = 8, NTHR = 512;
constexpr int DM = 1024, NB = 8, SEQ = 2048, DEPTH = 4, M = NB * SEQ;
constexpr int DIN = 2320, NPROJ = 2304;
constexpr int C_Q = 0, C_K = 512, C_V = 640, C_LX = 768, C_LG = 1024, C_MQ = 1280, C_MK = 1536, C_MV = 1792, C_MO = 2048;
constexpr int NE = 16, CAP = 256, DE = 2048, NSLOT = NB * CAP;
constexpr float EPS = 1e-6f;
constexpr int NPH = 1 + 10 * DEPTH;

constexpr size_t MiB = 1u << 20;
constexpr size_t WS_CTL = 0, CTL_ZERO_BYTES = 1 * MiB;
constexpr size_t WS_ROPE = 1 * MiB;
constexpr size_t WS_LRUW = 2 * MiB;
constexpr size_t WS_WIN = 4 * MiB;
constexpr size_t WS_WOUT = 22 * MiB;
constexpr size_t WS_WGU = 32 * MiB;
constexpr size_t WS_WDN = 544 * MiB;
constexpr size_t WS_H = 800 * MiB;
constexpr size_t WS_PROJ = 832 * MiB;
constexpr size_t WS_Y = 904 * MiB;
constexpr size_t WS_MG = 936 * MiB;
constexpr size_t WS_AFF = 937 * MiB;
constexpr size_t WS_SEL = 938 * MiB;
constexpr size_t WS_IDX = 939 * MiB;
constexpr size_t WS_GATE = WS_IDX + 128 * 1024;
constexpr size_t WS_LH = 940 * MiB;
constexpr size_t WS_CP = 956 * MiB;
constexpr size_t WS_CARRY = 972 * MiB;
constexpr size_t WS_CLOC = 974 * MiB;
constexpr size_t WS_NLOC = 990 * MiB;
constexpr size_t WS_MLOC = WS_NLOC + 512 * 1024;
constexpr size_t WS_XG = 992 * MiB;
constexpr size_t WS_HID = 1056 * MiB;
constexpr size_t WS_YE = 1184 * MiB;
constexpr size_t WS_END = 1248 * MiB;
constexpr int CW_BAR = 4096;

constexpr int RING_OFF = 0, RING_BYTES = 143360;
constexpr int MISC_OFF = RING_BYTES;
constexpr int LDS_BYTES = 147456;

typedef unsigned u32x2 __attribute__((ext_vector_type(2)));
__device__ __forceinline__ float bf2f(unsigned short v) { return __uint_as_float(((unsigned)v) << 16); }
__device__ __forceinline__ float bflo(unsigned v) { return __uint_as_float(v << 16); }
__device__ __forceinline__ float bfhi(unsigned v) { return __uint_as_float(v & 0xffff0000u); }
__device__ __forceinline__ float wave_sum(float v) {
#pragma unroll
    for (int o = 1; o < 64; o <<= 1) v += __shfl_xor(v, o);
    return v;
}
__device__ __forceinline__ float wave_max(float v) {
#pragma unroll
    for (int o = 1; o < 64; o <<= 1) v = fmaxf(v, __shfl_xor(v, o));
    return v;
}
__device__ __forceinline__ float sigmoid_f(float x) { return 1.0f / (1.0f + expf(-x)); }
__device__ __forceinline__ float logsig_f(float x) { return fminf(x, 0.f) - log1pf(expf(-fabsf(x))); }
__device__ __forceinline__ float gelu_tanh_f(float x) { const float u = 0.7978845608028654f * (x + 0.044715f * x * x * x); return 0.5f * x * (1.0f + tanhf(u)); }
template <bool MAXOP, bool REV> __device__ __forceinline__ void wave_scan128(const LAS float* in, LAS float* out, int lane) {
    const int j0 = REV ? 127 - 2 * lane : 2 * lane, j1 = REV ? 126 - 2 * lane : 2 * lane + 1;
    const float a = in[j0], b = in[j1];
    const float s1 = MAXOP ? fmaxf(a, b) : a + b;
    float incl = s1;
#pragma unroll
    for (int o = 1; o < 64; o <<= 1) { const float t = __shfl_up(incl, o); if (lane >= o) incl = MAXOP ? fmaxf(incl, t) : incl + t; }
    const float ex = __shfl_up(incl, 1);
    const float e = (lane == 0) ? (MAXOP ? -INFINITY : 0.f) : ex;
    out[j0] = MAXOP ? fmaxf(e, a) : e + a; out[j1] = MAXOP ? fmaxf(e, s1) : e + s1;
}
#define WAVE_LDS_FENCE() asm volatile("s_waitcnt lgkmcnt(0)" ::: "memory")
#define MFMA16(a, b, c) __builtin_amdgcn_mfma_f32_16x16x32_bf16((a), (b), (c), 0, 0, 0)
#define WG_SYNC() __syncthreads()

struct Args { const float* in[22]; float* out; unsigned char* ws; int ph_lo, ph_hi, li, pad; };
enum { I_X = 0, I_N1G, I_WIN, I_QG, I_KG, I_CW, I_CB, I_WA, I_BA, I_WX, I_BX, I_LAM, I_FB, I_MNG, I_AOG, I_LOG, I_WOUT, I_N2G, I_WR, I_WG, I_WU, I_WD };

__device__ __forceinline__ void cvt_item(const float* __restrict__ src, int N, int k0, int n0, bf16* dst, int Kd, LAS float* scr, int lane) {
#pragma unroll 16
    for (int i = 0; i < 64; ++i) scr[i * 65 + lane] = src[(size_t)(k0 + i) * N + n0 + lane];
    LDS_WAIT(); asm volatile("" ::: "memory");
    const int c = lane >> 3, nn = lane & 7;
#pragma unroll
    for (int j = 0; j < 8; ++j) { const int n = nn + 8 * j; const LAS float* s = scr + (8 * c) * 65 + n;
        v4u o; o.x = pk2(s[0], s[65]); o.y = pk2(s[130], s[195]); o.z = pk2(s[260], s[325]); o.w = pk2(s[390], s[455]);
        *(GAS v4u*)(dst + (size_t)n * Kd + 8 * c) = o; }
    LDS_WAIT(); asm volatile("" ::: "memory");
}
__device__ __forceinline__ void p0_weights(const Args& a, LAS unsigned char* lds, int tid, int lane, int wave, int G, int bid) {
    unsigned char* ws = a.ws;
    LAS float* scr = (LAS float*)(lds + RING_OFF + wave * 16640);
    const int gw = bid * NWAVES + wave, NGW = G * NWAVES;
    constexpr int I_IN = 16 * 36, I_OUT = 16 * 16, I_EXP = 1536, PER_LAYER = I_IN + I_OUT + NE * I_EXP, NITEMS = DEPTH * PER_LAYER;
    for (int it = gw; it < NITEMS; it += NGW) {
        const int l = it / PER_LAYER; int r = it - l * PER_LAYER;
        if (r < I_IN) { const int kb = r / 36, nb = r - kb * 36;
            cvt_item(a.in[I_WIN] + (size_t)l * DM * DIN, DIN, 64 * kb, 64 * nb, (bf16*)(ws + WS_WIN) + ((size_t)l * NPROJ + 64 * nb) * DM + 64 * kb, DM, scr, lane); continue; }
        r -= I_IN;
        if (r < I_OUT) { const int kb = r >> 4, nb = r & 15;
            cvt_item(a.in[I_WOUT] + (size_t)l * DM * DM, DM, 64 * kb, 64 * nb, (bf16*)(ws + WS_WOUT) + ((size_t)l * DM + 64 * nb) * DM + 64 * kb, DM, scr, lane); continue; }
        r -= I_OUT;
        const int e = r / I_EXP; int r2 = r - e * I_EXP; const size_t le = (size_t)l * NE + e;
        if (r2 < 1024) { const int up = r2 >> 9; r2 &= 511; const int kb = r2 >> 5, nb = r2 & 31, n0 = 64 * nb, drow = 256 * (n0 >> 7) + (n0 & 127) + 128 * up;
            cvt_item(a.in[up ? I_WU : I_WG] + le * DM * DE, DE, 64 * kb, n0, (bf16*)(ws + WS_WGU) + (le * 4096 + drow) * DM + 64 * kb, DM, scr, lane); continue; }
        r2 -= 1024; { const int kb = r2 >> 4, nb = r2 & 15;
            cvt_item(a.in[I_WD] + le * DE * DM, DM, 64 * kb, 64 * nb, (bf16*)(ws + WS_WDN) + (le * DM + 64 * nb) * DE + 64 * kb, DE, scr, lane); }
    }
    const int gt = bid * NTHR + tid, GT = G * NTHR;
    bf16* lw = (bf16*)(ws + WS_LRUW);
    for (int i = gt; i < DEPTH * 2 * 2 * 4 * 4096; i += GT) { const int d = i & 63, e = (i >> 6) & 63, n = (i >> 12) & 3, gate = (i >> 14) & 1, dir = (i >> 15) & 1, l = i >> 16;
        const float* src = a.in[gate ? I_WX : I_WA]; lw[i] = (bf16)f2bf(src[((((size_t)l * 2 + dir) * 4 + n) * 64 + d) * 64 + e]); }
    float* rc = (float*)(ws + WS_ROPE); float* rs = rc + SEQ * 32;
    for (int i = gt; i < SEQ * 32; i += GT) { const int s = i >> 5, j = i & 31, f = j & 15; const float pos = (float)((j < 16) ? (s >> 6) : (s & 63));
        const float inv = 1.0f / powf(10000.0f, (float)f * (1.0f / 16.0f)); const float ang = pos * inv; rc[i] = cosf(ang); rs[i] = sinf(ang); }
}

template <int MODE>
__device__ __forceinline__ void row_pass(const float* xin, float* xout, const float* gain, const float* WT  , int sk, bf16* H, float* O16, const int* SEL, const bf16* YE,
                                         LAS unsigned char* lds, int tid, int lane, int wave, int G, int bid) {
    constexpr int WLS = 1028;
    LAS float* wl = (LAS float*)(lds + RING_OFF);
    if (MODE != 3) { for (int i = tid; i < 16 * DM; i += NTHR) { const int k = i >> 4, jj = i & 15; wl[jj * WLS + k] = WT[(size_t)k * sk + jj]; } }
    WG_SYNC();
    const int gw = bid * NWAVES + wave, NGW = G * NWAVES;
    for (int m0 = 2 * gw; m0 < M; m0 += 2 * NGW) {
        asm volatile("" ::: "memory");
        f32x4 v[2][4];
#pragma unroll
        for (int r = 0; r < 2; ++r)
#pragma unroll
            for (int j = 0; j < 4; ++j) v[r][j] = *((const f32x4*)(xin + (size_t)(m0 + r) * DM) + 64 * j + lane);
        if (MODE >= 2) {
            const int b = m0 >> 11; int selv[2]; unsigned long long mk[2];
#pragma unroll
            for (int r = 0; r < 2; ++r) { selv[r] = (lane < NE) ? SEL[(size_t)(m0 + r) * NE + lane] : -1; }
#pragma unroll
            for (int r = 0; r < 2; ++r) mk[r] = __ballot(selv[r] >= 0);
            while (mk[0] | mk[1]) {
                u32x2 q[2][2][4]; float wt[2][2];
#pragma unroll
                for (int r = 0; r < 2; ++r)
#pragma unroll
                    for (int i = 0; i < 2; ++i) { const bf16* yr = YE; wt[r][i] = 0.f;
                        if (mk[r]) { const int e = __builtin_ctzll(mk[r]); mk[r] &= mk[r] - 1ull; const int sl = __builtin_amdgcn_readlane(selv[r], e);
                            yr = YE + ((size_t)e * NSLOT + b * CAP + sl) * DM; wt[r][i] = 1.f; }
#pragma unroll
                        for (int j = 0; j < 4; ++j) q[r][i][j] = *((const u32x2*)yr + 64 * j + lane); }
#pragma unroll
                for (int r = 0; r < 2; ++r)
#pragma unroll
                    for (int i = 0; i < 2; ++i)
#pragma unroll
                        for (int j = 0; j < 4; ++j) { const u32x2 w = q[r][i][j]; const float t = wt[r][i];
                            v[r][j][0] += t * bflo(w.x); v[r][j][1] += t * bfhi(w.x); v[r][j][2] += t * bflo(w.y); v[r][j][3] += t * bfhi(w.y); }
            }
#pragma unroll
            for (int r = 0; r < 2; ++r)
#pragma unroll
                for (int j = 0; j < 4; ++j) *((f32x4*)(xout + (size_t)(m0 + r) * DM) + 64 * j + lane) = v[r][j];
        }
        if (MODE == 3) continue;
        float ss[2];
#pragma unroll
        for (int r = 0; r < 2; ++r) { float a = 0.f;
#pragma unroll
            for (int j = 0; j < 4; ++j) a += (v[r][j][0] * v[r][j][0] + v[r][j][1] * v[r][j][1]) + (v[r][j][2] * v[r][j][2] + v[r][j][3] * v[r][j][3]);
            ss[r] = a; }
#pragma unroll
        for (int o = 1; o < 64; o <<= 1) { ss[0] += __shfl_xor(ss[0], o); ss[1] += __shfl_xor(ss[1], o); }
#pragma unroll
        for (int r = 0; r < 2; ++r) { const float rstd = 1.0f / sqrtf(ss[r] * (1.0f / DM) + EPS);
#pragma unroll
            for (int j = 0; j < 4; ++j) { const f32x4 gq = *((const f32x4*)gain + 64 * j + lane); v[r][j] = v[r][j] * rstd * gq;
                u32x2 o; o.x = pk2(v[r][j][0], v[r][j][1]); o.y = pk2(v[r][j][2], v[r][j][3]); *((u32x2*)(H + (size_t)(m0 + r) * DM) + 64 * j + lane) = o; } }
        float p[2][16];
#pragma unroll
        for (int jj = 0; jj < 16; ++jj) { float a0 = 0.f, a1 = 0.f;
#pragma unroll
            for (int j = 0; j < 4; ++j) { const f32x4 w = *((LAS f32x4*)(wl + jj * WLS) + 64 * j + lane);
                a0 += (v[0][j][0] * w[0] + v[0][j][1] * w[1]) + (v[0][j][2] * w[2] + v[0][j][3] * w[3]);
                a1 += (v[1][j][0] * w[0] + v[1][j][1] * w[1]) + (v[1][j][2] * w[2] + v[1][j][3] * w[3]); }
            p[0][jj] = a0; p[1][jj] = a1; }
#pragma unroll
        for (int o = 1; o < 64; o <<= 1)
#pragma unroll
            for (int jj = 0; jj < 16; ++jj) { p[0][jj] += __shfl_xor(p[0][jj], o); p[1][jj] += __shfl_xor(p[1][jj], o); }
#pragma unroll
        for (int r = 0; r < 2; ++r) { const int m = m0 + r;
            if (MODE == 1) {
                float mx = p[r][0];
#pragma unroll
                for (int jj = 1; jj < 16; ++jj) mx = fmaxf(mx, p[r][jj]);
                float sum = 0.f;
#pragma unroll
                for (int jj = 0; jj < 16; ++jj) { p[r][jj] = expf(p[r][jj] - mx); sum += p[r][jj]; }
                float mine = 0.f;
#pragma unroll
                for (int jj = 0; jj < 16; ++jj) mine = (lane == jj) ? p[r][jj] : mine;
                if (lane < 16) O16[(((size_t)(m >> 11) * NE + lane) << 11) + (m & 2047)] = mine / sum;
            } else {
                float mine = 0.f;
#pragma unroll
                for (int jj = 0; jj < 16; ++jj) mine = (lane == jj) ? p[r][jj] : mine;
                if (lane < 16) O16[(size_t)m * 16 + lane] = mine;
            } }
    }
}

__device__ __forceinline__ void rope_pass(const Args& a, int l, int lane, int wave, int G, int bid) {
    bf16* PROJ = (bf16*)(a.ws + WS_PROJ); const float* rc = (const float*)(a.ws + WS_ROPE); const float* rs = rc + SEQ * 32;
    const float* qg = a.in[I_QG] + l * 64; const float* kg = a.in[I_KG] + l * 64;
    const int gw = bid * NWAVES + wave, NGW = G * NWAVES, j = lane & 31;
    const float qg1 = qg[j], qg2 = qg[32 + j], kg1 = kg[j], kg2 = kg[32 + j];
    for (int mb = 2 * gw; mb < M; mb += 2 * NGW) {
        float x1[2][5], x2[2][5], cs[2], sn[2];
#pragma unroll
        for (int r = 0; r < 2; ++r) { const bf16* row = PROJ + (size_t)(mb + r) * NPROJ; const int s = (mb + r) & 2047; cs[r] = rc[s * 32 + j]; sn[r] = rs[s * 32 + j];
#pragma unroll
            for (int it = 0; it < 5; ++it) { const int hh = 2 * it + (lane >> 5); x1[r][it] = bf2f(row[hh * 64 + j]); x2[r][it] = bf2f(row[hh * 64 + 32 + j]); } }
#pragma unroll
        for (int r = 0; r < 2; ++r) { bf16* row = PROJ + (size_t)(mb + r) * NPROJ;
#pragma unroll
            for (int it = 0; it < 5; ++it) { const int hh = 2 * it + (lane >> 5);
                float ss = x1[r][it] * x1[r][it] + x2[r][it] * x2[r][it];
#pragma unroll
                for (int o = 1; o < 32; o <<= 1) ss += __shfl_xor(ss, o);
                const float rstd = 1.0f / sqrtf(ss * (1.0f / 64.0f) + EPS);
                const float n1 = x1[r][it] * rstd * (it < 4 ? qg1 : kg1), n2 = x2[r][it] * rstd * (it < 4 ? qg2 : kg2);
                float o1 = n1 * cs[r] - n2 * sn[r], o2 = n2 * cs[r] + n1 * sn[r];
                if (it < 4) { o1 *= attn_body::C2; o2 *= attn_body::C2; }
                row[hh * 64 + j] = (bf16)f2bf(o1); row[hh * 64 + 32 + j] = (bf16)f2bf(o2); } }
    }
}

constexpr int XS = 260;
__device__ __forceinline__ void lru_a_unit(const Args& a, int l, int unit, LAS unsigned char* lds, int tid, int lane, int wave) {
    const int b = unit >> 6, c32 = unit & 63, t0 = c32 * 32; const size_t m0 = (size_t)b * SEQ + t0;
    LAS float* XC = (LAS float*)(lds + RING_OFF); LAS float* AA = XC + 32 * XS; LAS float* UU = AA + 32 * XS;
    const bf16* PROJ = (const bf16*)(a.ws + WS_PROJ);
    {
        const int ch2 = tid & 127, rg = tid >> 7, ch = 2 * ch2;
        float x0[11], x1[11];
#pragma unroll
        for (int i = 0; i < 11; ++i) { const int s = t0 + rg * 8 - 2 + i; unsigned v = 0u;
            if (s >= 0 && s < SEQ) v = *(const unsigned*)(PROJ + ((size_t)b * SEQ + s) * NPROJ + C_LX + ch);
            x0[i] = bflo(v); x1[i] = bfhi(v); }
        const float* cw = a.in[I_CW] + (size_t)l * 4 * 256; const float* cb = a.in[I_CB] + (size_t)l * 256;
        float w0[4], w1[4];
#pragma unroll
        for (int j = 0; j < 4; ++j) { w0[j] = cw[j * 256 + ch]; w1[j] = cw[j * 256 + ch + 1]; }
        const float b0 = cb[ch], b1 = cb[ch + 1];
#pragma unroll
        for (int r = 0; r < 8; ++r) { float y0 = b0, y1 = b1;
#pragma unroll
            for (int j = 0; j < 4; ++j) { y0 += x0[r + j] * w0[j]; y1 += x1[r + j] * w1[j]; }
            XC[(rg * 8 + r) * XS + ch] = y0; XC[(rg * 8 + r) * XS + ch + 1] = y1; }
    }
    WG_SYNC();
    const int n = wave >> 1, hh = wave & 1, li = lane & 15, g = lane >> 4;
    bf16* LH = (bf16*)(a.ws + WS_LH); bf16* CPb = (bf16*)(a.ws + WS_CP); float* CARRY = (float*)(a.ws + WS_CARRY);
    for (int dir = 0; dir < 2; ++dir) {
        {
            f32x4 accA[2][2], accX[2][2];
#pragma unroll
            for (int i = 0; i < 2; ++i)
#pragma unroll
                for (int j = 0; j < 2; ++j) { accA[i][j] = (f32x4){0.f, 0.f, 0.f, 0.f}; accX[i][j] = (f32x4){0.f, 0.f, 0.f, 0.f}; }
            const bf16* WA = (const bf16*)(a.ws + WS_LRUW) + ((((size_t)l * 2 + dir) * 2 + 0) * 4 + n) * 4096;
            const bf16* WX = (const bf16*)(a.ws + WS_LRUW) + ((((size_t)l * 2 + dir) * 2 + 1) * 4 + n) * 4096;
#pragma unroll
            for (int ks = 0; ks < 2; ++ks) {
                bf16x8 af[2];
#pragma unroll
                for (int mt = 0; mt < 2; ++mt) { const LAS float* p = XC + (16 * mt + li) * XS + 64 * n + 32 * ks + 8 * g;
                    const f32x4 q0 = *(const LAS f32x4*)p, q1 = *(const LAS f32x4*)(p + 4);
                    v4u pk; pk.x = pk2(q0[0], q0[1]); pk.y = pk2(q0[2], q0[3]); pk.z = pk2(q1[0], q1[1]); pk.w = pk2(q1[2], q1[3]); af[mt] = __builtin_bit_cast(bf16x8, pk); }
#pragma unroll
                for (int nt = 0; nt < 2; ++nt) { const int ep = 32 * hh + 16 * nt + li;
                    const bf16x8 ba = *(const bf16x8*)(WA + ep * 64 + 32 * ks + 8 * g), bx = *(const bf16x8*)(WX + ep * 64 + 32 * ks + 8 * g);
#pragma unroll
                    for (int mt = 0; mt < 2; ++mt) { accA[mt][nt] = MFMA16(af[mt], ba, accA[mt][nt]); accX[mt][nt] = MFMA16(af[mt], bx, accX[mt][nt]); } }
            }
#pragma unroll
            for (int nt = 0; nt < 2; ++nt) { const int ch = 64 * n + 32 * hh + 16 * nt + li; const size_t pi = ((size_t)l * 2 + dir) * 256 + ch;
                const float bav = a.in[I_BA][pi], bxv = a.in[I_BX][pi], lam = a.in[I_LAM][pi];
                const float sp = fmaxf(-lam, 0.f) + log1pf(expf(-fabsf(lam)));
#pragma unroll
                for (int mt = 0; mt < 2; ++mt)
#pragma unroll
                    for (int r = 0; r < 4; ++r) { const int t = 16 * mt + 4 * g + r;
                        const float rg_ = sigmoid_f(accA[mt][nt][r] + bav), ig_ = sigmoid_f(accX[mt][nt][r] + bxv);
                        const float la = -8.0f * rg_ * sp; const float av = expf(la);
                        const float uv = sqrtf(-expm1f(2.0f * la)) * (ig_ * XC[t * XS + ch]);
                        AA[t * XS + ch] = av; UU[t * XS + ch] = uv; } }
        }
        WG_SYNC();
        if (tid < 256) { const int ch = tid; float h = 0.f, cp = 1.f;
            bf16* lh = LH + ((size_t)dir * M + m0) * 256 + ch; bf16* cpo = CPb + ((size_t)dir * M + m0) * 256 + ch;
            for (int q = 0; q < 32; ++q) { const int t = dir ? 31 - q : q; const float av = AA[t * XS + ch], uv = UU[t * XS + ch];
                h = av * h + uv; cp *= av; lh[(size_t)t * 256] = (bf16)f2bf(h); cpo[(size_t)t * 256] = (bf16)f2bf(cp); }
            float* cr = CARRY + ((((size_t)dir * NB + b) * 64 + c32) * 2) * 256 + ch; cr[0] = cp; cr[256] = h; }
        WG_SYNC();
    }
}

__device__ __forceinline__ void lru_b_unit(const Args& a, int l, int unit, LAS unsigned char* lds, int tid, int lane, int wave) {
    const int b = unit >> 6, c32 = unit & 63; const size_t m0 = (size_t)b * SEQ + c32 * 32;
    LAS float* CIN = (LAS float*)(lds + RING_OFF);
    const float* CARRY = (const float*)(a.ws + WS_CARRY);
    { const int dir = tid >> 8, ch = tid & 255; const float* cr = CARRY + (((size_t)dir * NB + b) * 64) * 512 + ch; float cin = 0.f;
      const int n = dir ? 63 - c32 : c32;
      for (int base = 0; base < n; base += 16) { float P[16], Hh[16];
#pragma unroll
          for (int i = 0; i < 16; ++i) { const int q = base + i; const bool v = q < n; const int k = v ? (dir ? 63 - q : q) : c32;
              const float p = cr[(size_t)k * 512], h = cr[(size_t)k * 512 + 256]; P[i] = v ? p : 1.f; Hh[i] = v ? h : 0.f; }
#pragma unroll
          for (int i = 0; i < 16; ++i) cin = P[i] * cin + Hh[i]; }
      CIN[tid] = cin; }
    WG_SYNC();
    const bf16* LH = (const bf16*)(a.ws + WS_LH); const bf16* CPb = (const bf16*)(a.ws + WS_CP); const bf16* PROJ = (const bf16*)(a.ws + WS_PROJ); bf16* Y = (bf16*)(a.ws + WS_Y);
    const f32x4 cf = *(const LAS f32x4*)(CIN + 4 * lane), cb = *(const LAS f32x4*)(CIN + 256 + 4 * lane);
    const f32x4 og = *(const f32x4*)(a.in[I_LOG] + (size_t)l * 256 + 4 * lane);
#pragma unroll
    for (int q = 0; q < 4; ++q) { const size_t m = m0 + wave * 4 + q;
        const u32x2 lf = *(const u32x2*)(LH + m * 256 + 4 * lane), pf = *(const u32x2*)(CPb + m * 256 + 4 * lane);
        const u32x2 lb = *(const u32x2*)(LH + ((size_t)M + m) * 256 + 4 * lane), pb = *(const u32x2*)(CPb + ((size_t)M + m) * 256 + 4 * lane);
        const u32x2 gt = *(const u32x2*)(PROJ + m * NPROJ + C_LG + 4 * lane);
        f32x4 h;
        h[0] = (bflo(lf.x) + bflo(pf.x) * cf[0]) + (bflo(lb.x) + bflo(pb.x) * cb[0]);
        h[1] = (bfhi(lf.x) + bfhi(pf.x) * cf[1]) + (bfhi(lb.x) + bfhi(pb.x) * cb[1]);
        h[2] = (bflo(lf.y) + bflo(pf.y) * cf[2]) + (bflo(lb.y) + bflo(pb.y) * cb[2]);
        h[3] = (bfhi(lf.y) + bfhi(pf.y) * cf[3]) + (bfhi(lb.y) + bfhi(pb.y) * cb[3]);
        h[0] *= gelu_tanh_f(bflo(gt.x)); h[1] *= gelu_tanh_f(bfhi(gt.x)); h[2] *= gelu_tanh_f(bflo(gt.y)); h[3] *= gelu_tanh_f(bfhi(gt.y));
        const float ss = wave_sum((h[0] * h[0] + h[1] * h[1]) + (h[2] * h[2] + h[3] * h[3]));
        const float rstd = 1.0f / sqrtf(ss * (1.0f / 256.0f) + EPS);
        u32x2 o; o.x = pk2(h[0] * rstd * og[0], h[1] * rstd * og[1]); o.y = pk2(h[2] * rstd * og[2], h[3] * rstd * og[3]);
        *(u32x2*)(Y + m * DM + 512 + 4 * lane) = o; }
    WG_SYNC();
}

__device__ __forceinline__ void mls_gates(const Args& a, int l, size_t m0, int hd, LAS float* GL, int tid) {
    if (tid < 128) { const float* r = (const float*)(a.ws + WS_MG) + (m0 + tid) * 16; const float* fb = a.in[I_FB] + (size_t)l * 8;
        GL[tid] = logsig_f(r[4 + hd] + fb[hd]); GL[128 + tid] = logsig_f(r[12 + hd] + fb[4 + hd]); GL[256 + tid] = r[hd]; GL[384 + tid] = r[8 + hd]; }
    WG_SYNC();
    if (tid < 64) wave_scan128<false, false>(GL, GL + 512, tid);
    else if (tid < 128) wave_scan128<false, true>(GL + 128, GL + 640, tid - 64);
    WG_SYNC();
}
constexpr int TS = 136;
constexpr int QS_ = 72;

__device__ __forceinline__ void mls_a_unit(const Args& a, int l, int unit, LAS unsigned char* lds, int tid, int lane, int wave) {
    const int c = unit & 15, hd = (unit >> 4) & 3, b = unit >> 6; const size_t m0 = (size_t)b * SEQ + c * 128;
    LAS float* GL = (LAS float*)(lds + RING_OFF);
    LAS float* WW = GL + 768;
    LAS bf16* VT = (LAS bf16*)(lds + RING_OFF + 4096); LAS bf16* KF = VT + 64 * TS; LAS bf16* KB = KF + 64 * TS;
    mls_gates(a, l, m0, hd, GL, tid);
    float* MLOC = (float*)(a.ws + WS_MLOC); float* NLOC = (float*)(a.ws + WS_NLOC); float* CLOC = (float*)(a.ws + WS_CLOC);
    const size_t sbase = ((size_t)b * 4 + hd) * 2;
    if (wave < 2) { const int dir = wave; const float gtot = dir ? GL[640] : GL[512 + 127]; const LAS float* Bc = GL + 512 + 128 * dir; const LAS float* IG = GL + 256 + 128 * dir;
        const float lw0 = gtot - Bc[lane] + IG[lane], lw1 = gtot - Bc[lane + 64] + IG[lane + 64];
        const float mx = wave_max(fmaxf(lw0, lw1));
        WW[dir * 128 + lane] = expf(lw0 - mx); WW[dir * 128 + lane + 64] = expf(lw1 - mx);
        if (lane == 0) { float* o = MLOC + ((sbase + dir) * 16 + c) * 2; o[0] = mx; o[1] = gtot; } }
    WG_SYNC();
    { const int j = tid & 127, part = tid >> 7; const bf16* PROJ = (const bf16*)(a.ws + WS_PROJ);
      const bf16* kp = PROJ + (m0 + j) * NPROJ + C_MK + hd * 64 + 16 * part; const bf16* vp = PROJ + (m0 + j) * NPROJ + C_MV + hd * 64 + 16 * part;
      const v4u k0 = *(const v4u*)kp, k1 = *(const v4u*)(kp + 8), v0 = *(const v4u*)vp, v1 = *(const v4u*)(vp + 8);
      const float wf = WW[j] * 0.125f, wb = WW[128 + j] * 0.125f;
      const unsigned kk[8] = {k0.x, k0.y, k0.z, k0.w, k1.x, k1.y, k1.z, k1.w}; const unsigned vv[8] = {v0.x, v0.y, v0.z, v0.w, v1.x, v1.y, v1.z, v1.w};
#pragma unroll
      for (int q = 0; q < 8; ++q) { const int e0 = 16 * part + 2 * q; const float ka = bflo(kk[q]), kb = bfhi(kk[q]);
          KF[e0 * TS + j] = (bf16)f2bf(ka * wf); KF[(e0 + 1) * TS + j] = (bf16)f2bf(kb * wf);
          KB[e0 * TS + j] = (bf16)f2bf(ka * wb); KB[(e0 + 1) * TS + j] = (bf16)f2bf(kb * wb);
          VT[e0 * TS + j] = (bf16)(vv[q] & 0xffffu); VT[(e0 + 1) * TS + j] = (bf16)(vv[q] >> 16); } }
    WG_SYNC();
    if (tid < 128) { const int dir = tid >> 6, e = tid & 63; const LAS bf16* kr = (dir ? KB : KF) + e * TS; float s = 0.f;
#pragma unroll
        for (int q = 0; q < 16; ++q) { const v4u w = *(const LAS v4u*)(kr + 8 * q); s += ((bflo(w.x) + bfhi(w.x)) + (bflo(w.y) + bfhi(w.y))) + ((bflo(w.z) + bfhi(w.z)) + (bflo(w.w) + bfhi(w.w))); }
        NLOC[((sbase + dir) * 16 + c) * 64 + e] = s; }
    { const int dir = wave >> 2, mt = wave & 3, li = lane & 15, g = lane >> 4; const LAS bf16* KD = dir ? KB : KF;
      f32x4 acc[4];
#pragma unroll
      for (int nt = 0; nt < 4; ++nt) acc[nt] = (f32x4){0.f, 0.f, 0.f, 0.f};
#pragma unroll
      for (int ks = 0; ks < 4; ++ks) { const bf16x8 af = *(const LAS bf16x8*)(VT + (16 * mt + li) * TS + 32 * ks + 8 * g);
#pragma unroll
          for (int nt = 0; nt < 4; ++nt) { const bf16x8 bfv = *(const LAS bf16x8*)(KD + (16 * nt + li) * TS + 32 * ks + 8 * g); acc[nt] = MFMA16(af, bfv, acc[nt]); } }
      float* co = CLOC + ((sbase + dir) * 16 + c) * 4096;
#pragma unroll
      for (int nt = 0; nt < 4; ++nt)
#pragma unroll
          for (int r = 0; r < 4; ++r) co[(16 * mt + 4 * g + r) * 64 + 16 * nt + li] = acc[nt][r]; }
    WG_SYNC();
}

template <int DIR>
__device__ __forceinline__ void mls_dir(f32x4 (&hacc)[4], const LAS bf16* QS, const LAS bf16* KS, const LAS bf16* VT, const LAS bf16* CP, const LAS float* AJ, const LAS float* MM,
                                        const LAS float* INTER, const LAS float* FLOOR, const LAS float* NP, LAS float* rowbuf, int w, int lane) {
    const int li = lane & 15, g = lane >> 4, i = 16 * w + li;
    bf16x8 qf[2];
#pragma unroll
    for (int ks = 0; ks < 2; ++ks) qf[ks] = *(const LAS bf16x8*)(QS + i * QS_ + 32 * ks + 8 * g);
    const float mmi = MM[i];
    float den = 0.f;
    f32x4 out[4];
#pragma unroll
    for (int dt = 0; dt < 4; ++dt) out[dt] = (f32x4){0.f, 0.f, 0.f, 0.f};
#pragma unroll
    for (int kp = 0; kp < 4; ++kp) {
        const bool need = (DIR == 0) ? (2 * kp <= w) : (2 * kp + 1 >= w);
        if (need) {
            f32x4 s0 = (f32x4){0.f, 0.f, 0.f, 0.f}, s1 = (f32x4){0.f, 0.f, 0.f, 0.f};
#pragma unroll
            for (int ks = 0; ks < 2; ++ks) { const bf16x8 k0 = *(const LAS bf16x8*)(KS + (32 * kp + li) * QS_ + 32 * ks + 8 * g), k1 = *(const LAS bf16x8*)(KS + (32 * kp + 16 + li) * QS_ + 32 * ks + 8 * g);
                s0 = MFMA16(k0, qf[ks], s0); s1 = MFMA16(k1, qf[ks], s1); }
            float p[8];
#pragma unroll
            for (int r = 0; r < 4; ++r) { const int j0 = 32 * kp + 4 * g + r, j1 = j0 + 16;
                const bool v0 = (DIR == 0) ? (j0 <= i) : (j0 >= i), v1 = (DIR == 0) ? (j1 <= i) : (j1 >= i);
                const float a0 = v0 ? (AJ[j0] - mmi) : -INFINITY, a1 = v1 ? (AJ[j1] - mmi) : -INFINITY;
                p[r] = s0[r] * 0.125f * expf(a0); p[4 + r] = s1[r] * 0.125f * expf(a1); den += p[r] + p[4 + r]; }
            v4u pk; pk.x = pk2(p[0], p[1]); pk.y = pk2(p[2], p[3]); pk.z = pk2(p[4], p[5]); pk.w = pk2(p[6], p[7]);
            const bf16x8 pf = __builtin_bit_cast(bf16x8, pk);
#pragma unroll
            for (int dt = 0; dt < 4; ++dt) { const LAS bf16* vr = VT + (16 * dt + li) * TS + 32 * kp + 4 * g;
                const u32x2 lo = *(const LAS u32x2*)vr, hi = *(const LAS u32x2*)(vr + 16);
                v4u vk; vk.x = lo.x; vk.y = lo.y; vk.z = hi.x; vk.w = hi.y;
                out[dt] = MFMA16(pf, __builtin_bit_cast(bf16x8, vk), out[dt]); }
        }
    }
    f32x4 qc[4];
#pragma unroll
    for (int dt = 0; dt < 4; ++dt) { qc[dt] = (f32x4){0.f, 0.f, 0.f, 0.f};
#pragma unroll
        for (int ks = 0; ks < 2; ++ks) { const bf16x8 cf = *(const LAS bf16x8*)(CP + (16 * dt + li) * QS_ + 32 * ks + 8 * g); qc[dt] = MFMA16(qf[ks], cf, qc[dt]); } }
    float nq = 0.f;
#pragma unroll
    for (int q = 0; q < 16; ++q) nq += NP[16 * g + q] * bf2f(QS[i * QS_ + 16 * g + q]);
    den += __shfl_xor(den, 16); den += __shfl_xor(den, 32); nq += __shfl_xor(nq, 16); nq += __shfl_xor(nq, 32);
    const float inter = INTER[i]; const float dn = fmaxf(fabsf(den + inter * nq), FLOOR[i]);
    asm volatile("s_waitcnt lgkmcnt(0)" ::: "memory");
    if (g == 0) { rowbuf[li] = inter; rowbuf[16 + li] = 1.0f / dn; }
    asm volatile("s_waitcnt lgkmcnt(0)" ::: "memory");
#pragma unroll
    for (int r = 0; r < 4; ++r) { const float it = rowbuf[4 * g + r], inv = rowbuf[16 + 4 * g + r];
#pragma unroll
        for (int dt = 0; dt < 4; ++dt) hacc[dt][r] += (out[dt][r] + it * qc[dt][r]) * inv; }
    asm volatile("s_waitcnt lgkmcnt(0)" ::: "memory");
}
__device__ __forceinline__ void mls_b_unit(const Args& a, int l, int unit, LAS unsigned char* lds, int tid, int lane, int wave) {
    const int c = unit & 15, hd = (unit >> 4) & 3, b = unit >> 6; const size_t m0 = (size_t)b * SEQ + c * 128;
    LAS float* GL = (LAS float*)(lds + RING_OFF);
    LAS float* AJ = GL + 768;
    LAS float* MMx = AJ + 256;
    LAS float* INT_ = MMx + 256;
    LAS float* FLR = INT_ + 256;
    LAS float* NP = FLR + 256;
    LAS float* COEF = NP + 128;
    LAS float* ROWB = COEF + 32;
    LAS bf16* QS = (LAS bf16*)(lds + RING_OFF + 16384); LAS bf16* KS = QS + 128 * QS_; LAS bf16* VT = KS + 128 * QS_; LAS bf16* CF = VT + 64 * TS; LAS bf16* CB = CF + 64 * QS_;
    mls_gates(a, l, m0, hd, GL, tid);
    const float* MLOC = (const float*)(a.ws + WS_MLOC); const float* NLOC = (const float*)(a.ws + WS_NLOC); const float* CLOC = (const float*)(a.ws + WS_CLOC);
    const size_t sbase = ((size_t)b * 4 + hd) * 2;
    if (wave < 2) {
        const int dir = wave; LAS float* SM = ROWB;
        if (lane < 32) SM[dir * 32 + lane] = MLOC[(sbase + dir) * 32 + lane];
        WAVE_LDS_FENCE();
        const LAS float* sm = SM + dir * 32;
        float m = 0.f;
        if (dir == 0) { for (int k = 0; k < c; ++k) m = fmaxf(sm[2 * k + 1] + m, sm[2 * k]); }
        else { for (int k = 15; k > c; --k) m = fmaxf(sm[2 * k + 1] + m, sm[2 * k]); }
        if (lane < 16) { float gs = 0.f;
            if (dir == 0) { for (int i = lane + 1; i < c; ++i) gs += sm[2 * i + 1]; } else { for (int i = c + 1; i < lane; ++i) gs += sm[2 * i + 1]; }
            const bool valid = dir == 0 ? (lane < c) : (lane > c);
            COEF[16 * dir + lane] = valid ? expf(sm[2 * lane] + gs - m) : 0.f; }
        const LAS float* IG = GL + 256 + 128 * dir; const LAS float* Bc = GL + 512 + 128 * dir;
        LAS float* aj = AJ + 128 * dir; LAS float* mmx = MMx + 128 * dir;
        aj[lane] = IG[lane] - Bc[lane]; aj[lane + 64] = IG[lane + 64] - Bc[lane + 64];
        WAVE_LDS_FENCE();
        if (dir == 0) wave_scan128<true, false>(aj, mmx, lane); else wave_scan128<true, true>(aj, mmx, lane);
        WAVE_LDS_FENCE();
#pragma unroll
        for (int q = 0; q < 2; ++q) { const int j = lane + 64 * q; const float mm = fmaxf(mmx[j], m);
            mmx[j] = mm; INT_[128 * dir + j] = expf(m - mm); FLR[128 * dir + j] = expf(-(Bc[j] + mm)); }
    }
    {
        const int j = tid >> 2, q4 = tid & 3; const bf16* PROJ = (const bf16*)(a.ws + WS_PROJ); const bf16* rp = PROJ + (m0 + j) * NPROJ + hd * 64 + 16 * q4;
        const v4u q0 = *(const v4u*)(rp + C_MQ), q1 = *(const v4u*)(rp + C_MQ + 8), k0 = *(const v4u*)(rp + C_MK), k1 = *(const v4u*)(rp + C_MK + 8), v0 = *(const v4u*)(rp + C_MV), v1 = *(const v4u*)(rp + C_MV + 8);
        *(LAS v4u*)(QS + j * QS_ + 16 * q4) = q0; *(LAS v4u*)(QS + j * QS_ + 16 * q4 + 8) = q1;
        *(LAS v4u*)(KS + j * QS_ + 16 * q4) = k0; *(LAS v4u*)(KS + j * QS_ + 16 * q4 + 8) = k1;
        const unsigned vv[8] = {v0.x, v0.y, v0.z, v0.w, v1.x, v1.y, v1.z, v1.w};
#pragma unroll
        for (int q = 0; q < 8; ++q) { const int d0 = 16 * q4 + 2 * q; VT[d0 * TS + j] = (bf16)(vv[q] & 0xffffu); VT[(d0 + 1) * TS + j] = (bf16)(vv[q] >> 16); }
    }
    WG_SYNC();
    {
        const int idx = tid * 8;
#pragma unroll
        for (int dir = 0; dir < 2; ++dir) { f32x4 s0 = (f32x4){0.f, 0.f, 0.f, 0.f}, s1 = (f32x4){0.f, 0.f, 0.f, 0.f};
            const int klo = dir ? c + 1 : 0, khi = dir ? 16 : c;
            for (int k = klo; k < khi; ++k) { const float cf = COEF[16 * dir + k]; const float* src = CLOC + ((sbase + dir) * 16 + k) * 4096 + idx;
                s0 += cf * *(const f32x4*)src; s1 += cf * *(const f32x4*)(src + 4); }
            v4u pk; pk.x = pk2(s0[0], s0[1]); pk.y = pk2(s0[2], s0[3]); pk.z = pk2(s1[0], s1[1]); pk.w = pk2(s1[2], s1[3]);
            *(LAS v4u*)((dir ? CB : CF) + (idx >> 6) * QS_ + (idx & 63)) = pk; }
        if (tid < 128) { const int dir = tid >> 6, e = tid & 63; const int klo = dir ? c + 1 : 0, khi = dir ? 16 : c; float s = 0.f;
            for (int k = klo; k < khi; ++k) s += COEF[16 * dir + k] * NLOC[((sbase + dir) * 16 + k) * 64 + e];
            NP[tid] = s; }
    }
    WG_SYNC();
    f32x4 hacc[4];
#pragma unroll
    for (int dt = 0; dt < 4; ++dt) hacc[dt] = (f32x4){0.f, 0.f, 0.f, 0.f};
    mls_dir<0>(hacc, QS, KS, VT, CF, AJ, MMx, INT_, FLR, NP, ROWB + wave * 32, wave, lane);
    mls_dir<1>(hacc, QS, KS, VT, CB, AJ + 128, MMx + 128, INT_ + 128, FLR + 128, NP + 64, ROWB + wave * 32, wave, lane);
    {
        const int li = lane & 15, g = lane >> 4; const bf16* PROJ = (const bf16*)(a.ws + WS_PROJ); bf16* Y = (bf16*)(a.ws + WS_Y);
        const float* hg = a.in[I_MNG] + ((size_t)l * 4 + hd) * 64;
#pragma unroll
        for (int r = 0; r < 4; ++r) { float ss = (hacc[0][r] * hacc[0][r] + hacc[1][r] * hacc[1][r]) + (hacc[2][r] * hacc[2][r] + hacc[3][r] * hacc[3][r]);
#pragma unroll
            for (int o = 1; o < 16; o <<= 1) ss += __shfl_xor(ss, o);
            const float rstd = 1.0f / sqrtf(ss * (1.0f / 64.0f) + EPS); const size_t m = m0 + 16 * wave + 4 * g + r;
#pragma unroll
            for (int dt = 0; dt < 4; ++dt) { const int d = 16 * dt + li; const float o = bf2f(PROJ[m * NPROJ + C_MO + hd * 64 + d]);
                Y[m * DM + 768 + hd * 64 + d] = (bf16)f2bf(hacc[dt][r] * rstd * hg[d] * sigmoid_f(o)); } }
    }
    WG_SYNC();
}

__device__ __forceinline__ void attnorm_pass(const Args& a, int l, int lane, int wave, int G, int bid) {
    bf16* Y = (bf16*)(a.ws + WS_Y); const float* gq = a.in[I_AOG] + (size_t)l * 512 + 8 * lane;
    const f32x4 g0 = *(const f32x4*)gq, g1 = *(const f32x4*)(gq + 4);
    const int gw = bid * NWAVES + wave, NGW = G * NWAVES;
    for (int mb = 4 * gw; mb < M; mb += 4 * NGW) { v4u q[4];
#pragma unroll
        for (int r = 0; r < 4; ++r) q[r] = *(const v4u*)(Y + (size_t)(mb + r) * DM + 8 * lane);
        float ss[4];
#pragma unroll
        for (int r = 0; r < 4; ++r) { const float x[8] = {bflo(q[r].x), bfhi(q[r].x), bflo(q[r].y), bfhi(q[r].y), bflo(q[r].z), bfhi(q[r].z), bflo(q[r].w), bfhi(q[r].w)}; float a = 0.f;
#pragma unroll
            for (int i = 0; i < 8; ++i) a += x[i] * x[i];
            ss[r] = a; }
#pragma unroll
        for (int o = 1; o < 64; o <<= 1)
#pragma unroll
            for (int r = 0; r < 4; ++r) ss[r] += __shfl_xor(ss[r], o);
#pragma unroll
        for (int r = 0; r < 4; ++r) { const float rstd = 1.0f / sqrtf(ss[r] * (1.0f / 512.0f) + EPS);
            const float x[8] = {bflo(q[r].x), bfhi(q[r].x), bflo(q[r].y), bfhi(q[r].y), bflo(q[r].z), bfhi(q[r].z), bflo(q[r].w), bfhi(q[r].w)};
            v4u o; o.x = pk2(x[0] * rstd * g0[0], x[1] * rstd * g0[1]); o.y = pk2(x[2] * rstd * g0[2], x[3] * rstd * g0[3]);
            o.z = pk2(x[4] * rstd * g1[0], x[5] * rstd * g1[1]); o.w = pk2(x[6] * rstd * g1[2], x[7] * rstd * g1[3]); *(v4u*)(Y + (size_t)(mb + r) * DM + 8 * lane) = o; } }
}

__device__ __forceinline__ void topk_item(const Args& a, int item, LAS unsigned char* lds, int tid, int lane, int wave) {
    const int unit = item & 127, half = item >> 7, b = unit >> 4, e = unit & 15;
    LAS unsigned long long* KEY = (LAS unsigned long long*)(lds + RING_OFF);
    LAS short* RANK = (LAS short*)(lds + RING_OFF + 16384);
    const float* aff = (const float*)(a.ws + WS_AFF) + ((size_t)b * NE + e) * SEQ;
    for (int s = tid; s < SEQ; s += NTHR) { KEY[s] = ((unsigned long long)__float_as_uint(aff[s]) << 32) | (unsigned)(SEQ - 1 - s); RANK[s] = (short)-1; }
    WG_SYNC();
    for (int k = 2; k <= SEQ; k <<= 1)
        for (int j = k >> 1; j > 0; j >>= 1) {
            if (j >= 128 && j == (k >> 1)) WG_SYNC();
#pragma unroll
            for (int q = 0; q < 2; ++q) { const int t = tid + q * NTHR; const int i = ((t & ~(j - 1)) << 1) | (t & (j - 1));
                const unsigned long long x = KEY[i], y = KEY[i + j]; const bool up = (i & k) == 0;
                if (up ? (x < y) : (x > y)) { KEY[i] = y; KEY[i + j] = x; } }
            if (j >= 128) WG_SYNC(); else WAVE_LDS_FENCE();
        }
    WG_SYNC();
    if (tid < CAP) RANK[SEQ - 1 - (int)(unsigned)(KEY[tid] & 0xffffffffull)] = (short)tid;
    WG_SYNC();
    int* SEL = (int*)(a.ws + WS_SEL); int* IDX = (int*)(a.ws + WS_IDX); float* GATE = (float*)(a.ws + WS_GATE);
    for (int s = half * 1024 + tid; s < half * 1024 + 1024; s += NTHR) SEL[((size_t)b * SEQ + s) * NE + e] = (int)RANK[s];
    if (tid < 128) { const int t = half * 128 + tid; const unsigned long long kv = KEY[t]; const int s = SEQ - 1 - (int)(unsigned)(kv & 0xffffffffull);
        IDX[e * NSLOT + b * CAP + t] = b * SEQ + s; GATE[e * NSLOT + b * CAP + t] = __uint_as_float((unsigned)(kv >> 32)); }
    const bf16* H = (const bf16*)(a.ws + WS_H); bf16* XG = (bf16*)(a.ws + WS_XG);
#pragma unroll
    for (int qb = 0; qb < 2; ++qb) { v4u r0[8], r1[8];
#pragma unroll
        for (int q = 0; q < 8; ++q) { const int t = half * 128 + wave * 16 + qb * 8 + q; const int s = SEQ - 1 - (int)(unsigned)(KEY[t] & 0xffffffffull);
            const v4u* src = (const v4u*)(H + ((size_t)b * SEQ + s) * DM); r0[q] = src[lane]; r1[q] = src[64 + lane]; }
#pragma unroll
        for (int q = 0; q < 8; ++q) { const int t = half * 128 + wave * 16 + qb * 8 + q; v4u* dst = (v4u*)(XG + ((size_t)e * NSLOT + b * CAP + t) * DM);
            dst[lane] = r0[q]; dst[64 + lane] = r1[q]; } }
    WG_SYNC();
}

#ifndef MK_PER_PHASE
#define MK_PER_PHASE 0
#endif
__global__ void __launch_bounds__(NTHR, 2) hybrid_fwd(Args args) {
    extern __shared__ __attribute__((aligned(16))) unsigned char lds_raw[];
    LAS unsigned char* lds = (LAS unsigned char*)lds_raw;
    volatile LAS unsigned* MISC = (volatile LAS unsigned*)(lds + MISC_OFF);
    const int tid0 = threadIdx.x, G = gridDim.x;
    unsigned char* ws = args.ws;
#define PHASE_IDS() const int tid = ltid(), lane = tid & 63, wave = __builtin_amdgcn_readfirstlane(tid >> 6), bid = lbid(); (void)lane; (void)wave; (void)bid
    gu32* ctl = (gu32*)(ws + WS_CTL);
    for (int u = tid0; u < (LDS_BYTES - MISC_OFF) / 4; u += NTHR) ((LAS unsigned*)(lds + MISC_OFF))[u] = 0u;
    __syncthreads();
    XcdBarrier bar; bar.bar = (unsigned*)(ctl + CW_BAR); bar.x = 0; bar.st = nullptr;
    if (!MK_PER_PHASE) bar = xcd_barrier_post((unsigned*)(ctl + CW_BAR), MISC + 8);
#define GRID_BAR() do { if (!MK_PER_PHASE) xcd_barrier(bar); } while (0)
    const int lo = args.ph_lo, hi = args.ph_hi;
#ifndef PT_MASK
#define PT_MASK 0x7ff
#endif
#define PT_ON(j) (((PT_MASK) >> (j)) & 1)
#ifndef REP_MASK
#define REP_MASK 0
#endif
#define REPS(j) for (int rep_ = 0; rep_ < 1 + (((REP_MASK) >> (j)) & 1); ++rep_)
#define IN(k) (lo <= (k) && (k) < hi)
#define BOTH(k) (IN(k) && IN((k) + 1))

    bf16* Hb = (bf16*)(ws + WS_H); bf16* PROJ = (bf16*)(ws + WS_PROJ); bf16* Yb = (bf16*)(ws + WS_Y);
    float* MG = (float*)(ws + WS_MG); float* AFF = (float*)(ws + WS_AFF); int* SEL = (int*)(ws + WS_SEL);
    bf16* XG = (bf16*)(ws + WS_XG); bf16* HID = (bf16*)(ws + WS_HID); bf16* YE = (bf16*)(ws + WS_YE);

    if (PT_ON(0) && IN(0)) { PHASE_IDS();
        REPS(0) p0_weights(args, lds, tid, lane, wave, G, bid);
        WG_SYNC();
        row_pass<0>(args.in[I_X], nullptr, args.in[I_N1G], args.in[I_WIN] + NPROJ, DIN, Hb, MG, nullptr, nullptr, lds, tid, lane, wave, G, bid);
        if (BOTH(0)) GRID_BAR();
    }
    for (int l = 0; l < DEPTH; ++l) {
        const int pb = 1 + 10 * l;
        if (PT_ON(1) && IN(pb + 0)) { PHASE_IDS();
            pg8::Gemm g{Hb, (const bf16*)(ws + WS_WIN) + (size_t)l * NPROJ * DM, M, NPROJ, DM}; pg8::StaticOrder S; S.init(M, NPROJ, G, bid);
            pg8::EpiBf16<0> E{PROJ, NPROJ, nullptr, 0, 0, 1.f};
            REPS(1) pg8::gemm_phase<pg8::EpiBf16<0>, pg8::StaticOrder, true, true>(lds + RING_OFF, g, S, E);
            if (BOTH(pb + 0)) GRID_BAR();
        }
        if (PT_ON(2) && IN(pb + 1)) { PHASE_IDS();
            rope_pass(args, l, lane, wave, G, bid);
            REPS(2) for (int u = bid; u < 512; u += G) lru_a_unit(args, l, u, lds, tid, lane, wave);
            REPS(3) for (int u = bid; u < 512; u += G) mls_a_unit(args, l, u, lds, tid, lane, wave);
            if (BOTH(pb + 1)) GRID_BAR();
        }
        if (PT_ON(3) && IN(pb + 2)) { PHASE_IDS();
            const attn_body::AttnTensors AT{(const attn_body::bf16*)(PROJ + C_Q), (const attn_body::bf16*)(PROJ + C_K), (const attn_body::bf16*)(PROJ + C_V), (attn_body::bf16*)Yb};
            const attn_body::StaticOrder S(G, bid);
#ifndef P3_PARTS
#define P3_PARTS 7
#endif
            if (P3_PARTS & 1) REPS(4) attn_body::attn_phase<attn_body::StaticOrder>((char*)lds_raw + RING_OFF, AT, S);
            WG_SYNC();
            if (P3_PARTS & 2) REPS(5) for (int u = bid; u < 512; u += G) mls_b_unit(args, l, u, lds, tid, lane, wave);
            if (P3_PARTS & 4) REPS(6) for (int u = bid; u < 512; u += G) lru_b_unit(args, l, u, lds, tid, lane, wave);
            if (BOTH(pb + 2)) GRID_BAR();
        }
        if (PT_ON(4) && IN(pb + 3)) { PHASE_IDS(); attnorm_pass(args, l, lane, wave, G, bid); if (BOTH(pb + 3)) GRID_BAR(); }
        if (PT_ON(5) && IN(pb + 4)) { PHASE_IDS();
            pg8::Gemm g{Yb, (const bf16*)(ws + WS_WOUT) + (size_t)l * DM * DM, M, DM, DM}; pg8::StaticOrder S; S.init(M, DM, G, bid);
            pg8::EpiResidF32 E{l == 0 ? args.in[I_X] : args.out, args.out, DM};
            pg8::gemm_phase<pg8::EpiResidF32, pg8::StaticOrder, false, true>(lds + RING_OFF, g, S, E);
            if (BOTH(pb + 4)) GRID_BAR();
        }
        if (PT_ON(6) && IN(pb + 5)) { PHASE_IDS();
            REPS(7) row_pass<1>(args.out, nullptr, args.in[I_N2G] + (size_t)l * DM, args.in[I_WR] + (size_t)l * DM * NE, NE, Hb, AFF, nullptr, nullptr, lds, tid, lane, wave, G, bid);
            if (BOTH(pb + 5)) GRID_BAR();
        }
        if (PT_ON(7) && IN(pb + 6)) { PHASE_IDS(); REPS(8) for (int it = bid; it < 256; it += G) topk_item(args, it, lds, tid, lane, wave); if (BOTH(pb + 6)) GRID_BAR(); }
        if (PT_ON(8) && IN(pb + 7)) { PHASE_IDS();
            pg8::Gemm g{XG, (const bf16*)(ws + WS_WGU) + (size_t)l * NE * 4096 * DM, NE * NSLOT, NE * 4096, DM}; pg8::Moe1Order S{G, bid};
            pg8::EpiSwiGLU E{HID, DE};
            REPS(9) pg8::gemm_phase<pg8::EpiSwiGLU, pg8::Moe1Order, true, true>(lds + RING_OFF, g, S, E);
            if (BOTH(pb + 7)) GRID_BAR();
        }
        if (PT_ON(9) && IN(pb + 8)) { PHASE_IDS();
            pg8::Gemm g{HID, (const bf16*)(ws + WS_WDN) + (size_t)l * NE * DM * DE, NE * NSLOT, NE * DM, DE}; pg8::Moe2Order S{G, bid};
            pg8::EpiScaleBf16 E{YE, DM, (const float*)(ws + WS_GATE)};
            REPS(10) pg8::gemm_phase<pg8::EpiScaleBf16, pg8::Moe2Order, true, true>(lds + RING_OFF, g, S, E);
            if (BOTH(pb + 8)) GRID_BAR();
        }
        if (PT_ON(10) && IN(pb + 9)) { PHASE_IDS();
            if (l + 1 < DEPTH) row_pass<2>(args.out, args.out, args.in[I_N1G] + (size_t)(l + 1) * DM, args.in[I_WIN] + (size_t)(l + 1) * DM * DIN + NPROJ, DIN, Hb, MG, SEL, YE, lds, tid, lane, wave, G, bid);
            else row_pass<3>(args.out, args.out, nullptr, nullptr, 0, nullptr, nullptr, SEL, YE, lds, tid, lane, wave, G, bid);
            if (BOTH(pb + 9)) GRID_BAR();
        }
    }
#undef IN
#undef BOTH
#undef GRID_BAR
}

extern "C" void kernel_launch(void* const* d_in, const int* in_sizes, int n_in, void* d_out, int out_size, void* d_ws, size_t ws_size, hipStream_t stream) {
    static int grid = 0;
    if (grid == 0) {
        if (n_in != 22 || in_sizes[0] != M * DM || out_size != M * DM || ws_size < WS_END) { fprintf(stderr, "kernel_launch: unexpected shapes (n_in %d, in0 %d, out %d, ws %zu); nothing launched\n", n_in, n_in > 0 ? in_sizes[0] : -1, out_size, ws_size); grid = -1; return; }
        int dev = 0, cus = 0, per_cu = 0;
        if (hipGetDevice(&dev) != hipSuccess || hipDeviceGetAttribute(&cus, hipDeviceAttributeMultiprocessorCount, dev) != hipSuccess) { grid = -1; return; }
        if (hipFuncSetAttribute((const void*)hybrid_fwd, hipFuncAttributeMaxDynamicSharedMemorySize, LDS_BYTES) != hipSuccess) { fprintf(stderr, "kernel_launch: hipFuncSetAttribute failed\n"); grid = -1; return; }
        if (hipOccupancyMaxActiveBlocksPerMultiprocessor(&per_cu, (const void*)hybrid_fwd, NTHR, LDS_BYTES) != hipSuccess || per_cu < 1) { fprintf(stderr, "kernel_launch: occupancy query says %d\n", per_cu); }
        (void)hipGetLastError();
        grid = cus;
    }
    if (grid < 0) return;
    if (hipMemsetAsync((char*)d_ws + WS_CTL, 0, CTL_ZERO_BYTES, stream) != hipSuccess) return;
    Args a{};
    for (int i = 0; i < 22; ++i) a.in[i] = (const float*)d_in[i];
    a.out = (float*)d_out; a.ws = (unsigned char*)d_ws; a.pad = 0;
#if MK_PER_PHASE
    for (int p = 0; p < NPH; ++p) { a.ph_lo = p; a.ph_hi = p + 1; a.li = p; hipLaunchKernelGGL(hybrid_fwd, dim3(grid), dim3(NTHR), LDS_BYTES, stream, a); }
#else
    a.ph_lo = 0; a.ph_hi = NPH; a.li = 0;
    hipLaunchKernelGGL(hybrid_fwd, dim3(grid), dim3(NTHR), LDS_BYTES, stream, a);
#endif
    const hipError_t le = hipPeekAtLastError();
    if (le != hipSuccess) fprintf(stderr, "kernel_launch: launch failed: %s\n", hipGetErrorName(le));
}
```

```cpp
#include <hip/hip_runtime.h>
#include <hip/hip_bf16.h>
#include <cstdio>
#include <cstdint>
#include <cmath>
__device__ __forceinline__ int ltid() { int t = threadIdx.x; asm volatile("" : "+v"(t)); return t; }
__device__ __forceinline__ int lbid() { int t = blockIdx.x; asm volatile("" : "+s"(t)); return t; }
namespace pg8 {
#define PG8_LAS __attribute__((address_space(3)))
typedef unsigned short bf16_t;
typedef short bf16x8 __attribute__((ext_vector_type(8)));
typedef float f32x4 __attribute__((ext_vector_type(4)));
typedef unsigned u32x4 __attribute__((ext_vector_type(4)));
typedef unsigned u32x2 __attribute__((ext_vector_type(2)));
constexpr int BM = 256, BK = 64, HALF = 128, HTB = HALF * BK * 2  , STAGE_BYTES = 8 * HTB, NXCD = 8, WGM = 8;

__host__ __device__ __forceinline__ int lds_byte(int r, int c) { const int st = (r >> 4) * 2 + (c >> 5), rr = r & 15, cc = c & 31, ob = rr * 64 + cc * 2; return st * 1024 + (ob ^ (((ob >> 9) & 1) << 5)); }
__host__ __device__ __forceinline__ void stage_rc(int b, int& R, int& C) { const int st = b / 1024, sb = b % 1024, swz = sb ^ (((sb >> 9) & 1) << 5); R = (st >> 1) * 16 + swz / 64; C = (st & 1) * 32 + (swz % 64) / 2; }
__host__ __device__ __forceinline__ int perm32(int rho) { const int n = rho >> 4, i = rho & 15; return 8 * (i >> 2) + 4 * n + (i & 3); }

struct Unit { int pm, pn; };
struct Gemm { const bf16_t* A; const bf16_t* Bt; int M, N, K; };

struct StaticOrder {
    int nM, nN, nwg, G, c;
    __host__ __device__ void init(int M, int N, int G_, int c_) { nM = M / BM; nN = N / BM; nwg = nM * nN; G = G_; c = c_; }
    __host__ __device__ bool next(int i, Unit& u) const {
        const long L = (long)i * G + c; if (L >= nwg) return false;
        int wgid = (int)L; { const int q = nwg / NXCD, r = nwg % NXCD, xcd = wgid % NXCD, off = wgid / NXCD; wgid = (xcd < r ? xcd * (q + 1) : r * (q + 1) + (xcd - r) * q) + off; }
        const int nig = WGM * nN, gid = wgid / nig, fm = gid * WGM, gsz = (nM - fm) < WGM ? (nM - fm) : WGM;
        u.pm = fm + ((wgid % nig) % gsz); u.pn = (wgid % nig) / gsz; return true;
    }
    __device__ __forceinline__ void a_ready(const Unit&) const {}
    __device__ __forceinline__ void done(const Unit&) const {}
};

__device__ __forceinline__ unsigned cvt_pk_bf16(float lo, float hi) { unsigned r; asm volatile("v_cvt_pk_bf16_f32 %0, %1, %2" : "=v"(r) : "v"(lo), "v"(hi)); return r; }
typedef int i32x4 __attribute__((ext_vector_type(4)));
typedef int i32x8 __attribute__((ext_vector_type(8)));
__device__ __forceinline__ i32x8 cat8(bf16x8 lo, bf16x8 hi) { return __builtin_shufflevector(__builtin_bit_cast(i32x4, lo), __builtin_bit_cast(i32x4, hi), 0, 1, 2, 3, 4, 5, 6, 7); }
__device__ __forceinline__ float clamp448(float v) { return __builtin_fminf(__builtin_fmaxf(v, -448.f), 448.f); }
__device__ __forceinline__ unsigned pk4_fp8(float a, float b, float c, float d) { unsigned r = 0u; r = (unsigned)__builtin_amdgcn_cvt_pk_fp8_f32(a, b, (int)r, false); r = (unsigned)__builtin_amdgcn_cvt_pk_fp8_f32(c, d, (int)r, true); return r; }
typedef float f32x2 __attribute__((ext_vector_type(2)));
__device__ __forceinline__ f32x2 gelu_pk(f32x2 v) {
    const f32x2 av = __builtin_elementwise_abs(v), d = av * 0.2316418882f + 1.0f;
    f32x2 t; t.x = __builtin_amdgcn_rcpf(d.x); t.y = __builtin_amdgcn_rcpf(d.y);
    f32x2 q = t * 0.5307027145f + (-0.7265760135f); q = q * t + 0.7107068705f; q = q * t + (-0.142248368f); q = q * t + 0.127414796f; q = q * t;
    const f32x2 s = (v * v) * (-0.72134752044f);
    f32x2 e; e.x = __builtin_amdgcn_exp2f(s.x); e.y = __builtin_amdgcn_exp2f(s.y);
    const f32x2 m = v * (q * e), r = v - m;
    f32x2 o; o.x = v.x < 0.f ? m.x : r.x; o.y = v.y < 0.f ? m.y : r.y; return o;
}

template <int ACT  > struct EpiBf16 {
    static constexpr bool PERM = true, AFTER_DRAIN = false; static_assert(ACT == 0 || ACT == 1, "EpiBf16: ACT is 0 (none) or 1 (gelu_pk)");
    bf16_t* O; int ldc; const float* bias; int split_cols; size_t split_stride; float scale0;
    __device__ __forceinline__ void operator()(const f32x4 (&acc)[2][2][4][2], const Unit& u, int wr, int wc, int fr, int fq) const {
        const int row0 = u.pm * BM + wr * 64 + fr; int colt = u.pn * BM; bf16_t* base = O;
        float sc = 1.f; if (split_cols) { const int t = colt / split_cols; base += (size_t)t * split_stride; colt -= t * split_cols; if (t == 0) sc = scale0; }
        const int col0 = colt + wc * 32 + 8 * fq, bcol0 = u.pn * BM + wc * 32 + 8 * fq;
        f32x4 bv[2][2];
#pragma unroll
        for (int bj = 0; bj < 2; ++bj)
#pragma unroll
            for (int n = 0; n < 2; ++n) bv[bj][n] = bias ? *(const f32x4*)(bias + bcol0 + bj * HALF + 4 * n) : (f32x4){0.f, 0.f, 0.f, 0.f};
#pragma unroll
        for (int ai = 0; ai < 2; ++ai)
#pragma unroll
            for (int m = 0; m < 4; ++m) { bf16_t* rowp = base + (size_t)(row0 + ai * HALF + m * 16) * ldc + col0;
#pragma unroll
                for (int bj = 0; bj < 2; ++bj) { f32x4 v0 = acc[ai][bj][m][0] + bv[bj][0], v1 = acc[ai][bj][m][1] + bv[bj][1];
                    if (ACT == 1) { f32x2 a = gelu_pk((f32x2){v0[0], v0[1]}), b = gelu_pk((f32x2){v0[2], v0[3]}), c = gelu_pk((f32x2){v1[0], v1[1]}), d = gelu_pk((f32x2){v1[2], v1[3]});
                        v0 = (f32x4){a.x, a.y, b.x, b.y}; v1 = (f32x4){c.x, c.y, d.x, d.y}; }
                    v0 = v0 * sc; v1 = v1 * sc; u32x4 w; w.x = cvt_pk_bf16(v0[0], v0[1]); w.y = cvt_pk_bf16(v0[2], v0[3]); w.z = cvt_pk_bf16(v1[0], v1[1]); w.w = cvt_pk_bf16(v1[2], v1[3]);
                    *(u32x4*)(rowp + bj * HALF) = w; } }
    }
};

struct EpiResidF32 {
    static constexpr bool PERM = false, AFTER_DRAIN = false;
    const float* base; float* C; int ldc;
    __device__ __forceinline__ void operator()(const f32x4 (&acc)[2][2][4][2], const Unit& u, int wr, int wc, int fr, int fq) const {
        const int row0 = u.pm * BM + wr * 64 + fr, col0 = u.pn * BM + wc * 32 + 4 * fq;
#pragma unroll
        for (int ai = 0; ai < 2; ++ai)
#pragma unroll
            for (int m = 0; m < 4; ++m) { const size_t off = (size_t)(row0 + ai * HALF + m * 16) * ldc + col0;
#pragma unroll
                for (int bj = 0; bj < 2; ++bj)
#pragma unroll
                    for (int n = 0; n < 2; ++n) { const f32x4 b = *(const f32x4*)(base + off + bj * HALF + n * 16); *(f32x4*)(C + off + bj * HALF + n * 16) = acc[ai][bj][m][n] + b; } }
    }
};
__device__ __forceinline__ float silu_f(float x) { return x * __builtin_amdgcn_rcpf(1.0f + __builtin_amdgcn_exp2f(-1.4426950408889634f * x)); }
constexpr float WSCALE = 64.f, HSCALE = 4.f;
struct EpiSwiGLU {
    static constexpr bool PERM = true, AFTER_DRAIN = false;
    unsigned char* O; int ldc;
    __device__ __forceinline__ void operator()(const f32x4 (&acc)[2][2][4][2], const Unit& u, int wr, int wc, int fr, int fq) const {
        const int row0 = u.pm * BM + wr * 64 + fr, col0 = (u.pn & 15) * HALF + wc * 32 + 8 * fq; constexpr float is = 1.0f / WSCALE;
#pragma unroll
        for (int ai = 0; ai < 2; ++ai)
#pragma unroll
            for (int m = 0; m < 4; ++m) { unsigned char* rowp = O + (size_t)(row0 + ai * HALF + m * 16) * ldc + col0;
                const f32x4 g0 = acc[ai][0][m][0] * is, g1 = acc[ai][0][m][1] * is, u0 = acc[ai][1][m][0] * (is * HSCALE), u1 = acc[ai][1][m][1] * (is * HSCALE);
                u32x2 w; w.x = pk4_fp8(clamp448(silu_f(g0[0]) * u0[0]), clamp448(silu_f(g0[1]) * u0[1]), clamp448(silu_f(g0[2]) * u0[2]), clamp448(silu_f(g0[3]) * u0[3]));
                w.y = pk4_fp8(clamp448(silu_f(g1[0]) * u1[0]), clamp448(silu_f(g1[1]) * u1[1]), clamp448(silu_f(g1[2]) * u1[2]), clamp448(silu_f(g1[3]) * u1[3]));
                *(u32x2*)rowp = w; }
    }
};
struct EpiScaleBf16 {
    static constexpr bool PERM = true, AFTER_DRAIN = false;
    bf16_t* O; int ldc; const float* rowscale;
    __device__ __forceinline__ void operator()(const f32x4 (&acc)[2][2][4][2], const Unit& u, int wr, int wc, int fr, int fq) const {
        const int row0 = u.pm * BM + wr * 64 + fr, col0 = (u.pn & 3) * BM + wc * 32 + 8 * fq;
#pragma unroll
        for (int ai = 0; ai < 2; ++ai)
#pragma unroll
            for (int m = 0; m < 4; ++m) { const int row = row0 + ai * HALF + m * 16; const float s = rowscale[row] * (1.0f / (WSCALE * HSCALE)); bf16_t* rowp = O + (size_t)row * ldc + col0;
#pragma unroll
                for (int bj = 0; bj < 2; ++bj) { const f32x4 v0 = acc[ai][bj][m][0] * s, v1 = acc[ai][bj][m][1] * s;
                    u32x4 w; w.x = cvt_pk_bf16(v0[0], v0[1]); w.y = cvt_pk_bf16(v0[2], v0[3]); w.z = cvt_pk_bf16(v1[0], v1[1]); w.w = cvt_pk_bf16(v1[2], v1[3]);
                    *(u32x4*)(rowp + bj * HALF) = w; } }
    }
};
struct Moe1Order {
    int G, c;
    __device__ __forceinline__ bool next(int i, Unit& u) const {
        const int L = i * G + c; if (L >= 2048) return false;
        const int e = L >> 7, r = L & 127; u.pm = e * 8 + ((r >> 3) & 7); u.pn = e * 16 + 2 * (r & 7) + (r >> 6); return true;
    }
    __device__ __forceinline__ void a_ready(const Unit&) const {}
    __device__ __forceinline__ void done(const Unit&) const {}
};
struct Moe2Order {
    int G, c;
    __device__ __forceinline__ bool next(int i, Unit& u) const {
        const int L = i * G + c; if (L >= 512) return false;
        const int q = L & 7, Lp = L >> 3, e = 8 * (Lp >> 5) + q, k = Lp & 31; u.pm = e * 8 + (k & 7); u.pn = e * 4 + (k >> 3); return true;
    }
    __device__ __forceinline__ void a_ready(const Unit&) const {}
    __device__ __forceinline__ void done(const Unit&) const {}
};
template <class Epi, class Sched, bool ALIGN_EPI = false, bool SP2 = false, bool F8 = false>
__device__ __forceinline__ void gemm_phase(PG8_LAS unsigned char* lds, const Gemm g, const Sched& S, const Epi& E) {
    const int tid = ltid(), wid = __builtin_amdgcn_readfirstlane(tid >> 6), lane = tid & 63, wr = wid >> 2, wc = wid & 3, fr = lane & 15, fq = lane >> 4;
    const int K = g.K, nt = K / BK;
    unsigned voffA[2], voffB[2];
#pragma unroll
    for (int i = 0; i < 2; ++i) { int R, C; stage_rc(tid * 16 + i * 8192, R, C); const int Rb = Epi::PERM ? ((R & ~31) + perm32(R & 31)) : R;
        voffA[i] = (unsigned)(R * K + C) * 2u; voffB[i] = (unsigned)(Rb * K + C) * 2u; }
    const size_t kstep = (size_t)(BK * 2);
    const size_t hstep = (size_t)HALF * K * 2;
    const size_t tstep = 2 * hstep;
    const unsigned ldsw = (unsigned)wid * 1024u;
    const int aoff = lds_byte(wr * 64 + fr, fq * 8), boff = lds_byte(wc * 32 + fr, fq * 8);
#define PG8_SA(b, h) (((b) * 2 + (h)) * HTB)
#define PG8_SB(b, h) ((4 + (b) * 2 + (h)) * HTB)
#define PG8_STAGE(bufoff, gbase, voff) do { _Pragma("unroll") for (int _i = 0; _i < 2; ++_i) \
        __builtin_amdgcn_global_load_lds((const unsigned*)((const char*)(gbase) + (voff)[_i]), (PG8_LAS unsigned*)(lds + (bufoff) + ldsw + _i * 8192), 16, 0, 0); } while (0)
#define PG8_LDA(dst, b, h) do { _Pragma("unroll") for (int m = 0; m < 4; ++m) { if constexpr (F8) { dst##8[m] = cat8(*(const PG8_LAS bf16x8*)(lds + PG8_SA(b, h) + aoff + m * 2048), *(const PG8_LAS bf16x8*)(lds + PG8_SA(b, h) + aoff + m * 2048 + 1024)); } \
        else { _Pragma("unroll") for (int k = 0; k < 2; ++k) dst[m][k] = *(const PG8_LAS bf16x8*)(lds + PG8_SA(b, h) + aoff + m * 2048 + k * 1024); } } } while (0)
#define PG8_LDB(dst, b, h) do { _Pragma("unroll") for (int n = 0; n < 2; ++n) { if constexpr (F8) { dst##8[n] = cat8(*(const PG8_LAS bf16x8*)(lds + PG8_SB(b, h) + boff + n * 2048), *(const PG8_LAS bf16x8*)(lds + PG8_SB(b, h) + boff + n * 2048 + 1024)); } \
        else { _Pragma("unroll") for (int k = 0; k < 2; ++k) dst[n][k] = *(const PG8_LAS bf16x8*)(lds + PG8_SB(b, h) + boff + n * 2048 + k * 1024); } } } while (0)
#define PG8_MMA(ai, bj, At, Bt) do { __builtin_amdgcn_s_setprio(1); _Pragma("unroll") for (int m = 0; m < 4; ++m) _Pragma("unroll") for (int n = 0; n < 2; ++n) { \
        if constexpr (F8) { asm volatile("v_mfma_scale_f32_16x16x128_f8f6f4 %0, %1, %2, %0, %3, %3 op_sel_hi:[0,0,0]" : "+v"(acc[ai][bj][m][n]) : "v"(Bt##8[n]), "v"(At##8[m]), "v"(sc1)); } \
        else { _Pragma("unroll") for (int k = 0; k < 2; ++k) acc[ai][bj][m][n] = __builtin_amdgcn_mfma_f32_16x16x32_bf16(Bt[n][k], At[m][k], acc[ai][bj][m][n], 0, 0, 0); } } __builtin_amdgcn_s_setprio(0); } while (0)
#define PG8_WAIT_V(n) asm volatile("s_waitcnt vmcnt(" #n ")" ::: "memory")
#define PG8_WAIT_L(n) asm volatile("s_waitcnt lgkmcnt(" #n ")" ::: "memory")
#define PG8_BAR __builtin_amdgcn_s_barrier()
#define PG8_SCHED __builtin_amdgcn_sched_barrier(0)
    Unit cur, nxt; int ui = 0;
    if (!S.next(0, cur)) return;
    f32x4 acc[2][2][4][2];
#pragma unroll
    for (int a = 0; a < 2; ++a)
#pragma unroll
        for (int b = 0; b < 2; ++b)
#pragma unroll
            for (int m = 0; m < 4; ++m)
#pragma unroll
                for (int n = 0; n < 2; ++n) acc[a][b][m][n] = (f32x4){0.f, 0.f, 0.f, 0.f};
    bf16x8 At[4][2], B0[2][2], B1[2][2]; i32x8 At8[4], B08[2], B18[2];
    const int sc1 = 0x7F7F7F7F;
    const char* cA = (const char*)g.A + (size_t)cur.pm * tstep; const char* cB = (const char*)g.Bt + (size_t)cur.pn * tstep;
    S.a_ready(cur);
    if constexpr (SP2) {
        PG8_STAGE(PG8_SB(0, 0), cB, voffB); PG8_STAGE(PG8_SB(0, 1), cB + hstep, voffB); PG8_STAGE(PG8_SA(0, 0), cA, voffA); PG8_STAGE(PG8_SA(0, 1), cA + hstep, voffA);
        if (wr == 1) PG8_BAR;
        PG8_WAIT_V(2); PG8_BAR;
        PG8_STAGE(PG8_SB(1, 0), cB + kstep, voffB); PG8_STAGE(PG8_SA(1, 0), cA + kstep, voffA); PG8_STAGE(PG8_SB(1, 1), cB + hstep + kstep, voffB);
        PG8_WAIT_V(6); PG8_BAR;
    } else {
        PG8_STAGE(PG8_SB(0, 0), cB, voffB); PG8_STAGE(PG8_SA(0, 0), cA, voffA); PG8_STAGE(PG8_SB(0, 1), cB + hstep, voffB); PG8_STAGE(PG8_SA(0, 1), cA + hstep, voffA);
        if (wr == 1) PG8_BAR;
        PG8_WAIT_V(4); PG8_BAR;
        PG8_STAGE(PG8_SB(1, 0), cB + kstep, voffB); PG8_STAGE(PG8_SA(1, 0), cA + kstep, voffA); PG8_STAGE(PG8_SB(1, 1), cB + hstep + kstep, voffB);
        PG8_WAIT_V(6); PG8_BAR;
    }
    for (;;) {
        const bool has_next = S.next(ui + 1, nxt);
        const char* nA = has_next ? (const char*)g.A + (size_t)nxt.pm * tstep : cA; const char* nB = has_next ? (const char*)g.Bt + (size_t)nxt.pn * tstep : cB;
        for (int t = 0; t < nt; t += 2) {
            const bool last = (t == nt - 2);
            const char* a1 = cA + (size_t)(t + 1) * kstep;
            const char* a2 = last ? nA : cA + (size_t)(t + 2) * kstep; const char* b2 = last ? nB : cB + (size_t)(t + 2) * kstep;
            const char* a3 = a2 + kstep; const char* b3 = b2 + kstep;
            if (last && has_next) S.a_ready(nxt);
            if constexpr (SP2) {
            PG8_LDB(B0, 0, 0); PG8_LDB(B1, 0, 1); PG8_SCHED; PG8_LDA(At, 0, 0); PG8_STAGE(PG8_SA(1, 1), a1 + hstep, voffA);
            PG8_WAIT_V(8); PG8_WAIT_L(0); PG8_BAR; PG8_MMA(0, 0, At, B0); PG8_MMA(0, 1, At, B1); PG8_BAR; PG8_SCHED;
            PG8_LDA(At, 0, 1); PG8_STAGE(PG8_SB(0, 0), b2, voffB); PG8_STAGE(PG8_SB(0, 1), b2 + hstep, voffB); PG8_STAGE(PG8_SA(0, 0), a2, voffA);
            PG8_WAIT_V(8); PG8_WAIT_L(0); PG8_BAR; PG8_MMA(1, 0, At, B0); PG8_MMA(1, 1, At, B1); PG8_BAR; PG8_SCHED;
            PG8_LDB(B0, 1, 0); PG8_LDB(B1, 1, 1); PG8_SCHED; PG8_LDA(At, 1, 0); PG8_STAGE(PG8_SA(0, 1), a2 + hstep, voffA);
            PG8_WAIT_V(8); PG8_WAIT_L(0); PG8_BAR; PG8_MMA(0, 0, At, B0); PG8_MMA(0, 1, At, B1); PG8_BAR; PG8_SCHED;
            PG8_LDA(At, 1, 1); PG8_STAGE(PG8_SB(1, 0), b3, voffB); PG8_STAGE(PG8_SB(1, 1), b3 + hstep, voffB); PG8_STAGE(PG8_SA(1, 0), a3, voffA);
            PG8_WAIT_V(8); PG8_WAIT_L(0); PG8_BAR; PG8_MMA(1, 0, At, B0); PG8_MMA(1, 1, At, B1); PG8_BAR; PG8_SCHED;
            } else {
            PG8_LDB(B0, 0, 0); PG8_SCHED; PG8_LDA(At, 0, 0); PG8_STAGE(PG8_SA(1, 1), a1 + hstep, voffA);
            PG8_WAIT_L(8); PG8_BAR; PG8_WAIT_L(0); PG8_MMA(0, 0, At, B0); PG8_BAR; PG8_SCHED;
            PG8_LDB(B1, 0, 1); PG8_STAGE(PG8_SB(0, 0), b2, voffB);
            PG8_BAR; PG8_WAIT_L(0); PG8_MMA(0, 1, At, B1); PG8_BAR;
            PG8_LDA(At, 0, 1); PG8_STAGE(PG8_SA(0, 0), a2, voffA);
            PG8_BAR; PG8_WAIT_L(0); PG8_MMA(1, 0, At, B0); PG8_BAR; PG8_SCHED;
            PG8_STAGE(PG8_SB(0, 1), b2 + hstep, voffB);
            PG8_WAIT_V(6); PG8_BAR; PG8_MMA(1, 1, At, B1); PG8_BAR;
            PG8_LDB(B0, 1, 0); PG8_SCHED; PG8_LDA(At, 1, 0); PG8_STAGE(PG8_SA(0, 1), a2 + hstep, voffA);
            PG8_WAIT_L(8); PG8_BAR; PG8_WAIT_L(0); PG8_MMA(0, 0, At, B0); PG8_BAR; PG8_SCHED;
            PG8_LDB(B1, 1, 1); PG8_STAGE(PG8_SB(1, 0), b3, voffB);
            PG8_BAR; PG8_WAIT_L(0); PG8_MMA(0, 1, At, B1); PG8_BAR;
            PG8_LDA(At, 1, 1); PG8_STAGE(PG8_SA(1, 0), a3, voffA);
            PG8_BAR; PG8_WAIT_L(0); PG8_MMA(1, 0, At, B0); PG8_BAR; PG8_SCHED;
            PG8_STAGE(PG8_SB(1, 1), b3 + hstep, voffB);
            PG8_WAIT_V(6); PG8_BAR; PG8_MMA(1, 1, At, B1); PG8_BAR;
            }
        }
        if constexpr (F8) { asm volatile("s_nop 15\n\ts_nop 15" ::: "memory"); }
        if constexpr (ALIGN_EPI) { if (wr == 0) PG8_BAR; }
        if constexpr (!Epi::AFTER_DRAIN) { E(acc, cur, wr, wc, fr, fq); S.done(cur); }
        if (!has_next) break;
#pragma unroll
        for (int a = 0; a < 2; ++a)
#pragma unroll
            for (int b = 0; b < 2; ++b)
#pragma unroll
                for (int m = 0; m < 4; ++m)
#pragma unroll
                    for (int n = 0; n < 2; ++n) acc[a][b][m][n] = (f32x4){0.f, 0.f, 0.f, 0.f};
        cur = nxt; cA = nA; cB = nB; ++ui;
        if constexpr (ALIGN_EPI) { if (wr == 1) PG8_BAR; }
    }
    PG8_WAIT_V(0);
    if constexpr (!ALIGN_EPI) { if (wr == 0) PG8_BAR; }
    PG8_BAR;
    if constexpr (Epi::AFTER_DRAIN) { E.fused(acc, cur, wr, wc, fr, fq, lds, wid, lane); S.done(cur); }
#undef PG8_SA
#undef PG8_SB
#undef PG8_STAGE
#undef PG8_LDA
#undef PG8_LDB
#undef PG8_MMA
#undef PG8_WAIT_V
#undef PG8_WAIT_L
#undef PG8_BAR
#undef PG8_SCHED
}
}

namespace attn_body {
using bf16=__hip_bfloat16;
using bf16x8=__attribute__((ext_vector_type(8)))short;
using s16x4=__attribute__((ext_vector_type(4)))short;
using f32x16=__attribute__((ext_vector_type(16)))float;
using u32x4=__attribute__((ext_vector_type(4)))unsigned;
constexpr int BATCH=8,NHEAD=8,NKV=2,SEQ=2048,D=64,PQ=2304,PO=1024;
constexpr int NW=8,QBLK=32,QB=QBLK*NW,KVBLK=64,NQB=SEQ/QB;
constexpr int ATTN_UNIT_ROWS=QB;
__device__ __forceinline__ int crow(int r,int hi){return (r&3)+8*(r>>2)+4*hi;}
#define SBAR() __builtin_amdgcn_sched_barrier(0)
__device__ __forceinline__ void cmask(f32x16&p0,f32x16&p1,int jb,int qrel,int hi){
  const float NEG=-INFINITY; int kb=64*jb+4*hi;
  #pragma unroll
  for(int r=0;r<16;++r){int kv=kb+(r&3)+8*(r>>2); if(kv>qrel)p0[r]=NEG; if(kv+32>qrel)p1[r]=NEG;}
}

constexpr int NSLOT=3, SLOTB=8192;
constexpr int LDS_K=0, LDS_V=NSLOT*SLOTB, LDS_WS=2*NSLOT*SLOTB, LDS_OST=LDS_WS+NW*64*4, LDS_BYTES=LDS_OST+NW*4096;
constexpr float C2=0.125f*1.4426950408889634f;
__device__ __forceinline__ void glds16(const void*gsrc,unsigned lds_dst){unsigned keep;
  asm volatile("s_mov_b32 %0, m0\n\ts_mov_b32 m0, %2\n\ts_nop 0\n\tglobal_load_lds_dwordx4 %1, off\n\ts_mov_b32 m0, %0":"=&s"(keep):"v"(gsrc),"s"(lds_dst):"memory");}
__device__ __forceinline__ float max3f(float a,float b,float c){float r;asm("v_max3_f32 %0, %1, %2, %3":"=v"(r):"v"(a),"v"(b),"v"(c));return r;}
__device__ __forceinline__ float max2f(float a,float b){float r;asm("v_max_f32_e32 %0, %1, %2":"=v"(r):"v"(a),"v"(b));return r;}
__device__ __forceinline__ float fadd_s(float a,float b){float r;asm("v_add_f32_e32 %0, %1, %2":"=v"(r):"v"(a),"v"(b));return r;}
__device__ __forceinline__ float fsub_s(float a,float b){float r;asm("v_sub_f32_e32 %0, %1, %2":"=v"(r):"v"(a),"v"(b));return r;}
typedef float f32x2_t __attribute__((ext_vector_type(2))); typedef __bf16 bf16x2_t __attribute__((ext_vector_type(2)));
__device__ __forceinline__ unsigned cvtpk_s(float lo,float hi){f32x2_t v={lo,hi};bf16x2_t b=__builtin_convertvector(v,bf16x2_t);return __builtin_bit_cast(unsigned,b);}
#define WAIT_BAR(N) asm volatile("s_waitcnt vmcnt(" #N ") lgkmcnt(0)\n\ts_barrier":::"memory")

__device__ __forceinline__ void qkt(f32x16&p0,f32x16&p1,const char*Kslot,const bf16x8*qr,const f32x16&negm,int r32,int hi){
  const char*kb=Kslot+hi*1024+r32*16;
  #pragma unroll
  for(int d0=0;d0<4;++d0){
    const bf16x8 b0=*reinterpret_cast<const bf16x8*>(kb+d0*2048);
    const bf16x8 b1=*reinterpret_cast<const bf16x8*>(kb+d0*2048+512);
    if(d0==0){p0=__builtin_amdgcn_mfma_f32_32x32x16_bf16(b0,qr[0],negm,0,0,0);p1=__builtin_amdgcn_mfma_f32_32x32x16_bf16(b1,qr[0],negm,0,0,0);}
    else{p0=__builtin_amdgcn_mfma_f32_32x32x16_bf16(b0,qr[d0],p0,0,0,0);p1=__builtin_amdgcn_mfma_f32_32x32x16_bf16(b1,qr[d0],p1,0,0,0);}}
}
typedef __attribute__((address_space(3))) const char* lds_cptr;
typedef short v4i16_t __attribute__((ext_vector_type(4)));
__device__ __forceinline__ void kload8(bf16x8*kf,lds_cptr kp){
  kf[0]=*(const __attribute__((address_space(3))) bf16x8*)(kp);      kf[1]=*(const __attribute__((address_space(3))) bf16x8*)(kp+512);
  kf[2]=*(const __attribute__((address_space(3))) bf16x8*)(kp+2048); kf[3]=*(const __attribute__((address_space(3))) bf16x8*)(kp+2560);
  kf[4]=*(const __attribute__((address_space(3))) bf16x8*)(kp+4096); kf[5]=*(const __attribute__((address_space(3))) bf16x8*)(kp+4608);
  kf[6]=*(const __attribute__((address_space(3))) bf16x8*)(kp+6144); kf[7]=*(const __attribute__((address_space(3))) bf16x8*)(kp+6656);
}
__device__ __forceinline__ void kload2(bf16x8*kf,lds_cptr kp,int j){ kf[2*j]=*(const __attribute__((address_space(3))) bf16x8*)(kp+j*2048); kf[2*j+1]=*(const __attribute__((address_space(3))) bf16x8*)(kp+j*2048+512); }
__device__ __forceinline__ s16x4 vtr(lds_cptr p){ return __builtin_bit_cast(s16x4,__builtin_amdgcn_ds_read_tr16_b64_v4i16((__attribute__((address_space(3))) v4i16_t*)p)); }
__device__ __forceinline__ float rowmax(const f32x16&p0,const f32x16&p1){
  float a=max3f(p0[0],p0[1],p1[0]),b=max3f(p0[2],p0[3],p1[1]);a=max3f(a,p1[2],p1[3]);
  #pragma unroll
  for(int r=4;r<16;r+=4){a=max3f(a,p0[r],p0[r+1]);b=max3f(b,p0[r+2],p0[r+3]);a=max3f(a,p1[r],p1[r+1]);b=max3f(b,p1[r+2],p1[r+3]);}
  const float m=max2f(a,b);
  auto rr=__builtin_amdgcn_permlane32_swap(__float_as_uint(m),__float_as_uint(m),false,false);
  return max2f(__uint_as_float(rr[0]),__uint_as_float(rr[1]));
}
__device__ __forceinline__ void pv(f32x16*o,int vb,bf16x8 pa0,bf16x8 pa1,bf16x8 pa2,bf16x8 pa3){
  #pragma unroll
  for(int d0=0;d0<2;++d0){s16x4 lo[4],hi[4];
    #pragma unroll
    for(int ks=0;ks<4;++ks){
      asm volatile("ds_read_b64_tr_b16 %0,%1 offset:%c2":"=&v"(lo[ks]):"v"(vb),"i"(d0*4096+ks*1024):"memory");
      asm volatile("ds_read_b64_tr_b16 %0,%1 offset:%c2":"=&v"(hi[ks]):"v"(vb),"i"(d0*4096+ks*1024+512):"memory");}
    asm volatile("s_waitcnt lgkmcnt(0)":::"memory");SBAR();
    #define PK(k) (bf16x8){lo[k][0],lo[k][1],lo[k][2],lo[k][3],hi[k][0],hi[k][1],hi[k][2],hi[k][3]}
    o[d0]=__builtin_amdgcn_mfma_f32_32x32x16_bf16(pa0,PK(0),o[d0],0,0,0);
    o[d0]=__builtin_amdgcn_mfma_f32_32x32x16_bf16(pa1,PK(1),o[d0],0,0,0);
    o[d0]=__builtin_amdgcn_mfma_f32_32x32x16_bf16(pa2,PK(2),o[d0],0,0,0);
    o[d0]=__builtin_amdgcn_mfma_f32_32x32x16_bf16(pa3,PK(3),o[d0],0,0,0);
    #undef PK
  }
}

#ifndef ATTN_STORE16
#define ATTN_STORE16(p,v) (*(u32x4*)(p)=(v))
#endif
template<int THRL> __device__ __forceinline__ void attn_unit(int b,int h,int qb,const bf16*Q,const bf16*__restrict__ K,const bf16*__restrict__ V,bf16*O,char*shm){
  const int tid=ltid(),lane=tid&63,r32=lane&31,hi=lane>>5; const int wid=__builtin_amdgcn_readfirstlane(tid>>6);
  const long rowbase=(long)b*SEQ; const int q0=qb*QB;
  const bf16*Qw=Q+(rowbase+q0+wid*QBLK)*PQ+h*D;
  const bf16*Kh=K+rowbase*PQ+(h>>2)*D,*Vh=V+rowbase*PQ+(h>>2)*D;
  const unsigned lds0=(unsigned)(uintptr_t)shm;
  float*wsf=(float*)(shm+LDS_WS)+wid*64;
  const bf16*ksrc=Kh+(long)lane*PQ+wid*8;
  const bf16*vsrc=Vh+(long)(16*(wid&3)+(lane>>2))*PQ+(wid>>2)*32+(lane&3)*8;
  const unsigned kdst=lds0+LDS_K+wid*1024, vdst=lds0+LDS_V+wid*1024;
  #define DMA_K(t,slot) glds16(ksrc+(long)(t)*KVBLK*PQ,(unsigned)__builtin_amdgcn_readfirstlane(kdst+(slot)))
  #define DMA_V(t,slot) glds16(vsrc+(long)(t)*KVBLK*PQ,(unsigned)__builtin_amdgcn_readfirstlane(vdst+(slot)))
  const int vb0=(int)(lds0+LDS_V)+((lane>>4)&1)*32+(lane&3)*8+(4*hi+((lane&15)>>2))*64;
  const char*Kbase=shm+LDS_K; bf16x8 kf[8];
  const lds_cptr shm3=(lds_cptr)shm; const lds_cptr kp0=shm3+LDS_K+hi*1024+r32*16; const lds_cptr vp0=shm3+LDS_V+((lane>>4)&1)*32+(lane&3)*8+(4*hi+((lane&15)>>2))*64;
  const int NT=SEQ/KVBLK;
  DMA_K(0,0);DMA_V(0,0);DMA_K(1,SLOTB);
  bf16x8 qr[4];
  #pragma unroll
  for(int d0=0;d0<4;++d0)qr[d0]=*reinterpret_cast<const bf16x8*>(&Qw[(long)r32*PQ+d0*16+hi*8]);
  float mhat=0.f,l_reg=0.f;f32x16 o[2];o[0]=f32x16{};o[1]=f32x16{};f32x16 negm=f32x16{};asm volatile("":"+v"(negm));
  const int qrel=wid*QBLK+r32;
  #define CMASK(P0,P1,t) do{}while(0)
  bool resc=false;
  #define START(P0,P1) do{ const float rm=rowmax(P0,P1); resc=false; \
    { const float dl=rm; mhat=fadd_s(mhat,dl); \
      _Pragma("unroll") for(int r=0;r<16;++r){P0[r]=fsub_s(P0[r],dl);P1[r]=fsub_s(P1[r],dl);} \
      _Pragma("unroll") for(int r=0;r<16;++r)negm[r]=-mhat; asm volatile("":"+v"(negm)); } \
    _Pragma("unroll") for(int r=0;r<16;++r)P0[r]=__builtin_amdgcn_exp2f(P0[r]); }while(0)
  #define RESC() do{ if(resc){ asm volatile("s_waitcnt lgkmcnt(0)":::"memory"); \
      _Pragma("unroll") for(int d_=0;d_<2;++d_) _Pragma("unroll") for(int r=0;r<16;++r)o[d_][r]*=wsf[crow(r,hi)]; } }while(0)
  f32x16 pA0,pA1,pB0,pB1;
  int sl_prev=0,sl_cur=0,sl_next=SLOTB;
  #define ROT() do{sl_prev=sl_cur;sl_cur=sl_next;sl_next=(sl_next==(NSLOT-1)*SLOTB)?0:sl_next+SLOTB;}while(0)
  DMA_K(2,2*SLOTB);
  WAIT_BAR(3);
  qkt(pA0,pA1,Kbase,qr,negm,r32,hi);asm volatile("s_nop 15\n\ts_nop 7":"+v"(pA0),"+v"(pA1));CMASK(pA0,pA1,0);
  START(pA0,pA1);
  _Pragma("unroll") for(int r=0;r<16;++r)pA1[r]=__builtin_amdgcn_exp2f(pA1[r]);
  WAIT_BAR(0);
  DMA_K(3,0);DMA_V(1,SLOTB);
  ROT();
  kload8(kf,kp0+sl_cur);
  WAIT_BAR(2);
  s16x4 vlo[8],vhi[8]; u32x4 pw0,pw1,pw2,pw3;
  #define PKW(P,B) cvtpk_s(P[B],P[B+1])
  #define PAF(k) __builtin_bit_cast(bf16x8,pw##k)
  #define VFR(i) (bf16x8){vlo[i][0],vlo[i][1],vlo[i][2],vlo[i][3],vhi[i][0],vhi[i][1],vhi[i][2],vhi[i][3]}
  #define PIN(x) asm volatile("":"+v"(x))
  #define MX3(a,b,c) __builtin_fmaxf(__builtin_fmaxf((a),(b)),(c))
  #define GAPA(MF,A0,A1,A2,A3,W0,W1,PW) do{ MF; sacc+=A0; sacc+=A1; sacc+=A2; sacc+=A3; PIN(sacc); W0; W1; PIN(PW); SBAR(); }while(0)
  #define EX(v) __builtin_amdgcn_exp2f(v)
  #define GAPB(MF,X,B) do{ MF; X[B]=EX(X[B]); X[B+1]=EX(X[B+1]); X[B+2]=EX(X[B+2]); X[B+3]=EX(X[B+3]); PIN(X); SBAR(); }while(0)
  #define VRD(i) do{ vlo[i]=vtr(vp_+(((i)>>2)*4096+((i)&3)*1024)); vhi[i]=vtr(vp_+(((i)>>2)*4096+((i)&3)*1024+512)); }while(0)
  #define KRD(G,j) do{ if(G){ kload2(kf,kp0+sl_next,j); SBAR(); } }while(0)
  #define STEP(C0,C1,P0,P1,t,GK,GV,GL) do{ SBAR(); \
    const lds_cptr vp_=vp0+sl_prev; \
    VRD(0); SBAR(); float sacc=(P0[0]+P0[1]); \
    GAPA(C0=__builtin_amdgcn_mfma_f32_32x32x16_bf16(kf[0],qr[0],negm,0,0,0), P0[2],P0[3],P0[4],P0[5],     pw0[0]=PKW(P0,0), pw0[1]=PKW(P0,2), pw0); \
    VRD(4); SBAR(); GAPA(C1=__builtin_amdgcn_mfma_f32_32x32x16_bf16(kf[1],qr[0],negm,0,0,0), P0[6],P0[7],P0[8],P0[9],     pw0[2]=PKW(P0,4), pw0[3]=PKW(P0,6), pw0); \
    VRD(1); SBAR(); GAPA(C0=__builtin_amdgcn_mfma_f32_32x32x16_bf16(kf[2],qr[1],C0,0,0,0),   P0[10],P0[11],P0[12],P0[13], pw1[0]=PKW(P0,8), pw1[1]=PKW(P0,10), pw1); \
    VRD(5); SBAR(); GAPA(C1=__builtin_amdgcn_mfma_f32_32x32x16_bf16(kf[3],qr[1],C1,0,0,0),   P0[14],P0[15],P1[0],P1[1],   pw1[2]=PKW(P0,12),pw1[3]=PKW(P0,14), pw1); \
    VRD(2); SBAR(); GAPA(C0=__builtin_amdgcn_mfma_f32_32x32x16_bf16(kf[4],qr[2],C0,0,0,0),   P1[2],P1[3],P1[4],P1[5],     pw2[0]=PKW(P1,0), pw2[1]=PKW(P1,2), pw2); \
    VRD(6); SBAR(); GAPA(C1=__builtin_amdgcn_mfma_f32_32x32x16_bf16(kf[5],qr[2],C1,0,0,0),   P1[6],P1[7],P1[8],P1[9],     pw2[2]=PKW(P1,4), pw2[3]=PKW(P1,6), pw2); \
    VRD(3); SBAR(); GAPA(C0=__builtin_amdgcn_mfma_f32_32x32x16_bf16(kf[6],qr[3],C0,0,0,0),   P1[10],P1[11],P1[12],P1[13], pw3[0]=PKW(P1,8), pw3[1]=PKW(P1,10), pw3); \
    VRD(7); SBAR(); GAPA(C1=__builtin_amdgcn_mfma_f32_32x32x16_bf16(kf[7],qr[3],C1,0,0,0),   P1[14],P1[15],0.f,0.f,       pw3[2]=PKW(P1,12),pw3[3]=PKW(P1,14), pw3); \
    l_reg+=sacc; \
    if(GK){DMA_K((t)+3,sl_cur);} if(GV){DMA_V((t)+1,sl_next);} \
    CMASK(C0,C1,t); \
    { float a=MX3(C0[0],C0[1],C1[0]),b=MX3(C0[2],C0[3],C1[1]); a=MX3(a,C1[2],C1[3]); \
      _Pragma("unroll") for(int r=4;r<16;r+=4){a=MX3(a,C0[r],C0[r+1]);b=MX3(b,C0[r+2],C0[r+3]);a=MX3(a,C1[r],C1[r+1]);b=MX3(b,C1[r+2],C1[r+3]);} \
      float rm=__builtin_fmaxf(a,b); { auto rr=__builtin_amdgcn_permlane32_swap(__float_as_uint(rm),__float_as_uint(rm),false,false); rm=__builtin_fmaxf(__uint_as_float(rr[0]),__uint_as_float(rr[1])); } \
      resc=false; \
      if(__builtin_expect(__any(rm>(float)THRL),0)){ const float dl=__builtin_fmaxf(rm,0.f); mhat+=dl; \
        _Pragma("unroll") for(int r=0;r<16;++r){C0[r]-=dl;C1[r]-=dl;} \
        _Pragma("unroll") for(int r=0;r<16;++r)negm[r]=-mhat; asm volatile("":"+v"(negm)); \
        const float f=__builtin_amdgcn_exp2f(-dl); l_reg*=f; if(hi==0)wsf[r32]=f; resc=true; } } \
    SBAR(); \
    GAPB(o[0]=__builtin_amdgcn_mfma_f32_32x32x16_bf16(PAF(0),VFR(0),o[0],0,0,0), C0,0); \
    GAPB(o[1]=__builtin_amdgcn_mfma_f32_32x32x16_bf16(PAF(0),VFR(4),o[1],0,0,0), C0,4); \
    KRD(GL,0); GAPB(o[0]=__builtin_amdgcn_mfma_f32_32x32x16_bf16(PAF(1),VFR(1),o[0],0,0,0), C0,8); \
    KRD(GL,1); GAPB(o[1]=__builtin_amdgcn_mfma_f32_32x32x16_bf16(PAF(1),VFR(5),o[1],0,0,0), C0,12); \
    KRD(GL,2); GAPB(o[0]=__builtin_amdgcn_mfma_f32_32x32x16_bf16(PAF(2),VFR(2),o[0],0,0,0), C1,0); \
    KRD(GL,3); GAPB(o[1]=__builtin_amdgcn_mfma_f32_32x32x16_bf16(PAF(2),VFR(6),o[1],0,0,0), C1,4); \
    GAPB(o[0]=__builtin_amdgcn_mfma_f32_32x32x16_bf16(PAF(3),VFR(3),o[0],0,0,0), C1,8); \
    GAPB(o[1]=__builtin_amdgcn_mfma_f32_32x32x16_bf16(PAF(3),VFR(7),o[1],0,0,0), C1,12); \
    }while(0)
  int t=1;
  #undef CMASK
  #define CMASK(P0,P1,t) do{}while(0)
  for(;t+5<NT;t+=2){
    STEP(pB0,pB1,pA0,pA1,t,true,true,true);     WAIT_BAR(2); RESC(); ROT();
    STEP(pA0,pA1,pB0,pB1,t+1,true,true,true);   WAIT_BAR(2); RESC(); ROT();
  }
  #undef CMASK
  #define CMASK(P0,P1,t) do{}while(0)
  #define ENDW(tt) do{ if((tt)+3<NT){WAIT_BAR(2);} else if((tt)+2<NT){WAIT_BAR(1);} else {WAIT_BAR(0);} }while(0)
  for(;t+1<NT;t+=2){
    STEP(pB0,pB1,pA0,pA1,t,(t+3<NT),(t+1<NT),(t+1<NT));       ENDW(t);   RESC(); ROT();
    STEP(pA0,pA1,pB0,pB1,t+1,(t+4<NT),(t+2<NT),(t+2<NT));     ENDW(t+1); RESC(); ROT();
  }
  STEP(pB0,pB1,pA0,pA1,NT-1,false,false,false); RESC();
  { float sacc=pB0[0]+pB0[1]; _Pragma("unroll") for(int r=2;r<16;++r)sacc+=pB0[r]; _Pragma("unroll") for(int r=0;r<16;++r)sacc+=pB1[r]; l_reg+=sacc;
    pw0=(u32x4){PKW(pB0,0),PKW(pB0,2),PKW(pB0,4),PKW(pB0,6)};pw1=(u32x4){PKW(pB0,8),PKW(pB0,10),PKW(pB0,12),PKW(pB0,14)};pw2=(u32x4){PKW(pB1,0),PKW(pB1,2),PKW(pB1,4),PKW(pB1,6)};pw3=(u32x4){PKW(pB1,8),PKW(pB1,10),PKW(pB1,12),PKW(pB1,14)};
    SBAR(); pv(o,vb0+sl_cur,PAF(0),PAF(1),PAF(2),PAF(3)); }
  #undef PKW
  #undef PAF
  #undef VFR
  #undef PIN
  #undef MX3
  #undef GAPA
  #undef GAPB
  #undef EX
  #undef VRD
  #undef KRD
  #undef STEP
  #undef ENDW
  {auto rr=__builtin_amdgcn_permlane32_swap(__float_as_uint(l_reg),__float_as_uint(l_reg),false,false);l_reg=__uint_as_float(rr[0])+__uint_as_float(rr[1]);}
  if(hi==0)wsf[32+r32]=l_reg;asm volatile("s_waitcnt lgkmcnt(0)":::"memory");
  float rli[16];
  #pragma unroll
  for(int r=0;r<16;++r)rli[r]=__builtin_amdgcn_rcpf(wsf[32+crow(r,hi)]);
  bf16*Ow=O+(rowbase+q0+wid*QBLK)*PO+h*D;
  { bf16*stg=(bf16*)(shm+LDS_OST)+wid*2048;
    #pragma unroll
    for(int r=0;r<16;++r){const int orow=crow(r,hi);
      #pragma unroll
      for(int d0=0;d0<2;++d0)stg[orow*64+d0*32+r32]=__float2bfloat16(o[d0][r]*rli[r]);}
    asm volatile("s_waitcnt lgkmcnt(0)":::"memory");
    #pragma unroll
    for(int i=0;i<4;++i){const int row=i*8+(lane>>3),ch=lane&7; const u32x4 v=*(const u32x4*)(stg+row*64+ch*8); ATTN_STORE16(Ow+(long)row*PO+ch*8,v);} }
  asm volatile("s_waitcnt lgkmcnt(0)\n\ts_barrier":::"memory");
  #undef DMA_K
  #undef DMA_V
  #undef CMASK
  #undef START
  #undef RESC
  #undef ROT
}
constexpr int ATTN_LDS_BYTES=LDS_BYTES;
struct AttnTensors { const bf16* Q; const bf16* K; const bf16* V; bf16* O; };
struct AttnUnit { int b; int h; int qb; };
struct StaticOrder {
  int vcu, G;
  __device__ __forceinline__ explicit StaticOrder(int grid,int block):vcu((grid%8==0)?(block%8)*(grid/8)+block/8:block),G(grid){}
  __device__ __forceinline__ bool next(int i,AttnUnit&u)const{ const int L=i*G+vcu; if(L>=BATCH*NHEAD*(SEQ/QB))return false; const int grp=L>>5,r=L&31; u.b=grp>>1; u.h=(grp&1)*4+(r>>3); u.qb=r&7; return true; }
  __device__ __forceinline__ void a_ready(const AttnUnit&)const{}
  __device__ __forceinline__ void done(const AttnUnit&)const{}
};
template<class Sched,int THRL=8> __device__ __forceinline__ void attn_phase(char*lds,const AttnTensors&T,const Sched&S){
  AttnUnit u;
  for(int i=0;S.next(i,u);++i){ S.a_ready(u); attn_unit<THRL>(u.b,u.h,u.qb,T.Q,T.K,T.V,T.O,lds); S.done(u); }
}
#undef SBAR
#undef WAIT_BAR
}


#define GAS __attribute__((address_space(1)))
#define LAS __attribute__((address_space(3)))
typedef unsigned short bf16;
typedef unsigned v4u __attribute__((ext_vector_type(4)));
typedef float f32x4 __attribute__((ext_vector_type(4)));
typedef short bf16x8 __attribute__((ext_vector_type(8)));
typedef GAS unsigned gu32;
typedef GAS unsigned long long gu64;
#define RLX_AGENT __ATOMIC_RELAXED, __HIP_MEMORY_SCOPE_AGENT
#define LDS_WAIT() asm volatile("s_waitcnt lgkmcnt(0)" ::: "memory")
#define VM_WAIT() asm volatile("s_waitcnt vmcnt(0)" ::: "memory")
__device__ __forceinline__ unsigned long long rt() { return __builtin_amdgcn_s_memrealtime(); }
__device__ __forceinline__ unsigned f2bf(float f) { unsigned u = __builtin_bit_cast(unsigned, f); return (u + 0x7fffu + ((u >> 16) & 1u)) >> 16; }
__device__ __forceinline__ unsigned pk2(float lo, float hi) { return f2bf(lo) | (f2bf(hi) << 16); }

#define XB_TMO      128
#define XB_XCNT(j)  (256  + 64 * (j))
#define XB_XSUB(j)  (1280 + 64 * (j))
#define XB_XGEN(j)  (2304 + 64 * (j))
#define XB_TOP      3328
#define XB_TOPGEN   3392
#define XCD_BAR_WORDS 3456
#define XB_SPIN_CAP (1u << 18)

__device__ __forceinline__ unsigned xb_ld(unsigned* p)              { return __hip_atomic_load(p, __ATOMIC_RELAXED, __HIP_MEMORY_SCOPE_AGENT); }
__device__ __forceinline__ unsigned xb_add(unsigned* p, unsigned v) { return __hip_atomic_fetch_add(p, v, __ATOMIC_RELAXED, __HIP_MEMORY_SCOPE_AGENT); }
__device__ __forceinline__ unsigned xb_xcc_id() { return (unsigned)__builtin_amdgcn_s_getreg((3 << 11) | 20) & 0xFu; }
#define XB_SPIN(cond, bar) do { unsigned _sp = 0; while (cond) { __builtin_amdgcn_s_sleep(1); \
    if ((++_sp & 255u) == 0u) { if (xb_ld(&(bar)[XB_TMO])) break; if (_sp > XB_SPIN_CAP) { atomicAdd(&(bar)[XB_TMO], 1u); break; } } } } while (0)

struct XcdBarrier {
    unsigned* bar; unsigned x;
    volatile LAS unsigned* st;
};

__device__ __forceinline__ XcdBarrier xcd_barrier_post(unsigned* bar, volatile LAS unsigned* st) {
    XcdBarrier b; b.bar = bar; b.x = xb_xcc_id(); b.st = st;
    if (threadIdx.x == 0) (void)xb_add(&bar[XB_XCNT(b.x)], 1u);
    return b;
}
__device__ __forceinline__ void xcd_barrier_complete(unsigned* bar, unsigned x, unsigned& nloc, unsigned& nx) {
    const unsigned G = gridDim.x * gridDim.y * gridDim.z;
    unsigned sum, cnt, mine, sp = 0u;
    for (;;) {
        sum = 0u; cnt = 0u; mine = 0u;
#pragma unroll
        for (unsigned j = 0; j < 16; ++j) { const unsigned c = xb_ld(&bar[XB_XCNT(j)]); sum += c; cnt += (c > 0u) ? 1u : 0u; mine = (j == x) ? c : mine; }
        if (sum == G) break;
        __builtin_amdgcn_s_sleep(1);
        if ((++sp & 255u) == 0u) { if (xb_ld(&bar[XB_TMO])) break; if (sp > XB_SPIN_CAP) { atomicAdd(&bar[XB_TMO], 1u); break; } }
    }
    nloc = mine > 0u ? mine : 1u; nx = cnt > 0u ? cnt : 1u;
}

__device__ __forceinline__ void xcd_barrier(const XcdBarrier& b) {
    asm volatile("s_waitcnt vmcnt(0)" ::: "memory");
    __syncthreads();
    if (threadIdx.x == 0) {
        unsigned* bar = b.bar;
        __builtin_amdgcn_s_waitcnt(0);
        unsigned nloc = b.st[0], nx = b.st[1];
        if (nloc == 0u) { xcd_barrier_complete(bar, b.x, nloc, nx); b.st[0] = nloc; b.st[1] = nx; }
        const unsigned old = xb_add(&bar[XB_XSUB(b.x)], 1u);
        const unsigned gen = old / nloc;
        if (old + 1u == (gen + 1u) * nloc) {
            __builtin_amdgcn_fence(__ATOMIC_RELEASE, "agent");
            asm volatile("s_waitcnt vmcnt(0)" ::: "memory");
            const unsigned og = xb_add(&bar[XB_TOP], 1u);
            const unsigned tg = og / nx;
            if (og + 1u == (tg + 1u) * nx) xb_add(&bar[XB_TOPGEN], 1u);
            else XB_SPIN(xb_ld(&bar[XB_TOPGEN]) == tg, bar);
            __builtin_amdgcn_fence(__ATOMIC_ACQUIRE, "agent");
            xb_add(&bar[XB_XGEN(b.x)], 1u);
            asm volatile("s_waitcnt vmcnt(0)" ::: "memory");
        } else {
            XB_SPIN(xb_ld(&bar[XB_XGEN(b.x)]) == gen, bar);
            __builtin_amdgcn_fence(__ATOMIC_ACQUIRE, "agent");
            asm volatile("s_waitcnt vmcnt(0)" ::: "memory");
        }
    }
    __syncthreads();
}

constexpr int NWAVES = 8, NTHR = 512;
constexpr int DM = 1024, NB = 8, SEQ = 2048, DEPTH = 4, M = NB * SEQ;
constexpr int DIN = 2320, NPROJ = 2304;
constexpr int C_Q = 0, C_K = 512, C_V = 640, C_LX = 768, C_LG = 1024, C_MQ = 1280, C_MK = 1536, C_MV = 1792, C_MO = 2048;
constexpr int NE = 16, CAP = 256, DE = 2048, NSLOT = NB * CAP;
constexpr float EPS = 1e-6f;
constexpr int NPH = 1 + 10 * DEPTH;

constexpr size_t MiB = 1u << 20;
constexpr size_t WS_CTL = 0, CTL_ZERO_BYTES = 1 * MiB;
constexpr size_t WS_ROPE = 1 * MiB;
constexpr size_t WS_LRUW = 2 * MiB;
constexpr size_t WS_WIN = 4 * MiB;
constexpr size_t WS_WOUT = 22 * MiB;
constexpr size_t WS_WGU = 32 * MiB;
constexpr size_t WS_WDN = 544 * MiB;
constexpr size_t WS_H = 800 * MiB;
constexpr size_t WS_PROJ = 832 * MiB;
constexpr size_t WS_Y = 904 * MiB;
constexpr size_t WS_MG = 936 * MiB;
constexpr size_t WS_AFF = 937 * MiB;
constexpr size_t WS_SEL = 938 * MiB;
constexpr size_t WS_IDX = 939 * MiB;
constexpr size_t WS_GATE = WS_IDX + 128 * 1024;
constexpr size_t WS_LH = 940 * MiB;
constexpr size_t WS_CP = 956 * MiB;
constexpr size_t WS_CARRY = 972 * MiB;
constexpr size_t WS_CLOC = 974 * MiB;
constexpr size_t WS_NLOC = 990 * MiB;
constexpr size_t WS_MLOC = WS_NLOC + 512 * 1024;
constexpr size_t WS_XG = 992 * MiB;
constexpr size_t WS_HID = 1056 * MiB;
constexpr size_t WS_YE = 1184 * MiB;
constexpr size_t WS_END = 1248 * MiB;
constexpr int CW_BAR = 4096;

constexpr int RING_OFF = 0, RING_BYTES = 143360;
constexpr int MISC_OFF = RING_BYTES;
constexpr int LDS_BYTES = 147456;

typedef unsigned u32x2 __attribute__((ext_vector_type(2)));
__device__ __forceinline__ float bf2f(unsigned short v) { return __uint_as_float(((unsigned)v) << 16); }
__device__ __forceinline__ float bflo(unsigned v) { return __uint_as_float(v << 16); }
__device__ __forceinline__ float bfhi(unsigned v) { return __uint_as_float(v & 0xffff0000u); }
__device__ __forceinline__ float wave_sum(float v) {
#pragma unroll
    for (int o = 1; o < 64; o <<= 1) v += __shfl_xor(v, o);
    return v;
}
__device__ __forceinline__ float wave_max(float v) {
#pragma unroll
    for (int o = 1; o < 64; o <<= 1) v = fmaxf(v, __shfl_xor(v, o));
    return v;
}
__device__ __forceinline__ float sigmoid_f(float x) { return 1.0f / (1.0f + expf(-x)); }
__device__ __forceinline__ float logsig_f(float x) { return fminf(x, 0.f) - log1pf(expf(-fabsf(x))); }
__device__ __forceinline__ float gelu_tanh_f(float x) { const float u = 0.7978845608028654f * (x + 0.044715f * x * x * x); return 0.5f * x * (1.0f + tanhf(u)); }
template <bool MAXOP, bool REV> __device__ __forceinline__ void wave_scan128(const LAS float* in, LAS float* out, int lane) {
    const int j0 = REV ? 127 - 2 * lane : 2 * lane, j1 = REV ? 126 - 2 * lane : 2 * lane + 1;
    const float a = in[j0], b = in[j1];
    const float s1 = MAXOP ? fmaxf(a, b) : a + b;
    float incl = s1;
#pragma unroll
    for (int o = 1; o < 64; o <<= 1) { const float t = __shfl_up(incl, o); if (lane >= o) incl = MAXOP ? fmaxf(incl, t) : incl + t; }
    const float ex = __shfl_up(incl, 1);
    const float e = (lane == 0) ? (MAXOP ? -INFINITY : 0.f) : ex;
    out[j0] = MAXOP ? fmaxf(e, a) : e + a; out[j1] = MAXOP ? fmaxf(e, s1) : e + s1;
}
#define WAVE_LDS_FENCE() asm volatile("s_waitcnt lgkmcnt(0)" ::: "memory")
#define MFMA16(a, b, c) __builtin_amdgcn_mfma_f32_16x16x32_bf16((a), (b), (c), 0, 0, 0)
#define WG_SYNC() __syncthreads()

struct Args { const float* in[22]; float* out; unsigned char* ws; int ph_lo, ph_hi, li, pad; };
enum { I_X = 0, I_N1G, I_WIN, I_QG, I_KG, I_CW, I_CB, I_WA, I_BA, I_WX, I_BX, I_LAM, I_FB, I_MNG, I_AOG, I_LOG, I_WOUT, I_N2G, I_WR, I_WG, I_WU, I_WD };

__device__ __forceinline__ void cvt_item(const float* __restrict__ src, int N, int k0, int n0, bf16* dst, int Kd, LAS float* scr, int lane) {
#pragma unroll 16
    for (int i = 0; i < 64; ++i) scr[i * 65 + lane] = src[(size_t)(k0 + i) * N + n0 + lane];
    LDS_WAIT(); asm volatile("" ::: "memory");
    const int c = lane >> 3, nn = lane & 7;
#pragma unroll
    for (int j = 0; j < 8; ++j) { const int n = nn + 8 * j; const LAS float* s = scr + (8 * c) * 65 + n;
        v4u o; o.x = pk2(s[0], s[65]); o.y = pk2(s[130], s[195]); o.z = pk2(s[260], s[325]); o.w = pk2(s[390], s[455]);
        *(GAS v4u*)(dst + (size_t)n * Kd + 8 * c) = o; }
    LDS_WAIT(); asm volatile("" ::: "memory");
}
__device__ __forceinline__ void cvt_item8(const float* __restrict__ src, int N, int k0, int n0, unsigned char* dst, int Kd, LAS float* scr, int lane) {
#pragma unroll 16
    for (int i = 0; i < 64; ++i) { const int kk = 2 * i + (lane >> 5); scr[kk * 33 + (lane & 31)] = src[(size_t)(k0 + kk) * N + n0 + (lane & 31)]; }
    LDS_WAIT(); asm volatile("" ::: "memory");
    const int c = lane >> 3, nn = lane & 7; constexpr float sc = pg8::WSCALE;
#pragma unroll
    for (int j = 0; j < 4; ++j) { const int n = nn + 8 * j; const LAS float* s = scr + (16 * c) * 33 + n;
        v4u o; o.x = pg8::pk4_fp8(s[0] * sc, s[33] * sc, s[66] * sc, s[99] * sc); o.y = pg8::pk4_fp8(s[132] * sc, s[165] * sc, s[198] * sc, s[231] * sc);
        o.z = pg8::pk4_fp8(s[264] * sc, s[297] * sc, s[330] * sc, s[363] * sc); o.w = pg8::pk4_fp8(s[396] * sc, s[429] * sc, s[462] * sc, s[495] * sc);
        *(GAS v4u*)(dst + (size_t)n * Kd + 16 * c) = o; }
    LDS_WAIT(); asm volatile("" ::: "memory");
}
__device__ __forceinline__ void p0_weights(const Args& a, LAS unsigned char* lds, int tid, int lane, int wave, int G, int bid) {
    unsigned char* ws = a.ws;
    LAS float* scr = (LAS float*)(lds + RING_OFF + wave * 16896);
    const int gw = bid * NWAVES + wave, NGW = G * NWAVES;
    constexpr int I_IN = 16 * 36, I_OUT = 16 * 16, I_EXP = 1536, PER_LAYER = I_IN + I_OUT + NE * I_EXP, NITEMS = DEPTH * PER_LAYER;
    for (int it = gw; it < NITEMS; it += NGW) {
        const int l = it / PER_LAYER; int r = it - l * PER_LAYER;
        if (r < I_IN) { const int kb = r / 36, nb = r - kb * 36;
            cvt_item(a.in[I_WIN] + (size_t)l * DM * DIN, DIN, 64 * kb, 64 * nb, (bf16*)(ws + WS_WIN) + ((size_t)l * NPROJ + 64 * nb) * DM + 64 * kb, DM, scr, lane); continue; }
        r -= I_IN;
        if (r < I_OUT) { const int kb = r >> 4, nb = r & 15;
            cvt_item(a.in[I_WOUT] + (size_t)l * DM * DM, DM, 64 * kb, 64 * nb, (bf16*)(ws + WS_WOUT) + ((size_t)l * DM + 64 * nb) * DM + 64 * kb, DM, scr, lane); continue; }
        r -= I_OUT;
        const int e = r / I_EXP; int r2 = r - e * I_EXP; const size_t le = (size_t)l * NE + e;
        LAS float* scr8 = (LAS float*)(lds + RING_OFF + wave * 16896);
        if (r2 < 1024) { const int up = r2 >> 9; r2 &= 511; const int kb = r2 >> 6, nb = r2 & 63, n0 = 32 * nb, drow = 256 * (n0 >> 7) + (n0 & 127) + 128 * up;
            cvt_item8(a.in[up ? I_WU : I_WG] + le * DM * DE, DE, 128 * kb, n0, ws + WS_WGU + (le * 4096 + drow) * DM + 128 * kb, DM, scr8, lane); continue; }
        r2 -= 1024; { const int kb = r2 >> 5, nb = r2 & 31;
            cvt_item8(a.in[I_WD] + le * DE * DM, DM, 128 * kb, 32 * nb, ws + WS_WDN + (le * DM + 32 * nb) * DE + 128 * kb, DE, scr8, lane); }
    }
    const int gt = bid * NTHR + tid, GT = G * NTHR;
    bf16* lw = (bf16*)(ws + WS_LRUW);
    for (int i = gt; i < DEPTH * 2 * 2 * 4 * 4096; i += GT) { const int d = i & 63, e = (i >> 6) & 63, n = (i >> 12) & 3, gate = (i >> 14) & 1, dir = (i >> 15) & 1, l = i >> 16;
        const float* src = a.in[gate ? I_WX : I_WA]; lw[i] = (bf16)f2bf(src[((((size_t)l * 2 + dir) * 4 + n) * 64 + d) * 64 + e]); }
    float* rc = (float*)(ws + WS_ROPE); float* rs = rc + SEQ * 32;
    for (int i = gt; i < SEQ * 32; i += GT) { const int s = i >> 5, j = i & 31, f = j & 15; const float pos = (float)((j < 16) ? (s >> 6) : (s & 63));
        const float inv = 1.0f / powf(10000.0f, (float)f * (1.0f / 16.0f)); const float ang = pos * inv; rc[i] = cosf(ang); rs[i] = sinf(ang); }
}

template <int MODE>
__device__ __forceinline__ void row_pass(const float* xin, float* xout, const float* gain, const float* WT  , int sk, bf16* H, float* O16, const int* SEL, const bf16* YE,
                                         LAS unsigned char* lds, int tid, int lane, int wave, int G, int bid) {
    constexpr int WLS = 1028;
    LAS float* wl = (LAS float*)(lds + RING_OFF);
    if (MODE != 3) { float wv[32];
#pragma unroll
        for (int q = 0; q < 32; ++q) { const int i = tid + q * NTHR; wv[q] = WT[(size_t)(i >> 4) * sk + (i & 15)]; }
#pragma unroll
        for (int q = 0; q < 32; ++q) { const int i = tid + q * NTHR; wl[(i & 15) * WLS + (i >> 4)] = wv[q]; } }
    WG_SYNC();
    const int gw = bid * NWAVES + wave, NGW = G * NWAVES;
    for (int m0 = 2 * gw; m0 < M; m0 += 2 * NGW) {
        asm volatile("" ::: "memory");
        f32x4 v[2][4];
#pragma unroll
        for (int r = 0; r < 2; ++r)
#pragma unroll
            for (int j = 0; j < 4; ++j) v[r][j] = *((const f32x4*)(xin + (size_t)(m0 + r) * DM) + 64 * j + lane);
        if (MODE >= 2) {
            const int b = m0 >> 11; int selv[2]; unsigned long long mk[2];
#pragma unroll
            for (int r = 0; r < 2; ++r) { selv[r] = (lane < NE) ? SEL[(size_t)(m0 + r) * NE + lane] : -1; }
#pragma unroll
            for (int r = 0; r < 2; ++r) mk[r] = __ballot(selv[r] >= 0);
            while (mk[0] | mk[1]) {
                u32x2 q[2][2][4]; float wt[2][2];
#pragma unroll
                for (int r = 0; r < 2; ++r)
#pragma unroll
                    for (int i = 0; i < 2; ++i) { const bf16* yr = YE; wt[r][i] = 0.f;
                        if (mk[r]) { const int e = __builtin_ctzll(mk[r]); mk[r] &= mk[r] - 1ull; const int sl = __builtin_amdgcn_readlane(selv[r], e);
                            yr = YE + ((size_t)e * NSLOT + b * CAP + sl) * DM; wt[r][i] = 1.f; }
#pragma unroll
                        for (int j = 0; j < 4; ++j) q[r][i][j] = *((const u32x2*)yr + 64 * j + lane); }
#pragma unroll
                for (int r = 0; r < 2; ++r)
#pragma unroll
                    for (int i = 0; i < 2; ++i)
#pragma unroll
                        for (int j = 0; j < 4; ++j) { const u32x2 w = q[r][i][j]; const float t = wt[r][i];
                            v[r][j][0] += t * bflo(w.x); v[r][j][1] += t * bfhi(w.x); v[r][j][2] += t * bflo(w.y); v[r][j][3] += t * bfhi(w.y); }
            }
#pragma unroll
            for (int r = 0; r < 2; ++r)
#pragma unroll
                for (int j = 0; j < 4; ++j) *((f32x4*)(xout + (size_t)(m0 + r) * DM) + 64 * j + lane) = v[r][j];
        }
        if (MODE == 3) continue;
        float ss[2];
#pragma unroll
        for (int r = 0; r < 2; ++r) { float a = 0.f;
#pragma unroll
            for (int j = 0; j < 4; ++j) a += (v[r][j][0] * v[r][j][0] + v[r][j][1] * v[r][j][1]) + (v[r][j][2] * v[r][j][2] + v[r][j][3] * v[r][j][3]);
            ss[r] = a; }
#pragma unroll
        for (int o = 1; o < 64; o <<= 1) { ss[0] += __shfl_xor(ss[0], o); ss[1] += __shfl_xor(ss[1], o); }
#pragma unroll
        for (int r = 0; r < 2; ++r) { const float rstd = 1.0f / sqrtf(ss[r] * (1.0f / DM) + EPS);
#pragma unroll
            for (int j = 0; j < 4; ++j) { const f32x4 gq = *((const f32x4*)gain + 64 * j + lane); v[r][j] = v[r][j] * rstd * gq;
                if (MODE == 1) { *((unsigned*)((unsigned char*)H + (size_t)(m0 + r) * DM) + 64 * j + lane) = pg8::pk4_fp8(v[r][j][0], v[r][j][1], v[r][j][2], v[r][j][3]); }
                else { u32x2 o; o.x = pk2(v[r][j][0], v[r][j][1]); o.y = pk2(v[r][j][2], v[r][j][3]); *((u32x2*)(H + (size_t)(m0 + r) * DM) + 64 * j + lane) = o; } } }
        float p[2][16];
#pragma unroll
        for (int jj = 0; jj < 16; ++jj) { float a0 = 0.f, a1 = 0.f;
#pragma unroll
            for (int j = 0; j < 4; ++j) { const f32x4 w = *((LAS f32x4*)(wl + jj * WLS) + 64 * j + lane);
                a0 += (v[0][j][0] * w[0] + v[0][j][1] * w[1]) + (v[0][j][2] * w[2] + v[0][j][3] * w[3]);
                a1 += (v[1][j][0] * w[0] + v[1][j][1] * w[1]) + (v[1][j][2] * w[2] + v[1][j][3] * w[3]); }
            p[0][jj] = a0; p[1][jj] = a1; }
#pragma unroll
        for (int o = 1; o < 64; o <<= 1)
#pragma unroll
            for (int jj = 0; jj < 16; ++jj) { p[0][jj] += __shfl_xor(p[0][jj], o); p[1][jj] += __shfl_xor(p[1][jj], o); }
#pragma unroll
        for (int r = 0; r < 2; ++r) { const int m = m0 + r;
            if (MODE == 1) {
                float mx = p[r][0];
#pragma unroll
                for (int jj = 1; jj < 16; ++jj) mx = fmaxf(mx, p[r][jj]);
                float sum = 0.f;
#pragma unroll
                for (int jj = 0; jj < 16; ++jj) { p[r][jj] = expf(p[r][jj] - mx); sum += p[r][jj]; }
                float mine = 0.f;
#pragma unroll
                for (int jj = 0; jj < 16; ++jj) mine = (lane == jj) ? p[r][jj] : mine;
                if (lane < 16) O16[(((size_t)(m >> 11) * NE + lane) << 11) + (m & 2047)] = mine / sum;
            } else {
                float mine = 0.f;
#pragma unroll
                for (int jj = 0; jj < 16; ++jj) mine = (lane == jj) ? p[r][jj] : mine;
                if (lane < 16) O16[(size_t)m * 16 + lane] = mine;
            } }
    }
}

__device__ __forceinline__ void rope_pass(const Args& a, int l, int lane, int wave, int G, int bid, bf16* DST) {
    bf16* PROJ = (bf16*)(a.ws + WS_PROJ); const float* rc = (const float*)(a.ws + WS_ROPE); const float* rs = rc + SEQ * 32;
    const float* qg = a.in[I_QG] + l * 64; const float* kg = a.in[I_KG] + l * 64;
    const int gw = bid * NWAVES + wave, NGW = G * NWAVES, j = lane & 31;
    const float qg1 = qg[j], qg2 = qg[32 + j], kg1 = kg[j], kg2 = kg[32 + j];
    for (int mb = 2 * gw; mb < M; mb += 2 * NGW) {
        float x1[2][5], x2[2][5], cs[2], sn[2];
#pragma unroll
        for (int r = 0; r < 2; ++r) { const bf16* row = PROJ + (size_t)(mb + r) * NPROJ; const int s = (mb + r) & 2047; cs[r] = rc[s * 32 + j]; sn[r] = rs[s * 32 + j];
#pragma unroll
            for (int it = 0; it < 5; ++it) { const int hh = 2 * it + (lane >> 5); x1[r][it] = bf2f(row[hh * 64 + j]); x2[r][it] = bf2f(row[hh * 64 + 32 + j]); } }
#pragma unroll
        for (int r = 0; r < 2; ++r) { bf16* row = DST + (size_t)(mb + r) * NPROJ;
#pragma unroll
            for (int it = 0; it < 5; ++it) { const int hh = 2 * it + (lane >> 5);
                float ss = x1[r][it] * x1[r][it] + x2[r][it] * x2[r][it];
#pragma unroll
                for (int o = 1; o < 32; o <<= 1) ss += __shfl_xor(ss, o);
                const float rstd = 1.0f / sqrtf(ss * (1.0f / 64.0f) + EPS);
                const float n1 = x1[r][it] * rstd * (it < 4 ? qg1 : kg1), n2 = x2[r][it] * rstd * (it < 4 ? qg2 : kg2);
                float o1 = n1 * cs[r] - n2 * sn[r], o2 = n2 * cs[r] + n1 * sn[r];
                if (it < 4) { o1 *= attn_body::C2; o2 *= attn_body::C2; }
                row[hh * 64 + j] = (bf16)f2bf(o1); row[hh * 64 + 32 + j] = (bf16)f2bf(o2); } }
    }
}

constexpr int XS = 260;
__device__ __forceinline__ void lru_a_unit(const Args& a, int l, int unit, LAS unsigned char* lds, int tid, int lane, int wave) {
    const int b = unit >> 6, c32 = unit & 63, t0 = c32 * 32; const size_t m0 = (size_t)b * SEQ + t0;
    LAS float* XC = (LAS float*)(lds + RING_OFF); LAS float* AA = XC + 32 * XS; LAS float* UU = AA + 32 * XS;
    const bf16* PROJ = (const bf16*)(a.ws + WS_PROJ);
    {
        const int ch2 = tid & 127, rg = tid >> 7, ch = 2 * ch2;
        float x0[11], x1[11];
#pragma unroll
        for (int i = 0; i < 11; ++i) { const int s = t0 + rg * 8 - 2 + i; unsigned v = 0u;
            if (s >= 0 && s < SEQ) v = *(const unsigned*)(PROJ + ((size_t)b * SEQ + s) * NPROJ + C_LX + ch);
            x0[i] = bflo(v); x1[i] = bfhi(v); }
        const float* cw = a.in[I_CW] + (size_t)l * 4 * 256; const float* cb = a.in[I_CB] + (size_t)l * 256;
        float w0[4], w1[4];
#pragma unroll
        for (int j = 0; j < 4; ++j) { w0[j] = cw[j * 256 + ch]; w1[j] = cw[j * 256 + ch + 1]; }
        const float b0 = cb[ch], b1 = cb[ch + 1];
#pragma unroll
        for (int r = 0; r < 8; ++r) { float y0 = b0, y1 = b1;
#pragma unroll
            for (int j = 0; j < 4; ++j) { y0 += x0[r + j] * w0[j]; y1 += x1[r + j] * w1[j]; }
            XC[(rg * 8 + r) * XS + ch] = y0; XC[(rg * 8 + r) * XS + ch + 1] = y1; }
    }
    WG_SYNC();
    const int n = wave >> 1, hh = wave & 1, li = lane & 15, g = lane >> 4;
    bf16* LH = (bf16*)(a.ws + WS_LH); bf16* CPb = (bf16*)(a.ws + WS_CP); float* CARRY = (float*)(a.ws + WS_CARRY);
    for (int dir = 0; dir < 2; ++dir) {
        {
            f32x4 accA[2][2], accX[2][2];
#pragma unroll
            for (int i = 0; i < 2; ++i)
#pragma unroll
                for (int j = 0; j < 2; ++j) { accA[i][j] = (f32x4){0.f, 0.f, 0.f, 0.f}; accX[i][j] = (f32x4){0.f, 0.f, 0.f, 0.f}; }
            const bf16* WA = (const bf16*)(a.ws + WS_LRUW) + ((((size_t)l * 2 + dir) * 2 + 0) * 4 + n) * 4096;
            const bf16* WX = (const bf16*)(a.ws + WS_LRUW) + ((((size_t)l * 2 + dir) * 2 + 1) * 4 + n) * 4096;
#pragma unroll
            for (int ks = 0; ks < 2; ++ks) {
                bf16x8 af[2];
#pragma unroll
                for (int mt = 0; mt < 2; ++mt) { const LAS float* p = XC + (16 * mt + li) * XS + 64 * n + 32 * ks + 8 * g;
                    const f32x4 q0 = *(const LAS f32x4*)p, q1 = *(const LAS f32x4*)(p + 4);
                    v4u pk; pk.x = pk2(q0[0], q0[1]); pk.y = pk2(q0[2], q0[3]); pk.z = pk2(q1[0], q1[1]); pk.w = pk2(q1[2], q1[3]); af[mt] = __builtin_bit_cast(bf16x8, pk); }
#pragma unroll
                for (int nt = 0; nt < 2; ++nt) { const int ep = 32 * hh + 16 * nt + li;
                    const bf16x8 ba = *(const bf16x8*)(WA + ep * 64 + 32 * ks + 8 * g), bx = *(const bf16x8*)(WX + ep * 64 + 32 * ks + 8 * g);
#pragma unroll
                    for (int mt = 0; mt < 2; ++mt) { accA[mt][nt] = MFMA16(af[mt], ba, accA[mt][nt]); accX[mt][nt] = MFMA16(af[mt], bx, accX[mt][nt]); } }
            }
#pragma unroll
            for (int nt = 0; nt < 2; ++nt) { const int ch = 64 * n + 32 * hh + 16 * nt + li; const size_t pi = ((size_t)l * 2 + dir) * 256 + ch;
                const float bav = a.in[I_BA][pi], bxv = a.in[I_BX][pi], lam = a.in[I_LAM][pi];
                const float sp = fmaxf(-lam, 0.f) + log1pf(expf(-fabsf(lam)));
#pragma unroll
                for (int mt = 0; mt < 2; ++mt)
#pragma unroll
                    for (int r = 0; r < 4; ++r) { const int t = 16 * mt + 4 * g + r;
                        const float rg_ = sigmoid_f(accA[mt][nt][r] + bav), ig_ = sigmoid_f(accX[mt][nt][r] + bxv);
                        const float la = -8.0f * rg_ * sp; const float av = expf(la);
                        const float uv = sqrtf(-expm1f(2.0f * la)) * (ig_ * XC[t * XS + ch]);
                        AA[t * XS + ch] = av; UU[t * XS + ch] = uv; } }
        }
        WG_SYNC();
        if (tid < 256) { const int ch = tid; float h = 0.f, cp = 1.f;
            bf16* lh = LH + ((size_t)dir * M + m0) * 256 + ch; bf16* cpo = CPb + ((size_t)dir * M + m0) * 256 + ch;
            for (int q = 0; q < 32; ++q) { const int t = dir ? 31 - q : q; const float av = AA[t * XS + ch], uv = UU[t * XS + ch];
                h = av * h + uv; cp *= av; lh[(size_t)t * 256] = (bf16)f2bf(h); cpo[(size_t)t * 256] = (bf16)f2bf(cp); }
            float* cr = CARRY + ((((size_t)dir * NB + b) * 64 + c32) * 2) * 256 + ch; cr[0] = cp; cr[256] = h; }
        WG_SYNC();
    }
}

__device__ __forceinline__ void lru_b_unit(const Args& a, int l, int unit, LAS unsigned char* lds, int tid, int lane, int wave) {
    const int b = unit >> 6, c32 = unit & 63; const size_t m0 = (size_t)b * SEQ + c32 * 32;
    LAS float* CIN = (LAS float*)(lds + RING_OFF);
    const float* CARRY = (const float*)(a.ws + WS_CARRY);
    { const int dir = tid >> 8, ch = tid & 255; const float* cr = CARRY + (((size_t)dir * NB + b) * 64) * 512 + ch; float cin = 0.f;
      const int n = dir ? 63 - c32 : c32;
      for (int base = 0; base < n; base += 16) { float P[16], Hh[16];
#pragma unroll
          for (int i = 0; i < 16; ++i) { const int q = base + i; const bool v = q < n; const int k = v ? (dir ? 63 - q : q) : c32;
              const float p = cr[(size_t)k * 512], h = cr[(size_t)k * 512 + 256]; P[i] = v ? p : 1.f; Hh[i] = v ? h : 0.f; }
#pragma unroll
          for (int i = 0; i < 16; ++i) cin = P[i] * cin + Hh[i]; }
      CIN[tid] = cin; }
    WG_SYNC();
    const bf16* LH = (const bf16*)(a.ws + WS_LH); const bf16* CPb = (const bf16*)(a.ws + WS_CP); const bf16* PROJ = (const bf16*)(a.ws + WS_PROJ); bf16* Y = (bf16*)(a.ws + WS_Y);
    const f32x4 cf = *(const LAS f32x4*)(CIN + 4 * lane), cb = *(const LAS f32x4*)(CIN + 256 + 4 * lane);
    const f32x4 og = *(const f32x4*)(a.in[I_LOG] + (size_t)l * 256 + 4 * lane);
#pragma unroll
    for (int q = 0; q < 4; ++q) { const size_t m = m0 + wave * 4 + q;
        const u32x2 lf = *(const u32x2*)(LH + m * 256 + 4 * lane), pf = *(const u32x2*)(CPb + m * 256 + 4 * lane);
        const u32x2 lb = *(const u32x2*)(LH + ((size_t)M + m) * 256 + 4 * lane), pb = *(const u32x2*)(CPb + ((size_t)M + m) * 256 + 4 * lane);
        const u32x2 gt = *(const u32x2*)(PROJ + m * NPROJ + C_LG + 4 * lane);
        f32x4 h;
        h[0] = (bflo(lf.x) + bflo(pf.x) * cf[0]) + (bflo(lb.x) + bflo(pb.x) * cb[0]);
        h[1] = (bfhi(lf.x) + bfhi(pf.x) * cf[1]) + (bfhi(lb.x) + bfhi(pb.x) * cb[1]);
        h[2] = (bflo(lf.y) + bflo(pf.y) * cf[2]) + (bflo(lb.y) + bflo(pb.y) * cb[2]);
        h[3] = (bfhi(lf.y) + bfhi(pf.y) * cf[3]) + (bfhi(lb.y) + bfhi(pb.y) * cb[3]);
        h[0] *= gelu_tanh_f(bflo(gt.x)); h[1] *= gelu_tanh_f(bfhi(gt.x)); h[2] *= gelu_tanh_f(bflo(gt.y)); h[3] *= gelu_tanh_f(bfhi(gt.y));
        const float ss = wave_sum((h[0] * h[0] + h[1] * h[1]) + (h[2] * h[2] + h[3] * h[3]));
        const float rstd = 1.0f / sqrtf(ss * (1.0f / 256.0f) + EPS);
        u32x2 o; o.x = pk2(h[0] * rstd * og[0], h[1] * rstd * og[1]); o.y = pk2(h[2] * rstd * og[2], h[3] * rstd * og[3]);
        *(u32x2*)(Y + m * DM + 512 + 4 * lane) = o; }
    WG_SYNC();
}

__device__ __forceinline__ void mls_gates(const Args& a, int l, size_t m0, int hd, LAS float* GL, int tid) {
    if (tid < 128) { const float* r = (const float*)(a.ws + WS_MG) + (m0 + tid) * 16; const float* fb = a.in[I_FB] + (size_t)l * 8;
        GL[tid] = logsig_f(r[4 + hd] + fb[hd]); GL[128 + tid] = logsig_f(r[12 + hd] + fb[4 + hd]); GL[256 + tid] = r[hd]; GL[384 + tid] = r[8 + hd]; }
    WG_SYNC();
    if (tid < 64) wave_scan128<false, false>(GL, GL + 512, tid);
    else if (tid < 128) wave_scan128<false, true>(GL + 128, GL + 640, tid - 64);
    WG_SYNC();
}
constexpr int TS = 136;
constexpr int QS_ = 72;

__device__ __forceinline__ void mls_a_unit(const Args& a, int l, int unit, LAS unsigned char* lds, int tid, int lane, int wave) {
    const int c = unit & 15, hd = (unit >> 4) & 3, b = unit >> 6; const size_t m0 = (size_t)b * SEQ + c * 128;
    LAS float* GL = (LAS float*)(lds + RING_OFF);
    LAS float* WW = GL + 768;
    LAS bf16* VT = (LAS bf16*)(lds + RING_OFF + 4096); LAS bf16* KF = VT + 64 * TS; LAS bf16* KB = KF + 64 * TS;
    mls_gates(a, l, m0, hd, GL, tid);
    float* MLOC = (float*)(a.ws + WS_MLOC); float* NLOC = (float*)(a.ws + WS_NLOC); float* CLOC = (float*)(a.ws + WS_CLOC);
    const size_t sbase = ((size_t)b * 4 + hd) * 2;
    if (wave < 2) { const int dir = wave; const float gtot = dir ? GL[640] : GL[512 + 127]; const LAS float* Bc = GL + 512 + 128 * dir; const LAS float* IG = GL + 256 + 128 * dir;
        const float lw0 = gtot - Bc[lane] + IG[lane], lw1 = gtot - Bc[lane + 64] + IG[lane + 64];
        const float mx = wave_max(fmaxf(lw0, lw1));
        WW[dir * 128 + lane] = expf(lw0 - mx); WW[dir * 128 + lane + 64] = expf(lw1 - mx);
        if (lane == 0) { float* o = MLOC + ((sbase + dir) * 16 + c) * 2; o[0] = mx; o[1] = gtot; } }
    WG_SYNC();
    { const int j = tid & 127, part = tid >> 7; const bf16* PROJ = (const bf16*)(a.ws + WS_PROJ);
      const bf16* kp = PROJ + (m0 + j) * NPROJ + C_MK + hd * 64 + 16 * part; const bf16* vp = PROJ + (m0 + j) * NPROJ + C_MV + hd * 64 + 16 * part;
      const v4u k0 = *(const v4u*)kp, k1 = *(const v4u*)(kp + 8), v0 = *(const v4u*)vp, v1 = *(const v4u*)(vp + 8);
      const float wf = WW[j] * 0.125f, wb = WW[128 + j] * 0.125f;
      const unsigned kk[8] = {k0.x, k0.y, k0.z, k0.w, k1.x, k1.y, k1.z, k1.w}; const unsigned vv[8] = {v0.x, v0.y, v0.z, v0.w, v1.x, v1.y, v1.z, v1.w};
#pragma unroll
      for (int q = 0; q < 8; ++q) { const int e0 = 16 * part + 2 * q; const float ka = bflo(kk[q]), kb = bfhi(kk[q]);
          KF[e0 * TS + j] = (bf16)f2bf(ka * wf); KF[(e0 + 1) * TS + j] = (bf16)f2bf(kb * wf);
          KB[e0 * TS + j] = (bf16)f2bf(ka * wb); KB[(e0 + 1) * TS + j] = (bf16)f2bf(kb * wb);
          VT[e0 * TS + j] = (bf16)(vv[q] & 0xffffu); VT[(e0 + 1) * TS + j] = (bf16)(vv[q] >> 16); } }
    WG_SYNC();
    if (tid < 128) { const int dir = tid >> 6, e = tid & 63; const LAS bf16* kr = (dir ? KB : KF) + e * TS; float s = 0.f;
#pragma unroll
        for (int q = 0; q < 16; ++q) { const v4u w = *(const LAS v4u*)(kr + 8 * q); s += ((bflo(w.x) + bfhi(w.x)) + (bflo(w.y) + bfhi(w.y))) + ((bflo(w.z) + bfhi(w.z)) + (bflo(w.w) + bfhi(w.w))); }
        NLOC[((sbase + dir) * 16 + c) * 64 + e] = s; }
    { const int dir = wave >> 2, mt = wave & 3, li = lane & 15, g = lane >> 4; const LAS bf16* KD = dir ? KB : KF;
      f32x4 acc[4];
#pragma unroll
      for (int nt = 0; nt < 4; ++nt) acc[nt] = (f32x4){0.f, 0.f, 0.f, 0.f};
#pragma unroll
      for (int ks = 0; ks < 4; ++ks) { const bf16x8 af = *(const LAS bf16x8*)(VT + (16 * mt + li) * TS + 32 * ks + 8 * g);
#pragma unroll
          for (int nt = 0; nt < 4; ++nt) { const bf16x8 bfv = *(const LAS bf16x8*)(KD + (16 * nt + li) * TS + 32 * ks + 8 * g); acc[nt] = MFMA16(af, bfv, acc[nt]); } }
      float* co = CLOC + ((sbase + dir) * 16 + c) * 4096;
#pragma unroll
      for (int nt = 0; nt < 4; ++nt)
#pragma unroll
          for (int r = 0; r < 4; ++r) co[(16 * mt + 4 * g + r) * 64 + 16 * nt + li] = acc[nt][r]; }
    WG_SYNC();
}

template <int DIR>
__device__ __forceinline__ void mls_dir(f32x4 (&hacc)[4], const LAS bf16* QS, const LAS bf16* KS, const LAS bf16* VT, const LAS bf16* CP, const LAS float* AJ, const LAS float* MM,
                                        const LAS float* INTER, const LAS float* FLOOR, const LAS float* NP, LAS float* rowbuf, int w, int lane) {
    const int li = lane & 15, g = lane >> 4, i = 16 * w + li;
    bf16x8 qf[2];
#pragma unroll
    for (int ks = 0; ks < 2; ++ks) qf[ks] = *(const LAS bf16x8*)(QS + i * QS_ + 32 * ks + 8 * g);
    const float mmi = MM[i];
    float den = 0.f;
    f32x4 out[4];
#pragma unroll
    for (int dt = 0; dt < 4; ++dt) out[dt] = (f32x4){0.f, 0.f, 0.f, 0.f};
#pragma unroll
    for (int kp = 0; kp < 4; ++kp) {
        const bool need = (DIR == 0) ? (2 * kp <= w) : (2 * kp + 1 >= w);
        if (need) {
            f32x4 s0 = (f32x4){0.f, 0.f, 0.f, 0.f}, s1 = (f32x4){0.f, 0.f, 0.f, 0.f};
#pragma unroll
            for (int ks = 0; ks < 2; ++ks) { const bf16x8 k0 = *(const LAS bf16x8*)(KS + (32 * kp + li) * QS_ + 32 * ks + 8 * g), k1 = *(const LAS bf16x8*)(KS + (32 * kp + 16 + li) * QS_ + 32 * ks + 8 * g);
                s0 = MFMA16(k0, qf[ks], s0); s1 = MFMA16(k1, qf[ks], s1); }
            float p[8];
#pragma unroll
            for (int r = 0; r < 4; ++r) { const int j0 = 32 * kp + 4 * g + r, j1 = j0 + 16;
                const bool v0 = (DIR == 0) ? (j0 <= i) : (j0 >= i), v1 = (DIR == 0) ? (j1 <= i) : (j1 >= i);
                const float a0 = v0 ? (AJ[j0] - mmi) : -INFINITY, a1 = v1 ? (AJ[j1] - mmi) : -INFINITY;
                p[r] = s0[r] * 0.125f * expf(a0); p[4 + r] = s1[r] * 0.125f * expf(a1); den += p[r] + p[4 + r]; }
            v4u pk; pk.x = pk2(p[0], p[1]); pk.y = pk2(p[2], p[3]); pk.z = pk2(p[4], p[5]); pk.w = pk2(p[6], p[7]);
            const bf16x8 pf = __builtin_bit_cast(bf16x8, pk);
#pragma unroll
            for (int dt = 0; dt < 4; ++dt) { const LAS bf16* vr = VT + (16 * dt + li) * TS + 32 * kp + 4 * g;
                const u32x2 lo = *(const LAS u32x2*)vr, hi = *(const LAS u32x2*)(vr + 16);
                v4u vk; vk.x = lo.x; vk.y = lo.y; vk.z = hi.x; vk.w = hi.y;
                out[dt] = MFMA16(pf, __builtin_bit_cast(bf16x8, vk), out[dt]); }
        }
    }
    f32x4 qc[4];
#pragma unroll
    for (int dt = 0; dt < 4; ++dt) { qc[dt] = (f32x4){0.f, 0.f, 0.f, 0.f};
#pragma unroll
        for (int ks = 0; ks < 2; ++ks) { const bf16x8 cf = *(const LAS bf16x8*)(CP + (16 * dt + li) * QS_ + 32 * ks + 8 * g); qc[dt] = MFMA16(qf[ks], cf, qc[dt]); } }
    float nq = 0.f;
#pragma unroll
    for (int q = 0; q < 16; ++q) nq += NP[16 * g + q] * bf2f(QS[i * QS_ + 16 * g + q]);
    den += __shfl_xor(den, 16); den += __shfl_xor(den, 32); nq += __shfl_xor(nq, 16); nq += __shfl_xor(nq, 32);
    const float inter = INTER[i]; const float dn = fmaxf(fabsf(den + inter * nq), FLOOR[i]);
    asm volatile("s_waitcnt lgkmcnt(0)" ::: "memory");
    if (g == 0) { rowbuf[li] = inter; rowbuf[16 + li] = 1.0f / dn; }
    asm volatile("s_waitcnt lgkmcnt(0)" ::: "memory");
#pragma unroll
    for (int r = 0; r < 4; ++r) { const float it = rowbuf[4 * g + r], inv = rowbuf[16 + 4 * g + r];
#pragma unroll
        for (int dt = 0; dt < 4; ++dt) hacc[dt][r] += (out[dt][r] + it * qc[dt][r]) * inv; }
    asm volatile("s_waitcnt lgkmcnt(0)" ::: "memory");
}
__device__ __forceinline__ void mls_b_unit(const Args& a, int l, int unit, LAS unsigned char* lds, int tid, int lane, int wave) {
    const int c = unit & 15, hd = (unit >> 4) & 3, b = unit >> 6; const size_t m0 = (size_t)b * SEQ + c * 128;
    LAS float* GL = (LAS float*)(lds + RING_OFF);
    LAS float* AJ = GL + 768;
    LAS float* MMx = AJ + 256;
    LAS float* INT_ = MMx + 256;
    LAS float* FLR = INT_ + 256;
    LAS float* NP = FLR + 256;
    LAS float* COEF = NP + 128;
    LAS float* ROWB = COEF + 32;
    LAS bf16* QS = (LAS bf16*)(lds + RING_OFF + 16384); LAS bf16* KS = QS + 128 * QS_; LAS bf16* VT = KS + 128 * QS_; LAS bf16* CF = VT + 64 * TS; LAS bf16* CB = CF + 64 * QS_;
    mls_gates(a, l, m0, hd, GL, tid);
    const float* MLOC = (const float*)(a.ws + WS_MLOC); const float* NLOC = (const float*)(a.ws + WS_NLOC); const float* CLOC = (const float*)(a.ws + WS_CLOC);
    const size_t sbase = ((size_t)b * 4 + hd) * 2;
    if (wave < 2) {
        const int dir = wave; LAS float* SM = ROWB;
        if (lane < 32) SM[dir * 32 + lane] = MLOC[(sbase + dir) * 32 + lane];
        WAVE_LDS_FENCE();
        const LAS float* sm = SM + dir * 32;
        float m = 0.f;
        if (dir == 0) { for (int k = 0; k < c; ++k) m = fmaxf(sm[2 * k + 1] + m, sm[2 * k]); }
        else { for (int k = 15; k > c; --k) m = fmaxf(sm[2 * k + 1] + m, sm[2 * k]); }
        if (lane < 16) { float gs = 0.f;
            if (dir == 0) { for (int i = lane + 1; i < c; ++i) gs += sm[2 * i + 1]; } else { for (int i = c + 1; i < lane; ++i) gs += sm[2 * i + 1]; }
            const bool valid = dir == 0 ? (lane < c) : (lane > c);
            COEF[16 * dir + lane] = valid ? expf(sm[2 * lane] + gs - m) : 0.f; }
        const LAS float* IG = GL + 256 + 128 * dir; const LAS float* Bc = GL + 512 + 128 * dir;
        LAS float* aj = AJ + 128 * dir; LAS float* mmx = MMx + 128 * dir;
        aj[lane] = IG[lane] - Bc[lane]; aj[lane + 64] = IG[lane + 64] - Bc[lane + 64];
        WAVE_LDS_FENCE();
        if (dir == 0) wave_scan128<true, false>(aj, mmx, lane); else wave_scan128<true, true>(aj, mmx, lane);
        WAVE_LDS_FENCE();
#pragma unroll
        for (int q = 0; q < 2; ++q) { const int j = lane + 64 * q; const float mm = fmaxf(mmx[j], m);
            mmx[j] = mm; INT_[128 * dir + j] = expf(m - mm); FLR[128 * dir + j] = expf(-(Bc[j] + mm)); }
    }
    {
        const int j = tid >> 2, q4 = tid & 3; const bf16* PROJ = (const bf16*)(a.ws + WS_PROJ); const bf16* rp = PROJ + (m0 + j) * NPROJ + hd * 64 + 16 * q4;
        const v4u q0 = *(const v4u*)(rp + C_MQ), q1 = *(const v4u*)(rp + C_MQ + 8), k0 = *(const v4u*)(rp + C_MK), k1 = *(const v4u*)(rp + C_MK + 8), v0 = *(const v4u*)(rp + C_MV), v1 = *(const v4u*)(rp + C_MV + 8);
        *(LAS v4u*)(QS + j * QS_ + 16 * q4) = q0; *(LAS v4u*)(QS + j * QS_ + 16 * q4 + 8) = q1;
        *(LAS v4u*)(KS + j * QS_ + 16 * q4) = k0; *(LAS v4u*)(KS + j * QS_ + 16 * q4 + 8) = k1;
        const unsigned vv[8] = {v0.x, v0.y, v0.z, v0.w, v1.x, v1.y, v1.z, v1.w};
#pragma unroll
        for (int q = 0; q < 8; ++q) { const int d0 = 16 * q4 + 2 * q; VT[d0 * TS + j] = (bf16)(vv[q] & 0xffffu); VT[(d0 + 1) * TS + j] = (bf16)(vv[q] >> 16); }
    }
    WG_SYNC();
    {
        const int idx = tid * 8;
        f32x4 f0 = (f32x4){0.f, 0.f, 0.f, 0.f}, f1 = f0, b0 = f0, b1 = f0;
#pragma unroll
        for (int kb = 0; kb < 2; ++kb) { f32x4 t0[8], t1[8];
#pragma unroll
            for (int q = 0; q < 8; ++q) { const int k = 8 * kb + q; const float* src = CLOC + ((sbase + (k > c ? 1 : 0)) * 16 + k) * 4096 + idx; t0[q] = *(const f32x4*)src; t1[q] = *(const f32x4*)(src + 4); }
#pragma unroll
            for (int q = 0; q < 8; ++q) { const int k = 8 * kb + q; const float cf = COEF[k], cb = COEF[16 + k]; f0 += cf * t0[q]; f1 += cf * t1[q]; b0 += cb * t0[q]; b1 += cb * t1[q]; } }
        { v4u pk; pk.x = pk2(f0[0], f0[1]); pk.y = pk2(f0[2], f0[3]); pk.z = pk2(f1[0], f1[1]); pk.w = pk2(f1[2], f1[3]); *(LAS v4u*)(CF + (idx >> 6) * QS_ + (idx & 63)) = pk; }
        { v4u pk; pk.x = pk2(b0[0], b0[1]); pk.y = pk2(b0[2], b0[3]); pk.z = pk2(b1[0], b1[1]); pk.w = pk2(b1[2], b1[3]); *(LAS v4u*)(CB + (idx >> 6) * QS_ + (idx & 63)) = pk; }
        if (tid < 128) { const int dir = tid >> 6, e = tid & 63; float nv[16]; float s = 0.f;
#pragma unroll
            for (int k = 0; k < 16; ++k) nv[k] = NLOC[((sbase + dir) * 16 + k) * 64 + e];
#pragma unroll
            for (int k = 0; k < 16; ++k) s += COEF[16 * dir + k] * nv[k];
            NP[tid] = s; }
    }
    WG_SYNC();
    f32x4 hacc[4];
#pragma unroll
    for (int dt = 0; dt < 4; ++dt) hacc[dt] = (f32x4){0.f, 0.f, 0.f, 0.f};
    mls_dir<0>(hacc, QS, KS, VT, CF, AJ, MMx, INT_, FLR, NP, ROWB + wave * 32, wave, lane);
    mls_dir<1>(hacc, QS, KS, VT, CB, AJ + 128, MMx + 128, INT_ + 128, FLR + 128, NP + 64, ROWB + wave * 32, wave, lane);
    {
        const int li = lane & 15, g = lane >> 4; const bf16* PROJ = (const bf16*)(a.ws + WS_PROJ); bf16* Y = (bf16*)(a.ws + WS_Y);
        const float* hg = a.in[I_MNG] + ((size_t)l * 4 + hd) * 64;
#pragma unroll
        for (int r = 0; r < 4; ++r) { float ss = (hacc[0][r] * hacc[0][r] + hacc[1][r] * hacc[1][r]) + (hacc[2][r] * hacc[2][r] + hacc[3][r] * hacc[3][r]);
#pragma unroll
            for (int o = 1; o < 16; o <<= 1) ss += __shfl_xor(ss, o);
            const float rstd = 1.0f / sqrtf(ss * (1.0f / 64.0f) + EPS); const size_t m = m0 + 16 * wave + 4 * g + r;
#pragma unroll
            for (int dt = 0; dt < 4; ++dt) { const int d = 16 * dt + li; const float o = bf2f(PROJ[m * NPROJ + C_MO + hd * 64 + d]);
                Y[m * DM + 768 + hd * 64 + d] = (bf16)f2bf(hacc[dt][r] * rstd * hg[d] * sigmoid_f(o)); } }
    }
    WG_SYNC();
}

__device__ __forceinline__ void attnorm_pass(const Args& a, int l, int lane, int wave, int G, int bid, bf16* DST) {
    bf16* Y = (bf16*)(a.ws + WS_Y); const float* gq = a.in[I_AOG] + (size_t)l * 512 + 8 * lane;
    const f32x4 g0 = *(const f32x4*)gq, g1 = *(const f32x4*)(gq + 4);
    const int gw = bid * NWAVES + wave, NGW = G * NWAVES;
    for (int mb = 4 * gw; mb < M; mb += 4 * NGW) { v4u q[4];
#pragma unroll
        for (int r = 0; r < 4; ++r) q[r] = *(const v4u*)(Y + (size_t)(mb + r) * DM + 8 * lane);
        float ss[4];
#pragma unroll
        for (int r = 0; r < 4; ++r) { const float x[8] = {bflo(q[r].x), bfhi(q[r].x), bflo(q[r].y), bfhi(q[r].y), bflo(q[r].z), bfhi(q[r].z), bflo(q[r].w), bfhi(q[r].w)}; float a = 0.f;
#pragma unroll
            for (int i = 0; i < 8; ++i) a += x[i] * x[i];
            ss[r] = a; }
#pragma unroll
        for (int o = 1; o < 64; o <<= 1)
#pragma unroll
            for (int r = 0; r < 4; ++r) ss[r] += __shfl_xor(ss[r], o);
#pragma unroll
        for (int r = 0; r < 4; ++r) { const float rstd = 1.0f / sqrtf(ss[r] * (1.0f / 512.0f) + EPS);
            const float x[8] = {bflo(q[r].x), bfhi(q[r].x), bflo(q[r].y), bfhi(q[r].y), bflo(q[r].z), bfhi(q[r].z), bflo(q[r].w), bfhi(q[r].w)};
            v4u o; o.x = pk2(x[0] * rstd * g0[0], x[1] * rstd * g0[1]); o.y = pk2(x[2] * rstd * g0[2], x[3] * rstd * g0[3]);
            o.z = pk2(x[4] * rstd * g1[0], x[5] * rstd * g1[1]); o.w = pk2(x[6] * rstd * g1[2], x[7] * rstd * g1[3]); *(v4u*)(DST + (size_t)(mb + r) * DM + 8 * lane) = o; } }
}

__device__ __forceinline__ void topk_item(const Args& a, int item, LAS unsigned char* lds, int tid, int lane, int wave) {
    const int unit = item & 127, half = item >> 7, b = unit >> 4, e = unit & 15;
    LAS unsigned long long* KEY = (LAS unsigned long long*)(lds + RING_OFF);
    LAS short* RANK = (LAS short*)(lds + RING_OFF + 16384);
    const float* aff = (const float*)(a.ws + WS_AFF) + ((size_t)b * NE + e) * SEQ;
    { float av[4];
#pragma unroll
      for (int q = 0; q < 4; ++q) av[q] = aff[tid + q * NTHR];
#pragma unroll
      for (int q = 0; q < 4; ++q) { const int s = tid + q * NTHR; KEY[s] = ((unsigned long long)__float_as_uint(av[q]) << 32) | (unsigned)(SEQ - 1 - s); RANK[s] = (short)-1; } }
    WG_SYNC();
    for (int k = 2; k <= SEQ; k <<= 1)
        for (int j = k >> 1; j > 0; j >>= 1) {
            if (j >= 128 && j == (k >> 1)) WG_SYNC();
#pragma unroll
            for (int q = 0; q < 2; ++q) { const int t = tid + q * NTHR; const int i = ((t & ~(j - 1)) << 1) | (t & (j - 1));
                const unsigned long long x = KEY[i], y = KEY[i + j]; const bool up = (i & k) == 0;
                if (up ? (x < y) : (x > y)) { KEY[i] = y; KEY[i + j] = x; } }
            if (j >= 128) WG_SYNC(); else WAVE_LDS_FENCE();
        }
    WG_SYNC();
    if (tid < CAP) RANK[SEQ - 1 - (int)(unsigned)(KEY[tid] & 0xffffffffull)] = (short)tid;
    WG_SYNC();
    int* SEL = (int*)(a.ws + WS_SEL); int* IDX = (int*)(a.ws + WS_IDX); float* GATE = (float*)(a.ws + WS_GATE);
    for (int s = half * 1024 + tid; s < half * 1024 + 1024; s += NTHR) SEL[((size_t)b * SEQ + s) * NE + e] = (int)RANK[s];
    if (tid < 128) { const int t = half * 128 + tid; const unsigned long long kv = KEY[t]; const int s = SEQ - 1 - (int)(unsigned)(kv & 0xffffffffull);
        IDX[e * NSLOT + b * CAP + t] = b * SEQ + s; GATE[e * NSLOT + b * CAP + t] = __uint_as_float((unsigned)(kv >> 32)); }
    const unsigned char* H8 = a.ws + WS_H; unsigned char* XG8 = a.ws + WS_XG;
    { v4u r0[16];
#pragma unroll
      for (int q = 0; q < 16; ++q) { const int t = half * 128 + wave * 16 + q; const int s = SEQ - 1 - (int)(unsigned)(KEY[t] & 0xffffffffull);
          r0[q] = *((const v4u*)(H8 + ((size_t)b * SEQ + s) * DM) + lane); }
#pragma unroll
      for (int q = 0; q < 16; ++q) { const int t = half * 128 + wave * 16 + q; *((v4u*)(XG8 + ((size_t)e * NSLOT + b * CAP + t) * DM) + lane) = r0[q]; } }
    WG_SYNC();
}

#ifndef MK_PER_PHASE
#define MK_PER_PHASE 0
#endif
__global__ void __launch_bounds__(NTHR, 2) hybrid_fwd(Args args) {
    extern __shared__ __attribute__((aligned(16))) unsigned char lds_raw[];
    LAS unsigned char* lds = (LAS unsigned char*)lds_raw;
    volatile LAS unsigned* MISC = (volatile LAS unsigned*)(lds + MISC_OFF);
    const int tid0 = threadIdx.x, G = gridDim.x;
    unsigned char* ws = args.ws;
#define PHASE_IDS() const int tid = ltid(), lane = tid & 63, wave = __builtin_amdgcn_readfirstlane(tid >> 6), bid = lbid(); (void)lane; (void)wave; (void)bid
    gu32* ctl = (gu32*)(ws + WS_CTL);
    for (int u = tid0; u < (LDS_BYTES - MISC_OFF) / 4; u += NTHR) ((LAS unsigned*)(lds + MISC_OFF))[u] = 0u;
    __syncthreads();
    XcdBarrier bar; bar.bar = (unsigned*)(ctl + CW_BAR); bar.x = 0; bar.st = nullptr;
    if (!MK_PER_PHASE) bar = xcd_barrier_post((unsigned*)(ctl + CW_BAR), MISC + 8);
#define GRID_BAR() do { if (!MK_PER_PHASE) { xcd_barrier(bar); if (REP_MASK & (1 << 11)) xcd_barrier(bar); } } while (0)
    const int lo = args.ph_lo, hi = args.ph_hi;
#ifndef PT_MASK
#define PT_MASK 0x7ff
#endif
#define PT_ON(j) (((PT_MASK) >> (j)) & 1)
#ifndef REP_MASK
#define REP_MASK 0
#endif
#define REPS(j) for (int rep_ = 0; rep_ < 1 + (((REP_MASK) >> (j)) & 1); ++rep_)
#define IN(k) (lo <= (k) && (k) < hi)
#define BOTH(k) (IN(k) && IN((k) + 1))

    bf16* Hb = (bf16*)(ws + WS_H); bf16* PROJ = (bf16*)(ws + WS_PROJ); bf16* Yb = (bf16*)(ws + WS_Y);
    float* MG = (float*)(ws + WS_MG); float* AFF = (float*)(ws + WS_AFF); int* SEL = (int*)(ws + WS_SEL);
    bf16* XG = (bf16*)(ws + WS_XG); bf16* HID = (bf16*)(ws + WS_HID); bf16* YE = (bf16*)(ws + WS_YE);

    if (PT_ON(0) && IN(0)) { PHASE_IDS();
        REPS(0) p0_weights(args, lds, tid, lane, wave, G, bid);
        WG_SYNC();
        REPS(16) row_pass<0>(args.in[I_X], nullptr, args.in[I_N1G], args.in[I_WIN] + NPROJ, DIN, Hb, MG, nullptr, nullptr, lds, tid, lane, wave, G, bid);
        if (BOTH(0)) GRID_BAR();
    }
    for (int l = 0; l < DEPTH; ++l) {
        const int pb = 1 + 10 * l;
        if (PT_ON(1) && IN(pb + 0)) { PHASE_IDS();
            pg8::Gemm g{Hb, (const bf16*)(ws + WS_WIN) + (size_t)l * NPROJ * DM, M, NPROJ, DM}; pg8::StaticOrder S; S.init(M, NPROJ, G, bid);
            pg8::EpiBf16<0> E{PROJ, NPROJ, nullptr, 0, 0, 1.f};
            REPS(1) pg8::gemm_phase<pg8::EpiBf16<0>, pg8::StaticOrder, true, true>(lds + RING_OFF, g, S, E);
            if (BOTH(pb + 0)) GRID_BAR();
        }
        if (PT_ON(2) && IN(pb + 1)) { PHASE_IDS();
            if (REP_MASK & (1 << 12)) rope_pass(args, l, lane, wave, G, bid, HID);
            rope_pass(args, l, lane, wave, G, bid, PROJ);
            REPS(2) for (int u = bid; u < 512; u += G) lru_a_unit(args, l, u, lds, tid, lane, wave);
            REPS(3) for (int u = bid; u < 512; u += G) mls_a_unit(args, l, u, lds, tid, lane, wave);
            if (BOTH(pb + 1)) GRID_BAR();
        }
        if (PT_ON(3) && IN(pb + 2)) { PHASE_IDS();
            const attn_body::AttnTensors AT{(const attn_body::bf16*)(PROJ + C_Q), (const attn_body::bf16*)(PROJ + C_K), (const attn_body::bf16*)(PROJ + C_V), (attn_body::bf16*)Yb};
            const attn_body::StaticOrder S(G, bid);
#ifndef P3_PARTS
#define P3_PARTS 7
#endif
            if (P3_PARTS & 1) REPS(4) attn_body::attn_phase<attn_body::StaticOrder>((char*)lds_raw + RING_OFF, AT, S);
            WG_SYNC();
            if (P3_PARTS & 2) REPS(5) for (int u = bid; u < 512; u += G) mls_b_unit(args, l, u, lds, tid, lane, wave);
            if (P3_PARTS & 4) REPS(6) for (int u = bid; u < 512; u += G) lru_b_unit(args, l, u, lds, tid, lane, wave);
            if (BOTH(pb + 2)) GRID_BAR();
        }
        if (PT_ON(4) && IN(pb + 3)) { PHASE_IDS(); if (REP_MASK & (1 << 13)) attnorm_pass(args, l, lane, wave, G, bid, HID); attnorm_pass(args, l, lane, wave, G, bid, Yb); if (BOTH(pb + 3)) GRID_BAR(); }
        if (PT_ON(5) && IN(pb + 4)) { PHASE_IDS();
            pg8::Gemm g{Yb, (const bf16*)(ws + WS_WOUT) + (size_t)l * DM * DM, M, DM, DM}; pg8::StaticOrder S; S.init(M, DM, G, bid);
            pg8::EpiResidF32 E{l == 0 ? args.in[I_X] : args.out, args.out, DM};
            if (REP_MASK & (1 << 14)) { pg8::EpiResidF32 E2{l == 0 ? args.in[I_X] : args.out, (float*)HID, DM}; pg8::gemm_phase<pg8::EpiResidF32, pg8::StaticOrder, false, true>(lds + RING_OFF, g, S, E2); }
            pg8::gemm_phase<pg8::EpiResidF32, pg8::StaticOrder, false, true>(lds + RING_OFF, g, S, E);
            if (BOTH(pb + 4)) GRID_BAR();
        }
        if (PT_ON(6) && IN(pb + 5)) { PHASE_IDS();
            REPS(7) row_pass<1>(args.out, nullptr, args.in[I_N2G] + (size_t)l * DM, args.in[I_WR] + (size_t)l * DM * NE, NE, Hb, AFF, nullptr, nullptr, lds, tid, lane, wave, G, bid);
            if (BOTH(pb + 5)) GRID_BAR();
        }
        if (PT_ON(7) && IN(pb + 6)) { PHASE_IDS(); REPS(8) for (int it = bid; it < 256; it += G) topk_item(args, it, lds, tid, lane, wave); if (BOTH(pb + 6)) GRID_BAR(); }
        if (PT_ON(8) && IN(pb + 7)) { PHASE_IDS();
            pg8::Gemm g{XG, (const bf16*)(ws + WS_WGU + (size_t)l * NE * 4096 * DM), NE * NSLOT, NE * 4096, DM / 2}; pg8::Moe1Order S{G, bid};
            pg8::EpiSwiGLU E{(unsigned char*)HID, DE};
            REPS(9) pg8::gemm_phase<pg8::EpiSwiGLU, pg8::Moe1Order, true, true, true>(lds + RING_OFF, g, S, E);
            if (BOTH(pb + 7)) GRID_BAR();
        }
        if (PT_ON(9) && IN(pb + 8)) { PHASE_IDS();
            pg8::Gemm g{HID, (const bf16*)(ws + WS_WDN + (size_t)l * NE * DM * DE), NE * NSLOT, NE * DM, DE / 2}; pg8::Moe2Order S{G, bid};
            pg8::EpiScaleBf16 E{YE, DM, (const float*)(ws + WS_GATE)};
            REPS(10) pg8::gemm_phase<pg8::EpiScaleBf16, pg8::Moe2Order, true, true, true>(lds + RING_OFF, g, S, E);
            if (BOTH(pb + 8)) GRID_BAR();
        }
        if (PT_ON(10) && IN(pb + 9)) { PHASE_IDS();
            if (REP_MASK & (1 << 15)) { if (l + 1 < DEPTH) row_pass<2>(args.out, (float*)HID, args.in[I_N1G] + (size_t)(l + 1) * DM, args.in[I_WIN] + (size_t)(l + 1) * DM * DIN + NPROJ, DIN, Hb, MG, SEL, YE, lds, tid, lane, wave, G, bid); else row_pass<3>(args.out, (float*)HID, nullptr, nullptr, 0, nullptr, nullptr, SEL, YE, lds, tid, lane, wave, G, bid); WG_SYNC(); }
            if (l + 1 < DEPTH) row_pass<2>(args.out, args.out, args.in[I_N1G] + (size_t)(l + 1) * DM, args.in[I_WIN] + (size_t)(l + 1) * DM * DIN + NPROJ, DIN, Hb, MG, SEL, YE, lds, tid, lane, wave, G, bid);
            else row_pass<3>(args.out, args.out, nullptr, nullptr, 0, nullptr, nullptr, SEL, YE, lds, tid, lane, wave, G, bid);
            if (BOTH(pb + 9)) GRID_BAR();
        }
    }
#undef IN
#undef BOTH
#undef GRID_BAR
}

extern "C" void kernel_launch(void* const* d_in, const int* in_sizes, int n_in, void* d_out, int out_size, void* d_ws, size_t ws_size, hipStream_t stream) {
    static int grid = 0;
    if (grid == 0) {
        if (n_in != 22 || in_sizes[0] != M * DM || out_size != M * DM || ws_size < WS_END) { fprintf(stderr, "kernel_launch: unexpected shapes (n_in %d, in0 %d, out %d, ws %zu); nothing launched\n", n_in, n_in > 0 ? in_sizes[0] : -1, out_size, ws_size); grid = -1; return; }
        int dev = 0, cus = 0, per_cu = 0;
        if (hipGetDevice(&dev) != hipSuccess || hipDeviceGetAttribute(&cus, hipDeviceAttributeMultiprocessorCount, dev) != hipSuccess) { grid = -1; return; }
        if (hipFuncSetAttribute((const void*)hybrid_fwd, hipFuncAttributeMaxDynamicSharedMemorySize, LDS_BYTES) != hipSuccess) { fprintf(stderr, "kernel_launch: hipFuncSetAttribute failed\n"); grid = -1; return; }
        if (hipOccupancyMaxActiveBlocksPerMultiprocessor(&per_cu, (const void*)hybrid_fwd, NTHR, LDS_BYTES) != hipSuccess || per_cu < 1) { fprintf(stderr, "kernel_launch: occupancy query says %d\n", per_cu); }
        (void)hipGetLastError();
        grid = cus;
    }
    if (grid < 0) return;
    if (hipMemsetAsync((char*)d_ws + WS_CTL, 0, CTL_ZERO_BYTES, stream) != hipSuccess) return;
    Args a{};
    for (int i = 0; i < 22; ++i) a.in[i] = (const float*)d_in[i];
    a.out = (float*)d_out; a.ws = (unsigned char*)d_ws; a.pad = 0;
#if MK_PER_PHASE
    for (int p = 0; p < NPH; ++p) { a.ph_lo = p; a.ph_hi = p + 1; a.li = p; hipLaunchKernelGGL(hybrid_fwd, dim3(grid), dim3(NTHR), LDS_BYTES, stream, a); }
#else
    a.ph_lo = 0; a.ph_hi = NPH; a.li = 0;
    hipLaunchKernelGGL(hybrid_fwd, dim3(grid), dim3(NTHR), LDS_BYTES, stream, a);
#endif
    const hipError_t le = hipPeekAtLastError();
    if (le != hipSuccess) fprintf(stderr, "kernel_launch: launch failed: %s\n", hipGetErrorName(le));
}
```

```cpp
#include <hip/hip_runtime.h>
#include <hip/hip_bf16.h>
#include <cstdio>
#include <cstdint>
#include <cmath>
__device__ __forceinline__ int ltid() { int t = threadIdx.x; asm volatile("" : "+v"(t)); return t; }
__device__ __forceinline__ int lbid() { int t = blockIdx.x; asm volatile("" : "+s"(t)); return t; }
namespace pg8 {
#define PG8_LAS __attribute__((address_space(3)))
typedef unsigned short bf16_t;
typedef short bf16x8 __attribute__((ext_vector_type(8)));
typedef float f32x4 __attribute__((ext_vector_type(4)));
typedef unsigned u32x4 __attribute__((ext_vector_type(4)));
typedef unsigned u32x2 __attribute__((ext_vector_type(2)));
constexpr int BM = 256, BK = 64, HALF = 128, HTB = HALF * BK * 2  , STAGE_BYTES = 8 * HTB, NXCD = 8, WGM = 8;

__host__ __device__ __forceinline__ int lds_byte(int r, int c) { const int st = (r >> 4) * 2 + (c >> 5), rr = r & 15, cc = c & 31, ob = rr * 64 + cc * 2; return st * 1024 + (ob ^ (((ob >> 9) & 1) << 5)); }
__host__ __device__ __forceinline__ void stage_rc(int b, int& R, int& C) { const int st = b / 1024, sb = b % 1024, swz = sb ^ (((sb >> 9) & 1) << 5); R = (st >> 1) * 16 + swz / 64; C = (st & 1) * 32 + (swz % 64) / 2; }
__host__ __device__ __forceinline__ int perm32(int rho) { const int n = rho >> 4, i = rho & 15; return 8 * (i >> 2) + 4 * n + (i & 3); }

struct Unit { int pm, pn; };
struct Gemm { const bf16_t* A; const bf16_t* Bt; int M, N, K; };

struct StaticOrder {
    int nM, nN, nwg, G, c;
    __host__ __device__ void init(int M, int N, int G_, int c_) { nM = M / BM; nN = N / BM; nwg = nM * nN; G = G_; c = c_; }
    __host__ __device__ bool next(int i, Unit& u) const {
        const long L = (long)i * G + c; if (L >= nwg) return false;
        int wgid = (int)L; { const int q = nwg / NXCD, r = nwg % NXCD, xcd = wgid % NXCD, off = wgid / NXCD; wgid = (xcd < r ? xcd * (q + 1) : r * (q + 1) + (xcd - r) * q) + off; }
        const int nig = WGM * nN, gid = wgid / nig, fm = gid * WGM, gsz = (nM - fm) < WGM ? (nM - fm) : WGM;
        u.pm = fm + ((wgid % nig) % gsz); u.pn = (wgid % nig) / gsz; return true;
    }
    __device__ __forceinline__ void a_ready(const Unit&) const {}
    __device__ __forceinline__ void done(const Unit&) const {}
};

__device__ __forceinline__ unsigned cvt_pk_bf16(float lo, float hi) { unsigned r; asm volatile("v_cvt_pk_bf16_f32 %0, %1, %2" : "=v"(r) : "v"(lo), "v"(hi)); return r; }
typedef int i32x4 __attribute__((ext_vector_type(4)));
typedef int i32x8 __attribute__((ext_vector_type(8)));
__device__ __forceinline__ i32x8 cat8(bf16x8 lo, bf16x8 hi) { return __builtin_shufflevector(__builtin_bit_cast(i32x4, lo), __builtin_bit_cast(i32x4, hi), 0, 1, 2, 3, 4, 5, 6, 7); }
__device__ __forceinline__ float clamp448(float v) { return __builtin_fminf(__builtin_fmaxf(v, -448.f), 448.f); }
__device__ __forceinline__ unsigned pk4_fp8(float a, float b, float c, float d) { unsigned r = 0u; r = (unsigned)__builtin_amdgcn_cvt_pk_fp8_f32(a, b, (int)r, false); r = (unsigned)__builtin_amdgcn_cvt_pk_fp8_f32(c, d, (int)r, true); return r; }
typedef float f32x2 __attribute__((ext_vector_type(2)));
__device__ __forceinline__ f32x2 gelu_pk(f32x2 v) {
    const f32x2 av = __builtin_elementwise_abs(v), d = av * 0.2316418882f + 1.0f;
    f32x2 t; t.x = __builtin_amdgcn_rcpf(d.x); t.y = __builtin_amdgcn_rcpf(d.y);
    f32x2 q = t * 0.5307027145f + (-0.7265760135f); q = q * t + 0.7107068705f; q = q * t + (-0.142248368f); q = q * t + 0.127414796f; q = q * t;
    const f32x2 s = (v * v) * (-0.72134752044f);
    f32x2 e; e.x = __builtin_amdgcn_exp2f(s.x); e.y = __builtin_amdgcn_exp2f(s.y);
    const f32x2 m = v * (q * e), r = v - m;
    f32x2 o; o.x = v.x < 0.f ? m.x : r.x; o.y = v.y < 0.f ? m.y : r.y; return o;
}

template <int ACT  > struct EpiBf16 {
    static constexpr bool PERM = true, AFTER_DRAIN = false; static_assert(ACT == 0 || ACT == 1, "EpiBf16: ACT is 0 (none) or 1 (gelu_pk)");
    bf16_t* O; int ldc; const float* bias; int split_cols; size_t split_stride; float scale0;
    __device__ __forceinline__ void operator()(const f32x4 (&acc)[2][2][4][2], const Unit& u, int wr, int wc, int fr, int fq) const {
        const int row0 = u.pm * BM + wr * 64 + fr; int colt = u.pn * BM; bf16_t* base = O;
        float sc = 1.f; if (split_cols) { const int t = colt / split_cols; base += (size_t)t * split_stride; colt -= t * split_cols; if (t == 0) sc = scale0; }
        const int col0 = colt + wc * 32 + 8 * fq, bcol0 = u.pn * BM + wc * 32 + 8 * fq;
        f32x4 bv[2][2];
#pragma unroll
        for (int bj = 0; bj < 2; ++bj)
#pragma unroll
            for (int n = 0; n < 2; ++n) bv[bj][n] = bias ? *(const f32x4*)(bias + bcol0 + bj * HALF + 4 * n) : (f32x4){0.f, 0.f, 0.f, 0.f};
#pragma unroll
        for (int ai = 0; ai < 2; ++ai)
#pragma unroll
            for (int m = 0; m < 4; ++m) { bf16_t* rowp = base + (size_t)(row0 + ai * HALF + m * 16) * ldc + col0;
#pragma unroll
                for (int bj = 0; bj < 2; ++bj) { f32x4 v0 = acc[ai][bj][m][0] + bv[bj][0], v1 = acc[ai][bj][m][1] + bv[bj][1];
                    if (ACT == 1) { f32x2 a = gelu_pk((f32x2){v0[0], v0[1]}), b = gelu_pk((f32x2){v0[2], v0[3]}), c = gelu_pk((f32x2){v1[0], v1[1]}), d = gelu_pk((f32x2){v1[2], v1[3]});
                        v0 = (f32x4){a.x, a.y, b.x, b.y}; v1 = (f32x4){c.x, c.y, d.x, d.y}; }
                    v0 = v0 * sc; v1 = v1 * sc; u32x4 w; w.x = cvt_pk_bf16(v0[0], v0[1]); w.y = cvt_pk_bf16(v0[2], v0[3]); w.z = cvt_pk_bf16(v1[0], v1[1]); w.w = cvt_pk_bf16(v1[2], v1[3]);
                    *(u32x4*)(rowp + bj * HALF) = w; } }
    }
};

struct EpiResidF32 {
    static constexpr bool PERM = false, AFTER_DRAIN = false;
    const float* base; float* C; int ldc;
    __device__ __forceinline__ void operator()(const f32x4 (&acc)[2][2][4][2], const Unit& u, int wr, int wc, int fr, int fq) const {
        const int row0 = u.pm * BM + wr * 64 + fr, col0 = u.pn * BM + wc * 32 + 4 * fq;
#pragma unroll
        for (int ai = 0; ai < 2; ++ai)
#pragma unroll
            for (int m = 0; m < 4; ++m) { const size_t off = (size_t)(row0 + ai * HALF + m * 16) * ldc + col0;
#pragma unroll
                for (int bj = 0; bj < 2; ++bj)
#pragma unroll
                    for (int n = 0; n < 2; ++n) { const f32x4 b = *(const f32x4*)(base + off + bj * HALF + n * 16); *(f32x4*)(C + off + bj * HALF + n * 16) = acc[ai][bj][m][n] + b; } }
    }
};
__device__ __forceinline__ float silu_f(float x) { return x * __builtin_amdgcn_rcpf(1.0f + __builtin_amdgcn_exp2f(-1.4426950408889634f * x)); }
constexpr float WSCALE = 64.f, HSCALE = 4.f;
struct EpiSwiGLU {
    static constexpr bool PERM = true, AFTER_DRAIN = false;
    unsigned char* O; int ldc;
    __device__ __forceinline__ void operator()(const f32x4 (&acc)[2][2][4][2], const Unit& u, int wr, int wc, int fr, int fq) const {
        const int row0 = u.pm * BM + wr * 64 + fr, col0 = (u.pn & 15) * HALF + wc * 32 + 8 * fq; constexpr float is = 1.0f / WSCALE;
#pragma unroll
        for (int ai = 0; ai < 2; ++ai)
#pragma unroll
            for (int m = 0; m < 4; ++m) { unsigned char* rowp = O + (size_t)(row0 + ai * HALF + m * 16) * ldc + col0;
                const f32x4 g0 = acc[ai][0][m][0] * is, g1 = acc[ai][0][m][1] * is, u0 = acc[ai][1][m][0] * (is * HSCALE), u1 = acc[ai][1][m][1] * (is * HSCALE);
                u32x2 w; w.x = pk4_fp8(clamp448(silu_f(g0[0]) * u0[0]), clamp448(silu_f(g0[1]) * u0[1]), clamp448(silu_f(g0[2]) * u0[2]), clamp448(silu_f(g0[3]) * u0[3]));
                w.y = pk4_fp8(clamp448(silu_f(g1[0]) * u1[0]), clamp448(silu_f(g1[1]) * u1[1]), clamp448(silu_f(g1[2]) * u1[2]), clamp448(silu_f(g1[3]) * u1[3]));
                *(u32x2*)rowp = w; }
    }
};
struct EpiScaleBf16 {
    static constexpr bool PERM = true, AFTER_DRAIN = false;
    bf16_t* O; int ldc; const float* rowscale;
    __device__ __forceinline__ void operator()(const f32x4 (&acc)[2][2][4][2], const Unit& u, int wr, int wc, int fr, int fq) const {
        const int row0 = u.pm * BM + wr * 64 + fr, col0 = (u.pn & 3) * BM + wc * 32 + 8 * fq;
#pragma unroll
        for (int ai = 0; ai < 2; ++ai)
#pragma unroll
            for (int m = 0; m < 4; ++m) { const int row = row0 + ai * HALF + m * 16; const float s = rowscale[row] * (1.0f / (WSCALE * HSCALE)); bf16_t* rowp = O + (size_t)row * ldc + col0;
#pragma unroll
                for (int bj = 0; bj < 2; ++bj) { const f32x4 v0 = acc[ai][bj][m][0] * s, v1 = acc[ai][bj][m][1] * s;
                    u32x4 w; w.x = cvt_pk_bf16(v0[0], v0[1]); w.y = cvt_pk_bf16(v0[2], v0[3]); w.z = cvt_pk_bf16(v1[0], v1[1]); w.w = cvt_pk_bf16(v1[2], v1[3]);
                    *(u32x4*)(rowp + bj * HALF) = w; } }
    }
};
struct Moe1Order {
    int G, c;
    __device__ __forceinline__ bool next(int i, Unit& u) const {
        const int L = i * G + c; if (L >= 2048) return false;
        const int e = L >> 7, r = L & 127; u.pm = e * 8 + ((r >> 3) & 7); u.pn = e * 16 + 2 * (r & 7) + (r >> 6); return true;
    }
    __device__ __forceinline__ void a_ready(const Unit&) const {}
    __device__ __forceinline__ void done(const Unit&) const {}
};
struct Moe2Order {
    int G, c;
    __device__ __forceinline__ bool next(int i, Unit& u) const {
        const int L = i * G + c; if (L >= 512) return false;
        const int q = L & 7, Lp = L >> 3, e = 8 * (Lp >> 5) + q, k = Lp & 31; u.pm = e * 8 + (k & 7); u.pn = e * 4 + (k >> 3); return true;
    }
    __device__ __forceinline__ void a_ready(const Unit&) const {}
    __device__ __forceinline__ void done(const Unit&) const {}
};
template <class Epi, class Sched, bool ALIGN_EPI = false, bool SP2 = false, bool F8 = false>
__device__ __forceinline__ void gemm_phase(PG8_LAS unsigned char* lds, const Gemm g, const Sched& S, const Epi& E) {
    const int tid = ltid(), wid = __builtin_amdgcn_readfirstlane(tid >> 6), lane = tid & 63, wr = wid >> 2, wc = wid & 3, fr = lane & 15, fq = lane >> 4;
    const int K = g.K, nt = K / BK;
    unsigned voffA[2], voffB[2];
#pragma unroll
    for (int i = 0; i < 2; ++i) { int R, C; stage_rc(tid * 16 + i * 8192, R, C); const int Rb = Epi::PERM ? ((R & ~31) + perm32(R & 31)) : R;
        voffA[i] = (unsigned)(R * K + C) * 2u; voffB[i] = (unsigned)(Rb * K + C) * 2u; }
    const size_t kstep = (size_t)(BK * 2);
    const size_t hstep = (size_t)HALF * K * 2;
    const size_t tstep = 2 * hstep;
    const unsigned ldsw = (unsigned)wid * 1024u;
    const int aoff = lds_byte(wr * 64 + fr, fq * 8), boff = lds_byte(wc * 32 + fr, fq * 8);
#define PG8_SA(b, h) (((b) * 2 + (h)) * HTB)
#define PG8_SB(b, h) ((4 + (b) * 2 + (h)) * HTB)
#define PG8_STAGE(bufoff, gbase, voff) do { _Pragma("unroll") for (int _i = 0; _i < 2; ++_i) \
        __builtin_amdgcn_global_load_lds((const unsigned*)((const char*)(gbase) + (voff)[_i]), (PG8_LAS unsigned*)(lds + (bufoff) + ldsw + _i * 8192), 16, 0, 0); } while (0)
#define PG8_LDA(dst, b, h) do { _Pragma("unroll") for (int m = 0; m < 4; ++m) { if constexpr (F8) { dst##8[m] = cat8(*(const PG8_LAS bf16x8*)(lds + PG8_SA(b, h) + aoff + m * 2048), *(const PG8_LAS bf16x8*)(lds + PG8_SA(b, h) + aoff + m * 2048 + 1024)); } \
        else { _Pragma("unroll") for (int k = 0; k < 2; ++k) dst[m][k] = *(const PG8_LAS bf16x8*)(lds + PG8_SA(b, h) + aoff + m * 2048 + k * 1024); } } } while (0)
#define PG8_LDB(dst, b, h) do { _Pragma("unroll") for (int n = 0; n < 2; ++n) { if constexpr (F8) { dst##8[n] = cat8(*(const PG8_LAS bf16x8*)(lds + PG8_SB(b, h) + boff + n * 2048), *(const PG8_LAS bf16x8*)(lds + PG8_SB(b, h) + boff + n * 2048 + 1024)); } \
        else { _Pragma("unroll") for (int k = 0; k < 2; ++k) dst[n][k] = *(const PG8_LAS bf16x8*)(lds + PG8_SB(b, h) + boff + n * 2048 + k * 1024); } } } while (0)
#define PG8_MMA(ai, bj, At, Bt) do { __builtin_amdgcn_s_setprio(1); _Pragma("unroll") for (int m = 0; m < 4; ++m) _Pragma("unroll") for (int n = 0; n < 2; ++n) { \
        if constexpr (F8) { asm volatile("v_mfma_scale_f32_16x16x128_f8f6f4 %0, %1, %2, %0, %3, %3 op_sel_hi:[0,0,0]" : "+v"(acc[ai][bj][m][n]) : "v"(Bt##8[n]), "v"(At##8[m]), "v"(sc1)); } \
        else { _Pragma("unroll") for (int k = 0; k < 2; ++k) acc[ai][bj][m][n] = __builtin_amdgcn_mfma_f32_16x16x32_bf16(Bt[n][k], At[m][k], acc[ai][bj][m][n], 0, 0, 0); } } __builtin_amdgcn_s_setprio(0); } while (0)
#define PG8_WAIT_V(n) asm volatile("s_waitcnt vmcnt(" #n ")" ::: "memory")
#define PG8_WAIT_L(n) asm volatile("s_waitcnt lgkmcnt(" #n ")" ::: "memory")
#define PG8_BAR __builtin_amdgcn_s_barrier()
#define PG8_SCHED __builtin_amdgcn_sched_barrier(0)
    Unit cur, nxt; int ui = 0;
    if (!S.next(0, cur)) return;
    f32x4 acc[2][2][4][2];
#pragma unroll
    for (int a = 0; a < 2; ++a)
#pragma unroll
        for (int b = 0; b < 2; ++b)
#pragma unroll
            for (int m = 0; m < 4; ++m)
#pragma unroll
                for (int n = 0; n < 2; ++n) acc[a][b][m][n] = (f32x4){0.f, 0.f, 0.f, 0.f};
    bf16x8 At[4][2], B0[2][2], B1[2][2]; i32x8 At8[4], B08[2], B18[2];
    const int sc1 = 0x7F7F7F7F;
    const char* cA = (const char*)g.A + (size_t)cur.pm * tstep; const char* cB = (const char*)g.Bt + (size_t)cur.pn * tstep;
    S.a_ready(cur);
    if constexpr (SP2) {
        PG8_STAGE(PG8_SB(0, 0), cB, voffB); PG8_STAGE(PG8_SB(0, 1), cB + hstep, voffB); PG8_STAGE(PG8_SA(0, 0), cA, voffA); PG8_STAGE(PG8_SA(0, 1), cA + hstep, voffA);
        if (wr == 1) PG8_BAR;
        PG8_WAIT_V(2); PG8_BAR;
        PG8_STAGE(PG8_SB(1, 0), cB + kstep, voffB); PG8_STAGE(PG8_SA(1, 0), cA + kstep, voffA); PG8_STAGE(PG8_SB(1, 1), cB + hstep + kstep, voffB);
        PG8_WAIT_V(6); PG8_BAR;
    } else {
        PG8_STAGE(PG8_SB(0, 0), cB, voffB); PG8_STAGE(PG8_SA(0, 0), cA, voffA); PG8_STAGE(PG8_SB(0, 1), cB + hstep, voffB); PG8_STAGE(PG8_SA(0, 1), cA + hstep, voffA);
        if (wr == 1) PG8_BAR;
        PG8_WAIT_V(4); PG8_BAR;
        PG8_STAGE(PG8_SB(1, 0), cB + kstep, voffB); PG8_STAGE(PG8_SA(1, 0), cA + kstep, voffA); PG8_STAGE(PG8_SB(1, 1), cB + hstep + kstep, voffB);
        PG8_WAIT_V(6); PG8_BAR;
    }
    for (;;) {
        const bool has_next = S.next(ui + 1, nxt);
        const char* nA = has_next ? (const char*)g.A + (size_t)nxt.pm * tstep : cA; const char* nB = has_next ? (const char*)g.Bt + (size_t)nxt.pn * tstep : cB;
        for (int t = 0; t < nt; t += 2) {
            const bool last = (t == nt - 2);
            const char* a1 = cA + (size_t)(t + 1) * kstep;
            const char* a2 = last ? nA : cA + (size_t)(t + 2) * kstep; const char* b2 = last ? nB : cB + (size_t)(t + 2) * kstep;
            const char* a3 = a2 + kstep; const char* b3 = b2 + kstep;
            if (last && has_next) S.a_ready(nxt);
            if constexpr (SP2) {
            PG8_LDB(B0, 0, 0); PG8_LDB(B1, 0, 1); PG8_SCHED; PG8_LDA(At, 0, 0); PG8_STAGE(PG8_SA(1, 1), a1 + hstep, voffA);
            PG8_WAIT_V(8); PG8_WAIT_L(0); PG8_BAR; PG8_MMA(0, 0, At, B0); PG8_MMA(0, 1, At, B1); PG8_BAR; PG8_SCHED;
            PG8_LDA(At, 0, 1); PG8_STAGE(PG8_SB(0, 0), b2, voffB); PG8_STAGE(PG8_SB(0, 1), b2 + hstep, voffB); PG8_STAGE(PG8_SA(0, 0), a2, voffA);
            PG8_WAIT_V(8); PG8_WAIT_L(0); PG8_BAR; PG8_MMA(1, 0, At, B0); PG8_MMA(1, 1, At, B1); PG8_BAR; PG8_SCHED;
            PG8_LDB(B0, 1, 0); PG8_LDB(B1, 1, 1); PG8_SCHED; PG8_LDA(At, 1, 0); PG8_STAGE(PG8_SA(0, 1), a2 + hstep, voffA);
            PG8_WAIT_V(8); PG8_WAIT_L(0); PG8_BAR; PG8_MMA(0, 0, At, B0); PG8_MMA(0, 1, At, B1); PG8_BAR; PG8_SCHED;
            PG8_LDA(At, 1, 1); PG8_STAGE(PG8_SB(1, 0), b3, voffB); PG8_STAGE(PG8_SB(1, 1), b3 + hstep, voffB); PG8_STAGE(PG8_SA(1, 0), a3, voffA);
            PG8_WAIT_V(8); PG8_WAIT_L(0); PG8_BAR; PG8_MMA(1, 0, At, B0); PG8_MMA(1, 1, At, B1); PG8_BAR; PG8_SCHED;
            } else {
            PG8_LDB(B0, 0, 0); PG8_SCHED; PG8_LDA(At, 0, 0); PG8_STAGE(PG8_SA(1, 1), a1 + hstep, voffA);
            PG8_WAIT_L(8); PG8_BAR; PG8_WAIT_L(0); PG8_MMA(0, 0, At, B0); PG8_BAR; PG8_SCHED;
            PG8_LDB(B1, 0, 1); PG8_STAGE(PG8_SB(0, 0), b2, voffB);
            PG8_BAR; PG8_WAIT_L(0); PG8_MMA(0, 1, At, B1); PG8_BAR;
            PG8_LDA(At, 0, 1); PG8_STAGE(PG8_SA(0, 0), a2, voffA);
            PG8_BAR; PG8_WAIT_L(0); PG8_MMA(1, 0, At, B0); PG8_BAR; PG8_SCHED;
            PG8_STAGE(PG8_SB(0, 1), b2 + hstep, voffB);
            PG8_WAIT_V(6); PG8_BAR; PG8_MMA(1, 1, At, B1); PG8_BAR;
            PG8_LDB(B0, 1, 0); PG8_SCHED; PG8_LDA(At, 1, 0); PG8_STAGE(PG8_SA(0, 1), a2 + hstep, voffA);
            PG8_WAIT_L(8); PG8_BAR; PG8_WAIT_L(0); PG8_MMA(0, 0, At, B0); PG8_BAR; PG8_SCHED;
            PG8_LDB(B1, 1, 1); PG8_STAGE(PG8_SB(1, 0), b3, voffB);
            PG8_BAR; PG8_WAIT_L(0); PG8_MMA(0, 1, At, B1); PG8_BAR;
            PG8_LDA(At, 1, 1); PG8_STAGE(PG8_SA(1, 0), a3, voffA);
            PG8_BAR; PG8_WAIT_L(0); PG8_MMA(1, 0, At, B0); PG8_BAR; PG8_SCHED;
            PG8_STAGE(PG8_SB(1, 1), b3 + hstep, voffB);
            PG8_WAIT_V(6); PG8_BAR; PG8_MMA(1, 1, At, B1); PG8_BAR;
            }
        }
        if constexpr (F8) { asm volatile("s_nop 15\n\ts_nop 15" ::: "memory"); }
        if constexpr (ALIGN_EPI) { if (wr == 0) PG8_BAR; }
        if constexpr (!Epi::AFTER_DRAIN) { E(acc, cur, wr, wc, fr, fq); S.done(cur); }
        if (!has_next) break;
#pragma unroll
        for (int a = 0; a < 2; ++a)
#pragma unroll
            for (int b = 0; b < 2; ++b)
#pragma unroll
                for (int m = 0; m < 4; ++m)
#pragma unroll
                    for (int n = 0; n < 2; ++n) acc[a][b][m][n] = (f32x4){0.f, 0.f, 0.f, 0.f};
        cur = nxt; cA = nA; cB = nB; ++ui;
        if constexpr (ALIGN_EPI) { if (wr == 1) PG8_BAR; }
    }
    PG8_WAIT_V(0);
    if constexpr (!ALIGN_EPI) { if (wr == 0) PG8_BAR; }
    PG8_BAR;
    if constexpr (Epi::AFTER_DRAIN) { E.fused(acc, cur, wr, wc, fr, fq, lds, wid, lane); S.done(cur); }
#undef PG8_SA
#undef PG8_SB
#undef PG8_STAGE
#undef PG8_LDA
#undef PG8_LDB
#undef PG8_MMA
#undef PG8_WAIT_V
#undef PG8_WAIT_L
#undef PG8_BAR
#undef PG8_SCHED
}
}

namespace attn_body {
using bf16=__hip_bfloat16;
using bf16x8=__attribute__((ext_vector_type(8)))short;
using s16x4=__attribute__((ext_vector_type(4)))short;
using f32x16=__attribute__((ext_vector_type(16)))float;
using u32x4=__attribute__((ext_vector_type(4)))unsigned;
constexpr int BATCH=8,NHEAD=8,NKV=2,SEQ=2048,D=64,PQ=2304,PO=1024;
constexpr int NW=8,QBLK=32,QB=QBLK*NW,KVBLK=64,NQB=SEQ/QB;
constexpr int ATTN_UNIT_ROWS=QB;
__device__ __forceinline__ int crow(int r,int hi){return (r&3)+8*(r>>2)+4*hi;}
#define SBAR() __builtin_amdgcn_sched_barrier(0)
__device__ __forceinline__ void cmask(f32x16&p0,f32x16&p1,int jb,int qrel,int hi){
  const float NEG=-INFINITY; int kb=64*jb+4*hi;
  #pragma unroll
  for(int r=0;r<16;++r){int kv=kb+(r&3)+8*(r>>2); if(kv>qrel)p0[r]=NEG; if(kv+32>qrel)p1[r]=NEG;}
}

constexpr int NSLOT=3, SLOTB=8192;
constexpr int LDS_K=0, LDS_V=NSLOT*SLOTB, LDS_WS=2*NSLOT*SLOTB, LDS_OST=LDS_WS+NW*64*4, LDS_BYTES=LDS_OST+NW*4096;
constexpr float C2=0.125f*1.4426950408889634f;
__device__ __forceinline__ void glds16(const void*gsrc,unsigned lds_dst){unsigned keep;
  asm volatile("s_mov_b32 %0, m0\n\ts_mov_b32 m0, %2\n\ts_nop 0\n\tglobal_load_lds_dwordx4 %1, off\n\ts_mov_b32 m0, %0":"=&s"(keep):"v"(gsrc),"s"(lds_dst):"memory");}
__device__ __forceinline__ float max3f(float a,float b,float c){float r;asm("v_max3_f32 %0, %1, %2, %3":"=v"(r):"v"(a),"v"(b),"v"(c));return r;}
__device__ __forceinline__ float max2f(float a,float b){float r;asm("v_max_f32_e32 %0, %1, %2":"=v"(r):"v"(a),"v"(b));return r;}
__device__ __forceinline__ float fadd_s(float a,float b){float r;asm("v_add_f32_e32 %0, %1, %2":"=v"(r):"v"(a),"v"(b));return r;}
__device__ __forceinline__ float fsub_s(float a,float b){float r;asm("v_sub_f32_e32 %0, %1, %2":"=v"(r):"v"(a),"v"(b));return r;}
typedef float f32x2_t __attribute__((ext_vector_type(2))); typedef __bf16 bf16x2_t __attribute__((ext_vector_type(2)));
__device__ __forceinline__ unsigned cvtpk_s(float lo,float hi){f32x2_t v={lo,hi};bf16x2_t b=__builtin_convertvector(v,bf16x2_t);return __builtin_bit_cast(unsigned,b);}
#define WAIT_BAR(N) asm volatile("s_waitcnt vmcnt(" #N ") lgkmcnt(0)\n\ts_barrier":::"memory")

__device__ __forceinline__ void qkt(f32x16&p0,f32x16&p1,const char*Kslot,const bf16x8*qr,const f32x16&negm,int r32,int hi){
  const char*kb=Kslot+hi*1024+r32*16;
  #pragma unroll
  for(int d0=0;d0<4;++d0){
    const bf16x8 b0=*reinterpret_cast<const bf16x8*>(kb+d0*2048);
    const bf16x8 b1=*reinterpret_cast<const bf16x8*>(kb+d0*2048+512);
    if(d0==0){p0=__builtin_amdgcn_mfma_f32_32x32x16_bf16(b0,qr[0],negm,0,0,0);p1=__builtin_amdgcn_mfma_f32_32x32x16_bf16(b1,qr[0],negm,0,0,0);}
    else{p0=__builtin_amdgcn_mfma_f32_32x32x16_bf16(b0,qr[d0],p0,0,0,0);p1=__builtin_amdgcn_mfma_f32_32x32x16_bf16(b1,qr[d0],p1,0,0,0);}}
}
typedef __attribute__((address_space(3))) const char* lds_cptr;
typedef short v4i16_t __attribute__((ext_vector_type(4)));
__device__ __forceinline__ void kload8(bf16x8*kf,lds_cptr kp){
  kf[0]=*(const __attribute__((address_space(3))) bf16x8*)(kp);      kf[1]=*(const __attribute__((address_space(3))) bf16x8*)(kp+512);
  kf[2]=*(const __attribute__((address_space(3))) bf16x8*)(kp+2048); kf[3]=*(const __attribute__((address_space(3))) bf16x8*)(kp+2560);
  kf[4]=*(const __attribute__((address_space(3))) bf16x8*)(kp+4096); kf[5]=*(const __attribute__((address_space(3))) bf16x8*)(kp+4608);
  kf[6]=*(const __attribute__((address_space(3))) bf16x8*)(kp+6144); kf[7]=*(const __attribute__((address_space(3))) bf16x8*)(kp+6656);
}
__device__ __forceinline__ void kload2(bf16x8*kf,lds_cptr kp,int j){ kf[2*j]=*(const __attribute__((address_space(3))) bf16x8*)(kp+j*2048); kf[2*j+1]=*(const __attribute__((address_space(3))) bf16x8*)(kp+j*2048+512); }
__device__ __forceinline__ s16x4 vtr(lds_cptr p){ return __builtin_bit_cast(s16x4,__builtin_amdgcn_ds_read_tr16_b64_v4i16((__attribute__((address_space(3))) v4i16_t*)p)); }
__device__ __forceinline__ float rowmax(const f32x16&p0,const f32x16&p1){
  float a=max3f(p0[0],p0[1],p1[0]),b=max3f(p0[2],p0[3],p1[1]);a=max3f(a,p1[2],p1[3]);
  #pragma unroll
  for(int r=4;r<16;r+=4){a=max3f(a,p0[r],p0[r+1]);b=max3f(b,p0[r+2],p0[r+3]);a=max3f(a,p1[r],p1[r+1]);b=max3f(b,p1[r+2],p1[r+3]);}
  const float m=max2f(a,b);
  auto rr=__builtin_amdgcn_permlane32_swap(__float_as_uint(m),__float_as_uint(m),false,false);
  return max2f(__uint_as_float(rr[0]),__uint_as_float(rr[1]));
}
__device__ __forceinline__ void pv(f32x16*o,int vb,bf16x8 pa0,bf16x8 pa1,bf16x8 pa2,bf16x8 pa3){
  #pragma unroll
  for(int d0=0;d0<2;++d0){s16x4 lo[4],hi[4];
    #pragma unroll
    for(int ks=0;ks<4;++ks){
      asm volatile("ds_read_b64_tr_b16 %0,%1 offset:%c2":"=&v"(lo[ks]):"v"(vb),"i"(d0*4096+ks*1024):"memory");
      asm volatile("ds_read_b64_tr_b16 %0,%1 offset:%c2":"=&v"(hi[ks]):"v"(vb),"i"(d0*4096+ks*1024+512):"memory");}
    asm volatile("s_waitcnt lgkmcnt(0)":::"memory");SBAR();
    #define PK(k) (bf16x8){lo[k][0],lo[k][1],lo[k][2],lo[k][3],hi[k][0],hi[k][1],hi[k][2],hi[k][3]}
    o[d0]=__builtin_amdgcn_mfma_f32_32x32x16_bf16(pa0,PK(0),o[d0],0,0,0);
    o[d0]=__builtin_amdgcn_mfma_f32_32x32x16_bf16(pa1,PK(1),o[d0],0,0,0);
    o[d0]=__builtin_amdgcn_mfma_f32_32x32x16_bf16(pa2,PK(2),o[d0],0,0,0);
    o[d0]=__builtin_amdgcn_mfma_f32_32x32x16_bf16(pa3,PK(3),o[d0],0,0,0);
    #undef PK
  }
}

#ifndef ATTN_STORE16
#define ATTN_STORE16(p,v) (*(u32x4*)(p)=(v))
#endif
template<int THRL> __device__ __forceinline__ void attn_unit(int b,int h,int qb,const bf16*Q,const bf16*__restrict__ K,const bf16*__restrict__ V,bf16*O,char*shm){
  const int tid=ltid(),lane=tid&63,r32=lane&31,hi=lane>>5; const int wid=__builtin_amdgcn_readfirstlane(tid>>6);
  const long rowbase=(long)b*SEQ; const int q0=qb*QB;
  const bf16*Qw=Q+(rowbase+q0+wid*QBLK)*PQ+h*D;
  const bf16*Kh=K+rowbase*PQ+(h>>2)*D,*Vh=V+rowbase*PQ+(h>>2)*D;
  const unsigned lds0=(unsigned)(uintptr_t)shm;
  float*wsf=(float*)(shm+LDS_WS)+wid*64;
  const bf16*ksrc=Kh+(long)lane*PQ+wid*8;
  const bf16*vsrc=Vh+(long)(16*(wid&3)+(lane>>2))*PQ+(wid>>2)*32+(lane&3)*8;
  const unsigned kdst=lds0+LDS_K+wid*1024, vdst=lds0+LDS_V+wid*1024;
  #define DMA_K(t,slot) glds16(ksrc+(long)(t)*KVBLK*PQ,(unsigned)__builtin_amdgcn_readfirstlane(kdst+(slot)))
  #define DMA_V(t,slot) glds16(vsrc+(long)(t)*KVBLK*PQ,(unsigned)__builtin_amdgcn_readfirstlane(vdst+(slot)))
  const int vb0=(int)(lds0+LDS_V)+((lane>>4)&1)*32+(lane&3)*8+(4*hi+((lane&15)>>2))*64;
  const char*Kbase=shm+LDS_K; bf16x8 kf[8];
  const lds_cptr shm3=(lds_cptr)shm; const lds_cptr kp0=shm3+LDS_K+hi*1024+r32*16; const lds_cptr vp0=shm3+LDS_V+((lane>>4)&1)*32+(lane&3)*8+(4*hi+((lane&15)>>2))*64;
  const int NT=SEQ/KVBLK;
  DMA_K(0,0);DMA_V(0,0);DMA_K(1,SLOTB);
  bf16x8 qr[4];
  #pragma unroll
  for(int d0=0;d0<4;++d0)qr[d0]=*reinterpret_cast<const bf16x8*>(&Qw[(long)r32*PQ+d0*16+hi*8]);
  float mhat=0.f,l_reg=0.f;f32x16 o[2];o[0]=f32x16{};o[1]=f32x16{};f32x16 negm=f32x16{};asm volatile("":"+v"(negm));
  const int qrel=wid*QBLK+r32;
  #define CMASK(P0,P1,t) do{}while(0)
  bool resc=false;
  #define START(P0,P1) do{ const float rm=rowmax(P0,P1); resc=false; \
    { const float dl=rm; mhat=fadd_s(mhat,dl); \
      _Pragma("unroll") for(int r=0;r<16;++r){P0[r]=fsub_s(P0[r],dl);P1[r]=fsub_s(P1[r],dl);} \
      _Pragma("unroll") for(int r=0;r<16;++r)negm[r]=-mhat; asm volatile("":"+v"(negm)); } \
    _Pragma("unroll") for(int r=0;r<16;++r)P0[r]=__builtin_amdgcn_exp2f(P0[r]); }while(0)
  #define RESC() do{ if(resc){ asm volatile("s_waitcnt lgkmcnt(0)":::"memory"); \
      _Pragma("unroll") for(int d_=0;d_<2;++d_) _Pragma("unroll") for(int r=0;r<16;++r)o[d_][r]*=wsf[crow(r,hi)]; } }while(0)
  f32x16 pA0,pA1,pB0,pB1;
  int sl_prev=0,sl_cur=0,sl_next=SLOTB;
  #define ROT() do{sl_prev=sl_cur;sl_cur=sl_next;sl_next=(sl_next==(NSLOT-1)*SLOTB)?0:sl_next+SLOTB;}while(0)
  DMA_K(2,2*SLOTB);
  WAIT_BAR(3);
  qkt(pA0,pA1,Kbase,qr,negm,r32,hi);asm volatile("s_nop 15\n\ts_nop 7":"+v"(pA0),"+v"(pA1));CMASK(pA0,pA1,0);
  START(pA0,pA1);
  _Pragma("unroll") for(int r=0;r<16;++r)pA1[r]=__builtin_amdgcn_exp2f(pA1[r]);
  WAIT_BAR(0);
  DMA_K(3,0);DMA_V(1,SLOTB);
  ROT();
  kload8(kf,kp0+sl_cur);
  WAIT_BAR(2);
  s16x4 vlo[8],vhi[8]; u32x4 pw0,pw1,pw2,pw3;
  #define PKW(P,B) cvtpk_s(P[B],P[B+1])
  #define PAF(k) __builtin_bit_cast(bf16x8,pw##k)
  #define VFR(i) (bf16x8){vlo[i][0],vlo[i][1],vlo[i][2],vlo[i][3],vhi[i][0],vhi[i][1],vhi[i][2],vhi[i][3]}
  #define PIN(x) asm volatile("":"+v"(x))
  #define MX3(a,b,c) __builtin_fmaxf(__builtin_fmaxf((a),(b)),(c))
  #define GAPA(MF,A0,A1,A2,A3,W0,W1,PW) do{ MF; sacc+=A0; sacc+=A1; sacc+=A2; sacc+=A3; PIN(sacc); W0; W1; PIN(PW); SBAR(); }while(0)
  #define EX(v) __builtin_amdgcn_exp2f(v)
  #define GAPB(MF,X,B) do{ MF; X[B]=EX(X[B]); X[B+1]=EX(X[B+1]); X[B+2]=EX(X[B+2]); X[B+3]=EX(X[B+3]); PIN(X); SBAR(); }while(0)
  #define VRD(i) do{ vlo[i]=vtr(vp_+(((i)>>2)*4096+((i)&3)*1024)); vhi[i]=vtr(vp_+(((i)>>2)*4096+((i)&3)*1024+512)); }while(0)
  #define KRD(G,j) do{ if(G){ kload2(kf,kp0+sl_next,j); SBAR(); } }while(0)
  #define STEP(C0,C1,P0,P1,t,GK,GV,GL) do{ SBAR(); \
    const lds_cptr vp_=vp0+sl_prev; \
    VRD(0); SBAR(); float sacc=(P0[0]+P0[1]); \
    GAPA(C0=__builtin_amdgcn_mfma_f32_32x32x16_bf16(kf[0],qr[0],negm,0,0,0), P0[2],P0[3],P0[4],P0[5],     pw0[0]=PKW(P0,0), pw0[1]=PKW(P0,2), pw0); \
    VRD(4); SBAR(); GAPA(C1=__builtin_amdgcn_mfma_f32_32x32x16_bf16(kf[1],qr[0],negm,0,0,0), P0[6],P0[7],P0[8],P0[9],     pw0[2]=PKW(P0,4), pw0[3]=PKW(P0,6), pw0); \
    VRD(1); SBAR(); GAPA(C0=__builtin_amdgcn_mfma_f32_32x32x16_bf16(kf[2],qr[1],C0,0,0,0),   P0[10],P0[11],P0[12],P0[13], pw1[0]=PKW(P0,8), pw1[1]=PKW(P0,10), pw1); \
    VRD(5); SBAR(); GAPA(C1=__builtin_amdgcn_mfma_f32_32x32x16_bf16(kf[3],qr[1],C1,0,0,0),   P0[14],P0[15],P1[0],P1[1],   pw1[2]=PKW(P0,12),pw1[3]=PKW(P0,14), pw1); \
    VRD(2); SBAR(); GAPA(C0=__builtin_amdgcn_mfma_f32_32x32x16_bf16(kf[4],qr[2],C0,0,0,0),   P1[2],P1[3],P1[4],P1[5],     pw2[0]=PKW(P1,0), pw2[1]=PKW(P1,2), pw2); \
    VRD(6); SBAR(); GAPA(C1=__builtin_amdgcn_mfma_f32_32x32x16_bf16(kf[5],qr[2],C1,0,0,0),   P1[6],P1[7],P1[8],P1[9],     pw2[2]=PKW(P1,4), pw2[3]=PKW(P1,6), pw2); \
    VRD(3); SBAR(); GAPA(C0=__builtin_amdgcn_mfma_f32_32x32x16_bf16(kf[6],qr[3],C0,0,0,0),   P1[10],P1[11],P1[12],P1[13], pw3[0]=PKW(P1,8), pw3[1]=PKW(P1,10), pw3); \
    VRD(7); SBAR(); GAPA(C1=__builtin_amdgcn_mfma_f32_32x32x16_bf16(kf[7],qr[3],C1,0,0,0),   P1[14],P1[15],0.f,0.f,       pw3[2]=PKW(P1,12),pw3[3]=PKW(P1,14), pw3); \
    l_reg+=sacc; \
    if(GK){DMA_K((t)+3,sl_cur);} if(GV){DMA_V((t)+1,sl_next);} \
    CMASK(C0,C1,t); \
    { float a=MX3(C0[0],C0[1],C1[0]),b=MX3(C0[2],C0[3],C1[1]); a=MX3(a,C1[2],C1[3]); \
      _Pragma("unroll") for(int r=4;r<16;r+=4){a=MX3(a,C0[r],C0[r+1]);b=MX3(b,C0[r+2],C0[r+3]);a=MX3(a,C1[r],C1[r+1]);b=MX3(b,C1[r+2],C1[r+3]);} \
      float rm=__builtin_fmaxf(a,b); { auto rr=__builtin_amdgcn_permlane32_swap(__float_as_uint(rm),__float_as_uint(rm),false,false); rm=__builtin_fmaxf(__uint_as_float(rr[0]),__uint_as_float(rr[1])); } \
      resc=false; \
      if(__builtin_expect(__any(rm>(float)THRL),0)){ const float dl=__builtin_fmaxf(rm,0.f); mhat+=dl; \
        _Pragma("unroll") for(int r=0;r<16;++r){C0[r]-=dl;C1[r]-=dl;} \
        _Pragma("unroll") for(int r=0;r<16;++r)negm[r]=-mhat; asm volatile("":"+v"(negm)); \
        const float f=__builtin_amdgcn_exp2f(-dl); l_reg*=f; if(hi==0)wsf[r32]=f; resc=true; } } \
    SBAR(); \
    GAPB(o[0]=__builtin_amdgcn_mfma_f32_32x32x16_bf16(PAF(0),VFR(0),o[0],0,0,0), C0,0); \
    GAPB(o[1]=__builtin_amdgcn_mfma_f32_32x32x16_bf16(PAF(0),VFR(4),o[1],0,0,0), C0,4); \
    KRD(GL,0); GAPB(o[0]=__builtin_amdgcn_mfma_f32_32x32x16_bf16(PAF(1),VFR(1),o[0],0,0,0), C0,8); \
    KRD(GL,1); GAPB(o[1]=__builtin_amdgcn_mfma_f32_32x32x16_bf16(PAF(1),VFR(5),o[1],0,0,0), C0,12); \
    KRD(GL,2); GAPB(o[0]=__builtin_amdgcn_mfma_f32_32x32x16_bf16(PAF(2),VFR(2),o[0],0,0,0), C1,0); \
    KRD(GL,3); GAPB(o[1]=__builtin_amdgcn_mfma_f32_32x32x16_bf16(PAF(2),VFR(6),o[1],0,0,0), C1,4); \
    GAPB(o[0]=__builtin_amdgcn_mfma_f32_32x32x16_bf16(PAF(3),VFR(3),o[0],0,0,0), C1,8); \
    GAPB(o[1]=__builtin_amdgcn_mfma_f32_32x32x16_bf16(PAF(3),VFR(7),o[1],0,0,0), C1,12); \
    }while(0)
  int t=1;
  #undef CMASK
  #define CMASK(P0,P1,t) do{}while(0)
  for(;t+5<NT;t+=2){
    STEP(pB0,pB1,pA0,pA1,t,true,true,true);     WAIT_BAR(2); RESC(); ROT();
    STEP(pA0,pA1,pB0,pB1,t+1,true,true,true);   WAIT_BAR(2); RESC(); ROT();
  }
  #undef CMASK
  #define CMASK(P0,P1,t) do{}while(0)
  #define ENDW(tt) do{ if((tt)+3<NT){WAIT_BAR(2);} else if((tt)+2<NT){WAIT_BAR(1);} else {WAIT_BAR(0);} }while(0)
  for(;t+1<NT;t+=2){
    STEP(pB0,pB1,pA0,pA1,t,(t+3<NT),(t+1<NT),(t+1<NT));       ENDW(t);   RESC(); ROT();
    STEP(pA0,pA1,pB0,pB1,t+1,(t+4<NT),(t+2<NT),(t+2<NT));     ENDW(t+1); RESC(); ROT();
  }
  STEP(pB0,pB1,pA0,pA1,NT-1,false,false,false); RESC();
  { float sacc=pB0[0]+pB0[1]; _Pragma("unroll") for(int r=2;r<16;++r)sacc+=pB0[r]; _Pragma("unroll") for(int r=0;r<16;++r)sacc+=pB1[r]; l_reg+=sacc;
    pw0=(u32x4){PKW(pB0,0),PKW(pB0,2),PKW(pB0,4),PKW(pB0,6)};pw1=(u32x4){PKW(pB0,8),PKW(pB0,10),PKW(pB0,12),PKW(pB0,14)};pw2=(u32x4){PKW(pB1,0),PKW(pB1,2),PKW(pB1,4),PKW(pB1,6)};pw3=(u32x4){PKW(pB1,8),PKW(pB1,10),PKW(pB1,12),PKW(pB1,14)};
    SBAR(); pv(o,vb0+sl_cur,PAF(0),PAF(1),PAF(2),PAF(3)); }
  #undef PKW
  #undef PAF
  #undef VFR
  #undef PIN
  #undef MX3
  #undef GAPA
  #undef GAPB
  #undef EX
  #undef VRD
  #undef KRD
  #undef STEP
  #undef ENDW
  {auto rr=__builtin_amdgcn_permlane32_swap(__float_as_uint(l_reg),__float_as_uint(l_reg),false,false);l_reg=__uint_as_float(rr[0])+__uint_as_float(rr[1]);}
  if(hi==0)wsf[32+r32]=l_reg;asm volatile("s_waitcnt lgkmcnt(0)":::"memory");
  float rli[16];
  #pragma unroll
  for(int r=0;r<16;++r)rli[r]=__builtin_amdgcn_rcpf(wsf[32+crow(r,hi)]);
  bf16*Ow=O+(rowbase+q0+wid*QBLK)*PO+h*D;
  { bf16*stg=(bf16*)(shm+LDS_OST)+wid*2048;
    #pragma unroll
    for(int r=0;r<16;++r){const int orow=crow(r,hi);
      #pragma unroll
      for(int d0=0;d0<2;++d0)stg[orow*64+d0*32+r32]=__float2bfloat16(o[d0][r]*rli[r]);}
    asm volatile("s_waitcnt lgkmcnt(0)":::"memory");
    #pragma unroll
    for(int i=0;i<4;++i){const int row=i*8+(lane>>3),ch=lane&7; const u32x4 v=*(const u32x4*)(stg+row*64+ch*8); ATTN_STORE16(Ow+(long)row*PO+ch*8,v);} }
  asm volatile("s_waitcnt lgkmcnt(0)\n\ts_barrier":::"memory");
  #undef DMA_K
  #undef DMA_V
  #undef CMASK
  #undef START
  #undef RESC
  #undef ROT
}
constexpr int ATTN_LDS_BYTES=LDS_BYTES;
struct AttnTensors { const bf16* Q; const bf16* K; const bf16* V; bf16* O; };
struct AttnUnit { int b; int h; int qb; };
struct StaticOrder {
  int vcu, G;
  __device__ __forceinline__ explicit StaticOrder(int grid,int block):vcu((grid%8==0)?(block%8)*(grid/8)+block/8:block),G(grid){}
  __device__ __forceinline__ bool next(int i,AttnUnit&u)const{ const int L=i*G+vcu; if(L>=BATCH*NHEAD*(SEQ/QB))return false; const int grp=L>>5,r=L&31; u.b=grp>>1; u.h=(grp&1)*4+(r>>3); u.qb=r&7; return true; }
  __device__ __forceinline__ void a_ready(const AttnUnit&)const{}
  __device__ __forceinline__ void done(const AttnUnit&)const{}
};
template<class Sched,int THRL=8> __device__ __forceinline__ void attn_phase(char*lds,const AttnTensors&T,const Sched&S){
  AttnUnit u;
  for(int i=0;S.next(i,u);++i){ S.a_ready(u); attn_unit<THRL>(u.b,u.h,u.qb,T.Q,T.K,T.V,T.O,lds); S.done(u); }
}
#undef SBAR
#undef WAIT_BAR
}


#define GAS __attribute__((address_space(1)))
#define LAS __attribute__((address_space(3)))
typedef unsigned short bf16;
typedef unsigned v4u __attribute__((ext_vector_type(4)));
typedef float f32x4 __attribute__((ext_vector_type(4)));
typedef short bf16x8 __attribute__((ext_vector_type(8)));
typedef GAS unsigned gu32;
typedef GAS unsigned long long gu64;
#define RLX_AGENT __ATOMIC_RELAXED, __HIP_MEMORY_SCOPE_AGENT
#define LDS_WAIT() asm volatile("s_waitcnt lgkmcnt(0)" ::: "memory")
#define VM_WAIT() asm volatile("s_waitcnt vmcnt(0)" ::: "memory")
__device__ __forceinline__ unsigned long long rt() { return __builtin_amdgcn_s_memrealtime(); }
__device__ __forceinline__ unsigned f2bf(float f) { unsigned u = __builtin_bit_cast(unsigned, f); return (u + 0x7fffu + ((u >> 16) & 1u)) >> 16; }
__device__ __forceinline__ unsigned pk2(float lo, float hi) { return f2bf(lo) | (f2bf(hi) << 16); }

#define XB_TMO      128
#define XB_XCNT(j)  (256  + 64 * (j))
#define XB_XSUB(j)  (1280 + 64 * (j))
#define XB_XGEN(j)  (2304 + 64 * (j))
#define XB_TOP      3328
#define XB_TOPGEN   3392
#define XCD_BAR_WORDS 3456
#define XB_SPIN_CAP (1u << 18)

__device__ __forceinline__ unsigned xb_ld(unsigned* p)              { return __hip_atomic_load(p, __ATOMIC_RELAXED, __HIP_MEMORY_SCOPE_AGENT); }
__device__ __forceinline__ unsigned xb_add(unsigned* p, unsigned v) { return __hip_atomic_fetch_add(p, v, __ATOMIC_RELAXED, __HIP_MEMORY_SCOPE_AGENT); }
__device__ __forceinline__ unsigned xb_xcc_id() { return (unsigned)__builtin_amdgcn_s_getreg((3 << 11) | 20) & 0xFu; }
#define XB_SPIN(cond, bar) do { unsigned _sp = 0; while (cond) { __builtin_amdgcn_s_sleep(1); \
    if ((++_sp & 255u) == 0u) { if (xb_ld(&(bar)[XB_TMO])) break; if (_sp > XB_SPIN_CAP) { atomicAdd(&(bar)[XB_TMO], 1u); break; } } } } while (0)

struct XcdBarrier {
    unsigned* bar; unsigned x;
    volatile LAS unsigned* st;
};

__device__ __forceinline__ XcdBarrier xcd_barrier_post(unsigned* bar, volatile LAS unsigned* st) {
    XcdBarrier b; b.bar = bar; b.x = xb_xcc_id(); b.st = st;
    if (threadIdx.x == 0) (void)xb_add(&bar[XB_XCNT(b.x)], 1u);
    return b;
}
__device__ __forceinline__ void xcd_barrier_complete(unsigned* bar, unsigned x, unsigned& nloc, unsigned& nx) {
    const unsigned G = gridDim.x * gridDim.y * gridDim.z;
    unsigned sum, cnt, mine, sp = 0u;
    for (;;) {
        sum = 0u; cnt = 0u; mine = 0u;
#pragma unroll
        for (unsigned j = 0; j < 16; ++j) { const unsigned c = xb_ld(&bar[XB_XCNT(j)]); sum += c; cnt += (c > 0u) ? 1u : 0u; mine = (j == x) ? c : mine; }
        if (sum == G) break;
        __builtin_amdgcn_s_sleep(1);
        if ((++sp & 255u) == 0u) { if (xb_ld(&bar[XB_TMO])) break; if (sp > XB_SPIN_CAP) { atomicAdd(&bar[XB_TMO], 1u); break; } }
    }
    nloc = mine > 0u ? mine : 1u; nx = cnt > 0u ? cnt : 1u;
}

__device__ __forceinline__ void xcd_barrier(const XcdBarrier& b) {
    asm volatile("s_waitcnt vmcnt(0)" ::: "memory");
    __syncthreads();
    if (threadIdx.x == 0) {
        unsigned* bar = b.bar;
        __builtin_amdgcn_s_waitcnt(0);
        unsigned nloc = b.st[0], nx = b.st[1];
        if (nloc == 0u) { xcd_barrier_complete(bar, b.x, nloc, nx); b.st[0] = nloc; b.st[1] = nx; }
        const unsigned old = xb_add(&bar[XB_XSUB(b.x)], 1u);
        const unsigned gen = old / nloc;
        if (old + 1u == (gen + 1u) * nloc) {
            __builtin_amdgcn_fence(__ATOMIC_RELEASE, "agent");
            asm volatile("s_waitcnt vmcnt(0)" ::: "memory");
            const unsigned og = xb_add(&bar[XB_TOP], 1u);
            const unsigned tg = og / nx;
            if (og + 1u == (tg + 1u) * nx) xb_add(&bar[XB_TOPGEN], 1u);
            else XB_SPIN(xb_ld(&bar[XB_TOPGEN]) == tg, bar);
            __builtin_amdgcn_fence(__ATOMIC_ACQUIRE, "agent");
            xb_add(&bar[XB_XGEN(b.x)], 1u);
            asm volatile("s_waitcnt vmcnt(0)" ::: "memory");
        } else {
            XB_SPIN(xb_ld(&bar[XB_XGEN(b.x)]) == gen, bar);
            __builtin_amdgcn_fence(__ATOMIC_ACQUIRE, "agent");
            asm volatile("s_waitcnt vmcnt(0)" ::: "memory");
        }
    }
    __syncthreads();
}

constexpr int NWAVES = 8, NTHR = 512;
constexpr int DM = 1024, NB = 8, SEQ = 2048, DEPTH = 4, M = NB * SEQ;
constexpr int DIN = 2320, NPROJ = 2304;
constexpr int C_Q = 0, C_K = 512, C_V = 640, C_LX = 768, C_LG = 1024, C_MQ = 1280, C_MK = 1536, C_MV = 1792, C_MO = 2048;
constexpr int NE = 16, CAP = 256, DE = 2048, NSLOT = NB * CAP;
constexpr float EPS = 1e-6f;
constexpr int NPH = 1 + 10 * DEPTH;

constexpr size_t MiB = 1u << 20;
constexpr size_t WS_CTL = 0, CTL_ZERO_BYTES = 1 * MiB;
constexpr size_t WS_ROPE = 1 * MiB;
constexpr size_t WS_LRUW = 2 * MiB;
constexpr size_t WS_WIN = 4 * MiB;
constexpr size_t WS_WOUT = 22 * MiB;
constexpr size_t WS_WGU = 32 * MiB;
constexpr size_t WS_WDN = 544 * MiB;
constexpr size_t WS_H = 800 * MiB;
constexpr size_t WS_PROJ = 832 * MiB;
constexpr size_t WS_Y = 904 * MiB;
constexpr size_t WS_MG = 936 * MiB;
constexpr size_t WS_AFF = 937 * MiB;
constexpr size_t WS_SEL = 938 * MiB;
constexpr size_t WS_IDX = 939 * MiB;
constexpr size_t WS_GATE = WS_IDX + 128 * 1024;
constexpr size_t WS_LH = 940 * MiB;
constexpr size_t WS_CP = 956 * MiB;
constexpr size_t WS_CARRY = 972 * MiB;
constexpr size_t WS_CLOC = 974 * MiB;
constexpr size_t WS_NLOC = 990 * MiB;
constexpr size_t WS_MLOC = WS_NLOC + 512 * 1024;
constexpr size_t WS_XG = 992 * MiB;
constexpr size_t WS_HID = 1056 * MiB;
constexpr size_t WS_YE = 1184 * MiB;
constexpr size_t WS_END = 1248 * MiB;
constexpr int CW_BAR = 4096;

constexpr int RING_OFF = 0, RING_BYTES = 143360;
constexpr int MISC_OFF = RING_BYTES;
constexpr int LDS_BYTES = 147456;

typedef unsigned u32x2 __attribute__((ext_vector_type(2)));
__device__ __forceinline__ float bf2f(unsigned short v) { return __uint_as_float(((unsigned)v) << 16); }
__device__ __forceinline__ float bflo(unsigned v) { return __uint_as_float(v << 16); }
__device__ __forceinline__ float bfhi(unsigned v) { return __uint_as_float(v & 0xffff0000u); }
template <int CTRL> __device__ __forceinline__ float dppf(float v) { return __uint_as_float((unsigned)__builtin_amdgcn_update_dpp(0, (int)__float_as_uint(v), CTRL, 0xF, 0xF, true)); }
__device__ __forceinline__ float row16_sum(float v) { v += dppf<0xB1>(v); v += dppf<0x4E>(v); v += dppf<0x141>(v); v += dppf<0x140>(v); return v; }
__device__ __forceinline__ float xor16_sum(float v) { const auto r = __builtin_amdgcn_permlane16_swap(__float_as_uint(v), __float_as_uint(v), false, false); return __uint_as_float(r[0]) + __uint_as_float(r[1]); }
__device__ __forceinline__ float xor32_sum(float v) { const auto r = __builtin_amdgcn_permlane32_swap(__float_as_uint(v), __float_as_uint(v), false, false); return __uint_as_float(r[0]) + __uint_as_float(r[1]); }
__device__ __forceinline__ float half_sum(float v) { return xor16_sum(row16_sum(v)); }
__device__ __forceinline__ float wave_sum(float v) { return xor32_sum(xor16_sum(row16_sum(v))); }
__device__ __forceinline__ float wave_max(float v) {
#pragma unroll
    for (int o = 1; o < 64; o <<= 1) v = fmaxf(v, __shfl_xor(v, o));
    return v;
}
__device__ __forceinline__ float fexp(float x) { return __builtin_amdgcn_exp2f(1.4426950408889634f * x); }
__device__ __forceinline__ float frcp(float x) { return __builtin_amdgcn_rcpf(x); }
__device__ __forceinline__ float frsq(float x) { return __builtin_amdgcn_rsqf(x); }
__device__ __forceinline__ float sigmoid_f(float x) { return frcp(1.0f + fexp(-x)); }
__device__ __forceinline__ float one_minus_exp(float x) {
    const float p = -x * (1.0f + 0.5f * x * (1.0f + (1.0f / 3.0f) * x * (1.0f + 0.25f * x * (1.0f + 0.2f * x))));
    return (x > -0.25f) ? p : 1.0f - fexp(x); }
__device__ __forceinline__ float logsig_f(float x) { return fminf(x, 0.f) - log1pf(expf(-fabsf(x))); }
__device__ __forceinline__ float gelu_tanh_f(float x) { const float u = 0.7978845608028654f * (x + 0.044715f * x * x * x); return x * (1.0f - frcp(1.0f + fexp(2.0f * u))); }
template <bool MAXOP, bool REV> __device__ __forceinline__ void wave_scan128(const LAS float* in, LAS float* out, int lane) {
    const int j0 = REV ? 127 - 2 * lane : 2 * lane, j1 = REV ? 126 - 2 * lane : 2 * lane + 1;
    const float a = in[j0], b = in[j1];
    const float s1 = MAXOP ? fmaxf(a, b) : a + b;
    float incl = s1;
#pragma unroll
    for (int o = 1; o < 64; o <<= 1) { const float t = __shfl_up(incl, o); if (lane >= o) incl = MAXOP ? fmaxf(incl, t) : incl + t; }
    const float ex = __shfl_up(incl, 1);
    const float e = (lane == 0) ? (MAXOP ? -INFINITY : 0.f) : ex;
    out[j0] = MAXOP ? fmaxf(e, a) : e + a; out[j1] = MAXOP ? fmaxf(e, s1) : e + s1;
}
#define WAVE_LDS_FENCE() asm volatile("s_waitcnt lgkmcnt(0)" ::: "memory")
#define MFMA16(a, b, c) __builtin_amdgcn_mfma_f32_16x16x32_bf16((a), (b), (c), 0, 0, 0)
#define WG_SYNC() __syncthreads()

struct Args { const float* in[22]; float* out; unsigned char* ws; int ph_lo, ph_hi, li, pad; };
enum { I_X = 0, I_N1G, I_WIN, I_QG, I_KG, I_CW, I_CB, I_WA, I_BA, I_WX, I_BX, I_LAM, I_FB, I_MNG, I_AOG, I_LOG, I_WOUT, I_N2G, I_WR, I_WG, I_WU, I_WD };

__device__ __forceinline__ void cvt_item(const float* __restrict__ src, int N, int k0, int n0, bf16* dst, int Kd, LAS float* scr, int lane) {
    { const int r4 = lane >> 4, c4 = lane & 15; f32x4 t[16];
#pragma unroll
      for (int i = 0; i < 16; ++i) t[i] = *(const f32x4*)(src + (size_t)(k0 + 4 * i + r4) * N + n0 + 4 * c4);
#pragma unroll
      for (int i = 0; i < 16; ++i) { LAS float* d = scr + (4 * i + r4) * 65 + 4 * c4; d[0] = t[i][0]; d[1] = t[i][1]; d[2] = t[i][2]; d[3] = t[i][3]; } }
    LDS_WAIT(); asm volatile("" ::: "memory");
    const int c = lane >> 3, nn = lane & 7;
#pragma unroll
    for (int j = 0; j < 8; ++j) { const int n = nn + 8 * j; const LAS float* s = scr + (8 * c) * 65 + n;
        v4u o; o.x = pk2(s[0], s[65]); o.y = pk2(s[130], s[195]); o.z = pk2(s[260], s[325]); o.w = pk2(s[390], s[455]);
        *(GAS v4u*)(dst + (size_t)n * Kd + 8 * c) = o; }
    LDS_WAIT(); asm volatile("" ::: "memory");
}
__device__ __forceinline__ void cvt_item8(const float* __restrict__ src, int N, int k0, int n0, unsigned char* dst, int Kd, LAS float* scr, int lane) {
    { const int r8 = lane >> 3, c8 = lane & 7; f32x4 t[16];
#pragma unroll
      for (int i = 0; i < 16; ++i) t[i] = *(const f32x4*)(src + (size_t)(k0 + 8 * i + r8) * N + n0 + 4 * c8);
#pragma unroll
      for (int i = 0; i < 16; ++i) { LAS float* d = scr + (8 * i + r8) * 33 + 4 * c8; d[0] = t[i][0]; d[1] = t[i][1]; d[2] = t[i][2]; d[3] = t[i][3]; } }
    LDS_WAIT(); asm volatile("" ::: "memory");
    const int c = lane >> 3, nn = lane & 7; constexpr float sc = pg8::WSCALE;
#pragma unroll
    for (int j = 0; j < 4; ++j) { const int n = nn + 8 * j; const LAS float* s = scr + (16 * c) * 33 + n;
        v4u o; o.x = pg8::pk4_fp8(s[0] * sc, s[33] * sc, s[66] * sc, s[99] * sc); o.y = pg8::pk4_fp8(s[132] * sc, s[165] * sc, s[198] * sc, s[231] * sc);
        o.z = pg8::pk4_fp8(s[264] * sc, s[297] * sc, s[330] * sc, s[363] * sc); o.w = pg8::pk4_fp8(s[396] * sc, s[429] * sc, s[462] * sc, s[495] * sc);
        *(GAS v4u*)(dst + (size_t)n * Kd + 16 * c) = o; }
    LDS_WAIT(); asm volatile("" ::: "memory");
}
__device__ __forceinline__ void p0_weights(const Args& a, LAS unsigned char* lds, int tid, int lane, int wave, int G, int bid) {
    unsigned char* ws = a.ws;
    LAS float* scr = (LAS float*)(lds + RING_OFF + wave * 16896);
    const int gw = bid * NWAVES + wave, NGW = G * NWAVES;
    constexpr int I_IN = 16 * 36, I_OUT = 16 * 16, I_EXP = 1536, PER_LAYER = I_IN + I_OUT + NE * I_EXP, NITEMS = DEPTH * PER_LAYER;
    for (int it = gw; it < NITEMS; it += NGW) {
        const int l = it / PER_LAYER; int r = it - l * PER_LAYER;
        if (r < I_IN) { const int kb = r / 36, nb = r - kb * 36;
            cvt_item(a.in[I_WIN] + (size_t)l * DM * DIN, DIN, 64 * kb, 64 * nb, (bf16*)(ws + WS_WIN) + ((size_t)l * NPROJ + 64 * nb) * DM + 64 * kb, DM, scr, lane); continue; }
        r -= I_IN;
        if (r < I_OUT) { const int kb = r >> 4, nb = r & 15;
            cvt_item(a.in[I_WOUT] + (size_t)l * DM * DM, DM, 64 * kb, 64 * nb, (bf16*)(ws + WS_WOUT) + ((size_t)l * DM + 64 * nb) * DM + 64 * kb, DM, scr, lane); continue; }
        r -= I_OUT;
        const int e = r / I_EXP; int r2 = r - e * I_EXP; const size_t le = (size_t)l * NE + e;
        LAS float* scr8 = (LAS float*)(lds + RING_OFF + wave * 16896);
        if (r2 < 1024) { const int up = r2 >> 9; r2 &= 511; const int kb = r2 >> 6, nb = r2 & 63, n0 = 32 * nb, drow = 256 * (n0 >> 7) + (n0 & 127) + 128 * up;
            cvt_item8(a.in[up ? I_WU : I_WG] + le * DM * DE, DE, 128 * kb, n0, ws + WS_WGU + (le * 4096 + drow) * DM + 128 * kb, DM, scr8, lane); continue; }
        r2 -= 1024; { const int kb = r2 >> 5, nb = r2 & 31;
            cvt_item8(a.in[I_WD] + le * DE * DM, DM, 128 * kb, 32 * nb, ws + WS_WDN + (le * DM + 32 * nb) * DE + 128 * kb, DE, scr8, lane); }
    }
    const int gt = bid * NTHR + tid, GT = G * NTHR;
    bf16* lw = (bf16*)(ws + WS_LRUW);
    for (int i = gt; i < DEPTH * 2 * 2 * 4 * 4096; i += GT) { const int d = i & 63, e = (i >> 6) & 63, n = (i >> 12) & 3, gate = (i >> 14) & 1, dir = (i >> 15) & 1, l = i >> 16;
        const float* src = a.in[gate ? I_WX : I_WA]; lw[i] = (bf16)f2bf(src[((((size_t)l * 2 + dir) * 4 + n) * 64 + d) * 64 + e]); }
    float* rc = (float*)(ws + WS_ROPE); float* rs = rc + SEQ * 32;
    for (int i = gt; i < SEQ * 32; i += GT) { const int s = i >> 5, j = i & 31, f = j & 15; const float pos = (float)((j < 16) ? (s >> 6) : (s & 63));
        const float inv = 1.0f / powf(10000.0f, (float)f * (1.0f / 16.0f)); const float ang = pos * inv; rc[i] = cosf(ang); rs[i] = sinf(ang); }
}

template <int MODE>
__device__ __forceinline__ void row_pass(const float* xin, float* xout, const float* gain, const float* WT  , int sk, bf16* H, float* O16, const int* SEL, const bf16* YE,
                                         LAS unsigned char* lds, int tid, int lane, int wave, int G, int bid) {
    constexpr int WLS = 1028;
    LAS float* wl = (LAS float*)(lds + RING_OFF);
    if (MODE != 3) { float wv[32];
#pragma unroll
        for (int q = 0; q < 32; ++q) { const int i = tid + q * NTHR; wv[q] = WT[(size_t)(i >> 4) * sk + (i & 15)]; }
#pragma unroll
        for (int q = 0; q < 32; ++q) { const int i = tid + q * NTHR; wl[(i & 15) * WLS + (i >> 4)] = wv[q]; } }
    WG_SYNC();
    const int gw = bid * NWAVES + wave, NGW = G * NWAVES;
    f32x4 gq4[4];
#pragma unroll
    for (int j = 0; j < 4; ++j) gq4[j] = (MODE != 3) ? *((const f32x4*)gain + 64 * j + lane) : (f32x4){0.f, 0.f, 0.f, 0.f};
    constexpr int R = 4;
    for (int m0 = R * gw; m0 < M; m0 += R * NGW) {
        asm volatile("" ::: "memory");
        f32x4 v[R][4];
#pragma unroll
        for (int r = 0; r < R; ++r)
#pragma unroll
            for (int j = 0; j < 4; ++j) v[r][j] = *((const f32x4*)(xin + (size_t)(m0 + r) * DM) + 64 * j + lane);
        if (MODE >= 2) {
            const int b = m0 >> 11; int selv[R]; unsigned long long mk[R];
#pragma unroll
            for (int r = 0; r < R; ++r) { selv[r] = (lane < NE) ? SEL[(size_t)(m0 + r) * NE + lane] : -1; }
#pragma unroll
            for (int r = 0; r < R; ++r) mk[r] = __ballot(selv[r] >= 0);
            while (mk[0] | mk[1] | mk[2] | mk[3]) {
                u32x2 q[R][2][4]; float wt[R][2];
#pragma unroll
                for (int r = 0; r < R; ++r)
#pragma unroll
                    for (int i = 0; i < 2; ++i) { const bf16* yr = YE; wt[r][i] = 0.f;
                        if (mk[r]) { const int e = __builtin_ctzll(mk[r]); mk[r] &= mk[r] - 1ull; const int sl = __builtin_amdgcn_readlane(selv[r], e);
                            yr = YE + ((size_t)e * NSLOT + b * CAP + sl) * DM; wt[r][i] = 1.f; }
#pragma unroll
                        for (int j = 0; j < 4; ++j) q[r][i][j] = *((const u32x2*)yr + 64 * j + lane); }
#pragma unroll
                for (int r = 0; r < R; ++r)
#pragma unroll
                    for (int i = 0; i < 2; ++i)
#pragma unroll
                        for (int j = 0; j < 4; ++j) { const u32x2 w = q[r][i][j]; const float t = wt[r][i];
                            v[r][j][0] += t * bflo(w.x); v[r][j][1] += t * bfhi(w.x); v[r][j][2] += t * bflo(w.y); v[r][j][3] += t * bfhi(w.y); }
            }
#pragma unroll
            for (int r = 0; r < R; ++r)
#pragma unroll
                for (int j = 0; j < 4; ++j) *((f32x4*)(xout + (size_t)(m0 + r) * DM) + 64 * j + lane) = v[r][j];
        }
        if (MODE == 3) continue;
        float ss[R];
#pragma unroll
        for (int r = 0; r < R; ++r) { float a = 0.f;
#pragma unroll
            for (int j = 0; j < 4; ++j) a += (v[r][j][0] * v[r][j][0] + v[r][j][1] * v[r][j][1]) + (v[r][j][2] * v[r][j][2] + v[r][j][3] * v[r][j][3]);
            ss[r] = wave_sum(a); }
#pragma unroll
        for (int r = 0; r < R; ++r) { const float rstd = frsq(ss[r] * (1.0f / DM) + EPS);
#pragma unroll
            for (int j = 0; j < 4; ++j) { v[r][j] = v[r][j] * rstd * gq4[j];
                if (MODE == 1) { *((unsigned*)((unsigned char*)H + (size_t)(m0 + r) * DM) + 64 * j + lane) = pg8::pk4_fp8(v[r][j][0], v[r][j][1], v[r][j][2], v[r][j][3]); }
                else { u32x2 o; o.x = pk2(v[r][j][0], v[r][j][1]); o.y = pk2(v[r][j][2], v[r][j][3]); *((u32x2*)(H + (size_t)(m0 + r) * DM) + 64 * j + lane) = o; } } }
        float p[R][16];
#pragma unroll
        for (int jj = 0; jj < 16; ++jj) { float a[R];
#pragma unroll
            for (int r = 0; r < R; ++r) a[r] = 0.f;
#pragma unroll
            for (int j = 0; j < 4; ++j) { const f32x4 w = *((LAS f32x4*)(wl + jj * WLS) + 64 * j + lane);
#pragma unroll
                for (int r = 0; r < R; ++r) a[r] += (v[r][j][0] * w[0] + v[r][j][1] * w[1]) + (v[r][j][2] * w[2] + v[r][j][3] * w[3]); }
#pragma unroll
            for (int r = 0; r < R; ++r) p[r][jj] = wave_sum(a[r]); }
#pragma unroll
        for (int r = 0; r < R; ++r) { const int m = m0 + r;
            if (MODE == 1) {
                float mx = p[r][0];
#pragma unroll
                for (int jj = 1; jj < 16; ++jj) mx = fmaxf(mx, p[r][jj]);
                float sum = 0.f;
#pragma unroll
                for (int jj = 0; jj < 16; ++jj) { p[r][jj] = fexp(p[r][jj] - mx); sum += p[r][jj]; }
                float mine = 0.f;
#pragma unroll
                for (int jj = 0; jj < 16; ++jj) mine = (lane == jj) ? p[r][jj] : mine;
                if (lane < 16) O16[(((size_t)(m >> 11) * NE + lane) << 11) + (m & 2047)] = mine / sum;
            } else {
                float mine = 0.f;
#pragma unroll
                for (int jj = 0; jj < 16; ++jj) mine = (lane == jj) ? p[r][jj] : mine;
                if (lane < 16) O16[(size_t)m * 16 + lane] = mine;
            } }
    }
}

__device__ __forceinline__ void rope_pass(const Args& a, int l, int lane, int wave, int G, int bid, bf16* DST) {
    bf16* PROJ = (bf16*)(a.ws + WS_PROJ); const float* rc = (const float*)(a.ws + WS_ROPE); const float* rs = rc + SEQ * 32;
    const float* qg = a.in[I_QG] + l * 64; const float* kg = a.in[I_KG] + l * 64;
    const int gw = bid * NWAVES + wave, NGW = G * NWAVES, j = lane & 31;
    const float qg1 = qg[j], qg2 = qg[32 + j], kg1 = kg[j], kg2 = kg[32 + j];
    for (int mb = 2 * gw; mb < M; mb += 2 * NGW) {
        float x1[2][5], x2[2][5], cs[2], sn[2];
#pragma unroll
        for (int r = 0; r < 2; ++r) { const bf16* row = PROJ + (size_t)(mb + r) * NPROJ; const int s = (mb + r) & 2047; cs[r] = rc[s * 32 + j]; sn[r] = rs[s * 32 + j];
#pragma unroll
            for (int it = 0; it < 5; ++it) { const int hh = 2 * it + (lane >> 5); x1[r][it] = bf2f(row[hh * 64 + j]); x2[r][it] = bf2f(row[hh * 64 + 32 + j]); } }
#pragma unroll
        for (int r = 0; r < 2; ++r) { bf16* row = DST + (size_t)(mb + r) * NPROJ;
#pragma unroll
            for (int it = 0; it < 5; ++it) { const int hh = 2 * it + (lane >> 5);
                const float ss = half_sum(x1[r][it] * x1[r][it] + x2[r][it] * x2[r][it]);
                const float rstd = frsq(ss * (1.0f / 64.0f) + EPS);
                const float n1 = x1[r][it] * rstd * (it < 4 ? qg1 : kg1), n2 = x2[r][it] * rstd * (it < 4 ? qg2 : kg2);
                float o1 = n1 * cs[r] - n2 * sn[r], o2 = n2 * cs[r] + n1 * sn[r];
                if (it < 4) { o1 *= attn_body::C2; o2 *= attn_body::C2; }
                row[hh * 64 + j] = (bf16)f2bf(o1); row[hh * 64 + 32 + j] = (bf16)f2bf(o2); } }
    }
}

constexpr int XS = 260;
__device__ __forceinline__ void lru_a_unit(const Args& a, int l, int unit, LAS unsigned char* lds, int tid, int lane, int wave) {
    const int b = unit >> 6, c32 = unit & 63, t0 = c32 * 32; const size_t m0 = (size_t)b * SEQ + t0;
    LAS float* XC = (LAS float*)(lds + RING_OFF); LAS float* AA = XC + 32 * XS; LAS float* UU = AA + 32 * XS;
    const bf16* PROJ = (const bf16*)(a.ws + WS_PROJ);
    {
        const int ch2 = tid & 127, rg = tid >> 7, ch = 2 * ch2;
        float x0[11], x1[11];
#pragma unroll
        for (int i = 0; i < 11; ++i) { const int s = t0 + rg * 8 - 2 + i; unsigned v = 0u;
            if (s >= 0 && s < SEQ) v = *(const unsigned*)(PROJ + ((size_t)b * SEQ + s) * NPROJ + C_LX + ch);
            x0[i] = bflo(v); x1[i] = bfhi(v); }
        const float* cw = a.in[I_CW] + (size_t)l * 4 * 256; const float* cb = a.in[I_CB] + (size_t)l * 256;
        float w0[4], w1[4];
#pragma unroll
        for (int j = 0; j < 4; ++j) { w0[j] = cw[j * 256 + ch]; w1[j] = cw[j * 256 + ch + 1]; }
        const float b0 = cb[ch], b1 = cb[ch + 1];
#pragma unroll
        for (int r = 0; r < 8; ++r) { float y0 = b0, y1 = b1;
#pragma unroll
            for (int j = 0; j < 4; ++j) { y0 += x0[r + j] * w0[j]; y1 += x1[r + j] * w1[j]; }
            XC[(rg * 8 + r) * XS + ch] = y0; XC[(rg * 8 + r) * XS + ch + 1] = y1; }
    }
    WG_SYNC();
    const int n = wave >> 1, hh = wave & 1, li = lane & 15, g = lane >> 4;
    bf16* LH = (bf16*)(a.ws + WS_LH); bf16* CPb = (bf16*)(a.ws + WS_CP); float* CARRY = (float*)(a.ws + WS_CARRY);
    for (int dir = 0; dir < 2; ++dir) {
        {
            f32x4 accA[2][2], accX[2][2];
#pragma unroll
            for (int i = 0; i < 2; ++i)
#pragma unroll
                for (int j = 0; j < 2; ++j) { accA[i][j] = (f32x4){0.f, 0.f, 0.f, 0.f}; accX[i][j] = (f32x4){0.f, 0.f, 0.f, 0.f}; }
            const bf16* WA = (const bf16*)(a.ws + WS_LRUW) + ((((size_t)l * 2 + dir) * 2 + 0) * 4 + n) * 4096;
            const bf16* WX = (const bf16*)(a.ws + WS_LRUW) + ((((size_t)l * 2 + dir) * 2 + 1) * 4 + n) * 4096;
#pragma unroll
            for (int ks = 0; ks < 2; ++ks) {
                bf16x8 af[2];
#pragma unroll
                for (int mt = 0; mt < 2; ++mt) { const LAS float* p = XC + (16 * mt + li) * XS + 64 * n + 32 * ks + 8 * g;
                    const f32x4 q0 = *(const LAS f32x4*)p, q1 = *(const LAS f32x4*)(p + 4);
                    v4u pk; pk.x = pk2(q0[0], q0[1]); pk.y = pk2(q0[2], q0[3]); pk.z = pk2(q1[0], q1[1]); pk.w = pk2(q1[2], q1[3]); af[mt] = __builtin_bit_cast(bf16x8, pk); }
#pragma unroll
                for (int nt = 0; nt < 2; ++nt) { const int ep = 32 * hh + 16 * nt + li;
                    const bf16x8 ba = *(const bf16x8*)(WA + ep * 64 + 32 * ks + 8 * g), bx = *(const bf16x8*)(WX + ep * 64 + 32 * ks + 8 * g);
#pragma unroll
                    for (int mt = 0; mt < 2; ++mt) { accA[mt][nt] = MFMA16(af[mt], ba, accA[mt][nt]); accX[mt][nt] = MFMA16(af[mt], bx, accX[mt][nt]); } }
            }
#pragma unroll
            for (int nt = 0; nt < 2; ++nt) { const int ch = 64 * n + 32 * hh + 16 * nt + li; const size_t pi = ((size_t)l * 2 + dir) * 256 + ch;
                const float bav = a.in[I_BA][pi], bxv = a.in[I_BX][pi], lam = a.in[I_LAM][pi];
                const float sp = fmaxf(-lam, 0.f) + log1pf(expf(-fabsf(lam)));
#pragma unroll
                for (int mt = 0; mt < 2; ++mt)
#pragma unroll
                    for (int r = 0; r < 4; ++r) { const int t = 16 * mt + 4 * g + r;
                        const float rg_ = sigmoid_f(accA[mt][nt][r] + bav), ig_ = sigmoid_f(accX[mt][nt][r] + bxv);
                        const float la = -8.0f * rg_ * sp; const float av = fexp(la);
                        const float uv = __builtin_amdgcn_sqrtf(one_minus_exp(2.0f * la)) * (ig_ * XC[t * XS + ch]);
                        AA[t * XS + ch] = av; UU[t * XS + ch] = uv; } }
        }
        WG_SYNC();
        if (tid < 256) { const int ch = tid; float h = 0.f, cp = 1.f;
            bf16* lh = LH + ((size_t)dir * M + m0) * 256 + ch; bf16* cpo = CPb + ((size_t)dir * M + m0) * 256 + ch;
            for (int q = 0; q < 32; ++q) { const int t = dir ? 31 - q : q; const float av = AA[t * XS + ch], uv = UU[t * XS + ch];
                h = av * h + uv; cp *= av; lh[(size_t)t * 256] = (bf16)f2bf(h); cpo[(size_t)t * 256] = (bf16)f2bf(cp); }
            float* cr = CARRY + ((((size_t)dir * NB + b) * 64 + c32) * 2) * 256 + ch; cr[0] = cp; cr[256] = h; }
        WG_SYNC();
    }
}

__device__ __forceinline__ void lru_b_unit(const Args& a, int l, int unit, LAS unsigned char* lds, int tid, int lane, int wave) {
    const int b = unit >> 6, c32 = unit & 63; const size_t m0 = (size_t)b * SEQ + c32 * 32;
    LAS float* CIN = (LAS float*)(lds + RING_OFF);
    const float* CARRY = (const float*)(a.ws + WS_CARRY);
    { const int dir = tid >> 8, ch = tid & 255; const float* cr = CARRY + (((size_t)dir * NB + b) * 64) * 512 + ch; float cin = 0.f;
      const int n = dir ? 63 - c32 : c32;
      for (int base = 0; base < n; base += 16) { float P[16], Hh[16];
#pragma unroll
          for (int i = 0; i < 16; ++i) { const int q = base + i; const bool v = q < n; const int k = v ? (dir ? 63 - q : q) : c32;
              const float p = cr[(size_t)k * 512], h = cr[(size_t)k * 512 + 256]; P[i] = v ? p : 1.f; Hh[i] = v ? h : 0.f; }
#pragma unroll
          for (int i = 0; i < 16; ++i) cin = P[i] * cin + Hh[i]; }
      CIN[tid] = cin; }
    WG_SYNC();
    const bf16* LH = (const bf16*)(a.ws + WS_LH); const bf16* CPb = (const bf16*)(a.ws + WS_CP); const bf16* PROJ = (const bf16*)(a.ws + WS_PROJ); bf16* Y = (bf16*)(a.ws + WS_Y);
    const f32x4 cf = *(const LAS f32x4*)(CIN + 4 * lane), cb = *(const LAS f32x4*)(CIN + 256 + 4 * lane);
    const f32x4 og = *(const f32x4*)(a.in[I_LOG] + (size_t)l * 256 + 4 * lane);
#pragma unroll
    for (int q = 0; q < 4; ++q) { const size_t m = m0 + wave * 4 + q;
        const u32x2 lf = *(const u32x2*)(LH + m * 256 + 4 * lane), pf = *(const u32x2*)(CPb + m * 256 + 4 * lane);
        const u32x2 lb = *(const u32x2*)(LH + ((size_t)M + m) * 256 + 4 * lane), pb = *(const u32x2*)(CPb + ((size_t)M + m) * 256 + 4 * lane);
        const u32x2 gt = *(const u32x2*)(PROJ + m * NPROJ + C_LG + 4 * lane);
        f32x4 h;
        h[0] = (bflo(lf.x) + bflo(pf.x) * cf[0]) + (bflo(lb.x) + bflo(pb.x) * cb[0]);
        h[1] = (bfhi(lf.x) + bfhi(pf.x) * cf[1]) + (bfhi(lb.x) + bfhi(pb.x) * cb[1]);
        h[2] = (bflo(lf.y) + bflo(pf.y) * cf[2]) + (bflo(lb.y) + bflo(pb.y) * cb[2]);
        h[3] = (bfhi(lf.y) + bfhi(pf.y) * cf[3]) + (bfhi(lb.y) + bfhi(pb.y) * cb[3]);
        h[0] *= gelu_tanh_f(bflo(gt.x)); h[1] *= gelu_tanh_f(bfhi(gt.x)); h[2] *= gelu_tanh_f(bflo(gt.y)); h[3] *= gelu_tanh_f(bfhi(gt.y));
        const float ss = wave_sum((h[0] * h[0] + h[1] * h[1]) + (h[2] * h[2] + h[3] * h[3]));
        const float rstd = frsq(ss * (1.0f / 256.0f) + EPS);
        u32x2 o; o.x = pk2(h[0] * rstd * og[0], h[1] * rstd * og[1]); o.y = pk2(h[2] * rstd * og[2], h[3] * rstd * og[3]);
        *(u32x2*)(Y + m * DM + 512 + 4 * lane) = o; }
    WG_SYNC();
}

__device__ __forceinline__ void mls_gates(const Args& a, int l, size_t m0, int hd, LAS float* GL, int tid) {
    if (tid < 128) { const float* r = (const float*)(a.ws + WS_MG) + (m0 + tid) * 16; const float* fb = a.in[I_FB] + (size_t)l * 8;
        GL[tid] = logsig_f(r[4 + hd] + fb[hd]); GL[128 + tid] = logsig_f(r[12 + hd] + fb[4 + hd]); GL[256 + tid] = r[hd]; GL[384 + tid] = r[8 + hd]; }
    WG_SYNC();
    if (tid < 64) wave_scan128<false, false>(GL, GL + 512, tid);
    else if (tid < 128) wave_scan128<false, true>(GL + 128, GL + 640, tid - 64);
    WG_SYNC();
}
constexpr int TS = 136;
constexpr int QS_ = 72;

__device__ __forceinline__ void mls_a_unit(const Args& a, int l, int unit, LAS unsigned char* lds, int tid, int lane, int wave) {
    const int c = unit & 15, hd = (unit >> 4) & 3, b = unit >> 6; const size_t m0 = (size_t)b * SEQ + c * 128;
    LAS float* GL = (LAS float*)(lds + RING_OFF);
    LAS float* WW = GL + 768;
    LAS bf16* VT = (LAS bf16*)(lds + RING_OFF + 4096); LAS bf16* KF = VT + 64 * TS; LAS bf16* KB = KF + 64 * TS;
    mls_gates(a, l, m0, hd, GL, tid);
    float* MLOC = (float*)(a.ws + WS_MLOC); float* NLOC = (float*)(a.ws + WS_NLOC); float* CLOC = (float*)(a.ws + WS_CLOC);
    const size_t sbase = ((size_t)b * 4 + hd) * 2;
    if (wave < 2) { const int dir = wave; const float gtot = dir ? GL[640] : GL[512 + 127]; const LAS float* Bc = GL + 512 + 128 * dir; const LAS float* IG = GL + 256 + 128 * dir;
        const float lw0 = gtot - Bc[lane] + IG[lane], lw1 = gtot - Bc[lane + 64] + IG[lane + 64];
        const float mx = wave_max(fmaxf(lw0, lw1));
        WW[dir * 128 + lane] = fexp(lw0 - mx); WW[dir * 128 + lane + 64] = fexp(lw1 - mx);
        if (lane == 0) { float* o = MLOC + ((sbase + dir) * 16 + c) * 2; o[0] = mx; o[1] = gtot; } }
    WG_SYNC();
    { const int j = tid & 127, part = tid >> 7; const bf16* PROJ = (const bf16*)(a.ws + WS_PROJ);
      const bf16* kp = PROJ + (m0 + j) * NPROJ + C_MK + hd * 64 + 16 * part; const bf16* vp = PROJ + (m0 + j) * NPROJ + C_MV + hd * 64 + 16 * part;
      const v4u k0 = *(const v4u*)kp, k1 = *(const v4u*)(kp + 8), v0 = *(const v4u*)vp, v1 = *(const v4u*)(vp + 8);
      const float wf = WW[j] * 0.125f, wb = WW[128 + j] * 0.125f;
      const unsigned kk[8] = {k0.x, k0.y, k0.z, k0.w, k1.x, k1.y, k1.z, k1.w}; const unsigned vv[8] = {v0.x, v0.y, v0.z, v0.w, v1.x, v1.y, v1.z, v1.w};
#pragma unroll
      for (int q = 0; q < 8; ++q) { const int e0 = 16 * part + 2 * q; const float ka = bflo(kk[q]), kb = bfhi(kk[q]);
          KF[e0 * TS + j] = (bf16)f2bf(ka * wf); KF[(e0 + 1) * TS + j] = (bf16)f2bf(kb * wf);
          KB[e0 * TS + j] = (bf16)f2bf(ka * wb); KB[(e0 + 1) * TS + j] = (bf16)f2bf(kb * wb);
          VT[e0 * TS + j] = (bf16)(vv[q] & 0xffffu); VT[(e0 + 1) * TS + j] = (bf16)(vv[q] >> 16); } }
    WG_SYNC();
    if (tid < 128) { const int dir = tid >> 6, e = tid & 63; const LAS bf16* kr = (dir ? KB : KF) + e * TS; float s = 0.f;
#pragma unroll
        for (int q = 0; q < 16; ++q) { const v4u w = *(const LAS v4u*)(kr + 8 * q); s += ((bflo(w.x) + bfhi(w.x)) + (bflo(w.y) + bfhi(w.y))) + ((bflo(w.z) + bfhi(w.z)) + (bflo(w.w) + bfhi(w.w))); }
        NLOC[((sbase + dir) * 16 + c) * 64 + e] = s; }
    { const int dir = wave >> 2, mt = wave & 3, li = lane & 15, g = lane >> 4; const LAS bf16* KD = dir ? KB : KF;
      f32x4 acc[4];
#pragma unroll
      for (int nt = 0; nt < 4; ++nt) acc[nt] = (f32x4){0.f, 0.f, 0.f, 0.f};
#pragma unroll
      for (int ks = 0; ks < 4; ++ks) { const bf16x8 af = *(const LAS bf16x8*)(VT + (16 * mt + li) * TS + 32 * ks + 8 * g);
#pragma unroll
          for (int nt = 0; nt < 4; ++nt) { const bf16x8 bfv = *(const LAS bf16x8*)(KD + (16 * nt + li) * TS + 32 * ks + 8 * g); acc[nt] = MFMA16(af, bfv, acc[nt]); } }
      float* co = CLOC + ((sbase + dir) * 16 + c) * 4096;
#pragma unroll
      for (int nt = 0; nt < 4; ++nt)
#pragma unroll
          for (int r = 0; r < 4; ++r) co[(16 * mt + 4 * g + r) * 64 + 16 * nt + li] = acc[nt][r]; }
    WG_SYNC();
}

template <int DIR>
__device__ __forceinline__ void mls_dir(f32x4 (&hacc)[4], const LAS bf16* QS, const LAS bf16* KS, const LAS bf16* VT, const LAS bf16* CP, const LAS float* AJ, const LAS float* MM,
                                        const LAS float* INTER, const LAS float* FLOOR, const LAS float* NP, LAS float* rowbuf, int w, int lane) {
    const int li = lane & 15, g = lane >> 4, i = 16 * w + li;
    bf16x8 qf[2];
#pragma unroll
    for (int ks = 0; ks < 2; ++ks) qf[ks] = *(const LAS bf16x8*)(QS + i * QS_ + 32 * ks + 8 * g);
    const float mmi = MM[i];
    float den = 0.f;
    f32x4 out[4];
#pragma unroll
    for (int dt = 0; dt < 4; ++dt) out[dt] = (f32x4){0.f, 0.f, 0.f, 0.f};
#pragma unroll
    for (int kp = 0; kp < 4; ++kp) {
        const bool need = (DIR == 0) ? (2 * kp <= w) : (2 * kp + 1 >= w);
        if (need) {
            f32x4 s0 = (f32x4){0.f, 0.f, 0.f, 0.f}, s1 = (f32x4){0.f, 0.f, 0.f, 0.f};
#pragma unroll
            for (int ks = 0; ks < 2; ++ks) { const bf16x8 k0 = *(const LAS bf16x8*)(KS + (32 * kp + li) * QS_ + 32 * ks + 8 * g), k1 = *(const LAS bf16x8*)(KS + (32 * kp + 16 + li) * QS_ + 32 * ks + 8 * g);
                s0 = MFMA16(k0, qf[ks], s0); s1 = MFMA16(k1, qf[ks], s1); }
            float p[8];
#pragma unroll
            for (int r = 0; r < 4; ++r) { const int j0 = 32 * kp + 4 * g + r, j1 = j0 + 16;
                const bool v0 = (DIR == 0) ? (j0 <= i) : (j0 >= i), v1 = (DIR == 0) ? (j1 <= i) : (j1 >= i);
                const float a0 = v0 ? (AJ[j0] - mmi) : -INFINITY, a1 = v1 ? (AJ[j1] - mmi) : -INFINITY;
                p[r] = s0[r] * 0.125f * fexp(a0); p[4 + r] = s1[r] * 0.125f * fexp(a1); den += p[r] + p[4 + r]; }
            v4u pk; pk.x = pk2(p[0], p[1]); pk.y = pk2(p[2], p[3]); pk.z = pk2(p[4], p[5]); pk.w = pk2(p[6], p[7]);
            const bf16x8 pf = __builtin_bit_cast(bf16x8, pk);
#pragma unroll
            for (int dt = 0; dt < 4; ++dt) { const LAS bf16* vr = VT + (16 * dt + li) * TS + 32 * kp + 4 * g;
                const u32x2 lo = *(const LAS u32x2*)vr, hi = *(const LAS u32x2*)(vr + 16);
                v4u vk; vk.x = lo.x; vk.y = lo.y; vk.z = hi.x; vk.w = hi.y;
                out[dt] = MFMA16(pf, __builtin_bit_cast(bf16x8, vk), out[dt]); }
        }
    }
    f32x4 qc[4];
#pragma unroll
    for (int dt = 0; dt < 4; ++dt) { qc[dt] = (f32x4){0.f, 0.f, 0.f, 0.f};
#pragma unroll
        for (int ks = 0; ks < 2; ++ks) { const bf16x8 cf = *(const LAS bf16x8*)(CP + (16 * dt + li) * QS_ + 32 * ks + 8 * g); qc[dt] = MFMA16(qf[ks], cf, qc[dt]); } }
    float nq = 0.f;
#pragma unroll
    for (int q = 0; q < 16; ++q) nq += NP[16 * g + q] * bf2f(QS[i * QS_ + 16 * g + q]);
    den = xor32_sum(xor16_sum(den)); nq = xor32_sum(xor16_sum(nq));
    const float inter = INTER[i]; const float dn = fmaxf(fabsf(den + inter * nq), FLOOR[i]);
    asm volatile("s_waitcnt lgkmcnt(0)" ::: "memory");
    if (g == 0) { rowbuf[li] = inter; rowbuf[16 + li] = frcp(dn); }
    asm volatile("s_waitcnt lgkmcnt(0)" ::: "memory");
#pragma unroll
    for (int r = 0; r < 4; ++r) { const float it = rowbuf[4 * g + r], inv = rowbuf[16 + 4 * g + r];
#pragma unroll
        for (int dt = 0; dt < 4; ++dt) hacc[dt][r] += (out[dt][r] + it * qc[dt][r]) * inv; }
    asm volatile("s_waitcnt lgkmcnt(0)" ::: "memory");
}
__device__ __forceinline__ void mls_b_unit(const Args& a, int l, int unit, LAS unsigned char* lds, int tid, int lane, int wave) {
    const int c = unit & 15, hd = (unit >> 4) & 3, b = unit >> 6; const size_t m0 = (size_t)b * SEQ + c * 128;
    LAS float* GL = (LAS float*)(lds + RING_OFF);
    LAS float* AJ = GL + 768;
    LAS float* MMx = AJ + 256;
    LAS float* INT_ = MMx + 256;
    LAS float* FLR = INT_ + 256;
    LAS float* NP = FLR + 256;
    LAS float* COEF = NP + 128;
    LAS float* ROWB = COEF + 32;
    LAS bf16* QS = (LAS bf16*)(lds + RING_OFF + 16384); LAS bf16* KS = QS + 128 * QS_; LAS bf16* VT = KS + 128 * QS_; LAS bf16* CF = VT + 64 * TS; LAS bf16* CB = CF + 64 * QS_;
    mls_gates(a, l, m0, hd, GL, tid);
    const float* MLOC = (const float*)(a.ws + WS_MLOC); const float* NLOC = (const float*)(a.ws + WS_NLOC); const float* CLOC = (const float*)(a.ws + WS_CLOC);
    const size_t sbase = ((size_t)b * 4 + hd) * 2;
    if (wave < 2) {
        const int dir = wave; LAS float* SM = ROWB;
        if (lane < 32) SM[dir * 32 + lane] = MLOC[(sbase + dir) * 32 + lane];
        WAVE_LDS_FENCE();
        const LAS float* sm = SM + dir * 32;
        float m = 0.f;
        if (dir == 0) { for (int k = 0; k < c; ++k) m = fmaxf(sm[2 * k + 1] + m, sm[2 * k]); }
        else { for (int k = 15; k > c; --k) m = fmaxf(sm[2 * k + 1] + m, sm[2 * k]); }
        if (lane < 16) { float gs = 0.f;
            if (dir == 0) { for (int i = lane + 1; i < c; ++i) gs += sm[2 * i + 1]; } else { for (int i = c + 1; i < lane; ++i) gs += sm[2 * i + 1]; }
            const bool valid = dir == 0 ? (lane < c) : (lane > c);
            COEF[16 * dir + lane] = valid ? fexp(sm[2 * lane] + gs - m) : 0.f; }
        const LAS float* IG = GL + 256 + 128 * dir; const LAS float* Bc = GL + 512 + 128 * dir;
        LAS float* aj = AJ + 128 * dir; LAS float* mmx = MMx + 128 * dir;
        aj[lane] = IG[lane] - Bc[lane]; aj[lane + 64] = IG[lane + 64] - Bc[lane + 64];
        WAVE_LDS_FENCE();
        if (dir == 0) wave_scan128<true, false>(aj, mmx, lane); else wave_scan128<true, true>(aj, mmx, lane);
        WAVE_LDS_FENCE();
#pragma unroll
        for (int q = 0; q < 2; ++q) { const int j = lane + 64 * q; const float mm = fmaxf(mmx[j], m);
            mmx[j] = mm; INT_[128 * dir + j] = fexp(m - mm); FLR[128 * dir + j] = fexp(-(Bc[j] + mm)); }
    }
    {
        const int j = tid >> 2, q4 = tid & 3; const bf16* PROJ = (const bf16*)(a.ws + WS_PROJ); const bf16* rp = PROJ + (m0 + j) * NPROJ + hd * 64 + 16 * q4;
        const v4u q0 = *(const v4u*)(rp + C_MQ), q1 = *(const v4u*)(rp + C_MQ + 8), k0 = *(const v4u*)(rp + C_MK), k1 = *(const v4u*)(rp + C_MK + 8), v0 = *(const v4u*)(rp + C_MV), v1 = *(const v4u*)(rp + C_MV + 8);
        *(LAS v4u*)(QS + j * QS_ + 16 * q4) = q0; *(LAS v4u*)(QS + j * QS_ + 16 * q4 + 8) = q1;
        *(LAS v4u*)(KS + j * QS_ + 16 * q4) = k0; *(LAS v4u*)(KS + j * QS_ + 16 * q4 + 8) = k1;
        const unsigned vv[8] = {v0.x, v0.y, v0.z, v0.w, v1.x, v1.y, v1.z, v1.w};
#pragma unroll
        for (int q = 0; q < 8; ++q) { const int d0 = 16 * q4 + 2 * q; VT[d0 * TS + j] = (bf16)(vv[q] & 0xffffu); VT[(d0 + 1) * TS + j] = (bf16)(vv[q] >> 16); }
    }
    WG_SYNC();
    {
        const int idx = tid * 8;
        f32x4 f0 = (f32x4){0.f, 0.f, 0.f, 0.f}, f1 = f0, b0 = f0, b1 = f0;
#pragma unroll
        for (int kb = 0; kb < 2; ++kb) { f32x4 t0[8], t1[8];
#pragma unroll
            for (int q = 0; q < 8; ++q) { const int k = 8 * kb + q; const float* src = CLOC + ((sbase + (k > c ? 1 : 0)) * 16 + k) * 4096 + idx; t0[q] = *(const f32x4*)src; t1[q] = *(const f32x4*)(src + 4); }
#pragma unroll
            for (int q = 0; q < 8; ++q) { const int k = 8 * kb + q; const float cf = COEF[k], cb = COEF[16 + k]; f0 += cf * t0[q]; f1 += cf * t1[q]; b0 += cb * t0[q]; b1 += cb * t1[q]; } }
        { v4u pk; pk.x = pk2(f0[0], f0[1]); pk.y = pk2(f0[2], f0[3]); pk.z = pk2(f1[0], f1[1]); pk.w = pk2(f1[2], f1[3]); *(LAS v4u*)(CF + (idx >> 6) * QS_ + (idx & 63)) = pk; }
        { v4u pk; pk.x = pk2(b0[0], b0[1]); pk.y = pk2(b0[2], b0[3]); pk.z = pk2(b1[0], b1[1]); pk.w = pk2(b1[2], b1[3]); *(LAS v4u*)(CB + (idx >> 6) * QS_ + (idx & 63)) = pk; }
        if (tid < 128) { const int dir = tid >> 6, e = tid & 63; float nv[16]; float s = 0.f;
#pragma unroll
            for (int k = 0; k < 16; ++k) nv[k] = NLOC[((sbase + dir) * 16 + k) * 64 + e];
#pragma unroll
            for (int k = 0; k < 16; ++k) s += COEF[16 * dir + k] * nv[k];
            NP[tid] = s; }
    }
    WG_SYNC();
    f32x4 hacc[4];
#pragma unroll
    for (int dt = 0; dt < 4; ++dt) hacc[dt] = (f32x4){0.f, 0.f, 0.f, 0.f};
    mls_dir<0>(hacc, QS, KS, VT, CF, AJ, MMx, INT_, FLR, NP, ROWB + wave * 32, wave, lane);
    mls_dir<1>(hacc, QS, KS, VT, CB, AJ + 128, MMx + 128, INT_ + 128, FLR + 128, NP + 64, ROWB + wave * 32, wave, lane);
    {
        const int li = lane & 15, g = lane >> 4; const bf16* PROJ = (const bf16*)(a.ws + WS_PROJ); bf16* Y = (bf16*)(a.ws + WS_Y);
        const float* hg = a.in[I_MNG] + ((size_t)l * 4 + hd) * 64;
#pragma unroll
        for (int r = 0; r < 4; ++r) { float ss = (hacc[0][r] * hacc[0][r] + hacc[1][r] * hacc[1][r]) + (hacc[2][r] * hacc[2][r] + hacc[3][r] * hacc[3][r]);
            ss = row16_sum(ss);
            const float rstd = frsq(ss * (1.0f / 64.0f) + EPS); const size_t m = m0 + 16 * wave + 4 * g + r;
#pragma unroll
            for (int dt = 0; dt < 4; ++dt) { const int d = 16 * dt + li; const float o = bf2f(PROJ[m * NPROJ + C_MO + hd * 64 + d]);
                Y[m * DM + 768 + hd * 64 + d] = (bf16)f2bf(hacc[dt][r] * rstd * hg[d] * sigmoid_f(o)); } }
    }
    WG_SYNC();
}

__device__ __forceinline__ void attnorm_pass(const Args& a, int l, int lane, int wave, int G, int bid, bf16* DST) {
    bf16* Y = (bf16*)(a.ws + WS_Y); const float* gq = a.in[I_AOG] + (size_t)l * 512 + 8 * lane;
    const f32x4 g0 = *(const f32x4*)gq, g1 = *(const f32x4*)(gq + 4);
    const int gw = bid * NWAVES + wave, NGW = G * NWAVES;
    for (int mb = 4 * gw; mb < M; mb += 4 * NGW) { v4u q[4];
#pragma unroll
        for (int r = 0; r < 4; ++r) q[r] = *(const v4u*)(Y + (size_t)(mb + r) * DM + 8 * lane);
        float ss[4];
#pragma unroll
        for (int r = 0; r < 4; ++r) { const float x[8] = {bflo(q[r].x), bfhi(q[r].x), bflo(q[r].y), bfhi(q[r].y), bflo(q[r].z), bfhi(q[r].z), bflo(q[r].w), bfhi(q[r].w)}; float a = 0.f;
#pragma unroll
            for (int i = 0; i < 8; ++i) a += x[i] * x[i];
            ss[r] = a; }
#pragma unroll
        for (int r = 0; r < 4; ++r) ss[r] = wave_sum(ss[r]);
#pragma unroll
        for (int r = 0; r < 4; ++r) { const float rstd = frsq(ss[r] * (1.0f / 512.0f) + EPS);
            const float x[8] = {bflo(q[r].x), bfhi(q[r].x), bflo(q[r].y), bfhi(q[r].y), bflo(q[r].z), bfhi(q[r].z), bflo(q[r].w), bfhi(q[r].w)};
            v4u o; o.x = pk2(x[0] * rstd * g0[0], x[1] * rstd * g0[1]); o.y = pk2(x[2] * rstd * g0[2], x[3] * rstd * g0[3]);
            o.z = pk2(x[4] * rstd * g1[0], x[5] * rstd * g1[1]); o.w = pk2(x[6] * rstd * g1[2], x[7] * rstd * g1[3]); *(v4u*)(DST + (size_t)(mb + r) * DM + 8 * lane) = o; } }
}

__device__ __forceinline__ unsigned mbcnt64(unsigned long long m) { return __builtin_amdgcn_mbcnt_hi((unsigned)(m >> 32), __builtin_amdgcn_mbcnt_lo((unsigned)m, 0u)); }
__device__ __forceinline__ void topk_item(const Args& a, int item, LAS unsigned char* lds, int tid, int lane, int wave) {
    const int unit = item & 127, half = item >> 7, b = unit >> 4, e = unit & 15;
    LAS unsigned* CNT = (LAS unsigned*)(lds + RING_OFF);
    LAS unsigned* SEG = CNT + 16;
    LAS int* TOK = (LAS int*)(SEG + 64);
    LAS float* GV = (LAS float*)(TOK + 256);
    const float* aff = (const float*)(a.ws + WS_AFF) + ((size_t)b * NE + e) * SEQ;
    float av[4]; unsigned key[4];
#pragma unroll
    for (int q = 0; q < 4; ++q) av[q] = aff[tid + q * NTHR];
#pragma unroll
    for (int q = 0; q < 4; ++q) key[q] = __float_as_uint(av[q]);
    unsigned lo = 0u, hi = 0x7F800000u; int par = 0;
    while (hi - lo > 1u) { const unsigned mid = lo + ((hi - lo) >> 1);
        unsigned c = 0u;
#pragma unroll
        for (int q = 0; q < 4; ++q) c += (unsigned)__popcll(__ballot(key[q] >= mid));
        if (lane == 0) CNT[par * 8 + wave] = c;
        WG_SYNC();
        const v4u c0 = *(const LAS v4u*)(CNT + par * 8), c1 = *(const LAS v4u*)(CNT + par * 8 + 4);
        const unsigned tot = (c0.x + c0.y) + (c0.z + c0.w) + (c1.x + c1.y) + (c1.z + c1.w);
        if (tot >= (unsigned)CAP) lo = mid; else hi = mid;
        par ^= 1; }
    const unsigned T = lo;
    unsigned long long mgt[4], meq[4];
#pragma unroll
    for (int q = 0; q < 4; ++q) { mgt[q] = __ballot(key[q] > T); meq[q] = __ballot(key[q] == T);
        if (lane == 0) { SEG[q * 8 + wave] = (unsigned)__popcll(mgt[q]); SEG[32 + q * 8 + wave] = (unsigned)__popcll(meq[q]); } }
    WG_SYNC();
    unsigned ngt = 0u;
#pragma unroll
    for (int g = 0; g < 32; ++g) ngt += SEG[g];
    const unsigned need = (unsigned)CAP - ngt;
    unsigned eqb = 0u, selb = 0u, my_eqb[4], my_selb[4];
#pragma unroll
    for (int g = 0; g < 32; ++g) { if ((g & 7) == wave) { my_eqb[g >> 3] = eqb; my_selb[g >> 3] = selb; }
        const unsigned cg = SEG[g], ce = SEG[32 + g]; const unsigned room = need > eqb ? need - eqb : 0u; selb += cg + (room < ce ? room : ce); eqb += ce; }
    int* SEL = (int*)(a.ws + WS_SEL);
#pragma unroll
    for (int q = 0; q < 4; ++q) { const bool gt = key[q] > T, eq = key[q] == T;
        const bool sel = gt || (eq && (my_eqb[q] + mbcnt64(meq[q])) < need);
        const unsigned long long ms = __ballot(sel); const int slot = (int)(my_selb[q] + mbcnt64(ms)); const int sidx = tid + q * NTHR;
        if (sel) { TOK[slot] = sidx; GV[slot] = av[q]; }
        if ((q >> 1) == half) SEL[((size_t)b * SEQ + sidx) * NE + e] = sel ? slot : -1; }
    WG_SYNC();
    int* IDX = (int*)(a.ws + WS_IDX); float* GATE = (float*)(a.ws + WS_GATE);
    if (tid < 128) { const int t = half * 128 + tid; IDX[e * NSLOT + b * CAP + t] = b * SEQ + TOK[t]; GATE[e * NSLOT + b * CAP + t] = GV[t]; }
    const unsigned char* H8 = a.ws + WS_H; unsigned char* XG8 = a.ws + WS_XG;
    { v4u r0[16];
#pragma unroll
      for (int q = 0; q < 16; ++q) { const int t = half * 128 + wave * 16 + q; r0[q] = *((const v4u*)(H8 + ((size_t)b * SEQ + TOK[t]) * DM) + lane); }
#pragma unroll
      for (int q = 0; q < 16; ++q) { const int t = half * 128 + wave * 16 + q; *((v4u*)(XG8 + ((size_t)e * NSLOT + b * CAP + t) * DM) + lane) = r0[q]; } }
    WG_SYNC();
}

#ifndef MK_PER_PHASE
#define MK_PER_PHASE 0
#endif
__global__ void __launch_bounds__(NTHR, 2) hybrid_fwd(Args args) {
    extern __shared__ __attribute__((aligned(16))) unsigned char lds_raw[];
    LAS unsigned char* lds = (LAS unsigned char*)lds_raw;
    volatile LAS unsigned* MISC = (volatile LAS unsigned*)(lds + MISC_OFF);
    const int tid0 = threadIdx.x, G = gridDim.x;
    unsigned char* ws = args.ws;
#define PHASE_IDS() const int tid = ltid(), lane = tid & 63, wave = __builtin_amdgcn_readfirstlane(tid >> 6), bid = lbid(); (void)lane; (void)wave; (void)bid
    gu32* ctl = (gu32*)(ws + WS_CTL);
    for (int u = tid0; u < (LDS_BYTES - MISC_OFF) / 4; u += NTHR) ((LAS unsigned*)(lds + MISC_OFF))[u] = 0u;
    __syncthreads();
    XcdBarrier bar; bar.bar = (unsigned*)(ctl + CW_BAR); bar.x = 0; bar.st = nullptr;
    if (!MK_PER_PHASE) bar = xcd_barrier_post((unsigned*)(ctl + CW_BAR), MISC + 8);
#define GRID_BAR() do { if (!MK_PER_PHASE) { xcd_barrier(bar); if (REP_MASK & (1 << 11)) xcd_barrier(bar); } } while (0)
    const int lo = args.ph_lo, hi = args.ph_hi;
#ifndef PT_MASK
#define PT_MASK 0x7ff
#endif
#define PT_ON(j) (((PT_MASK) >> (j)) & 1)
#ifndef REP_MASK
#define REP_MASK 0
#endif
#define REPS(j) for (int rep_ = 0; rep_ < 1 + (((REP_MASK) >> (j)) & 1); ++rep_)
#define IN(k) (lo <= (k) && (k) < hi)
#define BOTH(k) (IN(k) && IN((k) + 1))

    bf16* Hb = (bf16*)(ws + WS_H); bf16* PROJ = (bf16*)(ws + WS_PROJ); bf16* Yb = (bf16*)(ws + WS_Y);
    float* MG = (float*)(ws + WS_MG); float* AFF = (float*)(ws + WS_AFF); int* SEL = (int*)(ws + WS_SEL);
    bf16* XG = (bf16*)(ws + WS_XG); bf16* HID = (bf16*)(ws + WS_HID); bf16* YE = (bf16*)(ws + WS_YE);

    if (PT_ON(0) && IN(0)) { PHASE_IDS();
        REPS(0) p0_weights(args, lds, tid, lane, wave, G, bid);
        WG_SYNC();
        REPS(16) row_pass<0>(args.in[I_X], nullptr, args.in[I_N1G], args.in[I_WIN] + NPROJ, DIN, Hb, MG, nullptr, nullptr, lds, tid, lane, wave, G, bid);
        if (BOTH(0)) GRID_BAR();
    }
    for (int l = 0; l < DEPTH; ++l) {
        const int pb = 1 + 10 * l;
        if (PT_ON(1) && IN(pb + 0)) { PHASE_IDS();
            pg8::Gemm g{Hb, (const bf16*)(ws + WS_WIN) + (size_t)l * NPROJ * DM, M, NPROJ, DM}; pg8::StaticOrder S; S.init(M, NPROJ, G, bid);
            pg8::EpiBf16<0> E{PROJ, NPROJ, nullptr, 0, 0, 1.f};
            REPS(1) pg8::gemm_phase<pg8::EpiBf16<0>, pg8::StaticOrder, true, true>(lds + RING_OFF, g, S, E);
            if (BOTH(pb + 0)) GRID_BAR();
        }
        if (PT_ON(2) && IN(pb + 1)) { PHASE_IDS();
            if (REP_MASK & (1 << 12)) rope_pass(args, l, lane, wave, G, bid, HID);
            rope_pass(args, l, lane, wave, G, bid, PROJ);
            REPS(2) for (int u = bid; u < 512; u += G) lru_a_unit(args, l, u, lds, tid, lane, wave);
            REPS(3) for (int u = bid; u < 512; u += G) mls_a_unit(args, l, u, lds, tid, lane, wave);
            if (BOTH(pb + 1)) GRID_BAR();
        }
        if (PT_ON(3) && IN(pb + 2)) { PHASE_IDS();
            const attn_body::AttnTensors AT{(const attn_body::bf16*)(PROJ + C_Q), (const attn_body::bf16*)(PROJ + C_K), (const attn_body::bf16*)(PROJ + C_V), (attn_body::bf16*)Yb};
            const attn_body::StaticOrder S(G, bid);
#ifndef P3_PARTS
#define P3_PARTS 7
#endif
            if (P3_PARTS & 1) REPS(4) attn_body::attn_phase<attn_body::StaticOrder>((char*)lds_raw + RING_OFF, AT, S);
            WG_SYNC();
            if (P3_PARTS & 2) REPS(5) for (int u = bid; u < 512; u += G) mls_b_unit(args, l, u, lds, tid, lane, wave);
            if (P3_PARTS & 4) REPS(6) for (int u = bid; u < 512; u += G) lru_b_unit(args, l, u, lds, tid, lane, wave);
            if (BOTH(pb + 2)) GRID_BAR();
        }
        if (PT_ON(4) && IN(pb + 3)) { PHASE_IDS(); if (REP_MASK & (1 << 13)) attnorm_pass(args, l, lane, wave, G, bid, HID); attnorm_pass(args, l, lane, wave, G, bid, Yb); if (BOTH(pb + 3)) GRID_BAR(); }
        if (PT_ON(5) && IN(pb + 4)) { PHASE_IDS();
            pg8::Gemm g{Yb, (const bf16*)(ws + WS_WOUT) + (size_t)l * DM * DM, M, DM, DM}; pg8::StaticOrder S; S.init(M, DM, G, bid);
            pg8::EpiResidF32 E{l == 0 ? args.in[I_X] : args.out, args.out, DM};
            if (REP_MASK & (1 << 14)) { pg8::EpiResidF32 E2{l == 0 ? args.in[I_X] : args.out, (float*)HID, DM}; pg8::gemm_phase<pg8::EpiResidF32, pg8::StaticOrder, false, true>(lds + RING_OFF, g, S, E2); }
            pg8::gemm_phase<pg8::EpiResidF32, pg8::StaticOrder, false, true>(lds + RING_OFF, g, S, E);
            if (BOTH(pb + 4)) GRID_BAR();
        }
        if (PT_ON(6) && IN(pb + 5)) { PHASE_IDS();
            REPS(7) row_pass<1>(args.out, nullptr, args.in[I_N2G] + (size_t)l * DM, args.in[I_WR] + (size_t)l * DM * NE, NE, Hb, AFF, nullptr, nullptr, lds, tid, lane, wave, G, bid);
            if (BOTH(pb + 5)) GRID_BAR();
        }
        if (PT_ON(7) && IN(pb + 6)) { PHASE_IDS(); REPS(8) for (int it = bid; it < 256; it += G) topk_item(args, it, lds, tid, lane, wave); if (BOTH(pb + 6)) GRID_BAR(); }
        if (PT_ON(8) && IN(pb + 7)) { PHASE_IDS();
            pg8::Gemm g{XG, (const bf16*)(ws + WS_WGU + (size_t)l * NE * 4096 * DM), NE * NSLOT, NE * 4096, DM / 2}; pg8::Moe1Order S{G, bid};
            pg8::EpiSwiGLU E{(unsigned char*)HID, DE};
            REPS(9) pg8::gemm_phase<pg8::EpiSwiGLU, pg8::Moe1Order, true, true, true>(lds + RING_OFF, g, S, E);
            if (BOTH(pb + 7)) GRID_BAR();
        }
        if (PT_ON(9) && IN(pb + 8)) { PHASE_IDS();
            pg8::Gemm g{HID, (const bf16*)(ws + WS_WDN + (size_t)l * NE * DM * DE), NE * NSLOT, NE * DM, DE / 2}; pg8::Moe2Order S{G, bid};
            pg8::EpiScaleBf16 E{YE, DM, (const float*)(ws + WS_GATE)};
            REPS(10) pg8::gemm_phase<pg8::EpiScaleBf16, pg8::Moe2Order, true, true, true>(lds + RING_OFF, g, S, E);
            if (BOTH(pb + 8)) GRID_BAR();
        }
        if (PT_ON(10) && IN(pb + 9)) { PHASE_IDS();
            if (REP_MASK & (1 << 15)) { if (l + 1 < DEPTH) row_pass<2>(args.out, (float*)HID, args.in[I_N1G] + (size_t)(l + 1) * DM, args.in[I_WIN] + (size_t)(l + 1) * DM * DIN + NPROJ, DIN, Hb, MG, SEL, YE, lds, tid, lane, wave, G, bid); else row_pass<3>(args.out, (float*)HID, nullptr, nullptr, 0, nullptr, nullptr, SEL, YE, lds, tid, lane, wave, G, bid); WG_SYNC(); }
            if (l + 1 < DEPTH) row_pass<2>(args.out, args.out, args.in[I_N1G] + (size_t)(l + 1) * DM, args.in[I_WIN] + (size_t)(l + 1) * DM * DIN + NPROJ, DIN, Hb, MG, SEL, YE, lds, tid, lane, wave, G, bid);
            else row_pass<3>(args.out, args.out, nullptr, nullptr, 0, nullptr, nullptr, SEL, YE, lds, tid, lane, wave, G, bid);
            if (BOTH(pb + 9)) GRID_BAR();
        }
    }
#undef IN
#undef BOTH
#undef GRID_BAR
}

extern "C" void kernel_launch(void* const* d_in, const int* in_sizes, int n_in, void* d_out, int out_size, void* d_ws, size_t ws_size, hipStream_t stream) {
    static int grid = 0;
    if (grid == 0) {
        if (n_in != 22 || in_sizes[0] != M * DM || out_size != M * DM || ws_size < WS_END) { fprintf(stderr, "kernel_launch: unexpected shapes (n_in %d, in0 %d, out %d, ws %zu); nothing launched\n", n_in, n_in > 0 ? in_sizes[0] : -1, out_size, ws_size); grid = -1; return; }
        int dev = 0, cus = 0, per_cu = 0;
        if (hipGetDevice(&dev) != hipSuccess || hipDeviceGetAttribute(&cus, hipDeviceAttributeMultiprocessorCount, dev) != hipSuccess) { grid = -1; return; }
        if (hipFuncSetAttribute((const void*)hybrid_fwd, hipFuncAttributeMaxDynamicSharedMemorySize, LDS_BYTES) != hipSuccess) { fprintf(stderr, "kernel_launch: hipFuncSetAttribute failed\n"); grid = -1; return; }
        if (hipOccupancyMaxActiveBlocksPerMultiprocessor(&per_cu, (const void*)hybrid_fwd, NTHR, LDS_BYTES) != hipSuccess || per_cu < 1) { fprintf(stderr, "kernel_launch: occupancy query says %d\n", per_cu); }
        (void)hipGetLastError();
        grid = cus;
    }
    if (grid < 0) return;
    if (hipMemsetAsync((char*)d_ws + WS_CTL, 0, CTL_ZERO_BYTES, stream) != hipSuccess) return;
    Args a{};
    for (int i = 0; i < 22; ++i) a.in[i] = (const float*)d_in[i];
    a.out = (float*)d_out; a.ws = (unsigned char*)d_ws; a.pad = 0;
#if MK_PER_PHASE
    for (int p = 0; p < NPH; ++p) { a.ph_lo = p; a.ph_hi = p + 1; a.li = p; hipLaunchKernelGGL(hybrid_fwd, dim3(grid), dim3(NTHR), LDS_BYTES, stream, a); }
#else
    a.ph_lo = 0; a.ph_hi = NPH; a.li = 0;
    hipLaunchKernelGGL(hybrid_fwd, dim3(grid), dim3(NTHR), LDS_BYTES, stream, a);
#endif
    const hipError_t le = hipPeekAtLastError();
    if (le != hipSuccess) fprintf(stderr, "kernel_launch: launch failed: %s\n", hipGetErrorName(le));
}
```

```cpp
#include <hip/hip_runtime.h>
#include <hip/hip_bf16.h>
#include <cstdio>
#include <cstdint>
#include <cmath>
__device__ __forceinline__ int ltid() { int t = threadIdx.x; asm volatile("" : "+v"(t)); return t; }
__device__ __forceinline__ int lbid() { int t = blockIdx.x; asm volatile("" : "+s"(t)); return t; }
namespace pg8 {
#define PG8_LAS __attribute__((address_space(3)))
typedef unsigned short bf16_t;
typedef short bf16x8 __attribute__((ext_vector_type(8)));
typedef float f32x4 __attribute__((ext_vector_type(4)));
typedef unsigned u32x4 __attribute__((ext_vector_type(4)));
typedef unsigned u32x2 __attribute__((ext_vector_type(2)));
constexpr int BM = 256, BK = 64, HALF = 128, HTB = HALF * BK * 2  , STAGE_BYTES = 8 * HTB, NXCD = 8, WGM = 8;

__host__ __device__ __forceinline__ int lds_byte(int r, int c) { const int st = (r >> 4) * 2 + (c >> 5), rr = r & 15, cc = c & 31, ob = rr * 64 + cc * 2; return st * 1024 + (ob ^ (((ob >> 9) & 1) << 5)); }
__host__ __device__ __forceinline__ void stage_rc(int b, int& R, int& C) { const int st = b / 1024, sb = b % 1024, swz = sb ^ (((sb >> 9) & 1) << 5); R = (st >> 1) * 16 + swz / 64; C = (st & 1) * 32 + (swz % 64) / 2; }
__host__ __device__ __forceinline__ int perm32(int rho) { const int n = rho >> 4, i = rho & 15; return 8 * (i >> 2) + 4 * n + (i & 3); }

struct Unit { int pm, pn; };
struct Gemm { const bf16_t* A; const bf16_t* Bt; int M, N, K; };

struct StaticOrder {
    int nM, nN, nwg, G, c;
    __host__ __device__ void init(int M, int N, int G_, int c_) { nM = M / BM; nN = N / BM; nwg = nM * nN; G = G_; c = c_; }
    __host__ __device__ bool next(int i, Unit& u) const {
        const long L = (long)i * G + c; if (L >= nwg) return false;
        int wgid = (int)L; { const int q = nwg / NXCD, r = nwg % NXCD, xcd = wgid % NXCD, off = wgid / NXCD; wgid = (xcd < r ? xcd * (q + 1) : r * (q + 1) + (xcd - r) * q) + off; }
        const int nig = WGM * nN, gid = wgid / nig, fm = gid * WGM, gsz = (nM - fm) < WGM ? (nM - fm) : WGM;
        u.pm = fm + ((wgid % nig) % gsz); u.pn = (wgid % nig) / gsz; return true;
    }
    __device__ __forceinline__ void a_ready(const Unit&) const {}
    __device__ __forceinline__ void done(const Unit&) const {}
};

__device__ __forceinline__ unsigned cvt_pk_bf16(float lo, float hi) { unsigned r; asm volatile("v_cvt_pk_bf16_f32 %0, %1, %2" : "=v"(r) : "v"(lo), "v"(hi)); return r; }
typedef int i32x4 __attribute__((ext_vector_type(4)));
typedef int i32x8 __attribute__((ext_vector_type(8)));
__device__ __forceinline__ i32x8 cat8(bf16x8 lo, bf16x8 hi) { return __builtin_shufflevector(__builtin_bit_cast(i32x4, lo), __builtin_bit_cast(i32x4, hi), 0, 1, 2, 3, 4, 5, 6, 7); }
__device__ __forceinline__ float clamp448(float v) { return __builtin_amdgcn_fmed3f(v, -448.f, 448.f); }
__device__ __forceinline__ unsigned pk4_fp8(float a, float b, float c, float d) { unsigned r = 0u; r = (unsigned)__builtin_amdgcn_cvt_pk_fp8_f32(a, b, (int)r, false); r = (unsigned)__builtin_amdgcn_cvt_pk_fp8_f32(c, d, (int)r, true); return r; }
typedef float f32x2 __attribute__((ext_vector_type(2)));
__device__ __forceinline__ f32x2 gelu_pk(f32x2 v) {
    const f32x2 av = __builtin_elementwise_abs(v), d = av * 0.2316418882f + 1.0f;
    f32x2 t; t.x = __builtin_amdgcn_rcpf(d.x); t.y = __builtin_amdgcn_rcpf(d.y);
    f32x2 q = t * 0.5307027145f + (-0.7265760135f); q = q * t + 0.7107068705f; q = q * t + (-0.142248368f); q = q * t + 0.127414796f; q = q * t;
    const f32x2 s = (v * v) * (-0.72134752044f);
    f32x2 e; e.x = __builtin_amdgcn_exp2f(s.x); e.y = __builtin_amdgcn_exp2f(s.y);
    const f32x2 m = v * (q * e), r = v - m;
    f32x2 o; o.x = v.x < 0.f ? m.x : r.x; o.y = v.y < 0.f ? m.y : r.y; return o;
}

template <int ACT  > struct EpiBf16 {
    static constexpr bool PERM = true, AFTER_DRAIN = false; static_assert(ACT == 0 || ACT == 1, "EpiBf16: ACT is 0 (none) or 1 (gelu_pk)");
    bf16_t* O; int ldc; const float* bias; int split_cols; size_t split_stride; float scale0;
    __device__ __forceinline__ void operator()(const f32x4 (&acc)[2][2][4][2], const Unit& u, int wr, int wc, int fr, int fq) const {
        const int row0 = u.pm * BM + wr * 64 + fr; int colt = u.pn * BM; bf16_t* base = O;
        float sc = 1.f; if (split_cols) { const int t = colt / split_cols; base += (size_t)t * split_stride; colt -= t * split_cols; if (t == 0) sc = scale0; }
        const int col0 = colt + wc * 32 + 8 * fq, bcol0 = u.pn * BM + wc * 32 + 8 * fq;
        f32x4 bv[2][2];
#pragma unroll
        for (int bj = 0; bj < 2; ++bj)
#pragma unroll
            for (int n = 0; n < 2; ++n) bv[bj][n] = bias ? *(const f32x4*)(bias + bcol0 + bj * HALF + 4 * n) : (f32x4){0.f, 0.f, 0.f, 0.f};
#pragma unroll
        for (int ai = 0; ai < 2; ++ai)
#pragma unroll
            for (int m = 0; m < 4; ++m) { bf16_t* rowp = base + (size_t)(row0 + ai * HALF + m * 16) * ldc + col0;
#pragma unroll
                for (int bj = 0; bj < 2; ++bj) { f32x4 v0 = acc[ai][bj][m][0] + bv[bj][0], v1 = acc[ai][bj][m][1] + bv[bj][1];
                    if (ACT == 1) { f32x2 a = gelu_pk((f32x2){v0[0], v0[1]}), b = gelu_pk((f32x2){v0[2], v0[3]}), c = gelu_pk((f32x2){v1[0], v1[1]}), d = gelu_pk((f32x2){v1[2], v1[3]});
                        v0 = (f32x4){a.x, a.y, b.x, b.y}; v1 = (f32x4){c.x, c.y, d.x, d.y}; }
                    v0 = v0 * sc; v1 = v1 * sc; u32x4 w; w.x = cvt_pk_bf16(v0[0], v0[1]); w.y = cvt_pk_bf16(v0[2], v0[3]); w.z = cvt_pk_bf16(v1[0], v1[1]); w.w = cvt_pk_bf16(v1[2], v1[3]);
                    *(u32x4*)(rowp + bj * HALF) = w; } }
    }
};

struct EpiResid {
    static constexpr bool PERM = true, AFTER_DRAIN = false;
    const float* base32; const bf16_t* base16; bf16_t* C; int ldc;
    __device__ __forceinline__ void operator()(const f32x4 (&acc)[2][2][4][2], const Unit& u, int wr, int wc, int fr, int fq) const {
        const int row0 = u.pm * BM + wr * 64 + fr, col0 = u.pn * BM + wc * 32 + 8 * fq;
#pragma unroll
        for (int ai = 0; ai < 2; ++ai)
#pragma unroll
            for (int m = 0; m < 4; ++m) { const size_t off = (size_t)(row0 + ai * HALF + m * 16) * ldc + col0;
#pragma unroll
                for (int bj = 0; bj < 2; ++bj) { f32x4 b0, b1;
                    if (base32) { b0 = *(const f32x4*)(base32 + off + bj * HALF); b1 = *(const f32x4*)(base32 + off + bj * HALF + 4); }
                    else { const u32x4 q = *(const u32x4*)(base16 + off + bj * HALF);
                        b0 = (f32x4){__uint_as_float(q.x << 16), __uint_as_float(q.x & 0xffff0000u), __uint_as_float(q.y << 16), __uint_as_float(q.y & 0xffff0000u)};
                        b1 = (f32x4){__uint_as_float(q.z << 16), __uint_as_float(q.z & 0xffff0000u), __uint_as_float(q.w << 16), __uint_as_float(q.w & 0xffff0000u)}; }
                    const f32x4 v0 = acc[ai][bj][m][0] + b0, v1 = acc[ai][bj][m][1] + b1;
                    u32x4 w; w.x = cvt_pk_bf16(v0[0], v0[1]); w.y = cvt_pk_bf16(v0[2], v0[3]); w.z = cvt_pk_bf16(v1[0], v1[1]); w.w = cvt_pk_bf16(v1[2], v1[3]);
                    *(u32x4*)(C + off + bj * HALF) = w; } }
    }
};
__device__ __forceinline__ float silu_f(float x) { return x * __builtin_amdgcn_rcpf(1.0f + __builtin_amdgcn_exp2f(-1.4426950408889634f * x)); }
constexpr float WSCALE = 64.f, HSCALE = 4.f;
struct EpiSwiGLU {
    static constexpr bool PERM = true, AFTER_DRAIN = false;
    unsigned char* O; int ldc;
    __device__ __forceinline__ void operator()(const f32x4 (&acc)[2][2][4][2], const Unit& u, int wr, int wc, int fr, int fq) const {
        const int row0 = u.pm * BM + wr * 64 + fr, col0 = (u.pn & 15) * HALF + wc * 32 + 8 * fq; constexpr float is = 1.0f / WSCALE;
#pragma unroll
        for (int ai = 0; ai < 2; ++ai)
#pragma unroll
            for (int m = 0; m < 4; ++m) { unsigned char* rowp = O + (size_t)(row0 + ai * HALF + m * 16) * ldc + col0;
                const f32x4 g0 = acc[ai][0][m][0] * is, g1 = acc[ai][0][m][1] * is, u0 = acc[ai][1][m][0] * (is * HSCALE), u1 = acc[ai][1][m][1] * (is * HSCALE);
                u32x2 w; w.x = pk4_fp8(clamp448(silu_f(g0[0]) * u0[0]), clamp448(silu_f(g0[1]) * u0[1]), clamp448(silu_f(g0[2]) * u0[2]), clamp448(silu_f(g0[3]) * u0[3]));
                w.y = pk4_fp8(clamp448(silu_f(g1[0]) * u1[0]), clamp448(silu_f(g1[1]) * u1[1]), clamp448(silu_f(g1[2]) * u1[2]), clamp448(silu_f(g1[3]) * u1[3]));
                *(u32x2*)rowp = w; }
    }
};
struct EpiScaleBf16 {
    static constexpr bool PERM = true, AFTER_DRAIN = false;
    bf16_t* O; int ldc; const float* rowscale;
    __device__ __forceinline__ void operator()(const f32x4 (&acc)[2][2][4][2], const Unit& u, int wr, int wc, int fr, int fq) const {
        const int row0 = u.pm * BM + wr * 64 + fr, col0 = (u.pn & 3) * BM + wc * 32 + 8 * fq;
#pragma unroll
        for (int ai = 0; ai < 2; ++ai)
#pragma unroll
            for (int m = 0; m < 4; ++m) { const int row = row0 + ai * HALF + m * 16; const float s = rowscale[row] * (1.0f / (WSCALE * HSCALE)); bf16_t* rowp = O + (size_t)row * ldc + col0;
#pragma unroll
                for (int bj = 0; bj < 2; ++bj) { const f32x4 v0 = acc[ai][bj][m][0] * s, v1 = acc[ai][bj][m][1] * s;
                    u32x4 w; w.x = cvt_pk_bf16(v0[0], v0[1]); w.y = cvt_pk_bf16(v0[2], v0[3]); w.z = cvt_pk_bf16(v1[0], v1[1]); w.w = cvt_pk_bf16(v1[2], v1[3]);
                    *(u32x4*)(rowp + bj * HALF) = w; } }
    }
};
struct EpiNull { static constexpr bool PERM = true, AFTER_DRAIN = false; __device__ __forceinline__ void operator()(const f32x4 (&)[2][2][4][2], const Unit&, int, int, int, int) const {} };
struct Moe1Order {
    int G, c;
    __device__ __forceinline__ bool next(int i, Unit& u) const {
        const int L = i * G + c; if (L >= 2048) return false;
        const int e = L >> 7, r = L & 127; u.pm = e * 8 + ((r >> 3) & 7); u.pn = e * 16 + 2 * (r & 7) + (r >> 6); return true;
    }
    __device__ __forceinline__ void a_ready(const Unit&) const {}
    __device__ __forceinline__ void done(const Unit&) const {}
};
struct Moe2Order {
    int G, c;
    __device__ __forceinline__ bool next(int i, Unit& u) const {
        const int L = i * G + c; if (L >= 512) return false;
        const int q = L & 7, Lp = L >> 3, e = 8 * (Lp >> 5) + q, k = Lp & 31; u.pm = e * 8 + (k & 7); u.pn = e * 4 + (k >> 3); return true;
    }
    __device__ __forceinline__ void a_ready(const Unit&) const {}
    __device__ __forceinline__ void done(const Unit&) const {}
};
template <class Epi, class Sched, bool ALIGN_EPI = false, bool SP2 = false, bool F8 = false>
__device__ __forceinline__ void gemm_phase(PG8_LAS unsigned char* lds, const Gemm g, const Sched& S, const Epi& E) {
    const int tid = ltid(), wid = __builtin_amdgcn_readfirstlane(tid >> 6), lane = tid & 63, wr = wid >> 2, wc = wid & 3, fr = lane & 15, fq = lane >> 4;
    const int K = g.K, nt = K / BK;
    unsigned voffA[2], voffB[2];
#pragma unroll
    for (int i = 0; i < 2; ++i) { int R, C; stage_rc(tid * 16 + i * 8192, R, C); const int Rb = Epi::PERM ? ((R & ~31) + perm32(R & 31)) : R;
        voffA[i] = (unsigned)(R * K + C) * 2u; voffB[i] = (unsigned)(Rb * K + C) * 2u; }
    const size_t kstep = (size_t)(BK * 2);
    const size_t hstep = (size_t)HALF * K * 2;
    const size_t tstep = 2 * hstep;
    const unsigned ldsw = (unsigned)wid * 1024u;
    const int aoff = lds_byte(wr * 64 + fr, fq * 8), boff = lds_byte(wc * 32 + fr, fq * 8);
#define PG8_SA(b, h) (((b) * 2 + (h)) * HTB)
#define PG8_SB(b, h) ((4 + (b) * 2 + (h)) * HTB)
#define PG8_STAGE(bufoff, gbase, voff) do { _Pragma("unroll") for (int _i = 0; _i < 2; ++_i) \
        __builtin_amdgcn_global_load_lds((const unsigned*)((const char*)(gbase) + (voff)[_i]), (PG8_LAS unsigned*)(lds + (bufoff) + ldsw + _i * 8192), 16, 0, 0); } while (0)
#define PG8_LDA(dst, b, h) do { _Pragma("unroll") for (int m = 0; m < 4; ++m) { if constexpr (F8) { dst##8[m] = cat8(*(const PG8_LAS bf16x8*)(lds + PG8_SA(b, h) + aoff + m * 2048), *(const PG8_LAS bf16x8*)(lds + PG8_SA(b, h) + aoff + m * 2048 + 1024)); } \
        else { _Pragma("unroll") for (int k = 0; k < 2; ++k) dst[m][k] = *(const PG8_LAS bf16x8*)(lds + PG8_SA(b, h) + aoff + m * 2048 + k * 1024); } } } while (0)
#define PG8_LDB(dst, b, h) do { _Pragma("unroll") for (int n = 0; n < 2; ++n) { if constexpr (F8) { dst##8[n] = cat8(*(const PG8_LAS bf16x8*)(lds + PG8_SB(b, h) + boff + n * 2048), *(const PG8_LAS bf16x8*)(lds + PG8_SB(b, h) + boff + n * 2048 + 1024)); } \
        else { _Pragma("unroll") for (int k = 0; k < 2; ++k) dst[n][k] = *(const PG8_LAS bf16x8*)(lds + PG8_SB(b, h) + boff + n * 2048 + k * 1024); } } } while (0)
#define PG8_MMA(ai, bj, At, Bt) do { __builtin_amdgcn_s_setprio(1); _Pragma("unroll") for (int m = 0; m < 4; ++m) _Pragma("unroll") for (int n = 0; n < 2; ++n) { \
        if constexpr (F8) { asm volatile("v_mfma_scale_f32_16x16x128_f8f6f4 %0, %1, %2, %0, %3, %3 op_sel_hi:[0,0,0]" : "+v"(acc[ai][bj][m][n]) : "v"(Bt##8[n]), "v"(At##8[m]), "v"(sc1)); } \
        else { _Pragma("unroll") for (int k = 0; k < 2; ++k) acc[ai][bj][m][n] = __builtin_amdgcn_mfma_f32_16x16x32_bf16(Bt[n][k], At[m][k], acc[ai][bj][m][n], 0, 0, 0); } } __builtin_amdgcn_s_setprio(0); } while (0)
#define PG8_WAIT_V(n) asm volatile("s_waitcnt vmcnt(" #n ")" ::: "memory")
#define PG8_WAIT_L(n) asm volatile("s_waitcnt lgkmcnt(" #n ")" ::: "memory")
#define PG8_BAR __builtin_amdgcn_s_barrier()
#define PG8_SCHED __builtin_amdgcn_sched_barrier(0)
    Unit cur, nxt; int ui = 0;
    if (!S.next(0, cur)) return;
    f32x4 acc[2][2][4][2];
#pragma unroll
    for (int a = 0; a < 2; ++a)
#pragma unroll
        for (int b = 0; b < 2; ++b)
#pragma unroll
            for (int m = 0; m < 4; ++m)
#pragma unroll
                for (int n = 0; n < 2; ++n) acc[a][b][m][n] = (f32x4){0.f, 0.f, 0.f, 0.f};
    bf16x8 At[4][2], B0[2][2], B1[2][2]; i32x8 At8[4], B08[2], B18[2];
    const int sc1 = 0x7F7F7F7F;
    const char* cA = (const char*)g.A + (size_t)cur.pm * tstep; const char* cB = (const char*)g.Bt + (size_t)cur.pn * tstep;
    S.a_ready(cur);
    if constexpr (SP2) {
        PG8_STAGE(PG8_SB(0, 0), cB, voffB); PG8_STAGE(PG8_SB(0, 1), cB + hstep, voffB); PG8_STAGE(PG8_SA(0, 0), cA, voffA); PG8_STAGE(PG8_SA(0, 1), cA + hstep, voffA);
        if (wr == 1) PG8_BAR;
        PG8_WAIT_V(2); PG8_BAR;
        PG8_STAGE(PG8_SB(1, 0), cB + kstep, voffB); PG8_STAGE(PG8_SA(1, 0), cA + kstep, voffA); PG8_STAGE(PG8_SB(1, 1), cB + hstep + kstep, voffB);
        PG8_WAIT_V(6); PG8_BAR;
    } else {
        PG8_STAGE(PG8_SB(0, 0), cB, voffB); PG8_STAGE(PG8_SA(0, 0), cA, voffA); PG8_STAGE(PG8_SB(0, 1), cB + hstep, voffB); PG8_STAGE(PG8_SA(0, 1), cA + hstep, voffA);
        if (wr == 1) PG8_BAR;
        PG8_WAIT_V(4); PG8_BAR;
        PG8_STAGE(PG8_SB(1, 0), cB + kstep, voffB); PG8_STAGE(PG8_SA(1, 0), cA + kstep, voffA); PG8_STAGE(PG8_SB(1, 1), cB + hstep + kstep, voffB);
        PG8_WAIT_V(6); PG8_BAR;
    }
    for (;;) {
        const bool has_next = S.next(ui + 1, nxt);
        const char* nA = has_next ? (const char*)g.A + (size_t)nxt.pm * tstep : cA; const char* nB = has_next ? (const char*)g.Bt + (size_t)nxt.pn * tstep : cB;
        for (int t = 0; t < nt; t += 2) {
            const bool last = (t == nt - 2);
            const char* a1 = cA + (size_t)(t + 1) * kstep;
            const char* a2 = last ? nA : cA + (size_t)(t + 2) * kstep; const char* b2 = last ? nB : cB + (size_t)(t + 2) * kstep;
            const char* a3 = a2 + kstep; const char* b3 = b2 + kstep;
            if (last && has_next) S.a_ready(nxt);
            if constexpr (SP2) {
            PG8_LDB(B0, 0, 0); PG8_LDB(B1, 0, 1); PG8_SCHED; PG8_LDA(At, 0, 0); PG8_STAGE(PG8_SA(1, 1), a1 + hstep, voffA);
            PG8_WAIT_V(8); PG8_WAIT_L(0); PG8_BAR; PG8_MMA(0, 0, At, B0); PG8_MMA(0, 1, At, B1); PG8_BAR; PG8_SCHED;
            PG8_LDA(At, 0, 1); PG8_STAGE(PG8_SB(0, 0), b2, voffB); PG8_STAGE(PG8_SB(0, 1), b2 + hstep, voffB); PG8_STAGE(PG8_SA(0, 0), a2, voffA);
            PG8_WAIT_V(8); PG8_WAIT_L(0); PG8_BAR; PG8_MMA(1, 0, At, B0); PG8_MMA(1, 1, At, B1); PG8_BAR; PG8_SCHED;
            PG8_LDB(B0, 1, 0); PG8_LDB(B1, 1, 1); PG8_SCHED; PG8_LDA(At, 1, 0); PG8_STAGE(PG8_SA(0, 1), a2 + hstep, voffA);
            PG8_WAIT_V(8); PG8_WAIT_L(0); PG8_BAR; PG8_MMA(0, 0, At, B0); PG8_MMA(0, 1, At, B1); PG8_BAR; PG8_SCHED;
            PG8_LDA(At, 1, 1); PG8_STAGE(PG8_SB(1, 0), b3, voffB); PG8_STAGE(PG8_SB(1, 1), b3 + hstep, voffB); PG8_STAGE(PG8_SA(1, 0), a3, voffA);
            PG8_WAIT_V(8); PG8_WAIT_L(0); PG8_BAR; PG8_MMA(1, 0, At, B0); PG8_MMA(1, 1, At, B1); PG8_BAR; PG8_SCHED;
            } else {
            PG8_LDB(B0, 0, 0); PG8_SCHED; PG8_LDA(At, 0, 0); PG8_STAGE(PG8_SA(1, 1), a1 + hstep, voffA);
            PG8_WAIT_L(8); PG8_BAR; PG8_WAIT_L(0); PG8_MMA(0, 0, At, B0); PG8_BAR; PG8_SCHED;
            PG8_LDB(B1, 0, 1); PG8_STAGE(PG8_SB(0, 0), b2, voffB);
            PG8_BAR; PG8_WAIT_L(0); PG8_MMA(0, 1, At, B1); PG8_BAR;
            PG8_LDA(At, 0, 1); PG8_STAGE(PG8_SA(0, 0), a2, voffA);
            PG8_BAR; PG8_WAIT_L(0); PG8_MMA(1, 0, At, B0); PG8_BAR; PG8_SCHED;
            PG8_STAGE(PG8_SB(0, 1), b2 + hstep, voffB);
            PG8_WAIT_V(6); PG8_BAR; PG8_MMA(1, 1, At, B1); PG8_BAR;
            PG8_LDB(B0, 1, 0); PG8_SCHED; PG8_LDA(At, 1, 0); PG8_STAGE(PG8_SA(0, 1), a2 + hstep, voffA);
            PG8_WAIT_L(8); PG8_BAR; PG8_WAIT_L(0); PG8_MMA(0, 0, At, B0); PG8_BAR; PG8_SCHED;
            PG8_LDB(B1, 1, 1); PG8_STAGE(PG8_SB(1, 0), b3, voffB);
            PG8_BAR; PG8_WAIT_L(0); PG8_MMA(0, 1, At, B1); PG8_BAR;
            PG8_LDA(At, 1, 1); PG8_STAGE(PG8_SA(1, 0), a3, voffA);
            PG8_BAR; PG8_WAIT_L(0); PG8_MMA(1, 0, At, B0); PG8_BAR; PG8_SCHED;
            PG8_STAGE(PG8_SB(1, 1), b3 + hstep, voffB);
            PG8_WAIT_V(6); PG8_BAR; PG8_MMA(1, 1, At, B1); PG8_BAR;
            }
        }
        if constexpr (F8) { asm volatile("s_nop 15\n\ts_nop 15" ::: "memory"); }
        if constexpr (ALIGN_EPI) { if (wr == 0) PG8_BAR; }
        if constexpr (!Epi::AFTER_DRAIN) { E(acc, cur, wr, wc, fr, fq); S.done(cur); }
        if (!has_next) break;
#pragma unroll
        for (int a = 0; a < 2; ++a)
#pragma unroll
            for (int b = 0; b < 2; ++b)
#pragma unroll
                for (int m = 0; m < 4; ++m)
#pragma unroll
                    for (int n = 0; n < 2; ++n) acc[a][b][m][n] = (f32x4){0.f, 0.f, 0.f, 0.f};
        cur = nxt; cA = nA; cB = nB; ++ui;
        if constexpr (ALIGN_EPI) { if (wr == 1) PG8_BAR; }
    }
    PG8_WAIT_V(0);
    if constexpr (!ALIGN_EPI) { if (wr == 0) PG8_BAR; }
    PG8_BAR;
    if constexpr (Epi::AFTER_DRAIN) { E.fused(acc, cur, wr, wc, fr, fq, lds, wid, lane); S.done(cur); }
#undef PG8_SA
#undef PG8_SB
#undef PG8_STAGE
#undef PG8_LDA
#undef PG8_LDB
#undef PG8_MMA
#undef PG8_WAIT_V
#undef PG8_WAIT_L
#undef PG8_BAR
#undef PG8_SCHED
}
}

namespace attn_body {
using bf16=__hip_bfloat16;
using bf16x8=__attribute__((ext_vector_type(8)))short;
using s16x4=__attribute__((ext_vector_type(4)))short;
using f32x16=__attribute__((ext_vector_type(16)))float;
using u32x4=__attribute__((ext_vector_type(4)))unsigned;
constexpr int BATCH=8,NHEAD=8,NKV=2,SEQ=2048,D=64,PQ=2304,PO=1024;
constexpr int NW=8,QBLK=32,QB=QBLK*NW,KVBLK=64,NQB=SEQ/QB;
constexpr int ATTN_UNIT_ROWS=QB;
__device__ __forceinline__ int crow(int r,int hi){return (r&3)+8*(r>>2)+4*hi;}
#define SBAR() __builtin_amdgcn_sched_barrier(0)
__device__ __forceinline__ void cmask(f32x16&p0,f32x16&p1,int jb,int qrel,int hi){
  const float NEG=-INFINITY; int kb=64*jb+4*hi;
  #pragma unroll
  for(int r=0;r<16;++r){int kv=kb+(r&3)+8*(r>>2); if(kv>qrel)p0[r]=NEG; if(kv+32>qrel)p1[r]=NEG;}
}

constexpr int NSLOT=3, SLOTB=8192;
constexpr int LDS_K=0, LDS_V=NSLOT*SLOTB, LDS_WS=2*NSLOT*SLOTB, LDS_OST=LDS_WS+NW*64*4, LDS_BYTES=LDS_OST+NW*4096;
constexpr float C2=0.125f*1.4426950408889634f;
__device__ __forceinline__ void glds16(const void*gsrc,unsigned lds_dst){unsigned keep;
  asm volatile("s_mov_b32 %0, m0\n\ts_mov_b32 m0, %2\n\ts_nop 0\n\tglobal_load_lds_dwordx4 %1, off\n\ts_mov_b32 m0, %0":"=&s"(keep):"v"(gsrc),"s"(lds_dst):"memory");}
__device__ __forceinline__ float max3f(float a,float b,float c){float r;asm("v_max3_f32 %0, %1, %2, %3":"=v"(r):"v"(a),"v"(b),"v"(c));return r;}
__device__ __forceinline__ float max2f(float a,float b){float r;asm("v_max_f32_e32 %0, %1, %2":"=v"(r):"v"(a),"v"(b));return r;}
__device__ __forceinline__ float fadd_s(float a,float b){float r;asm("v_add_f32_e32 %0, %1, %2":"=v"(r):"v"(a),"v"(b));return r;}
__device__ __forceinline__ float fsub_s(float a,float b){float r;asm("v_sub_f32_e32 %0, %1, %2":"=v"(r):"v"(a),"v"(b));return r;}
typedef float f32x2_t __attribute__((ext_vector_type(2))); typedef __bf16 bf16x2_t __attribute__((ext_vector_type(2)));
__device__ __forceinline__ unsigned cvtpk_s(float lo,float hi){f32x2_t v={lo,hi};bf16x2_t b=__builtin_convertvector(v,bf16x2_t);return __builtin_bit_cast(unsigned,b);}
#define WAIT_BAR(N) asm volatile("s_waitcnt vmcnt(" #N ") lgkmcnt(0)\n\ts_barrier":::"memory")

__device__ __forceinline__ void qkt(f32x16&p0,f32x16&p1,const char*Kslot,const bf16x8*qr,const f32x16&negm,int r32,int hi){
  const char*kb=Kslot+hi*1024+r32*16;
  #pragma unroll
  for(int d0=0;d0<4;++d0){
    const bf16x8 b0=*reinterpret_cast<const bf16x8*>(kb+d0*2048);
    const bf16x8 b1=*reinterpret_cast<const bf16x8*>(kb+d0*2048+512);
    if(d0==0){p0=__builtin_amdgcn_mfma_f32_32x32x16_bf16(b0,qr[0],negm,0,0,0);p1=__builtin_amdgcn_mfma_f32_32x32x16_bf16(b1,qr[0],negm,0,0,0);}
    else{p0=__builtin_amdgcn_mfma_f32_32x32x16_bf16(b0,qr[d0],p0,0,0,0);p1=__builtin_amdgcn_mfma_f32_32x32x16_bf16(b1,qr[d0],p1,0,0,0);}}
}
typedef __attribute__((address_space(3))) const char* lds_cptr;
typedef short v4i16_t __attribute__((ext_vector_type(4)));
__device__ __forceinline__ void kload8(bf16x8*kf,lds_cptr kp){
  kf[0]=*(const __attribute__((address_space(3))) bf16x8*)(kp);      kf[1]=*(const __attribute__((address_space(3))) bf16x8*)(kp+512);
  kf[2]=*(const __attribute__((address_space(3))) bf16x8*)(kp+2048); kf[3]=*(const __attribute__((address_space(3))) bf16x8*)(kp+2560);
  kf[4]=*(const __attribute__((address_space(3))) bf16x8*)(kp+4096); kf[5]=*(const __attribute__((address_space(3))) bf16x8*)(kp+4608);
  kf[6]=*(const __attribute__((address_space(3))) bf16x8*)(kp+6144); kf[7]=*(const __attribute__((address_space(3))) bf16x8*)(kp+6656);
}
__device__ __forceinline__ void kload2(bf16x8*kf,lds_cptr kp,int j){ kf[2*j]=*(const __attribute__((address_space(3))) bf16x8*)(kp+j*2048); kf[2*j+1]=*(const __attribute__((address_space(3))) bf16x8*)(kp+j*2048+512); }
__device__ __forceinline__ s16x4 vtr(lds_cptr p){ return __builtin_bit_cast(s16x4,__builtin_amdgcn_ds_read_tr16_b64_v4i16((__attribute__((address_space(3))) v4i16_t*)p)); }
__device__ __forceinline__ float rowmax(const f32x16&p0,const f32x16&p1){
  float a=max3f(p0[0],p0[1],p1[0]),b=max3f(p0[2],p0[3],p1[1]);a=max3f(a,p1[2],p1[3]);
  #pragma unroll
  for(int r=4;r<16;r+=4){a=max3f(a,p0[r],p0[r+1]);b=max3f(b,p0[r+2],p0[r+3]);a=max3f(a,p1[r],p1[r+1]);b=max3f(b,p1[r+2],p1[r+3]);}
  const float m=max2f(a,b);
  auto rr=__builtin_amdgcn_permlane32_swap(__float_as_uint(m),__float_as_uint(m),false,false);
  return max2f(__uint_as_float(rr[0]),__uint_as_float(rr[1]));
}
__device__ __forceinline__ void pv(f32x16*o,int vb,bf16x8 pa0,bf16x8 pa1,bf16x8 pa2,bf16x8 pa3){
  #pragma unroll
  for(int d0=0;d0<2;++d0){s16x4 lo[4],hi[4];
    #pragma unroll
    for(int ks=0;ks<4;++ks){
      asm volatile("ds_read_b64_tr_b16 %0,%1 offset:%c2":"=&v"(lo[ks]):"v"(vb),"i"(d0*4096+ks*1024):"memory");
      asm volatile("ds_read_b64_tr_b16 %0,%1 offset:%c2":"=&v"(hi[ks]):"v"(vb),"i"(d0*4096+ks*1024+512):"memory");}
    asm volatile("s_waitcnt lgkmcnt(0)":::"memory");SBAR();
    #define PK(k) (bf16x8){lo[k][0],lo[k][1],lo[k][2],lo[k][3],hi[k][0],hi[k][1],hi[k][2],hi[k][3]}
    o[d0]=__builtin_amdgcn_mfma_f32_32x32x16_bf16(pa0,PK(0),o[d0],0,0,0);
    o[d0]=__builtin_amdgcn_mfma_f32_32x32x16_bf16(pa1,PK(1),o[d0],0,0,0);
    o[d0]=__builtin_amdgcn_mfma_f32_32x32x16_bf16(pa2,PK(2),o[d0],0,0,0);
    o[d0]=__builtin_amdgcn_mfma_f32_32x32x16_bf16(pa3,PK(3),o[d0],0,0,0);
    #undef PK
  }
}

#ifndef ATTN_STORE16
#define ATTN_STORE16(p,v) (*(u32x4*)(p)=(v))
#endif
template<int THRL> __device__ __forceinline__ void attn_unit(int b,int h,int qb,const bf16*Q,const bf16*__restrict__ K,const bf16*__restrict__ V,bf16*O,char*shm){
  const int tid=ltid(),lane=tid&63,r32=lane&31,hi=lane>>5; const int wid=__builtin_amdgcn_readfirstlane(tid>>6);
  const long rowbase=(long)b*SEQ; const int q0=qb*QB;
  const bf16*Qw=Q+(rowbase+q0+wid*QBLK)*PQ+h*D;
  const bf16*Kh=K+rowbase*PQ+(h>>2)*D,*Vh=V+rowbase*PQ+(h>>2)*D;
  const unsigned lds0=(unsigned)(uintptr_t)shm;
  float*wsf=(float*)(shm+LDS_WS)+wid*64;
  const bf16*ksrc=Kh+(long)lane*PQ+wid*8;
  const bf16*vsrc=Vh+(long)(16*(wid&3)+(lane>>2))*PQ+(wid>>2)*32+(lane&3)*8;
  const unsigned kdst=lds0+LDS_K+wid*1024, vdst=lds0+LDS_V+wid*1024;
  #define DMA_K(t,slot) glds16(ksrc+(long)(t)*KVBLK*PQ,(unsigned)__builtin_amdgcn_readfirstlane(kdst+(slot)))
  #define DMA_V(t,slot) glds16(vsrc+(long)(t)*KVBLK*PQ,(unsigned)__builtin_amdgcn_readfirstlane(vdst+(slot)))
  const int vb0=(int)(lds0+LDS_V)+((lane>>4)&1)*32+(lane&3)*8+(4*hi+((lane&15)>>2))*64;
  const char*Kbase=shm+LDS_K; bf16x8 kf[8];
  const lds_cptr shm3=(lds_cptr)shm; const lds_cptr kp0=shm3+LDS_K+hi*1024+r32*16; const lds_cptr vp0=shm3+LDS_V+((lane>>4)&1)*32+(lane&3)*8+(4*hi+((lane&15)>>2))*64;
  const int NT=SEQ/KVBLK;
  DMA_K(0,0);DMA_V(0,0);DMA_K(1,SLOTB);
  bf16x8 qr[4];
  #pragma unroll
  for(int d0=0;d0<4;++d0)qr[d0]=*reinterpret_cast<const bf16x8*>(&Qw[(long)r32*PQ+d0*16+hi*8]);
  float mhat=0.f,l_reg=0.f;f32x16 o[2];o[0]=f32x16{};o[1]=f32x16{};f32x16 negm=f32x16{};asm volatile("":"+v"(negm));
  const int qrel=wid*QBLK+r32;
  #define CMASK(P0,P1,t) do{}while(0)
  bool resc=false;
  #define START(P0,P1) do{ const float rm=rowmax(P0,P1); resc=false; \
    { const float dl=rm; mhat=fadd_s(mhat,dl); \
      _Pragma("unroll") for(int r=0;r<16;++r){P0[r]=fsub_s(P0[r],dl);P1[r]=fsub_s(P1[r],dl);} \
      _Pragma("unroll") for(int r=0;r<16;++r)negm[r]=-mhat; asm volatile("":"+v"(negm)); } \
    _Pragma("unroll") for(int r=0;r<16;++r)P0[r]=__builtin_amdgcn_exp2f(P0[r]); }while(0)
  #define RESC() do{ if(resc){ asm volatile("s_waitcnt lgkmcnt(0)":::"memory"); \
      _Pragma("unroll") for(int d_=0;d_<2;++d_) _Pragma("unroll") for(int r=0;r<16;++r)o[d_][r]*=wsf[crow(r,hi)]; } }while(0)
  f32x16 pA0,pA1,pB0,pB1;
  int sl_prev=0,sl_cur=0,sl_next=SLOTB;
  #define ROT() do{sl_prev=sl_cur;sl_cur=sl_next;sl_next=(sl_next==(NSLOT-1)*SLOTB)?0:sl_next+SLOTB;}while(0)
  DMA_K(2,2*SLOTB);
  WAIT_BAR(3);
  qkt(pA0,pA1,Kbase,qr,negm,r32,hi);asm volatile("s_nop 15\n\ts_nop 7":"+v"(pA0),"+v"(pA1));CMASK(pA0,pA1,0);
  START(pA0,pA1);
  _Pragma("unroll") for(int r=0;r<16;++r)pA1[r]=__builtin_amdgcn_exp2f(pA1[r]);
  WAIT_BAR(0);
  DMA_K(3,0);DMA_V(1,SLOTB);
  ROT();
  kload8(kf,kp0+sl_cur);
  WAIT_BAR(2);
  s16x4 vlo[8],vhi[8]; u32x4 pw0,pw1,pw2,pw3;
  #define PKW(P,B) cvtpk_s(P[B],P[B+1])
  #define PAF(k) __builtin_bit_cast(bf16x8,pw##k)
  #define VFR(i) (bf16x8){vlo[i][0],vlo[i][1],vlo[i][2],vlo[i][3],vhi[i][0],vhi[i][1],vhi[i][2],vhi[i][3]}
  #define PIN(x) asm volatile("":"+v"(x))
  #define MX3(a,b,c) __builtin_fmaxf(__builtin_fmaxf((a),(b)),(c))
  #define GAPA(MF,A0,A1,A2,A3,W0,W1,PW) do{ MF; sacc+=A0; sacc+=A1; sacc+=A2; sacc+=A3; PIN(sacc); W0; W1; PIN(PW); SBAR(); }while(0)
  #define EX(v) __builtin_amdgcn_exp2f(v)
  #define GAPB(MF,X,B) do{ MF; X[B]=EX(X[B]); X[B+1]=EX(X[B+1]); X[B+2]=EX(X[B+2]); X[B+3]=EX(X[B+3]); PIN(X); SBAR(); }while(0)
  #define VRD(i) do{ vlo[i]=vtr(vp_+(((i)>>2)*4096+((i)&3)*1024)); vhi[i]=vtr(vp_+(((i)>>2)*4096+((i)&3)*1024+512)); }while(0)
  #define KRD(G,j) do{ if(G){ kload2(kf,kp0+sl_next,j); SBAR(); } }while(0)
  #define STEP(C0,C1,P0,P1,t,GK,GV,GL) do{ SBAR(); \
    const lds_cptr vp_=vp0+sl_prev; \
    VRD(0); SBAR(); float sacc=(P0[0]+P0[1]); \
    GAPA(C0=__builtin_amdgcn_mfma_f32_32x32x16_bf16(kf[0],qr[0],negm,0,0,0), P0[2],P0[3],P0[4],P0[5],     pw0[0]=PKW(P0,0), pw0[1]=PKW(P0,2), pw0); \
    VRD(4); SBAR(); GAPA(C1=__builtin_amdgcn_mfma_f32_32x32x16_bf16(kf[1],qr[0],negm,0,0,0), P0[6],P0[7],P0[8],P0[9],     pw0[2]=PKW(P0,4), pw0[3]=PKW(P0,6), pw0); \
    VRD(1); SBAR(); GAPA(C0=__builtin_amdgcn_mfma_f32_32x32x16_bf16(kf[2],qr[1],C0,0,0,0),   P0[10],P0[11],P0[12],P0[13], pw1[0]=PKW(P0,8), pw1[1]=PKW(P0,10), pw1); \
    VRD(5); SBAR(); GAPA(C1=__builtin_amdgcn_mfma_f32_32x32x16_bf16(kf[3],qr[1],C1,0,0,0),   P0[14],P0[15],P1[0],P1[1],   pw1[2]=PKW(P0,12),pw1[3]=PKW(P0,14), pw1); \
    VRD(2); SBAR(); GAPA(C0=__builtin_amdgcn_mfma_f32_32x32x16_bf16(kf[4],qr[2],C0,0,0,0),   P1[2],P1[3],P1[4],P1[5],     pw2[0]=PKW(P1,0), pw2[1]=PKW(P1,2), pw2); \
    VRD(6); SBAR(); GAPA(C1=__builtin_amdgcn_mfma_f32_32x32x16_bf16(kf[5],qr[2],C1,0,0,0),   P1[6],P1[7],P1[8],P1[9],     pw2[2]=PKW(P1,4), pw2[3]=PKW(P1,6), pw2); \
    VRD(3); SBAR(); GAPA(C0=__builtin_amdgcn_mfma_f32_32x32x16_bf16(kf[6],qr[3],C0,0,0,0),   P1[10],P1[11],P1[12],P1[13], pw3[0]=PKW(P1,8), pw3[1]=PKW(P1,10), pw3); \
    VRD(7); SBAR(); GAPA(C1=__builtin_amdgcn_mfma_f32_32x32x16_bf16(kf[7],qr[3],C1,0,0,0),   P1[14],P1[15],0.f,0.f,       pw3[2]=PKW(P1,12),pw3[3]=PKW(P1,14), pw3); \
    l_reg+=sacc; \
    if(GK){DMA_K((t)+3,sl_cur);} if(GV){DMA_V((t)+1,sl_next);} \
    CMASK(C0,C1,t); \
    { float a=MX3(C0[0],C0[1],C1[0]),b=MX3(C0[2],C0[3],C1[1]); a=MX3(a,C1[2],C1[3]); \
      _Pragma("unroll") for(int r=4;r<16;r+=4){a=MX3(a,C0[r],C0[r+1]);b=MX3(b,C0[r+2],C0[r+3]);a=MX3(a,C1[r],C1[r+1]);b=MX3(b,C1[r+2],C1[r+3]);} \
      float rm=__builtin_fmaxf(a,b); { auto rr=__builtin_amdgcn_permlane32_swap(__float_as_uint(rm),__float_as_uint(rm),false,false); rm=__builtin_fmaxf(__uint_as_float(rr[0]),__uint_as_float(rr[1])); } \
      resc=false; \
      if(__builtin_expect(__any(rm>(float)THRL),0)){ const float dl=__builtin_fmaxf(rm,0.f); mhat+=dl; \
        _Pragma("unroll") for(int r=0;r<16;++r){C0[r]-=dl;C1[r]-=dl;} \
        _Pragma("unroll") for(int r=0;r<16;++r)negm[r]=-mhat; asm volatile("":"+v"(negm)); \
        const float f=__builtin_amdgcn_exp2f(-dl); l_reg*=f; if(hi==0)wsf[r32]=f; resc=true; } } \
    SBAR(); \
    GAPB(o[0]=__builtin_amdgcn_mfma_f32_32x32x16_bf16(PAF(0),VFR(0),o[0],0,0,0), C0,0); \
    GAPB(o[1]=__builtin_amdgcn_mfma_f32_32x32x16_bf16(PAF(0),VFR(4),o[1],0,0,0), C0,4); \
    KRD(GL,0); GAPB(o[0]=__builtin_amdgcn_mfma_f32_32x32x16_bf16(PAF(1),VFR(1),o[0],0,0,0), C0,8); \
    KRD(GL,1); GAPB(o[1]=__builtin_amdgcn_mfma_f32_32x32x16_bf16(PAF(1),VFR(5),o[1],0,0,0), C0,12); \
    KRD(GL,2); GAPB(o[0]=__builtin_amdgcn_mfma_f32_32x32x16_bf16(PAF(2),VFR(2),o[0],0,0,0), C1,0); \
    KRD(GL,3); GAPB(o[1]=__builtin_amdgcn_mfma_f32_32x32x16_bf16(PAF(2),VFR(6),o[1],0,0,0), C1,4); \
    GAPB(o[0]=__builtin_amdgcn_mfma_f32_32x32x16_bf16(PAF(3),VFR(3),o[0],0,0,0), C1,8); \
    GAPB(o[1]=__builtin_amdgcn_mfma_f32_32x32x16_bf16(PAF(3),VFR(7),o[1],0,0,0), C1,12); \
    }while(0)
  int t=1;
  #undef CMASK
  #define CMASK(P0,P1,t) do{}while(0)
  for(;t+5<NT;t+=2){
    STEP(pB0,pB1,pA0,pA1,t,true,true,true);     WAIT_BAR(2); RESC(); ROT();
    STEP(pA0,pA1,pB0,pB1,t+1,true,true,true);   WAIT_BAR(2); RESC(); ROT();
  }
  #undef CMASK
  #define CMASK(P0,P1,t) do{}while(0)
  #define ENDW(tt) do{ if((tt)+3<NT){WAIT_BAR(2);} else if((tt)+2<NT){WAIT_BAR(1);} else {WAIT_BAR(0);} }while(0)
  for(;t+1<NT;t+=2){
    STEP(pB0,pB1,pA0,pA1,t,(t+3<NT),(t+1<NT),(t+1<NT));       ENDW(t);   RESC(); ROT();
    STEP(pA0,pA1,pB0,pB1,t+1,(t+4<NT),(t+2<NT),(t+2<NT));     ENDW(t+1); RESC(); ROT();
  }
  STEP(pB0,pB1,pA0,pA1,NT-1,false,false,false); RESC();
  { float sacc=pB0[0]+pB0[1]; _Pragma("unroll") for(int r=2;r<16;++r)sacc+=pB0[r]; _Pragma("unroll") for(int r=0;r<16;++r)sacc+=pB1[r]; l_reg+=sacc;
    pw0=(u32x4){PKW(pB0,0),PKW(pB0,2),PKW(pB0,4),PKW(pB0,6)};pw1=(u32x4){PKW(pB0,8),PKW(pB0,10),PKW(pB0,12),PKW(pB0,14)};pw2=(u32x4){PKW(pB1,0),PKW(pB1,2),PKW(pB1,4),PKW(pB1,6)};pw3=(u32x4){PKW(pB1,8),PKW(pB1,10),PKW(pB1,12),PKW(pB1,14)};
    SBAR(); pv(o,vb0+sl_cur,PAF(0),PAF(1),PAF(2),PAF(3)); }
  #undef PKW
  #undef PAF
  #undef VFR
  #undef PIN
  #undef MX3
  #undef GAPA
  #undef GAPB
  #undef EX
  #undef VRD
  #undef KRD
  #undef STEP
  #undef ENDW
  {auto rr=__builtin_amdgcn_permlane32_swap(__float_as_uint(l_reg),__float_as_uint(l_reg),false,false);l_reg=__uint_as_float(rr[0])+__uint_as_float(rr[1]);}
  if(hi==0)wsf[32+r32]=l_reg;asm volatile("s_waitcnt lgkmcnt(0)":::"memory");
  float rli[16];
  #pragma unroll
  for(int r=0;r<16;++r)rli[r]=__builtin_amdgcn_rcpf(wsf[32+crow(r,hi)]);
  bf16*Ow=O+(rowbase+q0+wid*QBLK)*PO+h*D;
  { bf16*stg=(bf16*)(shm+LDS_OST)+wid*2048;
    #pragma unroll
    for(int r=0;r<16;++r){const int orow=crow(r,hi);
      #pragma unroll
      for(int d0=0;d0<2;++d0)stg[orow*64+d0*32+r32]=__float2bfloat16(o[d0][r]*rli[r]);}
    asm volatile("s_waitcnt lgkmcnt(0)":::"memory");
    #pragma unroll
    for(int i=0;i<4;++i){const int row=i*8+(lane>>3),ch=lane&7; const u32x4 v=*(const u32x4*)(stg+row*64+ch*8); ATTN_STORE16(Ow+(long)row*PO+ch*8,v);} }
  asm volatile("s_waitcnt lgkmcnt(0)\n\ts_barrier":::"memory");
  #undef DMA_K
  #undef DMA_V
  #undef CMASK
  #undef START
  #undef RESC
  #undef ROT
}
constexpr int ATTN_LDS_BYTES=LDS_BYTES;
struct AttnTensors { const bf16* Q; const bf16* K; const bf16* V; bf16* O; };
struct AttnUnit { int b; int h; int qb; };
struct StaticOrder {
  int vcu, G;
  __device__ __forceinline__ explicit StaticOrder(int grid,int block):vcu((grid%8==0)?(block%8)*(grid/8)+block/8:block),G(grid){}
  __device__ __forceinline__ bool next(int i,AttnUnit&u)const{ const int L=i*G+vcu; if(L>=BATCH*NHEAD*(SEQ/QB))return false; const int grp=L>>5,r=L&31; u.b=grp>>1; u.h=(grp&1)*4+(r>>3); u.qb=r&7; return true; }
  __device__ __forceinline__ void a_ready(const AttnUnit&)const{}
  __device__ __forceinline__ void done(const AttnUnit&)const{}
};
template<class Sched,int THRL=8> __device__ __forceinline__ void attn_phase(char*lds,const AttnTensors&T,const Sched&S){
  AttnUnit u;
  for(int i=0;S.next(i,u);++i){ S.a_ready(u); attn_unit<THRL>(u.b,u.h,u.qb,T.Q,T.K,T.V,T.O,lds); S.done(u); }
}
#undef SBAR
#undef WAIT_BAR
}


#define GAS __attribute__((address_space(1)))
#define LAS __attribute__((address_space(3)))
typedef unsigned short bf16;
typedef unsigned v4u __attribute__((ext_vector_type(4)));
typedef float f32x4 __attribute__((ext_vector_type(4)));
typedef short bf16x8 __attribute__((ext_vector_type(8)));
typedef GAS unsigned gu32;
typedef GAS unsigned long long gu64;
#define RLX_AGENT __ATOMIC_RELAXED, __HIP_MEMORY_SCOPE_AGENT
#define LDS_WAIT() asm volatile("s_waitcnt lgkmcnt(0)" ::: "memory")
#define VM_WAIT() asm volatile("s_waitcnt vmcnt(0)" ::: "memory")
__device__ __forceinline__ unsigned long long rt() { return __builtin_amdgcn_s_memrealtime(); }
__device__ __forceinline__ unsigned f2bf(float f) { unsigned u = __builtin_bit_cast(unsigned, f); return (u + 0x7fffu + ((u >> 16) & 1u)) >> 16; }
__device__ __forceinline__ unsigned pk2(float lo, float hi) { return f2bf(lo) | (f2bf(hi) << 16); }

#define XB_TMO      128
#define XB_XCNT(j)  (256  + 64 * (j))
#define XB_XSUB(j)  (1280 + 64 * (j))
#define XB_XGEN(j)  (2304 + 64 * (j))
#define XB_TOP      3328
#define XB_TOPGEN   3392
#define XCD_BAR_WORDS 3456
#define XB_SPIN_CAP (1u << 18)

__device__ __forceinline__ unsigned xb_ld(unsigned* p)              { return __hip_atomic_load(p, __ATOMIC_RELAXED, __HIP_MEMORY_SCOPE_AGENT); }
__device__ __forceinline__ unsigned xb_add(unsigned* p, unsigned v) { return __hip_atomic_fetch_add(p, v, __ATOMIC_RELAXED, __HIP_MEMORY_SCOPE_AGENT); }
__device__ __forceinline__ unsigned xb_xcc_id() { return (unsigned)__builtin_amdgcn_s_getreg((3 << 11) | 20) & 0xFu; }
#define XB_SPIN(cond, bar) do { unsigned _sp = 0; while (cond) { __builtin_amdgcn_s_sleep(1); \
    if ((++_sp & 255u) == 0u) { if (xb_ld(&(bar)[XB_TMO])) break; if (_sp > XB_SPIN_CAP) { atomicAdd(&(bar)[XB_TMO], 1u); break; } } } } while (0)

struct XcdBarrier {
    unsigned* bar; unsigned x;
    volatile LAS unsigned* st;
};

__device__ __forceinline__ XcdBarrier xcd_barrier_post(unsigned* bar, volatile LAS unsigned* st) {
    XcdBarrier b; b.bar = bar; b.x = xb_xcc_id(); b.st = st;
    if (threadIdx.x == 0) (void)xb_add(&bar[XB_XCNT(b.x)], 1u);
    return b;
}
__device__ __forceinline__ void xcd_barrier_complete(unsigned* bar, unsigned x, unsigned& nloc, unsigned& nx) {
    const unsigned G = gridDim.x * gridDim.y * gridDim.z;
    unsigned sum, cnt, mine, sp = 0u;
    for (;;) {
        sum = 0u; cnt = 0u; mine = 0u;
#pragma unroll
        for (unsigned j = 0; j < 16; ++j) { const unsigned c = xb_ld(&bar[XB_XCNT(j)]); sum += c; cnt += (c > 0u) ? 1u : 0u; mine = (j == x) ? c : mine; }
        if (sum == G) break;
        __builtin_amdgcn_s_sleep(1);
        if ((++sp & 255u) == 0u) { if (xb_ld(&bar[XB_TMO])) break; if (sp > XB_SPIN_CAP) { atomicAdd(&bar[XB_TMO], 1u); break; } }
    }
    nloc = mine > 0u ? mine : 1u; nx = cnt > 0u ? cnt : 1u;
}

__device__ __forceinline__ void xcd_barrier(const XcdBarrier& b) {
    asm volatile("s_waitcnt vmcnt(0)" ::: "memory");
    __syncthreads();
    if (threadIdx.x == 0) {
        unsigned* bar = b.bar;
        __builtin_amdgcn_s_waitcnt(0);
        unsigned nloc = b.st[0], nx = b.st[1];
        if (nloc == 0u) { xcd_barrier_complete(bar, b.x, nloc, nx); b.st[0] = nloc; b.st[1] = nx; }
        const unsigned old = xb_add(&bar[XB_XSUB(b.x)], 1u);
        const unsigned gen = old / nloc;
        if (old + 1u == (gen + 1u) * nloc) {
            __builtin_amdgcn_fence(__ATOMIC_RELEASE, "agent");
            asm volatile("s_waitcnt vmcnt(0)" ::: "memory");
            const unsigned og = xb_add(&bar[XB_TOP], 1u);
            const unsigned tg = og / nx;
            if (og + 1u == (tg + 1u) * nx) xb_add(&bar[XB_TOPGEN], 1u);
            else XB_SPIN(xb_ld(&bar[XB_TOPGEN]) == tg, bar);
            __builtin_amdgcn_fence(__ATOMIC_ACQUIRE, "agent");
            xb_add(&bar[XB_XGEN(b.x)], 1u);
            asm volatile("s_waitcnt vmcnt(0)" ::: "memory");
        } else {
            XB_SPIN(xb_ld(&bar[XB_XGEN(b.x)]) == gen, bar);
            __builtin_amdgcn_fence(__ATOMIC_ACQUIRE, "agent");
            asm volatile("s_waitcnt vmcnt(0)" ::: "memory");
        }
    }
    __syncthreads();
}

constexpr int NWAVES = 8, NTHR = 512;
constexpr int DM = 1024, NB = 8, SEQ = 2048, DEPTH = 4, M = NB * SEQ;
constexpr int DIN = 2320, NPROJ = 2304;
constexpr int C_Q = 0, C_K = 512, C_V = 640, C_LX = 768, C_LG = 1024, C_MQ = 1280, C_MK = 1536, C_MV = 1792, C_MO = 2048;
constexpr int NE = 16, CAP = 256, DE = 2048, NSLOT = NB * CAP;
constexpr float EPS = 1e-6f;
constexpr int NPH = 1 + 10 * DEPTH;

constexpr size_t MiB = 1u << 20;
constexpr size_t WS_CTL = 0, CTL_ZERO_BYTES = 1 * MiB;
constexpr size_t WS_ROPE = 1 * MiB;
constexpr size_t WS_LRUW = 2 * MiB;
constexpr size_t WS_WIN = 4 * MiB;
constexpr size_t WS_WOUT = 22 * MiB;
constexpr size_t WS_WGU = 32 * MiB;
constexpr size_t WS_WDN = 544 * MiB;
constexpr size_t WS_H = 800 * MiB;
constexpr size_t WS_PROJ = 832 * MiB;
constexpr size_t WS_Y = 904 * MiB;
constexpr size_t WS_MG = 936 * MiB;
constexpr size_t WS_AFF = 937 * MiB;
constexpr size_t WS_SEL = 938 * MiB;
constexpr size_t WS_IDX = 939 * MiB;
constexpr size_t WS_GATE = WS_IDX + 128 * 1024;
constexpr size_t WS_LH = 940 * MiB;
constexpr size_t WS_CP = 956 * MiB;
constexpr size_t WS_CARRY = 972 * MiB;
constexpr size_t WS_CLOC = 974 * MiB;
constexpr size_t WS_NLOC = 990 * MiB;
constexpr size_t WS_MLOC = WS_NLOC + 512 * 1024;
constexpr size_t WS_XG = 992 * MiB;
constexpr size_t WS_HID = 1056 * MiB;
constexpr size_t WS_YE = 1184 * MiB;
constexpr size_t WS_CPREV = 1280 * MiB;
constexpr size_t WS_NPREV = 1288 * MiB;
constexpr size_t WS_MPREV = WS_NPREV + 512 * 1024;
constexpr size_t WS_XB = 1248 * MiB;
constexpr size_t WS_END = 1290 * MiB;
constexpr int CW_BAR = 4096;

constexpr int RING_OFF = 0, RING_BYTES = 143360;
constexpr int MISC_OFF = RING_BYTES;
constexpr int LDS_BYTES = 147456;

typedef unsigned u32x2 __attribute__((ext_vector_type(2)));
__device__ __forceinline__ float bf2f(unsigned short v) { return __uint_as_float(((unsigned)v) << 16); }
__device__ __forceinline__ float bflo(unsigned v) { return __uint_as_float(v << 16); }
__device__ __forceinline__ float bfhi(unsigned v) { return __uint_as_float(v & 0xffff0000u); }
template <int CTRL> __device__ __forceinline__ float dppf(float v) { return __uint_as_float((unsigned)__builtin_amdgcn_update_dpp(0, (int)__float_as_uint(v), CTRL, 0xF, 0xF, true)); }
__device__ __forceinline__ float row16_sum(float v) { v += dppf<0xB1>(v); v += dppf<0x4E>(v); v += dppf<0x141>(v); v += dppf<0x140>(v); return v; }
__device__ __forceinline__ float xor16_sum(float v) { const auto r = __builtin_amdgcn_permlane16_swap(__float_as_uint(v), __float_as_uint(v), false, false); return __uint_as_float(r[0]) + __uint_as_float(r[1]); }
__device__ __forceinline__ float xor32_sum(float v) { const auto r = __builtin_amdgcn_permlane32_swap(__float_as_uint(v), __float_as_uint(v), false, false); return __uint_as_float(r[0]) + __uint_as_float(r[1]); }
__device__ __forceinline__ float half_sum(float v) { return xor16_sum(row16_sum(v)); }
__device__ __forceinline__ float wave_sum(float v) { return xor32_sum(xor16_sum(row16_sum(v))); }
__device__ __forceinline__ float wave_max(float v) {
#pragma unroll
    for (int o = 1; o < 64; o <<= 1) v = fmaxf(v, __shfl_xor(v, o));
    return v;
}
__device__ __forceinline__ float fexp(float x) { return __builtin_amdgcn_exp2f(1.4426950408889634f * x); }
__device__ __forceinline__ float frcp(float x) { return __builtin_amdgcn_rcpf(x); }
__device__ __forceinline__ float frsq(float x) { return __builtin_amdgcn_rsqf(x); }
__device__ __forceinline__ float sigmoid_f(float x) { return frcp(1.0f + fexp(-x)); }
__device__ __forceinline__ float one_minus_exp(float x) {
    const float p = -x * (1.0f + 0.5f * x * (1.0f + (1.0f / 3.0f) * x * (1.0f + 0.25f * x * (1.0f + 0.2f * x))));
    return (x > -0.25f) ? p : 1.0f - fexp(x); }
__device__ __forceinline__ float logsig_f(float x) { return fminf(x, 0.f) - log1pf(expf(-fabsf(x))); }
__device__ __forceinline__ float gelu_tanh_f(float x) { const float u = 0.7978845608028654f * (x + 0.044715f * x * x * x); return x * (1.0f - frcp(1.0f + fexp(2.0f * u))); }
template <bool MAXOP, bool REV> __device__ __forceinline__ void wave_scan128(const LAS float* in, LAS float* out, int lane) {
    const int j0 = REV ? 127 - 2 * lane : 2 * lane, j1 = REV ? 126 - 2 * lane : 2 * lane + 1;
    const float a = in[j0], b = in[j1];
    const float s1 = MAXOP ? fmaxf(a, b) : a + b;
    float incl = s1;
#pragma unroll
    for (int o = 1; o < 64; o <<= 1) { const float t = __shfl_up(incl, o); if (lane >= o) incl = MAXOP ? fmaxf(incl, t) : incl + t; }
    const float ex = __shfl_up(incl, 1);
    const float e = (lane == 0) ? (MAXOP ? -INFINITY : 0.f) : ex;
    out[j0] = MAXOP ? fmaxf(e, a) : e + a; out[j1] = MAXOP ? fmaxf(e, s1) : e + s1;
}
#define WAVE_LDS_FENCE() asm volatile("s_waitcnt lgkmcnt(0)" ::: "memory")
#define MFMA16(a, b, c) __builtin_amdgcn_mfma_f32_16x16x32_bf16((a), (b), (c), 0, 0, 0)
#define WG_SYNC() __syncthreads()

struct Args { const float* in[22]; float* out; unsigned char* ws; int ph_lo, ph_hi, li, pad; };
enum { I_X = 0, I_N1G, I_WIN, I_QG, I_KG, I_CW, I_CB, I_WA, I_BA, I_WX, I_BX, I_LAM, I_FB, I_MNG, I_AOG, I_LOG, I_WOUT, I_N2G, I_WR, I_WG, I_WU, I_WD };

__device__ __forceinline__ void cvt_item(const float* __restrict__ src, int N, int k0, int n0, bf16* dst, int Kd, LAS float* scr, int lane) {
    { const int r4 = lane >> 4, c4 = lane & 15; f32x4 t[16];
#pragma unroll
      for (int i = 0; i < 16; ++i) t[i] = __builtin_nontemporal_load((const f32x4*)(src + (size_t)(k0 + 4 * i + r4) * N + n0 + 4 * c4));
#pragma unroll
      for (int i = 0; i < 16; ++i) { LAS float* d = scr + (4 * i + r4) * 65 + 4 * c4; d[0] = t[i][0]; d[1] = t[i][1]; d[2] = t[i][2]; d[3] = t[i][3]; } }
    LDS_WAIT(); asm volatile("" ::: "memory");
    const int c = lane >> 3, nn = lane & 7;
#pragma unroll
    for (int j = 0; j < 8; ++j) { const int n = nn + 8 * j; const LAS float* s = scr + (8 * c) * 65 + n;
        v4u o; o.x = pk2(s[0], s[65]); o.y = pk2(s[130], s[195]); o.z = pk2(s[260], s[325]); o.w = pk2(s[390], s[455]);
        *(GAS v4u*)(dst + (size_t)n * Kd + 8 * c) = o; }
    LDS_WAIT(); asm volatile("" ::: "memory");
}
__device__ __forceinline__ void cvt_item8(const float* __restrict__ src, int N, int k0, int n0, unsigned char* dst, int Kd, LAS float* scr, int lane) {
    { const int r8 = lane >> 3, c8 = lane & 7; f32x4 t[16];
#pragma unroll
      for (int i = 0; i < 16; ++i) t[i] = __builtin_nontemporal_load((const f32x4*)(src + (size_t)(k0 + 8 * i + r8) * N + n0 + 4 * c8));
#pragma unroll
      for (int i = 0; i < 16; ++i) { LAS float* d = scr + (8 * i + r8) * 33 + 4 * c8; d[0] = t[i][0]; d[1] = t[i][1]; d[2] = t[i][2]; d[3] = t[i][3]; } }
    LDS_WAIT(); asm volatile("" ::: "memory");
    const int c = lane >> 3, nn = lane & 7; constexpr float sc = pg8::WSCALE;
#pragma unroll
    for (int j = 0; j < 4; ++j) { const int n = nn + 8 * j; const LAS float* s = scr + (16 * c) * 33 + n;
        v4u o; o.x = pg8::pk4_fp8(s[0] * sc, s[33] * sc, s[66] * sc, s[99] * sc); o.y = pg8::pk4_fp8(s[132] * sc, s[165] * sc, s[198] * sc, s[231] * sc);
        o.z = pg8::pk4_fp8(s[264] * sc, s[297] * sc, s[330] * sc, s[363] * sc); o.w = pg8::pk4_fp8(s[396] * sc, s[429] * sc, s[462] * sc, s[495] * sc);
        *(GAS v4u*)(dst + (size_t)n * Kd + 16 * c) = o; }
    LDS_WAIT(); asm volatile("" ::: "memory");
}
__device__ __forceinline__ void p0_weights(const Args& a, LAS unsigned char* lds, int tid, int lane, int wave, int G, int bid) {
    unsigned char* ws = a.ws;
    LAS float* scr = (LAS float*)(lds + RING_OFF + wave * 16896);
    const int gw = bid * NWAVES + wave, NGW = G * NWAVES;
    constexpr int I_IN = 16 * 36, I_OUT = 16 * 16, I_EXP = 1536, PER_LAYER = I_IN + I_OUT + NE * I_EXP, NITEMS = DEPTH * PER_LAYER;
    for (int it = gw; it < NITEMS; it += NGW) {
        const int l = it / PER_LAYER; int r = it - l * PER_LAYER;
        if (r < I_IN) { const int kb = r / 36, nb = r - kb * 36;
            cvt_item(a.in[I_WIN] + (size_t)l * DM * DIN, DIN, 64 * kb, 64 * nb, (bf16*)(ws + WS_WIN) + ((size_t)l * NPROJ + 64 * nb) * DM + 64 * kb, DM, scr, lane); continue; }
        r -= I_IN;
        if (r < I_OUT) { const int kb = r >> 4, nb = r & 15;
            cvt_item(a.in[I_WOUT] + (size_t)l * DM * DM, DM, 64 * kb, 64 * nb, (bf16*)(ws + WS_WOUT) + ((size_t)l * DM + 64 * nb) * DM + 64 * kb, DM, scr, lane); continue; }
        r -= I_OUT;
        const int e = r / I_EXP; int r2 = r - e * I_EXP; const size_t le = (size_t)l * NE + e;
        LAS float* scr8 = (LAS float*)(lds + RING_OFF + wave * 16896);
        if (r2 < 1024) { const int up = r2 >> 9; r2 &= 511; const int kb = r2 >> 6, nb = r2 & 63, n0 = 32 * nb, drow = 256 * (n0 >> 7) + (n0 & 127) + 128 * up;
            cvt_item8(a.in[up ? I_WU : I_WG] + le * DM * DE, DE, 128 * kb, n0, ws + WS_WGU + (le * 4096 + drow) * DM + 128 * kb, DM, scr8, lane); continue; }
        r2 -= 1024; { const int kb = r2 >> 5, nb = r2 & 31;
            cvt_item8(a.in[I_WD] + le * DE * DM, DM, 128 * kb, 32 * nb, ws + WS_WDN + (le * DM + 32 * nb) * DE + 128 * kb, DE, scr8, lane); }
    }
    const int gt = bid * NTHR + tid, GT = G * NTHR;
    bf16* lw = (bf16*)(ws + WS_LRUW);
    for (int i = gt; i < DEPTH * 2 * 2 * 4 * 4096; i += GT) { const int d = i & 63, e = (i >> 6) & 63, n = (i >> 12) & 3, gate = (i >> 14) & 1, dir = (i >> 15) & 1, l = i >> 16;
        const float* src = a.in[gate ? I_WX : I_WA]; lw[i] = (bf16)f2bf(src[((((size_t)l * 2 + dir) * 4 + n) * 64 + d) * 64 + e]); }
    float* rc = (float*)(ws + WS_ROPE); float* rs = rc + SEQ * 32;
    for (int i = gt; i < SEQ * 32; i += GT) { const int s = i >> 5, j = i & 31, f = j & 15; const float pos = (float)((j < 16) ? (s >> 6) : (s & 63));
        const float inv = 1.0f / powf(10000.0f, (float)f * (1.0f / 16.0f)); const float ang = pos * inv; rc[i] = cosf(ang); rs[i] = sinf(ang); }
}

template <int MODE, bool XB16>
__device__ __forceinline__ void row_pass(const void* xin_, void* xout_, const float* gain, const float* WT  , int sk, bf16* H, float* O16, const int* SEL, const bf16* YE,
                                         LAS unsigned char* lds, int tid, int lane, int wave, int G, int bid) {
    constexpr int WLS = 1028;
    LAS float* wl = (LAS float*)(lds + RING_OFF);
    if (MODE != 3) { float wv[32];
#pragma unroll
        for (int q = 0; q < 32; ++q) { const int i = tid + q * NTHR; wv[q] = WT[(size_t)(i >> 4) * sk + (i & 15)]; }
#pragma unroll
        for (int q = 0; q < 32; ++q) { const int i = tid + q * NTHR; wl[(i & 15) * WLS + (i >> 4)] = wv[q]; } }
    WG_SYNC();
    const int gw = bid * NWAVES + wave, NGW = G * NWAVES;
    f32x4 gq4[4];
#pragma unroll
    for (int j = 0; j < 4; ++j) gq4[j] = (MODE != 3) ? *((const f32x4*)gain + 64 * j + lane) : (f32x4){0.f, 0.f, 0.f, 0.f};
    constexpr int R = 4;
    for (int m0 = R * gw; m0 < M; m0 += R * NGW) {
        asm volatile("" ::: "memory");
        f32x4 v[R][4];
#pragma unroll
        for (int r = 0; r < R; ++r)
#pragma unroll
            for (int j = 0; j < 4; ++j) {
                if (XB16) { const u32x2 q = *((const u32x2*)((const bf16*)xin_ + (size_t)(m0 + r) * DM) + 64 * j + lane); v[r][j] = (f32x4){bflo(q.x), bfhi(q.x), bflo(q.y), bfhi(q.y)}; }
                else v[r][j] = *((const f32x4*)((const float*)xin_ + (size_t)(m0 + r) * DM) + 64 * j + lane); }
        if (MODE >= 2) {
            const int b = m0 >> 11; int selv[R]; unsigned long long mk[R];
#pragma unroll
            for (int r = 0; r < R; ++r) { selv[r] = (lane < NE) ? SEL[(size_t)(m0 + r) * NE + lane] : -1; }
#pragma unroll
            for (int r = 0; r < R; ++r) mk[r] = __ballot(selv[r] >= 0);
            while (mk[0] | mk[1] | mk[2] | mk[3]) {
                u32x2 q[R][2][4]; float wt[R][2];
#pragma unroll
                for (int r = 0; r < R; ++r)
#pragma unroll
                    for (int i = 0; i < 2; ++i) { const bf16* yr = YE; wt[r][i] = 0.f;
                        if (mk[r]) { const int e = __builtin_ctzll(mk[r]); mk[r] &= mk[r] - 1ull; const int sl = __builtin_amdgcn_readlane(selv[r], e);
                            yr = YE + ((size_t)e * NSLOT + b * CAP + sl) * DM; wt[r][i] = 1.f; }
#pragma unroll
                        for (int j = 0; j < 4; ++j) q[r][i][j] = *((const u32x2*)yr + 64 * j + lane); }
#pragma unroll
                for (int r = 0; r < R; ++r)
#pragma unroll
                    for (int i = 0; i < 2; ++i)
#pragma unroll
                        for (int j = 0; j < 4; ++j) { const u32x2 w = q[r][i][j]; const float t = wt[r][i];
                            v[r][j][0] += t * bflo(w.x); v[r][j][1] += t * bfhi(w.x); v[r][j][2] += t * bflo(w.y); v[r][j][3] += t * bfhi(w.y); }
            }
#pragma unroll
            for (int r = 0; r < R; ++r)
#pragma unroll
                for (int j = 0; j < 4; ++j) {
                    if (MODE == 3) *((f32x4*)((float*)xout_ + (size_t)(m0 + r) * DM) + 64 * j + lane) = v[r][j];
                    else { u32x2 o; o.x = pk2(v[r][j][0], v[r][j][1]); o.y = pk2(v[r][j][2], v[r][j][3]); *((u32x2*)((bf16*)xout_ + (size_t)(m0 + r) * DM) + 64 * j + lane) = o;
                        v[r][j] = (f32x4){bflo(o.x), bfhi(o.x), bflo(o.y), bfhi(o.y)}; } }
        }
        if (MODE == 3) continue;
        float ss[R];
#pragma unroll
        for (int r = 0; r < R; ++r) { float a = 0.f;
#pragma unroll
            for (int j = 0; j < 4; ++j) a += (v[r][j][0] * v[r][j][0] + v[r][j][1] * v[r][j][1]) + (v[r][j][2] * v[r][j][2] + v[r][j][3] * v[r][j][3]);
            ss[r] = wave_sum(a); }
#pragma unroll
        for (int r = 0; r < R; ++r) { const float rstd = frsq(ss[r] * (1.0f / DM) + EPS);
#pragma unroll
            for (int j = 0; j < 4; ++j) { v[r][j] = v[r][j] * rstd * gq4[j];
                if (MODE == 1) { *((unsigned*)((unsigned char*)H + (size_t)(m0 + r) * DM) + 64 * j + lane) = pg8::pk4_fp8(v[r][j][0], v[r][j][1], v[r][j][2], v[r][j][3]); }
                else { u32x2 o; o.x = pk2(v[r][j][0], v[r][j][1]); o.y = pk2(v[r][j][2], v[r][j][3]); *((u32x2*)(H + (size_t)(m0 + r) * DM) + 64 * j + lane) = o; } } }
        float p[R][16];
#pragma unroll
        for (int jj = 0; jj < 16; ++jj) { float a[R];
#pragma unroll
            for (int r = 0; r < R; ++r) a[r] = 0.f;
#pragma unroll
            for (int j = 0; j < 4; ++j) { const f32x4 w = *((LAS f32x4*)(wl + jj * WLS) + 64 * j + lane);
#pragma unroll
                for (int r = 0; r < R; ++r) a[r] += (v[r][j][0] * w[0] + v[r][j][1] * w[1]) + (v[r][j][2] * w[2] + v[r][j][3] * w[3]); }
#pragma unroll
            for (int r = 0; r < R; ++r) p[r][jj] = wave_sum(a[r]); }
#pragma unroll
        for (int r = 0; r < R; ++r) { const int m = m0 + r;
            if (MODE == 1) {
                float mx = p[r][0];
#pragma unroll
                for (int jj = 1; jj < 16; ++jj) mx = fmaxf(mx, p[r][jj]);
                float sum = 0.f;
#pragma unroll
                for (int jj = 0; jj < 16; ++jj) { p[r][jj] = fexp(p[r][jj] - mx); sum += p[r][jj]; }
                float mine = 0.f;
#pragma unroll
                for (int jj = 0; jj < 16; ++jj) mine = (lane == jj) ? p[r][jj] : mine;
                if (lane < 16) O16[(((size_t)(m >> 11) * NE + lane) << 11) + (m & 2047)] = mine / sum;
            } else {
                float mine = 0.f;
#pragma unroll
                for (int jj = 0; jj < 16; ++jj) mine = (lane == jj) ? p[r][jj] : mine;
                if (lane < 16) O16[(size_t)m * 16 + lane] = mine;
            } }
    }
}

__device__ __forceinline__ void rope_pass(const Args& a, int l, int lane, int wave, int G, int bid, bf16* DST) {
    bf16* PROJ = (bf16*)(a.ws + WS_PROJ); const float* rc = (const float*)(a.ws + WS_ROPE); const float* rs = rc + SEQ * 32;
    const float* qg = a.in[I_QG] + l * 64; const float* kg = a.in[I_KG] + l * 64;
    const int gw = bid * NWAVES + wave, NGW = G * NWAVES, j = lane & 31;
    const float qg1 = qg[j], qg2 = qg[32 + j], kg1 = kg[j], kg2 = kg[32 + j];
    for (int mb = 4 * gw; mb < M; mb += 4 * NGW) {
        float x1[4][5], x2[4][5], cs[4], sn[4];
#pragma unroll
        for (int r = 0; r < 4; ++r) { const bf16* row = PROJ + (size_t)(mb + r) * NPROJ; const int s = (mb + r) & 2047; cs[r] = rc[s * 32 + j]; sn[r] = rs[s * 32 + j];
#pragma unroll
            for (int it = 0; it < 5; ++it) { const int hh = 2 * it + (lane >> 5); x1[r][it] = bf2f(row[hh * 64 + j]); x2[r][it] = bf2f(row[hh * 64 + 32 + j]); } }
#pragma unroll
        for (int r = 0; r < 4; ++r) { bf16* row = DST + (size_t)(mb + r) * NPROJ;
#pragma unroll
            for (int it = 0; it < 5; ++it) { const int hh = 2 * it + (lane >> 5);
                const float ss = half_sum(x1[r][it] * x1[r][it] + x2[r][it] * x2[r][it]);
                const float rstd = frsq(ss * (1.0f / 64.0f) + EPS);
                const float n1 = x1[r][it] * rstd * (it < 4 ? qg1 : kg1), n2 = x2[r][it] * rstd * (it < 4 ? qg2 : kg2);
                float o1 = n1 * cs[r] - n2 * sn[r], o2 = n2 * cs[r] + n1 * sn[r];
                if (it < 4) { o1 *= attn_body::C2; o2 *= attn_body::C2; }
                row[hh * 64 + j] = (bf16)f2bf(o1); row[hh * 64 + 32 + j] = (bf16)f2bf(o2); } }
    }
}

constexpr int XS = 260;
__device__ __forceinline__ void lru_a_unit(const Args& a, int l, int unit, LAS unsigned char* lds, int tid, int lane, int wave) {
    const int b = unit >> 6, c32 = unit & 63, t0 = c32 * 32; const size_t m0 = (size_t)b * SEQ + t0;
    LAS float* XC = (LAS float*)(lds + RING_OFF); LAS float* AA = XC + 32 * XS; LAS float* UU = AA + 32 * XS;
    const bf16* PROJ = (const bf16*)(a.ws + WS_PROJ);
    {
        const int ch2 = tid & 127, rg = tid >> 7, ch = 2 * ch2;
        float x0[11], x1[11];
#pragma unroll
        for (int i = 0; i < 11; ++i) { const int s = t0 + rg * 8 - 2 + i; unsigned v = 0u;
            if (s >= 0 && s < SEQ) v = *(const unsigned*)(PROJ + ((size_t)b * SEQ + s) * NPROJ + C_LX + ch);
            x0[i] = bflo(v); x1[i] = bfhi(v); }
        const float* cw = a.in[I_CW] + (size_t)l * 4 * 256; const float* cb = a.in[I_CB] + (size_t)l * 256;
        float w0[4], w1[4];
#pragma unroll
        for (int j = 0; j < 4; ++j) { w0[j] = cw[j * 256 + ch]; w1[j] = cw[j * 256 + ch + 1]; }
        const float b0 = cb[ch], b1 = cb[ch + 1];
#pragma unroll
        for (int r = 0; r < 8; ++r) { float y0 = b0, y1 = b1;
#pragma unroll
            for (int j = 0; j < 4; ++j) { y0 += x0[r + j] * w0[j]; y1 += x1[r + j] * w1[j]; }
            XC[(rg * 8 + r) * XS + ch] = y0; XC[(rg * 8 + r) * XS + ch + 1] = y1; }
    }
    WG_SYNC();
    const int n = wave >> 1, hh = wave & 1, li = lane & 15, g = lane >> 4;
    bf16* LH = (bf16*)(a.ws + WS_LH); bf16* CPb = (bf16*)(a.ws + WS_CP); float* CARRY = (float*)(a.ws + WS_CARRY);
    for (int dir = 0; dir < 2; ++dir) {
        {
            f32x4 accA[2][2], accX[2][2];
#pragma unroll
            for (int i = 0; i < 2; ++i)
#pragma unroll
                for (int j = 0; j < 2; ++j) { accA[i][j] = (f32x4){0.f, 0.f, 0.f, 0.f}; accX[i][j] = (f32x4){0.f, 0.f, 0.f, 0.f}; }
            const bf16* WA = (const bf16*)(a.ws + WS_LRUW) + ((((size_t)l * 2 + dir) * 2 + 0) * 4 + n) * 4096;
            const bf16* WX = (const bf16*)(a.ws + WS_LRUW) + ((((size_t)l * 2 + dir) * 2 + 1) * 4 + n) * 4096;
#pragma unroll
            for (int ks = 0; ks < 2; ++ks) {
                bf16x8 af[2];
#pragma unroll
                for (int mt = 0; mt < 2; ++mt) { const LAS float* p = XC + (16 * mt + li) * XS + 64 * n + 32 * ks + 8 * g;
                    const f32x4 q0 = *(const LAS f32x4*)p, q1 = *(const LAS f32x4*)(p + 4);
                    v4u pk; pk.x = pk2(q0[0], q0[1]); pk.y = pk2(q0[2], q0[3]); pk.z = pk2(q1[0], q1[1]); pk.w = pk2(q1[2], q1[3]); af[mt] = __builtin_bit_cast(bf16x8, pk); }
#pragma unroll
                for (int nt = 0; nt < 2; ++nt) { const int ep = 32 * hh + 16 * nt + li;
                    const bf16x8 ba = *(const bf16x8*)(WA + ep * 64 + 32 * ks + 8 * g), bx = *(const bf16x8*)(WX + ep * 64 + 32 * ks + 8 * g);
#pragma unroll
                    for (int mt = 0; mt < 2; ++mt) { accA[mt][nt] = MFMA16(af[mt], ba, accA[mt][nt]); accX[mt][nt] = MFMA16(af[mt], bx, accX[mt][nt]); } }
            }
#pragma unroll
            for (int nt = 0; nt < 2; ++nt) { const int ch = 64 * n + 32 * hh + 16 * nt + li; const size_t pi = ((size_t)l * 2 + dir) * 256 + ch;
                const float bav = a.in[I_BA][pi], bxv = a.in[I_BX][pi], lam = a.in[I_LAM][pi];
                const float sp = fmaxf(-lam, 0.f) + log1pf(expf(-fabsf(lam)));
#pragma unroll
                for (int mt = 0; mt < 2; ++mt)
#pragma unroll
                    for (int r = 0; r < 4; ++r) { const int t = 16 * mt + 4 * g + r;
                        const float rg_ = sigmoid_f(accA[mt][nt][r] + bav), ig_ = sigmoid_f(accX[mt][nt][r] + bxv);
                        const float la = -8.0f * rg_ * sp; const float av = fexp(la);
                        const float uv = __builtin_amdgcn_sqrtf(one_minus_exp(2.0f * la)) * (ig_ * XC[t * XS + ch]);
                        AA[t * XS + ch] = av; UU[t * XS + ch] = uv; } }
        }
        WG_SYNC();
        if (tid < 256) { const int ch = tid; float h = 0.f, cp = 1.f;
            bf16* lh = LH + ((size_t)dir * M + m0) * 256 + ch; bf16* cpo = CPb + ((size_t)dir * M + m0) * 256 + ch;
            for (int q = 0; q < 32; ++q) { const int t = dir ? 31 - q : q; const float av = AA[t * XS + ch], uv = UU[t * XS + ch];
                h = av * h + uv; cp *= av; lh[(size_t)t * 256] = (bf16)f2bf(h); cpo[(size_t)t * 256] = (bf16)f2bf(cp); }
            float* cr = CARRY + ((((size_t)dir * NB + b) * 64 + c32) * 2) * 256 + ch; cr[0] = cp; cr[256] = h; }
        WG_SYNC();
    }
}

__device__ __forceinline__ void p4_rows_unit(const Args& a, int l, int unit, LAS unsigned char* lds, int tid, int lane, int wave) {
    const int b = unit >> 5, c0 = 2 * (unit & 31); const size_t m0 = (size_t)b * SEQ + c0 * 32;
    LAS float* CIN = (LAS float*)(lds + RING_OFF);
    const float* CARRY = (const float*)(a.ws + WS_CARRY);
    { const int dir = tid >> 8, ch = tid & 255; const float* cr = CARRY + (((size_t)dir * NB + b) * 64) * 512 + ch; float cin = 0.f;
      const int cs = dir ? c0 + 1 : c0;
      const int n = dir ? 63 - cs : cs;
      for (int base = 0; base < n; base += 16) { float P[16], Hh[16];
#pragma unroll
          for (int i = 0; i < 16; ++i) { const int q = base + i; const bool v = q < n; const int k = v ? (dir ? 63 - q : q) : cs;
              const float p = cr[(size_t)k * 512], h = cr[(size_t)k * 512 + 256]; P[i] = v ? p : 1.f; Hh[i] = v ? h : 0.f; }
#pragma unroll
          for (int i = 0; i < 16; ++i) cin = P[i] * cin + Hh[i]; }
      const float cin2 = cr[(size_t)cs * 512] * cin + cr[(size_t)cs * 512 + 256];
      CIN[((cs - c0) * 2 + dir) * 256 + ch] = cin; CIN[((1 - (cs - c0)) * 2 + dir) * 256 + ch] = cin2; }
    WG_SYNC();
    const bf16* LH = (const bf16*)(a.ws + WS_LH); const bf16* CPb = (const bf16*)(a.ws + WS_CP); const bf16* PROJ = (const bf16*)(a.ws + WS_PROJ); bf16* Y = (bf16*)(a.ws + WS_Y);
    const f32x4 og = *(const f32x4*)(a.in[I_LOG] + (size_t)l * 256 + 4 * lane);
    const float* gq = a.in[I_AOG] + (size_t)l * 512 + 8 * lane; const f32x4 g0 = *(const f32x4*)gq, g1 = *(const f32x4*)(gq + 4);
#pragma unroll
    for (int it = 0; it < 2; ++it) { const int tl = wave * 8 + it * 4;
        const LAS float* ci = CIN + (tl >> 5) * 512; const f32x4 cf = *(const LAS f32x4*)(ci + 4 * lane), cb = *(const LAS f32x4*)(ci + 256 + 4 * lane);
        v4u ya[4]; u32x2 lf[4], pf[4], lb[4], pb[4], gt[4];
#pragma unroll
        for (int r = 0; r < 4; ++r) { const size_t m = m0 + tl + r;
            ya[r] = *(const v4u*)(Y + m * DM + 8 * lane);
            lf[r] = *(const u32x2*)(LH + m * 256 + 4 * lane); pf[r] = *(const u32x2*)(CPb + m * 256 + 4 * lane);
            lb[r] = *(const u32x2*)(LH + ((size_t)M + m) * 256 + 4 * lane); pb[r] = *(const u32x2*)(CPb + ((size_t)M + m) * 256 + 4 * lane);
            gt[r] = *(const u32x2*)(PROJ + m * NPROJ + C_LG + 4 * lane); }
#pragma unroll
        for (int r = 0; r < 4; ++r) { const size_t m = m0 + tl + r;
            {
                const float x[8] = {bflo(ya[r].x), bfhi(ya[r].x), bflo(ya[r].y), bfhi(ya[r].y), bflo(ya[r].z), bfhi(ya[r].z), bflo(ya[r].w), bfhi(ya[r].w)}; float ss = 0.f;
#pragma unroll
                for (int i = 0; i < 8; ++i) ss += x[i] * x[i];
                const float rstd = frsq(wave_sum(ss) * (1.0f / 512.0f) + EPS);
                v4u o; o.x = pk2(x[0] * rstd * g0[0], x[1] * rstd * g0[1]); o.y = pk2(x[2] * rstd * g0[2], x[3] * rstd * g0[3]);
                o.z = pk2(x[4] * rstd * g1[0], x[5] * rstd * g1[1]); o.w = pk2(x[6] * rstd * g1[2], x[7] * rstd * g1[3]); *(v4u*)(Y + m * DM + 8 * lane) = o; }
            {
                f32x4 h;
                h[0] = (bflo(lf[r].x) + bflo(pf[r].x) * cf[0]) + (bflo(lb[r].x) + bflo(pb[r].x) * cb[0]);
                h[1] = (bfhi(lf[r].x) + bfhi(pf[r].x) * cf[1]) + (bfhi(lb[r].x) + bfhi(pb[r].x) * cb[1]);
                h[2] = (bflo(lf[r].y) + bflo(pf[r].y) * cf[2]) + (bflo(lb[r].y) + bflo(pb[r].y) * cb[2]);
                h[3] = (bfhi(lf[r].y) + bfhi(pf[r].y) * cf[3]) + (bfhi(lb[r].y) + bfhi(pb[r].y) * cb[3]);
                h[0] *= gelu_tanh_f(bflo(gt[r].x)); h[1] *= gelu_tanh_f(bfhi(gt[r].x)); h[2] *= gelu_tanh_f(bflo(gt[r].y)); h[3] *= gelu_tanh_f(bfhi(gt[r].y));
                const float ss = wave_sum((h[0] * h[0] + h[1] * h[1]) + (h[2] * h[2] + h[3] * h[3]));
                const float rstd = frsq(ss * (1.0f / 256.0f) + EPS);
                u32x2 o; o.x = pk2(h[0] * rstd * og[0], h[1] * rstd * og[1]); o.y = pk2(h[2] * rstd * og[2], h[3] * rstd * og[3]);
                *(u32x2*)(Y + m * DM + 512 + 4 * lane) = o; } } }
    WG_SYNC();
}

__device__ __forceinline__ void mls_gates(const Args& a, int l, size_t m0, int hd, LAS float* GL, int tid) {
    if (tid < 128) { const float* r = (const float*)(a.ws + WS_MG) + (m0 + tid) * 16; const float* fb = a.in[I_FB] + (size_t)l * 8;
        GL[tid] = logsig_f(r[4 + hd] + fb[hd]); GL[128 + tid] = logsig_f(r[12 + hd] + fb[4 + hd]); GL[256 + tid] = r[hd]; GL[384 + tid] = r[8 + hd]; }
    WG_SYNC();
    if (tid < 64) wave_scan128<false, false>(GL, GL + 512, tid);
    else if (tid < 128) wave_scan128<false, true>(GL + 128, GL + 640, tid - 64);
    WG_SYNC();
}
constexpr int TS = 136;
constexpr int QS_ = 72;

__device__ __forceinline__ void mls_a_unit(const Args& a, int l, int unit, LAS unsigned char* lds, int tid, int lane, int wave) {
    const int c = unit & 15, hd = (unit >> 4) & 3, b = unit >> 6; const size_t m0 = (size_t)b * SEQ + c * 128;
    LAS float* GL = (LAS float*)(lds + RING_OFF);
    LAS float* WW = GL + 768;
    LAS bf16* VT = (LAS bf16*)(lds + RING_OFF + 4096); LAS bf16* KF = VT + 64 * TS; LAS bf16* KB = KF + 64 * TS;
    mls_gates(a, l, m0, hd, GL, tid);
    float* MLOC = (float*)(a.ws + WS_MLOC); float* NLOC = (float*)(a.ws + WS_NLOC); float* CLOC = (float*)(a.ws + WS_CLOC);
    const size_t sbase = ((size_t)b * 4 + hd) * 2;
    if (wave < 2) { const int dir = wave; const float gtot = dir ? GL[640] : GL[512 + 127]; const LAS float* Bc = GL + 512 + 128 * dir; const LAS float* IG = GL + 256 + 128 * dir;
        const float lw0 = gtot - Bc[lane] + IG[lane], lw1 = gtot - Bc[lane + 64] + IG[lane + 64];
        const float mx = wave_max(fmaxf(lw0, lw1));
        WW[dir * 128 + lane] = fexp(lw0 - mx); WW[dir * 128 + lane + 64] = fexp(lw1 - mx);
        if (lane == 0) { float* o = MLOC + ((sbase + dir) * 16 + c) * 2; o[0] = mx; o[1] = gtot; } }
    WG_SYNC();
    { const int j = tid & 127, part = tid >> 7; const bf16* PROJ = (const bf16*)(a.ws + WS_PROJ);
      const bf16* kp = PROJ + (m0 + j) * NPROJ + C_MK + hd * 64 + 16 * part; const bf16* vp = PROJ + (m0 + j) * NPROJ + C_MV + hd * 64 + 16 * part;
      const v4u k0 = *(const v4u*)kp, k1 = *(const v4u*)(kp + 8), v0 = *(const v4u*)vp, v1 = *(const v4u*)(vp + 8);
      const float wf = WW[j] * 0.125f, wb = WW[128 + j] * 0.125f;
      const unsigned kk[8] = {k0.x, k0.y, k0.z, k0.w, k1.x, k1.y, k1.z, k1.w}; const unsigned vv[8] = {v0.x, v0.y, v0.z, v0.w, v1.x, v1.y, v1.z, v1.w};
#pragma unroll
      for (int q = 0; q < 8; ++q) { const int e0 = 16 * part + 2 * q; const float ka = bflo(kk[q]), kb = bfhi(kk[q]);
          KF[e0 * TS + j] = (bf16)f2bf(ka * wf); KF[(e0 + 1) * TS + j] = (bf16)f2bf(kb * wf);
          KB[e0 * TS + j] = (bf16)f2bf(ka * wb); KB[(e0 + 1) * TS + j] = (bf16)f2bf(kb * wb);
          VT[e0 * TS + j] = (bf16)(vv[q] & 0xffffu); VT[(e0 + 1) * TS + j] = (bf16)(vv[q] >> 16); } }
    WG_SYNC();
    if (tid < 128) { const int dir = tid >> 6, e = tid & 63; const LAS bf16* kr = (dir ? KB : KF) + e * TS; float s = 0.f;
#pragma unroll
        for (int q = 0; q < 16; ++q) { const v4u w = *(const LAS v4u*)(kr + 8 * q); s += ((bflo(w.x) + bfhi(w.x)) + (bflo(w.y) + bfhi(w.y))) + ((bflo(w.z) + bfhi(w.z)) + (bflo(w.w) + bfhi(w.w))); }
        NLOC[((sbase + dir) * 16 + c) * 64 + e] = s; }
    { const int dir = wave >> 2, mt = wave & 3, li = lane & 15, g = lane >> 4; const LAS bf16* KD = dir ? KB : KF;
      f32x4 acc[4];
#pragma unroll
      for (int nt = 0; nt < 4; ++nt) acc[nt] = (f32x4){0.f, 0.f, 0.f, 0.f};
#pragma unroll
      for (int ks = 0; ks < 4; ++ks) { const bf16x8 af = *(const LAS bf16x8*)(VT + (16 * mt + li) * TS + 32 * ks + 8 * g);
#pragma unroll
          for (int nt = 0; nt < 4; ++nt) { const bf16x8 bfv = *(const LAS bf16x8*)(KD + (16 * nt + li) * TS + 32 * ks + 8 * g); acc[nt] = MFMA16(af, bfv, acc[nt]); } }
      float* co = CLOC + ((sbase + dir) * 16 + c) * 4096;
#pragma unroll
      for (int nt = 0; nt < 4; ++nt)
#pragma unroll
          for (int r = 0; r < 4; ++r) co[(16 * mt + 4 * g + r) * 64 + 16 * nt + li] = acc[nt][r]; }
    WG_SYNC();
}

__device__ __forceinline__ void mls_scan_unit(const Args& a, int unit, LAS unsigned char* lds, int tid, int lane, int wave) {
    const int qtr = unit & 3, bhd = unit >> 2, dir = bhd & 1;
    LAS float* SM = (LAS float*)(lds + RING_OFF);
    const float* CLOC = (const float*)(a.ws + WS_CLOC) + (size_t)bhd * 16 * 4096 + 1024 * qtr + 2 * tid;
    const float* NLOC = (const float*)(a.ws + WS_NLOC) + (size_t)bhd * 16 * 64;
    typedef float f32x2 __attribute__((ext_vector_type(2)));
    f32x2 cl[16]; float nl[16];
#pragma unroll
    for (int k = 0; k < 16; ++k) cl[k] = *(const f32x2*)(CLOC + (size_t)k * 4096);
    const bool do_n = (qtr == 0) && (tid < 64);
#pragma unroll
    for (int k = 0; k < 16; ++k) nl[k] = do_n ? NLOC[k * 64 + tid] : 0.f;
    if (tid < 32) SM[tid] = ((const float*)(a.ws + WS_MLOC))[(size_t)bhd * 32 + tid];
    WG_SYNC();
    bf16* CP = (bf16*)(a.ws + WS_CPREV) + (size_t)bhd * 16 * 4096 + 1024 * qtr + 2 * tid;
    float* NP = (float*)(a.ws + WS_NPREV) + (size_t)bhd * 16 * 64; float* MP = (float*)(a.ws + WS_MPREV) + (size_t)bhd * 16;
    float m = 0.f; f32x2 C = (f32x2){0.f, 0.f}; float n = 0.f;
#pragma unroll
    for (int q = 0; q < 16; ++q) { const int k = dir ? 15 - q : q;
        *(unsigned*)(CP + (size_t)k * 4096) = pk2(C[0], C[1]);
        if (do_n) NP[k * 64 + tid] = n;
        if (qtr == 0 && tid == 64) MP[k] = m;
        const float mlk = SM[2 * k], gk = SM[2 * k + 1]; const float mn = fmaxf(gk + m, mlk); const float fa = fexp(gk + m - mn), fb = fexp(mlk - mn);
        C = fa * C + fb * (dir ? cl[15 - q] : cl[q]); n = fa * n + fb * (dir ? nl[15 - q] : nl[q]); m = mn; }
    WG_SYNC();
}

template <int DIR>
__device__ __forceinline__ void mls_dir(f32x4 (&hacc)[4], const LAS bf16* QS, const LAS bf16* KS, const LAS bf16* VT, const LAS bf16* CP, const LAS float* AJ, const LAS float* MM,
                                        const LAS float* INTER, const LAS float* FLOOR, const LAS float* NP, LAS float* rowbuf, int w, int lane) {
    const int li = lane & 15, g = lane >> 4, i = 16 * w + li;
    bf16x8 qf[2];
#pragma unroll
    for (int ks = 0; ks < 2; ++ks) qf[ks] = *(const LAS bf16x8*)(QS + i * QS_ + 32 * ks + 8 * g);
    const float mmi = MM[i];
    float den = 0.f;
    f32x4 out[4];
#pragma unroll
    for (int dt = 0; dt < 4; ++dt) out[dt] = (f32x4){0.f, 0.f, 0.f, 0.f};
#pragma unroll
    for (int kp = 0; kp < 4; ++kp) {
        const bool need = (DIR == 0) ? (2 * kp <= w) : (2 * kp + 1 >= w);
        if (need) {
            f32x4 s0 = (f32x4){0.f, 0.f, 0.f, 0.f}, s1 = (f32x4){0.f, 0.f, 0.f, 0.f};
#pragma unroll
            for (int ks = 0; ks < 2; ++ks) { const bf16x8 k0 = *(const LAS bf16x8*)(KS + (32 * kp + li) * QS_ + 32 * ks + 8 * g), k1 = *(const LAS bf16x8*)(KS + (32 * kp + 16 + li) * QS_ + 32 * ks + 8 * g);
                s0 = MFMA16(k0, qf[ks], s0); s1 = MFMA16(k1, qf[ks], s1); }
            float p[8];
#pragma unroll
            for (int r = 0; r < 4; ++r) { const int j0 = 32 * kp + 4 * g + r, j1 = j0 + 16;
                const bool v0 = (DIR == 0) ? (j0 <= i) : (j0 >= i), v1 = (DIR == 0) ? (j1 <= i) : (j1 >= i);
                const float a0 = v0 ? (AJ[j0] - mmi) : -INFINITY, a1 = v1 ? (AJ[j1] - mmi) : -INFINITY;
                p[r] = s0[r] * 0.125f * fexp(a0); p[4 + r] = s1[r] * 0.125f * fexp(a1); den += p[r] + p[4 + r]; }
            v4u pk; pk.x = pk2(p[0], p[1]); pk.y = pk2(p[2], p[3]); pk.z = pk2(p[4], p[5]); pk.w = pk2(p[6], p[7]);
            const bf16x8 pf = __builtin_bit_cast(bf16x8, pk);
#pragma unroll
            for (int dt = 0; dt < 4; ++dt) { const LAS bf16* vr = VT + (16 * dt + li) * TS + 32 * kp + 4 * g;
                const u32x2 lo = *(const LAS u32x2*)vr, hi = *(const LAS u32x2*)(vr + 16);
                v4u vk; vk.x = lo.x; vk.y = lo.y; vk.z = hi.x; vk.w = hi.y;
                out[dt] = MFMA16(pf, __builtin_bit_cast(bf16x8, vk), out[dt]); }
        }
    }
    f32x4 qc[4];
#pragma unroll
    for (int dt = 0; dt < 4; ++dt) { qc[dt] = (f32x4){0.f, 0.f, 0.f, 0.f};
#pragma unroll
        for (int ks = 0; ks < 2; ++ks) { const bf16x8 cf = *(const LAS bf16x8*)(CP + (16 * dt + li) * QS_ + 32 * ks + 8 * g); qc[dt] = MFMA16(qf[ks], cf, qc[dt]); } }
    float nq = 0.f;
#pragma unroll
    for (int q = 0; q < 16; ++q) nq += NP[16 * g + q] * bf2f(QS[i * QS_ + 16 * g + q]);
    den = xor32_sum(xor16_sum(den)); nq = xor32_sum(xor16_sum(nq));
    const float inter = INTER[i]; const float dn = fmaxf(fabsf(den + inter * nq), FLOOR[i]);
    asm volatile("s_waitcnt lgkmcnt(0)" ::: "memory");
    if (g == 0) { rowbuf[li] = inter; rowbuf[16 + li] = frcp(dn); }
    asm volatile("s_waitcnt lgkmcnt(0)" ::: "memory");
#pragma unroll
    for (int r = 0; r < 4; ++r) { const float it = rowbuf[4 * g + r], inv = rowbuf[16 + 4 * g + r];
#pragma unroll
        for (int dt = 0; dt < 4; ++dt) hacc[dt][r] += (out[dt][r] + it * qc[dt][r]) * inv; }
    asm volatile("s_waitcnt lgkmcnt(0)" ::: "memory");
}
__device__ __forceinline__ void mls_b_unit(const Args& a, int l, int unit, LAS unsigned char* lds, int tid, int lane, int wave) {
    const int c = unit & 15, hd = (unit >> 4) & 3, b = unit >> 6; const size_t m0 = (size_t)b * SEQ + c * 128;
    LAS float* GL = (LAS float*)(lds + RING_OFF);
    LAS float* AJ = GL + 768;
    LAS float* MMx = AJ + 256;
    LAS float* INT_ = MMx + 256;
    LAS float* FLR = INT_ + 256;
    LAS float* NP = FLR + 256;
    LAS float* COEF = NP + 128;
    LAS float* ROWB = COEF + 32;
    LAS bf16* QS = (LAS bf16*)(lds + RING_OFF + 16384); LAS bf16* KS = QS + 128 * QS_; LAS bf16* VT = KS + 128 * QS_; LAS bf16* CF = VT + 64 * TS; LAS bf16* CB = CF + 64 * QS_;
    mls_gates(a, l, m0, hd, GL, tid);
    const size_t sbase = ((size_t)b * 4 + hd) * 2;
    if (wave < 2) {
        const int dir = wave; const float m = ((const float*)(a.ws + WS_MPREV))[(sbase + dir) * 16 + c];
        const LAS float* IG = GL + 256 + 128 * dir; const LAS float* Bc = GL + 512 + 128 * dir;
        LAS float* aj = AJ + 128 * dir; LAS float* mmx = MMx + 128 * dir;
        aj[lane] = IG[lane] - Bc[lane]; aj[lane + 64] = IG[lane + 64] - Bc[lane + 64];
        WAVE_LDS_FENCE();
        if (dir == 0) wave_scan128<true, false>(aj, mmx, lane); else wave_scan128<true, true>(aj, mmx, lane);
        WAVE_LDS_FENCE();
#pragma unroll
        for (int q = 0; q < 2; ++q) { const int j = lane + 64 * q; const float mm = fmaxf(mmx[j], m);
            mmx[j] = mm; INT_[128 * dir + j] = fexp(m - mm); FLR[128 * dir + j] = fexp(-(Bc[j] + mm)); }
    }
    {
        const int j = tid >> 2, q4 = tid & 3; const bf16* PROJ = (const bf16*)(a.ws + WS_PROJ); const bf16* rp = PROJ + (m0 + j) * NPROJ + hd * 64 + 16 * q4;
        const v4u q0 = *(const v4u*)(rp + C_MQ), q1 = *(const v4u*)(rp + C_MQ + 8), k0 = *(const v4u*)(rp + C_MK), k1 = *(const v4u*)(rp + C_MK + 8), v0 = *(const v4u*)(rp + C_MV), v1 = *(const v4u*)(rp + C_MV + 8);
        *(LAS v4u*)(QS + j * QS_ + 16 * q4) = q0; *(LAS v4u*)(QS + j * QS_ + 16 * q4 + 8) = q1;
        *(LAS v4u*)(KS + j * QS_ + 16 * q4) = k0; *(LAS v4u*)(KS + j * QS_ + 16 * q4 + 8) = k1;
        const unsigned vv[8] = {v0.x, v0.y, v0.z, v0.w, v1.x, v1.y, v1.z, v1.w};
#pragma unroll
        for (int q = 0; q < 8; ++q) { const int d0 = 16 * q4 + 2 * q; VT[d0 * TS + j] = (bf16)(vv[q] & 0xffffu); VT[(d0 + 1) * TS + j] = (bf16)(vv[q] >> 16); }
    }
    WG_SYNC();
    {
        const int idx = tid * 8; const bf16* CPV = (const bf16*)(a.ws + WS_CPREV);
        const v4u cf = *(const v4u*)(CPV + ((sbase + 0) * 16 + c) * 4096 + idx), cb = *(const v4u*)(CPV + ((sbase + 1) * 16 + c) * 4096 + idx);
        *(LAS v4u*)(CF + (idx >> 6) * QS_ + (idx & 63)) = cf; *(LAS v4u*)(CB + (idx >> 6) * QS_ + (idx & 63)) = cb;
        if (tid < 128) { const int dir = tid >> 6, e = tid & 63; NP[tid] = ((const float*)(a.ws + WS_NPREV))[((sbase + dir) * 16 + c) * 64 + e]; }
    }
    WG_SYNC();
    f32x4 hacc[4];
#pragma unroll
    for (int dt = 0; dt < 4; ++dt) hacc[dt] = (f32x4){0.f, 0.f, 0.f, 0.f};
    mls_dir<0>(hacc, QS, KS, VT, CF, AJ, MMx, INT_, FLR, NP, ROWB + wave * 32, wave, lane);
    mls_dir<1>(hacc, QS, KS, VT, CB, AJ + 128, MMx + 128, INT_ + 128, FLR + 128, NP + 64, ROWB + wave * 32, wave, lane);
    {
        const int li = lane & 15, g = lane >> 4; const bf16* PROJ = (const bf16*)(a.ws + WS_PROJ); bf16* Y = (bf16*)(a.ws + WS_Y);
        const float* hg = a.in[I_MNG] + ((size_t)l * 4 + hd) * 64;
#pragma unroll
        for (int r = 0; r < 4; ++r) { float ss = (hacc[0][r] * hacc[0][r] + hacc[1][r] * hacc[1][r]) + (hacc[2][r] * hacc[2][r] + hacc[3][r] * hacc[3][r]);
            ss = row16_sum(ss);
            const float rstd = frsq(ss * (1.0f / 64.0f) + EPS); const size_t m = m0 + 16 * wave + 4 * g + r;
#pragma unroll
            for (int dt = 0; dt < 4; ++dt) { const int d = 16 * dt + li; const float o = bf2f(PROJ[m * NPROJ + C_MO + hd * 64 + d]);
                Y[m * DM + 768 + hd * 64 + d] = (bf16)f2bf(hacc[dt][r] * rstd * hg[d] * sigmoid_f(o)); } }
    }
    WG_SYNC();
}

__device__ __forceinline__ void attnorm_pass(const Args& a, int l, int lane, int wave, int G, int bid, bf16* DST) {
    bf16* Y = (bf16*)(a.ws + WS_Y); const float* gq = a.in[I_AOG] + (size_t)l * 512 + 8 * lane;
    const f32x4 g0 = *(const f32x4*)gq, g1 = *(const f32x4*)(gq + 4);
    const int gw = bid * NWAVES + wave, NGW = G * NWAVES;
    for (int mb = 4 * gw; mb < M; mb += 4 * NGW) { v4u q[4];
#pragma unroll
        for (int r = 0; r < 4; ++r) q[r] = *(const v4u*)(Y + (size_t)(mb + r) * DM + 8 * lane);
        float ss[4];
#pragma unroll
        for (int r = 0; r < 4; ++r) { const float x[8] = {bflo(q[r].x), bfhi(q[r].x), bflo(q[r].y), bfhi(q[r].y), bflo(q[r].z), bfhi(q[r].z), bflo(q[r].w), bfhi(q[r].w)}; float a = 0.f;
#pragma unroll
            for (int i = 0; i < 8; ++i) a += x[i] * x[i];
            ss[r] = a; }
#pragma unroll
        for (int r = 0; r < 4; ++r) ss[r] = wave_sum(ss[r]);
#pragma unroll
        for (int r = 0; r < 4; ++r) { const float rstd = frsq(ss[r] * (1.0f / 512.0f) + EPS);
            const float x[8] = {bflo(q[r].x), bfhi(q[r].x), bflo(q[r].y), bfhi(q[r].y), bflo(q[r].z), bfhi(q[r].z), bflo(q[r].w), bfhi(q[r].w)};
            v4u o; o.x = pk2(x[0] * rstd * g0[0], x[1] * rstd * g0[1]); o.y = pk2(x[2] * rstd * g0[2], x[3] * rstd * g0[3]);
            o.z = pk2(x[4] * rstd * g1[0], x[5] * rstd * g1[1]); o.w = pk2(x[6] * rstd * g1[2], x[7] * rstd * g1[3]); *(v4u*)(DST + (size_t)(mb + r) * DM + 8 * lane) = o; } }
}

__device__ __forceinline__ unsigned mbcnt64(unsigned long long m) { return __builtin_amdgcn_mbcnt_hi((unsigned)(m >> 32), __builtin_amdgcn_mbcnt_lo((unsigned)m, 0u)); }
__device__ __forceinline__ void topk_item(const Args& a, int item, LAS unsigned char* lds, int tid, int lane, int wave) {
    const int unit = item & 127, half = item >> 7, b = unit >> 4, e = unit & 15;
    LAS unsigned* CNT = (LAS unsigned*)(lds + RING_OFF);
    LAS unsigned* SEG = CNT + 16;
    LAS int* TOK = (LAS int*)(SEG + 64);
    LAS float* GV = (LAS float*)(TOK + 256);
    const float* aff = (const float*)(a.ws + WS_AFF) + ((size_t)b * NE + e) * SEQ;
    float av[4]; unsigned key[4];
#pragma unroll
    for (int q = 0; q < 4; ++q) av[q] = aff[tid + q * NTHR];
#pragma unroll
    for (int q = 0; q < 4; ++q) key[q] = __float_as_uint(av[q]);
    unsigned lo = 0u, hi = 0x7F800000u; int par = 0;
    while (hi - lo > 1u) { const unsigned mid = lo + ((hi - lo) >> 1);
        unsigned c = 0u;
#pragma unroll
        for (int q = 0; q < 4; ++q) c += (unsigned)__popcll(__ballot(key[q] >= mid));
        if (lane == 0) CNT[par * 8 + wave] = c;
        WG_SYNC();
        const v4u c0 = *(const LAS v4u*)(CNT + par * 8), c1 = *(const LAS v4u*)(CNT + par * 8 + 4);
        const unsigned tot = (c0.x + c0.y) + (c0.z + c0.w) + (c1.x + c1.y) + (c1.z + c1.w);
        if (tot >= (unsigned)CAP) lo = mid; else hi = mid;
        par ^= 1; }
    const unsigned T = lo;
    unsigned long long mgt[4], meq[4];
#pragma unroll
    for (int q = 0; q < 4; ++q) { mgt[q] = __ballot(key[q] > T); meq[q] = __ballot(key[q] == T);
        if (lane == 0) { SEG[q * 8 + wave] = (unsigned)__popcll(mgt[q]); SEG[32 + q * 8 + wave] = (unsigned)__popcll(meq[q]); } }
    WG_SYNC();
    unsigned ngt = 0u;
#pragma unroll
    for (int g = 0; g < 32; ++g) ngt += SEG[g];
    const unsigned need = (unsigned)CAP - ngt;
    unsigned eqb = 0u, selb = 0u, my_eqb[4], my_selb[4];
#pragma unroll
    for (int g = 0; g < 32; ++g) { if ((g & 7) == wave) { my_eqb[g >> 3] = eqb; my_selb[g >> 3] = selb; }
        const unsigned cg = SEG[g], ce = SEG[32 + g]; const unsigned room = need > eqb ? need - eqb : 0u; selb += cg + (room < ce ? room : ce); eqb += ce; }
    int* SEL = (int*)(a.ws + WS_SEL);
#pragma unroll
    for (int q = 0; q < 4; ++q) { const bool gt = key[q] > T, eq = key[q] == T;
        const bool sel = gt || (eq && (my_eqb[q] + mbcnt64(meq[q])) < need);
        const unsigned long long ms = __ballot(sel); const int slot = (int)(my_selb[q] + mbcnt64(ms)); const int sidx = tid + q * NTHR;
        if (sel) { TOK[slot] = sidx; GV[slot] = av[q]; }
        if ((q >> 1) == half) SEL[((size_t)b * SEQ + sidx) * NE + e] = sel ? slot : -1; }
    WG_SYNC();
    int* IDX = (int*)(a.ws + WS_IDX); float* GATE = (float*)(a.ws + WS_GATE);
    if (tid < 128) { const int t = half * 128 + tid; IDX[e * NSLOT + b * CAP + t] = b * SEQ + TOK[t]; GATE[e * NSLOT + b * CAP + t] = GV[t]; }
    const unsigned char* H8 = a.ws + WS_H; unsigned char* XG8 = a.ws + WS_XG;
    { v4u r0[16];
#pragma unroll
      for (int q = 0; q < 16; ++q) { const int t = half * 128 + wave * 16 + q; r0[q] = *((const v4u*)(H8 + ((size_t)b * SEQ + TOK[t]) * DM) + lane); }
#pragma unroll
      for (int q = 0; q < 16; ++q) { const int t = half * 128 + wave * 16 + q; *((v4u*)(XG8 + ((size_t)e * NSLOT + b * CAP + t) * DM) + lane) = r0[q]; } }
    WG_SYNC();
}

#ifndef MK_PER_PHASE
#define MK_PER_PHASE 0
#endif
__global__ void __launch_bounds__(NTHR, 2) hybrid_fwd(Args args) {
    extern __shared__ __attribute__((aligned(16))) unsigned char lds_raw[];
    LAS unsigned char* lds = (LAS unsigned char*)lds_raw;
    volatile LAS unsigned* MISC = (volatile LAS unsigned*)(lds + MISC_OFF);
    const int tid0 = threadIdx.x, G = gridDim.x;
    unsigned char* ws = args.ws;
#define PHASE_IDS() const int tid = ltid(), lane = tid & 63, wave = __builtin_amdgcn_readfirstlane(tid >> 6), bid = lbid(); (void)lane; (void)wave; (void)bid
    gu32* ctl = (gu32*)(ws + WS_CTL);
    for (int u = tid0; u < (LDS_BYTES - MISC_OFF) / 4; u += NTHR) ((LAS unsigned*)(lds + MISC_OFF))[u] = 0u;
    __syncthreads();
    XcdBarrier bar; bar.bar = (unsigned*)(ctl + CW_BAR); bar.x = 0; bar.st = nullptr;
    if (!MK_PER_PHASE) bar = xcd_barrier_post((unsigned*)(ctl + CW_BAR), MISC + 8);
#define GRID_BAR() do { if (!MK_PER_PHASE) { xcd_barrier(bar); if (REP_MASK & (1 << 11)) xcd_barrier(bar); } } while (0)
    const int lo = args.ph_lo, hi = args.ph_hi;
#ifndef PT_MASK
#define PT_MASK 0x7ff
#endif
#define PT_ON(j) (((PT_MASK) >> (j)) & 1)
#ifndef REP_MASK
#define REP_MASK 0
#endif
#define REPS(j) for (int rep_ = 0; rep_ < 1 + (((REP_MASK) >> (j)) & 1); ++rep_)
#define IN(k) (lo <= (k) && (k) < hi)
#define BOTH(k) (IN(k) && IN((k) + 1))

    bf16* Hb = (bf16*)(ws + WS_H); bf16* PROJ = (bf16*)(ws + WS_PROJ); bf16* Yb = (bf16*)(ws + WS_Y);
    float* MG = (float*)(ws + WS_MG); float* AFF = (float*)(ws + WS_AFF); int* SEL = (int*)(ws + WS_SEL);
    bf16* XG = (bf16*)(ws + WS_XG); bf16* HID = (bf16*)(ws + WS_HID); bf16* YE = (bf16*)(ws + WS_YE); bf16* XB = (bf16*)(ws + WS_XB);

    if (PT_ON(0) && IN(0)) { PHASE_IDS();
        REPS(0) p0_weights(args, lds, tid, lane, wave, G, bid);
        WG_SYNC();
        REPS(16) row_pass<0, false>(args.in[I_X], nullptr, args.in[I_N1G], args.in[I_WIN] + NPROJ, DIN, Hb, MG, nullptr, nullptr, lds, tid, lane, wave, G, bid);
        if (BOTH(0)) GRID_BAR();
    }
    for (int l = 0; l < DEPTH; ++l) {
        const int pb = 1 + 10 * l;
        if (PT_ON(1) && IN(pb + 0)) { PHASE_IDS();
            pg8::Gemm g{Hb, (const bf16*)(ws + WS_WIN) + (size_t)l * NPROJ * DM, M, NPROJ, DM}; pg8::StaticOrder S; S.init(M, NPROJ, G, bid);
            pg8::EpiBf16<0> E{PROJ, NPROJ, nullptr, 0, 0, 1.f};
            REPS(1) pg8::gemm_phase<pg8::EpiBf16<0>, pg8::StaticOrder, true, true>(lds + RING_OFF, g, S, E);
            if (BOTH(pb + 0)) GRID_BAR();
        }
        if (PT_ON(2) && IN(pb + 1)) { PHASE_IDS();
            if (REP_MASK & (1 << 12)) rope_pass(args, l, lane, wave, G, bid, HID);
            rope_pass(args, l, lane, wave, G, bid, PROJ);
            REPS(2) for (int u = bid; u < 512; u += G) lru_a_unit(args, l, u, lds, tid, lane, wave);
            REPS(3) for (int u = bid; u < 512; u += G) mls_a_unit(args, l, u, lds, tid, lane, wave);
            if (BOTH(pb + 1)) GRID_BAR();
        }
        if (PT_ON(3) && IN(pb + 2)) { PHASE_IDS();
            const attn_body::AttnTensors AT{(const attn_body::bf16*)(PROJ + C_Q), (const attn_body::bf16*)(PROJ + C_K), (const attn_body::bf16*)(PROJ + C_V), (attn_body::bf16*)Yb};
            const attn_body::StaticOrder S(G, bid);
#ifndef P3_PARTS
#define P3_PARTS 7
#endif
            for (int u = bid; u < 256; u += G) mls_scan_unit(args, u, lds, tid, lane, wave);
            WG_SYNC();
            REPS(4) attn_body::attn_phase<attn_body::StaticOrder>((char*)lds_raw + RING_OFF, AT, S);
            if (BOTH(pb + 2)) GRID_BAR();
        }
        if (PT_ON(4) && IN(pb + 3)) { PHASE_IDS();
            REPS(5) for (int u = bid; u < 512; u += G) mls_b_unit(args, l, u, lds, tid, lane, wave);
            for (int u = bid; u < 256; u += G) p4_rows_unit(args, l, u, lds, tid, lane, wave);
            if (BOTH(pb + 3)) GRID_BAR();
        }
        if (PT_ON(5) && IN(pb + 4)) { PHASE_IDS();
            pg8::Gemm g{Yb, (const bf16*)(ws + WS_WOUT) + (size_t)l * DM * DM, M, DM, DM}; pg8::StaticOrder S; S.init(M, DM, G, bid);
            pg8::EpiResid E{l == 0 ? args.in[I_X] : nullptr, XB, XB, DM};
            if (REP_MASK & (1 << 14)) { pg8::EpiResid E2{l == 0 ? args.in[I_X] : nullptr, XB, HID, DM}; pg8::gemm_phase<pg8::EpiResid, pg8::StaticOrder, false, true>(lds + RING_OFF, g, S, E2); }
            pg8::gemm_phase<pg8::EpiResid, pg8::StaticOrder, false, true>(lds + RING_OFF, g, S, E);
            if (BOTH(pb + 4)) GRID_BAR();
        }
        if (PT_ON(6) && IN(pb + 5)) { PHASE_IDS();
            REPS(7) row_pass<1, true>(XB, nullptr, args.in[I_N2G] + (size_t)l * DM, args.in[I_WR] + (size_t)l * DM * NE, NE, Hb, AFF, nullptr, nullptr, lds, tid, lane, wave, G, bid);
            if (BOTH(pb + 5)) GRID_BAR();
        }
        if (PT_ON(7) && IN(pb + 6)) { PHASE_IDS(); REPS(8) for (int it = bid; it < 256; it += G) topk_item(args, it, lds, tid, lane, wave); if (BOTH(pb + 6)) GRID_BAR(); }
        if (PT_ON(8) && IN(pb + 7)) { PHASE_IDS();
            pg8::Gemm g{XG, (const bf16*)(ws + WS_WGU + (size_t)l * NE * 4096 * DM), NE * NSLOT, NE * 4096, DM / 2}; pg8::Moe1Order S{G, bid};
            pg8::EpiSwiGLU E{(unsigned char*)HID, DE};
            if (REP_MASK & (1 << 17)) { pg8::EpiNull E0; pg8::gemm_phase<pg8::EpiNull, pg8::Moe1Order, true, true, true>(lds + RING_OFF, g, S, E0); }
            REPS(9) pg8::gemm_phase<pg8::EpiSwiGLU, pg8::Moe1Order, true, true, true>(lds + RING_OFF, g, S, E);
            if (BOTH(pb + 7)) GRID_BAR();
        }
        if (PT_ON(9) && IN(pb + 8)) { PHASE_IDS();
            pg8::Gemm g{HID, (const bf16*)(ws + WS_WDN + (size_t)l * NE * DM * DE), NE * NSLOT, NE * DM, DE / 2}; pg8::Moe2Order S{G, bid};
            pg8::EpiScaleBf16 E{YE, DM, (const float*)(ws + WS_GATE)};
            REPS(10) pg8::gemm_phase<pg8::EpiScaleBf16, pg8::Moe2Order, true, true, true>(lds + RING_OFF, g, S, E);
            if (BOTH(pb + 8)) GRID_BAR();
        }
        if (PT_ON(10) && IN(pb + 9)) { PHASE_IDS();
            if (REP_MASK & (1 << 15)) { if (l + 1 < DEPTH) row_pass<2, true>(XB, HID, args.in[I_N1G] + (size_t)(l + 1) * DM, args.in[I_WIN] + (size_t)(l + 1) * DM * DIN + NPROJ, DIN, Hb, MG, SEL, YE, lds, tid, lane, wave, G, bid); else row_pass<3, true>(XB, HID, nullptr, nullptr, 0, nullptr, nullptr, SEL, YE, lds, tid, lane, wave, G, bid); WG_SYNC(); }
            if (l + 1 < DEPTH) row_pass<2, true>(XB, XB, args.in[I_N1G] + (size_t)(l + 1) * DM, args.in[I_WIN] + (size_t)(l + 1) * DM * DIN + NPROJ, DIN, Hb, MG, SEL, YE, lds, tid, lane, wave, G, bid);
            else row_pass<3, true>(XB, args.out, nullptr, nullptr, 0, nullptr, nullptr, SEL, YE, lds, tid, lane, wave, G, bid);
            if (BOTH(pb + 9)) GRID_BAR();
        }
    }
#undef IN
#undef BOTH
#undef GRID_BAR
}

extern "C" void kernel_launch(void* const* d_in, const int* in_sizes, int n_in, void* d_out, int out_size, void* d_ws, size_t ws_size, hipStream_t stream) {
    static int grid = 0;
    if (grid == 0) {
        if (n_in != 22 || in_sizes[0] != M * DM || out_size != M * DM || ws_size < WS_END) { fprintf(stderr, "kernel_launch: unexpected shapes (n_in %d, in0 %d, out %d, ws %zu); nothing launched\n", n_in, n_in > 0 ? in_sizes[0] : -1, out_size, ws_size); grid = -1; return; }
        int dev = 0, cus = 0, per_cu = 0;
        if (hipGetDevice(&dev) != hipSuccess || hipDeviceGetAttribute(&cus, hipDeviceAttributeMultiprocessorCount, dev) != hipSuccess) { grid = -1; return; }
        if (hipFuncSetAttribute((const void*)hybrid_fwd, hipFuncAttributeMaxDynamicSharedMemorySize, LDS_BYTES) != hipSuccess) { fprintf(stderr, "kernel_launch: hipFuncSetAttribute failed\n"); grid = -1; return; }
        if (hipOccupancyMaxActiveBlocksPerMultiprocessor(&per_cu, (const void*)hybrid_fwd, NTHR, LDS_BYTES) != hipSuccess || per_cu < 1) { fprintf(stderr, "kernel_launch: occupancy query says %d\n", per_cu); }
        (void)hipGetLastError();
        grid = cus;
    }
    if (grid < 0) return;
    if (hipMemsetAsync((char*)d_ws + WS_CTL, 0, CTL_ZERO_BYTES, stream) != hipSuccess) return;
    Args a{};
    for (int i = 0; i < 22; ++i) a.in[i] = (const float*)d_in[i];
    a.out = (float*)d_out; a.ws = (unsigned char*)d_ws; a.pad = 0;
#if MK_PER_PHASE
    for (int p = 0; p < NPH; ++p) { a.ph_lo = p; a.ph_hi = p + 1; a.li = p; hipLaunchKernelGGL(hybrid_fwd, dim3(grid), dim3(NTHR), LDS_BYTES, stream, a); }
#else
    a.ph_lo = 0; a.ph_hi = NPH; a.li = 0;
    hipLaunchKernelGGL(hybrid_fwd, dim3(grid), dim3(NTHR), LDS_BYTES, stream, a);
#endif
    const hipError_t le = hipPeekAtLastError();
    if (le != hipSuccess) fprintf(stderr, "kernel_launch: launch failed: %s\n", hipGetErrorName(le));
}
```

```cpp
#include <hip/hip_runtime.h>
#include <hip/hip_bf16.h>
#include <cstdio>
#include <cstdint>
#include <cmath>
__device__ __forceinline__ int ltid() { int t = threadIdx.x; asm volatile("" : "+v"(t)); return t; }
__device__ __forceinline__ int lbid() { int t = blockIdx.x; asm volatile("" : "+s"(t)); return t; }
namespace pg8 {
#define PG8_LAS __attribute__((address_space(3)))
typedef unsigned short bf16_t;
typedef short bf16x8 __attribute__((ext_vector_type(8)));
typedef float f32x4 __attribute__((ext_vector_type(4)));
typedef unsigned u32x4 __attribute__((ext_vector_type(4)));
typedef unsigned u32x2 __attribute__((ext_vector_type(2)));
constexpr int BM = 256, BK = 64, HALF = 128, HTB = HALF * BK * 2  , STAGE_BYTES = 8 * HTB, NXCD = 8, WGM = 8;

__host__ __device__ __forceinline__ int lds_byte(int r, int c) { const int st = (r >> 4) * 2 + (c >> 5), rr = r & 15, cc = c & 31, ob = rr * 64 + cc * 2; return st * 1024 + (ob ^ (((ob >> 9) & 1) << 5)); }
__host__ __device__ __forceinline__ void stage_rc(int b, int& R, int& C) { const int st = b / 1024, sb = b % 1024, swz = sb ^ (((sb >> 9) & 1) << 5); R = (st >> 1) * 16 + swz / 64; C = (st & 1) * 32 + (swz % 64) / 2; }
__host__ __device__ __forceinline__ int perm32(int rho) { const int n = rho >> 4, i = rho & 15; return 8 * (i >> 2) + 4 * n + (i & 3); }

struct Unit { int pm, pn; };
struct Gemm { const bf16_t* A; const bf16_t* Bt; int M, N, K; };

struct StaticOrder {
    int nM, nN, nwg, G, c;
    __host__ __device__ void init(int M, int N, int G_, int c_) { nM = M / BM; nN = N / BM; nwg = nM * nN; G = G_; c = c_; }
    __host__ __device__ bool next(int i, Unit& u) const {
        const long L = (long)i * G + c; if (L >= nwg) return false;
        int wgid = (int)L; { const int q = nwg / NXCD, r = nwg % NXCD, xcd = wgid % NXCD, off = wgid / NXCD; wgid = (xcd < r ? xcd * (q + 1) : r * (q + 1) + (xcd - r) * q) + off; }
        const int nig = WGM * nN, gid = wgid / nig, fm = gid * WGM, gsz = (nM - fm) < WGM ? (nM - fm) : WGM;
        u.pm = fm + ((wgid % nig) % gsz); u.pn = (wgid % nig) / gsz; return true;
    }
    __device__ __forceinline__ void a_ready(const Unit&) const {}
    __device__ __forceinline__ void done(const Unit&) const {}
};

__device__ __forceinline__ unsigned cvt_pk_bf16(float lo, float hi) { unsigned r; asm volatile("v_cvt_pk_bf16_f32 %0, %1, %2" : "=v"(r) : "v"(lo), "v"(hi)); return r; }
typedef int i32x4 __attribute__((ext_vector_type(4)));
typedef int i32x8 __attribute__((ext_vector_type(8)));
__device__ __forceinline__ i32x8 cat8(bf16x8 lo, bf16x8 hi) { return __builtin_shufflevector(__builtin_bit_cast(i32x4, lo), __builtin_bit_cast(i32x4, hi), 0, 1, 2, 3, 4, 5, 6, 7); }
__device__ __forceinline__ float clamp448(float v) { return __builtin_amdgcn_fmed3f(v, -448.f, 448.f); }
__device__ __forceinline__ unsigned pk4_fp8(float a, float b, float c, float d) { unsigned r = 0u; r = (unsigned)__builtin_amdgcn_cvt_pk_fp8_f32(a, b, (int)r, false); r = (unsigned)__builtin_amdgcn_cvt_pk_fp8_f32(c, d, (int)r, true); return r; }
typedef float f32x2 __attribute__((ext_vector_type(2)));
__device__ __forceinline__ f32x2 gelu_pk(f32x2 v) {
    const f32x2 av = __builtin_elementwise_abs(v), d = av * 0.2316418882f + 1.0f;
    f32x2 t; t.x = __builtin_amdgcn_rcpf(d.x); t.y = __builtin_amdgcn_rcpf(d.y);
    f32x2 q = t * 0.5307027145f + (-0.7265760135f); q = q * t + 0.7107068705f; q = q * t + (-0.142248368f); q = q * t + 0.127414796f; q = q * t;
    const f32x2 s = (v * v) * (-0.72134752044f);
    f32x2 e; e.x = __builtin_amdgcn_exp2f(s.x); e.y = __builtin_amdgcn_exp2f(s.y);
    const f32x2 m = v * (q * e), r = v - m;
    f32x2 o; o.x = v.x < 0.f ? m.x : r.x; o.y = v.y < 0.f ? m.y : r.y; return o;
}

template <int ACT  > struct EpiBf16 {
    static constexpr bool PERM = true, AFTER_DRAIN = false; static_assert(ACT == 0 || ACT == 1, "EpiBf16: ACT is 0 (none) or 1 (gelu_pk)");
    bf16_t* O; int ldc; const float* bias; int split_cols; size_t split_stride; float scale0;
    __device__ __forceinline__ void operator()(const f32x4 (&acc)[2][2][4][2], const Unit& u, int wr, int wc, int fr, int fq) const {
        const int row0 = u.pm * BM + wr * 64 + fr; int colt = u.pn * BM; bf16_t* base = O;
        float sc = 1.f; if (split_cols) { const int t = colt / split_cols; base += (size_t)t * split_stride; colt -= t * split_cols; if (t == 0) sc = scale0; }
        const int col0 = colt + wc * 32 + 8 * fq, bcol0 = u.pn * BM + wc * 32 + 8 * fq;
        f32x4 bv[2][2];
#pragma unroll
        for (int bj = 0; bj < 2; ++bj)
#pragma unroll
            for (int n = 0; n < 2; ++n) bv[bj][n] = bias ? *(const f32x4*)(bias + bcol0 + bj * HALF + 4 * n) : (f32x4){0.f, 0.f, 0.f, 0.f};
#pragma unroll
        for (int ai = 0; ai < 2; ++ai)
#pragma unroll
            for (int m = 0; m < 4; ++m) { bf16_t* rowp = base + (size_t)(row0 + ai * HALF + m * 16) * ldc + col0;
#pragma unroll
                for (int bj = 0; bj < 2; ++bj) { f32x4 v0 = acc[ai][bj][m][0] + bv[bj][0], v1 = acc[ai][bj][m][1] + bv[bj][1];
                    if (ACT == 1) { f32x2 a = gelu_pk((f32x2){v0[0], v0[1]}), b = gelu_pk((f32x2){v0[2], v0[3]}), c = gelu_pk((f32x2){v1[0], v1[1]}), d = gelu_pk((f32x2){v1[2], v1[3]});
                        v0 = (f32x4){a.x, a.y, b.x, b.y}; v1 = (f32x4){c.x, c.y, d.x, d.y}; }
                    v0 = v0 * sc; v1 = v1 * sc; u32x4 w; w.x = cvt_pk_bf16(v0[0], v0[1]); w.y = cvt_pk_bf16(v0[2], v0[3]); w.z = cvt_pk_bf16(v1[0], v1[1]); w.w = cvt_pk_bf16(v1[2], v1[3]);
                    *(u32x4*)(rowp + bj * HALF) = w; } }
    }
};

struct EpiResid {
    static constexpr bool PERM = true, AFTER_DRAIN = false;
    const float* base32; const bf16_t* base16; bf16_t* C; int ldc;
    __device__ __forceinline__ void operator()(const f32x4 (&acc)[2][2][4][2], const Unit& u, int wr, int wc, int fr, int fq) const {
        const int row0 = u.pm * BM + wr * 64 + fr, col0 = u.pn * BM + wc * 32 + 8 * fq;
#pragma unroll
        for (int ai = 0; ai < 2; ++ai)
#pragma unroll
            for (int m = 0; m < 4; ++m) { const size_t off = (size_t)(row0 + ai * HALF + m * 16) * ldc + col0;
#pragma unroll
                for (int bj = 0; bj < 2; ++bj) { f32x4 b0, b1;
                    if (base32) { b0 = *(const f32x4*)(base32 + off + bj * HALF); b1 = *(const f32x4*)(base32 + off + bj * HALF + 4); }
                    else { const u32x4 q = *(const u32x4*)(base16 + off + bj * HALF);
                        b0 = (f32x4){__uint_as_float(q.x << 16), __uint_as_float(q.x & 0xffff0000u), __uint_as_float(q.y << 16), __uint_as_float(q.y & 0xffff0000u)};
                        b1 = (f32x4){__uint_as_float(q.z << 16), __uint_as_float(q.z & 0xffff0000u), __uint_as_float(q.w << 16), __uint_as_float(q.w & 0xffff0000u)}; }
                    const f32x4 v0 = acc[ai][bj][m][0] + b0, v1 = acc[ai][bj][m][1] + b1;
                    u32x4 w; w.x = cvt_pk_bf16(v0[0], v0[1]); w.y = cvt_pk_bf16(v0[2], v0[3]); w.z = cvt_pk_bf16(v1[0], v1[1]); w.w = cvt_pk_bf16(v1[2], v1[3]);
                    *(u32x4*)(C + off + bj * HALF) = w; } }
    }
};
__device__ __forceinline__ float silu_f(float x) { return x * __builtin_amdgcn_rcpf(1.0f + __builtin_amdgcn_exp2f(-1.4426950408889634f * x)); }
constexpr float WSCALE = 64.f, HSCALE = 4.f;
struct EpiSwiGLU {
    static constexpr bool PERM = true, AFTER_DRAIN = false;
    unsigned char* O; int ldc;
    __device__ __forceinline__ void operator()(const f32x4 (&acc)[2][2][4][2], const Unit& u, int wr, int wc, int fr, int fq) const {
        const int row0 = u.pm * BM + wr * 64 + fr, col0 = (u.pn & 15) * HALF + wc * 32 + 8 * fq; constexpr float is = 1.0f / WSCALE;
#pragma unroll
        for (int ai = 0; ai < 2; ++ai)
#pragma unroll
            for (int m = 0; m < 4; ++m) { unsigned char* rowp = O + (size_t)(row0 + ai * HALF + m * 16) * ldc + col0;
                const f32x4 g0 = acc[ai][0][m][0] * is, g1 = acc[ai][0][m][1] * is, u0 = acc[ai][1][m][0] * (is * HSCALE), u1 = acc[ai][1][m][1] * (is * HSCALE);
                u32x2 w; w.x = pk4_fp8(clamp448(silu_f(g0[0]) * u0[0]), clamp448(silu_f(g0[1]) * u0[1]), clamp448(silu_f(g0[2]) * u0[2]), clamp448(silu_f(g0[3]) * u0[3]));
                w.y = pk4_fp8(clamp448(silu_f(g1[0]) * u1[0]), clamp448(silu_f(g1[1]) * u1[1]), clamp448(silu_f(g1[2]) * u1[2]), clamp448(silu_f(g1[3]) * u1[3]));
                *(u32x2*)rowp = w; }
    }
};
struct EpiScaleBf16 {
    static constexpr bool PERM = true, AFTER_DRAIN = false;
    bf16_t* O; int ldc; const float* rowscale;
    __device__ __forceinline__ void operator()(const f32x4 (&acc)[2][2][4][2], const Unit& u, int wr, int wc, int fr, int fq) const {
        const int row0 = u.pm * BM + wr * 64 + fr, col0 = (u.pn & 3) * BM + wc * 32 + 8 * fq;
#pragma unroll
        for (int ai = 0; ai < 2; ++ai)
#pragma unroll
            for (int m = 0; m < 4; ++m) { const int row = row0 + ai * HALF + m * 16; const float s = rowscale[row] * (1.0f / (WSCALE * HSCALE)); bf16_t* rowp = O + (size_t)row * ldc + col0;
#pragma unroll
                for (int bj = 0; bj < 2; ++bj) { const f32x4 v0 = acc[ai][bj][m][0] * s, v1 = acc[ai][bj][m][1] * s;
                    u32x4 w; w.x = cvt_pk_bf16(v0[0], v0[1]); w.y = cvt_pk_bf16(v0[2], v0[3]); w.z = cvt_pk_bf16(v1[0], v1[1]); w.w = cvt_pk_bf16(v1[2], v1[3]);
                    *(u32x4*)(rowp + bj * HALF) = w; } }
    }
};
struct EpiNull { static constexpr bool PERM = true, AFTER_DRAIN = false; __device__ __forceinline__ void operator()(const f32x4 (&)[2][2][4][2], const Unit&, int, int, int, int) const {} };
struct TailOrder {
    int G, c, pn;
    __device__ __forceinline__ bool next(int i, Unit& u) const { const int L = i * G + c; if (L >= 64) return false; u.pm = L; u.pn = pn; return true; }
    __device__ __forceinline__ void a_ready(const Unit&) const {}
    __device__ __forceinline__ void done(const Unit&) const {}
};
struct Moe1Order {
    int G, c;
    __device__ __forceinline__ bool next(int i, Unit& u) const {
        const int L = i * G + c; if (L >= 2048) return false;
        const int e = L >> 7, r = L & 127; u.pm = e * 8 + ((r >> 3) & 7); u.pn = e * 16 + 2 * (r & 7) + (r >> 6); return true;
    }
    __device__ __forceinline__ void a_ready(const Unit&) const {}
    __device__ __forceinline__ void done(const Unit&) const {}
};
struct Moe2Order {
    int G, c;
    __device__ __forceinline__ bool next(int i, Unit& u) const {
        const int L = i * G + c; if (L >= 512) return false;
        const int q = L & 7, Lp = L >> 3, e = 8 * (Lp >> 5) + q, k = Lp & 31; u.pm = e * 8 + (k & 7); u.pn = e * 4 + (k >> 3); return true;
    }
    __device__ __forceinline__ void a_ready(const Unit&) const {}
    __device__ __forceinline__ void done(const Unit&) const {}
};
template <class Epi, class Sched, bool ALIGN_EPI = false, bool SP2 = false, bool F8 = false>
__device__ __forceinline__ void gemm_phase(PG8_LAS unsigned char* lds, const Gemm g, const Sched& S, const Epi& E) {
    const int tid = ltid(), wid = __builtin_amdgcn_readfirstlane(tid >> 6), lane = tid & 63, wr = wid >> 2, wc = wid & 3, fr = lane & 15, fq = lane >> 4;
    const int K = g.K, nt = K / BK;
    unsigned voffA[2], voffB[2];
#pragma unroll
    for (int i = 0; i < 2; ++i) { int R, C; stage_rc(tid * 16 + i * 8192, R, C); const int Rb = Epi::PERM ? ((R & ~31) + perm32(R & 31)) : R;
        voffA[i] = (unsigned)(R * K + C) * 2u; voffB[i] = (unsigned)(Rb * K + C) * 2u; }
    const size_t kstep = (size_t)(BK * 2);
    const size_t hstep = (size_t)HALF * K * 2;
    const size_t tstep = 2 * hstep;
    const unsigned ldsw = (unsigned)wid * 1024u;
    const int aoff = lds_byte(wr * 64 + fr, fq * 8), boff = lds_byte(wc * 32 + fr, fq * 8);
#define PG8_SA(b, h) (((b) * 2 + (h)) * HTB)
#define PG8_SB(b, h) ((4 + (b) * 2 + (h)) * HTB)
#define PG8_STAGE(bufoff, gbase, voff) do { _Pragma("unroll") for (int _i = 0; _i < 2; ++_i) \
        __builtin_amdgcn_global_load_lds((const unsigned*)((const char*)(gbase) + (voff)[_i]), (PG8_LAS unsigned*)(lds + (bufoff) + ldsw + _i * 8192), 16, 0, 0); } while (0)
#define PG8_LDA(dst, b, h) do { _Pragma("unroll") for (int m = 0; m < 4; ++m) { if constexpr (F8) { dst##8[m] = cat8(*(const PG8_LAS bf16x8*)(lds + PG8_SA(b, h) + aoff + m * 2048), *(const PG8_LAS bf16x8*)(lds + PG8_SA(b, h) + aoff + m * 2048 + 1024)); } \
        else { _Pragma("unroll") for (int k = 0; k < 2; ++k) dst[m][k] = *(const PG8_LAS bf16x8*)(lds + PG8_SA(b, h) + aoff + m * 2048 + k * 1024); } } } while (0)
#define PG8_LDB(dst, b, h) do { _Pragma("unroll") for (int n = 0; n < 2; ++n) { if constexpr (F8) { dst##8[n] = cat8(*(const PG8_LAS bf16x8*)(lds + PG8_SB(b, h) + boff + n * 2048), *(const PG8_LAS bf16x8*)(lds + PG8_SB(b, h) + boff + n * 2048 + 1024)); } \
        else { _Pragma("unroll") for (int k = 0; k < 2; ++k) dst[n][k] = *(const PG8_LAS bf16x8*)(lds + PG8_SB(b, h) + boff + n * 2048 + k * 1024); } } } while (0)
#define PG8_MMA(ai, bj, At, Bt) do { __builtin_amdgcn_s_setprio(1); _Pragma("unroll") for (int m = 0; m < 4; ++m) _Pragma("unroll") for (int n = 0; n < 2; ++n) { \
        if constexpr (F8) { asm volatile("v_mfma_scale_f32_16x16x128_f8f6f4 %0, %1, %2, %0, %3, %3 op_sel_hi:[0,0,0]" : "+v"(acc[ai][bj][m][n]) : "v"(Bt##8[n]), "v"(At##8[m]), "v"(sc1)); } \
        else { _Pragma("unroll") for (int k = 0; k < 2; ++k) acc[ai][bj][m][n] = __builtin_amdgcn_mfma_f32_16x16x32_bf16(Bt[n][k], At[m][k], acc[ai][bj][m][n], 0, 0, 0); } } __builtin_amdgcn_s_setprio(0); } while (0)
#define PG8_WAIT_V(n) asm volatile("s_waitcnt vmcnt(" #n ")" ::: "memory")
#define PG8_WAIT_L(n) asm volatile("s_waitcnt lgkmcnt(" #n ")" ::: "memory")
#define PG8_BAR __builtin_amdgcn_s_barrier()
#define PG8_SCHED __builtin_amdgcn_sched_barrier(0)
    Unit cur, nxt; int ui = 0;
    if (!S.next(0, cur)) return;
    f32x4 acc[2][2][4][2];
#pragma unroll
    for (int a = 0; a < 2; ++a)
#pragma unroll
        for (int b = 0; b < 2; ++b)
#pragma unroll
            for (int m = 0; m < 4; ++m)
#pragma unroll
                for (int n = 0; n < 2; ++n) acc[a][b][m][n] = (f32x4){0.f, 0.f, 0.f, 0.f};
    bf16x8 At[4][2], B0[2][2], B1[2][2]; i32x8 At8[4], B08[2], B18[2];
    const int sc1 = 0x7F7F7F7F;
    const char* cA = (const char*)g.A + (size_t)cur.pm * tstep; const char* cB = (const char*)g.Bt + (size_t)cur.pn * tstep;
    S.a_ready(cur);
    if constexpr (SP2) {
        PG8_STAGE(PG8_SB(0, 0), cB, voffB); PG8_STAGE(PG8_SB(0, 1), cB + hstep, voffB); PG8_STAGE(PG8_SA(0, 0), cA, voffA); PG8_STAGE(PG8_SA(0, 1), cA + hstep, voffA);
        if (wr == 1) PG8_BAR;
        PG8_WAIT_V(2); PG8_BAR;
        PG8_STAGE(PG8_SB(1, 0), cB + kstep, voffB); PG8_STAGE(PG8_SA(1, 0), cA + kstep, voffA); PG8_STAGE(PG8_SB(1, 1), cB + hstep + kstep, voffB);
        PG8_WAIT_V(6); PG8_BAR;
    } else {
        PG8_STAGE(PG8_SB(0, 0), cB, voffB); PG8_STAGE(PG8_SA(0, 0), cA, voffA); PG8_STAGE(PG8_SB(0, 1), cB + hstep, voffB); PG8_STAGE(PG8_SA(0, 1), cA + hstep, voffA);
        if (wr == 1) PG8_BAR;
        PG8_WAIT_V(4); PG8_BAR;
        PG8_STAGE(PG8_SB(1, 0), cB + kstep, voffB); PG8_STAGE(PG8_SA(1, 0), cA + kstep, voffA); PG8_STAGE(PG8_SB(1, 1), cB + hstep + kstep, voffB);
        PG8_WAIT_V(6); PG8_BAR;
    }
    for (;;) {
        const bool has_next = S.next(ui + 1, nxt);
        const char* nA = has_next ? (const char*)g.A + (size_t)nxt.pm * tstep : cA; const char* nB = has_next ? (const char*)g.Bt + (size_t)nxt.pn * tstep : cB;
        for (int t = 0; t < nt; t += 2) {
            const bool last = (t == nt - 2);
            const char* a1 = cA + (size_t)(t + 1) * kstep;
            const char* a2 = last ? nA : cA + (size_t)(t + 2) * kstep; const char* b2 = last ? nB : cB + (size_t)(t + 2) * kstep;
            const char* a3 = a2 + kstep; const char* b3 = b2 + kstep;
            if (last && has_next) S.a_ready(nxt);
            if constexpr (SP2) {
            PG8_LDB(B0, 0, 0); PG8_LDB(B1, 0, 1); PG8_SCHED; PG8_LDA(At, 0, 0); PG8_STAGE(PG8_SA(1, 1), a1 + hstep, voffA);
            PG8_WAIT_V(8); PG8_WAIT_L(0); PG8_BAR; PG8_MMA(0, 0, At, B0); PG8_MMA(0, 1, At, B1); PG8_BAR; PG8_SCHED;
            PG8_LDA(At, 0, 1); PG8_STAGE(PG8_SB(0, 0), b2, voffB); PG8_STAGE(PG8_SB(0, 1), b2 + hstep, voffB); PG8_STAGE(PG8_SA(0, 0), a2, voffA);
            PG8_WAIT_V(8); PG8_WAIT_L(0); PG8_BAR; PG8_MMA(1, 0, At, B0); PG8_MMA(1, 1, At, B1); PG8_BAR; PG8_SCHED;
            PG8_LDB(B0, 1, 0); PG8_LDB(B1, 1, 1); PG8_SCHED; PG8_LDA(At, 1, 0); PG8_STAGE(PG8_SA(0, 1), a2 + hstep, voffA);
            PG8_WAIT_V(8); PG8_WAIT_L(0); PG8_BAR; PG8_MMA(0, 0, At, B0); PG8_MMA(0, 1, At, B1); PG8_BAR; PG8_SCHED;
            PG8_LDA(At, 1, 1); PG8_STAGE(PG8_SB(1, 0), b3, voffB); PG8_STAGE(PG8_SB(1, 1), b3 + hstep, voffB); PG8_STAGE(PG8_SA(1, 0), a3, voffA);
            PG8_WAIT_V(8); PG8_WAIT_L(0); PG8_BAR; PG8_MMA(1, 0, At, B0); PG8_MMA(1, 1, At, B1); PG8_BAR; PG8_SCHED;
            } else {
            PG8_LDB(B0, 0, 0); PG8_SCHED; PG8_LDA(At, 0, 0); PG8_STAGE(PG8_SA(1, 1), a1 + hstep, voffA);
            PG8_WAIT_L(8); PG8_BAR; PG8_WAIT_L(0); PG8_MMA(0, 0, At, B0); PG8_BAR; PG8_SCHED;
            PG8_LDB(B1, 0, 1); PG8_STAGE(PG8_SB(0, 0), b2, voffB);
            PG8_BAR; PG8_WAIT_L(0); PG8_MMA(0, 1, At, B1); PG8_BAR;
            PG8_LDA(At, 0, 1); PG8_STAGE(PG8_SA(0, 0), a2, voffA);
            PG8_BAR; PG8_WAIT_L(0); PG8_MMA(1, 0, At, B0); PG8_BAR; PG8_SCHED;
            PG8_STAGE(PG8_SB(0, 1), b2 + hstep, voffB);
            PG8_WAIT_V(6); PG8_BAR; PG8_MMA(1, 1, At, B1); PG8_BAR;
            PG8_LDB(B0, 1, 0); PG8_SCHED; PG8_LDA(At, 1, 0); PG8_STAGE(PG8_SA(0, 1), a2 + hstep, voffA);
            PG8_WAIT_L(8); PG8_BAR; PG8_WAIT_L(0); PG8_MMA(0, 0, At, B0); PG8_BAR; PG8_SCHED;
            PG8_LDB(B1, 1, 1); PG8_STAGE(PG8_SB(1, 0), b3, voffB);
            PG8_BAR; PG8_WAIT_L(0); PG8_MMA(0, 1, At, B1); PG8_BAR;
            PG8_LDA(At, 1, 1); PG8_STAGE(PG8_SA(1, 0), a3, voffA);
            PG8_BAR; PG8_WAIT_L(0); PG8_MMA(1, 0, At, B0); PG8_BAR; PG8_SCHED;
            PG8_STAGE(PG8_SB(1, 1), b3 + hstep, voffB);
            PG8_WAIT_V(6); PG8_BAR; PG8_MMA(1, 1, At, B1); PG8_BAR;
            }
        }
        if constexpr (F8) { asm volatile("s_nop 15\n\ts_nop 15" ::: "memory"); }
        if constexpr (ALIGN_EPI) { if (wr == 0) PG8_BAR; }
        if constexpr (!Epi::AFTER_DRAIN) { E(acc, cur, wr, wc, fr, fq); S.done(cur); }
        if (!has_next) break;
#pragma unroll
        for (int a = 0; a < 2; ++a)
#pragma unroll
            for (int b = 0; b < 2; ++b)
#pragma unroll
                for (int m = 0; m < 4; ++m)
#pragma unroll
                    for (int n = 0; n < 2; ++n) acc[a][b][m][n] = (f32x4){0.f, 0.f, 0.f, 0.f};
        cur = nxt; cA = nA; cB = nB; ++ui;
        if constexpr (ALIGN_EPI) { if (wr == 1) PG8_BAR; }
    }
    PG8_WAIT_V(0);
    if constexpr (!ALIGN_EPI) { if (wr == 0) PG8_BAR; }
    PG8_BAR;
    if constexpr (Epi::AFTER_DRAIN) { E.fused(acc, cur, wr, wc, fr, fq, lds, wid, lane); S.done(cur); }
#undef PG8_SA
#undef PG8_SB
#undef PG8_STAGE
#undef PG8_LDA
#undef PG8_LDB
#undef PG8_MMA
#undef PG8_WAIT_V
#undef PG8_WAIT_L
#undef PG8_BAR
#undef PG8_SCHED
}
}

namespace attn_body {
using bf16=__hip_bfloat16;
using bf16x8=__attribute__((ext_vector_type(8)))short;
using s16x4=__attribute__((ext_vector_type(4)))short;
using f32x16=__attribute__((ext_vector_type(16)))float;
using u32x4=__attribute__((ext_vector_type(4)))unsigned;
constexpr int BATCH=8,NHEAD=8,NKV=2,SEQ=2048,D=64,PQ=2304,PO=1024;
constexpr int NW=8,QBLK=32,QB=QBLK*NW,KVBLK=64,NQB=SEQ/QB;
constexpr int ATTN_UNIT_ROWS=QB;
__device__ __forceinline__ int crow(int r,int hi){return (r&3)+8*(r>>2)+4*hi;}
#define SBAR() __builtin_amdgcn_sched_barrier(0)
__device__ __forceinline__ void cmask(f32x16&p0,f32x16&p1,int jb,int qrel,int hi){
  const float NEG=-INFINITY; int kb=64*jb+4*hi;
  #pragma unroll
  for(int r=0;r<16;++r){int kv=kb+(r&3)+8*(r>>2); if(kv>qrel)p0[r]=NEG; if(kv+32>qrel)p1[r]=NEG;}
}

constexpr int NSLOT=3, SLOTB=8192;
constexpr int LDS_K=0, LDS_V=NSLOT*SLOTB, LDS_WS=2*NSLOT*SLOTB, LDS_OST=LDS_WS+NW*64*4, LDS_BYTES=LDS_OST+NW*4096;
constexpr float C2=0.125f*1.4426950408889634f;
__device__ __forceinline__ void glds16(const void*gsrc,unsigned lds_dst){unsigned keep;
  asm volatile("s_mov_b32 %0, m0\n\ts_mov_b32 m0, %2\n\ts_nop 0\n\tglobal_load_lds_dwordx4 %1, off\n\ts_mov_b32 m0, %0":"=&s"(keep):"v"(gsrc),"s"(lds_dst):"memory");}
__device__ __forceinline__ float max3f(float a,float b,float c){float r;asm("v_max3_f32 %0, %1, %2, %3":"=v"(r):"v"(a),"v"(b),"v"(c));return r;}
__device__ __forceinline__ float max2f(float a,float b){float r;asm("v_max_f32_e32 %0, %1, %2":"=v"(r):"v"(a),"v"(b));return r;}
__device__ __forceinline__ float fadd_s(float a,float b){float r;asm("v_add_f32_e32 %0, %1, %2":"=v"(r):"v"(a),"v"(b));return r;}
__device__ __forceinline__ float fsub_s(float a,float b){float r;asm("v_sub_f32_e32 %0, %1, %2":"=v"(r):"v"(a),"v"(b));return r;}
typedef float f32x2_t __attribute__((ext_vector_type(2))); typedef __bf16 bf16x2_t __attribute__((ext_vector_type(2)));
__device__ __forceinline__ unsigned cvtpk_s(float lo,float hi){f32x2_t v={lo,hi};bf16x2_t b=__builtin_convertvector(v,bf16x2_t);return __builtin_bit_cast(unsigned,b);}
#define WAIT_BAR(N) asm volatile("s_waitcnt vmcnt(" #N ") lgkmcnt(0)\n\ts_barrier":::"memory")

__device__ __forceinline__ void qkt(f32x16&p0,f32x16&p1,const char*Kslot,const bf16x8*qr,const f32x16&negm,int r32,int hi){
  const char*kb=Kslot+hi*1024+r32*16;
  #pragma unroll
  for(int d0=0;d0<4;++d0){
    const bf16x8 b0=*reinterpret_cast<const bf16x8*>(kb+d0*2048);
    const bf16x8 b1=*reinterpret_cast<const bf16x8*>(kb+d0*2048+512);
    if(d0==0){p0=__builtin_amdgcn_mfma_f32_32x32x16_bf16(b0,qr[0],negm,0,0,0);p1=__builtin_amdgcn_mfma_f32_32x32x16_bf16(b1,qr[0],negm,0,0,0);}
    else{p0=__builtin_amdgcn_mfma_f32_32x32x16_bf16(b0,qr[d0],p0,0,0,0);p1=__builtin_amdgcn_mfma_f32_32x32x16_bf16(b1,qr[d0],p1,0,0,0);}}
}
typedef __attribute__((address_space(3))) const char* lds_cptr;
typedef short v4i16_t __attribute__((ext_vector_type(4)));
__device__ __forceinline__ void kload8(bf16x8*kf,lds_cptr kp){
  kf[0]=*(const __attribute__((address_space(3))) bf16x8*)(kp);      kf[1]=*(const __attribute__((address_space(3))) bf16x8*)(kp+512);
  kf[2]=*(const __attribute__((address_space(3))) bf16x8*)(kp+2048); kf[3]=*(const __attribute__((address_space(3))) bf16x8*)(kp+2560);
  kf[4]=*(const __attribute__((address_space(3))) bf16x8*)(kp+4096); kf[5]=*(const __attribute__((address_space(3))) bf16x8*)(kp+4608);
  kf[6]=*(const __attribute__((address_space(3))) bf16x8*)(kp+6144); kf[7]=*(const __attribute__((address_space(3))) bf16x8*)(kp+6656);
}
__device__ __forceinline__ void kload2(bf16x8*kf,lds_cptr kp,int j){ kf[2*j]=*(const __attribute__((address_space(3))) bf16x8*)(kp+j*2048); kf[2*j+1]=*(const __attribute__((address_space(3))) bf16x8*)(kp+j*2048+512); }
__device__ __forceinline__ s16x4 vtr(lds_cptr p){ return __builtin_bit_cast(s16x4,__builtin_amdgcn_ds_read_tr16_b64_v4i16((__attribute__((address_space(3))) v4i16_t*)p)); }
__device__ __forceinline__ float rowmax(const f32x16&p0,const f32x16&p1){
  float a=max3f(p0[0],p0[1],p1[0]),b=max3f(p0[2],p0[3],p1[1]);a=max3f(a,p1[2],p1[3]);
  #pragma unroll
  for(int r=4;r<16;r+=4){a=max3f(a,p0[r],p0[r+1]);b=max3f(b,p0[r+2],p0[r+3]);a=max3f(a,p1[r],p1[r+1]);b=max3f(b,p1[r+2],p1[r+3]);}
  const float m=max2f(a,b);
  auto rr=__builtin_amdgcn_permlane32_swap(__float_as_uint(m),__float_as_uint(m),false,false);
  return max2f(__uint_as_float(rr[0]),__uint_as_float(rr[1]));
}
__device__ __forceinline__ void pv(f32x16*o,int vb,bf16x8 pa0,bf16x8 pa1,bf16x8 pa2,bf16x8 pa3){
  #pragma unroll
  for(int d0=0;d0<2;++d0){s16x4 lo[4],hi[4];
    #pragma unroll
    for(int ks=0;ks<4;++ks){
      asm volatile("ds_read_b64_tr_b16 %0,%1 offset:%c2":"=&v"(lo[ks]):"v"(vb),"i"(d0*4096+ks*1024):"memory");
      asm volatile("ds_read_b64_tr_b16 %0,%1 offset:%c2":"=&v"(hi[ks]):"v"(vb),"i"(d0*4096+ks*1024+512):"memory");}
    asm volatile("s_waitcnt lgkmcnt(0)":::"memory");SBAR();
    #define PK(k) (bf16x8){lo[k][0],lo[k][1],lo[k][2],lo[k][3],hi[k][0],hi[k][1],hi[k][2],hi[k][3]}
    o[d0]=__builtin_amdgcn_mfma_f32_32x32x16_bf16(pa0,PK(0),o[d0],0,0,0);
    o[d0]=__builtin_amdgcn_mfma_f32_32x32x16_bf16(pa1,PK(1),o[d0],0,0,0);
    o[d0]=__builtin_amdgcn_mfma_f32_32x32x16_bf16(pa2,PK(2),o[d0],0,0,0);
    o[d0]=__builtin_amdgcn_mfma_f32_32x32x16_bf16(pa3,PK(3),o[d0],0,0,0);
    #undef PK
  }
}

#ifndef ATTN_STORE16
#define ATTN_STORE16(p,v) (*(u32x4*)(p)=(v))
#endif
template<int THRL> __device__ __forceinline__ void attn_unit(int b,int h,int qb,const bf16*Q,const bf16*__restrict__ K,const bf16*__restrict__ V,bf16*O,char*shm){
  const int tid=ltid(),lane=tid&63,r32=lane&31,hi=lane>>5; const int wid=__builtin_amdgcn_readfirstlane(tid>>6);
  const long rowbase=(long)b*SEQ; const int q0=qb*QB;
  const bf16*Qw=Q+(rowbase+q0+wid*QBLK)*PQ+h*D;
  const bf16*Kh=K+rowbase*PQ+(h>>2)*D,*Vh=V+rowbase*PQ+(h>>2)*D;
  const unsigned lds0=(unsigned)(uintptr_t)shm;
  float*wsf=(float*)(shm+LDS_WS)+wid*64;
  const bf16*ksrc=Kh+(long)lane*PQ+wid*8;
  const bf16*vsrc=Vh+(long)(16*(wid&3)+(lane>>2))*PQ+(wid>>2)*32+(lane&3)*8;
  const unsigned kdst=lds0+LDS_K+wid*1024, vdst=lds0+LDS_V+wid*1024;
  #define DMA_K(t,slot) glds16(ksrc+(long)(t)*KVBLK*PQ,(unsigned)__builtin_amdgcn_readfirstlane(kdst+(slot)))
  #define DMA_V(t,slot) glds16(vsrc+(long)(t)*KVBLK*PQ,(unsigned)__builtin_amdgcn_readfirstlane(vdst+(slot)))
  const int vb0=(int)(lds0+LDS_V)+((lane>>4)&1)*32+(lane&3)*8+(4*hi+((lane&15)>>2))*64;
  const char*Kbase=shm+LDS_K; bf16x8 kf[8];
  const lds_cptr shm3=(lds_cptr)shm; const lds_cptr kp0=shm3+LDS_K+hi*1024+r32*16; const lds_cptr vp0=shm3+LDS_V+((lane>>4)&1)*32+(lane&3)*8+(4*hi+((lane&15)>>2))*64;
  const int NT=SEQ/KVBLK;
  DMA_K(0,0);DMA_V(0,0);DMA_K(1,SLOTB);
  bf16x8 qr[4];
  #pragma unroll
  for(int d0=0;d0<4;++d0)qr[d0]=*reinterpret_cast<const bf16x8*>(&Qw[(long)r32*PQ+d0*16+hi*8]);
  float mhat=0.f,l_reg=0.f;f32x16 o[2];o[0]=f32x16{};o[1]=f32x16{};f32x16 negm=f32x16{};asm volatile("":"+v"(negm));
  const int qrel=wid*QBLK+r32;
  #define CMASK(P0,P1,t) do{}while(0)
  bool resc=false;
  #define START(P0,P1) do{ const float rm=rowmax(P0,P1); resc=false; \
    { const float dl=rm; mhat=fadd_s(mhat,dl); \
      _Pragma("unroll") for(int r=0;r<16;++r){P0[r]=fsub_s(P0[r],dl);P1[r]=fsub_s(P1[r],dl);} \
      _Pragma("unroll") for(int r=0;r<16;++r)negm[r]=-mhat; asm volatile("":"+v"(negm)); } \
    _Pragma("unroll") for(int r=0;r<16;++r)P0[r]=__builtin_amdgcn_exp2f(P0[r]); }while(0)
  #define RESC() do{ if(resc){ asm volatile("s_waitcnt lgkmcnt(0)":::"memory"); \
      _Pragma("unroll") for(int d_=0;d_<2;++d_) _Pragma("unroll") for(int r=0;r<16;++r)o[d_][r]*=wsf[crow(r,hi)]; } }while(0)
  f32x16 pA0,pA1,pB0,pB1;
  int sl_prev=0,sl_cur=0,sl_next=SLOTB;
  #define ROT() do{sl_prev=sl_cur;sl_cur=sl_next;sl_next=(sl_next==(NSLOT-1)*SLOTB)?0:sl_next+SLOTB;}while(0)
  DMA_K(2,2*SLOTB);
  WAIT_BAR(3);
  qkt(pA0,pA1,Kbase,qr,negm,r32,hi);asm volatile("s_nop 15\n\ts_nop 7":"+v"(pA0),"+v"(pA1));CMASK(pA0,pA1,0);
  START(pA0,pA1);
  _Pragma("unroll") for(int r=0;r<16;++r)pA1[r]=__builtin_amdgcn_exp2f(pA1[r]);
  WAIT_BAR(0);
  DMA_K(3,0);DMA_V(1,SLOTB);
  ROT();
  kload8(kf,kp0+sl_cur);
  WAIT_BAR(2);
  s16x4 vlo[8],vhi[8]; u32x4 pw0,pw1,pw2,pw3;
  #define PKW(P,B) cvtpk_s(P[B],P[B+1])
  #define PAF(k) __builtin_bit_cast(bf16x8,pw##k)
  #define VFR(i) (bf16x8){vlo[i][0],vlo[i][1],vlo[i][2],vlo[i][3],vhi[i][0],vhi[i][1],vhi[i][2],vhi[i][3]}
  #define PIN(x) asm volatile("":"+v"(x))
  #define MX3(a,b,c) __builtin_fmaxf(__builtin_fmaxf((a),(b)),(c))
  #define GAPA(MF,A0,A1,A2,A3,W0,W1,PW) do{ MF; sacc+=A0; sacc+=A1; sacc+=A2; sacc+=A3; PIN(sacc); W0; W1; PIN(PW); SBAR(); }while(0)
  #define EX(v) __builtin_amdgcn_exp2f(v)
  #define GAPB(MF,X,B) do{ MF; X[B]=EX(X[B]); X[B+1]=EX(X[B+1]); X[B+2]=EX(X[B+2]); X[B+3]=EX(X[B+3]); PIN(X); SBAR(); }while(0)
  #define VRD(i) do{ vlo[i]=vtr(vp_+(((i)>>2)*4096+((i)&3)*1024)); vhi[i]=vtr(vp_+(((i)>>2)*4096+((i)&3)*1024+512)); }while(0)
  #define KRD(G,j) do{ if(G){ kload2(kf,kp0+sl_next,j); SBAR(); } }while(0)
  #define STEP(C0,C1,P0,P1,t,GK,GV,GL) do{ SBAR(); \
    const lds_cptr vp_=vp0+sl_prev; \
    VRD(0); SBAR(); float sacc=(P0[0]+P0[1]); \
    GAPA(C0=__builtin_amdgcn_mfma_f32_32x32x16_bf16(kf[0],qr[0],negm,0,0,0), P0[2],P0[3],P0[4],P0[5],     pw0[0]=PKW(P0,0), pw0[1]=PKW(P0,2), pw0); \
    VRD(4); SBAR(); GAPA(C1=__builtin_amdgcn_mfma_f32_32x32x16_bf16(kf[1],qr[0],negm,0,0,0), P0[6],P0[7],P0[8],P0[9],     pw0[2]=PKW(P0,4), pw0[3]=PKW(P0,6), pw0); \
    VRD(1); SBAR(); GAPA(C0=__builtin_amdgcn_mfma_f32_32x32x16_bf16(kf[2],qr[1],C0,0,0,0),   P0[10],P0[11],P0[12],P0[13], pw1[0]=PKW(P0,8), pw1[1]=PKW(P0,10), pw1); \
    VRD(5); SBAR(); GAPA(C1=__builtin_amdgcn_mfma_f32_32x32x16_bf16(kf[3],qr[1],C1,0,0,0),   P0[14],P0[15],P1[0],P1[1],   pw1[2]=PKW(P0,12),pw1[3]=PKW(P0,14), pw1); \
    VRD(2); SBAR(); GAPA(C0=__builtin_amdgcn_mfma_f32_32x32x16_bf16(kf[4],qr[2],C0,0,0,0),   P1[2],P1[3],P1[4],P1[5],     pw2[0]=PKW(P1,0), pw2[1]=PKW(P1,2), pw2); \
    VRD(6); SBAR(); GAPA(C1=__builtin_amdgcn_mfma_f32_32x32x16_bf16(kf[5],qr[2],C1,0,0,0),   P1[6],P1[7],P1[8],P1[9],     pw2[2]=PKW(P1,4), pw2[3]=PKW(P1,6), pw2); \
    VRD(3); SBAR(); GAPA(C0=__builtin_amdgcn_mfma_f32_32x32x16_bf16(kf[6],qr[3],C0,0,0,0),   P1[10],P1[11],P1[12],P1[13], pw3[0]=PKW(P1,8), pw3[1]=PKW(P1,10), pw3); \
    VRD(7); SBAR(); GAPA(C1=__builtin_amdgcn_mfma_f32_32x32x16_bf16(kf[7],qr[3],C1,0,0,0),   P1[14],P1[15],0.f,0.f,       pw3[2]=PKW(P1,12),pw3[3]=PKW(P1,14), pw3); \
    l_reg+=sacc; \
    if(GK){DMA_K((t)+3,sl_cur);} if(GV){DMA_V((t)+1,sl_next);} \
    CMASK(C0,C1,t); \
    { float a=MX3(C0[0],C0[1],C1[0]),b=MX3(C0[2],C0[3],C1[1]); a=MX3(a,C1[2],C1[3]); \
      _Pragma("unroll") for(int r=4;r<16;r+=4){a=MX3(a,C0[r],C0[r+1]);b=MX3(b,C0[r+2],C0[r+3]);a=MX3(a,C1[r],C1[r+1]);b=MX3(b,C1[r+2],C1[r+3]);} \
      float rm=__builtin_fmaxf(a,b); { auto rr=__builtin_amdgcn_permlane32_swap(__float_as_uint(rm),__float_as_uint(rm),false,false); rm=__builtin_fmaxf(__uint_as_float(rr[0]),__uint_as_float(rr[1])); } \
      resc=false; \
      if(__builtin_expect(__any(rm>(float)THRL),0)){ const float dl=__builtin_fmaxf(rm,0.f); mhat+=dl; \
        _Pragma("unroll") for(int r=0;r<16;++r){C0[r]-=dl;C1[r]-=dl;} \
        _Pragma("unroll") for(int r=0;r<16;++r)negm[r]=-mhat; asm volatile("":"+v"(negm)); \
        const float f=__builtin_amdgcn_exp2f(-dl); l_reg*=f; if(hi==0)wsf[r32]=f; resc=true; } } \
    SBAR(); \
    GAPB(o[0]=__builtin_amdgcn_mfma_f32_32x32x16_bf16(PAF(0),VFR(0),o[0],0,0,0), C0,0); \
    GAPB(o[1]=__builtin_amdgcn_mfma_f32_32x32x16_bf16(PAF(0),VFR(4),o[1],0,0,0), C0,4); \
    KRD(GL,0); GAPB(o[0]=__builtin_amdgcn_mfma_f32_32x32x16_bf16(PAF(1),VFR(1),o[0],0,0,0), C0,8); \
    KRD(GL,1); GAPB(o[1]=__builtin_amdgcn_mfma_f32_32x32x16_bf16(PAF(1),VFR(5),o[1],0,0,0), C0,12); \
    KRD(GL,2); GAPB(o[0]=__builtin_amdgcn_mfma_f32_32x32x16_bf16(PAF(2),VFR(2),o[0],0,0,0), C1,0); \
    KRD(GL,3); GAPB(o[1]=__builtin_amdgcn_mfma_f32_32x32x16_bf16(PAF(2),VFR(6),o[1],0,0,0), C1,4); \
    GAPB(o[0]=__builtin_amdgcn_mfma_f32_32x32x16_bf16(PAF(3),VFR(3),o[0],0,0,0), C1,8); \
    GAPB(o[1]=__builtin_amdgcn_mfma_f32_32x32x16_bf16(PAF(3),VFR(7),o[1],0,0,0), C1,12); \
    }while(0)
  int t=1;
  #undef CMASK
  #define CMASK(P0,P1,t) do{}while(0)
  for(;t+5<NT;t+=2){
    STEP(pB0,pB1,pA0,pA1,t,true,true,true);     WAIT_BAR(2); RESC(); ROT();
    STEP(pA0,pA1,pB0,pB1,t+1,true,true,true);   WAIT_BAR(2); RESC(); ROT();
  }
  #undef CMASK
  #define CMASK(P0,P1,t) do{}while(0)
  #define ENDW(tt) do{ if((tt)+3<NT){WAIT_BAR(2);} else if((tt)+2<NT){WAIT_BAR(1);} else {WAIT_BAR(0);} }while(0)
  for(;t+1<NT;t+=2){
    STEP(pB0,pB1,pA0,pA1,t,(t+3<NT),(t+1<NT),(t+1<NT));       ENDW(t);   RESC(); ROT();
    STEP(pA0,pA1,pB0,pB1,t+1,(t+4<NT),(t+2<NT),(t+2<NT));     ENDW(t+1); RESC(); ROT();
  }
  STEP(pB0,pB1,pA0,pA1,NT-1,false,false,false); RESC();
  { float sacc=pB0[0]+pB0[1]; _Pragma("unroll") for(int r=2;r<16;++r)sacc+=pB0[r]; _Pragma("unroll") for(int r=0;r<16;++r)sacc+=pB1[r]; l_reg+=sacc;
    pw0=(u32x4){PKW(pB0,0),PKW(pB0,2),PKW(pB0,4),PKW(pB0,6)};pw1=(u32x4){PKW(pB0,8),PKW(pB0,10),PKW(pB0,12),PKW(pB0,14)};pw2=(u32x4){PKW(pB1,0),PKW(pB1,2),PKW(pB1,4),PKW(pB1,6)};pw3=(u32x4){PKW(pB1,8),PKW(pB1,10),PKW(pB1,12),PKW(pB1,14)};
    SBAR(); pv(o,vb0+sl_cur,PAF(0),PAF(1),PAF(2),PAF(3)); }
  #undef PKW
  #undef PAF
  #undef VFR
  #undef PIN
  #undef MX3
  #undef GAPA
  #undef GAPB
  #undef EX
  #undef VRD
  #undef KRD
  #undef STEP
  #undef ENDW
  {auto rr=__builtin_amdgcn_permlane32_swap(__float_as_uint(l_reg),__float_as_uint(l_reg),false,false);l_reg=__uint_as_float(rr[0])+__uint_as_float(rr[1]);}
  if(hi==0)wsf[32+r32]=l_reg;asm volatile("s_waitcnt lgkmcnt(0)":::"memory");
  float rli[16];
  #pragma unroll
  for(int r=0;r<16;++r)rli[r]=__builtin_amdgcn_rcpf(wsf[32+crow(r,hi)]);
  bf16*Ow=O+(rowbase+q0+wid*QBLK)*PO+h*D;
  { bf16*stg=(bf16*)(shm+LDS_OST)+wid*2048;
    #pragma unroll
    for(int r=0;r<16;++r){const int orow=crow(r,hi);
      #pragma unroll
      for(int d0=0;d0<2;++d0)stg[orow*64+d0*32+r32]=__float2bfloat16(o[d0][r]*rli[r]);}
    asm volatile("s_waitcnt lgkmcnt(0)":::"memory");
    #pragma unroll
    for(int i=0;i<4;++i){const int row=i*8+(lane>>3),ch=lane&7; const u32x4 v=*(const u32x4*)(stg+row*64+ch*8); ATTN_STORE16(Ow+(long)row*PO+ch*8,v);} }
  asm volatile("s_waitcnt lgkmcnt(0)\n\ts_barrier":::"memory");
  #undef DMA_K
  #undef DMA_V
  #undef CMASK
  #undef START
  #undef RESC
  #undef ROT
}
constexpr int ATTN_LDS_BYTES=LDS_BYTES;
struct AttnTensors { const bf16* Q; const bf16* K; const bf16* V; bf16* O; };
struct AttnUnit { int b; int h; int qb; };
struct StaticOrder {
  int vcu, G;
  __device__ __forceinline__ explicit StaticOrder(int grid,int block):vcu((grid%8==0)?(block%8)*(grid/8)+block/8:block),G(grid){}
  __device__ __forceinline__ bool next(int i,AttnUnit&u)const{ const int L=i*G+vcu; if(L>=BATCH*NHEAD*(SEQ/QB))return false; const int grp=L>>5,r=L&31; u.b=grp>>1; u.h=(grp&1)*4+(r>>3); u.qb=r&7; return true; }
  __device__ __forceinline__ void a_ready(const AttnUnit&)const{}
  __device__ __forceinline__ void done(const AttnUnit&)const{}
};
template<class Sched,int THRL=8> __device__ __forceinline__ void attn_phase(char*lds,const AttnTensors&T,const Sched&S){
  AttnUnit u;
  for(int i=0;S.next(i,u);++i){ S.a_ready(u); attn_unit<THRL>(u.b,u.h,u.qb,T.Q,T.K,T.V,T.O,lds); S.done(u); }
}
#undef SBAR
#undef WAIT_BAR
}


#define GAS __attribute__((address_space(1)))
#define LAS __attribute__((address_space(3)))
typedef unsigned short bf16;
typedef unsigned v4u __attribute__((ext_vector_type(4)));
typedef float f32x4 __attribute__((ext_vector_type(4)));
typedef short bf16x8 __attribute__((ext_vector_type(8)));
typedef GAS unsigned gu32;
typedef GAS unsigned long long gu64;
#define RLX_AGENT __ATOMIC_RELAXED, __HIP_MEMORY_SCOPE_AGENT
#define LDS_WAIT() asm volatile("s_waitcnt lgkmcnt(0)" ::: "memory")
#define VM_WAIT() asm volatile("s_waitcnt vmcnt(0)" ::: "memory")
__device__ __forceinline__ unsigned long long rt() { return __builtin_amdgcn_s_memrealtime(); }
__device__ __forceinline__ unsigned f2bf(float f) { unsigned u = __builtin_bit_cast(unsigned, f); return (u + 0x7fffu + ((u >> 16) & 1u)) >> 16; }
__device__ __forceinline__ unsigned pk2(float lo, float hi) { return f2bf(lo) | (f2bf(hi) << 16); }

#define XB_TMO      128
#define XB_XCNT(j)  (256  + 64 * (j))
#define XB_XSUB(j)  (1280 + 64 * (j))
#define XB_XGEN(j)  (2304 + 64 * (j))
#define XB_TOP      3328
#define XB_TOPGEN   3392
#define XCD_BAR_WORDS 3456
#define XB_SPIN_CAP (1u << 18)

__device__ __forceinline__ unsigned xb_ld(unsigned* p)              { return __hip_atomic_load(p, __ATOMIC_RELAXED, __HIP_MEMORY_SCOPE_AGENT); }
__device__ __forceinline__ unsigned xb_add(unsigned* p, unsigned v) { return __hip_atomic_fetch_add(p, v, __ATOMIC_RELAXED, __HIP_MEMORY_SCOPE_AGENT); }
__device__ __forceinline__ unsigned xb_xcc_id() { return (unsigned)__builtin_amdgcn_s_getreg((3 << 11) | 20) & 0xFu; }
#define XB_SPIN(cond, bar) do { unsigned _sp = 0; while (cond) { __builtin_amdgcn_s_sleep(1); \
    if ((++_sp & 255u) == 0u) { if (xb_ld(&(bar)[XB_TMO])) break; if (_sp > XB_SPIN_CAP) { atomicAdd(&(bar)[XB_TMO], 1u); break; } } } } while (0)

struct XcdBarrier {
    unsigned* bar; unsigned x;
    volatile LAS unsigned* st;
};

__device__ __forceinline__ XcdBarrier xcd_barrier_post(unsigned* bar, volatile LAS unsigned* st) {
    XcdBarrier b; b.bar = bar; b.x = xb_xcc_id(); b.st = st;
    if (threadIdx.x == 0) (void)xb_add(&bar[XB_XCNT(b.x)], 1u);
    return b;
}
__device__ __forceinline__ void xcd_barrier_complete(unsigned* bar, unsigned x, unsigned& nloc, unsigned& nx) {
    const unsigned G = gridDim.x * gridDim.y * gridDim.z;
    unsigned sum, cnt, mine, sp = 0u;
    for (;;) {
        sum = 0u; cnt = 0u; mine = 0u;
#pragma unroll
        for (unsigned j = 0; j < 16; ++j) { const unsigned c = xb_ld(&bar[XB_XCNT(j)]); sum += c; cnt += (c > 0u) ? 1u : 0u; mine = (j == x) ? c : mine; }
        if (sum == G) break;
        __builtin_amdgcn_s_sleep(1);
        if ((++sp & 255u) == 0u) { if (xb_ld(&bar[XB_TMO])) break; if (sp > XB_SPIN_CAP) { atomicAdd(&bar[XB_TMO], 1u); break; } }
    }
    nloc = mine > 0u ? mine : 1u; nx = cnt > 0u ? cnt : 1u;
}

__device__ __forceinline__ void xcd_barrier(const XcdBarrier& b) {
    asm volatile("s_waitcnt vmcnt(0)" ::: "memory");
    __syncthreads();
    if (threadIdx.x == 0) {
        unsigned* bar = b.bar;
        __builtin_amdgcn_s_waitcnt(0);
        unsigned nloc = b.st[0], nx = b.st[1];
        if (nloc == 0u) { xcd_barrier_complete(bar, b.x, nloc, nx); b.st[0] = nloc; b.st[1] = nx; }
        const unsigned old = xb_add(&bar[XB_XSUB(b.x)], 1u);
        const unsigned gen = old / nloc;
        if (old + 1u == (gen + 1u) * nloc) {
            __builtin_amdgcn_fence(__ATOMIC_RELEASE, "agent");
            asm volatile("s_waitcnt vmcnt(0)" ::: "memory");
            const unsigned og = xb_add(&bar[XB_TOP], 1u);
            const unsigned tg = og / nx;
            if (og + 1u == (tg + 1u) * nx) xb_add(&bar[XB_TOPGEN], 1u);
            else XB_SPIN(xb_ld(&bar[XB_TOPGEN]) == tg, bar);
            __builtin_amdgcn_fence(__ATOMIC_ACQUIRE, "agent");
            xb_add(&bar[XB_XGEN(b.x)], 1u);
            asm volatile("s_waitcnt vmcnt(0)" ::: "memory");
        } else {
            XB_SPIN(xb_ld(&bar[XB_XGEN(b.x)]) == gen, bar);
            __builtin_amdgcn_fence(__ATOMIC_ACQUIRE, "agent");
            asm volatile("s_waitcnt vmcnt(0)" ::: "memory");
        }
    }
    __syncthreads();
}

constexpr int NWAVES = 8, NTHR = 512;
constexpr int DM = 1024, NB = 8, SEQ = 2048, DEPTH = 4, M = NB * SEQ;
constexpr int DIN = 2320, NPROJ = 2304;
constexpr int C_Q = 0, C_K = 512, C_V = 640, C_LX = 768, C_LG = 1024, C_MQ = 1280, C_MK = 1536, C_MV = 1792, C_MO = 2048;
constexpr int NE = 16, CAP = 256, DE = 2048, NSLOT = NB * CAP;
constexpr float EPS = 1e-6f;
constexpr int NPH = 1 + 10 * DEPTH;

constexpr size_t MiB = 1u << 20;
constexpr size_t WS_CTL = 0, CTL_ZERO_BYTES = 1 * MiB;
constexpr size_t WS_ROPE = 1 * MiB;
constexpr size_t WS_LRUW = 2 * MiB;
constexpr size_t WS_WIN = 4 * MiB;
constexpr size_t WS_WOUT = 22 * MiB;
constexpr size_t WS_WGU = 32 * MiB;
constexpr size_t WS_WDN = 544 * MiB;
constexpr size_t WS_H = 800 * MiB;
constexpr size_t WS_PROJ = 832 * MiB;
constexpr size_t WS_Y = 904 * MiB;
constexpr size_t WS_MG = 936 * MiB;
constexpr size_t WS_AFF = 937 * MiB;
constexpr size_t WS_SEL = 938 * MiB;
constexpr size_t WS_IDX = 939 * MiB;
constexpr size_t WS_GATE = WS_IDX + 128 * 1024;
constexpr size_t WS_LH = 940 * MiB;
constexpr size_t WS_CP = 956 * MiB;
constexpr size_t WS_CARRY = 972 * MiB;
constexpr size_t WS_CLOC = 974 * MiB;
constexpr size_t WS_NLOC = 990 * MiB;
constexpr size_t WS_MLOC = WS_NLOC + 512 * 1024;
constexpr size_t WS_XG = 992 * MiB;
constexpr size_t WS_HID = 1056 * MiB;
constexpr size_t WS_YE = 1184 * MiB;
constexpr size_t WS_CPREV = 1280 * MiB;
constexpr size_t WS_NPREV = 1288 * MiB;
constexpr size_t WS_MPREV = WS_NPREV + 512 * 1024;
constexpr size_t WS_XB = 1248 * MiB;
constexpr size_t WS_END = 1290 * MiB;
constexpr int CW_BAR = 4096;

constexpr int RING_OFF = 0, RING_BYTES = 143360;
constexpr int MISC_OFF = RING_BYTES;
constexpr int LDS_BYTES = 147456;

typedef unsigned u32x2 __attribute__((ext_vector_type(2)));
__device__ __forceinline__ float bf2f(unsigned short v) { return __uint_as_float(((unsigned)v) << 16); }
__device__ __forceinline__ float bflo(unsigned v) { return __uint_as_float(v << 16); }
__device__ __forceinline__ float bfhi(unsigned v) { return __uint_as_float(v & 0xffff0000u); }
template <int CTRL> __device__ __forceinline__ float dppf(float v) { return __uint_as_float((unsigned)__builtin_amdgcn_update_dpp(0, (int)__float_as_uint(v), CTRL, 0xF, 0xF, true)); }
__device__ __forceinline__ float row16_sum(float v) { v += dppf<0xB1>(v); v += dppf<0x4E>(v); v += dppf<0x141>(v); v += dppf<0x140>(v); return v; }
__device__ __forceinline__ float xor16_sum(float v) { const auto r = __builtin_amdgcn_permlane16_swap(__float_as_uint(v), __float_as_uint(v), false, false); return __uint_as_float(r[0]) + __uint_as_float(r[1]); }
__device__ __forceinline__ float xor32_sum(float v) { const auto r = __builtin_amdgcn_permlane32_swap(__float_as_uint(v), __float_as_uint(v), false, false); return __uint_as_float(r[0]) + __uint_as_float(r[1]); }
__device__ __forceinline__ float half_sum(float v) { return xor16_sum(row16_sum(v)); }
__device__ __forceinline__ float wave_sum(float v) { return xor32_sum(xor16_sum(row16_sum(v))); }
__device__ __forceinline__ float wave_max(float v) {
#pragma unroll
    for (int o = 1; o < 64; o <<= 1) v = fmaxf(v, __shfl_xor(v, o));
    return v;
}
__device__ __forceinline__ float fexp(float x) { return __builtin_amdgcn_exp2f(1.4426950408889634f * x); }
__device__ __forceinline__ float frcp(float x) { return __builtin_amdgcn_rcpf(x); }
__device__ __forceinline__ float frsq(float x) { return __builtin_amdgcn_rsqf(x); }
__device__ __forceinline__ float sigmoid_f(float x) { return frcp(1.0f + fexp(-x)); }
__device__ __forceinline__ float one_minus_exp(float x) {
    const float p = -x * (1.0f + 0.5f * x * (1.0f + (1.0f / 3.0f) * x * (1.0f + 0.25f * x * (1.0f + 0.2f * x))));
    return (x > -0.25f) ? p : 1.0f - fexp(x); }
__device__ __forceinline__ float logsig_f(float x) { return fminf(x, 0.f) - log1pf(expf(-fabsf(x))); }
__device__ __forceinline__ float gelu_tanh_f(float x) { const float u = 0.7978845608028654f * (x + 0.044715f * x * x * x); return x * (1.0f - frcp(1.0f + fexp(2.0f * u))); }
template <bool MAXOP, bool REV> __device__ __forceinline__ void wave_scan128(const LAS float* in, LAS float* out, int lane) {
    const int j0 = REV ? 127 - 2 * lane : 2 * lane, j1 = REV ? 126 - 2 * lane : 2 * lane + 1;
    const float a = in[j0], b = in[j1];
    const float s1 = MAXOP ? fmaxf(a, b) : a + b;
    float incl = s1;
#pragma unroll
    for (int o = 1; o < 64; o <<= 1) { const float t = __shfl_up(incl, o); if (lane >= o) incl = MAXOP ? fmaxf(incl, t) : incl + t; }
    const float ex = __shfl_up(incl, 1);
    const float e = (lane == 0) ? (MAXOP ? -INFINITY : 0.f) : ex;
    out[j0] = MAXOP ? fmaxf(e, a) : e + a; out[j1] = MAXOP ? fmaxf(e, s1) : e + s1;
}
#define WAVE_LDS_FENCE() asm volatile("s_waitcnt lgkmcnt(0)" ::: "memory")
#define MFMA16(a, b, c) __builtin_amdgcn_mfma_f32_16x16x32_bf16((a), (b), (c), 0, 0, 0)
#define WG_SYNC() __syncthreads()

struct Args { const float* in[22]; float* out; unsigned char* ws; int ph_lo, ph_hi, li, pad; };
enum { I_X = 0, I_N1G, I_WIN, I_QG, I_KG, I_CW, I_CB, I_WA, I_BA, I_WX, I_BX, I_LAM, I_FB, I_MNG, I_AOG, I_LOG, I_WOUT, I_N2G, I_WR, I_WG, I_WU, I_WD };

__device__ __forceinline__ void cvt_item(const float* __restrict__ src, int N, int k0, int n0, bf16* dst, int Kd, LAS float* scr, int lane) {
    { const int r4 = lane >> 4, c4 = lane & 15; f32x4 t[16];
#pragma unroll
      for (int i = 0; i < 16; ++i) t[i] = __builtin_nontemporal_load((const f32x4*)(src + (size_t)(k0 + 4 * i + r4) * N + n0 + 4 * c4));
#pragma unroll
      for (int i = 0; i < 16; ++i) { LAS float* d = scr + (4 * i + r4) * 65 + 4 * c4; d[0] = t[i][0]; d[1] = t[i][1]; d[2] = t[i][2]; d[3] = t[i][3]; } }
    LDS_WAIT(); asm volatile("" ::: "memory");
    const int c = lane >> 3, nn = lane & 7;
#pragma unroll
    for (int j = 0; j < 8; ++j) { const int n = nn + 8 * j; const LAS float* s = scr + (8 * c) * 65 + n;
        v4u o; o.x = pk2(s[0], s[65]); o.y = pk2(s[130], s[195]); o.z = pk2(s[260], s[325]); o.w = pk2(s[390], s[455]);
        *(GAS v4u*)(dst + (size_t)n * Kd + 8 * c) = o; }
    LDS_WAIT(); asm volatile("" ::: "memory");
}
__device__ __forceinline__ void cvt_item8(const float* __restrict__ src, int N, int k0, int n0, unsigned char* dst, int Kd, LAS float* scr, int lane) {
    { const int r8 = lane >> 3, c8 = lane & 7; f32x4 t[16];
#pragma unroll
      for (int i = 0; i < 16; ++i) t[i] = __builtin_nontemporal_load((const f32x4*)(src + (size_t)(k0 + 8 * i + r8) * N + n0 + 4 * c8));
#pragma unroll
      for (int i = 0; i < 16; ++i) { LAS float* d = scr + (8 * i + r8) * 33 + 4 * c8; d[0] = t[i][0]; d[1] = t[i][1]; d[2] = t[i][2]; d[3] = t[i][3]; } }
    LDS_WAIT(); asm volatile("" ::: "memory");
    const int c = lane >> 3, nn = lane & 7; constexpr float sc = pg8::WSCALE;
#pragma unroll
    for (int j = 0; j < 4; ++j) { const int n = nn + 8 * j; const LAS float* s = scr + (16 * c) * 33 + n;
        v4u o; o.x = pg8::pk4_fp8(s[0] * sc, s[33] * sc, s[66] * sc, s[99] * sc); o.y = pg8::pk4_fp8(s[132] * sc, s[165] * sc, s[198] * sc, s[231] * sc);
        o.z = pg8::pk4_fp8(s[264] * sc, s[297] * sc, s[330] * sc, s[363] * sc); o.w = pg8::pk4_fp8(s[396] * sc, s[429] * sc, s[462] * sc, s[495] * sc);
        *(GAS v4u*)(dst + (size_t)n * Kd + 16 * c) = o; }
    LDS_WAIT(); asm volatile("" ::: "memory");
}
__device__ __forceinline__ void p0_weights(const Args& a, LAS unsigned char* lds, int tid, int lane, int wave, int G, int bid) {
    unsigned char* ws = a.ws;
    LAS float* scr = (LAS float*)(lds + RING_OFF + wave * 16896);
    const int gw = bid * NWAVES + wave, NGW = G * NWAVES;
    constexpr int I_IN = 16 * 36, I_OUT = 16 * 16, I_EXP = 1536, PER_LAYER = I_IN + I_OUT + NE * I_EXP, NITEMS = DEPTH * PER_LAYER;
    for (int it = gw; it < NITEMS; it += NGW) {
        const int l = it / PER_LAYER; int r = it - l * PER_LAYER;
        if (r < I_IN) { const int kb = r / 36, nb = r - kb * 36;
            cvt_item(a.in[I_WIN] + (size_t)l * DM * DIN, DIN, 64 * kb, 64 * nb, (bf16*)(ws + WS_WIN) + ((size_t)l * NPROJ + 64 * nb) * DM + 64 * kb, DM, scr, lane); continue; }
        r -= I_IN;
        if (r < I_OUT) { const int kb = r >> 4, nb = r & 15;
            cvt_item(a.in[I_WOUT] + (size_t)l * DM * DM, DM, 64 * kb, 64 * nb, (bf16*)(ws + WS_WOUT) + ((size_t)l * DM + 64 * nb) * DM + 64 * kb, DM, scr, lane); continue; }
        r -= I_OUT;
        const int e = r / I_EXP; int r2 = r - e * I_EXP; const size_t le = (size_t)l * NE + e;
        LAS float* scr8 = (LAS float*)(lds + RING_OFF + wave * 16896);
        if (r2 < 1024) { const int up = r2 >> 9; r2 &= 511; const int kb = r2 >> 6, nb = r2 & 63, n0 = 32 * nb, drow = 256 * (n0 >> 7) + (n0 & 127) + 128 * up;
            cvt_item8(a.in[up ? I_WU : I_WG] + le * DM * DE, DE, 128 * kb, n0, ws + WS_WGU + (le * 4096 + drow) * DM + 128 * kb, DM, scr8, lane); continue; }
        r2 -= 1024; { const int kb = r2 >> 5, nb = r2 & 31;
            cvt_item8(a.in[I_WD] + le * DE * DM, DM, 128 * kb, 32 * nb, ws + WS_WDN + (le * DM + 32 * nb) * DE + 128 * kb, DE, scr8, lane); }
    }
    const int gt = bid * NTHR + tid, GT = G * NTHR;
    bf16* lw = (bf16*)(ws + WS_LRUW);
    for (int i = gt; i < DEPTH * 2 * 2 * 4 * 4096; i += GT) { const int d = i & 63, e = (i >> 6) & 63, n = (i >> 12) & 3, gate = (i >> 14) & 1, dir = (i >> 15) & 1, l = i >> 16;
        const float* src = a.in[gate ? I_WX : I_WA]; lw[i] = (bf16)f2bf(src[((((size_t)l * 2 + dir) * 4 + n) * 64 + d) * 64 + e]); }
    float* rc = (float*)(ws + WS_ROPE); float* rs = rc + SEQ * 32;
    for (int i = gt; i < SEQ * 32; i += GT) { const int s = i >> 5, j = i & 31, f = j & 15; const float pos = (float)((j < 16) ? (s >> 6) : (s & 63));
        const float inv = 1.0f / powf(10000.0f, (float)f * (1.0f / 16.0f)); const float ang = pos * inv; rc[i] = cosf(ang); rs[i] = sinf(ang); }
}

template <int MODE, bool XB16>
__device__ __forceinline__ void row_pass(const void* xin_, void* xout_, const float* gain, const float* WT  , int sk, bf16* H, float* O16, const int* SEL, const bf16* YE,
                                         LAS unsigned char* lds, int tid, int lane, int wave, int G, int bid) {
    constexpr int WLS = 1028;
    LAS float* wl = (LAS float*)(lds + RING_OFF);
    if (MODE != 3) { float wv[32];
#pragma unroll
        for (int q = 0; q < 32; ++q) { const int i = tid + q * NTHR; wv[q] = WT[(size_t)(i >> 4) * sk + (i & 15)]; }
#pragma unroll
        for (int q = 0; q < 32; ++q) { const int i = tid + q * NTHR; wl[(i & 15) * WLS + (i >> 4)] = wv[q]; } }
    WG_SYNC();
    const int gw = bid * NWAVES + wave, NGW = G * NWAVES;
    f32x4 gq4[4];
#pragma unroll
    for (int j = 0; j < 4; ++j) gq4[j] = (MODE != 3) ? *((const f32x4*)gain + 64 * j + lane) : (f32x4){0.f, 0.f, 0.f, 0.f};
    constexpr int R = 4;
    for (int m0 = R * gw; m0 < M; m0 += R * NGW) {
        asm volatile("" ::: "memory");
        f32x4 v[R][4];
#pragma unroll
        for (int r = 0; r < R; ++r)
#pragma unroll
            for (int j = 0; j < 4; ++j) {
                if (XB16) { const u32x2 q = *((const u32x2*)((const bf16*)xin_ + (size_t)(m0 + r) * DM) + 64 * j + lane); v[r][j] = (f32x4){bflo(q.x), bfhi(q.x), bflo(q.y), bfhi(q.y)}; }
                else v[r][j] = *((const f32x4*)((const float*)xin_ + (size_t)(m0 + r) * DM) + 64 * j + lane); }
        if (MODE >= 2) {
            const int b = m0 >> 11; int selv[R]; unsigned long long mk[R];
#pragma unroll
            for (int r = 0; r < R; ++r) { selv[r] = (lane < NE) ? SEL[(size_t)(m0 + r) * NE + lane] : -1; }
#pragma unroll
            for (int r = 0; r < R; ++r) mk[r] = __ballot(selv[r] >= 0);
            while (mk[0] | mk[1] | mk[2] | mk[3]) {
                u32x2 q[R][2][4]; float wt[R][2];
#pragma unroll
                for (int r = 0; r < R; ++r)
#pragma unroll
                    for (int i = 0; i < 2; ++i) { const bf16* yr = YE; wt[r][i] = 0.f;
                        if (mk[r]) { const int e = __builtin_ctzll(mk[r]); mk[r] &= mk[r] - 1ull; const int sl = __builtin_amdgcn_readlane(selv[r], e);
                            yr = YE + ((size_t)e * NSLOT + b * CAP + sl) * DM; wt[r][i] = 1.f; }
#pragma unroll
                        for (int j = 0; j < 4; ++j) q[r][i][j] = *((const u32x2*)yr + 64 * j + lane); }
#pragma unroll
                for (int r = 0; r < R; ++r)
#pragma unroll
                    for (int i = 0; i < 2; ++i)
#pragma unroll
                        for (int j = 0; j < 4; ++j) { const u32x2 w = q[r][i][j]; const float t = wt[r][i];
                            v[r][j][0] += t * bflo(w.x); v[r][j][1] += t * bfhi(w.x); v[r][j][2] += t * bflo(w.y); v[r][j][3] += t * bfhi(w.y); }
            }
#pragma unroll
            for (int r = 0; r < R; ++r)
#pragma unroll
                for (int j = 0; j < 4; ++j) {
                    if (MODE == 3) *((f32x4*)((float*)xout_ + (size_t)(m0 + r) * DM) + 64 * j + lane) = v[r][j];
                    else { u32x2 o; o.x = pk2(v[r][j][0], v[r][j][1]); o.y = pk2(v[r][j][2], v[r][j][3]); *((u32x2*)((bf16*)xout_ + (size_t)(m0 + r) * DM) + 64 * j + lane) = o;
                        v[r][j] = (f32x4){bflo(o.x), bfhi(o.x), bflo(o.y), bfhi(o.y)}; } }
        }
        if (MODE == 3) continue;
        float ss[R];
#pragma unroll
        for (int r = 0; r < R; ++r) { float a = 0.f;
#pragma unroll
            for (int j = 0; j < 4; ++j) a += (v[r][j][0] * v[r][j][0] + v[r][j][1] * v[r][j][1]) + (v[r][j][2] * v[r][j][2] + v[r][j][3] * v[r][j][3]);
            ss[r] = wave_sum(a); }
#pragma unroll
        for (int r = 0; r < R; ++r) { const float rstd = frsq(ss[r] * (1.0f / DM) + EPS);
#pragma unroll
            for (int j = 0; j < 4; ++j) { v[r][j] = v[r][j] * rstd * gq4[j];
                if (MODE == 1) { *((unsigned*)((unsigned char*)H + (size_t)(m0 + r) * DM) + 64 * j + lane) = pg8::pk4_fp8(v[r][j][0], v[r][j][1], v[r][j][2], v[r][j][3]); }
                else { u32x2 o; o.x = pk2(v[r][j][0], v[r][j][1]); o.y = pk2(v[r][j][2], v[r][j][3]); *((u32x2*)(H + (size_t)(m0 + r) * DM) + 64 * j + lane) = o; } } }
        float p[R][16];
#pragma unroll
        for (int jj = 0; jj < 16; ++jj) { float a[R];
#pragma unroll
            for (int r = 0; r < R; ++r) a[r] = 0.f;
#pragma unroll
            for (int j = 0; j < 4; ++j) { const f32x4 w = *((LAS f32x4*)(wl + jj * WLS) + 64 * j + lane);
#pragma unroll
                for (int r = 0; r < R; ++r) a[r] += (v[r][j][0] * w[0] + v[r][j][1] * w[1]) + (v[r][j][2] * w[2] + v[r][j][3] * w[3]); }
#pragma unroll
            for (int r = 0; r < R; ++r) p[r][jj] = wave_sum(a[r]); }
#pragma unroll
        for (int r = 0; r < R; ++r) { const int m = m0 + r;
            if (MODE == 1) {
                float mx = p[r][0];
#pragma unroll
                for (int jj = 1; jj < 16; ++jj) mx = fmaxf(mx, p[r][jj]);
                float sum = 0.f;
#pragma unroll
                for (int jj = 0; jj < 16; ++jj) { p[r][jj] = fexp(p[r][jj] - mx); sum += p[r][jj]; }
                float mine = 0.f;
#pragma unroll
                for (int jj = 0; jj < 16; ++jj) mine = (lane == jj) ? p[r][jj] : mine;
                if (lane < 16) O16[(((size_t)(m >> 11) * NE + lane) << 11) + (m & 2047)] = mine / sum;
            } else {
                float mine = 0.f;
#pragma unroll
                for (int jj = 0; jj < 16; ++jj) mine = (lane == jj) ? p[r][jj] : mine;
                if (lane < 16) O16[(size_t)m * 16 + lane] = mine;
            } }
    }
}

__device__ __forceinline__ void rope_pass(const Args& a, int l, int lane, int wave, int G, int bid, bf16* DST) {
    bf16* PROJ = (bf16*)(a.ws + WS_PROJ); const float* rc = (const float*)(a.ws + WS_ROPE); const float* rs = rc + SEQ * 32;
    const float* qg = a.in[I_QG] + l * 64; const float* kg = a.in[I_KG] + l * 64;
    const int gw = bid * NWAVES + wave, NGW = G * NWAVES, j = lane & 31;
    const float qg1 = qg[j], qg2 = qg[32 + j], kg1 = kg[j], kg2 = kg[32 + j];
    for (int mb = 4 * gw; mb < M; mb += 4 * NGW) {
        float x1[4][5], x2[4][5], cs[4], sn[4];
#pragma unroll
        for (int r = 0; r < 4; ++r) { const bf16* row = PROJ + (size_t)(mb + r) * NPROJ; const int s = (mb + r) & 2047; cs[r] = rc[s * 32 + j]; sn[r] = rs[s * 32 + j];
#pragma unroll
            for (int it = 0; it < 5; ++it) { const int hh = 2 * it + (lane >> 5); x1[r][it] = bf2f(row[hh * 64 + j]); x2[r][it] = bf2f(row[hh * 64 + 32 + j]); } }
#pragma unroll
        for (int r = 0; r < 4; ++r) { bf16* row = DST + (size_t)(mb + r) * NPROJ;
#pragma unroll
            for (int it = 0; it < 5; ++it) { const int hh = 2 * it + (lane >> 5);
                const float ss = half_sum(x1[r][it] * x1[r][it] + x2[r][it] * x2[r][it]);
                const float rstd = frsq(ss * (1.0f / 64.0f) + EPS);
                const float n1 = x1[r][it] * rstd * (it < 4 ? qg1 : kg1), n2 = x2[r][it] * rstd * (it < 4 ? qg2 : kg2);
                float o1 = n1 * cs[r] - n2 * sn[r], o2 = n2 * cs[r] + n1 * sn[r];
                if (it < 4) { o1 *= attn_body::C2; o2 *= attn_body::C2; }
                row[hh * 64 + j] = (bf16)f2bf(o1); row[hh * 64 + 32 + j] = (bf16)f2bf(o2); } }
    }
}

constexpr int XS = 260;
constexpr int XSB = 264;
__device__ __forceinline__ void lru_a_unit(const Args& a, int l, int unit, LAS unsigned char* lds, int tid, int lane, int wave) {
    const int b = unit >> 6, c32 = unit & 63, t0 = c32 * 32; const size_t m0 = (size_t)b * SEQ + t0;
    LAS bf16* XCb = (LAS bf16*)(lds + RING_OFF);
    LAS float* AA = (LAS float*)(lds + RING_OFF + 32 * XSB * 2);
    LAS bf16* UUb = (LAS bf16*)(AA + 2 * 32 * XS);
    const bf16* PROJ = (const bf16*)(a.ws + WS_PROJ);
    const int n = wave >> 1, hh = wave & 1, li = lane & 15, g = lane >> 4;
    bf16x8 wfr[2][2][2][2];
#pragma unroll
    for (int dir = 0; dir < 2; ++dir)
#pragma unroll
        for (int gate = 0; gate < 2; ++gate) { const bf16* W = (const bf16*)(a.ws + WS_LRUW) + ((((size_t)l * 2 + dir) * 2 + gate) * 4 + n) * 4096;
#pragma unroll
            for (int nt = 0; nt < 2; ++nt)
#pragma unroll
                for (int ks = 0; ks < 2; ++ks) wfr[dir][gate][nt][ks] = *(const bf16x8*)(W + (32 * hh + 16 * nt + li) * 64 + 32 * ks + 8 * g); }
    float bav[2][2], bxv[2][2], lamv[2][2];
#pragma unroll
    for (int dir = 0; dir < 2; ++dir)
#pragma unroll
        for (int nt = 0; nt < 2; ++nt) { const size_t pi = ((size_t)l * 2 + dir) * 256 + 64 * n + 32 * hh + 16 * nt + li; bav[dir][nt] = a.in[I_BA][pi]; bxv[dir][nt] = a.in[I_BX][pi]; lamv[dir][nt] = a.in[I_LAM][pi]; }
    {
        const int ch2 = tid & 127, rg = tid >> 7, ch = 2 * ch2;
        float x0[11], x1[11];
#pragma unroll
        for (int i = 0; i < 11; ++i) { const int s = t0 + rg * 8 - 2 + i; unsigned v = 0u;
            if (s >= 0 && s < SEQ) v = *(const unsigned*)(PROJ + ((size_t)b * SEQ + s) * NPROJ + C_LX + ch);
            x0[i] = bflo(v); x1[i] = bfhi(v); }
        const float* cw = a.in[I_CW] + (size_t)l * 4 * 256; const float* cb = a.in[I_CB] + (size_t)l * 256;
        float w0[4], w1[4];
#pragma unroll
        for (int j = 0; j < 4; ++j) { w0[j] = cw[j * 256 + ch]; w1[j] = cw[j * 256 + ch + 1]; }
        const float b0 = cb[ch], b1 = cb[ch + 1];
#pragma unroll
        for (int r = 0; r < 8; ++r) { float y0 = b0, y1 = b1;
#pragma unroll
            for (int j = 0; j < 4; ++j) { y0 += x0[r + j] * w0[j]; y1 += x1[r + j] * w1[j]; }
            *(LAS unsigned*)(XCb + (rg * 8 + r) * XSB + ch) = pk2(y0, y1); }
    }
    WG_SYNC();
    bf16x8 af[2][2];
#pragma unroll
    for (int mt = 0; mt < 2; ++mt)
#pragma unroll
        for (int ks = 0; ks < 2; ++ks) af[mt][ks] = *(const LAS bf16x8*)(XCb + (16 * mt + li) * XSB + 64 * n + 32 * ks + 8 * g);
#pragma unroll
    for (int dir = 0; dir < 2; ++dir) {
        f32x4 accA[2][2], accX[2][2];
#pragma unroll
        for (int i = 0; i < 2; ++i)
#pragma unroll
            for (int j = 0; j < 2; ++j) { accA[i][j] = (f32x4){0.f, 0.f, 0.f, 0.f}; accX[i][j] = (f32x4){0.f, 0.f, 0.f, 0.f}; }
#pragma unroll
        for (int ks = 0; ks < 2; ++ks)
#pragma unroll
            for (int nt = 0; nt < 2; ++nt)
#pragma unroll
                for (int mt = 0; mt < 2; ++mt) { accA[mt][nt] = MFMA16(af[mt][ks], wfr[dir][0][nt][ks], accA[mt][nt]); accX[mt][nt] = MFMA16(af[mt][ks], wfr[dir][1][nt][ks], accX[mt][nt]); }
#pragma unroll
        for (int nt = 0; nt < 2; ++nt) { const int ch = 64 * n + 32 * hh + 16 * nt + li; const float lam = lamv[dir][nt];
            const float sp = fmaxf(-lam, 0.f) + log1pf(expf(-fabsf(lam)));
#pragma unroll
            for (int mt = 0; mt < 2; ++mt)
#pragma unroll
                for (int r = 0; r < 4; ++r) { const int t = 16 * mt + 4 * g + r;
                    const float rg_ = sigmoid_f(accA[mt][nt][r] + bav[dir][nt]), ig_ = sigmoid_f(accX[mt][nt][r] + bxv[dir][nt]);
                    const float la = -8.0f * rg_ * sp; const float av = fexp(la);
                    const float uv = __builtin_amdgcn_sqrtf(one_minus_exp(2.0f * la)) * (ig_ * bf2f(XCb[t * XSB + ch]));
                    AA[(dir * 32 + t) * XS + ch] = av; UUb[(dir * 32 + t) * XSB + ch] = (bf16)f2bf(uv); } }
    }
    WG_SYNC();
    { const int dir = tid >> 8, ch = tid & 255; float h = 0.f, cp = 1.f;
      bf16* lh = (bf16*)(a.ws + WS_LH) + ((size_t)dir * M + m0) * 256 + ch; bf16* cpo = (bf16*)(a.ws + WS_CP) + ((size_t)dir * M + m0) * 256 + ch;
      float av[32], uv[32];
#pragma unroll
      for (int q = 0; q < 32; ++q) { av[q] = AA[(dir * 32 + q) * XS + ch]; uv[q] = bf2f(UUb[(dir * 32 + q) * XSB + ch]); }
      if (dir == 0) {
#pragma unroll
          for (int q = 0; q < 32; ++q) { h = av[q] * h + uv[q]; cp *= av[q]; lh[(size_t)q * 256] = (bf16)f2bf(h); cpo[(size_t)q * 256] = (bf16)f2bf(cp); }
      } else {
#pragma unroll
          for (int q = 31; q >= 0; --q) { h = av[q] * h + uv[q]; cp *= av[q]; lh[(size_t)q * 256] = (bf16)f2bf(h); cpo[(size_t)q * 256] = (bf16)f2bf(cp); }
      }
      float* cr = (float*)(a.ws + WS_CARRY) + ((((size_t)dir * NB + b) * 64 + c32) * 2) * 256 + ch; cr[0] = cp; cr[256] = h; }
    WG_SYNC();
}

__device__ __forceinline__ void p4_rows_unit(const Args& a, int l, int unit, LAS unsigned char* lds, int tid, int lane, int wave) {
    const int b = unit >> 5, c0 = 2 * (unit & 31); const size_t m0 = (size_t)b * SEQ + c0 * 32;
    LAS float* CIN = (LAS float*)(lds + RING_OFF);
    const float* CARRY = (const float*)(a.ws + WS_CARRY);
    { const int dir = tid >> 8, ch = tid & 255; const float* cr = CARRY + (((size_t)dir * NB + b) * 64) * 512 + ch; float cin = 0.f;
      const int cs = dir ? c0 + 1 : c0;
      const int n = dir ? 63 - cs : cs;
      for (int base = 0; base < n; base += 16) { float P[16], Hh[16];
#pragma unroll
          for (int i = 0; i < 16; ++i) { const int q = base + i; const bool v = q < n; const int k = v ? (dir ? 63 - q : q) : cs;
              const float p = cr[(size_t)k * 512], h = cr[(size_t)k * 512 + 256]; P[i] = v ? p : 1.f; Hh[i] = v ? h : 0.f; }
#pragma unroll
          for (int i = 0; i < 16; ++i) cin = P[i] * cin + Hh[i]; }
      const float cin2 = cr[(size_t)cs * 512] * cin + cr[(size_t)cs * 512 + 256];
      CIN[((cs - c0) * 2 + dir) * 256 + ch] = cin; CIN[((1 - (cs - c0)) * 2 + dir) * 256 + ch] = cin2; }
    WG_SYNC();
    const bf16* LH = (const bf16*)(a.ws + WS_LH); const bf16* CPb = (const bf16*)(a.ws + WS_CP); const bf16* PROJ = (const bf16*)(a.ws + WS_PROJ); bf16* Y = (bf16*)(a.ws + WS_Y);
    const f32x4 og = *(const f32x4*)(a.in[I_LOG] + (size_t)l * 256 + 4 * lane);
    const float* gq = a.in[I_AOG] + (size_t)l * 512 + 8 * lane; const f32x4 g0 = *(const f32x4*)gq, g1 = *(const f32x4*)(gq + 4);
#pragma unroll
    for (int it = 0; it < 2; ++it) { const int tl = wave * 8 + it * 4;
        const LAS float* ci = CIN + (tl >> 5) * 512; const f32x4 cf = *(const LAS f32x4*)(ci + 4 * lane), cb = *(const LAS f32x4*)(ci + 256 + 4 * lane);
        v4u ya[4]; u32x2 lf[4], pf[4], lb[4], pb[4], gt[4];
#pragma unroll
        for (int r = 0; r < 4; ++r) { const size_t m = m0 + tl + r;
            ya[r] = *(const v4u*)(Y + m * DM + 8 * lane);
            lf[r] = *(const u32x2*)(LH + m * 256 + 4 * lane); pf[r] = *(const u32x2*)(CPb + m * 256 + 4 * lane);
            lb[r] = *(const u32x2*)(LH + ((size_t)M + m) * 256 + 4 * lane); pb[r] = *(const u32x2*)(CPb + ((size_t)M + m) * 256 + 4 * lane);
            gt[r] = *(const u32x2*)(PROJ + m * NPROJ + C_LG + 4 * lane); }
#pragma unroll
        for (int r = 0; r < 4; ++r) { const size_t m = m0 + tl + r;
            {
                const float x[8] = {bflo(ya[r].x), bfhi(ya[r].x), bflo(ya[r].y), bfhi(ya[r].y), bflo(ya[r].z), bfhi(ya[r].z), bflo(ya[r].w), bfhi(ya[r].w)}; float ss = 0.f;
#pragma unroll
                for (int i = 0; i < 8; ++i) ss += x[i] * x[i];
                const float rstd = frsq(wave_sum(ss) * (1.0f / 512.0f) + EPS);
                v4u o; o.x = pk2(x[0] * rstd * g0[0], x[1] * rstd * g0[1]); o.y = pk2(x[2] * rstd * g0[2], x[3] * rstd * g0[3]);
                o.z = pk2(x[4] * rstd * g1[0], x[5] * rstd * g1[1]); o.w = pk2(x[6] * rstd * g1[2], x[7] * rstd * g1[3]); *(v4u*)(Y + m * DM + 8 * lane) = o; }
            {
                f32x4 h;
                h[0] = (bflo(lf[r].x) + bflo(pf[r].x) * cf[0]) + (bflo(lb[r].x) + bflo(pb[r].x) * cb[0]);
                h[1] = (bfhi(lf[r].x) + bfhi(pf[r].x) * cf[1]) + (bfhi(lb[r].x) + bfhi(pb[r].x) * cb[1]);
                h[2] = (bflo(lf[r].y) + bflo(pf[r].y) * cf[2]) + (bflo(lb[r].y) + bflo(pb[r].y) * cb[2]);
                h[3] = (bfhi(lf[r].y) + bfhi(pf[r].y) * cf[3]) + (bfhi(lb[r].y) + bfhi(pb[r].y) * cb[3]);
                h[0] *= gelu_tanh_f(bflo(gt[r].x)); h[1] *= gelu_tanh_f(bfhi(gt[r].x)); h[2] *= gelu_tanh_f(bflo(gt[r].y)); h[3] *= gelu_tanh_f(bfhi(gt[r].y));
                const float ss = wave_sum((h[0] * h[0] + h[1] * h[1]) + (h[2] * h[2] + h[3] * h[3]));
                const float rstd = frsq(ss * (1.0f / 256.0f) + EPS);
                u32x2 o; o.x = pk2(h[0] * rstd * og[0], h[1] * rstd * og[1]); o.y = pk2(h[2] * rstd * og[2], h[3] * rstd * og[3]);
                *(u32x2*)(Y + m * DM + 512 + 4 * lane) = o; } } }
    WG_SYNC();
}

struct MlsGateRaw { float i_f, f_f, i_b, f_b; };
__device__ __forceinline__ MlsGateRaw mls_gates_load(const Args& a, int l, size_t m0, int hd, int tid) {
    MlsGateRaw r{0.f, 0.f, 0.f, 0.f};
    if (tid < 128) { const float* p = (const float*)(a.ws + WS_MG) + (m0 + tid) * 16; const float* fb = a.in[I_FB] + (size_t)l * 8;
        r.i_f = p[hd]; r.f_f = p[4 + hd] + fb[hd]; r.i_b = p[8 + hd]; r.f_b = p[12 + hd] + fb[4 + hd]; }
    return r;
}
__device__ __forceinline__ void mls_gates_store(const MlsGateRaw& r, LAS float* GL, int tid) {
    if (tid < 128) { GL[tid] = logsig_f(r.f_f); GL[128 + tid] = logsig_f(r.f_b); GL[256 + tid] = r.i_f; GL[384 + tid] = r.i_b; }
}
__device__ __forceinline__ void mls_gates_scan(LAS float* GL, int wave, int lane) {
    if (wave == 0) wave_scan128<false, false>(GL, GL + 512, lane);
    else if (wave == 1) wave_scan128<false, true>(GL + 128, GL + 640, lane);
}
constexpr int TS = 136;
constexpr int QS_ = 72;

__device__ __forceinline__ void mls_a_unit(const Args& a, int l, int unit, LAS unsigned char* lds, int tid, int lane, int wave) {
    const int c = unit & 15, hd = (unit >> 4) & 3, b = unit >> 6; const size_t m0 = (size_t)b * SEQ + c * 128;
    LAS float* GL = (LAS float*)(lds + RING_OFF);
    LAS float* WW = GL + 768;
    LAS bf16* VT = (LAS bf16*)(lds + RING_OFF + 4096); LAS bf16* KF = VT + 64 * TS; LAS bf16* KB = KF + 64 * TS;
    const MlsGateRaw graw = mls_gates_load(a, l, m0, hd, tid);
    const int j = tid & 127, part = tid >> 7; const bf16* PROJ = (const bf16*)(a.ws + WS_PROJ);
    const bf16* kp = PROJ + (m0 + j) * NPROJ + C_MK + hd * 64 + 16 * part; const bf16* vp = PROJ + (m0 + j) * NPROJ + C_MV + hd * 64 + 16 * part;
    const v4u k0 = *(const v4u*)kp, k1 = *(const v4u*)(kp + 8), v0 = *(const v4u*)vp, v1 = *(const v4u*)(vp + 8);
    mls_gates_store(graw, GL, tid);
    WG_SYNC();
    float* MLOC = (float*)(a.ws + WS_MLOC); float* NLOC = (float*)(a.ws + WS_NLOC); float* CLOC = (float*)(a.ws + WS_CLOC);
    const size_t sbase = ((size_t)b * 4 + hd) * 2;
    mls_gates_scan(GL, wave, lane);
    if (wave < 2) { WAVE_LDS_FENCE(); const int dir = wave; const float gtot = dir ? GL[640] : GL[512 + 127]; const LAS float* Bc = GL + 512 + 128 * dir; const LAS float* IG = GL + 256 + 128 * dir;
        const float lw0 = gtot - Bc[lane] + IG[lane], lw1 = gtot - Bc[lane + 64] + IG[lane + 64];
        const float mx = wave_max(fmaxf(lw0, lw1));
        WW[dir * 128 + lane] = fexp(lw0 - mx); WW[dir * 128 + lane + 64] = fexp(lw1 - mx);
        if (lane == 0) { float* o = MLOC + ((sbase + dir) * 16 + c) * 2; o[0] = mx; o[1] = gtot; } }
    WG_SYNC();
    { const float wf = WW[j] * 0.125f, wb = WW[128 + j] * 0.125f;
      const unsigned kk[8] = {k0.x, k0.y, k0.z, k0.w, k1.x, k1.y, k1.z, k1.w}; const unsigned vv[8] = {v0.x, v0.y, v0.z, v0.w, v1.x, v1.y, v1.z, v1.w};
#pragma unroll
      for (int q = 0; q < 8; ++q) { const int e0 = 16 * part + 2 * q; const float ka = bflo(kk[q]), kb = bfhi(kk[q]);
          KF[e0 * TS + j] = (bf16)f2bf(ka * wf); KF[(e0 + 1) * TS + j] = (bf16)f2bf(kb * wf);
          KB[e0 * TS + j] = (bf16)f2bf(ka * wb); KB[(e0 + 1) * TS + j] = (bf16)f2bf(kb * wb);
          VT[e0 * TS + j] = (bf16)(vv[q] & 0xffffu); VT[(e0 + 1) * TS + j] = (bf16)(vv[q] >> 16); } }
    WG_SYNC();
    if (tid < 128) { const int dir = tid >> 6, e = tid & 63; const LAS bf16* kr = (dir ? KB : KF) + e * TS; float s = 0.f;
#pragma unroll
        for (int q = 0; q < 16; ++q) { const v4u w = *(const LAS v4u*)(kr + 8 * q); s += ((bflo(w.x) + bfhi(w.x)) + (bflo(w.y) + bfhi(w.y))) + ((bflo(w.z) + bfhi(w.z)) + (bflo(w.w) + bfhi(w.w))); }
        NLOC[((sbase + dir) * 16 + c) * 64 + e] = s; }
    { const int dir = wave >> 2, mt = wave & 3, li = lane & 15, g = lane >> 4; const LAS bf16* KD = dir ? KB : KF;
      f32x4 acc[4];
#pragma unroll
      for (int nt = 0; nt < 4; ++nt) acc[nt] = (f32x4){0.f, 0.f, 0.f, 0.f};
#pragma unroll
      for (int ks = 0; ks < 4; ++ks) { const bf16x8 af = *(const LAS bf16x8*)(VT + (16 * mt + li) * TS + 32 * ks + 8 * g);
#pragma unroll
          for (int nt = 0; nt < 4; ++nt) { const bf16x8 bfv = *(const LAS bf16x8*)(KD + (16 * nt + li) * TS + 32 * ks + 8 * g); acc[nt] = MFMA16(af, bfv, acc[nt]); } }
      float* co = CLOC + ((sbase + dir) * 16 + c) * 4096;
#pragma unroll
      for (int nt = 0; nt < 4; ++nt)
#pragma unroll
          for (int r = 0; r < 4; ++r) co[(16 * mt + 4 * g + r) * 64 + 16 * nt + li] = acc[nt][r]; }
    WG_SYNC();
}

__device__ __forceinline__ void mls_scan_unit(const Args& a, int unit, LAS unsigned char* lds, int tid, int lane, int wave) {
    const int qtr = unit & 3, bhd = unit >> 2, dir = bhd & 1;
    LAS float* SM = (LAS float*)(lds + RING_OFF);
    const float* CLOC = (const float*)(a.ws + WS_CLOC) + (size_t)bhd * 16 * 4096 + 1024 * qtr + 2 * tid;
    const float* NLOC = (const float*)(a.ws + WS_NLOC) + (size_t)bhd * 16 * 64;
    typedef float f32x2 __attribute__((ext_vector_type(2)));
    f32x2 cl[16]; float nl[16];
#pragma unroll
    for (int k = 0; k < 16; ++k) cl[k] = *(const f32x2*)(CLOC + (size_t)k * 4096);
    const bool do_n = (qtr == 0) && (tid < 64);
#pragma unroll
    for (int k = 0; k < 16; ++k) nl[k] = do_n ? NLOC[k * 64 + tid] : 0.f;
    if (tid < 32) SM[tid] = ((const float*)(a.ws + WS_MLOC))[(size_t)bhd * 32 + tid];
    WG_SYNC();
    bf16* CP = (bf16*)(a.ws + WS_CPREV) + (size_t)bhd * 16 * 4096 + 1024 * qtr + 2 * tid;
    float* NP = (float*)(a.ws + WS_NPREV) + (size_t)bhd * 16 * 64; float* MP = (float*)(a.ws + WS_MPREV) + (size_t)bhd * 16;
    float m = 0.f; f32x2 C = (f32x2){0.f, 0.f}; float n = 0.f;
#pragma unroll
    for (int q = 0; q < 16; ++q) { const int k = dir ? 15 - q : q;
        *(unsigned*)(CP + (size_t)k * 4096) = pk2(C[0], C[1]);
        if (do_n) NP[k * 64 + tid] = n;
        if (qtr == 0 && tid == 64) MP[k] = m;
        const float mlk = SM[2 * k], gk = SM[2 * k + 1]; const float mn = fmaxf(gk + m, mlk); const float fa = fexp(gk + m - mn), fb = fexp(mlk - mn);
        C = fa * C + fb * (dir ? cl[15 - q] : cl[q]); n = fa * n + fb * (dir ? nl[15 - q] : nl[q]); m = mn; }
    WG_SYNC();
}

template <int DIR>
__device__ __forceinline__ void mls_dir(f32x4 (&hacc)[4], const LAS bf16* QS, const LAS bf16* KS, const LAS bf16* VT, const LAS bf16* CP, const LAS float* AJ, const LAS float* MM,
                                        const LAS float* INTER, const LAS float* FLOOR, const LAS float* NP, LAS float* rowbuf, int w, int lane) {
    const int li = lane & 15, g = lane >> 4, i = 16 * w + li;
    bf16x8 qf[2];
#pragma unroll
    for (int ks = 0; ks < 2; ++ks) qf[ks] = *(const LAS bf16x8*)(QS + i * QS_ + 32 * ks + 8 * g);
    const float mmi = MM[i];
    float den = 0.f;
    f32x4 out[4];
#pragma unroll
    for (int dt = 0; dt < 4; ++dt) out[dt] = (f32x4){0.f, 0.f, 0.f, 0.f};
#pragma unroll
    for (int kp = 0; kp < 4; ++kp) {
        const bool need = (DIR == 0) ? (2 * kp <= w) : (2 * kp + 1 >= w);
        if (need) {
            f32x4 s0 = (f32x4){0.f, 0.f, 0.f, 0.f}, s1 = (f32x4){0.f, 0.f, 0.f, 0.f};
#pragma unroll
            for (int ks = 0; ks < 2; ++ks) { const bf16x8 k0 = *(const LAS bf16x8*)(KS + (32 * kp + li) * QS_ + 32 * ks + 8 * g), k1 = *(const LAS bf16x8*)(KS + (32 * kp + 16 + li) * QS_ + 32 * ks + 8 * g);
                s0 = MFMA16(k0, qf[ks], s0); s1 = MFMA16(k1, qf[ks], s1); }
            float p[8];
#pragma unroll
            for (int r = 0; r < 4; ++r) { const int j0 = 32 * kp + 4 * g + r, j1 = j0 + 16;
                const bool v0 = (DIR == 0) ? (j0 <= i) : (j0 >= i), v1 = (DIR == 0) ? (j1 <= i) : (j1 >= i);
                const float a0 = v0 ? (AJ[j0] - mmi) : -INFINITY, a1 = v1 ? (AJ[j1] - mmi) : -INFINITY;
                p[r] = s0[r] * 0.125f * fexp(a0); p[4 + r] = s1[r] * 0.125f * fexp(a1); den += p[r] + p[4 + r]; }
            v4u pk; pk.x = pk2(p[0], p[1]); pk.y = pk2(p[2], p[3]); pk.z = pk2(p[4], p[5]); pk.w = pk2(p[6], p[7]);
            const bf16x8 pf = __builtin_bit_cast(bf16x8, pk);
#pragma unroll
            for (int dt = 0; dt < 4; ++dt) { const LAS bf16* vr = VT + (16 * dt + li) * TS + 32 * kp + 4 * g;
                const u32x2 lo = *(const LAS u32x2*)vr, hi = *(const LAS u32x2*)(vr + 16);
                v4u vk; vk.x = lo.x; vk.y = lo.y; vk.z = hi.x; vk.w = hi.y;
                out[dt] = MFMA16(pf, __builtin_bit_cast(bf16x8, vk), out[dt]); }
        }
    }
    f32x4 qc[4];
#pragma unroll
    for (int dt = 0; dt < 4; ++dt) { qc[dt] = (f32x4){0.f, 0.f, 0.f, 0.f};
#pragma unroll
        for (int ks = 0; ks < 2; ++ks) { const bf16x8 cf = *(const LAS bf16x8*)(CP + (16 * dt + li) * QS_ + 32 * ks + 8 * g); qc[dt] = MFMA16(qf[ks], cf, qc[dt]); } }
    float nq = 0.f;
#pragma unroll
    for (int q = 0; q < 16; ++q) nq += NP[16 * g + q] * bf2f(QS[i * QS_ + 16 * g + q]);
    den = xor32_sum(xor16_sum(den)); nq = xor32_sum(xor16_sum(nq));
    const float inter = INTER[i]; const float dn = fmaxf(fabsf(den + inter * nq), FLOOR[i]);
    asm volatile("s_waitcnt lgkmcnt(0)" ::: "memory");
    if (g == 0) { rowbuf[li] = inter; rowbuf[16 + li] = frcp(dn); }
    asm volatile("s_waitcnt lgkmcnt(0)" ::: "memory");
#pragma unroll
    for (int r = 0; r < 4; ++r) { const float it = rowbuf[4 * g + r], inv = rowbuf[16 + 4 * g + r];
#pragma unroll
        for (int dt = 0; dt < 4; ++dt) hacc[dt][r] += (out[dt][r] + it * qc[dt][r]) * inv; }
    asm volatile("s_waitcnt lgkmcnt(0)" ::: "memory");
}
__device__ __forceinline__ void mls_b_unit(const Args& a, int l, int unit, LAS unsigned char* lds, int tid, int lane, int wave) {
    const int c = unit & 15, hd = (unit >> 4) & 3, b = unit >> 6; const size_t m0 = (size_t)b * SEQ + c * 128;
    LAS float* GL = (LAS float*)(lds + RING_OFF);
    LAS float* AJ = GL + 768;
    LAS float* MMx = AJ + 256;
    LAS float* INT_ = MMx + 256;
    LAS float* FLR = INT_ + 256;
    LAS float* NP = FLR + 256;
    LAS float* COEF = NP + 128;
    LAS float* ROWB = COEF + 32;
    LAS bf16* QS = (LAS bf16*)(lds + RING_OFF + 16384); LAS bf16* KS = QS + 128 * QS_; LAS bf16* VT = KS + 128 * QS_; LAS bf16* CF = VT + 64 * TS; LAS bf16* CB = CF + 64 * QS_;
    const size_t sbase = ((size_t)b * 4 + hd) * 2;
    const MlsGateRaw graw = mls_gates_load(a, l, m0, hd, tid);
    const float mprev = ((const float*)(a.ws + WS_MPREV))[(sbase + (wave & 1)) * 16 + c];
    const bf16* PROJ = (const bf16*)(a.ws + WS_PROJ);
    const int sj = tid >> 2, q4 = tid & 3; const bf16* rp = PROJ + (m0 + sj) * NPROJ + hd * 64 + 16 * q4;
    const v4u q0 = *(const v4u*)(rp + C_MQ), q1 = *(const v4u*)(rp + C_MQ + 8), k0 = *(const v4u*)(rp + C_MK), k1 = *(const v4u*)(rp + C_MK + 8), v0 = *(const v4u*)(rp + C_MV), v1 = *(const v4u*)(rp + C_MV + 8);
    const int idx = tid * 8; const bf16* CPV = (const bf16*)(a.ws + WS_CPREV);
    const v4u cfv = *(const v4u*)(CPV + ((sbase + 0) * 16 + c) * 4096 + idx), cbv = *(const v4u*)(CPV + ((sbase + 1) * 16 + c) * 4096 + idx);
    float npv = 0.f; if (tid < 128) npv = ((const float*)(a.ws + WS_NPREV))[((sbase + (tid >> 6)) * 16 + c) * 64 + (tid & 63)];
    const int li_ = lane & 15, g_ = lane >> 4; const float* hg = a.in[I_MNG] + ((size_t)l * 4 + hd) * 64;
    unsigned short ogv[4][4]; float hgv[4];
#pragma unroll
    for (int dt = 0; dt < 4; ++dt) { hgv[dt] = hg[16 * dt + li_];
#pragma unroll
        for (int r = 0; r < 4; ++r) ogv[r][dt] = PROJ[(m0 + 16 * wave + 4 * g_ + r) * NPROJ + C_MO + hd * 64 + 16 * dt + li_]; }
    mls_gates_store(graw, GL, tid);
    *(LAS v4u*)(QS + sj * QS_ + 16 * q4) = q0; *(LAS v4u*)(QS + sj * QS_ + 16 * q4 + 8) = q1;
    *(LAS v4u*)(KS + sj * QS_ + 16 * q4) = k0; *(LAS v4u*)(KS + sj * QS_ + 16 * q4 + 8) = k1;
    { const unsigned vv[8] = {v0.x, v0.y, v0.z, v0.w, v1.x, v1.y, v1.z, v1.w};
#pragma unroll
      for (int q = 0; q < 8; ++q) { const int d0 = 16 * q4 + 2 * q; VT[d0 * TS + sj] = (bf16)(vv[q] & 0xffffu); VT[(d0 + 1) * TS + sj] = (bf16)(vv[q] >> 16); } }
    *(LAS v4u*)(CF + (idx >> 6) * QS_ + (idx & 63)) = cfv; *(LAS v4u*)(CB + (idx >> 6) * QS_ + (idx & 63)) = cbv;
    if (tid < 128) NP[tid] = npv;
    WG_SYNC();
    mls_gates_scan(GL, wave, lane);
    if (wave < 2) {
        WAVE_LDS_FENCE();
        const int dir = wave; const float m = mprev;
        const LAS float* IG = GL + 256 + 128 * dir; const LAS float* Bc = GL + 512 + 128 * dir;
        LAS float* aj = AJ + 128 * dir; LAS float* mmx = MMx + 128 * dir;
        aj[lane] = IG[lane] - Bc[lane]; aj[lane + 64] = IG[lane + 64] - Bc[lane + 64];
        WAVE_LDS_FENCE();
        if (dir == 0) wave_scan128<true, false>(aj, mmx, lane); else wave_scan128<true, true>(aj, mmx, lane);
        WAVE_LDS_FENCE();
#pragma unroll
        for (int q = 0; q < 2; ++q) { const int j = lane + 64 * q; const float mm = fmaxf(mmx[j], m);
            mmx[j] = mm; INT_[128 * dir + j] = fexp(m - mm); FLR[128 * dir + j] = fexp(-(Bc[j] + mm)); }
    }
    WG_SYNC();
    f32x4 hacc[4];
#pragma unroll
    for (int dt = 0; dt < 4; ++dt) hacc[dt] = (f32x4){0.f, 0.f, 0.f, 0.f};
    mls_dir<0>(hacc, QS, KS, VT, CF, AJ, MMx, INT_, FLR, NP, ROWB + wave * 32, wave, lane);
    mls_dir<1>(hacc, QS, KS, VT, CB, AJ + 128, MMx + 128, INT_ + 128, FLR + 128, NP + 64, ROWB + wave * 32, wave, lane);
    {
        bf16* Y = (bf16*)(a.ws + WS_Y);
#pragma unroll
        for (int r = 0; r < 4; ++r) { float ss = (hacc[0][r] * hacc[0][r] + hacc[1][r] * hacc[1][r]) + (hacc[2][r] * hacc[2][r] + hacc[3][r] * hacc[3][r]);
            ss = row16_sum(ss);
            const float rstd = frsq(ss * (1.0f / 64.0f) + EPS); const size_t m = m0 + 16 * wave + 4 * g_ + r;
#pragma unroll
            for (int dt = 0; dt < 4; ++dt) Y[m * DM + 768 + hd * 64 + 16 * dt + li_] = (bf16)f2bf(hacc[dt][r] * rstd * hgv[dt] * sigmoid_f(bf2f(ogv[r][dt]))); }
    }
    WG_SYNC();
}

__device__ __forceinline__ void attnorm_pass(const Args& a, int l, int lane, int wave, int G, int bid, bf16* DST) {
    bf16* Y = (bf16*)(a.ws + WS_Y); const float* gq = a.in[I_AOG] + (size_t)l * 512 + 8 * lane;
    const f32x4 g0 = *(const f32x4*)gq, g1 = *(const f32x4*)(gq + 4);
    const int gw = bid * NWAVES + wave, NGW = G * NWAVES;
    for (int mb = 4 * gw; mb < M; mb += 4 * NGW) { v4u q[4];
#pragma unroll
        for (int r = 0; r < 4; ++r) q[r] = *(const v4u*)(Y + (size_t)(mb + r) * DM + 8 * lane);
        float ss[4];
#pragma unroll
        for (int r = 0; r < 4; ++r) { const float x[8] = {bflo(q[r].x), bfhi(q[r].x), bflo(q[r].y), bfhi(q[r].y), bflo(q[r].z), bfhi(q[r].z), bflo(q[r].w), bfhi(q[r].w)}; float a = 0.f;
#pragma unroll
            for (int i = 0; i < 8; ++i) a += x[i] * x[i];
            ss[r] = a; }
#pragma unroll
        for (int r = 0; r < 4; ++r) ss[r] = wave_sum(ss[r]);
#pragma unroll
        for (int r = 0; r < 4; ++r) { const float rstd = frsq(ss[r] * (1.0f / 512.0f) + EPS);
            const float x[8] = {bflo(q[r].x), bfhi(q[r].x), bflo(q[r].y), bfhi(q[r].y), bflo(q[r].z), bfhi(q[r].z), bflo(q[r].w), bfhi(q[r].w)};
            v4u o; o.x = pk2(x[0] * rstd * g0[0], x[1] * rstd * g0[1]); o.y = pk2(x[2] * rstd * g0[2], x[3] * rstd * g0[3]);
            o.z = pk2(x[4] * rstd * g1[0], x[5] * rstd * g1[1]); o.w = pk2(x[6] * rstd * g1[2], x[7] * rstd * g1[3]); *(v4u*)(DST + (size_t)(mb + r) * DM + 8 * lane) = o; } }
}

__device__ __forceinline__ unsigned mbcnt64(unsigned long long m) { return __builtin_amdgcn_mbcnt_hi((unsigned)(m >> 32), __builtin_amdgcn_mbcnt_lo((unsigned)m, 0u)); }
__device__ __forceinline__ void topk_item(const Args& a, int item, LAS unsigned char* lds, int tid, int lane, int wave) {
    const int unit = item & 127, half = item >> 7, b = unit >> 4, e = unit & 15;
    LAS unsigned* CNT = (LAS unsigned*)(lds + RING_OFF);
    LAS unsigned* SEG = CNT + 16;
    LAS int* TOK = (LAS int*)(SEG + 64);
    LAS float* GV = (LAS float*)(TOK + 256);
    const float* aff = (const float*)(a.ws + WS_AFF) + ((size_t)b * NE + e) * SEQ;
    float av[4]; unsigned key[4];
#pragma unroll
    for (int q = 0; q < 4; ++q) av[q] = aff[tid + q * NTHR];
#pragma unroll
    for (int q = 0; q < 4; ++q) key[q] = __float_as_uint(av[q]);
    unsigned lo = 0u, hi = 0x7F800000u; int par = 0;
    while (hi - lo > 1u) { const unsigned mid = lo + ((hi - lo) >> 1);
        unsigned c = 0u;
#pragma unroll
        for (int q = 0; q < 4; ++q) c += (unsigned)__popcll(__ballot(key[q] >= mid));
        if (lane == 0) CNT[par * 8 + wave] = c;
        WG_SYNC();
        const v4u c0 = *(const LAS v4u*)(CNT + par * 8), c1 = *(const LAS v4u*)(CNT + par * 8 + 4);
        const unsigned tot = (c0.x + c0.y) + (c0.z + c0.w) + (c1.x + c1.y) + (c1.z + c1.w);
        if (tot >= (unsigned)CAP) lo = mid; else hi = mid;
        par ^= 1; }
    const unsigned T = lo;
    unsigned long long mgt[4], meq[4];
#pragma unroll
    for (int q = 0; q < 4; ++q) { mgt[q] = __ballot(key[q] > T); meq[q] = __ballot(key[q] == T);
        if (lane == 0) { SEG[q * 8 + wave] = (unsigned)__popcll(mgt[q]); SEG[32 + q * 8 + wave] = (unsigned)__popcll(meq[q]); } }
    WG_SYNC();
    unsigned ngt = 0u;
#pragma unroll
    for (int g = 0; g < 32; ++g) ngt += SEG[g];
    const unsigned need = (unsigned)CAP - ngt;
    unsigned eqb = 0u, selb = 0u, my_eqb[4], my_selb[4];
#pragma unroll
    for (int g = 0; g < 32; ++g) { if ((g & 7) == wave) { my_eqb[g >> 3] = eqb; my_selb[g >> 3] = selb; }
        const unsigned cg = SEG[g], ce = SEG[32 + g]; const unsigned room = need > eqb ? need - eqb : 0u; selb += cg + (room < ce ? room : ce); eqb += ce; }
    int* SEL = (int*)(a.ws + WS_SEL);
#pragma unroll
    for (int q = 0; q < 4; ++q) { const bool gt = key[q] > T, eq = key[q] == T;
        const bool sel = gt || (eq && (my_eqb[q] + mbcnt64(meq[q])) < need);
        const unsigned long long ms = __ballot(sel); const int slot = (int)(my_selb[q] + mbcnt64(ms)); const int sidx = tid + q * NTHR;
        if (sel) { TOK[slot] = sidx; GV[slot] = av[q]; }
        if ((q >> 1) == half) SEL[((size_t)b * SEQ + sidx) * NE + e] = sel ? slot : -1; }
    WG_SYNC();
    int* IDX = (int*)(a.ws + WS_IDX); float* GATE = (float*)(a.ws + WS_GATE);
    if (tid < 128) { const int t = half * 128 + tid; IDX[e * NSLOT + b * CAP + t] = b * SEQ + TOK[t]; GATE[e * NSLOT + b * CAP + t] = GV[t]; }
    const unsigned char* H8 = a.ws + WS_H; unsigned char* XG8 = a.ws + WS_XG;
    { v4u r0[16];
#pragma unroll
      for (int q = 0; q < 16; ++q) { const int t = half * 128 + wave * 16 + q; r0[q] = *((const v4u*)(H8 + ((size_t)b * SEQ + TOK[t]) * DM) + lane); }
#pragma unroll
      for (int q = 0; q < 16; ++q) { const int t = half * 128 + wave * 16 + q; *((v4u*)(XG8 + ((size_t)e * NSLOT + b * CAP + t) * DM) + lane) = r0[q]; } }
    WG_SYNC();
}

#ifndef MK_PER_PHASE
#define MK_PER_PHASE 0
#endif
__global__ void __launch_bounds__(NTHR, 2) hybrid_fwd(Args args) {
    extern __shared__ __attribute__((aligned(16))) unsigned char lds_raw[];
    LAS unsigned char* lds = (LAS unsigned char*)lds_raw;
    volatile LAS unsigned* MISC = (volatile LAS unsigned*)(lds + MISC_OFF);
    const int tid0 = threadIdx.x, G = gridDim.x;
    unsigned char* ws = args.ws;
#define PHASE_IDS() const int tid = ltid(), lane = tid & 63, wave = __builtin_amdgcn_readfirstlane(tid >> 6), bid = lbid(); (void)lane; (void)wave; (void)bid
    gu32* ctl = (gu32*)(ws + WS_CTL);
    for (int u = tid0; u < (LDS_BYTES - MISC_OFF) / 4; u += NTHR) ((LAS unsigned*)(lds + MISC_OFF))[u] = 0u;
    __syncthreads();
    XcdBarrier bar; bar.bar = (unsigned*)(ctl + CW_BAR); bar.x = 0; bar.st = nullptr;
    if (!MK_PER_PHASE) bar = xcd_barrier_post((unsigned*)(ctl + CW_BAR), MISC + 8);
#define GRID_BAR() do { if (!MK_PER_PHASE) { xcd_barrier(bar); if (REP_MASK & (1 << 11)) xcd_barrier(bar); } } while (0)
    const int lo = args.ph_lo, hi = args.ph_hi;
#ifndef PT_MASK
#define PT_MASK 0x7ff
#endif
#define PT_ON(j) (((PT_MASK) >> (j)) & 1)
#ifndef REP_MASK
#define REP_MASK 0
#endif
#define REPS(j) for (int rep_ = 0; rep_ < 1 + (((REP_MASK) >> (j)) & 1); ++rep_)
#define IN(k) (lo <= (k) && (k) < hi)
#define BOTH(k) (IN(k) && IN((k) + 1))

    bf16* Hb = (bf16*)(ws + WS_H); bf16* PROJ = (bf16*)(ws + WS_PROJ); bf16* Yb = (bf16*)(ws + WS_Y);
    float* MG = (float*)(ws + WS_MG); float* AFF = (float*)(ws + WS_AFF); int* SEL = (int*)(ws + WS_SEL);
    bf16* XG = (bf16*)(ws + WS_XG); bf16* HID = (bf16*)(ws + WS_HID); bf16* YE = (bf16*)(ws + WS_YE); bf16* XB = (bf16*)(ws + WS_XB);

    if (PT_ON(0) && IN(0)) { PHASE_IDS();
        REPS(0) p0_weights(args, lds, tid, lane, wave, G, bid);
        WG_SYNC();
        REPS(16) row_pass<0, false>(args.in[I_X], nullptr, args.in[I_N1G], args.in[I_WIN] + NPROJ, DIN, Hb, MG, nullptr, nullptr, lds, tid, lane, wave, G, bid);
        if (BOTH(0)) GRID_BAR();
    }
    for (int l = 0; l < DEPTH; ++l) {
        const int pb = 1 + 10 * l;
        if (PT_ON(1) && IN(pb + 0)) { PHASE_IDS();
            pg8::Gemm g{Hb, (const bf16*)(ws + WS_WIN) + (size_t)l * NPROJ * DM, M, NPROJ, DM}; pg8::StaticOrder S; S.init(M, NPROJ - 256, G, bid);
            pg8::EpiBf16<0> E{PROJ, NPROJ, nullptr, 0, 0, 1.f};
            REPS(1) pg8::gemm_phase<pg8::EpiBf16<0>, pg8::StaticOrder, true, true>(lds + RING_OFF, g, S, E);
            if (BOTH(pb + 0)) GRID_BAR();
        }
        if (PT_ON(2) && IN(pb + 1)) { PHASE_IDS();
            const bool split = (G == 256);
            if (bid < 64 || !split) { pg8::Gemm g{Hb, (const bf16*)(ws + WS_WIN) + (size_t)l * NPROJ * DM, M, NPROJ, DM}; pg8::TailOrder S{G, bid, 8}; pg8::EpiBf16<0> E{PROJ, NPROJ, nullptr, 0, 0, 1.f};
                pg8::gemm_phase<pg8::EpiBf16<0>, pg8::TailOrder, false, true>(lds + RING_OFF, g, S, E); WG_SYNC(); }
            if (!split) rope_pass(args, l, lane, wave, G, bid, PROJ);
            else if (bid >= 64) rope_pass(args, l, lane, wave, 192, bid - 64, PROJ);
            REPS(2) for (int u = bid; u < 512; u += G) lru_a_unit(args, l, u, lds, tid, lane, wave);
            REPS(3) for (int u = bid; u < 512; u += G) mls_a_unit(args, l, u, lds, tid, lane, wave);
            if (BOTH(pb + 1)) GRID_BAR();
        }
        if (PT_ON(3) && IN(pb + 2)) { PHASE_IDS();
            const attn_body::AttnTensors AT{(const attn_body::bf16*)(PROJ + C_Q), (const attn_body::bf16*)(PROJ + C_K), (const attn_body::bf16*)(PROJ + C_V), (attn_body::bf16*)Yb};
            const attn_body::StaticOrder S(G, bid);
#ifndef P3_PARTS
#define P3_PARTS 7
#endif
            for (int u = bid; u < 256; u += G) mls_scan_unit(args, u, lds, tid, lane, wave);
            WG_SYNC();
            REPS(4) attn_body::attn_phase<attn_body::StaticOrder>((char*)lds_raw + RING_OFF, AT, S);
            if (BOTH(pb + 2)) GRID_BAR();
        }
        if (PT_ON(4) && IN(pb + 3)) { PHASE_IDS();
            REPS(5) for (int u = bid; u < 512; u += G) mls_b_unit(args, l, u, lds, tid, lane, wave);
            for (int u = bid; u < 256; u += G) p4_rows_unit(args, l, u, lds, tid, lane, wave);
            if (BOTH(pb + 3)) GRID_BAR();
        }
        if (PT_ON(5) && IN(pb + 4)) { PHASE_IDS();
            pg8::Gemm g{Yb, (const bf16*)(ws + WS_WOUT) + (size_t)l * DM * DM, M, DM, DM}; pg8::StaticOrder S; S.init(M, DM, G, bid);
            pg8::EpiResid E{l == 0 ? args.in[I_X] : nullptr, XB, XB, DM};
            if (REP_MASK & (1 << 14)) { pg8::EpiResid E2{l == 0 ? args.in[I_X] : nullptr, XB, HID, DM}; pg8::gemm_phase<pg8::EpiResid, pg8::StaticOrder, false, true>(lds + RING_OFF, g, S, E2); }
            pg8::gemm_phase<pg8::EpiResid, pg8::StaticOrder, false, true>(lds + RING_OFF, g, S, E);
            if (BOTH(pb + 4)) GRID_BAR();
        }
        if (PT_ON(6) && IN(pb + 5)) { PHASE_IDS();
            REPS(7) row_pass<1, true>(XB, nullptr, args.in[I_N2G] + (size_t)l * DM, args.in[I_WR] + (size_t)l * DM * NE, NE, Hb, AFF, nullptr, nullptr, lds, tid, lane, wave, G, bid);
            if (BOTH(pb + 5)) GRID_BAR();
        }
        if (PT_ON(7) && IN(pb + 6)) { PHASE_IDS(); REPS(8) for (int it = bid; it < 256; it += G) topk_item(args, it, lds, tid, lane, wave); if (BOTH(pb + 6)) GRID_BAR(); }
        if (PT_ON(8) && IN(pb + 7)) { PHASE_IDS();
            pg8::Gemm g{XG, (const bf16*)(ws + WS_WGU + (size_t)l * NE * 4096 * DM), NE * NSLOT, NE * 4096, DM / 2}; pg8::Moe1Order S{G, bid};
            pg8::EpiSwiGLU E{(unsigned char*)HID, DE};
            if (REP_MASK & (1 << 17)) { pg8::EpiNull E0; pg8::gemm_phase<pg8::EpiNull, pg8::Moe1Order, true, true, true>(lds + RING_OFF, g, S, E0); }
            REPS(9) pg8::gemm_phase<pg8::EpiSwiGLU, pg8::Moe1Order, true, true, true>(lds + RING_OFF, g, S, E);
            if (BOTH(pb + 7)) GRID_BAR();
        }
        if (PT_ON(9) && IN(pb + 8)) { PHASE_IDS();
            pg8::Gemm g{HID, (const bf16*)(ws + WS_WDN + (size_t)l * NE * DM * DE), NE * NSLOT, NE * DM, DE / 2}; pg8::Moe2Order S{G, bid};
            pg8::EpiScaleBf16 E{YE, DM, (const float*)(ws + WS_GATE)};
            REPS(10) pg8::gemm_phase<pg8::EpiScaleBf16, pg8::Moe2Order, true, true, true>(lds + RING_OFF, g, S, E);
            if (BOTH(pb + 8)) GRID_BAR();
        }
        if (PT_ON(10) && IN(pb + 9)) { PHASE_IDS();
            if (REP_MASK & (1 << 15)) { if (l + 1 < DEPTH) row_pass<2, true>(XB, HID, args.in[I_N1G] + (size_t)(l + 1) * DM, args.in[I_WIN] + (size_t)(l + 1) * DM * DIN + NPROJ, DIN, Hb, MG, SEL, YE, lds, tid, lane, wave, G, bid); else row_pass<3, true>(XB, HID, nullptr, nullptr, 0, nullptr, nullptr, SEL, YE, lds, tid, lane, wave, G, bid); WG_SYNC(); }
            if (l + 1 < DEPTH) row_pass<2, true>(XB, XB, args.in[I_N1G] + (size_t)(l + 1) * DM, args.in[I_WIN] + (size_t)(l + 1) * DM * DIN + NPROJ, DIN, Hb, MG, SEL, YE, lds, tid, lane, wave, G, bid);
            else row_pass<3, true>(XB, args.out, nullptr, nullptr, 0, nullptr, nullptr, SEL, YE, lds, tid, lane, wave, G, bid);
            if (BOTH(pb + 9)) GRID_BAR();
        }
    }
#undef IN
#undef BOTH
#undef GRID_BAR
}

extern "C" void kernel_launch(void* const* d_in, const int* in_sizes, int n_in, void* d_out, int out_size, void* d_ws, size_t ws_size, hipStream_t stream) {
    static int grid = 0;
    if (grid == 0) {
        if (n_in != 22 || in_sizes[0] != M * DM || out_size != M * DM || ws_size < WS_END) { fprintf(stderr, "kernel_launch: unexpected shapes (n_in %d, in0 %d, out %d, ws %zu); nothing launched\n", n_in, n_in > 0 ? in_sizes[0] : -1, out_size, ws_size); grid = -1; return; }
        int dev = 0, cus = 0, per_cu = 0;
        if (hipGetDevice(&dev) != hipSuccess || hipDeviceGetAttribute(&cus, hipDeviceAttributeMultiprocessorCount, dev) != hipSuccess) { grid = -1; return; }
        if (hipFuncSetAttribute((const void*)hybrid_fwd, hipFuncAttributeMaxDynamicSharedMemorySize, LDS_BYTES) != hipSuccess) { fprintf(stderr, "kernel_launch: hipFuncSetAttribute failed\n"); grid = -1; return; }
        if (hipOccupancyMaxActiveBlocksPerMultiprocessor(&per_cu, (const void*)hybrid_fwd, NTHR, LDS_BYTES) != hipSuccess || per_cu < 1) { fprintf(stderr, "kernel_launch: occupancy query says %d\n", per_cu); }
        (void)hipGetLastError();
        grid = cus;
    }
    if (grid < 0) return;
    if (hipMemsetAsync((char*)d_ws + WS_CTL, 0, CTL_ZERO_BYTES, stream) != hipSuccess) return;
    Args a{};
    for (int i = 0; i < 22; ++i) a.in[i] = (const float*)d_in[i];
    a.out = (float*)d_out; a.ws = (unsigned char*)d_ws; a.pad = 0;
#if MK_PER_PHASE
    for (int p = 0; p < NPH; ++p) { a.ph_lo = p; a.ph_hi = p + 1; a.li = p; hipLaunchKernelGGL(hybrid_fwd, dim3(grid), dim3(NTHR), LDS_BYTES, stream, a); }
#else
    a.ph_lo = 0; a.ph_hi = NPH; a.li = 0;
    hipLaunchKernelGGL(hybrid_fwd, dim3(grid), dim3(NTHR), LDS_BYTES, stream, a);
#endif
    const hipError_t le = hipPeekAtLastError();
    if (le != hipSuccess) fprintf(stderr, "kernel_launch: launch failed: %s\n", hipGetErrorName(le));
}
```

```cpp
#include <hip/hip_runtime.h>
#include <hip/hip_bf16.h>
#include <cstdio>
#include <cstdint>
#include <cmath>
__device__ __forceinline__ int ltid() { int t = threadIdx.x; asm volatile("" : "+v"(t)); return t; }
__device__ __forceinline__ int lbid() { int t = blockIdx.x; asm volatile("" : "+s"(t)); return t; }
namespace pg8 {
#define PG8_LAS __attribute__((address_space(3)))
typedef unsigned short bf16_t;
typedef short bf16x8 __attribute__((ext_vector_type(8)));
typedef float f32x4 __attribute__((ext_vector_type(4)));
typedef unsigned u32x4 __attribute__((ext_vector_type(4)));
typedef unsigned u32x2 __attribute__((ext_vector_type(2)));
constexpr int BM = 256, BK = 64, HALF = 128, HTB = HALF * BK * 2  , STAGE_BYTES = 8 * HTB, NXCD = 8, WGM = 8;

__host__ __device__ __forceinline__ int lds_byte(int r, int c) { const int st = (r >> 4) * 2 + (c >> 5), rr = r & 15, cc = c & 31, ob = rr * 64 + cc * 2; return st * 1024 + (ob ^ (((ob >> 9) & 1) << 5)); }
__host__ __device__ __forceinline__ void stage_rc(int b, int& R, int& C) { const int st = b / 1024, sb = b % 1024, swz = sb ^ (((sb >> 9) & 1) << 5); R = (st >> 1) * 16 + swz / 64; C = (st & 1) * 32 + (swz % 64) / 2; }
__host__ __device__ __forceinline__ int perm32(int rho) { const int n = rho >> 4, i = rho & 15; return 8 * (i >> 2) + 4 * n + (i & 3); }

struct Unit { int pm, pn; };
struct Gemm { const bf16_t* A; const bf16_t* Bt; int M, N, K; };

struct StaticOrder {
    int nM, nN, nwg, G, c;
    __host__ __device__ void init(int M, int N, int G_, int c_) { nM = M / BM; nN = N / BM; nwg = nM * nN; G = G_; c = c_; }
    __host__ __device__ bool next(int i, Unit& u) const {
        const long L = (long)i * G + c; if (L >= nwg) return false;
        int wgid = (int)L; { const int q = nwg / NXCD, r = nwg % NXCD, xcd = wgid % NXCD, off = wgid / NXCD; wgid = (xcd < r ? xcd * (q + 1) : r * (q + 1) + (xcd - r) * q) + off; }
        const int nig = WGM * nN, gid = wgid / nig, fm = gid * WGM, gsz = (nM - fm) < WGM ? (nM - fm) : WGM;
        u.pm = fm + ((wgid % nig) % gsz); u.pn = (wgid % nig) / gsz; return true;
    }
    __device__ __forceinline__ void a_ready(const Unit&) const {}
    __device__ __forceinline__ void done(const Unit&) const {}
};

__device__ __forceinline__ unsigned cvt_pk_bf16(float lo, float hi) { unsigned r; asm volatile("v_cvt_pk_bf16_f32 %0, %1, %2" : "=v"(r) : "v"(lo), "v"(hi)); return r; }
typedef int i32x4 __attribute__((ext_vector_type(4)));
typedef int i32x8 __attribute__((ext_vector_type(8)));
__device__ __forceinline__ i32x8 cat8(bf16x8 lo, bf16x8 hi) { return __builtin_shufflevector(__builtin_bit_cast(i32x4, lo), __builtin_bit_cast(i32x4, hi), 0, 1, 2, 3, 4, 5, 6, 7); }
__device__ __forceinline__ float clamp448(float v) { return __builtin_amdgcn_fmed3f(v, -448.f, 448.f); }
__device__ __forceinline__ unsigned pk4_fp8(float a, float b, float c, float d) { unsigned r = 0u; r = (unsigned)__builtin_amdgcn_cvt_pk_fp8_f32(a, b, (int)r, false); r = (unsigned)__builtin_amdgcn_cvt_pk_fp8_f32(c, d, (int)r, true); return r; }
typedef float f32x2 __attribute__((ext_vector_type(2)));
__device__ __forceinline__ f32x2 gelu_pk(f32x2 v) {
    const f32x2 av = __builtin_elementwise_abs(v), d = av * 0.2316418882f + 1.0f;
    f32x2 t; t.x = __builtin_amdgcn_rcpf(d.x); t.y = __builtin_amdgcn_rcpf(d.y);
    f32x2 q = t * 0.5307027145f + (-0.7265760135f); q = q * t + 0.7107068705f; q = q * t + (-0.142248368f); q = q * t + 0.127414796f; q = q * t;
    const f32x2 s = (v * v) * (-0.72134752044f);
    f32x2 e; e.x = __builtin_amdgcn_exp2f(s.x); e.y = __builtin_amdgcn_exp2f(s.y);
    const f32x2 m = v * (q * e), r = v - m;
    f32x2 o; o.x = v.x < 0.f ? m.x : r.x; o.y = v.y < 0.f ? m.y : r.y; return o;
}

template <int ACT  > struct EpiBf16 {
    static constexpr bool PERM = true, AFTER_DRAIN = false; static_assert(ACT == 0 || ACT == 1, "EpiBf16: ACT is 0 (none) or 1 (gelu_pk)");
    bf16_t* O; int ldc; const float* bias; int split_cols; size_t split_stride; float scale0;
    __device__ __forceinline__ void operator()(const f32x4 (&acc)[2][2][4][2], const Unit& u, int wr, int wc, int fr, int fq) const {
        const int row0 = u.pm * BM + wr * 64 + fr; int colt = u.pn * BM; bf16_t* base = O;
        float sc = 1.f; if (split_cols) { const int t = colt / split_cols; base += (size_t)t * split_stride; colt -= t * split_cols; if (t == 0) sc = scale0; }
        const int col0 = colt + wc * 32 + 8 * fq, bcol0 = u.pn * BM + wc * 32 + 8 * fq;
        f32x4 bv[2][2];
#pragma unroll
        for (int bj = 0; bj < 2; ++bj)
#pragma unroll
            for (int n = 0; n < 2; ++n) bv[bj][n] = bias ? *(const f32x4*)(bias + bcol0 + bj * HALF + 4 * n) : (f32x4){0.f, 0.f, 0.f, 0.f};
#pragma unroll
        for (int ai = 0; ai < 2; ++ai)
#pragma unroll
            for (int m = 0; m < 4; ++m) { bf16_t* rowp = base + (size_t)(row0 + ai * HALF + m * 16) * ldc + col0;
#pragma unroll
                for (int bj = 0; bj < 2; ++bj) { f32x4 v0 = acc[ai][bj][m][0] + bv[bj][0], v1 = acc[ai][bj][m][1] + bv[bj][1];
                    if (ACT == 1) { f32x2 a = gelu_pk((f32x2){v0[0], v0[1]}), b = gelu_pk((f32x2){v0[2], v0[3]}), c = gelu_pk((f32x2){v1[0], v1[1]}), d = gelu_pk((f32x2){v1[2], v1[3]});
                        v0 = (f32x4){a.x, a.y, b.x, b.y}; v1 = (f32x4){c.x, c.y, d.x, d.y}; }
                    v0 = v0 * sc; v1 = v1 * sc; u32x4 w; w.x = cvt_pk_bf16(v0[0], v0[1]); w.y = cvt_pk_bf16(v0[2], v0[3]); w.z = cvt_pk_bf16(v1[0], v1[1]); w.w = cvt_pk_bf16(v1[2], v1[3]);
                    *(u32x4*)(rowp + bj * HALF) = w; } }
    }
};

struct EpiResid {
    static constexpr bool PERM = true, AFTER_DRAIN = false;
    const float* base32; const bf16_t* base16; bf16_t* C; int ldc;
    __device__ __forceinline__ void operator()(const f32x4 (&acc)[2][2][4][2], const Unit& u, int wr, int wc, int fr, int fq) const {
        const int row0 = u.pm * BM + wr * 64 + fr, col0 = u.pn * BM + wc * 32 + 8 * fq;
#pragma unroll
        for (int ai = 0; ai < 2; ++ai)
#pragma unroll
            for (int m = 0; m < 4; ++m) { const size_t off = (size_t)(row0 + ai * HALF + m * 16) * ldc + col0;
#pragma unroll
                for (int bj = 0; bj < 2; ++bj) { f32x4 b0, b1;
                    if (base32) { b0 = *(const f32x4*)(base32 + off + bj * HALF); b1 = *(const f32x4*)(base32 + off + bj * HALF + 4); }
                    else { const u32x4 q = *(const u32x4*)(base16 + off + bj * HALF);
                        b0 = (f32x4){__uint_as_float(q.x << 16), __uint_as_float(q.x & 0xffff0000u), __uint_as_float(q.y << 16), __uint_as_float(q.y & 0xffff0000u)};
                        b1 = (f32x4){__uint_as_float(q.z << 16), __uint_as_float(q.z & 0xffff0000u), __uint_as_float(q.w << 16), __uint_as_float(q.w & 0xffff0000u)}; }
                    const f32x4 v0 = acc[ai][bj][m][0] + b0, v1 = acc[ai][bj][m][1] + b1;
                    u32x4 w; w.x = cvt_pk_bf16(v0[0], v0[1]); w.y = cvt_pk_bf16(v0[2], v0[3]); w.z = cvt_pk_bf16(v1[0], v1[1]); w.w = cvt_pk_bf16(v1[2], v1[3]);
                    *(u32x4*)(C + off + bj * HALF) = w; } }
    }
};
__device__ __forceinline__ float silu_f(float x) { return x * __builtin_amdgcn_rcpf(1.0f + __builtin_amdgcn_exp2f(-1.4426950408889634f * x)); }
constexpr float WSCALE = 64.f, HSCALE = 4.f;
struct EpiSwiGLU {
    static constexpr bool PERM = true, AFTER_DRAIN = false;
    unsigned char* O; int ldc;
    __device__ __forceinline__ static f32x2 sw2(f32x2 g, f32x2 u) {
        constexpr float c1 = -1.4426950408889634f / WSCALE, c2 = HSCALE / (WSCALE * WSCALE);
        const f32x2 t = g * c1; f32x2 d; d.x = __builtin_amdgcn_exp2f(t.x); d.y = __builtin_amdgcn_exp2f(t.y); d = d + 1.0f;
        f32x2 r; r.x = __builtin_amdgcn_rcpf(d.x); r.y = __builtin_amdgcn_rcpf(d.y);
        f32x2 p = (g * u) * (r * c2); p.x = clamp448(p.x); p.y = clamp448(p.y); return p; }
    __device__ __forceinline__ void operator()(const f32x4 (&acc)[2][2][4][2], const Unit& u, int wr, int wc, int fr, int fq) const {
        const int row0 = u.pm * BM + wr * 64 + fr, col0 = (u.pn & 15) * HALF + wc * 32 + 8 * fq;
#pragma unroll
        for (int ai = 0; ai < 2; ++ai)
#pragma unroll
            for (int m = 0; m < 4; ++m) { unsigned char* rowp = O + (size_t)(row0 + ai * HALF + m * 16) * ldc + col0;
                const f32x4 g0 = acc[ai][0][m][0], g1 = acc[ai][0][m][1], u0 = acc[ai][1][m][0], u1 = acc[ai][1][m][1];
                const f32x2 a = sw2((f32x2){g0[0], g0[1]}, (f32x2){u0[0], u0[1]}), b = sw2((f32x2){g0[2], g0[3]}, (f32x2){u0[2], u0[3]});
                const f32x2 c = sw2((f32x2){g1[0], g1[1]}, (f32x2){u1[0], u1[1]}), d = sw2((f32x2){g1[2], g1[3]}, (f32x2){u1[2], u1[3]});
                u32x2 w; w.x = pk4_fp8(a.x, a.y, b.x, b.y); w.y = pk4_fp8(c.x, c.y, d.x, d.y);
                *(u32x2*)rowp = w; }
    }
};
struct EpiScaleBf16 {
    static constexpr bool PERM = true, AFTER_DRAIN = false;
    bf16_t* O; int ldc; const float* rowscale;
    __device__ __forceinline__ void operator()(const f32x4 (&acc)[2][2][4][2], const Unit& u, int wr, int wc, int fr, int fq) const {
        const int row0 = u.pm * BM + wr * 64 + fr, col0 = (u.pn & 3) * BM + wc * 32 + 8 * fq;
#pragma unroll
        for (int ai = 0; ai < 2; ++ai)
#pragma unroll
            for (int m = 0; m < 4; ++m) { const int row = row0 + ai * HALF + m * 16; const float s = rowscale[row] * (1.0f / (WSCALE * HSCALE)); bf16_t* rowp = O + (size_t)row * ldc + col0;
#pragma unroll
                for (int bj = 0; bj < 2; ++bj) { const f32x4 v0 = acc[ai][bj][m][0] * s, v1 = acc[ai][bj][m][1] * s;
                    u32x4 w; w.x = cvt_pk_bf16(v0[0], v0[1]); w.y = cvt_pk_bf16(v0[2], v0[3]); w.z = cvt_pk_bf16(v1[0], v1[1]); w.w = cvt_pk_bf16(v1[2], v1[3]);
                    *(u32x4*)(rowp + bj * HALF) = w; } }
    }
};
struct EpiNull { static constexpr bool PERM = true, AFTER_DRAIN = false; __device__ __forceinline__ void operator()(const f32x4 (&)[2][2][4][2], const Unit&, int, int, int, int) const {} };
struct TailOrder {
    int G, c, pn;
    __device__ __forceinline__ bool next(int i, Unit& u) const { const int L = i * G + c; if (L >= 64) return false; u.pm = L; u.pn = pn; return true; }
    __device__ __forceinline__ void a_ready(const Unit&) const {}
    __device__ __forceinline__ void done(const Unit&) const {}
};
struct Moe1Order {
    int G, c;
    __device__ __forceinline__ bool next(int i, Unit& u) const {
        const int L = i * G + c; if (L >= 2048) return false;
        const int e = L >> 7, r = L & 127; u.pm = e * 8 + ((r >> 3) & 7); u.pn = e * 16 + 2 * (r & 7) + (r >> 6); return true;
    }
    __device__ __forceinline__ void a_ready(const Unit&) const {}
    __device__ __forceinline__ void done(const Unit&) const {}
};
struct Moe2Order {
    int G, c;
    __device__ __forceinline__ bool next(int i, Unit& u) const {
        const int L = i * G + c; if (L >= 512) return false;
        const int q = L & 7, Lp = L >> 3, e = 8 * (Lp >> 5) + q, k = Lp & 31; u.pm = e * 8 + (k & 7); u.pn = e * 4 + (k >> 3); return true;
    }
    __device__ __forceinline__ void a_ready(const Unit&) const {}
    __device__ __forceinline__ void done(const Unit&) const {}
};
template <class Epi, class Sched, bool ALIGN_EPI = false, bool SP2 = false, bool F8 = false>
__device__ __forceinline__ void gemm_phase(PG8_LAS unsigned char* lds, const Gemm g, const Sched& S, const Epi& E) {
    const int tid = ltid(), wid = __builtin_amdgcn_readfirstlane(tid >> 6), lane = tid & 63, wr = wid >> 2, wc = wid & 3, fr = lane & 15, fq = lane >> 4;
    const int K = g.K, nt = K / BK;
    unsigned voffA[2], voffB[2];
#pragma unroll
    for (int i = 0; i < 2; ++i) { int R, C; stage_rc(tid * 16 + i * 8192, R, C); const int Rb = Epi::PERM ? ((R & ~31) + perm32(R & 31)) : R;
        voffA[i] = (unsigned)(R * K + C) * 2u; voffB[i] = (unsigned)(Rb * K + C) * 2u; }
    const size_t kstep = (size_t)(BK * 2);
    const size_t hstep = (size_t)HALF * K * 2;
    const size_t tstep = 2 * hstep;
    const unsigned ldsw = (unsigned)wid * 1024u;
    const int aoff = lds_byte(wr * 64 + fr, fq * 8), boff = lds_byte(wc * 32 + fr, fq * 8);
#define PG8_SA(b, h) (((b) * 2 + (h)) * HTB)
#define PG8_SB(b, h) ((4 + (b) * 2 + (h)) * HTB)
#define PG8_STAGE(bufoff, gbase, voff) do { _Pragma("unroll") for (int _i = 0; _i < 2; ++_i) \
        __builtin_amdgcn_global_load_lds((const unsigned*)((const char*)(gbase) + (voff)[_i]), (PG8_LAS unsigned*)(lds + (bufoff) + ldsw + _i * 8192), 16, 0, 0); } while (0)
#define PG8_LDA(dst, b, h) do { _Pragma("unroll") for (int m = 0; m < 4; ++m) { if constexpr (F8) { dst##8[m] = cat8(*(const PG8_LAS bf16x8*)(lds + PG8_SA(b, h) + aoff + m * 2048), *(const PG8_LAS bf16x8*)(lds + PG8_SA(b, h) + aoff + m * 2048 + 1024)); } \
        else { _Pragma("unroll") for (int k = 0; k < 2; ++k) dst[m][k] = *(const PG8_LAS bf16x8*)(lds + PG8_SA(b, h) + aoff + m * 2048 + k * 1024); } } } while (0)
#define PG8_LDB(dst, b, h) do { _Pragma("unroll") for (int n = 0; n < 2; ++n) { if constexpr (F8) { dst##8[n] = cat8(*(const PG8_LAS bf16x8*)(lds + PG8_SB(b, h) + boff + n * 2048), *(const PG8_LAS bf16x8*)(lds + PG8_SB(b, h) + boff + n * 2048 + 1024)); } \
        else { _Pragma("unroll") for (int k = 0; k < 2; ++k) dst[n][k] = *(const PG8_LAS bf16x8*)(lds + PG8_SB(b, h) + boff + n * 2048 + k * 1024); } } } while (0)
#define PG8_MMA(ai, bj, At, Bt) do { __builtin_amdgcn_s_setprio(1); _Pragma("unroll") for (int m = 0; m < 4; ++m) _Pragma("unroll") for (int n = 0; n < 2; ++n) { \
        if constexpr (F8) { asm volatile("v_mfma_scale_f32_16x16x128_f8f6f4 %0, %1, %2, %0, %3, %3 op_sel_hi:[0,0,0]" : "+v"(acc[ai][bj][m][n]) : "v"(Bt##8[n]), "v"(At##8[m]), "v"(sc1)); } \
        else { _Pragma("unroll") for (int k = 0; k < 2; ++k) acc[ai][bj][m][n] = __builtin_amdgcn_mfma_f32_16x16x32_bf16(Bt[n][k], At[m][k], acc[ai][bj][m][n], 0, 0, 0); } } __builtin_amdgcn_s_setprio(0); } while (0)
#define PG8_WAIT_V(n) asm volatile("s_waitcnt vmcnt(" #n ")" ::: "memory")
#define PG8_WAIT_L(n) asm volatile("s_waitcnt lgkmcnt(" #n ")" ::: "memory")
#define PG8_BAR __builtin_amdgcn_s_barrier()
#define PG8_SCHED __builtin_amdgcn_sched_barrier(0)
    Unit cur, nxt; int ui = 0;
    if (!S.next(0, cur)) return;
    f32x4 acc[2][2][4][2];
#pragma unroll
    for (int a = 0; a < 2; ++a)
#pragma unroll
        for (int b = 0; b < 2; ++b)
#pragma unroll
            for (int m = 0; m < 4; ++m)
#pragma unroll
                for (int n = 0; n < 2; ++n) acc[a][b][m][n] = (f32x4){0.f, 0.f, 0.f, 0.f};
    bf16x8 At[4][2], B0[2][2], B1[2][2]; i32x8 At8[4], B08[2], B18[2];
    const int sc1 = 0x7F7F7F7F;
    const char* cA = (const char*)g.A + (size_t)cur.pm * tstep; const char* cB = (const char*)g.Bt + (size_t)cur.pn * tstep;
    S.a_ready(cur);
    if constexpr (SP2) {
        PG8_STAGE(PG8_SB(0, 0), cB, voffB); PG8_STAGE(PG8_SB(0, 1), cB + hstep, voffB); PG8_STAGE(PG8_SA(0, 0), cA, voffA); PG8_STAGE(PG8_SA(0, 1), cA + hstep, voffA);
        if (wr == 1) PG8_BAR;
        PG8_WAIT_V(2); PG8_BAR;
        PG8_STAGE(PG8_SB(1, 0), cB + kstep, voffB); PG8_STAGE(PG8_SA(1, 0), cA + kstep, voffA); PG8_STAGE(PG8_SB(1, 1), cB + hstep + kstep, voffB);
        PG8_WAIT_V(6); PG8_BAR;
    } else {
        PG8_STAGE(PG8_SB(0, 0), cB, voffB); PG8_STAGE(PG8_SA(0, 0), cA, voffA); PG8_STAGE(PG8_SB(0, 1), cB + hstep, voffB); PG8_STAGE(PG8_SA(0, 1), cA + hstep, voffA);
        if (wr == 1) PG8_BAR;
        PG8_WAIT_V(4); PG8_BAR;
        PG8_STAGE(PG8_SB(1, 0), cB + kstep, voffB); PG8_STAGE(PG8_SA(1, 0), cA + kstep, voffA); PG8_STAGE(PG8_SB(1, 1), cB + hstep + kstep, voffB);
        PG8_WAIT_V(6); PG8_BAR;
    }
    for (;;) {
        const bool has_next = S.next(ui + 1, nxt);
        const char* nA = has_next ? (const char*)g.A + (size_t)nxt.pm * tstep : cA; const char* nB = has_next ? (const char*)g.Bt + (size_t)nxt.pn * tstep : cB;
        for (int t = 0; t < nt; t += 2) {
            const bool last = (t == nt - 2);
            const char* a1 = cA + (size_t)(t + 1) * kstep;
            const char* a2 = last ? nA : cA + (size_t)(t + 2) * kstep; const char* b2 = last ? nB : cB + (size_t)(t + 2) * kstep;
            const char* a3 = a2 + kstep; const char* b3 = b2 + kstep;
            if (last && has_next) S.a_ready(nxt);
            if constexpr (SP2) {
            PG8_LDB(B0, 0, 0); PG8_LDB(B1, 0, 1); PG8_SCHED; PG8_LDA(At, 0, 0); PG8_STAGE(PG8_SA(1, 1), a1 + hstep, voffA);
            PG8_WAIT_V(8); PG8_WAIT_L(0); PG8_BAR; PG8_MMA(0, 0, At, B0); PG8_MMA(0, 1, At, B1); PG8_BAR; PG8_SCHED;
            PG8_LDA(At, 0, 1); PG8_STAGE(PG8_SB(0, 0), b2, voffB); PG8_STAGE(PG8_SB(0, 1), b2 + hstep, voffB); PG8_STAGE(PG8_SA(0, 0), a2, voffA);
            PG8_WAIT_V(8); PG8_WAIT_L(0); PG8_BAR; PG8_MMA(1, 0, At, B0); PG8_MMA(1, 1, At, B1); PG8_BAR; PG8_SCHED;
            PG8_LDB(B0, 1, 0); PG8_LDB(B1, 1, 1); PG8_SCHED; PG8_LDA(At, 1, 0); PG8_STAGE(PG8_SA(0, 1), a2 + hstep, voffA);
            PG8_WAIT_V(8); PG8_WAIT_L(0); PG8_BAR; PG8_MMA(0, 0, At, B0); PG8_MMA(0, 1, At, B1); PG8_BAR; PG8_SCHED;
            PG8_LDA(At, 1, 1); PG8_STAGE(PG8_SB(1, 0), b3, voffB); PG8_STAGE(PG8_SB(1, 1), b3 + hstep, voffB); PG8_STAGE(PG8_SA(1, 0), a3, voffA);
            PG8_WAIT_V(8); PG8_WAIT_L(0); PG8_BAR; PG8_MMA(1, 0, At, B0); PG8_MMA(1, 1, At, B1); PG8_BAR; PG8_SCHED;
            } else {
            PG8_LDB(B0, 0, 0); PG8_SCHED; PG8_LDA(At, 0, 0); PG8_STAGE(PG8_SA(1, 1), a1 + hstep, voffA);
            PG8_WAIT_L(8); PG8_BAR; PG8_WAIT_L(0); PG8_MMA(0, 0, At, B0); PG8_BAR; PG8_SCHED;
            PG8_LDB(B1, 0, 1); PG8_STAGE(PG8_SB(0, 0), b2, voffB);
            PG8_BAR; PG8_WAIT_L(0); PG8_MMA(0, 1, At, B1); PG8_BAR;
            PG8_LDA(At, 0, 1); PG8_STAGE(PG8_SA(0, 0), a2, voffA);
            PG8_BAR; PG8_WAIT_L(0); PG8_MMA(1, 0, At, B0); PG8_BAR; PG8_SCHED;
            PG8_STAGE(PG8_SB(0, 1), b2 + hstep, voffB);
            PG8_WAIT_V(6); PG8_BAR; PG8_MMA(1, 1, At, B1); PG8_BAR;
            PG8_LDB(B0, 1, 0); PG8_SCHED; PG8_LDA(At, 1, 0); PG8_STAGE(PG8_SA(0, 1), a2 + hstep, voffA);
            PG8_WAIT_L(8); PG8_BAR; PG8_WAIT_L(0); PG8_MMA(0, 0, At, B0); PG8_BAR; PG8_SCHED;
            PG8_LDB(B1, 1, 1); PG8_STAGE(PG8_SB(1, 0), b3, voffB);
            PG8_BAR; PG8_WAIT_L(0); PG8_MMA(0, 1, At, B1); PG8_BAR;
            PG8_LDA(At, 1, 1); PG8_STAGE(PG8_SA(1, 0), a3, voffA);
            PG8_BAR; PG8_WAIT_L(0); PG8_MMA(1, 0, At, B0); PG8_BAR; PG8_SCHED;
            PG8_STAGE(PG8_SB(1, 1), b3 + hstep, voffB);
            PG8_WAIT_V(6); PG8_BAR; PG8_MMA(1, 1, At, B1); PG8_BAR;
            }
        }
        if constexpr (F8) { asm volatile("s_nop 15\n\ts_nop 15" ::: "memory"); }
        if constexpr (ALIGN_EPI) { if (wr == 0) PG8_BAR; }
        if constexpr (!Epi::AFTER_DRAIN) { E(acc, cur, wr, wc, fr, fq); S.done(cur); }
        if (!has_next) break;
#pragma unroll
        for (int a = 0; a < 2; ++a)
#pragma unroll
            for (int b = 0; b < 2; ++b)
#pragma unroll
                for (int m = 0; m < 4; ++m)
#pragma unroll
                    for (int n = 0; n < 2; ++n) acc[a][b][m][n] = (f32x4){0.f, 0.f, 0.f, 0.f};
        cur = nxt; cA = nA; cB = nB; ++ui;
        if constexpr (ALIGN_EPI) { if (wr == 1) PG8_BAR; }
    }
    PG8_WAIT_V(0);
    if constexpr (!ALIGN_EPI) { if (wr == 0) PG8_BAR; }
    PG8_BAR;
    if constexpr (Epi::AFTER_DRAIN) { E.fused(acc, cur, wr, wc, fr, fq, lds, wid, lane); S.done(cur); }
#undef PG8_SA
#undef PG8_SB
#undef PG8_STAGE
#undef PG8_LDA
#undef PG8_LDB
#undef PG8_MMA
#undef PG8_WAIT_V
#undef PG8_WAIT_L
#undef PG8_BAR
#undef PG8_SCHED
}
}

namespace attn_body {
using bf16=__hip_bfloat16;
using bf16x8=__attribute__((ext_vector_type(8)))short;
using s16x4=__attribute__((ext_vector_type(4)))short;
using f32x16=__attribute__((ext_vector_type(16)))float;
using u32x4=__attribute__((ext_vector_type(4)))unsigned;
constexpr int BATCH=8,NHEAD=8,NKV=2,SEQ=2048,D=64,PQ=2304,PO=1024;
constexpr int NW=8,QBLK=32,QB=QBLK*NW,KVBLK=64,NQB=SEQ/QB;
constexpr int ATTN_UNIT_ROWS=QB;
__device__ __forceinline__ int crow(int r,int hi){return (r&3)+8*(r>>2)+4*hi;}
#define SBAR() __builtin_amdgcn_sched_barrier(0)
__device__ __forceinline__ void cmask(f32x16&p0,f32x16&p1,int jb,int qrel,int hi){
  const float NEG=-INFINITY; int kb=64*jb+4*hi;
  #pragma unroll
  for(int r=0;r<16;++r){int kv=kb+(r&3)+8*(r>>2); if(kv>qrel)p0[r]=NEG; if(kv+32>qrel)p1[r]=NEG;}
}

constexpr int NSLOT=3, SLOTB=8192;
constexpr int LDS_K=0, LDS_V=NSLOT*SLOTB, LDS_WS=2*NSLOT*SLOTB, LDS_OST=LDS_WS+NW*64*4, LDS_BYTES=LDS_OST+NW*4096;
constexpr float C2=0.125f*1.4426950408889634f;
__device__ __forceinline__ void glds16(const void*gsrc,unsigned lds_dst){unsigned keep;
  asm volatile("s_mov_b32 %0, m0\n\ts_mov_b32 m0, %2\n\ts_nop 0\n\tglobal_load_lds_dwordx4 %1, off\n\ts_mov_b32 m0, %0":"=&s"(keep):"v"(gsrc),"s"(lds_dst):"memory");}
__device__ __forceinline__ float max3f(float a,float b,float c){float r;asm("v_max3_f32 %0, %1, %2, %3":"=v"(r):"v"(a),"v"(b),"v"(c));return r;}
__device__ __forceinline__ float max2f(float a,float b){float r;asm("v_max_f32_e32 %0, %1, %2":"=v"(r):"v"(a),"v"(b));return r;}
__device__ __forceinline__ float fadd_s(float a,float b){float r;asm("v_add_f32_e32 %0, %1, %2":"=v"(r):"v"(a),"v"(b));return r;}
__device__ __forceinline__ float fsub_s(float a,float b){float r;asm("v_sub_f32_e32 %0, %1, %2":"=v"(r):"v"(a),"v"(b));return r;}
typedef float f32x2_t __attribute__((ext_vector_type(2))); typedef __bf16 bf16x2_t __attribute__((ext_vector_type(2)));
__device__ __forceinline__ unsigned cvtpk_s(float lo,float hi){f32x2_t v={lo,hi};bf16x2_t b=__builtin_convertvector(v,bf16x2_t);return __builtin_bit_cast(unsigned,b);}
#define WAIT_BAR(N) asm volatile("s_waitcnt vmcnt(" #N ") lgkmcnt(0)\n\ts_barrier":::"memory")

__device__ __forceinline__ void qkt(f32x16&p0,f32x16&p1,const char*Kslot,const bf16x8*qr,const f32x16&negm,int r32,int hi){
  const char*kb=Kslot+hi*1024+r32*16;
  #pragma unroll
  for(int d0=0;d0<4;++d0){
    const bf16x8 b0=*reinterpret_cast<const bf16x8*>(kb+d0*2048);
    const bf16x8 b1=*reinterpret_cast<const bf16x8*>(kb+d0*2048+512);
    if(d0==0){p0=__builtin_amdgcn_mfma_f32_32x32x16_bf16(b0,qr[0],negm,0,0,0);p1=__builtin_amdgcn_mfma_f32_32x32x16_bf16(b1,qr[0],negm,0,0,0);}
    else{p0=__builtin_amdgcn_mfma_f32_32x32x16_bf16(b0,qr[d0],p0,0,0,0);p1=__builtin_amdgcn_mfma_f32_32x32x16_bf16(b1,qr[d0],p1,0,0,0);}}
}
typedef __attribute__((address_space(3))) const char* lds_cptr;
typedef short v4i16_t __attribute__((ext_vector_type(4)));
__device__ __forceinline__ void kload8(bf16x8*kf,lds_cptr kp){
  kf[0]=*(const __attribute__((address_space(3))) bf16x8*)(kp);      kf[1]=*(const __attribute__((address_space(3))) bf16x8*)(kp+512);
  kf[2]=*(const __attribute__((address_space(3))) bf16x8*)(kp+2048); kf[3]=*(const __attribute__((address_space(3))) bf16x8*)(kp+2560);
  kf[4]=*(const __attribute__((address_space(3))) bf16x8*)(kp+4096); kf[5]=*(const __attribute__((address_space(3))) bf16x8*)(kp+4608);
  kf[6]=*(const __attribute__((address_space(3))) bf16x8*)(kp+6144); kf[7]=*(const __attribute__((address_space(3))) bf16x8*)(kp+6656);
}
__device__ __forceinline__ void kload2(bf16x8*kf,lds_cptr kp,int j){ kf[2*j]=*(const __attribute__((address_space(3))) bf16x8*)(kp+j*2048); kf[2*j+1]=*(const __attribute__((address_space(3))) bf16x8*)(kp+j*2048+512); }
__device__ __forceinline__ s16x4 vtr(lds_cptr p){ return __builtin_bit_cast(s16x4,__builtin_amdgcn_ds_read_tr16_b64_v4i16((__attribute__((address_space(3))) v4i16_t*)p)); }
__device__ __forceinline__ float rowmax(const f32x16&p0,const f32x16&p1){
  float a=max3f(p0[0],p0[1],p1[0]),b=max3f(p0[2],p0[3],p1[1]);a=max3f(a,p1[2],p1[3]);
  #pragma unroll
  for(int r=4;r<16;r+=4){a=max3f(a,p0[r],p0[r+1]);b=max3f(b,p0[r+2],p0[r+3]);a=max3f(a,p1[r],p1[r+1]);b=max3f(b,p1[r+2],p1[r+3]);}
  const float m=max2f(a,b);
  auto rr=__builtin_amdgcn_permlane32_swap(__float_as_uint(m),__float_as_uint(m),false,false);
  return max2f(__uint_as_float(rr[0]),__uint_as_float(rr[1]));
}
__device__ __forceinline__ void pv(f32x16*o,int vb,bf16x8 pa0,bf16x8 pa1,bf16x8 pa2,bf16x8 pa3){
  #pragma unroll
  for(int d0=0;d0<2;++d0){s16x4 lo[4],hi[4];
    #pragma unroll
    for(int ks=0;ks<4;++ks){
      asm volatile("ds_read_b64_tr_b16 %0,%1 offset:%c2":"=&v"(lo[ks]):"v"(vb),"i"(d0*4096+ks*1024):"memory");
      asm volatile("ds_read_b64_tr_b16 %0,%1 offset:%c2":"=&v"(hi[ks]):"v"(vb),"i"(d0*4096+ks*1024+512):"memory");}
    asm volatile("s_waitcnt lgkmcnt(0)":::"memory");SBAR();
    #define PK(k) (bf16x8){lo[k][0],lo[k][1],lo[k][2],lo[k][3],hi[k][0],hi[k][1],hi[k][2],hi[k][3]}
    o[d0]=__builtin_amdgcn_mfma_f32_32x32x16_bf16(pa0,PK(0),o[d0],0,0,0);
    o[d0]=__builtin_amdgcn_mfma_f32_32x32x16_bf16(pa1,PK(1),o[d0],0,0,0);
    o[d0]=__builtin_amdgcn_mfma_f32_32x32x16_bf16(pa2,PK(2),o[d0],0,0,0);
    o[d0]=__builtin_amdgcn_mfma_f32_32x32x16_bf16(pa3,PK(3),o[d0],0,0,0);
    #undef PK
  }
}

#ifndef ATTN_STORE16
#define ATTN_STORE16(p,v) (*(u32x4*)(p)=(v))
#endif
template<int THRL> __device__ __forceinline__ void attn_unit(int b,int h,int qb,const bf16*Q,const bf16*__restrict__ K,const bf16*__restrict__ V,bf16*O,char*shm){
  const int tid=ltid(),lane=tid&63,r32=lane&31,hi=lane>>5; const int wid=__builtin_amdgcn_readfirstlane(tid>>6);
  const long rowbase=(long)b*SEQ; const int q0=qb*QB;
  const bf16*Qw=Q+(rowbase+q0+wid*QBLK)*PQ+h*D;
  const bf16*Kh=K+rowbase*PQ+(h>>2)*D,*Vh=V+rowbase*PQ+(h>>2)*D;
  const unsigned lds0=(unsigned)(uintptr_t)shm;
  float*wsf=(float*)(shm+LDS_WS)+wid*64;
  const bf16*ksrc=Kh+(long)lane*PQ+wid*8;
  const bf16*vsrc=Vh+(long)(16*(wid&3)+(lane>>2))*PQ+(wid>>2)*32+(lane&3)*8;
  const unsigned kdst=lds0+LDS_K+wid*1024, vdst=lds0+LDS_V+wid*1024;
  #define DMA_K(t,slot) glds16(ksrc+(long)(t)*KVBLK*PQ,(unsigned)__builtin_amdgcn_readfirstlane(kdst+(slot)))
  #define DMA_V(t,slot) glds16(vsrc+(long)(t)*KVBLK*PQ,(unsigned)__builtin_amdgcn_readfirstlane(vdst+(slot)))
  const int vb0=(int)(lds0+LDS_V)+((lane>>4)&1)*32+(lane&3)*8+(4*hi+((lane&15)>>2))*64;
  const char*Kbase=shm+LDS_K; bf16x8 kf[8];
  const lds_cptr shm3=(lds_cptr)shm; const lds_cptr kp0=shm3+LDS_K+hi*1024+r32*16; const lds_cptr vp0=shm3+LDS_V+((lane>>4)&1)*32+(lane&3)*8+(4*hi+((lane&15)>>2))*64;
  const int NT=SEQ/KVBLK;
  DMA_K(0,0);DMA_V(0,0);DMA_K(1,SLOTB);
  bf16x8 qr[4];
  #pragma unroll
  for(int d0=0;d0<4;++d0)qr[d0]=*reinterpret_cast<const bf16x8*>(&Qw[(long)r32*PQ+d0*16+hi*8]);
  float mhat=0.f,l_reg=0.f;f32x16 o[2];o[0]=f32x16{};o[1]=f32x16{};f32x16 negm=f32x16{};asm volatile("":"+v"(negm));
  const int qrel=wid*QBLK+r32;
  #define CMASK(P0,P1,t) do{}while(0)
  bool resc=false;
  #define START(P0,P1) do{ const float rm=rowmax(P0,P1); resc=false; \
    { const float dl=rm; mhat=fadd_s(mhat,dl); \
      _Pragma("unroll") for(int r=0;r<16;++r){P0[r]=fsub_s(P0[r],dl);P1[r]=fsub_s(P1[r],dl);} \
      _Pragma("unroll") for(int r=0;r<16;++r)negm[r]=-mhat; asm volatile("":"+v"(negm)); } \
    _Pragma("unroll") for(int r=0;r<16;++r)P0[r]=__builtin_amdgcn_exp2f(P0[r]); }while(0)
  #define RESC() do{ if(resc){ asm volatile("s_waitcnt lgkmcnt(0)":::"memory"); \
      _Pragma("unroll") for(int d_=0;d_<2;++d_) _Pragma("unroll") for(int r=0;r<16;++r)o[d_][r]*=wsf[crow(r,hi)]; } }while(0)
  f32x16 pA0,pA1,pB0,pB1;
  int sl_prev=0,sl_cur=0,sl_next=SLOTB;
  #define ROT() do{sl_prev=sl_cur;sl_cur=sl_next;sl_next=(sl_next==(NSLOT-1)*SLOTB)?0:sl_next+SLOTB;}while(0)
  DMA_K(2,2*SLOTB);
  WAIT_BAR(3);
  qkt(pA0,pA1,Kbase,qr,negm,r32,hi);asm volatile("s_nop 15\n\ts_nop 7":"+v"(pA0),"+v"(pA1));CMASK(pA0,pA1,0);
  START(pA0,pA1);
  _Pragma("unroll") for(int r=0;r<16;++r)pA1[r]=__builtin_amdgcn_exp2f(pA1[r]);
  WAIT_BAR(0);
  DMA_K(3,0);DMA_V(1,SLOTB);
  ROT();
  kload8(kf,kp0+sl_cur);
  WAIT_BAR(2);
  s16x4 vlo[8],vhi[8]; u32x4 pw0,pw1,pw2,pw3;
  #define PKW(P,B) cvtpk_s(P[B],P[B+1])
  #define PAF(k) __builtin_bit_cast(bf16x8,pw##k)
  #define VFR(i) (bf16x8){vlo[i][0],vlo[i][1],vlo[i][2],vlo[i][3],vhi[i][0],vhi[i][1],vhi[i][2],vhi[i][3]}
  #define PIN(x) asm volatile("":"+v"(x))
  #define MX3(a,b,c) __builtin_fmaxf(__builtin_fmaxf((a),(b)),(c))
  #define GAPA(MF,A0,A1,A2,A3,W0,W1,PW) do{ MF; sacc+=A0; sacc+=A1; sacc+=A2; sacc+=A3; PIN(sacc); W0; W1; PIN(PW); SBAR(); }while(0)
  #define EX(v) __builtin_amdgcn_exp2f(v)
  #define GAPB(MF,X,B) do{ MF; X[B]=EX(X[B]); X[B+1]=EX(X[B+1]); X[B+2]=EX(X[B+2]); X[B+3]=EX(X[B+3]); PIN(X); SBAR(); }while(0)
  #define VRD(i) do{ vlo[i]=vtr(vp_+(((i)>>2)*4096+((i)&3)*1024)); vhi[i]=vtr(vp_+(((i)>>2)*4096+((i)&3)*1024+512)); }while(0)
  #define KRD(G,j) do{ if(G){ kload2(kf,kp0+sl_next,j); SBAR(); } }while(0)
  #define STEP(C0,C1,P0,P1,t,GK,GV,GL) do{ SBAR(); \
    const lds_cptr vp_=vp0+sl_prev; \
    VRD(0); SBAR(); float sacc=(P0[0]+P0[1]); \
    GAPA(C0=__builtin_amdgcn_mfma_f32_32x32x16_bf16(kf[0],qr[0],negm,0,0,0), P0[2],P0[3],P0[4],P0[5],     pw0[0]=PKW(P0,0), pw0[1]=PKW(P0,2), pw0); \
    VRD(4); SBAR(); GAPA(C1=__builtin_amdgcn_mfma_f32_32x32x16_bf16(kf[1],qr[0],negm,0,0,0), P0[6],P0[7],P0[8],P0[9],     pw0[2]=PKW(P0,4), pw0[3]=PKW(P0,6), pw0); \
    VRD(1); SBAR(); GAPA(C0=__builtin_amdgcn_mfma_f32_32x32x16_bf16(kf[2],qr[1],C0,0,0,0),   P0[10],P0[11],P0[12],P0[13], pw1[0]=PKW(P0,8), pw1[1]=PKW(P0,10), pw1); \
    VRD(5); SBAR(); GAPA(C1=__builtin_amdgcn_mfma_f32_32x32x16_bf16(kf[3],qr[1],C1,0,0,0),   P0[14],P0[15],P1[0],P1[1],   pw1[2]=PKW(P0,12),pw1[3]=PKW(P0,14), pw1); \
    VRD(2); SBAR(); GAPA(C0=__builtin_amdgcn_mfma_f32_32x32x16_bf16(kf[4],qr[2],C0,0,0,0),   P1[2],P1[3],P1[4],P1[5],     pw2[0]=PKW(P1,0), pw2[1]=PKW(P1,2), pw2); \
    VRD(6); SBAR(); GAPA(C1=__builtin_amdgcn_mfma_f32_32x32x16_bf16(kf[5],qr[2],C1,0,0,0),   P1[6],P1[7],P1[8],P1[9],     pw2[2]=PKW(P1,4), pw2[3]=PKW(P1,6), pw2); \
    VRD(3); SBAR(); GAPA(C0=__builtin_amdgcn_mfma_f32_32x32x16_bf16(kf[6],qr[3],C0,0,0,0),   P1[10],P1[11],P1[12],P1[13], pw3[0]=PKW(P1,8), pw3[1]=PKW(P1,10), pw3); \
    VRD(7); SBAR(); GAPA(C1=__builtin_amdgcn_mfma_f32_32x32x16_bf16(kf[7],qr[3],C1,0,0,0),   P1[14],P1[15],0.f,0.f,       pw3[2]=PKW(P1,12),pw3[3]=PKW(P1,14), pw3); \
    l_reg+=sacc; \
    if(GK){DMA_K((t)+3,sl_cur);} if(GV){DMA_V((t)+1,sl_next);} \
    CMASK(C0,C1,t); \
    { float a=MX3(C0[0],C0[1],C1[0]),b=MX3(C0[2],C0[3],C1[1]); a=MX3(a,C1[2],C1[3]); \
      _Pragma("unroll") for(int r=4;r<16;r+=4){a=MX3(a,C0[r],C0[r+1]);b=MX3(b,C0[r+2],C0[r+3]);a=MX3(a,C1[r],C1[r+1]);b=MX3(b,C1[r+2],C1[r+3]);} \
      float rm=__builtin_fmaxf(a,b); { auto rr=__builtin_amdgcn_permlane32_swap(__float_as_uint(rm),__float_as_uint(rm),false,false); rm=__builtin_fmaxf(__uint_as_float(rr[0]),__uint_as_float(rr[1])); } \
      resc=false; \
      if(__builtin_expect(__any(rm>(float)THRL),0)){ const float dl=__builtin_fmaxf(rm,0.f); mhat+=dl; \
        _Pragma("unroll") for(int r=0;r<16;++r){C0[r]-=dl;C1[r]-=dl;} \
        _Pragma("unroll") for(int r=0;r<16;++r)negm[r]=-mhat; asm volatile("":"+v"(negm)); \
        const float f=__builtin_amdgcn_exp2f(-dl); l_reg*=f; if(hi==0)wsf[r32]=f; resc=true; } } \
    SBAR(); \
    GAPB(o[0]=__builtin_amdgcn_mfma_f32_32x32x16_bf16(PAF(0),VFR(0),o[0],0,0,0), C0,0); \
    GAPB(o[1]=__builtin_amdgcn_mfma_f32_32x32x16_bf16(PAF(0),VFR(4),o[1],0,0,0), C0,4); \
    KRD(GL,0); GAPB(o[0]=__builtin_amdgcn_mfma_f32_32x32x16_bf16(PAF(1),VFR(1),o[0],0,0,0), C0,8); \
    KRD(GL,1); GAPB(o[1]=__builtin_amdgcn_mfma_f32_32x32x16_bf16(PAF(1),VFR(5),o[1],0,0,0), C0,12); \
    KRD(GL,2); GAPB(o[0]=__builtin_amdgcn_mfma_f32_32x32x16_bf16(PAF(2),VFR(2),o[0],0,0,0), C1,0); \
    KRD(GL,3); GAPB(o[1]=__builtin_amdgcn_mfma_f32_32x32x16_bf16(PAF(2),VFR(6),o[1],0,0,0), C1,4); \
    GAPB(o[0]=__builtin_amdgcn_mfma_f32_32x32x16_bf16(PAF(3),VFR(3),o[0],0,0,0), C1,8); \
    GAPB(o[1]=__builtin_amdgcn_mfma_f32_32x32x16_bf16(PAF(3),VFR(7),o[1],0,0,0), C1,12); \
    }while(0)
  int t=1;
  #undef CMASK
  #define CMASK(P0,P1,t) do{}while(0)
  for(;t+5<NT;t+=2){
    STEP(pB0,pB1,pA0,pA1,t,true,true,true);     WAIT_BAR(2); RESC(); ROT();
    STEP(pA0,pA1,pB0,pB1,t+1,true,true,true);   WAIT_BAR(2); RESC(); ROT();
  }
  #undef CMASK
  #define CMASK(P0,P1,t) do{}while(0)
  #define ENDW(tt) do{ if((tt)+3<NT){WAIT_BAR(2);} else if((tt)+2<NT){WAIT_BAR(1);} else {WAIT_BAR(0);} }while(0)
  for(;t+1<NT;t+=2){
    STEP(pB0,pB1,pA0,pA1,t,(t+3<NT),(t+1<NT),(t+1<NT));       ENDW(t);   RESC(); ROT();
    STEP(pA0,pA1,pB0,pB1,t+1,(t+4<NT),(t+2<NT),(t+2<NT));     ENDW(t+1); RESC(); ROT();
  }
  STEP(pB0,pB1,pA0,pA1,NT-1,false,false,false); RESC();
  { float sacc=pB0[0]+pB0[1]; _Pragma("unroll") for(int r=2;r<16;++r)sacc+=pB0[r]; _Pragma("unroll") for(int r=0;r<16;++r)sacc+=pB1[r]; l_reg+=sacc;
    pw0=(u32x4){PKW(pB0,0),PKW(pB0,2),PKW(pB0,4),PKW(pB0,6)};pw1=(u32x4){PKW(pB0,8),PKW(pB0,10),PKW(pB0,12),PKW(pB0,14)};pw2=(u32x4){PKW(pB1,0),PKW(pB1,2),PKW(pB1,4),PKW(pB1,6)};pw3=(u32x4){PKW(pB1,8),PKW(pB1,10),PKW(pB1,12),PKW(pB1,14)};
    SBAR(); pv(o,vb0+sl_cur,PAF(0),PAF(1),PAF(2),PAF(3)); }
  #undef PKW
  #undef PAF
  #undef VFR
  #undef PIN
  #undef MX3
  #undef GAPA
  #undef GAPB
  #undef EX
  #undef VRD
  #undef KRD
  #undef STEP
  #undef ENDW
  {auto rr=__builtin_amdgcn_permlane32_swap(__float_as_uint(l_reg),__float_as_uint(l_reg),false,false);l_reg=__uint_as_float(rr[0])+__uint_as_float(rr[1]);}
  if(hi==0)wsf[32+r32]=l_reg;asm volatile("s_waitcnt lgkmcnt(0)":::"memory");
  float rli[16];
  #pragma unroll
  for(int r=0;r<16;++r)rli[r]=__builtin_amdgcn_rcpf(wsf[32+crow(r,hi)]);
  bf16*Ow=O+(rowbase+q0+wid*QBLK)*PO+h*D;
  { bf16*stg=(bf16*)(shm+LDS_OST)+wid*2048;
    #pragma unroll
    for(int r=0;r<16;++r){const int orow=crow(r,hi);
      #pragma unroll
      for(int d0=0;d0<2;++d0)stg[orow*64+d0*32+r32]=__float2bfloat16(o[d0][r]*rli[r]);}
    asm volatile("s_waitcnt lgkmcnt(0)":::"memory");
    #pragma unroll
    for(int i=0;i<4;++i){const int row=i*8+(lane>>3),ch=lane&7; const u32x4 v=*(const u32x4*)(stg+row*64+ch*8); ATTN_STORE16(Ow+(long)row*PO+ch*8,v);} }
  asm volatile("s_waitcnt lgkmcnt(0)\n\ts_barrier":::"memory");
  #undef DMA_K
  #undef DMA_V
  #undef CMASK
  #undef START
  #undef RESC
  #undef ROT
}
constexpr int ATTN_LDS_BYTES=LDS_BYTES;
struct AttnTensors { const bf16* Q; const bf16* K; const bf16* V; bf16* O; };
struct AttnUnit { int b; int h; int qb; };
struct StaticOrder {
  int vcu, G;
  __device__ __forceinline__ explicit StaticOrder(int grid,int block):vcu((grid%8==0)?(block%8)*(grid/8)+block/8:block),G(grid){}
  __device__ __forceinline__ bool next(int i,AttnUnit&u)const{ const int L=i*G+vcu; if(L>=BATCH*NHEAD*(SEQ/QB))return false; const int grp=L>>5,r=L&31; u.b=grp>>1; u.h=(grp&1)*4+(r>>3); u.qb=r&7; return true; }
  __device__ __forceinline__ void a_ready(const AttnUnit&)const{}
  __device__ __forceinline__ void done(const AttnUnit&)const{}
};
template<class Sched,int THRL=8> __device__ __forceinline__ void attn_phase(char*lds,const AttnTensors&T,const Sched&S){
  AttnUnit u;
  for(int i=0;S.next(i,u);++i){ S.a_ready(u); attn_unit<THRL>(u.b,u.h,u.qb,T.Q,T.K,T.V,T.O,lds); S.done(u); }
}
#undef SBAR
#undef WAIT_BAR
}


#define GAS __attribute__((address_space(1)))
#define LAS __attribute__((address_space(3)))
typedef unsigned short bf16;
typedef unsigned v4u __attribute__((ext_vector_type(4)));
typedef float f32x4 __attribute__((ext_vector_type(4)));
typedef short bf16x8 __attribute__((ext_vector_type(8)));
typedef GAS unsigned gu32;
typedef GAS unsigned long long gu64;
#define RLX_AGENT __ATOMIC_RELAXED, __HIP_MEMORY_SCOPE_AGENT
#define LDS_WAIT() asm volatile("s_waitcnt lgkmcnt(0)" ::: "memory")
#define VM_WAIT() asm volatile("s_waitcnt vmcnt(0)" ::: "memory")
__device__ __forceinline__ unsigned long long rt() { return __builtin_amdgcn_s_memrealtime(); }
__device__ __forceinline__ unsigned pk2(float lo, float hi) { typedef float f2_ __attribute__((ext_vector_type(2))); typedef __bf16 b2_ __attribute__((ext_vector_type(2))); const f2_ v = {lo, hi}; return __builtin_bit_cast(unsigned, __builtin_convertvector(v, b2_)); }
__device__ __forceinline__ unsigned f2bf(float f) { return pk2(f, 0.f) & 0xffffu; }

#define XB_TMO      128
#define XB_XCNT(j)  (256  + 64 * (j))
#define XB_XSUB(j)  (1280 + 64 * (j))
#define XB_XGEN(j)  (2304 + 64 * (j))
#define XB_TOP      3328
#define XB_TOPGEN   3392
#define XCD_BAR_WORDS 3456
#define XB_SPIN_CAP (1u << 18)

__device__ __forceinline__ unsigned xb_ld(unsigned* p)              { return __hip_atomic_load(p, __ATOMIC_RELAXED, __HIP_MEMORY_SCOPE_AGENT); }
__device__ __forceinline__ unsigned xb_add(unsigned* p, unsigned v) { return __hip_atomic_fetch_add(p, v, __ATOMIC_RELAXED, __HIP_MEMORY_SCOPE_AGENT); }
__device__ __forceinline__ unsigned xb_xcc_id() { return (unsigned)__builtin_amdgcn_s_getreg((3 << 11) | 20) & 0xFu; }
#define XB_SPIN(cond, bar) do { unsigned _sp = 0; while (cond) { __builtin_amdgcn_s_sleep(1); \
    if ((++_sp & 255u) == 0u) { if (xb_ld(&(bar)[XB_TMO])) break; if (_sp > XB_SPIN_CAP) { atomicAdd(&(bar)[XB_TMO], 1u); break; } } } } while (0)

struct XcdBarrier {
    unsigned* bar; unsigned x;
    volatile LAS unsigned* st;
};

__device__ __forceinline__ XcdBarrier xcd_barrier_post(unsigned* bar, volatile LAS unsigned* st) {
    XcdBarrier b; b.bar = bar; b.x = xb_xcc_id(); b.st = st;
    if (threadIdx.x == 0) (void)xb_add(&bar[XB_XCNT(b.x)], 1u);
    return b;
}
__device__ __forceinline__ void xcd_barrier_complete(unsigned* bar, unsigned x, unsigned& nloc, unsigned& nx) {
    const unsigned G = gridDim.x * gridDim.y * gridDim.z;
    unsigned sum, cnt, mine, sp = 0u;
    for (;;) {
        sum = 0u; cnt = 0u; mine = 0u;
#pragma unroll
        for (unsigned j = 0; j < 16; ++j) { const unsigned c = xb_ld(&bar[XB_XCNT(j)]); sum += c; cnt += (c > 0u) ? 1u : 0u; mine = (j == x) ? c : mine; }
        if (sum == G) break;
        __builtin_amdgcn_s_sleep(1);
        if ((++sp & 255u) == 0u) { if (xb_ld(&bar[XB_TMO])) break; if (sp > XB_SPIN_CAP) { atomicAdd(&bar[XB_TMO], 1u); break; } }
    }
    nloc = mine > 0u ? mine : 1u; nx = cnt > 0u ? cnt : 1u;
}

__device__ __forceinline__ void xcd_barrier(const XcdBarrier& b) {
    asm volatile("s_waitcnt vmcnt(0)" ::: "memory");
    __syncthreads();
    if (threadIdx.x == 0) {
        unsigned* bar = b.bar;
        __builtin_amdgcn_s_waitcnt(0);
        unsigned nloc = b.st[0], nx = b.st[1];
        if (nloc == 0u) { xcd_barrier_complete(bar, b.x, nloc, nx); b.st[0] = nloc; b.st[1] = nx; }
        const unsigned old = xb_add(&bar[XB_XSUB(b.x)], 1u);
        const unsigned gen = old / nloc;
        if (old + 1u == (gen + 1u) * nloc) {
            __builtin_amdgcn_fence(__ATOMIC_RELEASE, "agent");
            asm volatile("s_waitcnt vmcnt(0)" ::: "memory");
            const unsigned og = xb_add(&bar[XB_TOP], 1u);
            const unsigned tg = og / nx;
            if (og + 1u == (tg + 1u) * nx) xb_add(&bar[XB_TOPGEN], 1u);
            else XB_SPIN(xb_ld(&bar[XB_TOPGEN]) == tg, bar);
            __builtin_amdgcn_fence(__ATOMIC_ACQUIRE, "agent");
            xb_add(&bar[XB_XGEN(b.x)], 1u);
            asm volatile("s_waitcnt vmcnt(0)" ::: "memory");
        } else {
            XB_SPIN(xb_ld(&bar[XB_XGEN(b.x)]) == gen, bar);
            __builtin_amdgcn_fence(__ATOMIC_ACQUIRE, "agent");
            asm volatile("s_waitcnt vmcnt(0)" ::: "memory");
        }
    }
    __syncthreads();
}

constexpr int NWAVES = 8, NTHR = 512;
constexpr int DM = 1024, NB = 8, SEQ = 2048, DEPTH = 4, M = NB * SEQ;
constexpr int DIN = 2320, NPROJ = 2304;
constexpr int C_Q = 0, C_K = 512, C_V = 640, C_LX = 768, C_LG = 1024, C_MQ = 1280, C_MK = 1536, C_MV = 1792, C_MO = 2048;
constexpr int NE = 16, CAP = 256, DE = 2048, NSLOT = NB * CAP;
constexpr float EPS = 1e-6f;
constexpr int NPH = 1 + 10 * DEPTH;

constexpr size_t MiB = 1u << 20;
constexpr size_t WS_CTL = 0, CTL_ZERO_BYTES = 1 * MiB;
constexpr size_t WS_ROPE = 1 * MiB;
constexpr size_t WS_LRUW = 2 * MiB;
constexpr size_t WS_WIN = 4 * MiB;
constexpr size_t WS_WOUT = 22 * MiB;
constexpr size_t WS_WGU = 32 * MiB;
constexpr size_t WS_WDN = 544 * MiB;
constexpr size_t WS_H = 800 * MiB;
constexpr size_t WS_PROJ = 832 * MiB;
constexpr size_t WS_Y = 904 * MiB;
constexpr size_t WS_MG = 936 * MiB;
constexpr size_t WS_AFF = 937 * MiB;
constexpr size_t WS_SEL = 938 * MiB;
constexpr size_t WS_IDX = 939 * MiB;
constexpr size_t WS_GATE = WS_IDX + 128 * 1024;
constexpr size_t WS_LH = 940 * MiB;
constexpr size_t WS_CP = 956 * MiB;
constexpr size_t WS_CARRY = 972 * MiB;
constexpr size_t WS_CLOC = 974 * MiB;
constexpr size_t WS_NLOC = 990 * MiB;
constexpr size_t WS_MLOC = WS_NLOC + 512 * 1024;
constexpr size_t WS_XG = 992 * MiB;
constexpr size_t WS_HID = 1056 * MiB;
constexpr size_t WS_YE = 1184 * MiB;
constexpr size_t WS_CPREV = 1280 * MiB;
constexpr size_t WS_NPREV = 1288 * MiB;
constexpr size_t WS_MPREV = WS_NPREV + 512 * 1024;
constexpr size_t WS_XB = 1248 * MiB;
constexpr size_t WS_END = 1290 * MiB;
constexpr int CW_BAR = 4096;

constexpr int RING_OFF = 0, RING_BYTES = 143360;
constexpr int MISC_OFF = RING_BYTES;
constexpr int LDS_BYTES = 147456;

typedef unsigned u32x2 __attribute__((ext_vector_type(2)));
__device__ __forceinline__ float bf2f(unsigned short v) { return __uint_as_float(((unsigned)v) << 16); }
__device__ __forceinline__ float bflo(unsigned v) { return __uint_as_float(v << 16); }
__device__ __forceinline__ float bfhi(unsigned v) { return __uint_as_float(v & 0xffff0000u); }
template <int CTRL> __device__ __forceinline__ float dppf(float v) { return __uint_as_float((unsigned)__builtin_amdgcn_update_dpp(0, (int)__float_as_uint(v), CTRL, 0xF, 0xF, true)); }
__device__ __forceinline__ float row16_sum(float v) { v += dppf<0xB1>(v); v += dppf<0x4E>(v); v += dppf<0x141>(v); v += dppf<0x140>(v); return v; }
__device__ __forceinline__ float xor16_sum(float v) { const auto r = __builtin_amdgcn_permlane16_swap(__float_as_uint(v), __float_as_uint(v), false, false); return __uint_as_float(r[0]) + __uint_as_float(r[1]); }
__device__ __forceinline__ float xor32_sum(float v) { const auto r = __builtin_amdgcn_permlane32_swap(__float_as_uint(v), __float_as_uint(v), false, false); return __uint_as_float(r[0]) + __uint_as_float(r[1]); }
__device__ __forceinline__ float half_sum(float v) { return xor16_sum(row16_sum(v)); }
__device__ __forceinline__ float wave_sum(float v) { return xor32_sum(xor16_sum(row16_sum(v))); }
__device__ __forceinline__ void reduce16(const float (&p)[16], float (&r)[4]) {
    float q[8];
#pragma unroll
    for (int j = 0; j < 8; ++j) { const auto t = __builtin_amdgcn_permlane32_swap(__float_as_uint(p[j]), __float_as_uint(p[j + 8]), false, false); q[j] = __uint_as_float(t[0]) + __uint_as_float(t[1]); }
#pragma unroll
    for (int j = 0; j < 4; ++j) { const auto t = __builtin_amdgcn_permlane16_swap(__float_as_uint(q[j]), __float_as_uint(q[j + 4]), false, false); r[j] = row16_sum(__uint_as_float(t[0]) + __uint_as_float(t[1])); }
}
__device__ __forceinline__ float wave_max(float v) {
#pragma unroll
    for (int o = 1; o < 64; o <<= 1) v = fmaxf(v, __shfl_xor(v, o));
    return v;
}
__device__ __forceinline__ float fexp(float x) { return __builtin_amdgcn_exp2f(1.4426950408889634f * x); }
__device__ __forceinline__ float frcp(float x) { return __builtin_amdgcn_rcpf(x); }
__device__ __forceinline__ float frsq(float x) { return __builtin_amdgcn_rsqf(x); }
__device__ __forceinline__ float sigmoid_f(float x) { return frcp(1.0f + fexp(-x)); }
__device__ __forceinline__ float one_minus_exp(float x) {
    const float p = -x * (1.0f + 0.5f * x * (1.0f + (1.0f / 3.0f) * x * (1.0f + 0.25f * x * (1.0f + 0.2f * x))));
    return (x > -0.25f) ? p : 1.0f - fexp(x); }
__device__ __forceinline__ float logsig_f(float x) { return fminf(x, 0.f) - log1pf(expf(-fabsf(x))); }
__device__ __forceinline__ float gelu_tanh_f(float x) { const float u = 0.7978845608028654f * (x + 0.044715f * x * x * x); return x * (1.0f - frcp(1.0f + fexp(2.0f * u))); }
template <bool MAXOP, bool REV> __device__ __forceinline__ void wave_scan128(const LAS float* in, LAS float* out, int lane) {
    const int j0 = REV ? 127 - 2 * lane : 2 * lane, j1 = REV ? 126 - 2 * lane : 2 * lane + 1;
    const float a = in[j0], b = in[j1];
    const float s1 = MAXOP ? fmaxf(a, b) : a + b;
    float incl = s1;
#pragma unroll
    for (int o = 1; o < 64; o <<= 1) { const float t = __shfl_up(incl, o); if (lane >= o) incl = MAXOP ? fmaxf(incl, t) : incl + t; }
    const float ex = __shfl_up(incl, 1);
    const float e = (lane == 0) ? (MAXOP ? -INFINITY : 0.f) : ex;
    out[j0] = MAXOP ? fmaxf(e, a) : e + a; out[j1] = MAXOP ? fmaxf(e, s1) : e + s1;
}
#define WAVE_LDS_FENCE() asm volatile("s_waitcnt lgkmcnt(0)" ::: "memory")
#define MFMA16(a, b, c) __builtin_amdgcn_mfma_f32_16x16x32_bf16((a), (b), (c), 0, 0, 0)
#define WG_SYNC() __syncthreads()

struct Args { const float* in[22]; float* out; unsigned char* ws; int ph_lo, ph_hi, li, pad; };
enum { I_X = 0, I_N1G, I_WIN, I_QG, I_KG, I_CW, I_CB, I_WA, I_BA, I_WX, I_BX, I_LAM, I_FB, I_MNG, I_AOG, I_LOG, I_WOUT, I_N2G, I_WR, I_WG, I_WU, I_WD };

__device__ __forceinline__ void cvt_item(const float* __restrict__ src, int N, int k0, int n0, bf16* dst, int Kd, LAS float* scr, int lane) {
    { const int r4 = lane >> 4, c4 = lane & 15; f32x4 t[16];
#pragma unroll
      for (int i = 0; i < 16; ++i) t[i] = __builtin_nontemporal_load((const f32x4*)(src + (size_t)(k0 + 4 * i + r4) * N + n0 + 4 * c4));
#pragma unroll
      for (int i = 0; i < 16; ++i) { LAS float* d = scr + (4 * i + r4) * 65 + 4 * c4; d[0] = t[i][0]; d[1] = t[i][1]; d[2] = t[i][2]; d[3] = t[i][3]; } }
    LDS_WAIT(); asm volatile("" ::: "memory");
    const int c = lane >> 3, nn = lane & 7;
#pragma unroll
    for (int j = 0; j < 8; ++j) { const int n = nn + 8 * j; const LAS float* s = scr + (8 * c) * 65 + n;
        v4u o; o.x = pk2(s[0], s[65]); o.y = pk2(s[130], s[195]); o.z = pk2(s[260], s[325]); o.w = pk2(s[390], s[455]);
        *(GAS v4u*)(dst + (size_t)n * Kd + 8 * c) = o; }
    LDS_WAIT(); asm volatile("" ::: "memory");
}
__device__ __forceinline__ void cvt_item8(const float* __restrict__ src, int N, int k0, int n0, unsigned char* dst, int Kd, LAS float* scr, int lane) {
    { const int r8 = lane >> 3, c8 = lane & 7; f32x4 t[16];
#pragma unroll
      for (int i = 0; i < 16; ++i) t[i] = __builtin_nontemporal_load((const f32x4*)(src + (size_t)(k0 + 8 * i + r8) * N + n0 + 4 * c8));
#pragma unroll
      for (int i = 0; i < 16; ++i) { LAS float* d = scr + (8 * i + r8) * 33 + 4 * c8; d[0] = t[i][0]; d[1] = t[i][1]; d[2] = t[i][2]; d[3] = t[i][3]; } }
    LDS_WAIT(); asm volatile("" ::: "memory");
    const int c = lane >> 3, nn = lane & 7; constexpr float sc = pg8::WSCALE;
#pragma unroll
    for (int j = 0; j < 4; ++j) { const int n = nn + 8 * j; const LAS float* s = scr + (16 * c) * 33 + n;
        v4u o; o.x = pg8::pk4_fp8(s[0] * sc, s[33] * sc, s[66] * sc, s[99] * sc); o.y = pg8::pk4_fp8(s[132] * sc, s[165] * sc, s[198] * sc, s[231] * sc);
        o.z = pg8::pk4_fp8(s[264] * sc, s[297] * sc, s[330] * sc, s[363] * sc); o.w = pg8::pk4_fp8(s[396] * sc, s[429] * sc, s[462] * sc, s[495] * sc);
        *(GAS v4u*)(dst + (size_t)n * Kd + 16 * c) = o; }
    LDS_WAIT(); asm volatile("" ::: "memory");
}
__device__ __forceinline__ void p0_weights(const Args& a, LAS unsigned char* lds, int tid, int lane, int wave, int G, int bid) {
    unsigned char* ws = a.ws;
    LAS float* scr = (LAS float*)(lds + RING_OFF + wave * 16896);
    const int gw = bid * NWAVES + wave, NGW = G * NWAVES;
    constexpr int I_IN = 16 * 36, I_OUT = 16 * 16, I_EXP = 1536, PER_LAYER = I_IN + I_OUT + NE * I_EXP, NITEMS = DEPTH * PER_LAYER;
    for (int it = gw; it < NITEMS; it += NGW) {
        const int l = it / PER_LAYER; int r = it - l * PER_LAYER;
        if (r < I_IN) { const int kb = r / 36, nb = r - kb * 36;
            cvt_item(a.in[I_WIN] + (size_t)l * DM * DIN, DIN, 64 * kb, 64 * nb, (bf16*)(ws + WS_WIN) + ((size_t)l * NPROJ + 64 * nb) * DM + 64 * kb, DM, scr, lane); continue; }
        r -= I_IN;
        if (r < I_OUT) { const int kb = r >> 4, nb = r & 15;
            cvt_item(a.in[I_WOUT] + (size_t)l * DM * DM, DM, 64 * kb, 64 * nb, (bf16*)(ws + WS_WOUT) + ((size_t)l * DM + 64 * nb) * DM + 64 * kb, DM, scr, lane); continue; }
        r -= I_OUT;
        const int e = r / I_EXP; int r2 = r - e * I_EXP; const size_t le = (size_t)l * NE + e;
        LAS float* scr8 = (LAS float*)(lds + RING_OFF + wave * 16896);
        if (r2 < 1024) { const int up = r2 >> 9; r2 &= 511; const int kb = r2 >> 6, nb = r2 & 63, n0 = 32 * nb, drow = 256 * (n0 >> 7) + (n0 & 127) + 128 * up;
            cvt_item8(a.in[up ? I_WU : I_WG] + le * DM * DE, DE, 128 * kb, n0, ws + WS_WGU + (le * 4096 + drow) * DM + 128 * kb, DM, scr8, lane); continue; }
        r2 -= 1024; { const int kb = r2 >> 5, nb = r2 & 31;
            cvt_item8(a.in[I_WD] + le * DE * DM, DM, 128 * kb, 32 * nb, ws + WS_WDN + (le * DM + 32 * nb) * DE + 128 * kb, DE, scr8, lane); }
    }
    const int gt = bid * NTHR + tid, GT = G * NTHR;
    bf16* lw = (bf16*)(ws + WS_LRUW);
    for (int i = gt; i < DEPTH * 2 * 2 * 4 * 4096; i += GT) { const int d = i & 63, e = (i >> 6) & 63, n = (i >> 12) & 3, gate = (i >> 14) & 1, dir = (i >> 15) & 1, l = i >> 16;
        const float* src = a.in[gate ? I_WX : I_WA]; lw[i] = (bf16)f2bf(src[((((size_t)l * 2 + dir) * 4 + n) * 64 + d) * 64 + e]); }
    float* rc = (float*)(ws + WS_ROPE); float* rs = rc + SEQ * 32;
    for (int i = gt; i < SEQ * 32; i += GT) { const int s = i >> 5, j = i & 31, f = j & 15; const float pos = (float)((j < 16) ? (s >> 6) : (s & 63));
        const float inv = 1.0f / powf(10000.0f, (float)f * (1.0f / 16.0f)); const float ang = pos * inv; rc[i] = cosf(ang); rs[i] = sinf(ang); }
}

template <int MODE, bool XB16>
__device__ __forceinline__ void row_pass(const void* xin_, void* xout_, const float* gain, const float* WT  , int sk, bf16* H, float* O16, const int* SEL, const bf16* YE,
                                         LAS unsigned char* lds, int tid, int lane, int wave, int G, int bid) {
    constexpr int WLS = 1028;
    LAS float* wl = (LAS float*)(lds + RING_OFF);
    if (MODE != 3) { float wv[32];
#pragma unroll
        for (int q = 0; q < 32; ++q) { const int i = tid + q * NTHR; wv[q] = WT[(size_t)(i >> 4) * sk + (i & 15)]; }
#pragma unroll
        for (int q = 0; q < 32; ++q) { const int i = tid + q * NTHR; wl[(i & 15) * WLS + (i >> 4)] = wv[q]; } }
    WG_SYNC();
    const int gw = bid * NWAVES + wave, NGW = G * NWAVES;
    f32x4 gq4[4];
#pragma unroll
    for (int j = 0; j < 4; ++j) gq4[j] = (MODE != 3) ? *((const f32x4*)gain + 64 * j + lane) : (f32x4){0.f, 0.f, 0.f, 0.f};
    constexpr int R = 4;
    for (int m0 = R * gw; m0 < M; m0 += R * NGW) {
        asm volatile("" ::: "memory");
        f32x4 v[R][4];
#pragma unroll
        for (int r = 0; r < R; ++r)
#pragma unroll
            for (int j = 0; j < 4; ++j) {
                if (XB16) { const u32x2 q = *((const u32x2*)((const bf16*)xin_ + (size_t)(m0 + r) * DM) + 64 * j + lane); v[r][j] = (f32x4){bflo(q.x), bfhi(q.x), bflo(q.y), bfhi(q.y)}; }
                else v[r][j] = *((const f32x4*)((const float*)xin_ + (size_t)(m0 + r) * DM) + 64 * j + lane); }
        if (MODE >= 2) {
            const int b = m0 >> 11; int selv[R]; unsigned long long mk[R];
#pragma unroll
            for (int r = 0; r < R; ++r) { selv[r] = (lane < NE) ? SEL[(size_t)(m0 + r) * NE + lane] : -1; }
#pragma unroll
            for (int r = 0; r < R; ++r) mk[r] = __ballot(selv[r] >= 0);
            while (mk[0] | mk[1] | mk[2] | mk[3]) {
                u32x2 q[R][2][4]; float wt[R][2];
#pragma unroll
                for (int r = 0; r < R; ++r)
#pragma unroll
                    for (int i = 0; i < 2; ++i) { const bf16* yr = YE; wt[r][i] = 0.f;
                        if (mk[r]) { const int e = __builtin_ctzll(mk[r]); mk[r] &= mk[r] - 1ull; const int sl = __builtin_amdgcn_readlane(selv[r], e);
                            yr = YE + ((size_t)e * NSLOT + b * CAP + sl) * DM; wt[r][i] = 1.f; }
#pragma unroll
                        for (int j = 0; j < 4; ++j) q[r][i][j] = *((const u32x2*)yr + 64 * j + lane); }
#pragma unroll
                for (int r = 0; r < R; ++r)
#pragma unroll
                    for (int i = 0; i < 2; ++i)
#pragma unroll
                        for (int j = 0; j < 4; ++j) { const u32x2 w = q[r][i][j]; const float t = wt[r][i];
                            v[r][j][0] += t * bflo(w.x); v[r][j][1] += t * bfhi(w.x); v[r][j][2] += t * bflo(w.y); v[r][j][3] += t * bfhi(w.y); }
            }
#pragma unroll
            for (int r = 0; r < R; ++r)
#pragma unroll
                for (int j = 0; j < 4; ++j) {
                    if (MODE == 3) *((f32x4*)((float*)xout_ + (size_t)(m0 + r) * DM) + 64 * j + lane) = v[r][j];
                    else { u32x2 o; o.x = pk2(v[r][j][0], v[r][j][1]); o.y = pk2(v[r][j][2], v[r][j][3]); *((u32x2*)((bf16*)xout_ + (size_t)(m0 + r) * DM) + 64 * j + lane) = o;
                        v[r][j] = (f32x4){bflo(o.x), bfhi(o.x), bflo(o.y), bfhi(o.y)}; } }
        }
        if (MODE == 3) continue;
        float ss[R];
#pragma unroll
        for (int r = 0; r < R; ++r) { float a = 0.f;
#pragma unroll
            for (int j = 0; j < 4; ++j) a += (v[r][j][0] * v[r][j][0] + v[r][j][1] * v[r][j][1]) + (v[r][j][2] * v[r][j][2] + v[r][j][3] * v[r][j][3]);
            ss[r] = wave_sum(a); }
#pragma unroll
        for (int r = 0; r < R; ++r) { const float rstd = frsq(ss[r] * (1.0f / DM) + EPS);
#pragma unroll
            for (int j = 0; j < 4; ++j) { v[r][j] = v[r][j] * rstd * gq4[j];
                if (MODE == 1) { *((unsigned*)((unsigned char*)H + (size_t)(m0 + r) * DM) + 64 * j + lane) = pg8::pk4_fp8(v[r][j][0], v[r][j][1], v[r][j][2], v[r][j][3]); }
                else { u32x2 o; o.x = pk2(v[r][j][0], v[r][j][1]); o.y = pk2(v[r][j][2], v[r][j][3]); *((u32x2*)(H + (size_t)(m0 + r) * DM) + 64 * j + lane) = o; } } }
        typedef float f32x2_ __attribute__((ext_vector_type(2)));
        float t4[R][4];
#pragma unroll
        for (int j4 = 0; j4 < 4; ++j4) { float pp[4][R];
#pragma unroll
            for (int h = 0; h < 4; ++h) { const int jj = j4 + 4 * h; f32x2_ a2[R];
#pragma unroll
                for (int r = 0; r < R; ++r) a2[r] = (f32x2_){0.f, 0.f};
#pragma unroll
                for (int j = 0; j < 4; ++j) { const f32x4 w = *((LAS f32x4*)(wl + jj * WLS) + 64 * j + lane); const f32x2_ wlo = (f32x2_){w[0], w[1]}, whi = (f32x2_){w[2], w[3]};
#pragma unroll
                    for (int r = 0; r < R; ++r) { a2[r] += (f32x2_){v[r][j][0], v[r][j][1]} * wlo; a2[r] += (f32x2_){v[r][j][2], v[r][j][3]} * whi; } }
#pragma unroll
                for (int r = 0; r < R; ++r) pp[h][r] = a2[r][0] + a2[r][1]; }
#pragma unroll
            for (int r = 0; r < R; ++r) {
                const auto ta = __builtin_amdgcn_permlane32_swap(__float_as_uint(pp[0][r]), __float_as_uint(pp[2][r]), false, false); const float qa = __uint_as_float(ta[0]) + __uint_as_float(ta[1]);
                const auto tb = __builtin_amdgcn_permlane32_swap(__float_as_uint(pp[1][r]), __float_as_uint(pp[3][r]), false, false); const float qb = __uint_as_float(tb[0]) + __uint_as_float(tb[1]);
                const auto tc = __builtin_amdgcn_permlane16_swap(__float_as_uint(qa), __float_as_uint(qb), false, false); t4[r][j4] = row16_sum(__uint_as_float(tc[0]) + __uint_as_float(tc[1])); }
            __builtin_amdgcn_sched_barrier(0); }
#pragma unroll
        for (int r = 0; r < R; ++r) { const int m = m0 + r;
            const int li = lane & 15, rho = lane >> 4, jj = (li & 3) + 4 * (rho & 1) + 8 * (rho >> 1);
            if (MODE == 1) {
                const float lm = fmaxf(fmaxf(t4[r][0], t4[r][1]), fmaxf(t4[r][2], t4[r][3]));
                const auto ta = __builtin_amdgcn_permlane16_swap(__float_as_uint(lm), __float_as_uint(lm), false, false); const float m1 = fmaxf(__uint_as_float(ta[0]), __uint_as_float(ta[1]));
                const auto tb = __builtin_amdgcn_permlane32_swap(__float_as_uint(m1), __float_as_uint(m1), false, false); const float mx = fmaxf(__uint_as_float(tb[0]), __uint_as_float(tb[1]));
                const float e0 = fexp(t4[r][0] - mx), e1 = fexp(t4[r][1] - mx), e2 = fexp(t4[r][2] - mx), e3 = fexp(t4[r][3] - mx);
                const float sum = xor32_sum(xor16_sum((e0 + e1) + (e2 + e3)));
                const float mine = (li & 3) == 0 ? e0 : (li & 3) == 1 ? e1 : (li & 3) == 2 ? e2 : e3;
                if (li < 4) O16[(((size_t)(m >> 11) * NE + jj) << 11) + (m & 2047)] = mine / sum;
            } else {
#pragma unroll
                for (int j = 0; j < 4; ++j) if (li == j) O16[(size_t)m * 16 + jj] = t4[r][j];
            } }
    }
}

__device__ __forceinline__ void rope_pass(const Args& a, int l, int lane, int wave, int G, int bid, bf16* DST) {
    bf16* PROJ = (bf16*)(a.ws + WS_PROJ); const float* rc = (const float*)(a.ws + WS_ROPE); const float* rs = rc + SEQ * 32;
    const float* qg = a.in[I_QG] + l * 64; const float* kg = a.in[I_KG] + l * 64;
    const int gw = bid * NWAVES + wave, NGW = G * NWAVES, j = lane & 31;
    const float qg1 = qg[j], qg2 = qg[32 + j], kg1 = kg[j], kg2 = kg[32 + j];
    for (int mb = 4 * gw; mb < M; mb += 4 * NGW) {
        float x1[4][5], x2[4][5], cs[4], sn[4];
#pragma unroll
        for (int r = 0; r < 4; ++r) { const bf16* row = PROJ + (size_t)(mb + r) * NPROJ; const int s = (mb + r) & 2047; cs[r] = rc[s * 32 + j]; sn[r] = rs[s * 32 + j];
#pragma unroll
            for (int it = 0; it < 5; ++it) { const int hh = 2 * it + (lane >> 5); x1[r][it] = bf2f(row[hh * 64 + j]); x2[r][it] = bf2f(row[hh * 64 + 32 + j]); } }
#pragma unroll
        for (int r = 0; r < 4; ++r) { bf16* row = DST + (size_t)(mb + r) * NPROJ;
#pragma unroll
            for (int it = 0; it < 5; ++it) { const int hh = 2 * it + (lane >> 5);
                const float ss = half_sum(x1[r][it] * x1[r][it] + x2[r][it] * x2[r][it]);
                const float rstd = frsq(ss * (1.0f / 64.0f) + EPS);
                const float n1 = x1[r][it] * rstd * (it < 4 ? qg1 : kg1), n2 = x2[r][it] * rstd * (it < 4 ? qg2 : kg2);
                float o1 = n1 * cs[r] - n2 * sn[r], o2 = n2 * cs[r] + n1 * sn[r];
                if (it < 4) { o1 *= attn_body::C2; o2 *= attn_body::C2; }
                row[hh * 64 + j] = (bf16)f2bf(o1); row[hh * 64 + 32 + j] = (bf16)f2bf(o2); } }
    }
}

constexpr int XS = 260;
constexpr int XSB = 264;
__device__ __forceinline__ void lru_a_unit(const Args& a, int l, int unit, LAS unsigned char* lds, int tid, int lane, int wave) {
    const int b = unit >> 6, c32 = unit & 63, t0 = c32 * 32; const size_t m0 = (size_t)b * SEQ + t0;
    LAS bf16* XCb = (LAS bf16*)(lds + RING_OFF);
    LAS float* AA = (LAS float*)(lds + RING_OFF + 32 * XSB * 2);
    LAS bf16* UUb = (LAS bf16*)(AA + 2 * 32 * XS);
    const bf16* PROJ = (const bf16*)(a.ws + WS_PROJ);
    const int n = wave >> 1, hh = wave & 1, li = lane & 15, g = lane >> 4;
    bf16x8 wfr[2][2][2][2];
#pragma unroll
    for (int dir = 0; dir < 2; ++dir)
#pragma unroll
        for (int gate = 0; gate < 2; ++gate) { const bf16* W = (const bf16*)(a.ws + WS_LRUW) + ((((size_t)l * 2 + dir) * 2 + gate) * 4 + n) * 4096;
#pragma unroll
            for (int nt = 0; nt < 2; ++nt)
#pragma unroll
                for (int ks = 0; ks < 2; ++ks) wfr[dir][gate][nt][ks] = *(const bf16x8*)(W + (32 * hh + 16 * nt + li) * 64 + 32 * ks + 8 * g); }
    float bav[2][2], bxv[2][2], lamv[2][2];
#pragma unroll
    for (int dir = 0; dir < 2; ++dir)
#pragma unroll
        for (int nt = 0; nt < 2; ++nt) { const size_t pi = ((size_t)l * 2 + dir) * 256 + 64 * n + 32 * hh + 16 * nt + li; bav[dir][nt] = a.in[I_BA][pi]; bxv[dir][nt] = a.in[I_BX][pi]; lamv[dir][nt] = a.in[I_LAM][pi]; }
    {
        const int ch2 = tid & 127, rg = tid >> 7, ch = 2 * ch2;
        float x0[11], x1[11];
#pragma unroll
        for (int i = 0; i < 11; ++i) { const int s = t0 + rg * 8 - 2 + i; unsigned v = 0u;
            if (s >= 0 && s < SEQ) v = *(const unsigned*)(PROJ + ((size_t)b * SEQ + s) * NPROJ + C_LX + ch);
            x0[i] = bflo(v); x1[i] = bfhi(v); }
        const float* cw = a.in[I_CW] + (size_t)l * 4 * 256; const float* cb = a.in[I_CB] + (size_t)l * 256;
        float w0[4], w1[4];
#pragma unroll
        for (int j = 0; j < 4; ++j) { w0[j] = cw[j * 256 + ch]; w1[j] = cw[j * 256 + ch + 1]; }
        const float b0 = cb[ch], b1 = cb[ch + 1];
#pragma unroll
        for (int r = 0; r < 8; ++r) { float y0 = b0, y1 = b1;
#pragma unroll
            for (int j = 0; j < 4; ++j) { y0 += x0[r + j] * w0[j]; y1 += x1[r + j] * w1[j]; }
            *(LAS unsigned*)(XCb + (rg * 8 + r) * XSB + ch) = pk2(y0, y1); }
    }
    WG_SYNC();
    bf16x8 af[2][2];
#pragma unroll
    for (int mt = 0; mt < 2; ++mt)
#pragma unroll
        for (int ks = 0; ks < 2; ++ks) af[mt][ks] = *(const LAS bf16x8*)(XCb + (16 * mt + li) * XSB + 64 * n + 32 * ks + 8 * g);
#pragma unroll
    for (int dir = 0; dir < 2; ++dir) {
        f32x4 accA[2][2], accX[2][2];
#pragma unroll
        for (int i = 0; i < 2; ++i)
#pragma unroll
            for (int j = 0; j < 2; ++j) { accA[i][j] = (f32x4){0.f, 0.f, 0.f, 0.f}; accX[i][j] = (f32x4){0.f, 0.f, 0.f, 0.f}; }
#pragma unroll
        for (int ks = 0; ks < 2; ++ks)
#pragma unroll
            for (int nt = 0; nt < 2; ++nt)
#pragma unroll
                for (int mt = 0; mt < 2; ++mt) { accA[mt][nt] = MFMA16(af[mt][ks], wfr[dir][0][nt][ks], accA[mt][nt]); accX[mt][nt] = MFMA16(af[mt][ks], wfr[dir][1][nt][ks], accX[mt][nt]); }
#pragma unroll
        for (int nt = 0; nt < 2; ++nt) { const int ch = 64 * n + 32 * hh + 16 * nt + li; const float lam = lamv[dir][nt];
            const float sp = fmaxf(-lam, 0.f) + log1pf(expf(-fabsf(lam)));
#pragma unroll
            for (int mt = 0; mt < 2; ++mt)
#pragma unroll
                for (int r = 0; r < 4; ++r) { const int t = 16 * mt + 4 * g + r;
                    const float rg_ = sigmoid_f(accA[mt][nt][r] + bav[dir][nt]), ig_ = sigmoid_f(accX[mt][nt][r] + bxv[dir][nt]);
                    const float la = -8.0f * rg_ * sp; const float av = fexp(la);
                    const float uv = __builtin_amdgcn_sqrtf(one_minus_exp(2.0f * la)) * (ig_ * bf2f(XCb[t * XSB + ch]));
                    AA[(dir * 32 + t) * XS + ch] = av; UUb[(dir * 32 + t) * XSB + ch] = (bf16)f2bf(uv); } }
    }
    WG_SYNC();
    { const int dir = tid >> 8, ch = tid & 255; float h = 0.f, cp = 1.f;
      bf16* lh = (bf16*)(a.ws + WS_LH) + ((size_t)dir * M + m0) * 256 + ch; bf16* cpo = (bf16*)(a.ws + WS_CP) + ((size_t)dir * M + m0) * 256 + ch;
      float av[32], uv[32];
#pragma unroll
      for (int q = 0; q < 32; ++q) { av[q] = AA[(dir * 32 + q) * XS + ch]; uv[q] = bf2f(UUb[(dir * 32 + q) * XSB + ch]); }
      if (dir == 0) {
#pragma unroll
          for (int q = 0; q < 32; ++q) { h = av[q] * h + uv[q]; cp *= av[q]; lh[(size_t)q * 256] = (bf16)f2bf(h); cpo[(size_t)q * 256] = (bf16)f2bf(cp); }
      } else {
#pragma unroll
          for (int q = 31; q >= 0; --q) { h = av[q] * h + uv[q]; cp *= av[q]; lh[(size_t)q * 256] = (bf16)f2bf(h); cpo[(size_t)q * 256] = (bf16)f2bf(cp); }
      }
      float* cr = (float*)(a.ws + WS_CARRY) + ((((size_t)dir * NB + b) * 64 + c32) * 2) * 256 + ch; cr[0] = cp; cr[256] = h; }
    WG_SYNC();
}

__device__ __forceinline__ void p4_rows_unit(const Args& a, int l, int unit, LAS unsigned char* lds, int tid, int lane, int wave) {
    const int b = unit >> 5, c0 = 2 * (unit & 31); const size_t m0 = (size_t)b * SEQ + c0 * 32;
    LAS float* CIN = (LAS float*)(lds + RING_OFF);
    const float* CARRY = (const float*)(a.ws + WS_CARRY);
    { const int dir = tid >> 8, ch = tid & 255; const float* cr = CARRY + (((size_t)dir * NB + b) * 64) * 512 + ch; float cin = 0.f;
      const int cs = dir ? c0 + 1 : c0;
      const int n = dir ? 63 - cs : cs;
      for (int base = 0; base < n; base += 16) { float P[16], Hh[16];
#pragma unroll
          for (int i = 0; i < 16; ++i) { const int q = base + i; const bool v = q < n; const int k = v ? (dir ? 63 - q : q) : cs;
              const float p = cr[(size_t)k * 512], h = cr[(size_t)k * 512 + 256]; P[i] = v ? p : 1.f; Hh[i] = v ? h : 0.f; }
#pragma unroll
          for (int i = 0; i < 16; ++i) cin = P[i] * cin + Hh[i]; }
      const float cin2 = cr[(size_t)cs * 512] * cin + cr[(size_t)cs * 512 + 256];
      CIN[((cs - c0) * 2 + dir) * 256 + ch] = cin; CIN[((1 - (cs - c0)) * 2 + dir) * 256 + ch] = cin2; }
    WG_SYNC();
    const bf16* LH = (const bf16*)(a.ws + WS_LH); const bf16* CPb = (const bf16*)(a.ws + WS_CP); const bf16* PROJ = (const bf16*)(a.ws + WS_PROJ); bf16* Y = (bf16*)(a.ws + WS_Y);
    const f32x4 og = *(const f32x4*)(a.in[I_LOG] + (size_t)l * 256 + 4 * lane);
    const float* gq = a.in[I_AOG] + (size_t)l * 512 + 8 * lane; const f32x4 g0 = *(const f32x4*)gq, g1 = *(const f32x4*)(gq + 4);
#pragma unroll
    for (int it = 0; it < 2; ++it) { const int tl = wave * 8 + it * 4;
        const LAS float* ci = CIN + (tl >> 5) * 512; const f32x4 cf = *(const LAS f32x4*)(ci + 4 * lane), cb = *(const LAS f32x4*)(ci + 256 + 4 * lane);
        v4u ya[4]; u32x2 lf[4], pf[4], lb[4], pb[4], gt[4];
#pragma unroll
        for (int r = 0; r < 4; ++r) { const size_t m = m0 + tl + r;
            ya[r] = *(const v4u*)(Y + m * DM + 8 * lane);
            lf[r] = *(const u32x2*)(LH + m * 256 + 4 * lane); pf[r] = *(const u32x2*)(CPb + m * 256 + 4 * lane);
            lb[r] = *(const u32x2*)(LH + ((size_t)M + m) * 256 + 4 * lane); pb[r] = *(const u32x2*)(CPb + ((size_t)M + m) * 256 + 4 * lane);
            gt[r] = *(const u32x2*)(PROJ + m * NPROJ + C_LG + 4 * lane); }
#pragma unroll
        for (int r = 0; r < 4; ++r) { const size_t m = m0 + tl + r;
            {
                const float x[8] = {bflo(ya[r].x), bfhi(ya[r].x), bflo(ya[r].y), bfhi(ya[r].y), bflo(ya[r].z), bfhi(ya[r].z), bflo(ya[r].w), bfhi(ya[r].w)}; float ss = 0.f;
#pragma unroll
                for (int i = 0; i < 8; ++i) ss += x[i] * x[i];
                const float rstd = frsq(wave_sum(ss) * (1.0f / 512.0f) + EPS);
                v4u o; o.x = pk2(x[0] * rstd * g0[0], x[1] * rstd * g0[1]); o.y = pk2(x[2] * rstd * g0[2], x[3] * rstd * g0[3]);
                o.z = pk2(x[4] * rstd * g1[0], x[5] * rstd * g1[1]); o.w = pk2(x[6] * rstd * g1[2], x[7] * rstd * g1[3]); *(v4u*)(Y + m * DM + 8 * lane) = o; }
            {
                f32x4 h;
                h[0] = (bflo(lf[r].x) + bflo(pf[r].x) * cf[0]) + (bflo(lb[r].x) + bflo(pb[r].x) * cb[0]);
                h[1] = (bfhi(lf[r].x) + bfhi(pf[r].x) * cf[1]) + (bfhi(lb[r].x) + bfhi(pb[r].x) * cb[1]);
                h[2] = (bflo(lf[r].y) + bflo(pf[r].y) * cf[2]) + (bflo(lb[r].y) + bflo(pb[r].y) * cb[2]);
                h[3] = (bfhi(lf[r].y) + bfhi(pf[r].y) * cf[3]) + (bfhi(lb[r].y) + bfhi(pb[r].y) * cb[3]);
                h[0] *= gelu_tanh_f(bflo(gt[r].x)); h[1] *= gelu_tanh_f(bfhi(gt[r].x)); h[2] *= gelu_tanh_f(bflo(gt[r].y)); h[3] *= gelu_tanh_f(bfhi(gt[r].y));
                const float ss = wave_sum((h[0] * h[0] + h[1] * h[1]) + (h[2] * h[2] + h[3] * h[3]));
                const float rstd = frsq(ss * (1.0f / 256.0f) + EPS);
                u32x2 o; o.x = pk2(h[0] * rstd * og[0], h[1] * rstd * og[1]); o.y = pk2(h[2] * rstd * og[2], h[3] * rstd * og[3]);
                *(u32x2*)(Y + m * DM + 512 + 4 * lane) = o; } } }
    WG_SYNC();
}

struct MlsGateRaw { float i_f, f_f, i_b, f_b; };
__device__ __forceinline__ MlsGateRaw mls_gates_load(const Args& a, int l, size_t m0, int hd, int tid) {
    MlsGateRaw r{0.f, 0.f, 0.f, 0.f};
    if (tid < 128) { const float* p = (const float*)(a.ws + WS_MG) + (m0 + tid) * 16; const float* fb = a.in[I_FB] + (size_t)l * 8;
        r.i_f = p[hd]; r.f_f = p[4 + hd] + fb[hd]; r.i_b = p[8 + hd]; r.f_b = p[12 + hd] + fb[4 + hd]; }
    return r;
}
__device__ __forceinline__ void mls_gates_store(const MlsGateRaw& r, LAS float* GL, int tid) {
    if (tid < 128) { GL[tid] = logsig_f(r.f_f); GL[128 + tid] = logsig_f(r.f_b); GL[256 + tid] = r.i_f; GL[384 + tid] = r.i_b; }
}
__device__ __forceinline__ void mls_gates_scan(LAS float* GL, int wave, int lane) {
    if (wave == 0) wave_scan128<false, false>(GL, GL + 512, lane);
    else if (wave == 1) wave_scan128<false, true>(GL + 128, GL + 640, lane);
}
constexpr int TS = 136;
constexpr int QS_ = 72;

__device__ __forceinline__ void mls_a_unit(const Args& a, int l, int unit, LAS unsigned char* lds, int tid, int lane, int wave) {
    const int c = unit & 15, hd = (unit >> 4) & 3, b = unit >> 6; const size_t m0 = (size_t)b * SEQ + c * 128;
    LAS float* GL = (LAS float*)(lds + RING_OFF);
    LAS float* WW = GL + 768;
    LAS bf16* VT = (LAS bf16*)(lds + RING_OFF + 4096); LAS bf16* KF = VT + 64 * TS; LAS bf16* KB = KF + 64 * TS;
    const MlsGateRaw graw = mls_gates_load(a, l, m0, hd, tid);
    const int j = tid & 127, part = tid >> 7; const bf16* PROJ = (const bf16*)(a.ws + WS_PROJ);
    const bf16* kp = PROJ + (m0 + j) * NPROJ + C_MK + hd * 64 + 16 * part; const bf16* vp = PROJ + (m0 + j) * NPROJ + C_MV + hd * 64 + 16 * part;
    const v4u k0 = *(const v4u*)kp, k1 = *(const v4u*)(kp + 8), v0 = *(const v4u*)vp, v1 = *(const v4u*)(vp + 8);
    mls_gates_store(graw, GL, tid);
    WG_SYNC();
    float* MLOC = (float*)(a.ws + WS_MLOC); float* NLOC = (float*)(a.ws + WS_NLOC); float* CLOC = (float*)(a.ws + WS_CLOC);
    const size_t sbase = ((size_t)b * 4 + hd) * 2;
    mls_gates_scan(GL, wave, lane);
    if (wave < 2) { WAVE_LDS_FENCE(); const int dir = wave; const float gtot = dir ? GL[640] : GL[512 + 127]; const LAS float* Bc = GL + 512 + 128 * dir; const LAS float* IG = GL + 256 + 128 * dir;
        const float lw0 = gtot - Bc[lane] + IG[lane], lw1 = gtot - Bc[lane + 64] + IG[lane + 64];
        const float mx = wave_max(fmaxf(lw0, lw1));
        WW[dir * 128 + lane] = fexp(lw0 - mx); WW[dir * 128 + lane + 64] = fexp(lw1 - mx);
        if (lane == 0) { float* o = MLOC + ((sbase + dir) * 16 + c) * 2; o[0] = mx; o[1] = gtot; } }
    WG_SYNC();
    { const float wf = WW[j] * 0.125f, wb = WW[128 + j] * 0.125f;
      const unsigned kk[8] = {k0.x, k0.y, k0.z, k0.w, k1.x, k1.y, k1.z, k1.w}; const unsigned vv[8] = {v0.x, v0.y, v0.z, v0.w, v1.x, v1.y, v1.z, v1.w};
#pragma unroll
      for (int q = 0; q < 8; ++q) { const int e0 = 16 * part + 2 * q; const float ka = bflo(kk[q]), kb = bfhi(kk[q]);
          KF[e0 * TS + j] = (bf16)f2bf(ka * wf); KF[(e0 + 1) * TS + j] = (bf16)f2bf(kb * wf);
          KB[e0 * TS + j] = (bf16)f2bf(ka * wb); KB[(e0 + 1) * TS + j] = (bf16)f2bf(kb * wb);
          VT[e0 * TS + j] = (bf16)(vv[q] & 0xffffu); VT[(e0 + 1) * TS + j] = (bf16)(vv[q] >> 16); } }
    WG_SYNC();
    if (tid < 128) { const int dir = tid >> 6, e = tid & 63; const LAS bf16* kr = (dir ? KB : KF) + e * TS; float s = 0.f;
#pragma unroll
        for (int q = 0; q < 16; ++q) { const v4u w = *(const LAS v4u*)(kr + 8 * q); s += ((bflo(w.x) + bfhi(w.x)) + (bflo(w.y) + bfhi(w.y))) + ((bflo(w.z) + bfhi(w.z)) + (bflo(w.w) + bfhi(w.w))); }
        NLOC[((sbase + dir) * 16 + c) * 64 + e] = s; }
    { const int dir = wave >> 2, mt = wave & 3, li = lane & 15, g = lane >> 4; const LAS bf16* KD = dir ? KB : KF;
      f32x4 acc[4];
#pragma unroll
      for (int nt = 0; nt < 4; ++nt) acc[nt] = (f32x4){0.f, 0.f, 0.f, 0.f};
#pragma unroll
      for (int ks = 0; ks < 4; ++ks) { const bf16x8 af = *(const LAS bf16x8*)(VT + (16 * mt + li) * TS + 32 * ks + 8 * g);
#pragma unroll
          for (int nt = 0; nt < 4; ++nt) { const bf16x8 bfv = *(const LAS bf16x8*)(KD + (16 * nt + li) * TS + 32 * ks + 8 * g); acc[nt] = MFMA16(af, bfv, acc[nt]); } }
      float* co = CLOC + ((sbase + dir) * 16 + c) * 4096;
#pragma unroll
      for (int nt = 0; nt < 4; ++nt)
#pragma unroll
          for (int r = 0; r < 4; ++r) co[(16 * mt + 4 * g + r) * 64 + 16 * nt + li] = acc[nt][r]; }
    WG_SYNC();
}

__device__ __forceinline__ void mls_scan_unit(const Args& a, int unit, LAS unsigned char* lds, int tid, int lane, int wave) {
    const int qtr = unit & 3, bhd = unit >> 2, dir = bhd & 1;
    LAS float* SM = (LAS float*)(lds + RING_OFF);
    const float* CLOC = (const float*)(a.ws + WS_CLOC) + (size_t)bhd * 16 * 4096 + 1024 * qtr + 2 * tid;
    const float* NLOC = (const float*)(a.ws + WS_NLOC) + (size_t)bhd * 16 * 64;
    typedef float f32x2 __attribute__((ext_vector_type(2)));
    f32x2 cl[16]; float nl[16];
#pragma unroll
    for (int k = 0; k < 16; ++k) cl[k] = *(const f32x2*)(CLOC + (size_t)k * 4096);
    const bool do_n = (qtr == 0) && (tid < 64);
#pragma unroll
    for (int k = 0; k < 16; ++k) nl[k] = do_n ? NLOC[k * 64 + tid] : 0.f;
    if (tid < 32) SM[tid] = ((const float*)(a.ws + WS_MLOC))[(size_t)bhd * 32 + tid];
    WG_SYNC();
    bf16* CP = (bf16*)(a.ws + WS_CPREV) + (size_t)bhd * 16 * 4096 + 1024 * qtr + 2 * tid;
    float* NP = (float*)(a.ws + WS_NPREV) + (size_t)bhd * 16 * 64; float* MP = (float*)(a.ws + WS_MPREV) + (size_t)bhd * 16;
    float m = 0.f; f32x2 C = (f32x2){0.f, 0.f}; float n = 0.f;
#pragma unroll
    for (int q = 0; q < 16; ++q) { const int k = dir ? 15 - q : q;
        *(unsigned*)(CP + (size_t)k * 4096) = pk2(C[0], C[1]);
        if (do_n) NP[k * 64 + tid] = n;
        if (qtr == 0 && tid == 64) MP[k] = m;
        const float mlk = SM[2 * k], gk = SM[2 * k + 1]; const float mn = fmaxf(gk + m, mlk); const float fa = fexp(gk + m - mn), fb = fexp(mlk - mn);
        C = fa * C + fb * (dir ? cl[15 - q] : cl[q]); n = fa * n + fb * (dir ? nl[15 - q] : nl[q]); m = mn; }
    WG_SYNC();
}

template <int DIR>
__device__ __forceinline__ void mls_dir(f32x4 (&hacc)[4], const LAS bf16* QS, const LAS bf16* KS, const LAS bf16* VT, const LAS bf16* CP, const LAS float* AJ, const LAS float* MM,
                                        const LAS float* INTER, const LAS float* FLOOR, const LAS float* NP, LAS float* rowbuf, int w, int lane) {
    const int li = lane & 15, g = lane >> 4, i = 16 * w + li;
    bf16x8 qf[2];
#pragma unroll
    for (int ks = 0; ks < 2; ++ks) qf[ks] = *(const LAS bf16x8*)(QS + i * QS_ + 32 * ks + 8 * g);
    const float mmi = MM[i];
    float den = 0.f;
    f32x4 out[4];
#pragma unroll
    for (int dt = 0; dt < 4; ++dt) out[dt] = (f32x4){0.f, 0.f, 0.f, 0.f};
#pragma unroll
    for (int kp = 0; kp < 4; ++kp) {
        const bool need = (DIR == 0) ? (2 * kp <= w) : (2 * kp + 1 >= w);
        if (need) {
            f32x4 s0 = (f32x4){0.f, 0.f, 0.f, 0.f}, s1 = (f32x4){0.f, 0.f, 0.f, 0.f};
#pragma unroll
            for (int ks = 0; ks < 2; ++ks) { const bf16x8 k0 = *(const LAS bf16x8*)(KS + (32 * kp + li) * QS_ + 32 * ks + 8 * g), k1 = *(const LAS bf16x8*)(KS + (32 * kp + 16 + li) * QS_ + 32 * ks + 8 * g);
                s0 = MFMA16(k0, qf[ks], s0); s1 = MFMA16(k1, qf[ks], s1); }
            float p[8];
#pragma unroll
            for (int r = 0; r < 4; ++r) { const int j0 = 32 * kp + 4 * g + r, j1 = j0 + 16;
                const bool v0 = (DIR == 0) ? (j0 <= i) : (j0 >= i), v1 = (DIR == 0) ? (j1 <= i) : (j1 >= i);
                const float a0 = v0 ? (AJ[j0] - mmi) : -INFINITY, a1 = v1 ? (AJ[j1] - mmi) : -INFINITY;
                p[r] = s0[r] * 0.125f * fexp(a0); p[4 + r] = s1[r] * 0.125f * fexp(a1); den += p[r] + p[4 + r]; }
            v4u pk; pk.x = pk2(p[0], p[1]); pk.y = pk2(p[2], p[3]); pk.z = pk2(p[4], p[5]); pk.w = pk2(p[6], p[7]);
            const bf16x8 pf = __builtin_bit_cast(bf16x8, pk);
#pragma unroll
            for (int dt = 0; dt < 4; ++dt) { const LAS bf16* vr = VT + (16 * dt + li) * TS + 32 * kp + 4 * g;
                const u32x2 lo = *(const LAS u32x2*)vr, hi = *(const LAS u32x2*)(vr + 16);
                v4u vk; vk.x = lo.x; vk.y = lo.y; vk.z = hi.x; vk.w = hi.y;
                out[dt] = MFMA16(pf, __builtin_bit_cast(bf16x8, vk), out[dt]); }
        }
    }
    f32x4 qc[4];
#pragma unroll
    for (int dt = 0; dt < 4; ++dt) { qc[dt] = (f32x4){0.f, 0.f, 0.f, 0.f};
#pragma unroll
        for (int ks = 0; ks < 2; ++ks) { const bf16x8 cf = *(const LAS bf16x8*)(CP + (16 * dt + li) * QS_ + 32 * ks + 8 * g); qc[dt] = MFMA16(qf[ks], cf, qc[dt]); } }
    float nq = 0.f;
#pragma unroll
    for (int q = 0; q < 16; ++q) nq += NP[16 * g + q] * bf2f(QS[i * QS_ + 16 * g + q]);
    den = xor32_sum(xor16_sum(den)); nq = xor32_sum(xor16_sum(nq));
    const float inter = INTER[i]; const float dn = fmaxf(fabsf(den + inter * nq), FLOOR[i]);
    asm volatile("s_waitcnt lgkmcnt(0)" ::: "memory");
    if (g == 0) { rowbuf[li] = inter; rowbuf[16 + li] = frcp(dn); }
    asm volatile("s_waitcnt lgkmcnt(0)" ::: "memory");
#pragma unroll
    for (int r = 0; r < 4; ++r) { const float it = rowbuf[4 * g + r], inv = rowbuf[16 + 4 * g + r];
#pragma unroll
        for (int dt = 0; dt < 4; ++dt) hacc[dt][r] += (out[dt][r] + it * qc[dt][r]) * inv; }
    asm volatile("s_waitcnt lgkmcnt(0)" ::: "memory");
}
__device__ __forceinline__ void mls_b_unit(const Args& a, int l, int unit, LAS unsigned char* lds, int tid, int lane, int wave) {
    const int c = unit & 15, hd = (unit >> 4) & 3, b = unit >> 6; const size_t m0 = (size_t)b * SEQ + c * 128;
    LAS float* GL = (LAS float*)(lds + RING_OFF);
    LAS float* AJ = GL + 768;
    LAS float* MMx = AJ + 256;
    LAS float* INT_ = MMx + 256;
    LAS float* FLR = INT_ + 256;
    LAS float* NP = FLR + 256;
    LAS float* COEF = NP + 128;
    LAS float* ROWB = COEF + 32;
    LAS bf16* QS = (LAS bf16*)(lds + RING_OFF + 16384); LAS bf16* KS = QS + 128 * QS_; LAS bf16* VT = KS + 128 * QS_; LAS bf16* CF = VT + 64 * TS; LAS bf16* CB = CF + 64 * QS_;
    const size_t sbase = ((size_t)b * 4 + hd) * 2;
    const MlsGateRaw graw = mls_gates_load(a, l, m0, hd, tid);
    const float mprev = ((const float*)(a.ws + WS_MPREV))[(sbase + (wave & 1)) * 16 + c];
    const bf16* PROJ = (const bf16*)(a.ws + WS_PROJ);
    const int sj = tid >> 2, q4 = tid & 3; const bf16* rp = PROJ + (m0 + sj) * NPROJ + hd * 64 + 16 * q4;
    const v4u q0 = *(const v4u*)(rp + C_MQ), q1 = *(const v4u*)(rp + C_MQ + 8), k0 = *(const v4u*)(rp + C_MK), k1 = *(const v4u*)(rp + C_MK + 8), v0 = *(const v4u*)(rp + C_MV), v1 = *(const v4u*)(rp + C_MV + 8);
    const int idx = tid * 8; const bf16* CPV = (const bf16*)(a.ws + WS_CPREV);
    const v4u cfv = *(const v4u*)(CPV + ((sbase + 0) * 16 + c) * 4096 + idx), cbv = *(const v4u*)(CPV + ((sbase + 1) * 16 + c) * 4096 + idx);
    float npv = 0.f; if (tid < 128) npv = ((const float*)(a.ws + WS_NPREV))[((sbase + (tid >> 6)) * 16 + c) * 64 + (tid & 63)];
    const int li_ = lane & 15, g_ = lane >> 4; const float* hg = a.in[I_MNG] + ((size_t)l * 4 + hd) * 64;
    unsigned short ogv[4][4]; float hgv[4];
#pragma unroll
    for (int dt = 0; dt < 4; ++dt) { hgv[dt] = hg[16 * dt + li_];
#pragma unroll
        for (int r = 0; r < 4; ++r) ogv[r][dt] = PROJ[(m0 + 16 * wave + 4 * g_ + r) * NPROJ + C_MO + hd * 64 + 16 * dt + li_]; }
    mls_gates_store(graw, GL, tid);
    *(LAS v4u*)(QS + sj * QS_ + 16 * q4) = q0; *(LAS v4u*)(QS + sj * QS_ + 16 * q4 + 8) = q1;
    *(LAS v4u*)(KS + sj * QS_ + 16 * q4) = k0; *(LAS v4u*)(KS + sj * QS_ + 16 * q4 + 8) = k1;
    { const unsigned vv[8] = {v0.x, v0.y, v0.z, v0.w, v1.x, v1.y, v1.z, v1.w};
#pragma unroll
      for (int q = 0; q < 8; ++q) { const int d0 = 16 * q4 + 2 * q; VT[d0 * TS + sj] = (bf16)(vv[q] & 0xffffu); VT[(d0 + 1) * TS + sj] = (bf16)(vv[q] >> 16); } }
    *(LAS v4u*)(CF + (idx >> 6) * QS_ + (idx & 63)) = cfv; *(LAS v4u*)(CB + (idx >> 6) * QS_ + (idx & 63)) = cbv;
    if (tid < 128) NP[tid] = npv;
    WG_SYNC();
    mls_gates_scan(GL, wave, lane);
    if (wave < 2) {
        WAVE_LDS_FENCE();
        const int dir = wave; const float m = mprev;
        const LAS float* IG = GL + 256 + 128 * dir; const LAS float* Bc = GL + 512 + 128 * dir;
        LAS float* aj = AJ + 128 * dir; LAS float* mmx = MMx + 128 * dir;
        aj[lane] = IG[lane] - Bc[lane]; aj[lane + 64] = IG[lane + 64] - Bc[lane + 64];
        WAVE_LDS_FENCE();
        if (dir == 0) wave_scan128<true, false>(aj, mmx, lane); else wave_scan128<true, true>(aj, mmx, lane);
        WAVE_LDS_FENCE();
#pragma unroll
        for (int q = 0; q < 2; ++q) { const int j = lane + 64 * q; const float mm = fmaxf(mmx[j], m);
            mmx[j] = mm; INT_[128 * dir + j] = fexp(m - mm); FLR[128 * dir + j] = fexp(-(Bc[j] + mm)); }
    }
    WG_SYNC();
    f32x4 hacc[4];
#pragma unroll
    for (int dt = 0; dt < 4; ++dt) hacc[dt] = (f32x4){0.f, 0.f, 0.f, 0.f};
    mls_dir<0>(hacc, QS, KS, VT, CF, AJ, MMx, INT_, FLR, NP, ROWB + wave * 32, wave, lane);
    mls_dir<1>(hacc, QS, KS, VT, CB, AJ + 128, MMx + 128, INT_ + 128, FLR + 128, NP + 64, ROWB + wave * 32, wave, lane);
    {
        bf16* Y = (bf16*)(a.ws + WS_Y);
#pragma unroll
        for (int r = 0; r < 4; ++r) { float ss = (hacc[0][r] * hacc[0][r] + hacc[1][r] * hacc[1][r]) + (hacc[2][r] * hacc[2][r] + hacc[3][r] * hacc[3][r]);
            ss = row16_sum(ss);
            const float rstd = frsq(ss * (1.0f / 64.0f) + EPS); const size_t m = m0 + 16 * wave + 4 * g_ + r;
#pragma unroll
            for (int dt = 0; dt < 4; ++dt) Y[m * DM + 768 + hd * 64 + 16 * dt + li_] = (bf16)f2bf(hacc[dt][r] * rstd * hgv[dt] * sigmoid_f(bf2f(ogv[r][dt]))); }
    }
    WG_SYNC();
}

__device__ __forceinline__ void attnorm_pass(const Args& a, int l, int lane, int wave, int G, int bid, bf16* DST) {
    bf16* Y = (bf16*)(a.ws + WS_Y); const float* gq = a.in[I_AOG] + (size_t)l * 512 + 8 * lane;
    const f32x4 g0 = *(const f32x4*)gq, g1 = *(const f32x4*)(gq + 4);
    const int gw = bid * NWAVES + wave, NGW = G * NWAVES;
    for (int mb = 4 * gw; mb < M; mb += 4 * NGW) { v4u q[4];
#pragma unroll
        for (int r = 0; r < 4; ++r) q[r] = *(const v4u*)(Y + (size_t)(mb + r) * DM + 8 * lane);
        float ss[4];
#pragma unroll
        for (int r = 0; r < 4; ++r) { const float x[8] = {bflo(q[r].x), bfhi(q[r].x), bflo(q[r].y), bfhi(q[r].y), bflo(q[r].z), bfhi(q[r].z), bflo(q[r].w), bfhi(q[r].w)}; float a = 0.f;
#pragma unroll
            for (int i = 0; i < 8; ++i) a += x[i] * x[i];
            ss[r] = a; }
#pragma unroll
        for (int r = 0; r < 4; ++r) ss[r] = wave_sum(ss[r]);
#pragma unroll
        for (int r = 0; r < 4; ++r) { const float rstd = frsq(ss[r] * (1.0f / 512.0f) + EPS);
            const float x[8] = {bflo(q[r].x), bfhi(q[r].x), bflo(q[r].y), bfhi(q[r].y), bflo(q[r].z), bfhi(q[r].z), bflo(q[r].w), bfhi(q[r].w)};
            v4u o; o.x = pk2(x[0] * rstd * g0[0], x[1] * rstd * g0[1]); o.y = pk2(x[2] * rstd * g0[2], x[3] * rstd * g0[3]);
            o.z = pk2(x[4] * rstd * g1[0], x[5] * rstd * g1[1]); o.w = pk2(x[6] * rstd * g1[2], x[7] * rstd * g1[3]); *(v4u*)(DST + (size_t)(mb + r) * DM + 8 * lane) = o; } }
}

__device__ __forceinline__ unsigned mbcnt64(unsigned long long m) { return __builtin_amdgcn_mbcnt_hi((unsigned)(m >> 32), __builtin_amdgcn_mbcnt_lo((unsigned)m, 0u)); }
__device__ __forceinline__ void topk_item(const Args& a, int item, LAS unsigned char* lds, int tid, int lane, int wave) {
    const int unit = item & 127, half = item >> 7, b = unit >> 4, e = unit & 15;
    LAS unsigned* CNT = (LAS unsigned*)(lds + RING_OFF);
    LAS unsigned* SEG = CNT + 16;
    LAS int* TOK = (LAS int*)(SEG + 64);
    LAS float* GV = (LAS float*)(TOK + 256);
    const float* aff = (const float*)(a.ws + WS_AFF) + ((size_t)b * NE + e) * SEQ;
    float av[4]; unsigned key[4];
#pragma unroll
    for (int q = 0; q < 4; ++q) av[q] = aff[tid + q * NTHR];
#pragma unroll
    for (int q = 0; q < 4; ++q) key[q] = __float_as_uint(av[q]);
    unsigned lo = 0u, hi = 0x7F800000u; int par = 0;
    while (hi - lo > 1u) { const unsigned mid = lo + ((hi - lo) >> 1);
        unsigned c = 0u;
#pragma unroll
        for (int q = 0; q < 4; ++q) c += (unsigned)__popcll(__ballot(key[q] >= mid));
        if (lane == 0) CNT[par * 8 + wave] = c;
        WG_SYNC();
        const v4u c0 = *(const LAS v4u*)(CNT + par * 8), c1 = *(const LAS v4u*)(CNT + par * 8 + 4);
        const unsigned tot = (c0.x + c0.y) + (c0.z + c0.w) + (c1.x + c1.y) + (c1.z + c1.w);
        if (tot >= (unsigned)CAP) lo = mid; else hi = mid;
        par ^= 1; }
    const unsigned T = lo;
    unsigned long long mgt[4], meq[4];
#pragma unroll
    for (int q = 0; q < 4; ++q) { mgt[q] = __ballot(key[q] > T); meq[q] = __ballot(key[q] == T);
        if (lane == 0) { SEG[q * 8 + wave] = (unsigned)__popcll(mgt[q]); SEG[32 + q * 8 + wave] = (unsigned)__popcll(meq[q]); } }
    WG_SYNC();
    unsigned ngt = 0u;
#pragma unroll
    for (int g = 0; g < 32; ++g) ngt += SEG[g];
    const unsigned need = (unsigned)CAP - ngt;
    unsigned eqb = 0u, selb = 0u, my_eqb[4], my_selb[4];
#pragma unroll
    for (int g = 0; g < 32; ++g) { if ((g & 7) == wave) { my_eqb[g >> 3] = eqb; my_selb[g >> 3] = selb; }
        const unsigned cg = SEG[g], ce = SEG[32 + g]; const unsigned room = need > eqb ? need - eqb : 0u; selb += cg + (room < ce ? room : ce); eqb += ce; }
    int* SEL = (int*)(a.ws + WS_SEL);
#pragma unroll
    for (int q = 0; q < 4; ++q) { const bool gt = key[q] > T, eq = key[q] == T;
        const bool sel = gt || (eq && (my_eqb[q] + mbcnt64(meq[q])) < need);
        const unsigned long long ms = __ballot(sel); const int slot = (int)(my_selb[q] + mbcnt64(ms)); const int sidx = tid + q * NTHR;
        if (sel) { TOK[slot] = sidx; GV[slot] = av[q]; }
        if ((q >> 1) == half) SEL[((size_t)b * SEQ + sidx) * NE + e] = sel ? slot : -1; }
    WG_SYNC();
    int* IDX = (int*)(a.ws + WS_IDX); float* GATE = (float*)(a.ws + WS_GATE);
    if (tid < 128) { const int t = half * 128 + tid; IDX[e * NSLOT + b * CAP + t] = b * SEQ + TOK[t]; GATE[e * NSLOT + b * CAP + t] = GV[t]; }
    const unsigned char* H8 = a.ws + WS_H; unsigned char* XG8 = a.ws + WS_XG;
    { v4u r0[16];
#pragma unroll
      for (int q = 0; q < 16; ++q) { const int t = half * 128 + wave * 16 + q; r0[q] = *((const v4u*)(H8 + ((size_t)b * SEQ + TOK[t]) * DM) + lane); }
#pragma unroll
      for (int q = 0; q < 16; ++q) { const int t = half * 128 + wave * 16 + q; *((v4u*)(XG8 + ((size_t)e * NSLOT + b * CAP + t) * DM) + lane) = r0[q]; } }
    WG_SYNC();
}

#ifndef MK_PER_PHASE
#define MK_PER_PHASE 0
#endif
__global__ void __launch_bounds__(NTHR, 2) hybrid_fwd(Args args) {
    extern __shared__ __attribute__((aligned(16))) unsigned char lds_raw[];
    LAS unsigned char* lds = (LAS unsigned char*)lds_raw;
    volatile LAS unsigned* MISC = (volatile LAS unsigned*)(lds + MISC_OFF);
    const int tid0 = threadIdx.x, G = gridDim.x;
    unsigned char* ws = args.ws;
#define PHASE_IDS() const int tid = ltid(), lane = tid & 63, wave = __builtin_amdgcn_readfirstlane(tid >> 6), bid = lbid(); (void)lane; (void)wave; (void)bid
    gu32* ctl = (gu32*)(ws + WS_CTL);
    for (int u = tid0; u < (LDS_BYTES - MISC_OFF) / 4; u += NTHR) ((LAS unsigned*)(lds + MISC_OFF))[u] = 0u;
    __syncthreads();
    XcdBarrier bar; bar.bar = (unsigned*)(ctl + CW_BAR); bar.x = 0; bar.st = nullptr;
    if (!MK_PER_PHASE) bar = xcd_barrier_post((unsigned*)(ctl + CW_BAR), MISC + 8);
#define GRID_BAR() do { if (!MK_PER_PHASE) { xcd_barrier(bar); if (REP_MASK & (1 << 11)) xcd_barrier(bar); } } while (0)
    const int lo = args.ph_lo, hi = args.ph_hi;
#ifndef PT_MASK
#define PT_MASK 0x7ff
#endif
#define PT_ON(j) (((PT_MASK) >> (j)) & 1)
#ifndef REP_MASK
#define REP_MASK 0
#endif
#define REPS(j) for (int rep_ = 0; rep_ < 1 + (((REP_MASK) >> (j)) & 1); ++rep_)
#define IN(k) (lo <= (k) && (k) < hi)
#define BOTH(k) (IN(k) && IN((k) + 1))

    bf16* Hb = (bf16*)(ws + WS_H); bf16* PROJ = (bf16*)(ws + WS_PROJ); bf16* Yb = (bf16*)(ws + WS_Y);
    float* MG = (float*)(ws + WS_MG); float* AFF = (float*)(ws + WS_AFF); int* SEL = (int*)(ws + WS_SEL);
    bf16* XG = (bf16*)(ws + WS_XG); bf16* HID = (bf16*)(ws + WS_HID); bf16* YE = (bf16*)(ws + WS_YE); bf16* XB = (bf16*)(ws + WS_XB);

    if (PT_ON(0) && IN(0)) { PHASE_IDS();
        REPS(0) p0_weights(args, lds, tid, lane, wave, G, bid);
        WG_SYNC();
        REPS(16) row_pass<0, false>(args.in[I_X], nullptr, args.in[I_N1G], args.in[I_WIN] + NPROJ, DIN, Hb, MG, nullptr, nullptr, lds, tid, lane, wave, G, bid);
        if (BOTH(0)) GRID_BAR();
    }
    for (int l = 0; l < DEPTH; ++l) {
        const int pb = 1 + 10 * l;
        if (PT_ON(1) && IN(pb + 0)) { PHASE_IDS();
            pg8::Gemm g{Hb, (const bf16*)(ws + WS_WIN) + (size_t)l * NPROJ * DM, M, NPROJ, DM}; pg8::StaticOrder S; S.init(M, NPROJ - 256, G, bid);
            pg8::EpiBf16<0> E{PROJ, NPROJ, nullptr, 0, 0, 1.f};
            REPS(1) pg8::gemm_phase<pg8::EpiBf16<0>, pg8::StaticOrder, true, true>(lds + RING_OFF, g, S, E);
            if (BOTH(pb + 0)) GRID_BAR();
        }
        if (PT_ON(2) && IN(pb + 1)) { PHASE_IDS();
            const bool split = (G == 256);
            if (bid < 64 || !split) { pg8::Gemm g{Hb, (const bf16*)(ws + WS_WIN) + (size_t)l * NPROJ * DM, M, NPROJ, DM}; pg8::TailOrder S{G, bid, 8}; pg8::EpiBf16<0> E{PROJ, NPROJ, nullptr, 0, 0, 1.f};
                pg8::gemm_phase<pg8::EpiBf16<0>, pg8::TailOrder, false, true>(lds + RING_OFF, g, S, E); WG_SYNC(); }
            if (!split) rope_pass(args, l, lane, wave, G, bid, PROJ);
            else if (bid >= 64) rope_pass(args, l, lane, wave, 192, bid - 64, PROJ);
            REPS(2) for (int u = bid; u < 512; u += G) lru_a_unit(args, l, u, lds, tid, lane, wave);
            REPS(3) for (int u = bid; u < 512; u += G) mls_a_unit(args, l, u, lds, tid, lane, wave);
            if (BOTH(pb + 1)) GRID_BAR();
        }
        if (PT_ON(3) && IN(pb + 2)) { PHASE_IDS();
            const attn_body::AttnTensors AT{(const attn_body::bf16*)(PROJ + C_Q), (const attn_body::bf16*)(PROJ + C_K), (const attn_body::bf16*)(PROJ + C_V), (attn_body::bf16*)Yb};
            const attn_body::StaticOrder S(G, bid);
#ifndef P3_PARTS
#define P3_PARTS 7
#endif
            for (int u = bid; u < 256; u += G) mls_scan_unit(args, u, lds, tid, lane, wave);
            WG_SYNC();
            REPS(4) attn_body::attn_phase<attn_body::StaticOrder>((char*)lds_raw + RING_OFF, AT, S);
            if (BOTH(pb + 2)) GRID_BAR();
        }
        if (PT_ON(4) && IN(pb + 3)) { PHASE_IDS();
            REPS(5) for (int u = bid; u < 512; u += G) mls_b_unit(args, l, u, lds, tid, lane, wave);
            for (int u = bid; u < 256; u += G) p4_rows_unit(args, l, u, lds, tid, lane, wave);
            if (BOTH(pb + 3)) GRID_BAR();
        }
        if (PT_ON(5) && IN(pb + 4)) { PHASE_IDS();
            pg8::Gemm g{Yb, (const bf16*)(ws + WS_WOUT) + (size_t)l * DM * DM, M, DM, DM}; pg8::StaticOrder S; S.init(M, DM, G, bid);
            pg8::EpiResid E{l == 0 ? args.in[I_X] : nullptr, XB, XB, DM};
            if (REP_MASK & (1 << 14)) { pg8::EpiResid E2{l == 0 ? args.in[I_X] : nullptr, XB, HID, DM}; pg8::gemm_phase<pg8::EpiResid, pg8::StaticOrder, false, true>(lds + RING_OFF, g, S, E2); }
            pg8::gemm_phase<pg8::EpiResid, pg8::StaticOrder, false, true>(lds + RING_OFF, g, S, E);
            if (BOTH(pb + 4)) GRID_BAR();
        }
        if (PT_ON(6) && IN(pb + 5)) { PHASE_IDS();
            REPS(7) row_pass<1, true>(XB, nullptr, args.in[I_N2G] + (size_t)l * DM, args.in[I_WR] + (size_t)l * DM * NE, NE, Hb, AFF, nullptr, nullptr, lds, tid, lane, wave, G, bid);
            if (BOTH(pb + 5)) GRID_BAR();
        }
        if (PT_ON(7) && IN(pb + 6)) { PHASE_IDS(); REPS(8) for (int it = bid; it < 256; it += G) topk_item(args, it, lds, tid, lane, wave); if (BOTH(pb + 6)) GRID_BAR(); }
        if (PT_ON(8) && IN(pb + 7)) { PHASE_IDS();
            pg8::Gemm g{XG, (const bf16*)(ws + WS_WGU + (size_t)l * NE * 4096 * DM), NE * NSLOT, NE * 4096, DM / 2}; pg8::Moe1Order S{G, bid};
            pg8::EpiSwiGLU E{(unsigned char*)HID, DE};
            if (REP_MASK & (1 << 17)) { pg8::EpiNull E0; pg8::gemm_phase<pg8::EpiNull, pg8::Moe1Order, true, true, true>(lds + RING_OFF, g, S, E0); }
            REPS(9) pg8::gemm_phase<pg8::EpiSwiGLU, pg8::Moe1Order, true, true, true>(lds + RING_OFF, g, S, E);
            if (BOTH(pb + 7)) GRID_BAR();
        }
        if (PT_ON(9) && IN(pb + 8)) { PHASE_IDS();
            pg8::Gemm g{HID, (const bf16*)(ws + WS_WDN + (size_t)l * NE * DM * DE), NE * NSLOT, NE * DM, DE / 2}; pg8::Moe2Order S{G, bid};
            pg8::EpiScaleBf16 E{YE, DM, (const float*)(ws + WS_GATE)};
            REPS(10) pg8::gemm_phase<pg8::EpiScaleBf16, pg8::Moe2Order, true, true, true>(lds + RING_OFF, g, S, E);
            if (BOTH(pb + 8)) GRID_BAR();
        }
        if (PT_ON(10) && IN(pb + 9)) { PHASE_IDS();
            if (REP_MASK & (1 << 15)) { if (l + 1 < DEPTH) row_pass<2, true>(XB, HID, args.in[I_N1G] + (size_t)(l + 1) * DM, args.in[I_WIN] + (size_t)(l + 1) * DM * DIN + NPROJ, DIN, Hb, MG, SEL, YE, lds, tid, lane, wave, G, bid); else row_pass<3, true>(XB, HID, nullptr, nullptr, 0, nullptr, nullptr, SEL, YE, lds, tid, lane, wave, G, bid); WG_SYNC(); }
            if (l + 1 < DEPTH) row_pass<2, true>(XB, XB, args.in[I_N1G] + (size_t)(l + 1) * DM, args.in[I_WIN] + (size_t)(l + 1) * DM * DIN + NPROJ, DIN, Hb, MG, SEL, YE, lds, tid, lane, wave, G, bid);
            else row_pass<3, true>(XB, args.out, nullptr, nullptr, 0, nullptr, nullptr, SEL, YE, lds, tid, lane, wave, G, bid);
            if (BOTH(pb + 9)) GRID_BAR();
        }
    }
#undef IN
#undef BOTH
#undef GRID_BAR
}

extern "C" void kernel_launch(void* const* d_in, const int* in_sizes, int n_in, void* d_out, int out_size, void* d_ws, size_t ws_size, hipStream_t stream) {
    static int grid = 0;
    if (grid == 0) {
        if (n_in != 22 || in_sizes[0] != M * DM || out_size != M * DM || ws_size < WS_END) { fprintf(stderr, "kernel_launch: unexpected shapes (n_in %d, in0 %d, out %d, ws %zu); nothing launched\n", n_in, n_in > 0 ? in_sizes[0] : -1, out_size, ws_size); grid = -1; return; }
        int dev = 0, cus = 0, per_cu = 0;
        if (hipGetDevice(&dev) != hipSuccess || hipDeviceGetAttribute(&cus, hipDeviceAttributeMultiprocessorCount, dev) != hipSuccess) { grid = -1; return; }
        if (hipFuncSetAttribute((const void*)hybrid_fwd, hipFuncAttributeMaxDynamicSharedMemorySize, LDS_BYTES) != hipSuccess) { fprintf(stderr, "kernel_launch: hipFuncSetAttribute failed\n"); grid = -1; return; }
        if (hipOccupancyMaxActiveBlocksPerMultiprocessor(&per_cu, (const void*)hybrid_fwd, NTHR, LDS_BYTES) != hipSuccess || per_cu < 1) { fprintf(stderr, "kernel_launch: occupancy query says %d\n", per_cu); }
        (void)hipGetLastError();
        grid = cus;
    }
    if (grid < 0) return;
    if (hipMemsetAsync((char*)d_ws + WS_CTL, 0, CTL_ZERO_BYTES, stream) != hipSuccess) return;
    Args a{};
    for (int i = 0; i < 22; ++i) a.in[i] = (const float*)d_in[i];
    a.out = (float*)d_out; a.ws = (unsigned char*)d_ws; a.pad = 0;
#if MK_PER_PHASE
    for (int p = 0; p < NPH; ++p) { a.ph_lo = p; a.ph_hi = p + 1; a.li = p; hipLaunchKernelGGL(hybrid_fwd, dim3(grid), dim3(NTHR), LDS_BYTES, stream, a); }
#else
    a.ph_lo = 0; a.ph_hi = NPH; a.li = 0;
    hipLaunchKernelGGL(hybrid_fwd, dim3(grid), dim3(NTHR), LDS_BYTES, stream, a);
#endif
    const hipError_t le = hipPeekAtLastError();
    if (le != hipSuccess) fprintf(stderr, "kernel_launch: launch failed: %s\n", hipGetErrorName(le));
}
```

```cpp
#include <hip/hip_runtime.h>
#include <hip/hip_bf16.h>
#include <cstdio>
#include <cstdint>
#include <cmath>
__device__ __forceinline__ int ltid() { int t = threadIdx.x; asm volatile("" : "+v"(t)); return t; }
__device__ __forceinline__ int lbid() { int t = blockIdx.x; asm volatile("" : "+s"(t)); return t; }
namespace pg8 {
#define PG8_LAS __attribute__((address_space(3)))
typedef unsigned short bf16_t;
typedef short bf16x8 __attribute__((ext_vector_type(8)));
typedef float f32x4 __attribute__((ext_vector_type(4)));
typedef unsigned u32x4 __attribute__((ext_vector_type(4)));
typedef unsigned u32x2 __attribute__((ext_vector_type(2)));
constexpr int BM = 256, BK = 64, HALF = 128, HTB = HALF * BK * 2  , STAGE_BYTES = 8 * HTB, NXCD = 8, WGM = 8;

__host__ __device__ __forceinline__ int lds_byte(int r, int c) { const int st = (r >> 4) * 2 + (c >> 5), rr = r & 15, cc = c & 31, ob = rr * 64 + cc * 2; return st * 1024 + (ob ^ (((ob >> 9) & 1) << 5)); }
__host__ __device__ __forceinline__ void stage_rc(int b, int& R, int& C) { const int st = b / 1024, sb = b % 1024, swz = sb ^ (((sb >> 9) & 1) << 5); R = (st >> 1) * 16 + swz / 64; C = (st & 1) * 32 + (swz % 64) / 2; }
__host__ __device__ __forceinline__ int perm32(int rho) { const int n = rho >> 4, i = rho & 15; return 8 * (i >> 2) + 4 * n + (i & 3); }

struct Unit { int pm, pn; };
struct Gemm { const bf16_t* A; const bf16_t* Bt; int M, N, K; };

struct StaticOrder {
    int nM, nN, nwg, G, c;
    __host__ __device__ void init(int M, int N, int G_, int c_) { nM = M / BM; nN = N / BM; nwg = nM * nN; G = G_; c = c_; }
    __host__ __device__ bool next(int i, Unit& u) const {
        const long L = (long)i * G + c; if (L >= nwg) return false;
        int wgid = (int)L; { const int q = nwg / NXCD, r = nwg % NXCD, xcd = wgid % NXCD, off = wgid / NXCD; wgid = (xcd < r ? xcd * (q + 1) : r * (q + 1) + (xcd - r) * q) + off; }
        const int nig = WGM * nN, gid = wgid / nig, fm = gid * WGM, gsz = (nM - fm) < WGM ? (nM - fm) : WGM;
        u.pm = fm + ((wgid % nig) % gsz); u.pn = (wgid % nig) / gsz; return true;
    }
    __device__ __forceinline__ void a_ready(const Unit&) const {}
    __device__ __forceinline__ void done(const Unit&) const {}
};

__device__ __forceinline__ unsigned cvt_pk_bf16(float lo, float hi) { unsigned r; asm volatile("v_cvt_pk_bf16_f32 %0, %1, %2" : "=v"(r) : "v"(lo), "v"(hi)); return r; }
typedef int i32x4 __attribute__((ext_vector_type(4)));
typedef int i32x8 __attribute__((ext_vector_type(8)));
__device__ __forceinline__ i32x8 cat8(bf16x8 lo, bf16x8 hi) { return __builtin_shufflevector(__builtin_bit_cast(i32x4, lo), __builtin_bit_cast(i32x4, hi), 0, 1, 2, 3, 4, 5, 6, 7); }
__device__ __forceinline__ float clamp448(float v) { return __builtin_amdgcn_fmed3f(v, -448.f, 448.f); }
__device__ __forceinline__ unsigned pk4_fp8(float a, float b, float c, float d) { unsigned r = 0u; r = (unsigned)__builtin_amdgcn_cvt_pk_fp8_f32(a, b, (int)r, false); r = (unsigned)__builtin_amdgcn_cvt_pk_fp8_f32(c, d, (int)r, true); return r; }
typedef float f32x2 __attribute__((ext_vector_type(2)));
__device__ __forceinline__ f32x2 gelu_pk(f32x2 v) {
    const f32x2 av = __builtin_elementwise_abs(v), d = av * 0.2316418882f + 1.0f;
    f32x2 t; t.x = __builtin_amdgcn_rcpf(d.x); t.y = __builtin_amdgcn_rcpf(d.y);
    f32x2 q = t * 0.5307027145f + (-0.7265760135f); q = q * t + 0.7107068705f; q = q * t + (-0.142248368f); q = q * t + 0.127414796f; q = q * t;
    const f32x2 s = (v * v) * (-0.72134752044f);
    f32x2 e; e.x = __builtin_amdgcn_exp2f(s.x); e.y = __builtin_amdgcn_exp2f(s.y);
    const f32x2 m = v * (q * e), r = v - m;
    f32x2 o; o.x = v.x < 0.f ? m.x : r.x; o.y = v.y < 0.f ? m.y : r.y; return o;
}

template <int ACT  > struct EpiBf16 {
    static constexpr bool PERM = true, AFTER_DRAIN = false; static_assert(ACT == 0 || ACT == 1, "EpiBf16: ACT is 0 (none) or 1 (gelu_pk)");
    bf16_t* O; int ldc; const float* bias; int split_cols; size_t split_stride; float scale0;
    __device__ __forceinline__ void operator()(const f32x4 (&acc)[2][2][4][2], const Unit& u, int wr, int wc, int fr, int fq) const {
        const int row0 = u.pm * BM + wr * 64 + fr; int colt = u.pn * BM; bf16_t* base = O;
        float sc = 1.f; if (split_cols) { const int t = colt / split_cols; base += (size_t)t * split_stride; colt -= t * split_cols; if (t == 0) sc = scale0; }
        const int col0 = colt + wc * 32 + 8 * fq, bcol0 = u.pn * BM + wc * 32 + 8 * fq;
        f32x4 bv[2][2];
#pragma unroll
        for (int bj = 0; bj < 2; ++bj)
#pragma unroll
            for (int n = 0; n < 2; ++n) bv[bj][n] = bias ? *(const f32x4*)(bias + bcol0 + bj * HALF + 4 * n) : (f32x4){0.f, 0.f, 0.f, 0.f};
#pragma unroll
        for (int ai = 0; ai < 2; ++ai)
#pragma unroll
            for (int m = 0; m < 4; ++m) { bf16_t* rowp = base + (size_t)(row0 + ai * HALF + m * 16) * ldc + col0;
#pragma unroll
                for (int bj = 0; bj < 2; ++bj) { f32x4 v0 = acc[ai][bj][m][0] + bv[bj][0], v1 = acc[ai][bj][m][1] + bv[bj][1];
                    if (ACT == 1) { f32x2 a = gelu_pk((f32x2){v0[0], v0[1]}), b = gelu_pk((f32x2){v0[2], v0[3]}), c = gelu_pk((f32x2){v1[0], v1[1]}), d = gelu_pk((f32x2){v1[2], v1[3]});
                        v0 = (f32x4){a.x, a.y, b.x, b.y}; v1 = (f32x4){c.x, c.y, d.x, d.y}; }
                    v0 = v0 * sc; v1 = v1 * sc; u32x4 w; w.x = cvt_pk_bf16(v0[0], v0[1]); w.y = cvt_pk_bf16(v0[2], v0[3]); w.z = cvt_pk_bf16(v1[0], v1[1]); w.w = cvt_pk_bf16(v1[2], v1[3]);
                    *(u32x4*)(rowp + bj * HALF) = w; } }
    }
};

struct EpiResid {
    static constexpr bool PERM = true, AFTER_DRAIN = false;
    const float* base32; const bf16_t* base16; bf16_t* C; int ldc;
    __device__ __forceinline__ void operator()(const f32x4 (&acc)[2][2][4][2], const Unit& u, int wr, int wc, int fr, int fq) const {
        const int row0 = u.pm * BM + wr * 64 + fr, col0 = u.pn * BM + wc * 32 + 8 * fq;
#pragma unroll
        for (int ai = 0; ai < 2; ++ai)
#pragma unroll
            for (int m = 0; m < 4; ++m) { const size_t off = (size_t)(row0 + ai * HALF + m * 16) * ldc + col0;
#pragma unroll
                for (int bj = 0; bj < 2; ++bj) { f32x4 b0, b1;
                    if (base32) { b0 = *(const f32x4*)(base32 + off + bj * HALF); b1 = *(const f32x4*)(base32 + off + bj * HALF + 4); }
                    else { const u32x4 q = *(const u32x4*)(base16 + off + bj * HALF);
                        b0 = (f32x4){__uint_as_float(q.x << 16), __uint_as_float(q.x & 0xffff0000u), __uint_as_float(q.y << 16), __uint_as_float(q.y & 0xffff0000u)};
                        b1 = (f32x4){__uint_as_float(q.z << 16), __uint_as_float(q.z & 0xffff0000u), __uint_as_float(q.w << 16), __uint_as_float(q.w & 0xffff0000u)}; }
                    const f32x4 v0 = acc[ai][bj][m][0] + b0, v1 = acc[ai][bj][m][1] + b1;
                    u32x4 w; w.x = cvt_pk_bf16(v0[0], v0[1]); w.y = cvt_pk_bf16(v0[2], v0[3]); w.z = cvt_pk_bf16(v1[0], v1[1]); w.w = cvt_pk_bf16(v1[2], v1[3]);
                    *(u32x4*)(C + off + bj * HALF) = w; } }
    }
};
__device__ __forceinline__ float silu_f(float x) { return x * __builtin_amdgcn_rcpf(1.0f + __builtin_amdgcn_exp2f(-1.4426950408889634f * x)); }
constexpr float WSCALE = 64.f, HSCALE = 4.f;
struct EpiSwiGLU {
    static constexpr bool PERM = true, AFTER_DRAIN = false;
    unsigned char* O; int ldc;
    __device__ __forceinline__ static f32x2 sw2(f32x2 g, f32x2 u) {
        constexpr float c1 = -1.4426950408889634f / WSCALE, c2 = HSCALE / (WSCALE * WSCALE);
        const f32x2 t = g * c1; f32x2 d; d.x = __builtin_amdgcn_exp2f(t.x); d.y = __builtin_amdgcn_exp2f(t.y); d = d + 1.0f;
        f32x2 r; r.x = __builtin_amdgcn_rcpf(d.x); r.y = __builtin_amdgcn_rcpf(d.y);
        f32x2 p = (g * u) * (r * c2); p.x = clamp448(p.x); p.y = clamp448(p.y); return p; }
    __device__ __forceinline__ void operator()(const f32x4 (&acc)[2][2][4][2], const Unit& u, int wr, int wc, int fr, int fq) const {
        const int row0 = u.pm * BM + wr * 64 + fr, col0 = (u.pn & 15) * HALF + wc * 32 + 8 * fq;
#pragma unroll
        for (int ai = 0; ai < 2; ++ai)
#pragma unroll
            for (int m = 0; m < 4; ++m) { unsigned char* rowp = O + (size_t)(row0 + ai * HALF + m * 16) * ldc + col0;
                const f32x4 g0 = acc[ai][0][m][0], g1 = acc[ai][0][m][1], u0 = acc[ai][1][m][0], u1 = acc[ai][1][m][1];
                const f32x2 a = sw2((f32x2){g0[0], g0[1]}, (f32x2){u0[0], u0[1]}), b = sw2((f32x2){g0[2], g0[3]}, (f32x2){u0[2], u0[3]});
                const f32x2 c = sw2((f32x2){g1[0], g1[1]}, (f32x2){u1[0], u1[1]}), d = sw2((f32x2){g1[2], g1[3]}, (f32x2){u1[2], u1[3]});
                u32x2 w; w.x = pk4_fp8(a.x, a.y, b.x, b.y); w.y = pk4_fp8(c.x, c.y, d.x, d.y);
                *(u32x2*)rowp = w; }
    }
};
struct EpiScaleBf16 {
    static constexpr bool PERM = true, AFTER_DRAIN = false;
    bf16_t* O; int ldc; const float* rowscale;
    __device__ __forceinline__ void operator()(const f32x4 (&acc)[2][2][4][2], const Unit& u, int wr, int wc, int fr, int fq) const {
        const int row0 = u.pm * BM + wr * 64 + fr, col0 = (u.pn & 3) * BM + wc * 32 + 8 * fq;
#pragma unroll
        for (int ai = 0; ai < 2; ++ai)
#pragma unroll
            for (int m = 0; m < 4; ++m) { const int row = row0 + ai * HALF + m * 16; const float s = rowscale[row] * (1.0f / (WSCALE * HSCALE)); bf16_t* rowp = O + (size_t)row * ldc + col0;
#pragma unroll
                for (int bj = 0; bj < 2; ++bj) { const f32x4 v0 = acc[ai][bj][m][0] * s, v1 = acc[ai][bj][m][1] * s;
                    u32x4 w; w.x = cvt_pk_bf16(v0[0], v0[1]); w.y = cvt_pk_bf16(v0[2], v0[3]); w.z = cvt_pk_bf16(v1[0], v1[1]); w.w = cvt_pk_bf16(v1[2], v1[3]);
                    *(u32x4*)(rowp + bj * HALF) = w; } }
    }
};
struct EpiNull { static constexpr bool PERM = true, AFTER_DRAIN = false; __device__ __forceinline__ void operator()(const f32x4 (&)[2][2][4][2], const Unit&, int, int, int, int) const {} };
struct TailOrder {
    int G, c, pn;
    __device__ __forceinline__ bool next(int i, Unit& u) const { const int L = i * G + c; if (L >= 64) return false; u.pm = L; u.pn = pn; return true; }
    __device__ __forceinline__ void a_ready(const Unit&) const {}
    __device__ __forceinline__ void done(const Unit&) const {}
};
struct Moe1Order {
    int G, c;
    __device__ __forceinline__ bool next(int i, Unit& u) const {
        const int L = i * G + c; if (L >= 2048) return false;
        const int e = L >> 7, r = L & 127; u.pm = e * 8 + ((r >> 3) & 7); u.pn = e * 16 + 2 * (r & 7) + (r >> 6); return true;
    }
    __device__ __forceinline__ void a_ready(const Unit&) const {}
    __device__ __forceinline__ void done(const Unit&) const {}
};
struct Moe2Order {
    int G, c;
    __device__ __forceinline__ bool next(int i, Unit& u) const {
        const int L = i * G + c; if (L >= 512) return false;
        const int q = L & 7, Lp = L >> 3, e = 8 * (Lp >> 5) + q, k = Lp & 31; u.pm = e * 8 + (k & 7); u.pn = e * 4 + (k >> 3); return true;
    }
    __device__ __forceinline__ void a_ready(const Unit&) const {}
    __device__ __forceinline__ void done(const Unit&) const {}
};
template <class Epi, class Sched, bool ALIGN_EPI = false, bool SP2 = false, bool F8 = false>
__device__ __forceinline__ void gemm_phase(PG8_LAS unsigned char* lds, const Gemm g, const Sched& S, const Epi& E) {
    const int tid = ltid(), wid = __builtin_amdgcn_readfirstlane(tid >> 6), lane = tid & 63, wr = wid >> 2, wc = wid & 3, fr = lane & 15, fq = lane >> 4;
    const int K = g.K, nt = K / BK;
    unsigned voffA[2], voffB[2];
#pragma unroll
    for (int i = 0; i < 2; ++i) { int R, C; stage_rc(tid * 16 + i * 8192, R, C); const int Rb = Epi::PERM ? ((R & ~31) + perm32(R & 31)) : R;
        voffA[i] = (unsigned)(R * K + C) * 2u; voffB[i] = (unsigned)(Rb * K + C) * 2u; }
    const size_t kstep = (size_t)(BK * 2);
    const size_t hstep = (size_t)HALF * K * 2;
    const size_t tstep = 2 * hstep;
    const unsigned ldsw = (unsigned)wid * 1024u;
    const int aoff = lds_byte(wr * 64 + fr, fq * 8), boff = lds_byte(wc * 32 + fr, fq * 8);
#define PG8_SA(b, h) (((b) * 2 + (h)) * HTB)
#define PG8_SB(b, h) ((4 + (b) * 2 + (h)) * HTB)
#define PG8_STAGE(bufoff, gbase, voff) do { _Pragma("unroll") for (int _i = 0; _i < 2; ++_i) \
        __builtin_amdgcn_global_load_lds((const unsigned*)((const char*)(gbase) + (voff)[_i]), (PG8_LAS unsigned*)(lds + (bufoff) + ldsw + _i * 8192), 16, 0, 0); } while (0)
#define PG8_LDA(dst, b, h) do { _Pragma("unroll") for (int m = 0; m < 4; ++m) { if constexpr (F8) { dst##8[m] = cat8(*(const PG8_LAS bf16x8*)(lds + PG8_SA(b, h) + aoff + m * 2048), *(const PG8_LAS bf16x8*)(lds + PG8_SA(b, h) + aoff + m * 2048 + 1024)); } \
        else { _Pragma("unroll") for (int k = 0; k < 2; ++k) dst[m][k] = *(const PG8_LAS bf16x8*)(lds + PG8_SA(b, h) + aoff + m * 2048 + k * 1024); } } } while (0)
#define PG8_LDB(dst, b, h) do { _Pragma("unroll") for (int n = 0; n < 2; ++n) { if constexpr (F8) { dst##8[n] = cat8(*(const PG8_LAS bf16x8*)(lds + PG8_SB(b, h) + boff + n * 2048), *(const PG8_LAS bf16x8*)(lds + PG8_SB(b, h) + boff + n * 2048 + 1024)); } \
        else { _Pragma("unroll") for (int k = 0; k < 2; ++k) dst[n][k] = *(const PG8_LAS bf16x8*)(lds + PG8_SB(b, h) + boff + n * 2048 + k * 1024); } } } while (0)
#define PG8_MMA(ai, bj, At, Bt) do { __builtin_amdgcn_s_setprio(1); _Pragma("unroll") for (int m = 0; m < 4; ++m) _Pragma("unroll") for (int n = 0; n < 2; ++n) { \
        if constexpr (F8) { asm volatile("v_mfma_scale_f32_16x16x128_f8f6f4 %0, %1, %2, %0, %3, %3 op_sel_hi:[0,0,0]" : "+v"(acc[ai][bj][m][n]) : "v"(Bt##8[n]), "v"(At##8[m]), "v"(sc1)); } \
        else { _Pragma("unroll") for (int k = 0; k < 2; ++k) acc[ai][bj][m][n] = __builtin_amdgcn_mfma_f32_16x16x32_bf16(Bt[n][k], At[m][k], acc[ai][bj][m][n], 0, 0, 0); } } __builtin_amdgcn_s_setprio(0); } while (0)
#define PG8_WAIT_V(n) asm volatile("s_waitcnt vmcnt(" #n ")" ::: "memory")
#define PG8_WAIT_L(n) asm volatile("s_waitcnt lgkmcnt(" #n ")" ::: "memory")
#define PG8_BAR __builtin_amdgcn_s_barrier()
#define PG8_SCHED __builtin_amdgcn_sched_barrier(0)
    Unit cur, nxt; int ui = 0;
    if (!S.next(0, cur)) return;
    f32x4 acc[2][2][4][2];
#pragma unroll
    for (int a = 0; a < 2; ++a)
#pragma unroll
        for (int b = 0; b < 2; ++b)
#pragma unroll
            for (int m = 0; m < 4; ++m)
#pragma unroll
                for (int n = 0; n < 2; ++n) acc[a][b][m][n] = (f32x4){0.f, 0.f, 0.f, 0.f};
    bf16x8 At[4][2], B0[2][2], B1[2][2]; i32x8 At8[4], B08[2], B18[2];
    const int sc1 = 0x7F7F7F7F;
    const char* cA = (const char*)g.A + (size_t)cur.pm * tstep; const char* cB = (const char*)g.Bt + (size_t)cur.pn * tstep;
    S.a_ready(cur);
    if constexpr (SP2) {
        PG8_STAGE(PG8_SB(0, 0), cB, voffB); PG8_STAGE(PG8_SB(0, 1), cB + hstep, voffB); PG8_STAGE(PG8_SA(0, 0), cA, voffA); PG8_STAGE(PG8_SA(0, 1), cA + hstep, voffA);
        if (wr == 1) PG8_BAR;
        PG8_WAIT_V(2); PG8_BAR;
        PG8_STAGE(PG8_SB(1, 0), cB + kstep, voffB); PG8_STAGE(PG8_SA(1, 0), cA + kstep, voffA); PG8_STAGE(PG8_SB(1, 1), cB + hstep + kstep, voffB);
        PG8_WAIT_V(6); PG8_BAR;
    } else {
        PG8_STAGE(PG8_SB(0, 0), cB, voffB); PG8_STAGE(PG8_SA(0, 0), cA, voffA); PG8_STAGE(PG8_SB(0, 1), cB + hstep, voffB); PG8_STAGE(PG8_SA(0, 1), cA + hstep, voffA);
        if (wr == 1) PG8_BAR;
        PG8_WAIT_V(4); PG8_BAR;
        PG8_STAGE(PG8_SB(1, 0), cB + kstep, voffB); PG8_STAGE(PG8_SA(1, 0), cA + kstep, voffA); PG8_STAGE(PG8_SB(1, 1), cB + hstep + kstep, voffB);
        PG8_WAIT_V(6); PG8_BAR;
    }
    for (;;) {
        const bool has_next = S.next(ui + 1, nxt);
        const char* nA = has_next ? (const char*)g.A + (size_t)nxt.pm * tstep : cA; const char* nB = has_next ? (const char*)g.Bt + (size_t)nxt.pn * tstep : cB;
        for (int t = 0; t < nt; t += 2) {
            const bool last = (t == nt - 2);
            const char* a1 = cA + (size_t)(t + 1) * kstep;
            const char* a2 = last ? nA : cA + (size_t)(t + 2) * kstep; const char* b2 = last ? nB : cB + (size_t)(t + 2) * kstep;
            const char* a3 = a2 + kstep; const char* b3 = b2 + kstep;
            if (last && has_next) S.a_ready(nxt);
            if constexpr (SP2) {
            PG8_LDB(B0, 0, 0); PG8_LDB(B1, 0, 1); PG8_SCHED; PG8_LDA(At, 0, 0); PG8_STAGE(PG8_SA(1, 1), a1 + hstep, voffA);
            PG8_WAIT_V(8); PG8_WAIT_L(0); PG8_BAR; PG8_MMA(0, 0, At, B0); PG8_MMA(0, 1, At, B1); PG8_BAR; PG8_SCHED;
            PG8_LDA(At, 0, 1); PG8_STAGE(PG8_SB(0, 0), b2, voffB); PG8_STAGE(PG8_SB(0, 1), b2 + hstep, voffB); PG8_STAGE(PG8_SA(0, 0), a2, voffA);
            PG8_WAIT_V(8); PG8_WAIT_L(0); PG8_BAR; PG8_MMA(1, 0, At, B0); PG8_MMA(1, 1, At, B1); PG8_BAR; PG8_SCHED;
            PG8_LDB(B0, 1, 0); PG8_LDB(B1, 1, 1); PG8_SCHED; PG8_LDA(At, 1, 0); PG8_STAGE(PG8_SA(0, 1), a2 + hstep, voffA);
            PG8_WAIT_V(8); PG8_WAIT_L(0); PG8_BAR; PG8_MMA(0, 0, At, B0); PG8_MMA(0, 1, At, B1); PG8_BAR; PG8_SCHED;
            PG8_LDA(At, 1, 1); PG8_STAGE(PG8_SB(1, 0), b3, voffB); PG8_STAGE(PG8_SB(1, 1), b3 + hstep, voffB); PG8_STAGE(PG8_SA(1, 0), a3, voffA);
            PG8_WAIT_V(8); PG8_WAIT_L(0); PG8_BAR; PG8_MMA(1, 0, At, B0); PG8_MMA(1, 1, At, B1); PG8_BAR; PG8_SCHED;
            } else {
            PG8_LDB(B0, 0, 0); PG8_SCHED; PG8_LDA(At, 0, 0); PG8_STAGE(PG8_SA(1, 1), a1 + hstep, voffA);
            PG8_WAIT_L(8); PG8_BAR; PG8_WAIT_L(0); PG8_MMA(0, 0, At, B0); PG8_BAR; PG8_SCHED;
            PG8_LDB(B1, 0, 1); PG8_STAGE(PG8_SB(0, 0), b2, voffB);
            PG8_BAR; PG8_WAIT_L(0); PG8_MMA(0, 1, At, B1); PG8_BAR;
            PG8_LDA(At, 0, 1); PG8_STAGE(PG8_SA(0, 0), a2, voffA);
            PG8_BAR; PG8_WAIT_L(0); PG8_MMA(1, 0, At, B0); PG8_BAR; PG8_SCHED;
            PG8_STAGE(PG8_SB(0, 1), b2 + hstep, voffB);
            PG8_WAIT_V(6); PG8_BAR; PG8_MMA(1, 1, At, B1); PG8_BAR;
            PG8_LDB(B0, 1, 0); PG8_SCHED; PG8_LDA(At, 1, 0); PG8_STAGE(PG8_SA(0, 1), a2 + hstep, voffA);
            PG8_WAIT_L(8); PG8_BAR; PG8_WAIT_L(0); PG8_MMA(0, 0, At, B0); PG8_BAR; PG8_SCHED;
            PG8_LDB(B1, 1, 1); PG8_STAGE(PG8_SB(1, 0), b3, voffB);
            PG8_BAR; PG8_WAIT_L(0); PG8_MMA(0, 1, At, B1); PG8_BAR;
            PG8_LDA(At, 1, 1); PG8_STAGE(PG8_SA(1, 0), a3, voffA);
            PG8_BAR; PG8_WAIT_L(0); PG8_MMA(1, 0, At, B0); PG8_BAR; PG8_SCHED;
            PG8_STAGE(PG8_SB(1, 1), b3 + hstep, voffB);
            PG8_WAIT_V(6); PG8_BAR; PG8_MMA(1, 1, At, B1); PG8_BAR;
            }
        }
        if constexpr (F8) { asm volatile("s_nop 15\n\ts_nop 15" ::: "memory"); }
        if constexpr (ALIGN_EPI) { if (wr == 0) PG8_BAR; }
        if constexpr (!Epi::AFTER_DRAIN) { E(acc, cur, wr, wc, fr, fq); S.done(cur); }
        if (!has_next) break;
#pragma unroll
        for (int a = 0; a < 2; ++a)
#pragma unroll
            for (int b = 0; b < 2; ++b)
#pragma unroll
                for (int m = 0; m < 4; ++m)
#pragma unroll
                    for (int n = 0; n < 2; ++n) acc[a][b][m][n] = (f32x4){0.f, 0.f, 0.f, 0.f};
        cur = nxt; cA = nA; cB = nB; ++ui;
        if constexpr (ALIGN_EPI) { if (wr == 1) PG8_BAR; }
    }
    PG8_WAIT_V(0);
    if constexpr (!ALIGN_EPI) { if (wr == 0) PG8_BAR; }
    PG8_BAR;
    if constexpr (Epi::AFTER_DRAIN) { E.fused(acc, cur, wr, wc, fr, fq, lds, wid, lane); S.done(cur); }
#undef PG8_SA
#undef PG8_SB
#undef PG8_STAGE
#undef PG8_LDA
#undef PG8_LDB
#undef PG8_MMA
#undef PG8_WAIT_V
#undef PG8_WAIT_L
#undef PG8_BAR
#undef PG8_SCHED
}
}

namespace attn_body {
using bf16=__hip_bfloat16;
using bf16x8=__attribute__((ext_vector_type(8)))short;
using s16x4=__attribute__((ext_vector_type(4)))short;
using f32x16=__attribute__((ext_vector_type(16)))float;
using u32x4=__attribute__((ext_vector_type(4)))unsigned;
constexpr int BATCH=8,NHEAD=8,NKV=2,SEQ=2048,D=64,PQ=2304,PO=1024;
constexpr int NW=8,QBLK=32,QB=QBLK*NW,KVBLK=64,NQB=SEQ/QB;
constexpr int ATTN_UNIT_ROWS=QB;
__device__ __forceinline__ int crow(int r,int hi){return (r&3)+8*(r>>2)+4*hi;}
#define SBAR() __builtin_amdgcn_sched_barrier(0)
__device__ __forceinline__ void cmask(f32x16&p0,f32x16&p1,int jb,int qrel,int hi){
  const float NEG=-INFINITY; int kb=64*jb+4*hi;
  #pragma unroll
  for(int r=0;r<16;++r){int kv=kb+(r&3)+8*(r>>2); if(kv>qrel)p0[r]=NEG; if(kv+32>qrel)p1[r]=NEG;}
}

constexpr int NSLOT=3, SLOTB=8192;
constexpr int LDS_K=0, LDS_V=NSLOT*SLOTB, LDS_WS=2*NSLOT*SLOTB, LDS_OST=LDS_WS+NW*64*4, LDS_BYTES=LDS_OST+NW*4096;
constexpr float C2=0.125f*1.4426950408889634f;
__device__ __forceinline__ void glds16(const void*gsrc,unsigned lds_dst){unsigned keep;
  asm volatile("s_mov_b32 %0, m0\n\ts_mov_b32 m0, %2\n\ts_nop 0\n\tglobal_load_lds_dwordx4 %1, off\n\ts_mov_b32 m0, %0":"=&s"(keep):"v"(gsrc),"s"(lds_dst):"memory");}
__device__ __forceinline__ float max3f(float a,float b,float c){float r;asm("v_max3_f32 %0, %1, %2, %3":"=v"(r):"v"(a),"v"(b),"v"(c));return r;}
__device__ __forceinline__ float max2f(float a,float b){float r;asm("v_max_f32_e32 %0, %1, %2":"=v"(r):"v"(a),"v"(b));return r;}
__device__ __forceinline__ float fadd_s(float a,float b){float r;asm("v_add_f32_e32 %0, %1, %2":"=v"(r):"v"(a),"v"(b));return r;}
__device__ __forceinline__ float fsub_s(float a,float b){float r;asm("v_sub_f32_e32 %0, %1, %2":"=v"(r):"v"(a),"v"(b));return r;}
typedef float f32x2_t __attribute__((ext_vector_type(2))); typedef __bf16 bf16x2_t __attribute__((ext_vector_type(2)));
__device__ __forceinline__ unsigned cvtpk_s(float lo,float hi){f32x2_t v={lo,hi};bf16x2_t b=__builtin_convertvector(v,bf16x2_t);return __builtin_bit_cast(unsigned,b);}
#define WAIT_BAR(N) asm volatile("s_waitcnt vmcnt(" #N ") lgkmcnt(0)\n\ts_barrier":::"memory")

__device__ __forceinline__ void qkt(f32x16&p0,f32x16&p1,const char*Kslot,const bf16x8*qr,const f32x16&negm,int r32,int hi){
  const char*kb=Kslot+hi*1024+r32*16;
  #pragma unroll
  for(int d0=0;d0<4;++d0){
    const bf16x8 b0=*reinterpret_cast<const bf16x8*>(kb+d0*2048);
    const bf16x8 b1=*reinterpret_cast<const bf16x8*>(kb+d0*2048+512);
    if(d0==0){p0=__builtin_amdgcn_mfma_f32_32x32x16_bf16(b0,qr[0],negm,0,0,0);p1=__builtin_amdgcn_mfma_f32_32x32x16_bf16(b1,qr[0],negm,0,0,0);}
    else{p0=__builtin_amdgcn_mfma_f32_32x32x16_bf16(b0,qr[d0],p0,0,0,0);p1=__builtin_amdgcn_mfma_f32_32x32x16_bf16(b1,qr[d0],p1,0,0,0);}}
}
typedef __attribute__((address_space(3))) const char* lds_cptr;
typedef short v4i16_t __attribute__((ext_vector_type(4)));
__device__ __forceinline__ void kload8(bf16x8*kf,lds_cptr kp){
  kf[0]=*(const __attribute__((address_space(3))) bf16x8*)(kp);      kf[1]=*(const __attribute__((address_space(3))) bf16x8*)(kp+512);
  kf[2]=*(const __attribute__((address_space(3))) bf16x8*)(kp+2048); kf[3]=*(const __attribute__((address_space(3))) bf16x8*)(kp+2560);
  kf[4]=*(const __attribute__((address_space(3))) bf16x8*)(kp+4096); kf[5]=*(const __attribute__((address_space(3))) bf16x8*)(kp+4608);
  kf[6]=*(const __attribute__((address_space(3))) bf16x8*)(kp+6144); kf[7]=*(const __attribute__((address_space(3))) bf16x8*)(kp+6656);
}
__device__ __forceinline__ void kload2(bf16x8*kf,lds_cptr kp,int j){ kf[2*j]=*(const __attribute__((address_space(3))) bf16x8*)(kp+j*2048); kf[2*j+1]=*(const __attribute__((address_space(3))) bf16x8*)(kp+j*2048+512); }
__device__ __forceinline__ s16x4 vtr(lds_cptr p){ return __builtin_bit_cast(s16x4,__builtin_amdgcn_ds_read_tr16_b64_v4i16((__attribute__((address_space(3))) v4i16_t*)p)); }
__device__ __forceinline__ float rowmax(const f32x16&p0,const f32x16&p1){
  float a=max3f(p0[0],p0[1],p1[0]),b=max3f(p0[2],p0[3],p1[1]);a=max3f(a,p1[2],p1[3]);
  #pragma unroll
  for(int r=4;r<16;r+=4){a=max3f(a,p0[r],p0[r+1]);b=max3f(b,p0[r+2],p0[r+3]);a=max3f(a,p1[r],p1[r+1]);b=max3f(b,p1[r+2],p1[r+3]);}
  const float m=max2f(a,b);
  auto rr=__builtin_amdgcn_permlane32_swap(__float_as_uint(m),__float_as_uint(m),false,false);
  return max2f(__uint_as_float(rr[0]),__uint_as_float(rr[1]));
}
__device__ __forceinline__ void pv(f32x16*o,int vb,bf16x8 pa0,bf16x8 pa1,bf16x8 pa2,bf16x8 pa3){
  #pragma unroll
  for(int d0=0;d0<2;++d0){s16x4 lo[4],hi[4];
    #pragma unroll
    for(int ks=0;ks<4;++ks){
      asm volatile("ds_read_b64_tr_b16 %0,%1 offset:%c2":"=&v"(lo[ks]):"v"(vb),"i"(d0*4096+ks*1024):"memory");
      asm volatile("ds_read_b64_tr_b16 %0,%1 offset:%c2":"=&v"(hi[ks]):"v"(vb),"i"(d0*4096+ks*1024+512):"memory");}
    asm volatile("s_waitcnt lgkmcnt(0)":::"memory");SBAR();
    #define PK(k) (bf16x8){lo[k][0],lo[k][1],lo[k][2],lo[k][3],hi[k][0],hi[k][1],hi[k][2],hi[k][3]}
    o[d0]=__builtin_amdgcn_mfma_f32_32x32x16_bf16(pa0,PK(0),o[d0],0,0,0);
    o[d0]=__builtin_amdgcn_mfma_f32_32x32x16_bf16(pa1,PK(1),o[d0],0,0,0);
    o[d0]=__builtin_amdgcn_mfma_f32_32x32x16_bf16(pa2,PK(2),o[d0],0,0,0);
    o[d0]=__builtin_amdgcn_mfma_f32_32x32x16_bf16(pa3,PK(3),o[d0],0,0,0);
    #undef PK
  }
}

#ifndef ATTN_STORE16
#define ATTN_STORE16(p,v) (*(u32x4*)(p)=(v))
#endif
template<int THRL> __device__ __forceinline__ void attn_unit(int b,int h,int qb,const bf16*Q,const bf16*__restrict__ K,const bf16*__restrict__ V,bf16*O,char*shm){
  const int tid=ltid(),lane=tid&63,r32=lane&31,hi=lane>>5; const int wid=__builtin_amdgcn_readfirstlane(tid>>6);
  const long rowbase=(long)b*SEQ; const int q0=qb*QB;
  const bf16*Qw=Q+(rowbase+q0+wid*QBLK)*PQ+h*D;
  const bf16*Kh=K+rowbase*PQ+(h>>2)*D,*Vh=V+rowbase*PQ+(h>>2)*D;
  const unsigned lds0=(unsigned)(uintptr_t)shm;
  float*wsf=(float*)(shm+LDS_WS)+wid*64;
  const bf16*ksrc=Kh+(long)lane*PQ+wid*8;
  const bf16*vsrc=Vh+(long)(16*(wid&3)+(lane>>2))*PQ+(wid>>2)*32+(lane&3)*8;
  const unsigned kdst=lds0+LDS_K+wid*1024, vdst=lds0+LDS_V+wid*1024;
  #define DMA_K(t,slot) glds16(ksrc+(long)(t)*KVBLK*PQ,(unsigned)__builtin_amdgcn_readfirstlane(kdst+(slot)))
  #define DMA_V(t,slot) glds16(vsrc+(long)(t)*KVBLK*PQ,(unsigned)__builtin_amdgcn_readfirstlane(vdst+(slot)))
  const int vb0=(int)(lds0+LDS_V)+((lane>>4)&1)*32+(lane&3)*8+(4*hi+((lane&15)>>2))*64;
  const char*Kbase=shm+LDS_K; bf16x8 kf[8];
  const lds_cptr shm3=(lds_cptr)shm; const lds_cptr kp0=shm3+LDS_K+hi*1024+r32*16; const lds_cptr vp0=shm3+LDS_V+((lane>>4)&1)*32+(lane&3)*8+(4*hi+((lane&15)>>2))*64;
  const int NT=SEQ/KVBLK;
  DMA_K(0,0);DMA_V(0,0);DMA_K(1,SLOTB);
  bf16x8 qr[4];
  #pragma unroll
  for(int d0=0;d0<4;++d0)qr[d0]=*reinterpret_cast<const bf16x8*>(&Qw[(long)r32*PQ+d0*16+hi*8]);
  float mhat=0.f,l_reg=0.f;f32x16 o[2];o[0]=f32x16{};o[1]=f32x16{};f32x16 negm=f32x16{};asm volatile("":"+v"(negm));
  const int qrel=wid*QBLK+r32;
  #define CMASK(P0,P1,t) do{}while(0)
  bool resc=false;
  #define START(P0,P1) do{ const float rm=rowmax(P0,P1); resc=false; \
    { const float dl=rm; mhat=fadd_s(mhat,dl); \
      _Pragma("unroll") for(int r=0;r<16;++r){P0[r]=fsub_s(P0[r],dl);P1[r]=fsub_s(P1[r],dl);} \
      _Pragma("unroll") for(int r=0;r<16;++r)negm[r]=-mhat; asm volatile("":"+v"(negm)); } \
    _Pragma("unroll") for(int r=0;r<16;++r)P0[r]=__builtin_amdgcn_exp2f(P0[r]); }while(0)
  #define RESC() do{ if(resc){ asm volatile("s_waitcnt lgkmcnt(0)":::"memory"); \
      _Pragma("unroll") for(int d_=0;d_<2;++d_) _Pragma("unroll") for(int r=0;r<16;++r)o[d_][r]*=wsf[crow(r,hi)]; } }while(0)
  f32x16 pA0,pA1,pB0,pB1;
  int sl_prev=0,sl_cur=0,sl_next=SLOTB;
  #define ROT() do{sl_prev=sl_cur;sl_cur=sl_next;sl_next=(sl_next==(NSLOT-1)*SLOTB)?0:sl_next+SLOTB;}while(0)
  DMA_K(2,2*SLOTB);
  WAIT_BAR(3);
  qkt(pA0,pA1,Kbase,qr,negm,r32,hi);asm volatile("s_nop 15\n\ts_nop 7":"+v"(pA0),"+v"(pA1));CMASK(pA0,pA1,0);
  START(pA0,pA1);
  _Pragma("unroll") for(int r=0;r<16;++r)pA1[r]=__builtin_amdgcn_exp2f(pA1[r]);
  WAIT_BAR(0);
  DMA_K(3,0);DMA_V(1,SLOTB);
  ROT();
  kload8(kf,kp0+sl_cur);
  WAIT_BAR(2);
  s16x4 vlo[8],vhi[8]; u32x4 pw0,pw1,pw2,pw3;
  #define PKW(P,B) cvtpk_s(P[B],P[B+1])
  #define PAF(k) __builtin_bit_cast(bf16x8,pw##k)
  #define VFR(i) (bf16x8){vlo[i][0],vlo[i][1],vlo[i][2],vlo[i][3],vhi[i][0],vhi[i][1],vhi[i][2],vhi[i][3]}
  #define PIN(x) asm volatile("":"+v"(x))
  #define MX3(a,b,c) __builtin_fmaxf(__builtin_fmaxf((a),(b)),(c))
  #define GAPA(MF,A0,A1,A2,A3,W0,W1,PW) do{ MF; sacc+=A0; sacc+=A1; sacc+=A2; sacc+=A3; PIN(sacc); W0; W1; PIN(PW); SBAR(); }while(0)
  #define EX(v) __builtin_amdgcn_exp2f(v)
  #define GAPB(MF,X,B) do{ MF; X[B]=EX(X[B]); X[B+1]=EX(X[B+1]); X[B+2]=EX(X[B+2]); X[B+3]=EX(X[B+3]); PIN(X); SBAR(); }while(0)
  #define VRD(i) do{ vlo[i]=vtr(vp_+(((i)>>2)*4096+((i)&3)*1024)); vhi[i]=vtr(vp_+(((i)>>2)*4096+((i)&3)*1024+512)); }while(0)
  #define KRD(G,j) do{ if(G){ kload2(kf,kp0+sl_next,j); SBAR(); } }while(0)
  #define STEP(C0,C1,P0,P1,t,GK,GV,GL) do{ SBAR(); \
    const lds_cptr vp_=vp0+sl_prev; \
    VRD(0); SBAR(); float sacc=(P0[0]+P0[1]); \
    GAPA(C0=__builtin_amdgcn_mfma_f32_32x32x16_bf16(kf[0],qr[0],negm,0,0,0), P0[2],P0[3],P0[4],P0[5],     pw0[0]=PKW(P0,0), pw0[1]=PKW(P0,2), pw0); \
    VRD(4); SBAR(); GAPA(C1=__builtin_amdgcn_mfma_f32_32x32x16_bf16(kf[1],qr[0],negm,0,0,0), P0[6],P0[7],P0[8],P0[9],     pw0[2]=PKW(P0,4), pw0[3]=PKW(P0,6), pw0); \
    VRD(1); SBAR(); GAPA(C0=__builtin_amdgcn_mfma_f32_32x32x16_bf16(kf[2],qr[1],C0,0,0,0),   P0[10],P0[11],P0[12],P0[13], pw1[0]=PKW(P0,8), pw1[1]=PKW(P0,10), pw1); \
    VRD(5); SBAR(); GAPA(C1=__builtin_amdgcn_mfma_f32_32x32x16_bf16(kf[3],qr[1],C1,0,0,0),   P0[14],P0[15],P1[0],P1[1],   pw1[2]=PKW(P0,12),pw1[3]=PKW(P0,14), pw1); \
    VRD(2); SBAR(); GAPA(C0=__builtin_amdgcn_mfma_f32_32x32x16_bf16(kf[4],qr[2],C0,0,0,0),   P1[2],P1[3],P1[4],P1[5],     pw2[0]=PKW(P1,0), pw2[1]=PKW(P1,2), pw2); \
    VRD(6); SBAR(); GAPA(C1=__builtin_amdgcn_mfma_f32_32x32x16_bf16(kf[5],qr[2],C1,0,0,0),   P1[6],P1[7],P1[8],P1[9],     pw2[2]=PKW(P1,4), pw2[3]=PKW(P1,6), pw2); \
    VRD(3); SBAR(); GAPA(C0=__builtin_amdgcn_mfma_f32_32x32x16_bf16(kf[6],qr[3],C0,0,0,0),   P1[10],P1[11],P1[12],P1[13], pw3[0]=PKW(P1,8), pw3[1]=PKW(P1,10), pw3); \
    VRD(7); SBAR(); GAPA(C1=__builtin_amdgcn_mfma_f32_32x32x16_bf16(kf[7],qr[3],C1,0,0,0),   P1[14],P1[15],0.f,0.f,       pw3[2]=PKW(P1,12),pw3[3]=PKW(P1,14), pw3); \
    l_reg+=sacc; \
    if(GK){DMA_K((t)+3,sl_cur);} if(GV){DMA_V((t)+1,sl_next);} \
    CMASK(C0,C1,t); \
    { float a=MX3(C0[0],C0[1],C1[0]),b=MX3(C0[2],C0[3],C1[1]); a=MX3(a,C1[2],C1[3]); \
      _Pragma("unroll") for(int r=4;r<16;r+=4){a=MX3(a,C0[r],C0[r+1]);b=MX3(b,C0[r+2],C0[r+3]);a=MX3(a,C1[r],C1[r+1]);b=MX3(b,C1[r+2],C1[r+3]);} \
      float rm=__builtin_fmaxf(a,b); { auto rr=__builtin_amdgcn_permlane32_swap(__float_as_uint(rm),__float_as_uint(rm),false,false); rm=__builtin_fmaxf(__uint_as_float(rr[0]),__uint_as_float(rr[1])); } \
      resc=false; \
      if(__builtin_expect(__any(rm>(float)THRL),0)){ const float dl=__builtin_fmaxf(rm,0.f); mhat+=dl; \
        _Pragma("unroll") for(int r=0;r<16;++r){C0[r]-=dl;C1[r]-=dl;} \
        _Pragma("unroll") for(int r=0;r<16;++r)negm[r]=-mhat; asm volatile("":"+v"(negm)); \
        const float f=__builtin_amdgcn_exp2f(-dl); l_reg*=f; if(hi==0)wsf[r32]=f; resc=true; } } \
    SBAR(); \
    GAPB(o[0]=__builtin_amdgcn_mfma_f32_32x32x16_bf16(PAF(0),VFR(0),o[0],0,0,0), C0,0); \
    GAPB(o[1]=__builtin_amdgcn_mfma_f32_32x32x16_bf16(PAF(0),VFR(4),o[1],0,0,0), C0,4); \
    KRD(GL,0); GAPB(o[0]=__builtin_amdgcn_mfma_f32_32x32x16_bf16(PAF(1),VFR(1),o[0],0,0,0), C0,8); \
    KRD(GL,1); GAPB(o[1]=__builtin_amdgcn_mfma_f32_32x32x16_bf16(PAF(1),VFR(5),o[1],0,0,0), C0,12); \
    KRD(GL,2); GAPB(o[0]=__builtin_amdgcn_mfma_f32_32x32x16_bf16(PAF(2),VFR(2),o[0],0,0,0), C1,0); \
    KRD(GL,3); GAPB(o[1]=__builtin_amdgcn_mfma_f32_32x32x16_bf16(PAF(2),VFR(6),o[1],0,0,0), C1,4); \
    GAPB(o[0]=__builtin_amdgcn_mfma_f32_32x32x16_bf16(PAF(3),VFR(3),o[0],0,0,0), C1,8); \
    GAPB(o[1]=__builtin_amdgcn_mfma_f32_32x32x16_bf16(PAF(3),VFR(7),o[1],0,0,0), C1,12); \
    }while(0)
  int t=1;
  #undef CMASK
  #define CMASK(P0,P1,t) do{}while(0)
  for(;t+5<NT;t+=2){
    STEP(pB0,pB1,pA0,pA1,t,true,true,true);     WAIT_BAR(2); RESC(); ROT();
    STEP(pA0,pA1,pB0,pB1,t+1,true,true,true);   WAIT_BAR(2); RESC(); ROT();
  }
  #undef CMASK
  #define CMASK(P0,P1,t) do{}while(0)
  #define ENDW(tt) do{ if((tt)+3<NT){WAIT_BAR(2);} else if((tt)+2<NT){WAIT_BAR(1);} else {WAIT_BAR(0);} }while(0)
  for(;t+1<NT;t+=2){
    STEP(pB0,pB1,pA0,pA1,t,(t+3<NT),(t+1<NT),(t+1<NT));       ENDW(t);   RESC(); ROT();
    STEP(pA0,pA1,pB0,pB1,t+1,(t+4<NT),(t+2<NT),(t+2<NT));     ENDW(t+1); RESC(); ROT();
  }
  STEP(pB0,pB1,pA0,pA1,NT-1,false,false,false); RESC();
  { float sacc=pB0[0]+pB0[1]; _Pragma("unroll") for(int r=2;r<16;++r)sacc+=pB0[r]; _Pragma("unroll") for(int r=0;r<16;++r)sacc+=pB1[r]; l_reg+=sacc;
    pw0=(u32x4){PKW(pB0,0),PKW(pB0,2),PKW(pB0,4),PKW(pB0,6)};pw1=(u32x4){PKW(pB0,8),PKW(pB0,10),PKW(pB0,12),PKW(pB0,14)};pw2=(u32x4){PKW(pB1,0),PKW(pB1,2),PKW(pB1,4),PKW(pB1,6)};pw3=(u32x4){PKW(pB1,8),PKW(pB1,10),PKW(pB1,12),PKW(pB1,14)};
    SBAR(); pv(o,vb0+sl_cur,PAF(0),PAF(1),PAF(2),PAF(3)); }
  #undef PKW
  #undef PAF
  #undef VFR
  #undef PIN
  #undef MX3
  #undef GAPA
  #undef GAPB
  #undef EX
  #undef VRD
  #undef KRD
  #undef STEP
  #undef ENDW
  {auto rr=__builtin_amdgcn_permlane32_swap(__float_as_uint(l_reg),__float_as_uint(l_reg),false,false);l_reg=__uint_as_float(rr[0])+__uint_as_float(rr[1]);}
  if(hi==0)wsf[32+r32]=l_reg;asm volatile("s_waitcnt lgkmcnt(0)":::"memory");
  float rli[16];
  #pragma unroll
  for(int r=0;r<16;++r)rli[r]=__builtin_amdgcn_rcpf(wsf[32+crow(r,hi)]);
  bf16*Ow=O+(rowbase+q0+wid*QBLK)*PO+h*D;
  { bf16*stg=(bf16*)(shm+LDS_OST)+wid*2048;
    #pragma unroll
    for(int r=0;r<16;++r){const int orow=crow(r,hi);
      #pragma unroll
      for(int d0=0;d0<2;++d0)stg[orow*64+d0*32+r32]=__float2bfloat16(o[d0][r]*rli[r]);}
    asm volatile("s_waitcnt lgkmcnt(0)":::"memory");
    #pragma unroll
    for(int i=0;i<4;++i){const int row=i*8+(lane>>3),ch=lane&7; const u32x4 v=*(const u32x4*)(stg+row*64+ch*8); ATTN_STORE16(Ow+(long)row*PO+ch*8,v);} }
  asm volatile("s_waitcnt lgkmcnt(0)\n\ts_barrier":::"memory");
  #undef DMA_K
  #undef DMA_V
  #undef CMASK
  #undef START
  #undef RESC
  #undef ROT
}
constexpr int ATTN_LDS_BYTES=LDS_BYTES;
struct AttnTensors { const bf16* Q; const bf16* K; const bf16* V; bf16* O; };
struct AttnUnit { int b; int h; int qb; };
struct StaticOrder {
  int vcu, G;
  __device__ __forceinline__ explicit StaticOrder(int grid,int block):vcu((grid%8==0)?(block%8)*(grid/8)+block/8:block),G(grid){}
  __device__ __forceinline__ bool next(int i,AttnUnit&u)const{ const int L=i*G+vcu; if(L>=BATCH*NHEAD*(SEQ/QB))return false; const int grp=L>>5,r=L&31; u.b=grp>>1; u.h=(grp&1)*4+(r>>3); u.qb=r&7; return true; }
  __device__ __forceinline__ void a_ready(const AttnUnit&)const{}
  __device__ __forceinline__ void done(const AttnUnit&)const{}
};
template<class Sched,int THRL=8> __device__ __forceinline__ void attn_phase(char*lds,const AttnTensors&T,const Sched&S){
  AttnUnit u;
  for(int i=0;S.next(i,u);++i){ S.a_ready(u); attn_unit<THRL>(u.b,u.h,u.qb,T.Q,T.K,T.V,T.O,lds); S.done(u); }
}
#undef SBAR
#undef WAIT_BAR
}


#define GAS __attribute__((address_space(1)))
#define LAS __attribute__((address_space(3)))
typedef unsigned short bf16;
typedef unsigned v4u __attribute__((ext_vector_type(4)));
typedef float f32x4 __attribute__((ext_vector_type(4)));
typedef short bf16x8 __attribute__((ext_vector_type(8)));
typedef GAS unsigned gu32;
typedef GAS unsigned long long gu64;
#define RLX_AGENT __ATOMIC_RELAXED, __HIP_MEMORY_SCOPE_AGENT
#define LDS_WAIT() asm volatile("s_waitcnt lgkmcnt(0)" ::: "memory")
#define VM_WAIT() asm volatile("s_waitcnt vmcnt(0)" ::: "memory")
__device__ __forceinline__ unsigned long long rt() { return __builtin_amdgcn_s_memrealtime(); }
__device__ __forceinline__ unsigned pk2(float lo, float hi) { typedef float f2_ __attribute__((ext_vector_type(2))); typedef __bf16 b2_ __attribute__((ext_vector_type(2))); const f2_ v = {lo, hi}; return __builtin_bit_cast(unsigned, __builtin_convertvector(v, b2_)); }
__device__ __forceinline__ unsigned f2bf(float f) { return pk2(f, 0.f) & 0xffffu; }

#define XB_TMO      128
#define XB_XCNT(j)  (256  + 64 * (j))
#define XB_XSUB(j)  (1280 + 64 * (j))
#define XB_XGEN(j)  (2304 + 64 * (j))
#define XB_TOP      3328
#define XB_TOPGEN   3392
#define XCD_BAR_WORDS 3456
#define XB_SPIN_CAP (1u << 18)

__device__ __forceinline__ unsigned xb_ld(unsigned* p)              { return __hip_atomic_load(p, __ATOMIC_RELAXED, __HIP_MEMORY_SCOPE_AGENT); }
__device__ __forceinline__ unsigned xb_add(unsigned* p, unsigned v) { return __hip_atomic_fetch_add(p, v, __ATOMIC_RELAXED, __HIP_MEMORY_SCOPE_AGENT); }
__device__ __forceinline__ unsigned xb_xcc_id() { return (unsigned)__builtin_amdgcn_s_getreg((3 << 11) | 20) & 0xFu; }
#define XB_SPIN(cond, bar) do { unsigned _sp = 0; while (cond) { __builtin_amdgcn_s_sleep(1); \
    if ((++_sp & 255u) == 0u) { if (xb_ld(&(bar)[XB_TMO])) break; if (_sp > XB_SPIN_CAP) { atomicAdd(&(bar)[XB_TMO], 1u); break; } } } } while (0)

struct XcdBarrier {
    unsigned* bar; unsigned x;
    volatile LAS unsigned* st;
};

__device__ __forceinline__ XcdBarrier xcd_barrier_post(unsigned* bar, volatile LAS unsigned* st) {
    XcdBarrier b; b.bar = bar; b.x = xb_xcc_id(); b.st = st;
    if (threadIdx.x == 0) (void)xb_add(&bar[XB_XCNT(b.x)], 1u);
    return b;
}
__device__ __forceinline__ void xcd_barrier_complete(unsigned* bar, unsigned x, unsigned& nloc, unsigned& nx) {
    const unsigned G = gridDim.x * gridDim.y * gridDim.z;
    unsigned sum, cnt, mine, sp = 0u;
    for (;;) {
        sum = 0u; cnt = 0u; mine = 0u;
#pragma unroll
        for (unsigned j = 0; j < 16; ++j) { const unsigned c = xb_ld(&bar[XB_XCNT(j)]); sum += c; cnt += (c > 0u) ? 1u : 0u; mine = (j == x) ? c : mine; }
        if (sum == G) break;
        __builtin_amdgcn_s_sleep(1);
        if ((++sp & 255u) == 0u) { if (xb_ld(&bar[XB_TMO])) break; if (sp > XB_SPIN_CAP) { atomicAdd(&bar[XB_TMO], 1u); break; } }
    }
    nloc = mine > 0u ? mine : 1u; nx = cnt > 0u ? cnt : 1u;
}

__device__ __forceinline__ void xcd_barrier(const XcdBarrier& b) {
    asm volatile("s_waitcnt vmcnt(0)" ::: "memory");
    __syncthreads();
    if (threadIdx.x == 0) {
        unsigned* bar = b.bar;
        __builtin_amdgcn_s_waitcnt(0);
        unsigned nloc = b.st[0], nx = b.st[1];
        if (nloc == 0u) { xcd_barrier_complete(bar, b.x, nloc, nx); b.st[0] = nloc; b.st[1] = nx; }
        const unsigned old = xb_add(&bar[XB_XSUB(b.x)], 1u);
        const unsigned gen = old / nloc;
        if (old + 1u == (gen + 1u) * nloc) {
            __builtin_amdgcn_fence(__ATOMIC_RELEASE, "agent");
            asm volatile("s_waitcnt vmcnt(0)" ::: "memory");
            const unsigned og = xb_add(&bar[XB_TOP], 1u);
            const unsigned tg = og / nx;
            if (og + 1u == (tg + 1u) * nx) xb_add(&bar[XB_TOPGEN], 1u);
            else XB_SPIN(xb_ld(&bar[XB_TOPGEN]) == tg, bar);
            __builtin_amdgcn_fence(__ATOMIC_ACQUIRE, "agent");
            xb_add(&bar[XB_XGEN(b.x)], 1u);
            asm volatile("s_waitcnt vmcnt(0)" ::: "memory");
        } else {
            XB_SPIN(xb_ld(&bar[XB_XGEN(b.x)]) == gen, bar);
            __builtin_amdgcn_fence(__ATOMIC_ACQUIRE, "agent");
            asm volatile("s_waitcnt vmcnt(0)" ::: "memory");
        }
    }
    __syncthreads();
}

#ifndef MK_PER_PHASE
#define MK_PER_PHASE 0
#endif
constexpr int NWAVES = 8, NTHR = 512;
constexpr int DM = 1024, NB = 8, SEQ = 2048, DEPTH = 4, M = NB * SEQ;
constexpr int DIN = 2320, NPROJ = 2304;
constexpr int C_Q = 0, C_K = 512, C_V = 640, C_LX = 768, C_LG = 1024, C_MQ = 1280, C_MK = 1536, C_MV = 1792, C_MO = 2048;
constexpr int NE = 16, CAP = 256, DE = 2048, NSLOT = NB * CAP;
constexpr float EPS = 1e-6f;
constexpr int NPH = 1 + 10 * DEPTH;

constexpr size_t MiB = 1u << 20;
constexpr size_t WS_CTL = 0, CTL_ZERO_BYTES = 1 * MiB;
constexpr size_t WS_ROPE = 1 * MiB;
constexpr size_t WS_LRUW = 2 * MiB;
constexpr size_t WS_WIN = 4 * MiB;
constexpr size_t WS_WOUT = 22 * MiB;
constexpr size_t WS_WGU = 32 * MiB;
constexpr size_t WS_WDN = 544 * MiB;
constexpr size_t WS_H = 800 * MiB;
constexpr size_t WS_PROJ = 832 * MiB;
constexpr size_t WS_Y = 904 * MiB;
constexpr size_t WS_MG = 936 * MiB;
constexpr size_t WS_AFF = 937 * MiB;
constexpr size_t WS_SEL = 938 * MiB;
constexpr size_t WS_IDX = 939 * MiB;
constexpr size_t WS_GATE = WS_IDX + 128 * 1024;
constexpr size_t WS_LH = 940 * MiB;
constexpr size_t WS_CP = 956 * MiB;
constexpr size_t WS_CARRY = 972 * MiB;
constexpr size_t WS_CLOC = 974 * MiB;
constexpr size_t WS_NLOC = 990 * MiB;
constexpr size_t WS_MLOC = WS_NLOC + 512 * 1024;
constexpr size_t WS_XG = 992 * MiB;
constexpr size_t WS_HID = 1056 * MiB;
constexpr size_t WS_YE = 1184 * MiB;
constexpr size_t WS_CPREV = 1280 * MiB;
constexpr size_t WS_NPREV = 1288 * MiB;
constexpr size_t WS_MPREV = WS_NPREV + 512 * 1024;
constexpr size_t WS_XB = 1248 * MiB;
constexpr size_t WS_END = 1290 * MiB;
constexpr int CW_BAR = 4096;

constexpr int RING_OFF = 0, RING_BYTES = 143360;
constexpr int MISC_OFF = RING_BYTES;
constexpr int LDS_BYTES = 147456;

typedef unsigned u32x2 __attribute__((ext_vector_type(2)));
__device__ __forceinline__ float bf2f(unsigned short v) { return __uint_as_float(((unsigned)v) << 16); }
__device__ __forceinline__ float bflo(unsigned v) { return __uint_as_float(v << 16); }
__device__ __forceinline__ float bfhi(unsigned v) { return __uint_as_float(v & 0xffff0000u); }
template <int CTRL> __device__ __forceinline__ float dppf(float v) { return __uint_as_float((unsigned)__builtin_amdgcn_update_dpp(0, (int)__float_as_uint(v), CTRL, 0xF, 0xF, true)); }
__device__ __forceinline__ float row16_sum(float v) { v += dppf<0xB1>(v); v += dppf<0x4E>(v); v += dppf<0x141>(v); v += dppf<0x140>(v); return v; }
__device__ __forceinline__ float xor16_sum(float v) { const auto r = __builtin_amdgcn_permlane16_swap(__float_as_uint(v), __float_as_uint(v), false, false); return __uint_as_float(r[0]) + __uint_as_float(r[1]); }
__device__ __forceinline__ float xor32_sum(float v) { const auto r = __builtin_amdgcn_permlane32_swap(__float_as_uint(v), __float_as_uint(v), false, false); return __uint_as_float(r[0]) + __uint_as_float(r[1]); }
__device__ __forceinline__ float half_sum(float v) { return xor16_sum(row16_sum(v)); }
__device__ __forceinline__ float wave_sum(float v) { return xor32_sum(xor16_sum(row16_sum(v))); }
__device__ __forceinline__ void reduce16(const float (&p)[16], float (&r)[4]) {
    float q[8];
#pragma unroll
    for (int j = 0; j < 8; ++j) { const auto t = __builtin_amdgcn_permlane32_swap(__float_as_uint(p[j]), __float_as_uint(p[j + 8]), false, false); q[j] = __uint_as_float(t[0]) + __uint_as_float(t[1]); }
#pragma unroll
    for (int j = 0; j < 4; ++j) { const auto t = __builtin_amdgcn_permlane16_swap(__float_as_uint(q[j]), __float_as_uint(q[j + 4]), false, false); r[j] = row16_sum(__uint_as_float(t[0]) + __uint_as_float(t[1])); }
}
__device__ __forceinline__ float wave_max(float v) {
#pragma unroll
    for (int o = 1; o < 64; o <<= 1) v = fmaxf(v, __shfl_xor(v, o));
    return v;
}
__device__ __forceinline__ float fexp(float x) { return __builtin_amdgcn_exp2f(1.4426950408889634f * x); }
__device__ __forceinline__ float frcp(float x) { return __builtin_amdgcn_rcpf(x); }
__device__ __forceinline__ float frsq(float x) { return __builtin_amdgcn_rsqf(x); }
__device__ __forceinline__ float sigmoid_f(float x) { return frcp(1.0f + fexp(-x)); }
__device__ __forceinline__ float one_minus_exp(float x) {
    const float p = -x * (1.0f + 0.5f * x * (1.0f + (1.0f / 3.0f) * x * (1.0f + 0.25f * x * (1.0f + 0.2f * x))));
    return (x > -0.25f) ? p : 1.0f - fexp(x); }
__device__ __forceinline__ float logsig_f(float x) { return fminf(x, 0.f) - log1pf(expf(-fabsf(x))); }
__device__ __forceinline__ float gelu_tanh_f(float x) { const float u = 0.7978845608028654f * (x + 0.044715f * x * x * x); return x * (1.0f - frcp(1.0f + fexp(2.0f * u))); }
template <bool MAXOP, bool REV> __device__ __forceinline__ void wave_scan128(const LAS float* in, LAS float* out, int lane) {
    const int j0 = REV ? 127 - 2 * lane : 2 * lane, j1 = REV ? 126 - 2 * lane : 2 * lane + 1;
    const float a = in[j0], b = in[j1];
    const float s1 = MAXOP ? fmaxf(a, b) : a + b;
    float incl = s1;
#pragma unroll
    for (int o = 1; o < 64; o <<= 1) { const float t = __shfl_up(incl, o); if (lane >= o) incl = MAXOP ? fmaxf(incl, t) : incl + t; }
    const float ex = __shfl_up(incl, 1);
    const float e = (lane == 0) ? (MAXOP ? -INFINITY : 0.f) : ex;
    out[j0] = MAXOP ? fmaxf(e, a) : e + a; out[j1] = MAXOP ? fmaxf(e, s1) : e + s1;
}
#define WAVE_LDS_FENCE() asm volatile("s_waitcnt lgkmcnt(0)" ::: "memory")
#define MFMA16(a, b, c) __builtin_amdgcn_mfma_f32_16x16x32_bf16((a), (b), (c), 0, 0, 0)
#define WG_SYNC() __syncthreads()

struct Args { const float* in[22]; float* out; unsigned char* ws; int ph_lo, ph_hi, li, pad; };
enum { I_X = 0, I_N1G, I_WIN, I_QG, I_KG, I_CW, I_CB, I_WA, I_BA, I_WX, I_BX, I_LAM, I_FB, I_MNG, I_AOG, I_LOG, I_WOUT, I_N2G, I_WR, I_WG, I_WU, I_WD };

__device__ __forceinline__ void cvt_item(const float* __restrict__ src, int N, int k0, int n0, bf16* dst, int Kd, LAS float* scr, int lane) {
    { const int r4 = lane >> 4, c4 = lane & 15; f32x4 t[16];
#pragma unroll
      for (int i = 0; i < 16; ++i) t[i] = __builtin_nontemporal_load((const f32x4*)(src + (size_t)(k0 + 4 * i + r4) * N + n0 + 4 * c4));
#pragma unroll
      for (int i = 0; i < 16; ++i) { LAS float* d = scr + (4 * i + r4) * 65 + 4 * c4; d[0] = t[i][0]; d[1] = t[i][1]; d[2] = t[i][2]; d[3] = t[i][3]; } }
    LDS_WAIT(); asm volatile("" ::: "memory");
    const int c = lane >> 3, nn = lane & 7;
#pragma unroll
    for (int j = 0; j < 8; ++j) { const int n = nn + 8 * j; const LAS float* s = scr + (8 * c) * 65 + n;
        v4u o; o.x = pk2(s[0], s[65]); o.y = pk2(s[130], s[195]); o.z = pk2(s[260], s[325]); o.w = pk2(s[390], s[455]);
        *(GAS v4u*)(dst + (size_t)n * Kd + 8 * c) = o; }
    LDS_WAIT(); asm volatile("" ::: "memory");
}
__device__ __forceinline__ void cvt_item8(const float* __restrict__ src, int N, int k0, int n0, unsigned char* dst, int Kd, LAS float* scr, int lane) {
    { const int r8 = lane >> 3, c8 = lane & 7; f32x4 t[16];
#pragma unroll
      for (int i = 0; i < 16; ++i) t[i] = __builtin_nontemporal_load((const f32x4*)(src + (size_t)(k0 + 8 * i + r8) * N + n0 + 4 * c8));
#pragma unroll
      for (int i = 0; i < 16; ++i) { LAS float* d = scr + (8 * i + r8) * 33 + 4 * c8; d[0] = t[i][0]; d[1] = t[i][1]; d[2] = t[i][2]; d[3] = t[i][3]; } }
    LDS_WAIT(); asm volatile("" ::: "memory");
    const int c = lane >> 3, nn = lane & 7; constexpr float sc = pg8::WSCALE;
#pragma unroll
    for (int j = 0; j < 4; ++j) { const int n = nn + 8 * j; const LAS float* s = scr + (16 * c) * 33 + n;
        v4u o; o.x = pg8::pk4_fp8(s[0] * sc, s[33] * sc, s[66] * sc, s[99] * sc); o.y = pg8::pk4_fp8(s[132] * sc, s[165] * sc, s[198] * sc, s[231] * sc);
        o.z = pg8::pk4_fp8(s[264] * sc, s[297] * sc, s[330] * sc, s[363] * sc); o.w = pg8::pk4_fp8(s[396] * sc, s[429] * sc, s[462] * sc, s[495] * sc);
        *(GAS v4u*)(dst + (size_t)n * Kd + 16 * c) = o; }
    LDS_WAIT(); asm volatile("" ::: "memory");
}
__device__ __forceinline__ void p0_weights(const Args& a, LAS unsigned char* lds, int tid, int lane, int wave, int G, int bid) {
    unsigned char* ws = a.ws;
    LAS float* scr = (LAS float*)(lds + RING_OFF + wave * 16896);
    const int gw = bid * NWAVES + wave, NGW = G * NWAVES;
    constexpr int I_IN = 16 * 36, I_OUT = 16 * 16, I_EXP = 1536, PER_LAYER = I_IN + I_OUT + NE * I_EXP, NITEMS = DEPTH * PER_LAYER;
    for (int it = gw; it < NITEMS; it += NGW) {
        const int l = it / PER_LAYER; int r = it - l * PER_LAYER;
        if (r < I_IN) { const int kb = r / 36, nb = r - kb * 36;
            cvt_item(a.in[I_WIN] + (size_t)l * DM * DIN, DIN, 64 * kb, 64 * nb, (bf16*)(ws + WS_WIN) + ((size_t)l * NPROJ + 64 * nb) * DM + 64 * kb, DM, scr, lane); continue; }
        r -= I_IN;
        if (r < I_OUT) { const int kb = r >> 4, nb = r & 15;
            cvt_item(a.in[I_WOUT] + (size_t)l * DM * DM, DM, 64 * kb, 64 * nb, (bf16*)(ws + WS_WOUT) + ((size_t)l * DM + 64 * nb) * DM + 64 * kb, DM, scr, lane); continue; }
        r -= I_OUT;
        const int e = r / I_EXP; int r2 = r - e * I_EXP; const size_t le = (size_t)l * NE + e;
        LAS float* scr8 = (LAS float*)(lds + RING_OFF + wave * 16896);
        if (r2 < 1024) { const int up = r2 >> 9; r2 &= 511; const int kb = r2 >> 6, nb = r2 & 63, n0 = 32 * nb, drow = 256 * (n0 >> 7) + (n0 & 127) + 128 * up;
            cvt_item8(a.in[up ? I_WU : I_WG] + le * DM * DE, DE, 128 * kb, n0, ws + WS_WGU + (le * 4096 + drow) * DM + 128 * kb, DM, scr8, lane); continue; }
        r2 -= 1024; { const int kb = r2 >> 5, nb = r2 & 31;
            cvt_item8(a.in[I_WD] + le * DE * DM, DM, 128 * kb, 32 * nb, ws + WS_WDN + (le * DM + 32 * nb) * DE + 128 * kb, DE, scr8, lane); }
    }
    const int gt = bid * NTHR + tid, GT = G * NTHR;
    bf16* lw = (bf16*)(ws + WS_LRUW);
    for (int i = gt; i < DEPTH * 2 * 2 * 4 * 4096; i += GT) { const int d = i & 63, e = (i >> 6) & 63, n = (i >> 12) & 3, gate = (i >> 14) & 1, dir = (i >> 15) & 1, l = i >> 16;
        const float* src = a.in[gate ? I_WX : I_WA]; lw[i] = (bf16)f2bf(src[((((size_t)l * 2 + dir) * 4 + n) * 64 + d) * 64 + e]); }
    float* rc = (float*)(ws + WS_ROPE); float* rs = rc + SEQ * 32;
    for (int i = gt; i < SEQ * 32; i += GT) { const int s = i >> 5, j = i & 31, f = j & 15; const float pos = (float)((j < 16) ? (s >> 6) : (s & 63));
        const float inv = 1.0f / powf(10000.0f, (float)f * (1.0f / 16.0f)); const float ang = pos * inv; rc[i] = cosf(ang); rs[i] = sinf(ang); }
}

__device__ __forceinline__ void stage_w16(const float* WT, int sk, LAS unsigned char* lds, int tid) {
    constexpr int WLS = 1028; LAS float* wl = (LAS float*)(lds + RING_OFF); float wv[32];
#pragma unroll
    for (int q = 0; q < 32; ++q) { const int i = tid + q * NTHR; wv[q] = WT[(size_t)(i >> 4) * sk + (i & 15)]; }
#pragma unroll
    for (int q = 0; q < 32; ++q) { const int i = tid + q * NTHR; wl[(i & 15) * WLS + (i >> 4)] = wv[q]; }
}
template <int MODE, bool XB16, bool PRESTAGED = false>
__device__ __forceinline__ void row_pass(const void* xin_, void* xout_, const float* gain, const float* WT  , int sk, bf16* H, float* O16, const int* SEL, const bf16* YE,
                                         LAS unsigned char* lds, int tid, int lane, int wave, int G, int bid) {
    constexpr int WLS = 1028;
    LAS float* wl = (LAS float*)(lds + RING_OFF);
    if (MODE != 3 && !(PRESTAGED && !MK_PER_PHASE)) stage_w16(WT, sk, lds, tid);
    WG_SYNC();
    const int gw = bid * NWAVES + wave, NGW = G * NWAVES;
    f32x4 gq4[4];
#pragma unroll
    for (int j = 0; j < 4; ++j) gq4[j] = (MODE != 3) ? *((const f32x4*)gain + 64 * j + lane) : (f32x4){0.f, 0.f, 0.f, 0.f};
    constexpr int R = 4;
    for (int m0 = R * gw; m0 < M; m0 += R * NGW) {
        asm volatile("" ::: "memory");
        f32x4 v[R][4];
#pragma unroll
        for (int r = 0; r < R; ++r)
#pragma unroll
            for (int j = 0; j < 4; ++j) {
                if (XB16) { const u32x2 q = *((const u32x2*)((const bf16*)xin_ + (size_t)(m0 + r) * DM) + 64 * j + lane); v[r][j] = (f32x4){bflo(q.x), bfhi(q.x), bflo(q.y), bfhi(q.y)}; }
                else v[r][j] = *((const f32x4*)((const float*)xin_ + (size_t)(m0 + r) * DM) + 64 * j + lane); }
        if (MODE >= 2) {
            const int b = m0 >> 11; int selv[R]; unsigned long long mk[R];
#pragma unroll
            for (int r = 0; r < R; ++r) { selv[r] = (lane < NE) ? SEL[(size_t)(m0 + r) * NE + lane] : -1; }
#pragma unroll
            for (int r = 0; r < R; ++r) mk[r] = __ballot(selv[r] >= 0);
            while (mk[0] | mk[1] | mk[2] | mk[3]) {
                u32x2 q[R][2][4]; float wt[R][2];
#pragma unroll
                for (int r = 0; r < R; ++r)
#pragma unroll
                    for (int i = 0; i < 2; ++i) { const bf16* yr = YE; wt[r][i] = 0.f;
                        if (mk[r]) { const int e = __builtin_ctzll(mk[r]); mk[r] &= mk[r] - 1ull; const int sl = __builtin_amdgcn_readlane(selv[r], e);
                            yr = YE + ((size_t)e * NSLOT + b * CAP + sl) * DM; wt[r][i] = 1.f; }
#pragma unroll
                        for (int j = 0; j < 4; ++j) q[r][i][j] = *((const u32x2*)yr + 64 * j + lane); }
#pragma unroll
                for (int r = 0; r < R; ++r)
#pragma unroll
                    for (int i = 0; i < 2; ++i)
#pragma unroll
                        for (int j = 0; j < 4; ++j) { const u32x2 w = q[r][i][j]; const float t = wt[r][i];
                            v[r][j][0] += t * bflo(w.x); v[r][j][1] += t * bfhi(w.x); v[r][j][2] += t * bflo(w.y); v[r][j][3] += t * bfhi(w.y); }
            }
#pragma unroll
            for (int r = 0; r < R; ++r)
#pragma unroll
                for (int j = 0; j < 4; ++j) {
                    if (MODE == 3) *((f32x4*)((float*)xout_ + (size_t)(m0 + r) * DM) + 64 * j + lane) = v[r][j];
                    else { u32x2 o; o.x = pk2(v[r][j][0], v[r][j][1]); o.y = pk2(v[r][j][2], v[r][j][3]); *((u32x2*)((bf16*)xout_ + (size_t)(m0 + r) * DM) + 64 * j + lane) = o;
                        v[r][j] = (f32x4){bflo(o.x), bfhi(o.x), bflo(o.y), bfhi(o.y)}; } }
        }
        if (MODE == 3) continue;
        float ss[R];
#pragma unroll
        for (int r = 0; r < R; ++r) { float a = 0.f;
#pragma unroll
            for (int j = 0; j < 4; ++j) a += (v[r][j][0] * v[r][j][0] + v[r][j][1] * v[r][j][1]) + (v[r][j][2] * v[r][j][2] + v[r][j][3] * v[r][j][3]);
            ss[r] = wave_sum(a); }
#pragma unroll
        for (int r = 0; r < R; ++r) { const float rstd = frsq(ss[r] * (1.0f / DM) + EPS);
#pragma unroll
            for (int j = 0; j < 4; ++j) { v[r][j] = v[r][j] * rstd * gq4[j];
                if (MODE == 1) { *((unsigned*)((unsigned char*)H + (size_t)(m0 + r) * DM) + 64 * j + lane) = pg8::pk4_fp8(v[r][j][0], v[r][j][1], v[r][j][2], v[r][j][3]); }
                else { u32x2 o; o.x = pk2(v[r][j][0], v[r][j][1]); o.y = pk2(v[r][j][2], v[r][j][3]); *((u32x2*)(H + (size_t)(m0 + r) * DM) + 64 * j + lane) = o; } } }
        typedef float f32x2_ __attribute__((ext_vector_type(2)));
        float t4[R][4];
#pragma unroll
        for (int j4 = 0; j4 < 4; ++j4) { float pp[4][R];
#pragma unroll
            for (int h = 0; h < 4; ++h) { const int jj = j4 + 4 * h; f32x2_ a2[R];
#pragma unroll
                for (int r = 0; r < R; ++r) a2[r] = (f32x2_){0.f, 0.f};
#pragma unroll
                for (int j = 0; j < 4; ++j) { const f32x4 w = *((LAS f32x4*)(wl + jj * WLS) + 64 * j + lane); const f32x2_ wlo = (f32x2_){w[0], w[1]}, whi = (f32x2_){w[2], w[3]};
#pragma unroll
                    for (int r = 0; r < R; ++r) { a2[r] += (f32x2_){v[r][j][0], v[r][j][1]} * wlo; a2[r] += (f32x2_){v[r][j][2], v[r][j][3]} * whi; } }
#pragma unroll
                for (int r = 0; r < R; ++r) pp[h][r] = a2[r][0] + a2[r][1]; }
#pragma unroll
            for (int r = 0; r < R; ++r) {
                const auto ta = __builtin_amdgcn_permlane32_swap(__float_as_uint(pp[0][r]), __float_as_uint(pp[2][r]), false, false); const float qa = __uint_as_float(ta[0]) + __uint_as_float(ta[1]);
                const auto tb = __builtin_amdgcn_permlane32_swap(__float_as_uint(pp[1][r]), __float_as_uint(pp[3][r]), false, false); const float qb = __uint_as_float(tb[0]) + __uint_as_float(tb[1]);
                const auto tc = __builtin_amdgcn_permlane16_swap(__float_as_uint(qa), __float_as_uint(qb), false, false); t4[r][j4] = row16_sum(__uint_as_float(tc[0]) + __uint_as_float(tc[1])); }
            __builtin_amdgcn_sched_barrier(0); }
#pragma unroll
        for (int r = 0; r < R; ++r) { const int m = m0 + r;
            const int li = lane & 15, rho = lane >> 4, jj = (li & 3) + 4 * (rho & 1) + 8 * (rho >> 1);
            if (MODE == 1) {
                const float lm = fmaxf(fmaxf(t4[r][0], t4[r][1]), fmaxf(t4[r][2], t4[r][3]));
                const auto ta = __builtin_amdgcn_permlane16_swap(__float_as_uint(lm), __float_as_uint(lm), false, false); const float m1 = fmaxf(__uint_as_float(ta[0]), __uint_as_float(ta[1]));
                const auto tb = __builtin_amdgcn_permlane32_swap(__float_as_uint(m1), __float_as_uint(m1), false, false); const float mx = fmaxf(__uint_as_float(tb[0]), __uint_as_float(tb[1]));
                const float e0 = fexp(t4[r][0] - mx), e1 = fexp(t4[r][1] - mx), e2 = fexp(t4[r][2] - mx), e3 = fexp(t4[r][3] - mx);
                const float sum = xor32_sum(xor16_sum((e0 + e1) + (e2 + e3)));
                const float mine = (li & 3) == 0 ? e0 : (li & 3) == 1 ? e1 : (li & 3) == 2 ? e2 : e3;
                if (li < 4) O16[(((size_t)(m >> 11) * NE + jj) << 11) + (m & 2047)] = mine / sum;
            } else {
#pragma unroll
                for (int j = 0; j < 4; ++j) if (li == j) O16[(size_t)m * 16 + jj] = t4[r][j];
            } }
    }
}

__device__ __forceinline__ void rope_pass(const Args& a, int l, int lane, int wave, int G, int bid, bf16* DST) {
    const bf16* PROJ = (const bf16*)(a.ws + WS_PROJ); const float* rc = (const float*)(a.ws + WS_ROPE); const float* rs = rc + SEQ * 32;
    const float* qg = a.in[I_QG] + l * 64; const float* kg = a.in[I_KG] + l * 64;
    const int gw = bid * NWAVES + wave, NGW = G * NWAVES, hslot = lane >> 3, l8 = lane & 7;
    const f32x4 gq1 = *(const f32x4*)(qg + 4 * l8) * attn_body::C2, gq2 = *(const f32x4*)(qg + 32 + 4 * l8) * attn_body::C2;
    const f32x4 gk1 = *(const f32x4*)(kg + 4 * l8), gk2 = *(const f32x4*)(kg + 32 + 4 * l8);
    for (int mb = 4 * gw; mb < M; mb += 4 * NGW) {
        u32x2 xa[5], xb[5]; f32x4 cs[5], sn[5];
#pragma unroll
        for (int it = 0; it < 5; ++it) { const int hh = 8 * it + hslot, tok = (hh * 205) >> 11, head = hh - 10 * tok; const size_t m = (size_t)(mb + tok); const int s = (int)(m & 2047);
            const bf16* row = PROJ + m * NPROJ + head * 64 + 4 * l8; xa[it] = *(const u32x2*)row; xb[it] = *(const u32x2*)(row + 32);
            cs[it] = *(const f32x4*)(rc + s * 32 + 4 * l8); sn[it] = *(const f32x4*)(rs + s * 32 + 4 * l8); }
#pragma unroll
        for (int it = 0; it < 5; ++it) { const int hh = 8 * it + hslot, tok = (hh * 205) >> 11, head = hh - 10 * tok; const size_t m = (size_t)(mb + tok);
            const f32x4 x1 = (f32x4){bflo(xa[it].x), bfhi(xa[it].x), bflo(xa[it].y), bfhi(xa[it].y)}, x2 = (f32x4){bflo(xb[it].x), bfhi(xb[it].x), bflo(xb[it].y), bfhi(xb[it].y)};
            float ss = ((x1[0] * x1[0] + x1[1] * x1[1]) + (x1[2] * x1[2] + x1[3] * x1[3])) + ((x2[0] * x2[0] + x2[1] * x2[1]) + (x2[2] * x2[2] + x2[3] * x2[3]));
            ss += dppf<0xB1>(ss); ss += dppf<0x4E>(ss); ss += dppf<0x141>(ss);
            const float rstd = frsq(ss * (1.0f / 64.0f) + EPS);
            const bool isk = head >= 8; const f32x4 g1 = isk ? gk1 : gq1, g2 = isk ? gk2 : gq2;
            const f32x4 n1 = x1 * rstd * g1, n2 = x2 * rstd * g2;
            const f32x4 o1 = n1 * cs[it] - n2 * sn[it], o2 = n2 * cs[it] + n1 * sn[it];
            bf16* orow = DST + m * NPROJ + head * 64 + 4 * l8;
            u32x2 w1, w2; w1.x = pk2(o1[0], o1[1]); w1.y = pk2(o1[2], o1[3]); w2.x = pk2(o2[0], o2[1]); w2.y = pk2(o2[2], o2[3]);
            *(u32x2*)orow = w1; *(u32x2*)(orow + 32) = w2; }
    }
}

constexpr int XS = 260;
constexpr int XSB = 264;
__device__ __forceinline__ void lru_a_unit(const Args& a, int l, int unit, LAS unsigned char* lds, int tid, int lane, int wave) {
    const int b = unit >> 6, c32 = unit & 63, t0 = c32 * 32; const size_t m0 = (size_t)b * SEQ + t0;
    LAS bf16* XCb = (LAS bf16*)(lds + RING_OFF);
    LAS float* AA = (LAS float*)(lds + RING_OFF + 32 * XSB * 2);
    LAS bf16* UUb = (LAS bf16*)(AA + 2 * 32 * XS);
    const bf16* PROJ = (const bf16*)(a.ws + WS_PROJ);
    const int n = wave >> 1, hh = wave & 1, li = lane & 15, g = lane >> 4;
    bf16x8 wfr[2][2][2][2];
#pragma unroll
    for (int dir = 0; dir < 2; ++dir)
#pragma unroll
        for (int gate = 0; gate < 2; ++gate) { const bf16* W = (const bf16*)(a.ws + WS_LRUW) + ((((size_t)l * 2 + dir) * 2 + gate) * 4 + n) * 4096;
#pragma unroll
            for (int nt = 0; nt < 2; ++nt)
#pragma unroll
                for (int ks = 0; ks < 2; ++ks) wfr[dir][gate][nt][ks] = *(const bf16x8*)(W + (32 * hh + 16 * nt + li) * 64 + 32 * ks + 8 * g); }
    float bav[2][2], bxv[2][2], lamv[2][2];
#pragma unroll
    for (int dir = 0; dir < 2; ++dir)
#pragma unroll
        for (int nt = 0; nt < 2; ++nt) { const size_t pi = ((size_t)l * 2 + dir) * 256 + 64 * n + 32 * hh + 16 * nt + li; bav[dir][nt] = a.in[I_BA][pi]; bxv[dir][nt] = a.in[I_BX][pi]; lamv[dir][nt] = a.in[I_LAM][pi]; }
    {
        const int ch2 = tid & 127, rg = tid >> 7, ch = 2 * ch2;
        float x0[11], x1[11];
#pragma unroll
        for (int i = 0; i < 11; ++i) { const int s = t0 + rg * 8 - 2 + i; unsigned v = 0u;
            if (s >= 0 && s < SEQ) v = *(const unsigned*)(PROJ + ((size_t)b * SEQ + s) * NPROJ + C_LX + ch);
            x0[i] = bflo(v); x1[i] = bfhi(v); }
        const float* cw = a.in[I_CW] + (size_t)l * 4 * 256; const float* cb = a.in[I_CB] + (size_t)l * 256;
        float w0[4], w1[4];
#pragma unroll
        for (int j = 0; j < 4; ++j) { w0[j] = cw[j * 256 + ch]; w1[j] = cw[j * 256 + ch + 1]; }
        const float b0 = cb[ch], b1 = cb[ch + 1];
#pragma unroll
        for (int r = 0; r < 8; ++r) { float y0 = b0, y1 = b1;
#pragma unroll
            for (int j = 0; j < 4; ++j) { y0 += x0[r + j] * w0[j]; y1 += x1[r + j] * w1[j]; }
            *(LAS unsigned*)(XCb + (rg * 8 + r) * XSB + ch) = pk2(y0, y1); }
    }
    WG_SYNC();
    bf16x8 af[2][2];
#pragma unroll
    for (int mt = 0; mt < 2; ++mt)
#pragma unroll
        for (int ks = 0; ks < 2; ++ks) af[mt][ks] = *(const LAS bf16x8*)(XCb + (16 * mt + li) * XSB + 64 * n + 32 * ks + 8 * g);
#pragma unroll
    for (int dir = 0; dir < 2; ++dir) {
        f32x4 accA[2][2], accX[2][2];
#pragma unroll
        for (int i = 0; i < 2; ++i)
#pragma unroll
            for (int j = 0; j < 2; ++j) { accA[i][j] = (f32x4){0.f, 0.f, 0.f, 0.f}; accX[i][j] = (f32x4){0.f, 0.f, 0.f, 0.f}; }
#pragma unroll
        for (int ks = 0; ks < 2; ++ks)
#pragma unroll
            for (int nt = 0; nt < 2; ++nt)
#pragma unroll
                for (int mt = 0; mt < 2; ++mt) { accA[mt][nt] = MFMA16(af[mt][ks], wfr[dir][0][nt][ks], accA[mt][nt]); accX[mt][nt] = MFMA16(af[mt][ks], wfr[dir][1][nt][ks], accX[mt][nt]); }
#pragma unroll
        for (int nt = 0; nt < 2; ++nt) { const int ch = 64 * n + 32 * hh + 16 * nt + li; const float lam = lamv[dir][nt];
            const float ex_ = fexp(-fabsf(lam)); const float l1p = (ex_ < 0.25f) ? ex_ * (1.0f - ex_ * (0.5f - ex_ * ((1.0f / 3.0f) - 0.25f * ex_))) : log1pf(ex_);
            const float sp = fmaxf(-lam, 0.f) + l1p;
            const float k8 = -8.0f * sp;
#pragma unroll
            for (int mt = 0; mt < 2; ++mt) {
                constexpr float L2E = 1.4426950408889634f;
                const f32x4 za = (accA[mt][nt] + bav[dir][nt]) * (-L2E), zx = (accX[mt][nt] + bxv[dir][nt]) * (-L2E);
                f32x4 ea, ex;
#pragma unroll
                for (int r = 0; r < 4; ++r) { ea[r] = __builtin_amdgcn_exp2f(za[r]); ex[r] = __builtin_amdgcn_exp2f(zx[r]); }
                ea = ea + 1.0f; ex = ex + 1.0f;
                f32x4 rg_, ig_;
#pragma unroll
                for (int r = 0; r < 4; ++r) { rg_[r] = __builtin_amdgcn_rcpf(ea[r]); ig_[r] = __builtin_amdgcn_rcpf(ex[r]); }
                const f32x4 la = rg_ * k8, lal = la * L2E, x2 = la * 2.0f;
                f32x4 av, om;
#pragma unroll
                for (int r = 0; r < 4; ++r) av[r] = __builtin_amdgcn_exp2f(lal[r]);
                const f32x4 ser = -x2 * (1.0f + 0.5f * x2 * (1.0f + (1.0f / 3.0f) * x2 * (1.0f + 0.25f * x2)));
#pragma unroll
                for (int r = 0; r < 4; ++r) om[r] = (x2[r] > -0.25f) ? ser[r] : 1.0f - av[r] * av[r];
                f32x4 xc4, sq;
#pragma unroll
                for (int r = 0; r < 4; ++r) { xc4[r] = bf2f(XCb[(16 * mt + 4 * g + r) * XSB + ch]); sq[r] = __builtin_amdgcn_sqrtf(om[r]); }
                const f32x4 uv = sq * (ig_ * xc4);
#pragma unroll
                for (int r = 0; r < 4; ++r) { const int t = 16 * mt + 4 * g + r; AA[(dir * 32 + t) * XS + ch] = av[r]; UUb[(dir * 32 + t) * XSB + ch] = (bf16)f2bf(uv[r]); } } }
    }
    WG_SYNC();
    { const int dir = tid >> 8, ch = tid & 255; float h = 0.f, cp = 1.f;
      bf16* lh = (bf16*)(a.ws + WS_LH) + ((size_t)dir * M + m0) * 256 + ch; bf16* cpo = (bf16*)(a.ws + WS_CP) + ((size_t)dir * M + m0) * 256 + ch;
      float av[32], uv[32];
#pragma unroll
      for (int q = 0; q < 32; ++q) { av[q] = AA[(dir * 32 + q) * XS + ch]; uv[q] = bf2f(UUb[(dir * 32 + q) * XSB + ch]); }
      if (dir == 0) {
#pragma unroll
          for (int q = 0; q < 32; ++q) { h = av[q] * h + uv[q]; cp *= av[q]; lh[(size_t)q * 256] = (bf16)f2bf(h); cpo[(size_t)q * 256] = (bf16)f2bf(cp); }
      } else {
#pragma unroll
          for (int q = 31; q >= 0; --q) { h = av[q] * h + uv[q]; cp *= av[q]; lh[(size_t)q * 256] = (bf16)f2bf(h); cpo[(size_t)q * 256] = (bf16)f2bf(cp); }
      }
      float* cr = (float*)(a.ws + WS_CARRY) + ((((size_t)dir * NB + b) * 64 + c32) * 2) * 256 + ch; cr[0] = cp; cr[256] = h; }
    WG_SYNC();
}

__device__ __forceinline__ void p4_rows_unit(const Args& a, int l, int unit, LAS unsigned char* lds, int tid, int lane, int wave) {
    const int b = unit >> 5, c0 = 2 * (unit & 31); const size_t m0 = (size_t)b * SEQ + c0 * 32;
    LAS float* CIN = (LAS float*)(lds + RING_OFF);
    const float* CARRY = (const float*)(a.ws + WS_CARRY);
    { const int dir = tid >> 8, ch = tid & 255; const float* cr = CARRY + (((size_t)dir * NB + b) * 64) * 512 + ch; float cin = 0.f;
      const int cs = dir ? c0 + 1 : c0;
      const int n = dir ? 63 - cs : cs;
      for (int base = 0; base < n; base += 16) { float P[16], Hh[16];
#pragma unroll
          for (int i = 0; i < 16; ++i) { const int q = base + i; const bool v = q < n; const int k = v ? (dir ? 63 - q : q) : cs;
              const float p = cr[(size_t)k * 512], h = cr[(size_t)k * 512 + 256]; P[i] = v ? p : 1.f; Hh[i] = v ? h : 0.f; }
#pragma unroll
          for (int i = 0; i < 16; ++i) cin = P[i] * cin + Hh[i]; }
      const float cin2 = cr[(size_t)cs * 512] * cin + cr[(size_t)cs * 512 + 256];
      CIN[((cs - c0) * 2 + dir) * 256 + ch] = cin; CIN[((1 - (cs - c0)) * 2 + dir) * 256 + ch] = cin2; }
    WG_SYNC();
    const bf16* LH = (const bf16*)(a.ws + WS_LH); const bf16* CPb = (const bf16*)(a.ws + WS_CP); const bf16* PROJ = (const bf16*)(a.ws + WS_PROJ); bf16* Y = (bf16*)(a.ws + WS_Y);
    const f32x4 og = *(const f32x4*)(a.in[I_LOG] + (size_t)l * 256 + 4 * lane);
    const float* gq = a.in[I_AOG] + (size_t)l * 512 + 8 * lane; const f32x4 g0 = *(const f32x4*)gq, g1 = *(const f32x4*)(gq + 4);
#pragma unroll
    for (int it = 0; it < 2; ++it) { const int tl = wave * 8 + it * 4;
        const LAS float* ci = CIN + (tl >> 5) * 512; const f32x4 cf = *(const LAS f32x4*)(ci + 4 * lane), cb = *(const LAS f32x4*)(ci + 256 + 4 * lane);
        v4u ya[4]; u32x2 lf[4], pf[4], lb[4], pb[4], gt[4];
#pragma unroll
        for (int r = 0; r < 4; ++r) { const size_t m = m0 + tl + r;
            ya[r] = *(const v4u*)(Y + m * DM + 8 * lane);
            lf[r] = *(const u32x2*)(LH + m * 256 + 4 * lane); pf[r] = *(const u32x2*)(CPb + m * 256 + 4 * lane);
            lb[r] = *(const u32x2*)(LH + ((size_t)M + m) * 256 + 4 * lane); pb[r] = *(const u32x2*)(CPb + ((size_t)M + m) * 256 + 4 * lane);
            gt[r] = *(const u32x2*)(PROJ + m * NPROJ + C_LG + 4 * lane); }
#pragma unroll
        for (int r = 0; r < 4; ++r) { const size_t m = m0 + tl + r;
            {
                const float x[8] = {bflo(ya[r].x), bfhi(ya[r].x), bflo(ya[r].y), bfhi(ya[r].y), bflo(ya[r].z), bfhi(ya[r].z), bflo(ya[r].w), bfhi(ya[r].w)}; float ss = 0.f;
#pragma unroll
                for (int i = 0; i < 8; ++i) ss += x[i] * x[i];
                const float rstd = frsq(wave_sum(ss) * (1.0f / 512.0f) + EPS);
                v4u o; o.x = pk2(x[0] * rstd * g0[0], x[1] * rstd * g0[1]); o.y = pk2(x[2] * rstd * g0[2], x[3] * rstd * g0[3]);
                o.z = pk2(x[4] * rstd * g1[0], x[5] * rstd * g1[1]); o.w = pk2(x[6] * rstd * g1[2], x[7] * rstd * g1[3]); *(v4u*)(Y + m * DM + 8 * lane) = o; }
            {
                f32x4 h;
                h[0] = (bflo(lf[r].x) + bflo(pf[r].x) * cf[0]) + (bflo(lb[r].x) + bflo(pb[r].x) * cb[0]);
                h[1] = (bfhi(lf[r].x) + bfhi(pf[r].x) * cf[1]) + (bfhi(lb[r].x) + bfhi(pb[r].x) * cb[1]);
                h[2] = (bflo(lf[r].y) + bflo(pf[r].y) * cf[2]) + (bflo(lb[r].y) + bflo(pb[r].y) * cb[2]);
                h[3] = (bfhi(lf[r].y) + bfhi(pf[r].y) * cf[3]) + (bfhi(lb[r].y) + bfhi(pb[r].y) * cb[3]);
                h[0] *= gelu_tanh_f(bflo(gt[r].x)); h[1] *= gelu_tanh_f(bfhi(gt[r].x)); h[2] *= gelu_tanh_f(bflo(gt[r].y)); h[3] *= gelu_tanh_f(bfhi(gt[r].y));
                const float ss = wave_sum((h[0] * h[0] + h[1] * h[1]) + (h[2] * h[2] + h[3] * h[3]));
                const float rstd = frsq(ss * (1.0f / 256.0f) + EPS);
                u32x2 o; o.x = pk2(h[0] * rstd * og[0], h[1] * rstd * og[1]); o.y = pk2(h[2] * rstd * og[2], h[3] * rstd * og[3]);
                *(u32x2*)(Y + m * DM + 512 + 4 * lane) = o; } } }
    WG_SYNC();
}

struct MlsGateRaw { float i_f, f_f, i_b, f_b; };
__device__ __forceinline__ MlsGateRaw mls_gates_load(const Args& a, int l, size_t m0, int hd, int tid) {
    MlsGateRaw r{0.f, 0.f, 0.f, 0.f};
    if (tid < 128) { const float* p = (const float*)(a.ws + WS_MG) + (m0 + tid) * 16; const float* fb = a.in[I_FB] + (size_t)l * 8;
        r.i_f = p[hd]; r.f_f = p[4 + hd] + fb[hd]; r.i_b = p[8 + hd]; r.f_b = p[12 + hd] + fb[4 + hd]; }
    return r;
}
__device__ __forceinline__ void mls_gates_store(const MlsGateRaw& r, LAS float* GL, int tid) {
    if (tid < 128) { GL[tid] = logsig_f(r.f_f); GL[128 + tid] = logsig_f(r.f_b); GL[256 + tid] = r.i_f; GL[384 + tid] = r.i_b; }
}
__device__ __forceinline__ void mls_gates_scan(LAS float* GL, int wave, int lane) {
    if (wave == 0) wave_scan128<false, false>(GL, GL + 512, lane);
    else if (wave == 1) wave_scan128<false, true>(GL + 128, GL + 640, lane);
}
constexpr int TS = 136;
constexpr int QS_ = 72;

__device__ __forceinline__ void mls_a_unit(const Args& a, int l, int unit, LAS unsigned char* lds, int tid, int lane, int wave) {
    const int c = unit & 15, hd = (unit >> 4) & 3, b = unit >> 6; const size_t m0 = (size_t)b * SEQ + c * 128;
    LAS float* GL = (LAS float*)(lds + RING_OFF);
    LAS float* WW = GL + 768;
    LAS bf16* VT = (LAS bf16*)(lds + RING_OFF + 4096); LAS bf16* KF = VT + 64 * TS; LAS bf16* KB = KF + 64 * TS;
    const MlsGateRaw graw = mls_gates_load(a, l, m0, hd, tid);
    const int j = tid & 127, part = tid >> 7; const bf16* PROJ = (const bf16*)(a.ws + WS_PROJ);
    const bf16* kp = PROJ + (m0 + j) * NPROJ + C_MK + hd * 64 + 16 * part; const bf16* vp = PROJ + (m0 + j) * NPROJ + C_MV + hd * 64 + 16 * part;
    const v4u k0 = *(const v4u*)kp, k1 = *(const v4u*)(kp + 8), v0 = *(const v4u*)vp, v1 = *(const v4u*)(vp + 8);
    mls_gates_store(graw, GL, tid);
    WG_SYNC();
    float* MLOC = (float*)(a.ws + WS_MLOC); float* NLOC = (float*)(a.ws + WS_NLOC); float* CLOC = (float*)(a.ws + WS_CLOC);
    const size_t sbase = ((size_t)b * 4 + hd) * 2;
    mls_gates_scan(GL, wave, lane);
    if (wave < 2) { WAVE_LDS_FENCE(); const int dir = wave; const float gtot = dir ? GL[640] : GL[512 + 127]; const LAS float* Bc = GL + 512 + 128 * dir; const LAS float* IG = GL + 256 + 128 * dir;
        const float lw0 = gtot - Bc[lane] + IG[lane], lw1 = gtot - Bc[lane + 64] + IG[lane + 64];
        const float mx = wave_max(fmaxf(lw0, lw1));
        WW[dir * 128 + lane] = fexp(lw0 - mx); WW[dir * 128 + lane + 64] = fexp(lw1 - mx);
        if (lane == 0) { float* o = MLOC + ((sbase + dir) * 16 + c) * 2; o[0] = mx; o[1] = gtot; } }
    WG_SYNC();
    { const float wf = WW[j] * 0.125f, wb = WW[128 + j] * 0.125f;
      const unsigned kk[8] = {k0.x, k0.y, k0.z, k0.w, k1.x, k1.y, k1.z, k1.w}; const unsigned vv[8] = {v0.x, v0.y, v0.z, v0.w, v1.x, v1.y, v1.z, v1.w};
#pragma unroll
      for (int q = 0; q < 8; ++q) { const int e0 = 16 * part + 2 * q; const float ka = bflo(kk[q]), kb = bfhi(kk[q]);
          KF[e0 * TS + j] = (bf16)f2bf(ka * wf); KF[(e0 + 1) * TS + j] = (bf16)f2bf(kb * wf);
          KB[e0 * TS + j] = (bf16)f2bf(ka * wb); KB[(e0 + 1) * TS + j] = (bf16)f2bf(kb * wb);
          VT[e0 * TS + j] = (bf16)(vv[q] & 0xffffu); VT[(e0 + 1) * TS + j] = (bf16)(vv[q] >> 16); } }
    WG_SYNC();
    if (tid < 128) { const int dir = tid >> 6, e = tid & 63; const LAS bf16* kr = (dir ? KB : KF) + e * TS; float s = 0.f;
#pragma unroll
        for (int q = 0; q < 16; ++q) { const v4u w = *(const LAS v4u*)(kr + 8 * q); s += ((bflo(w.x) + bfhi(w.x)) + (bflo(w.y) + bfhi(w.y))) + ((bflo(w.z) + bfhi(w.z)) + (bflo(w.w) + bfhi(w.w))); }
        NLOC[((sbase + dir) * 16 + c) * 64 + e] = s; }
    { const int dir = wave >> 2, mt = wave & 3, li = lane & 15, g = lane >> 4; const LAS bf16* KD = dir ? KB : KF;
      f32x4 acc[4];
#pragma unroll
      for (int nt = 0; nt < 4; ++nt) acc[nt] = (f32x4){0.f, 0.f, 0.f, 0.f};
#pragma unroll
      for (int ks = 0; ks < 4; ++ks) { const bf16x8 af = *(const LAS bf16x8*)(VT + (16 * mt + li) * TS + 32 * ks + 8 * g);
#pragma unroll
          for (int nt = 0; nt < 4; ++nt) { const bf16x8 bfv = *(const LAS bf16x8*)(KD + (16 * nt + li) * TS + 32 * ks + 8 * g); acc[nt] = MFMA16(af, bfv, acc[nt]); } }
      float* co = CLOC + ((sbase + dir) * 16 + c) * 4096;
#pragma unroll
      for (int nt = 0; nt < 4; ++nt)
#pragma unroll
          for (int r = 0; r < 4; ++r) co[(16 * mt + 4 * g + r) * 64 + 16 * nt + li] = acc[nt][r]; }
    WG_SYNC();
}

__device__ __forceinline__ void mls_scan_unit(const Args& a, int unit, LAS unsigned char* lds, int tid, int lane, int wave) {
    const int qtr = unit & 3, bhd = unit >> 2, dir = bhd & 1;
    LAS float* SM = (LAS float*)(lds + RING_OFF);
    const float* CLOC = (const float*)(a.ws + WS_CLOC) + (size_t)bhd * 16 * 4096 + 1024 * qtr + 2 * tid;
    const float* NLOC = (const float*)(a.ws + WS_NLOC) + (size_t)bhd * 16 * 64;
    typedef float f32x2 __attribute__((ext_vector_type(2)));
    f32x2 cl[16]; float nl[16];
#pragma unroll
    for (int k = 0; k < 16; ++k) cl[k] = *(const f32x2*)(CLOC + (size_t)k * 4096);
    const bool do_n = (qtr == 0) && (tid < 64);
#pragma unroll
    for (int k = 0; k < 16; ++k) nl[k] = do_n ? NLOC[k * 64 + tid] : 0.f;
    if (tid < 32) SM[tid] = ((const float*)(a.ws + WS_MLOC))[(size_t)bhd * 32 + tid];
    WG_SYNC();
    bf16* CP = (bf16*)(a.ws + WS_CPREV) + (size_t)bhd * 16 * 4096 + 1024 * qtr + 2 * tid;
    float* NP = (float*)(a.ws + WS_NPREV) + (size_t)bhd * 16 * 64; float* MP = (float*)(a.ws + WS_MPREV) + (size_t)bhd * 16;
    float m = 0.f; f32x2 C = (f32x2){0.f, 0.f}; float n = 0.f;
#pragma unroll
    for (int q = 0; q < 16; ++q) { const int k = dir ? 15 - q : q;
        *(unsigned*)(CP + (size_t)k * 4096) = pk2(C[0], C[1]);
        if (do_n) NP[k * 64 + tid] = n;
        if (qtr == 0 && tid == 64) MP[k] = m;
        const float mlk = SM[2 * k], gk = SM[2 * k + 1]; const float mn = fmaxf(gk + m, mlk); const float fa = fexp(gk + m - mn), fb = fexp(mlk - mn);
        C = fa * C + fb * (dir ? cl[15 - q] : cl[q]); n = fa * n + fb * (dir ? nl[15 - q] : nl[q]); m = mn; }
    WG_SYNC();
}

template <int DIR>
__device__ __forceinline__ void mls_dir(f32x4 (&hacc)[4], const LAS bf16* QS, const LAS bf16* KS, const LAS bf16* VT, const LAS bf16* CP, const LAS float* AJ, const LAS float* MM,
                                        const LAS float* INTER, const LAS float* FLOOR, const LAS float* NP, LAS float* rowbuf, int w, int lane) {
    const int li = lane & 15, g = lane >> 4, i = 16 * w + li;
    bf16x8 qf[2];
#pragma unroll
    for (int ks = 0; ks < 2; ++ks) qf[ks] = *(const LAS bf16x8*)(QS + i * QS_ + 32 * ks + 8 * g);
    const float mmi = MM[i];
    float den = 0.f;
    f32x4 out[4];
#pragma unroll
    for (int dt = 0; dt < 4; ++dt) out[dt] = (f32x4){0.f, 0.f, 0.f, 0.f};
#pragma unroll
    for (int kp = 0; kp < 4; ++kp) {
        const bool need = (DIR == 0) ? (2 * kp <= w) : (2 * kp + 1 >= w);
        if (need) {
            f32x4 s0 = (f32x4){0.f, 0.f, 0.f, 0.f}, s1 = (f32x4){0.f, 0.f, 0.f, 0.f};
#pragma unroll
            for (int ks = 0; ks < 2; ++ks) { const bf16x8 k0 = *(const LAS bf16x8*)(KS + (32 * kp + li) * QS_ + 32 * ks + 8 * g), k1 = *(const LAS bf16x8*)(KS + (32 * kp + 16 + li) * QS_ + 32 * ks + 8 * g);
                s0 = MFMA16(k0, qf[ks], s0); s1 = MFMA16(k1, qf[ks], s1); }
            constexpr float L2E = 1.4426950408889634f;
            const int jb = 32 * kp + 4 * g;
            const f32x4 aj0 = *(const LAS f32x4*)(AJ + jb), aj1 = *(const LAS f32x4*)(AJ + jb + 16);
            f32x4 e0 = (aj0 - mmi) * L2E - 3.0f, e1 = (aj1 - mmi) * L2E - 3.0f;
#pragma unroll
            for (int r = 0; r < 4; ++r) { const bool v0 = (DIR == 0) ? (jb + r <= i) : (jb + r >= i), v1 = (DIR == 0) ? (jb + 16 + r <= i) : (jb + 16 + r >= i);
                e0[r] = __builtin_amdgcn_exp2f(v0 ? e0[r] : -INFINITY); e1[r] = __builtin_amdgcn_exp2f(v1 ? e1[r] : -INFINITY); }
            const f32x4 p0 = s0 * e0, p1 = s1 * e1;
            den += ((p0[0] + p0[1]) + (p0[2] + p0[3])) + ((p1[0] + p1[1]) + (p1[2] + p1[3]));
            const float p[8] = {p0[0], p0[1], p0[2], p0[3], p1[0], p1[1], p1[2], p1[3]};
            v4u pk; pk.x = pk2(p[0], p[1]); pk.y = pk2(p[2], p[3]); pk.z = pk2(p[4], p[5]); pk.w = pk2(p[6], p[7]);
            const bf16x8 pf = __builtin_bit_cast(bf16x8, pk);
#pragma unroll
            for (int dt = 0; dt < 4; ++dt) { const LAS bf16* vr = VT + (16 * dt + li) * TS + 32 * kp + 4 * g;
                const u32x2 lo = *(const LAS u32x2*)vr, hi = *(const LAS u32x2*)(vr + 16);
                v4u vk; vk.x = lo.x; vk.y = lo.y; vk.z = hi.x; vk.w = hi.y;
                out[dt] = MFMA16(pf, __builtin_bit_cast(bf16x8, vk), out[dt]); }
        }
    }
    f32x4 qc[4];
#pragma unroll
    for (int dt = 0; dt < 4; ++dt) { qc[dt] = (f32x4){0.f, 0.f, 0.f, 0.f};
#pragma unroll
        for (int ks = 0; ks < 2; ++ks) { const bf16x8 cf = *(const LAS bf16x8*)(CP + (16 * dt + li) * QS_ + 32 * ks + 8 * g); qc[dt] = MFMA16(qf[ks], cf, qc[dt]); } }
    float nq = 0.f;
    { const v4u qa = *(const LAS v4u*)(QS + i * QS_ + 16 * g), qb = *(const LAS v4u*)(QS + i * QS_ + 16 * g + 8);
      const unsigned qq[8] = {qa.x, qa.y, qa.z, qa.w, qb.x, qb.y, qb.z, qb.w};
#pragma unroll
      for (int q = 0; q < 4; ++q) { const f32x4 nv = *(const LAS f32x4*)(NP + 16 * g + 4 * q);
          nq += (nv[0] * bflo(qq[2 * q]) + nv[1] * bfhi(qq[2 * q])) + (nv[2] * bflo(qq[2 * q + 1]) + nv[3] * bfhi(qq[2 * q + 1])); } }
    den = xor32_sum(xor16_sum(den)); nq = xor32_sum(xor16_sum(nq));
    const float inter = INTER[i]; const float dn = fmaxf(fabsf(den + inter * nq), FLOOR[i]);
    asm volatile("s_waitcnt lgkmcnt(0)" ::: "memory");
    if (g == 0) { rowbuf[li] = inter; rowbuf[16 + li] = frcp(dn); }
    asm volatile("s_waitcnt lgkmcnt(0)" ::: "memory");
#pragma unroll
    for (int r = 0; r < 4; ++r) { const float it = rowbuf[4 * g + r], inv = rowbuf[16 + 4 * g + r];
#pragma unroll
        for (int dt = 0; dt < 4; ++dt) hacc[dt][r] += (out[dt][r] + it * qc[dt][r]) * inv; }
    asm volatile("s_waitcnt lgkmcnt(0)" ::: "memory");
}
__device__ __forceinline__ void mls_b_unit(const Args& a, int l, int unit, LAS unsigned char* lds, int tid, int lane, int wave) {
    const int c = unit & 15, hd = (unit >> 4) & 3, b = unit >> 6; const size_t m0 = (size_t)b * SEQ + c * 128;
    LAS float* GL = (LAS float*)(lds + RING_OFF);
    LAS float* AJ = GL + 768;
    LAS float* MMx = AJ + 256;
    LAS float* INT_ = MMx + 256;
    LAS float* FLR = INT_ + 256;
    LAS float* NP = FLR + 256;
    LAS float* COEF = NP + 128;
    LAS float* ROWB = COEF + 32;
    LAS bf16* QS = (LAS bf16*)(lds + RING_OFF + 16384); LAS bf16* KS = QS + 128 * QS_; LAS bf16* VT = KS + 128 * QS_; LAS bf16* CF = VT + 64 * TS; LAS bf16* CB = CF + 64 * QS_;
    const size_t sbase = ((size_t)b * 4 + hd) * 2;
    const MlsGateRaw graw = mls_gates_load(a, l, m0, hd, tid);
    const float mprev = ((const float*)(a.ws + WS_MPREV))[(sbase + (wave & 1)) * 16 + c];
    const bf16* PROJ = (const bf16*)(a.ws + WS_PROJ);
    const int sj = tid >> 2, q4 = tid & 3; const bf16* rp = PROJ + (m0 + sj) * NPROJ + hd * 64 + 16 * q4;
    const v4u q0 = *(const v4u*)(rp + C_MQ), q1 = *(const v4u*)(rp + C_MQ + 8), k0 = *(const v4u*)(rp + C_MK), k1 = *(const v4u*)(rp + C_MK + 8), v0 = *(const v4u*)(rp + C_MV), v1 = *(const v4u*)(rp + C_MV + 8);
    const int idx = tid * 8; const bf16* CPV = (const bf16*)(a.ws + WS_CPREV);
    const v4u cfv = *(const v4u*)(CPV + ((sbase + 0) * 16 + c) * 4096 + idx), cbv = *(const v4u*)(CPV + ((sbase + 1) * 16 + c) * 4096 + idx);
    float npv = 0.f; if (tid < 128) npv = ((const float*)(a.ws + WS_NPREV))[((sbase + (tid >> 6)) * 16 + c) * 64 + (tid & 63)];
    const int li_ = lane & 15, g_ = lane >> 4; const float* hg = a.in[I_MNG] + ((size_t)l * 4 + hd) * 64;
    unsigned short ogv[4][4]; float hgv[4];
#pragma unroll
    for (int dt = 0; dt < 4; ++dt) { hgv[dt] = hg[16 * dt + li_];
#pragma unroll
        for (int r = 0; r < 4; ++r) ogv[r][dt] = PROJ[(m0 + 16 * wave + 4 * g_ + r) * NPROJ + C_MO + hd * 64 + 16 * dt + li_]; }
    mls_gates_store(graw, GL, tid);
    *(LAS v4u*)(QS + sj * QS_ + 16 * q4) = q0; *(LAS v4u*)(QS + sj * QS_ + 16 * q4 + 8) = q1;
    *(LAS v4u*)(KS + sj * QS_ + 16 * q4) = k0; *(LAS v4u*)(KS + sj * QS_ + 16 * q4 + 8) = k1;
    { const unsigned vv[8] = {v0.x, v0.y, v0.z, v0.w, v1.x, v1.y, v1.z, v1.w};
#pragma unroll
      for (int q = 0; q < 8; ++q) { const int d0 = 16 * q4 + 2 * q; VT[d0 * TS + sj] = (bf16)(vv[q] & 0xffffu); VT[(d0 + 1) * TS + sj] = (bf16)(vv[q] >> 16); } }
    *(LAS v4u*)(CF + (idx >> 6) * QS_ + (idx & 63)) = cfv; *(LAS v4u*)(CB + (idx >> 6) * QS_ + (idx & 63)) = cbv;
    if (tid < 128) NP[tid] = npv;
    WG_SYNC();
    mls_gates_scan(GL, wave, lane);
    if (wave < 2) {
        WAVE_LDS_FENCE();
        const int dir = wave; const float m = mprev;
        const LAS float* IG = GL + 256 + 128 * dir; const LAS float* Bc = GL + 512 + 128 * dir;
        LAS float* aj = AJ + 128 * dir; LAS float* mmx = MMx + 128 * dir;
        aj[lane] = IG[lane] - Bc[lane]; aj[lane + 64] = IG[lane + 64] - Bc[lane + 64];
        WAVE_LDS_FENCE();
        if (dir == 0) wave_scan128<true, false>(aj, mmx, lane); else wave_scan128<true, true>(aj, mmx, lane);
        WAVE_LDS_FENCE();
#pragma unroll
        for (int q = 0; q < 2; ++q) { const int j = lane + 64 * q; const float mm = fmaxf(mmx[j], m);
            mmx[j] = mm; INT_[128 * dir + j] = fexp(m - mm); FLR[128 * dir + j] = fexp(-(Bc[j] + mm)); }
    }
    WG_SYNC();
    f32x4 hacc[4];
#pragma unroll
    for (int dt = 0; dt < 4; ++dt) hacc[dt] = (f32x4){0.f, 0.f, 0.f, 0.f};
    mls_dir<0>(hacc, QS, KS, VT, CF, AJ, MMx, INT_, FLR, NP, ROWB + wave * 32, wave, lane);
    mls_dir<1>(hacc, QS, KS, VT, CB, AJ + 128, MMx + 128, INT_ + 128, FLR + 128, NP + 64, ROWB + wave * 32, wave, lane);
    {
        bf16* Y = (bf16*)(a.ws + WS_Y);
#pragma unroll
        for (int r = 0; r < 4; ++r) { float ss = (hacc[0][r] * hacc[0][r] + hacc[1][r] * hacc[1][r]) + (hacc[2][r] * hacc[2][r] + hacc[3][r] * hacc[3][r]);
            ss = row16_sum(ss);
            const float rstd = frsq(ss * (1.0f / 64.0f) + EPS); const size_t m = m0 + 16 * wave + 4 * g_ + r;
#pragma unroll
            for (int dt = 0; dt < 4; ++dt) Y[m * DM + 768 + hd * 64 + 16 * dt + li_] = (bf16)f2bf(hacc[dt][r] * rstd * hgv[dt] * sigmoid_f(bf2f(ogv[r][dt]))); }
    }
    WG_SYNC();
}

__device__ __forceinline__ void attnorm_pass(const Args& a, int l, int lane, int wave, int G, int bid, bf16* DST) {
    bf16* Y = (bf16*)(a.ws + WS_Y); const float* gq = a.in[I_AOG] + (size_t)l * 512 + 8 * lane;
    const f32x4 g0 = *(const f32x4*)gq, g1 = *(const f32x4*)(gq + 4);
    const int gw = bid * NWAVES + wave, NGW = G * NWAVES;
    for (int mb = 4 * gw; mb < M; mb += 4 * NGW) { v4u q[4];
#pragma unroll
        for (int r = 0; r < 4; ++r) q[r] = *(const v4u*)(Y + (size_t)(mb + r) * DM + 8 * lane);
        float ss[4];
#pragma unroll
        for (int r = 0; r < 4; ++r) { const float x[8] = {bflo(q[r].x), bfhi(q[r].x), bflo(q[r].y), bfhi(q[r].y), bflo(q[r].z), bfhi(q[r].z), bflo(q[r].w), bfhi(q[r].w)}; float a = 0.f;
#pragma unroll
            for (int i = 0; i < 8; ++i) a += x[i] * x[i];
            ss[r] = a; }
#pragma unroll
        for (int r = 0; r < 4; ++r) ss[r] = wave_sum(ss[r]);
#pragma unroll
        for (int r = 0; r < 4; ++r) { const float rstd = frsq(ss[r] * (1.0f / 512.0f) + EPS);
            const float x[8] = {bflo(q[r].x), bfhi(q[r].x), bflo(q[r].y), bfhi(q[r].y), bflo(q[r].z), bfhi(q[r].z), bflo(q[r].w), bfhi(q[r].w)};
            v4u o; o.x = pk2(x[0] * rstd * g0[0], x[1] * rstd * g0[1]); o.y = pk2(x[2] * rstd * g0[2], x[3] * rstd * g0[3]);
            o.z = pk2(x[4] * rstd * g1[0], x[5] * rstd * g1[1]); o.w = pk2(x[6] * rstd * g1[2], x[7] * rstd * g1[3]); *(v4u*)(DST + (size_t)(mb + r) * DM + 8 * lane) = o; } }
}

__device__ __forceinline__ unsigned mbcnt64(unsigned long long m) { return __builtin_amdgcn_mbcnt_hi((unsigned)(m >> 32), __builtin_amdgcn_mbcnt_lo((unsigned)m, 0u)); }
__device__ __forceinline__ void topk_item(const Args& a, int item, LAS unsigned char* lds, int tid, int lane, int wave) {
    const int unit = item & 127, half = item >> 7, b = unit >> 4, e = unit & 15;
    LAS unsigned* CNT = (LAS unsigned*)(lds + RING_OFF);
    LAS unsigned* SEG = CNT + 16;
    LAS int* TOK = (LAS int*)(SEG + 64);
    LAS float* GV = (LAS float*)(TOK + 256);
    const float* aff = (const float*)(a.ws + WS_AFF) + ((size_t)b * NE + e) * SEQ;
    float av[4]; unsigned key[4];
#pragma unroll
    for (int q = 0; q < 4; ++q) av[q] = aff[tid + q * NTHR];
#pragma unroll
    for (int q = 0; q < 4; ++q) key[q] = __float_as_uint(av[q]);
    unsigned lo = 0u, hi = 0x7F800000u; int par = 0;
    while (hi - lo > 1u) { const unsigned mid = lo + ((hi - lo) >> 1);
        unsigned c = 0u;
#pragma unroll
        for (int q = 0; q < 4; ++q) c += (unsigned)__popcll(__ballot(key[q] >= mid));
        if (lane == 0) CNT[par * 8 + wave] = c;
        WG_SYNC();
        const v4u c0 = *(const LAS v4u*)(CNT + par * 8), c1 = *(const LAS v4u*)(CNT + par * 8 + 4);
        const unsigned tot = (c0.x + c0.y) + (c0.z + c0.w) + (c1.x + c1.y) + (c1.z + c1.w);
        if (tot >= (unsigned)CAP) lo = mid; else hi = mid;
        par ^= 1; }
    const unsigned T = lo;
    unsigned long long mgt[4], meq[4];
#pragma unroll
    for (int q = 0; q < 4; ++q) { mgt[q] = __ballot(key[q] > T); meq[q] = __ballot(key[q] == T);
        if (lane == 0) { SEG[q * 8 + wave] = (unsigned)__popcll(mgt[q]); SEG[32 + q * 8 + wave] = (unsigned)__popcll(meq[q]); } }
    WG_SYNC();
    unsigned ngt = 0u;
#pragma unroll
    for (int g = 0; g < 32; ++g) ngt += SEG[g];
    const unsigned need = (unsigned)CAP - ngt;
    unsigned eqb = 0u, selb = 0u, my_eqb[4], my_selb[4];
#pragma unroll
    for (int g = 0; g < 32; ++g) { if ((g & 7) == wave) { my_eqb[g >> 3] = eqb; my_selb[g >> 3] = selb; }
        const unsigned cg = SEG[g], ce = SEG[32 + g]; const unsigned room = need > eqb ? need - eqb : 0u; selb += cg + (room < ce ? room : ce); eqb += ce; }
    int* SEL = (int*)(a.ws + WS_SEL);
#pragma unroll
    for (int q = 0; q < 4; ++q) { const bool gt = key[q] > T, eq = key[q] == T;
        const bool sel = gt || (eq && (my_eqb[q] + mbcnt64(meq[q])) < need);
        const unsigned long long ms = __ballot(sel); const int slot = (int)(my_selb[q] + mbcnt64(ms)); const int sidx = tid + q * NTHR;
        if (sel) { TOK[slot] = sidx; GV[slot] = av[q]; }
        if ((q >> 1) == half) SEL[((size_t)b * SEQ + sidx) * NE + e] = sel ? slot : -1; }
    WG_SYNC();
    int* IDX = (int*)(a.ws + WS_IDX); float* GATE = (float*)(a.ws + WS_GATE);
    if (tid < 128) { const int t = half * 128 + tid; IDX[e * NSLOT + b * CAP + t] = b * SEQ + TOK[t]; GATE[e * NSLOT + b * CAP + t] = GV[t]; }
    const unsigned char* H8 = a.ws + WS_H; unsigned char* XG8 = a.ws + WS_XG;
    { v4u r0[16];
#pragma unroll
      for (int q = 0; q < 16; ++q) { const int t = half * 128 + wave * 16 + q; r0[q] = *((const v4u*)(H8 + ((size_t)b * SEQ + TOK[t]) * DM) + lane); }
#pragma unroll
      for (int q = 0; q < 16; ++q) { const int t = half * 128 + wave * 16 + q; *((v4u*)(XG8 + ((size_t)e * NSLOT + b * CAP + t) * DM) + lane) = r0[q]; } }
    WG_SYNC();
}

__global__ void __launch_bounds__(NTHR, 2) hybrid_fwd(Args args) {
    extern __shared__ __attribute__((aligned(16))) unsigned char lds_raw[];
    LAS unsigned char* lds = (LAS unsigned char*)lds_raw;
    volatile LAS unsigned* MISC = (volatile LAS unsigned*)(lds + MISC_OFF);
    const int tid0 = threadIdx.x, G = gridDim.x;
    unsigned char* ws = args.ws;
#define PHASE_IDS() const int tid = ltid(), lane = tid & 63, wave = __builtin_amdgcn_readfirstlane(tid >> 6), bid = lbid(); (void)lane; (void)wave; (void)bid
    gu32* ctl = (gu32*)(ws + WS_CTL);
    for (int u = tid0; u < (LDS_BYTES - MISC_OFF) / 4; u += NTHR) ((LAS unsigned*)(lds + MISC_OFF))[u] = 0u;
    __syncthreads();
    XcdBarrier bar; bar.bar = (unsigned*)(ctl + CW_BAR); bar.x = 0; bar.st = nullptr;
    if (!MK_PER_PHASE) bar = xcd_barrier_post((unsigned*)(ctl + CW_BAR), MISC + 8);
#define GRID_BAR() do { if (!MK_PER_PHASE) { xcd_barrier(bar); if (REP_MASK & (1 << 11)) xcd_barrier(bar); } } while (0)
    const int lo = args.ph_lo, hi = args.ph_hi;
#ifndef PT_MASK
#define PT_MASK 0x7ff
#endif
#define PT_ON(j) (((PT_MASK) >> (j)) & 1)
#ifndef REP_MASK
#define REP_MASK 0
#endif
#define REPS(j) for (int rep_ = 0; rep_ < 1 + (((REP_MASK) >> (j)) & 1); ++rep_)
#define IN(k) (lo <= (k) && (k) < hi)
#define BOTH(k) (IN(k) && IN((k) + 1))

    bf16* Hb = (bf16*)(ws + WS_H); bf16* PROJ = (bf16*)(ws + WS_PROJ); bf16* Yb = (bf16*)(ws + WS_Y);
    float* MG = (float*)(ws + WS_MG); float* AFF = (float*)(ws + WS_AFF); int* SEL = (int*)(ws + WS_SEL);
    bf16* XG = (bf16*)(ws + WS_XG); bf16* HID = (bf16*)(ws + WS_HID); bf16* YE = (bf16*)(ws + WS_YE); bf16* XB = (bf16*)(ws + WS_XB);

    if (PT_ON(0) && IN(0)) { PHASE_IDS();
        REPS(0) p0_weights(args, lds, tid, lane, wave, G, bid);
        WG_SYNC();
        REPS(16) row_pass<0, false>(args.in[I_X], nullptr, args.in[I_N1G], args.in[I_WIN] + NPROJ, DIN, Hb, MG, nullptr, nullptr, lds, tid, lane, wave, G, bid);
        if (BOTH(0)) GRID_BAR();
    }
    for (int l = 0; l < DEPTH; ++l) {
        const int pb = 1 + 10 * l;
        if (PT_ON(1) && IN(pb + 0)) { PHASE_IDS();
            pg8::Gemm g{Hb, (const bf16*)(ws + WS_WIN) + (size_t)l * NPROJ * DM, M, NPROJ, DM}; pg8::StaticOrder S; S.init(M, NPROJ - 256, G, bid);
            pg8::EpiBf16<0> E{PROJ, NPROJ, nullptr, 0, 0, 1.f};
            REPS(1) pg8::gemm_phase<pg8::EpiBf16<0>, pg8::StaticOrder, true, true>(lds + RING_OFF, g, S, E);
            if (BOTH(pb + 0)) GRID_BAR();
        }
        if (PT_ON(2) && IN(pb + 1)) { PHASE_IDS();
            const bool split = (G == 256);
            if (bid < 64 || !split) { pg8::Gemm g{Hb, (const bf16*)(ws + WS_WIN) + (size_t)l * NPROJ * DM, M, NPROJ, DM}; pg8::TailOrder S{G, bid, 8}; pg8::EpiBf16<0> E{PROJ, NPROJ, nullptr, 0, 0, 1.f};
                pg8::gemm_phase<pg8::EpiBf16<0>, pg8::TailOrder, false, true>(lds + RING_OFF, g, S, E); WG_SYNC(); }
            if (!split) rope_pass(args, l, lane, wave, G, bid, PROJ);
            else if (bid >= 64) rope_pass(args, l, lane, wave, 192, bid - 64, PROJ);
            REPS(2) for (int u = bid; u < 512; u += G) lru_a_unit(args, l, u, lds, tid, lane, wave);
            if (!split) { for (int u = bid; u < 512; u += G) mls_a_unit(args, l, u, lds, tid, lane, wave); }
            else if (bid >= 64) { for (int u = bid - 64; u < 512; u += 192) mls_a_unit(args, l, u, lds, tid, lane, wave); }
            if (BOTH(pb + 1)) GRID_BAR();
        }
        if (PT_ON(3) && IN(pb + 2)) { PHASE_IDS();
            const attn_body::AttnTensors AT{(const attn_body::bf16*)(PROJ + C_Q), (const attn_body::bf16*)(PROJ + C_K), (const attn_body::bf16*)(PROJ + C_V), (attn_body::bf16*)Yb};
            const attn_body::StaticOrder S(G, bid);
#ifndef P3_PARTS
#define P3_PARTS 7
#endif
            for (int u = bid; u < 256; u += G) mls_scan_unit(args, u, lds, tid, lane, wave);
            WG_SYNC();
            REPS(4) attn_body::attn_phase<attn_body::StaticOrder>((char*)lds_raw + RING_OFF, AT, S);
            if (BOTH(pb + 2)) GRID_BAR();
        }
        if (PT_ON(4) && IN(pb + 3)) { PHASE_IDS();
            REPS(5) for (int u = bid; u < 512; u += G) mls_b_unit(args, l, u, lds, tid, lane, wave);
            for (int u = bid; u < 256; u += G) p4_rows_unit(args, l, u, lds, tid, lane, wave);
            if (BOTH(pb + 3)) GRID_BAR();
        }
        if (PT_ON(5) && IN(pb + 4)) { PHASE_IDS();
            pg8::Gemm g{Yb, (const bf16*)(ws + WS_WOUT) + (size_t)l * DM * DM, M, DM, DM}; pg8::StaticOrder S; S.init(M, DM, G, bid);
            pg8::EpiResid E{l == 0 ? args.in[I_X] : nullptr, XB, XB, DM};
            if (REP_MASK & (1 << 14)) { pg8::EpiResid E2{l == 0 ? args.in[I_X] : nullptr, XB, HID, DM}; pg8::gemm_phase<pg8::EpiResid, pg8::StaticOrder, false, true>(lds + RING_OFF, g, S, E2); }
            pg8::gemm_phase<pg8::EpiResid, pg8::StaticOrder, false, true>(lds + RING_OFF, g, S, E);
            stage_w16(args.in[I_WR] + (size_t)l * DM * NE, NE, lds, tid);
            if (BOTH(pb + 4)) GRID_BAR();
        }
        if (PT_ON(6) && IN(pb + 5)) { PHASE_IDS();
            REPS(7) row_pass<1, true, true>(XB, nullptr, args.in[I_N2G] + (size_t)l * DM, args.in[I_WR] + (size_t)l * DM * NE, NE, Hb, AFF, nullptr, nullptr, lds, tid, lane, wave, G, bid);
            if (BOTH(pb + 5)) GRID_BAR();
        }
        if (PT_ON(7) && IN(pb + 6)) { PHASE_IDS(); REPS(8) for (int it = bid; it < 256; it += G) topk_item(args, it, lds, tid, lane, wave); if (BOTH(pb + 6)) GRID_BAR(); }
        if (PT_ON(8) && IN(pb + 7)) { PHASE_IDS();
            pg8::Gemm g{XG, (const bf16*)(ws + WS_WGU + (size_t)l * NE * 4096 * DM), NE * NSLOT, NE * 4096, DM / 2}; pg8::Moe1Order S{G, bid};
            pg8::EpiSwiGLU E{(unsigned char*)HID, DE};
            if (REP_MASK & (1 << 17)) { pg8::EpiNull E0; pg8::gemm_phase<pg8::EpiNull, pg8::Moe1Order, true, true, true>(lds + RING_OFF, g, S, E0); }
            REPS(9) pg8::gemm_phase<pg8::EpiSwiGLU, pg8::Moe1Order, true, true, true>(lds + RING_OFF, g, S, E);
            if (BOTH(pb + 7)) GRID_BAR();
        }
        if (PT_ON(9) && IN(pb + 8)) { PHASE_IDS();
            pg8::Gemm g{HID, (const bf16*)(ws + WS_WDN + (size_t)l * NE * DM * DE), NE * NSLOT, NE * DM, DE / 2}; pg8::Moe2Order S{G, bid};
            pg8::EpiScaleBf16 E{YE, DM, (const float*)(ws + WS_GATE)};
            REPS(10) pg8::gemm_phase<pg8::EpiScaleBf16, pg8::Moe2Order, true, true, true>(lds + RING_OFF, g, S, E);
            if (l + 1 < DEPTH) stage_w16(args.in[I_WIN] + (size_t)(l + 1) * DM * DIN + NPROJ, DIN, lds, tid);
            if (BOTH(pb + 8)) GRID_BAR();
        }
        if (PT_ON(10) && IN(pb + 9)) { PHASE_IDS();
            if (REP_MASK & (1 << 15)) { if (l + 1 < DEPTH) row_pass<2, true>(XB, HID, args.in[I_N1G] + (size_t)(l + 1) * DM, args.in[I_WIN] + (size_t)(l + 1) * DM * DIN + NPROJ, DIN, Hb, MG, SEL, YE, lds, tid, lane, wave, G, bid); else row_pass<3, true>(XB, HID, nullptr, nullptr, 0, nullptr, nullptr, SEL, YE, lds, tid, lane, wave, G, bid); WG_SYNC(); }
            if (l + 1 < DEPTH) row_pass<2, true, true>(XB, XB, args.in[I_N1G] + (size_t)(l + 1) * DM, args.in[I_WIN] + (size_t)(l + 1) * DM * DIN + NPROJ, DIN, Hb, MG, SEL, YE, lds, tid, lane, wave, G, bid);
            else row_pass<3, true>(XB, args.out, nullptr, nullptr, 0, nullptr, nullptr, SEL, YE, lds, tid, lane, wave, G, bid);
            if (BOTH(pb + 9)) GRID_BAR();
        }
    }
#undef IN
#undef BOTH
#undef GRID_BAR
}

extern "C" void kernel_launch(void* const* d_in, const int* in_sizes, int n_in, void* d_out, int out_size, void* d_ws, size_t ws_size, hipStream_t stream) {
    static int grid = 0;
    if (grid == 0) {
        if (n_in != 22 || in_sizes[0] != M * DM || out_size != M * DM || ws_size < WS_END) { fprintf(stderr, "kernel_launch: unexpected shapes (n_in %d, in0 %d, out %d, ws %zu); nothing launched\n", n_in, n_in > 0 ? in_sizes[0] : -1, out_size, ws_size); grid = -1; return; }
        int dev = 0, cus = 0, per_cu = 0;
        if (hipGetDevice(&dev) != hipSuccess || hipDeviceGetAttribute(&cus, hipDeviceAttributeMultiprocessorCount, dev) != hipSuccess) { grid = -1; return; }
        if (hipFuncSetAttribute((const void*)hybrid_fwd, hipFuncAttributeMaxDynamicSharedMemorySize, LDS_BYTES) != hipSuccess) { fprintf(stderr, "kernel_launch: hipFuncSetAttribute failed\n"); grid = -1; return; }
        if (hipOccupancyMaxActiveBlocksPerMultiprocessor(&per_cu, (const void*)hybrid_fwd, NTHR, LDS_BYTES) != hipSuccess || per_cu < 1) { fprintf(stderr, "kernel_launch: occupancy query says %d\n", per_cu); }
        (void)hipGetLastError();
        grid = cus;
    }
    if (grid < 0) return;
    if (hipMemsetAsync((char*)d_ws + WS_CTL, 0, CTL_ZERO_BYTES, stream) != hipSuccess) return;
    Args a{};
    for (int i = 0; i < 22; ++i) a.in[i] = (const float*)d_in[i];
    a.out = (float*)d_out; a.ws = (unsigned char*)d_ws; a.pad = 0;
#if MK_PER_PHASE
    for (int p = 0; p < NPH; ++p) { a.ph_lo = p; a.ph_hi = p + 1; a.li = p; hipLaunchKernelGGL(hybrid_fwd, dim3(grid), dim3(NTHR), LDS_BYTES, stream, a); }
#else
    a.ph_lo = 0; a.ph_hi = NPH; a.li = 0;
    hipLaunchKernelGGL(hybrid_fwd, dim3(grid), dim3(NTHR), LDS_BYTES, stream, a);
#endif
    const hipError_t le = hipPeekAtLastError();
    if (le != hipSuccess) fprintf(stderr, "kernel_launch: launch failed: %s\n", hipGetErrorName(le));
}
```

```cpp
#include <hip/hip_runtime.h>
#include <hip/hip_bf16.h>
#include <cstdio>
#include <cstdint>
#include <cmath>
__device__ __forceinline__ int ltid() { int t = threadIdx.x; asm volatile("" : "+v"(t)); return t; }
__device__ __forceinline__ int lbid() { int t = blockIdx.x; asm volatile("" : "+s"(t)); return t; }
namespace pg8 {
#define PG8_LAS __attribute__((address_space(3)))
typedef unsigned short bf16_t;
typedef short bf16x8 __attribute__((ext_vector_type(8)));
typedef float f32x4 __attribute__((ext_vector_type(4)));
typedef unsigned u32x4 __attribute__((ext_vector_type(4)));
typedef unsigned u32x2 __attribute__((ext_vector_type(2)));
constexpr int BM = 256, BK = 64, HALF = 128, HTB = HALF * BK * 2  , STAGE_BYTES = 8 * HTB, NXCD = 8, WGM = 8;

__host__ __device__ __forceinline__ int lds_byte(int r, int c) { const int st = (r >> 4) * 2 + (c >> 5), rr = r & 15, cc = c & 31, ob = rr * 64 + cc * 2; return st * 1024 + (ob ^ (((ob >> 9) & 1) << 5)); }
__host__ __device__ __forceinline__ void stage_rc(int b, int& R, int& C) { const int st = b / 1024, sb = b % 1024, swz = sb ^ (((sb >> 9) & 1) << 5); R = (st >> 1) * 16 + swz / 64; C = (st & 1) * 32 + (swz % 64) / 2; }
__host__ __device__ __forceinline__ int perm32(int rho) { const int n = rho >> 4, i = rho & 15; return 8 * (i >> 2) + 4 * n + (i & 3); }

struct Unit { int pm, pn; };
struct Gemm { const bf16_t* A; const bf16_t* Bt; int M, N, K; };

struct StaticOrder {
    int nM, nN, nwg, G, c;
    __host__ __device__ void init(int M, int N, int G_, int c_) { nM = M / BM; nN = N / BM; nwg = nM * nN; G = G_; c = c_; }
    __host__ __device__ bool next(int i, Unit& u) const {
        const long L = (long)i * G + c; if (L >= nwg) return false;
        int wgid = (int)L; { const int q = nwg / NXCD, r = nwg % NXCD, xcd = wgid % NXCD, off = wgid / NXCD; wgid = (xcd < r ? xcd * (q + 1) : r * (q + 1) + (xcd - r) * q) + off; }
        const int nig = WGM * nN, gid = wgid / nig, fm = gid * WGM, gsz = (nM - fm) < WGM ? (nM - fm) : WGM;
        u.pm = fm + ((wgid % nig) % gsz); u.pn = (wgid % nig) / gsz; return true;
    }
    __device__ __forceinline__ void a_ready(const Unit&) const {}
    __device__ __forceinline__ void done(const Unit&) const {}
};

__device__ __forceinline__ unsigned cvt_pk_bf16(float lo, float hi) { unsigned r; asm volatile("v_cvt_pk_bf16_f32 %0, %1, %2" : "=v"(r) : "v"(lo), "v"(hi)); return r; }
typedef int i32x4 __attribute__((ext_vector_type(4)));
typedef int i32x8 __attribute__((ext_vector_type(8)));
__device__ __forceinline__ i32x8 cat8(bf16x8 lo, bf16x8 hi) { return __builtin_shufflevector(__builtin_bit_cast(i32x4, lo), __builtin_bit_cast(i32x4, hi), 0, 1, 2, 3, 4, 5, 6, 7); }
__device__ __forceinline__ float clamp448(float v) { return __builtin_amdgcn_fmed3f(v, -448.f, 448.f); }
__device__ __forceinline__ unsigned pk4_fp8(float a, float b, float c, float d) { unsigned r = 0u; r = (unsigned)__builtin_amdgcn_cvt_pk_fp8_f32(a, b, (int)r, false); r = (unsigned)__builtin_amdgcn_cvt_pk_fp8_f32(c, d, (int)r, true); return r; }
typedef float f32x2 __attribute__((ext_vector_type(2)));
__device__ __forceinline__ f32x2 gelu_pk(f32x2 v) {
    const f32x2 av = __builtin_elementwise_abs(v), d = av * 0.2316418882f + 1.0f;
    f32x2 t; t.x = __builtin_amdgcn_rcpf(d.x); t.y = __builtin_amdgcn_rcpf(d.y);
    f32x2 q = t * 0.5307027145f + (-0.7265760135f); q = q * t + 0.7107068705f; q = q * t + (-0.142248368f); q = q * t + 0.127414796f; q = q * t;
    const f32x2 s = (v * v) * (-0.72134752044f);
    f32x2 e; e.x = __builtin_amdgcn_exp2f(s.x); e.y = __builtin_amdgcn_exp2f(s.y);
    const f32x2 m = v * (q * e), r = v - m;
    f32x2 o; o.x = v.x < 0.f ? m.x : r.x; o.y = v.y < 0.f ? m.y : r.y; return o;
}

template <int ACT  > struct EpiBf16 {
    static constexpr bool PERM = true, AFTER_DRAIN = false; static_assert(ACT == 0 || ACT == 1, "EpiBf16: ACT is 0 (none) or 1 (gelu_pk)");
    bf16_t* O; int ldc; const float* bias; int split_cols; size_t split_stride; float scale0;
    __device__ __forceinline__ void operator()(const f32x4 (&acc)[2][2][4][2], const Unit& u, int wr, int wc, int fr, int fq) const {
        const int row0 = u.pm * BM + wr * 64 + fr; int colt = u.pn * BM; bf16_t* base = O;
        float sc = 1.f; if (split_cols) { const int t = colt / split_cols; base += (size_t)t * split_stride; colt -= t * split_cols; if (t == 0) sc = scale0; }
        const int col0 = colt + wc * 32 + 8 * fq, bcol0 = u.pn * BM + wc * 32 + 8 * fq;
        f32x4 bv[2][2];
#pragma unroll
        for (int bj = 0; bj < 2; ++bj)
#pragma unroll
            for (int n = 0; n < 2; ++n) bv[bj][n] = bias ? *(const f32x4*)(bias + bcol0 + bj * HALF + 4 * n) : (f32x4){0.f, 0.f, 0.f, 0.f};
#pragma unroll
        for (int ai = 0; ai < 2; ++ai)
#pragma unroll
            for (int m = 0; m < 4; ++m) { bf16_t* rowp = base + (size_t)(row0 + ai * HALF + m * 16) * ldc + col0;
#pragma unroll
                for (int bj = 0; bj < 2; ++bj) { f32x4 v0 = acc[ai][bj][m][0] + bv[bj][0], v1 = acc[ai][bj][m][1] + bv[bj][1];
                    if (ACT == 1) { f32x2 a = gelu_pk((f32x2){v0[0], v0[1]}), b = gelu_pk((f32x2){v0[2], v0[3]}), c = gelu_pk((f32x2){v1[0], v1[1]}), d = gelu_pk((f32x2){v1[2], v1[3]});
                        v0 = (f32x4){a.x, a.y, b.x, b.y}; v1 = (f32x4){c.x, c.y, d.x, d.y}; }
                    v0 = v0 * sc; v1 = v1 * sc; u32x4 w; w.x = cvt_pk_bf16(v0[0], v0[1]); w.y = cvt_pk_bf16(v0[2], v0[3]); w.z = cvt_pk_bf16(v1[0], v1[1]); w.w = cvt_pk_bf16(v1[2], v1[3]);
                    *(u32x4*)(rowp + bj * HALF) = w; } }
    }
};

struct EpiResid {
    static constexpr bool PERM = true, AFTER_DRAIN = false;
    const float* base32; const bf16_t* base16; bf16_t* C; int ldc;
    __device__ __forceinline__ void operator()(const f32x4 (&acc)[2][2][4][2], const Unit& u, int wr, int wc, int fr, int fq) const {
        const int row0 = u.pm * BM + wr * 64 + fr, col0 = u.pn * BM + wc * 32 + 8 * fq;
#pragma unroll
        for (int ai = 0; ai < 2; ++ai)
#pragma unroll
            for (int m = 0; m < 4; ++m) { const size_t off = (size_t)(row0 + ai * HALF + m * 16) * ldc + col0;
#pragma unroll
                for (int bj = 0; bj < 2; ++bj) { f32x4 b0, b1;
                    if (base32) { b0 = *(const f32x4*)(base32 + off + bj * HALF); b1 = *(const f32x4*)(base32 + off + bj * HALF + 4); }
                    else { const u32x4 q = *(const u32x4*)(base16 + off + bj * HALF);
                        b0 = (f32x4){__uint_as_float(q.x << 16), __uint_as_float(q.x & 0xffff0000u), __uint_as_float(q.y << 16), __uint_as_float(q.y & 0xffff0000u)};
                        b1 = (f32x4){__uint_as_float(q.z << 16), __uint_as_float(q.z & 0xffff0000u), __uint_as_float(q.w << 16), __uint_as_float(q.w & 0xffff0000u)}; }
                    const f32x4 v0 = acc[ai][bj][m][0] + b0, v1 = acc[ai][bj][m][1] + b1;
                    u32x4 w; w.x = cvt_pk_bf16(v0[0], v0[1]); w.y = cvt_pk_bf16(v0[2], v0[3]); w.z = cvt_pk_bf16(v1[0], v1[1]); w.w = cvt_pk_bf16(v1[2], v1[3]);
                    *(u32x4*)(C + off + bj * HALF) = w; } }
    }
};
__device__ __forceinline__ float silu_f(float x) { return x * __builtin_amdgcn_rcpf(1.0f + __builtin_amdgcn_exp2f(-1.4426950408889634f * x)); }
constexpr float WSCALE = 64.f, HSCALE = 4.f;
struct EpiSwiGLU {
    static constexpr bool PERM = true, AFTER_DRAIN = false;
    unsigned char* O; int ldc;
    __device__ __forceinline__ static f32x2 sw2(f32x2 g, f32x2 u) {
        constexpr float c1 = -1.4426950408889634f / WSCALE, c2 = HSCALE / (WSCALE * WSCALE);
        const f32x2 t = g * c1; f32x2 d; d.x = __builtin_amdgcn_exp2f(t.x); d.y = __builtin_amdgcn_exp2f(t.y); d = d + 1.0f;
        f32x2 r; r.x = __builtin_amdgcn_rcpf(d.x); r.y = __builtin_amdgcn_rcpf(d.y);
        f32x2 p = (g * u) * (r * c2); p.x = clamp448(p.x); p.y = clamp448(p.y); return p; }
    __device__ __forceinline__ void operator()(const f32x4 (&acc)[2][2][4][2], const Unit& u, int wr, int wc, int fr, int fq) const {
        const int row0 = u.pm * BM + wr * 64 + fr, col0 = (u.pn & 15) * HALF + wc * 32 + 8 * fq;
#pragma unroll
        for (int ai = 0; ai < 2; ++ai)
#pragma unroll
            for (int m = 0; m < 4; ++m) { unsigned char* rowp = O + (size_t)(row0 + ai * HALF + m * 16) * ldc + col0;
                const f32x4 g0 = acc[ai][0][m][0], g1 = acc[ai][0][m][1], u0 = acc[ai][1][m][0], u1 = acc[ai][1][m][1];
                const f32x2 a = sw2((f32x2){g0[0], g0[1]}, (f32x2){u0[0], u0[1]}), b = sw2((f32x2){g0[2], g0[3]}, (f32x2){u0[2], u0[3]});
                const f32x2 c = sw2((f32x2){g1[0], g1[1]}, (f32x2){u1[0], u1[1]}), d = sw2((f32x2){g1[2], g1[3]}, (f32x2){u1[2], u1[3]});
                u32x2 w; w.x = pk4_fp8(a.x, a.y, b.x, b.y); w.y = pk4_fp8(c.x, c.y, d.x, d.y);
                *(u32x2*)rowp = w; }
    }
};
struct EpiScaleBf16 {
    static constexpr bool PERM = true, AFTER_DRAIN = false;
    bf16_t* O; int ldc; const float* rowscale;
    __device__ __forceinline__ void operator()(const f32x4 (&acc)[2][2][4][2], const Unit& u, int wr, int wc, int fr, int fq) const {
        const int row0 = u.pm * BM + wr * 64 + fr, col0 = (u.pn & 3) * BM + wc * 32 + 8 * fq;
#pragma unroll
        for (int ai = 0; ai < 2; ++ai)
#pragma unroll
            for (int m = 0; m < 4; ++m) { const int row = row0 + ai * HALF + m * 16; const float s = rowscale[row] * (1.0f / (WSCALE * HSCALE)); bf16_t* rowp = O + (size_t)row * ldc + col0;
#pragma unroll
                for (int bj = 0; bj < 2; ++bj) { const f32x4 v0 = acc[ai][bj][m][0] * s, v1 = acc[ai][bj][m][1] * s;
                    u32x4 w; w.x = cvt_pk_bf16(v0[0], v0[1]); w.y = cvt_pk_bf16(v0[2], v0[3]); w.z = cvt_pk_bf16(v1[0], v1[1]); w.w = cvt_pk_bf16(v1[2], v1[3]);
                    *(u32x4*)(rowp + bj * HALF) = w; } }
    }
};
struct EpiNull { static constexpr bool PERM = true, AFTER_DRAIN = false; __device__ __forceinline__ void operator()(const f32x4 (&)[2][2][4][2], const Unit&, int, int, int, int) const {} };
struct TailOrder {
    int G, c, pn;
    __device__ __forceinline__ bool next(int i, Unit& u) const { const int L = i * G + c; if (L >= 64) return false; u.pm = L; u.pn = pn; return true; }
    __device__ __forceinline__ void a_ready(const Unit&) const {}
    __device__ __forceinline__ void done(const Unit&) const {}
};
struct Moe1Order {
    int G, c;
    __device__ __forceinline__ bool next(int i, Unit& u) const {
        const int L = i * G + c; if (L >= 2048) return false;
        const int e = L >> 7, r = L & 127; u.pm = e * 8 + ((r >> 3) & 7); u.pn = e * 16 + 2 * (r & 7) + (r >> 6); return true;
    }
    __device__ __forceinline__ void a_ready(const Unit&) const {}
    __device__ __forceinline__ void done(const Unit&) const {}
};
struct Moe2Order {
    int G, c;
    __device__ __forceinline__ bool next(int i, Unit& u) const {
        const int L = i * G + c; if (L >= 512) return false;
        const int q = L & 7, Lp = L >> 3, e = 8 * (Lp >> 5) + q, k = Lp & 31; u.pm = e * 8 + (k & 7); u.pn = e * 4 + (k >> 3); return true;
    }
    __device__ __forceinline__ void a_ready(const Unit&) const {}
    __device__ __forceinline__ void done(const Unit&) const {}
};
template <class Epi, class Sched, bool ALIGN_EPI = false, bool SP2 = false, bool F8 = false>
__device__ __forceinline__ void gemm_phase(PG8_LAS unsigned char* lds, const Gemm g, const Sched& S, const Epi& E) {
    const int tid = ltid(), wid = __builtin_amdgcn_readfirstlane(tid >> 6), lane = tid & 63, wr = wid >> 2, wc = wid & 3, fr = lane & 15, fq = lane >> 4;
    const int K = g.K, nt = K / BK;
    unsigned voffA[2], voffB[2];
#pragma unroll
    for (int i = 0; i < 2; ++i) { int R, C; stage_rc(tid * 16 + i * 8192, R, C); const int Rb = Epi::PERM ? ((R & ~31) + perm32(R & 31)) : R;
        voffA[i] = (unsigned)(R * K + C) * 2u; voffB[i] = (unsigned)(Rb * K + C) * 2u; }
    const size_t kstep = (size_t)(BK * 2);
    const size_t hstep = (size_t)HALF * K * 2;
    const size_t tstep = 2 * hstep;
    const unsigned ldsw = (unsigned)wid * 1024u;
    const int aoff = lds_byte(wr * 64 + fr, fq * 8), boff = lds_byte(wc * 32 + fr, fq * 8);
#define PG8_SA(b, h) (((b) * 2 + (h)) * HTB)
#define PG8_SB(b, h) ((4 + (b) * 2 + (h)) * HTB)
#define PG8_STAGE(bufoff, gbase, voff) do { _Pragma("unroll") for (int _i = 0; _i < 2; ++_i) \
        __builtin_amdgcn_global_load_lds((const unsigned*)((const char*)(gbase) + (voff)[_i]), (PG8_LAS unsigned*)(lds + (bufoff) + ldsw + _i * 8192), 16, 0, 0); } while (0)
#define PG8_LDA(dst, b, h) do { _Pragma("unroll") for (int m = 0; m < 4; ++m) { if constexpr (F8) { dst##8[m] = cat8(*(const PG8_LAS bf16x8*)(lds + PG8_SA(b, h) + aoff + m * 2048), *(const PG8_LAS bf16x8*)(lds + PG8_SA(b, h) + aoff + m * 2048 + 1024)); } \
        else { _Pragma("unroll") for (int k = 0; k < 2; ++k) dst[m][k] = *(const PG8_LAS bf16x8*)(lds + PG8_SA(b, h) + aoff + m * 2048 + k * 1024); } } } while (0)
#define PG8_LDB(dst, b, h) do { _Pragma("unroll") for (int n = 0; n < 2; ++n) { if constexpr (F8) { dst##8[n] = cat8(*(const PG8_LAS bf16x8*)(lds + PG8_SB(b, h) + boff + n * 2048), *(const PG8_LAS bf16x8*)(lds + PG8_SB(b, h) + boff + n * 2048 + 1024)); } \
        else { _Pragma("unroll") for (int k = 0; k < 2; ++k) dst[n][k] = *(const PG8_LAS bf16x8*)(lds + PG8_SB(b, h) + boff + n * 2048 + k * 1024); } } } while (0)
#define PG8_MMA(ai, bj, At, Bt) do { __builtin_amdgcn_s_setprio(1); _Pragma("unroll") for (int m = 0; m < 4; ++m) _Pragma("unroll") for (int n = 0; n < 2; ++n) { \
        if constexpr (F8) { asm volatile("v_mfma_scale_f32_16x16x128_f8f6f4 %0, %1, %2, %0, %3, %3 op_sel_hi:[0,0,0]" : "+v"(acc[ai][bj][m][n]) : "v"(Bt##8[n]), "v"(At##8[m]), "v"(sc1)); } \
        else { _Pragma("unroll") for (int k = 0; k < 2; ++k) acc[ai][bj][m][n] = __builtin_amdgcn_mfma_f32_16x16x32_bf16(Bt[n][k], At[m][k], acc[ai][bj][m][n], 0, 0, 0); } } __builtin_amdgcn_s_setprio(0); } while (0)
#define PG8_WAIT_V(n) asm volatile("s_waitcnt vmcnt(" #n ")" ::: "memory")
#define PG8_WAIT_L(n) asm volatile("s_waitcnt lgkmcnt(" #n ")" ::: "memory")
#define PG8_BAR __builtin_amdgcn_s_barrier()
#define PG8_SCHED __builtin_amdgcn_sched_barrier(0)
    Unit cur, nxt; int ui = 0;
    if (!S.next(0, cur)) return;
    f32x4 acc[2][2][4][2];
#pragma unroll
    for (int a = 0; a < 2; ++a)
#pragma unroll
        for (int b = 0; b < 2; ++b)
#pragma unroll
            for (int m = 0; m < 4; ++m)
#pragma unroll
                for (int n = 0; n < 2; ++n) acc[a][b][m][n] = (f32x4){0.f, 0.f, 0.f, 0.f};
    bf16x8 At[4][2], B0[2][2], B1[2][2]; i32x8 At8[4], B08[2], B18[2];
    const int sc1 = 0x7F7F7F7F;
    const char* cA = (const char*)g.A + (size_t)cur.pm * tstep; const char* cB = (const char*)g.Bt + (size_t)cur.pn * tstep;
    S.a_ready(cur);
    if constexpr (SP2) {
        PG8_STAGE(PG8_SB(0, 0), cB, voffB); PG8_STAGE(PG8_SB(0, 1), cB + hstep, voffB); PG8_STAGE(PG8_SA(0, 0), cA, voffA); PG8_STAGE(PG8_SA(0, 1), cA + hstep, voffA);
        if (wr == 1) PG8_BAR;
        PG8_WAIT_V(2); PG8_BAR;
        PG8_STAGE(PG8_SB(1, 0), cB + kstep, voffB); PG8_STAGE(PG8_SA(1, 0), cA + kstep, voffA); PG8_STAGE(PG8_SB(1, 1), cB + hstep + kstep, voffB);
        PG8_WAIT_V(6); PG8_BAR;
    } else {
        PG8_STAGE(PG8_SB(0, 0), cB, voffB); PG8_STAGE(PG8_SA(0, 0), cA, voffA); PG8_STAGE(PG8_SB(0, 1), cB + hstep, voffB); PG8_STAGE(PG8_SA(0, 1), cA + hstep, voffA);
        if (wr == 1) PG8_BAR;
        PG8_WAIT_V(4); PG8_BAR;
        PG8_STAGE(PG8_SB(1, 0), cB + kstep, voffB); PG8_STAGE(PG8_SA(1, 0), cA + kstep, voffA); PG8_STAGE(PG8_SB(1, 1), cB + hstep + kstep, voffB);
        PG8_WAIT_V(6); PG8_BAR;
    }
    for (;;) {
        const bool has_next = S.next(ui + 1, nxt);
        const char* nA = has_next ? (const char*)g.A + (size_t)nxt.pm * tstep : cA; const char* nB = has_next ? (const char*)g.Bt + (size_t)nxt.pn * tstep : cB;
        for (int t = 0; t < nt; t += 2) {
            const bool last = (t == nt - 2);
            const char* a1 = cA + (size_t)(t + 1) * kstep;
            const char* a2 = last ? nA : cA + (size_t)(t + 2) * kstep; const char* b2 = last ? nB : cB + (size_t)(t + 2) * kstep;
            const char* a3 = a2 + kstep; const char* b3 = b2 + kstep;
            if (last && has_next) S.a_ready(nxt);
            if constexpr (SP2) {
            PG8_LDB(B0, 0, 0); PG8_LDB(B1, 0, 1); PG8_SCHED; PG8_LDA(At, 0, 0); PG8_STAGE(PG8_SA(1, 1), a1 + hstep, voffA);
            PG8_WAIT_V(8); PG8_WAIT_L(0); PG8_BAR; PG8_MMA(0, 0, At, B0); PG8_MMA(0, 1, At, B1); PG8_BAR; PG8_SCHED;
            PG8_LDA(At, 0, 1); PG8_STAGE(PG8_SB(0, 0), b2, voffB); PG8_STAGE(PG8_SB(0, 1), b2 + hstep, voffB); PG8_STAGE(PG8_SA(0, 0), a2, voffA);
            PG8_WAIT_V(8); PG8_WAIT_L(0); PG8_BAR; PG8_MMA(1, 0, At, B0); PG8_MMA(1, 1, At, B1); PG8_BAR; PG8_SCHED;
            PG8_LDB(B0, 1, 0); PG8_LDB(B1, 1, 1); PG8_SCHED; PG8_LDA(At, 1, 0); PG8_STAGE(PG8_SA(0, 1), a2 + hstep, voffA);
            PG8_WAIT_V(8); PG8_WAIT_L(0); PG8_BAR; PG8_MMA(0, 0, At, B0); PG8_MMA(0, 1, At, B1); PG8_BAR; PG8_SCHED;
            PG8_LDA(At, 1, 1); PG8_STAGE(PG8_SB(1, 0), b3, voffB); PG8_STAGE(PG8_SB(1, 1), b3 + hstep, voffB); PG8_STAGE(PG8_SA(1, 0), a3, voffA);
            PG8_WAIT_V(8); PG8_WAIT_L(0); PG8_BAR; PG8_MMA(1, 0, At, B0); PG8_MMA(1, 1, At, B1); PG8_BAR; PG8_SCHED;
            } else {
            PG8_LDB(B0, 0, 0); PG8_SCHED; PG8_LDA(At, 0, 0); PG8_STAGE(PG8_SA(1, 1), a1 + hstep, voffA);
            PG8_WAIT_L(8); PG8_BAR; PG8_WAIT_L(0); PG8_MMA(0, 0, At, B0); PG8_BAR; PG8_SCHED;
            PG8_LDB(B1, 0, 1); PG8_STAGE(PG8_SB(0, 0), b2, voffB);
            PG8_BAR; PG8_WAIT_L(0); PG8_MMA(0, 1, At, B1); PG8_BAR;
            PG8_LDA(At, 0, 1); PG8_STAGE(PG8_SA(0, 0), a2, voffA);
            PG8_BAR; PG8_WAIT_L(0); PG8_MMA(1, 0, At, B0); PG8_BAR; PG8_SCHED;
            PG8_STAGE(PG8_SB(0, 1), b2 + hstep, voffB);
            PG8_WAIT_V(6); PG8_BAR; PG8_MMA(1, 1, At, B1); PG8_BAR;
            PG8_LDB(B0, 1, 0); PG8_SCHED; PG8_LDA(At, 1, 0); PG8_STAGE(PG8_SA(0, 1), a2 + hstep, voffA);
            PG8_WAIT_L(8); PG8_BAR; PG8_WAIT_L(0); PG8_MMA(0, 0, At, B0); PG8_BAR; PG8_SCHED;
            PG8_LDB(B1, 1, 1); PG8_STAGE(PG8_SB(1, 0), b3, voffB);
            PG8_BAR; PG8_WAIT_L(0); PG8_MMA(0, 1, At, B1); PG8_BAR;
            PG8_LDA(At, 1, 1); PG8_STAGE(PG8_SA(1, 0), a3, voffA);
            PG8_BAR; PG8_WAIT_L(0); PG8_MMA(1, 0, At, B0); PG8_BAR; PG8_SCHED;
            PG8_STAGE(PG8_SB(1, 1), b3 + hstep, voffB);
            PG8_WAIT_V(6); PG8_BAR; PG8_MMA(1, 1, At, B1); PG8_BAR;
            }
        }
        if constexpr (F8) { asm volatile("s_nop 15\n\ts_nop 15" ::: "memory"); }
        if constexpr (ALIGN_EPI) { if (wr == 0) PG8_BAR; }
        if constexpr (!Epi::AFTER_DRAIN) { E(acc, cur, wr, wc, fr, fq); S.done(cur); }
        if (!has_next) break;
#pragma unroll
        for (int a = 0; a < 2; ++a)
#pragma unroll
            for (int b = 0; b < 2; ++b)
#pragma unroll
                for (int m = 0; m < 4; ++m)
#pragma unroll
                    for (int n = 0; n < 2; ++n) acc[a][b][m][n] = (f32x4){0.f, 0.f, 0.f, 0.f};
        cur = nxt; cA = nA; cB = nB; ++ui;
        if constexpr (ALIGN_EPI) { if (wr == 1) PG8_BAR; }
    }
    PG8_WAIT_V(0);
    if constexpr (!ALIGN_EPI) { if (wr == 0) PG8_BAR; }
    PG8_BAR;
    if constexpr (Epi::AFTER_DRAIN) { E.fused(acc, cur, wr, wc, fr, fq, lds, wid, lane); S.done(cur); }
#undef PG8_SA
#undef PG8_SB
#undef PG8_STAGE
#undef PG8_LDA
#undef PG8_LDB
#undef PG8_MMA
#undef PG8_WAIT_V
#undef PG8_WAIT_L
#undef PG8_BAR
#undef PG8_SCHED
}
}

namespace attn_body {
using bf16=__hip_bfloat16;
using bf16x8=__attribute__((ext_vector_type(8)))short;
using s16x4=__attribute__((ext_vector_type(4)))short;
using f32x16=__attribute__((ext_vector_type(16)))float;
using u32x4=__attribute__((ext_vector_type(4)))unsigned;
constexpr int BATCH=8,NHEAD=8,NKV=2,SEQ=2048,D=64,PQ=2304,PO=1024;
constexpr int NW=8,QBLK=32,QB=QBLK*NW,KVBLK=64,NQB=SEQ/QB;
constexpr int ATTN_UNIT_ROWS=QB;
__device__ __forceinline__ int crow(int r,int hi){return (r&3)+8*(r>>2)+4*hi;}
#define SBAR() __builtin_amdgcn_sched_barrier(0)
__device__ __forceinline__ void cmask(f32x16&p0,f32x16&p1,int jb,int qrel,int hi){
  const float NEG=-INFINITY; int kb=64*jb+4*hi;
  #pragma unroll
  for(int r=0;r<16;++r){int kv=kb+(r&3)+8*(r>>2); if(kv>qrel)p0[r]=NEG; if(kv+32>qrel)p1[r]=NEG;}
}

constexpr int NSLOT=3, SLOTB=8192;
constexpr int LDS_K=0, LDS_V=NSLOT*SLOTB, LDS_WS=2*NSLOT*SLOTB, LDS_OST=LDS_WS+NW*64*4, LDS_BYTES=LDS_OST+NW*4096;
constexpr float C2=0.125f*1.4426950408889634f;
__device__ __forceinline__ void glds16(const void*gsrc,unsigned lds_dst){unsigned keep;
  asm volatile("s_mov_b32 %0, m0\n\ts_mov_b32 m0, %2\n\ts_nop 0\n\tglobal_load_lds_dwordx4 %1, off\n\ts_mov_b32 m0, %0":"=&s"(keep):"v"(gsrc),"s"(lds_dst):"memory");}
__device__ __forceinline__ float max3f(float a,float b,float c){float r;asm("v_max3_f32 %0, %1, %2, %3":"=v"(r):"v"(a),"v"(b),"v"(c));return r;}
__device__ __forceinline__ float max2f(float a,float b){float r;asm("v_max_f32_e32 %0, %1, %2":"=v"(r):"v"(a),"v"(b));return r;}
__device__ __forceinline__ float fadd_s(float a,float b){float r;asm("v_add_f32_e32 %0, %1, %2":"=v"(r):"v"(a),"v"(b));return r;}
__device__ __forceinline__ float fsub_s(float a,float b){float r;asm("v_sub_f32_e32 %0, %1, %2":"=v"(r):"v"(a),"v"(b));return r;}
typedef float f32x2_t __attribute__((ext_vector_type(2))); typedef __bf16 bf16x2_t __attribute__((ext_vector_type(2)));
__device__ __forceinline__ unsigned cvtpk_s(float lo,float hi){f32x2_t v={lo,hi};bf16x2_t b=__builtin_convertvector(v,bf16x2_t);return __builtin_bit_cast(unsigned,b);}
#define WAIT_BAR(N) asm volatile("s_waitcnt vmcnt(" #N ") lgkmcnt(0)\n\ts_barrier":::"memory")

__device__ __forceinline__ void qkt(f32x16&p0,f32x16&p1,const char*Kslot,const bf16x8*qr,const f32x16&negm,int r32,int hi){
  const char*kb=Kslot+hi*1024+r32*16;
  #pragma unroll
  for(int d0=0;d0<4;++d0){
    const bf16x8 b0=*reinterpret_cast<const bf16x8*>(kb+d0*2048);
    const bf16x8 b1=*reinterpret_cast<const bf16x8*>(kb+d0*2048+512);
    if(d0==0){p0=__builtin_amdgcn_mfma_f32_32x32x16_bf16(b0,qr[0],negm,0,0,0);p1=__builtin_amdgcn_mfma_f32_32x32x16_bf16(b1,qr[0],negm,0,0,0);}
    else{p0=__builtin_amdgcn_mfma_f32_32x32x16_bf16(b0,qr[d0],p0,0,0,0);p1=__builtin_amdgcn_mfma_f32_32x32x16_bf16(b1,qr[d0],p1,0,0,0);}}
}
typedef __attribute__((address_space(3))) const char* lds_cptr;
typedef short v4i16_t __attribute__((ext_vector_type(4)));
__device__ __forceinline__ void kload8(bf16x8*kf,lds_cptr kp){
  kf[0]=*(const __attribute__((address_space(3))) bf16x8*)(kp);      kf[1]=*(const __attribute__((address_space(3))) bf16x8*)(kp+512);
  kf[2]=*(const __attribute__((address_space(3))) bf16x8*)(kp+2048); kf[3]=*(const __attribute__((address_space(3))) bf16x8*)(kp+2560);
  kf[4]=*(const __attribute__((address_space(3))) bf16x8*)(kp+4096); kf[5]=*(const __attribute__((address_space(3))) bf16x8*)(kp+4608);
  kf[6]=*(const __attribute__((address_space(3))) bf16x8*)(kp+6144); kf[7]=*(const __attribute__((address_space(3))) bf16x8*)(kp+6656);
}
__device__ __forceinline__ void kload2(bf16x8*kf,lds_cptr kp,int j){ kf[2*j]=*(const __attribute__((address_space(3))) bf16x8*)(kp+j*2048); kf[2*j+1]=*(const __attribute__((address_space(3))) bf16x8*)(kp+j*2048+512); }
__device__ __forceinline__ s16x4 vtr(lds_cptr p){ return __builtin_bit_cast(s16x4,__builtin_amdgcn_ds_read_tr16_b64_v4i16((__attribute__((address_space(3))) v4i16_t*)p)); }
__device__ __forceinline__ float rowmax(const f32x16&p0,const f32x16&p1){
  float a=max3f(p0[0],p0[1],p1[0]),b=max3f(p0[2],p0[3],p1[1]);a=max3f(a,p1[2],p1[3]);
  #pragma unroll
  for(int r=4;r<16;r+=4){a=max3f(a,p0[r],p0[r+1]);b=max3f(b,p0[r+2],p0[r+3]);a=max3f(a,p1[r],p1[r+1]);b=max3f(b,p1[r+2],p1[r+3]);}
  const float m=max2f(a,b);
  auto rr=__builtin_amdgcn_permlane32_swap(__float_as_uint(m),__float_as_uint(m),false,false);
  return max2f(__uint_as_float(rr[0]),__uint_as_float(rr[1]));
}
__device__ __forceinline__ void pv(f32x16*o,int vb,bf16x8 pa0,bf16x8 pa1,bf16x8 pa2,bf16x8 pa3){
  #pragma unroll
  for(int d0=0;d0<2;++d0){s16x4 lo[4],hi[4];
    #pragma unroll
    for(int ks=0;ks<4;++ks){
      asm volatile("ds_read_b64_tr_b16 %0,%1 offset:%c2":"=&v"(lo[ks]):"v"(vb),"i"(d0*4096+ks*1024):"memory");
      asm volatile("ds_read_b64_tr_b16 %0,%1 offset:%c2":"=&v"(hi[ks]):"v"(vb),"i"(d0*4096+ks*1024+512):"memory");}
    asm volatile("s_waitcnt lgkmcnt(0)":::"memory");SBAR();
    #define PK(k) (bf16x8){lo[k][0],lo[k][1],lo[k][2],lo[k][3],hi[k][0],hi[k][1],hi[k][2],hi[k][3]}
    o[d0]=__builtin_amdgcn_mfma_f32_32x32x16_bf16(pa0,PK(0),o[d0],0,0,0);
    o[d0]=__builtin_amdgcn_mfma_f32_32x32x16_bf16(pa1,PK(1),o[d0],0,0,0);
    o[d0]=__builtin_amdgcn_mfma_f32_32x32x16_bf16(pa2,PK(2),o[d0],0,0,0);
    o[d0]=__builtin_amdgcn_mfma_f32_32x32x16_bf16(pa3,PK(3),o[d0],0,0,0);
    #undef PK
  }
}

#ifndef ATTN_STORE16
#define ATTN_STORE16(p,v) (*(u32x4*)(p)=(v))
#endif
template<int THRL> __device__ __forceinline__ void attn_unit(int b,int h,int qb,const bf16*Q,const bf16*__restrict__ K,const bf16*__restrict__ V,bf16*O,char*shm){
  const int tid=ltid(),lane=tid&63,r32=lane&31,hi=lane>>5; const int wid=__builtin_amdgcn_readfirstlane(tid>>6);
  const long rowbase=(long)b*SEQ; const int q0=qb*QB;
  const bf16*Qw=Q+(rowbase+q0+wid*QBLK)*PQ+h*D;
  const bf16*Kh=K+rowbase*PQ+(h>>2)*D,*Vh=V+rowbase*PQ+(h>>2)*D;
  const unsigned lds0=(unsigned)(uintptr_t)shm;
  float*wsf=(float*)(shm+LDS_WS)+wid*64;
  const bf16*ksrc=Kh+(long)lane*PQ+wid*8;
  const bf16*vsrc=Vh+(long)(16*(wid&3)+(lane>>2))*PQ+(wid>>2)*32+(lane&3)*8;
  const unsigned kdst=lds0+LDS_K+wid*1024, vdst=lds0+LDS_V+wid*1024;
  #define DMA_K(t,slot) glds16(ksrc+(long)(t)*KVBLK*PQ,(unsigned)__builtin_amdgcn_readfirstlane(kdst+(slot)))
  #define DMA_V(t,slot) glds16(vsrc+(long)(t)*KVBLK*PQ,(unsigned)__builtin_amdgcn_readfirstlane(vdst+(slot)))
  const int vb0=(int)(lds0+LDS_V)+((lane>>4)&1)*32+(lane&3)*8+(4*hi+((lane&15)>>2))*64;
  const char*Kbase=shm+LDS_K; bf16x8 kf[8];
  const lds_cptr shm3=(lds_cptr)shm; const lds_cptr kp0=shm3+LDS_K+hi*1024+r32*16; const lds_cptr vp0=shm3+LDS_V+((lane>>4)&1)*32+(lane&3)*8+(4*hi+((lane&15)>>2))*64;
  const int NT=SEQ/KVBLK;
  DMA_K(0,0);DMA_V(0,0);DMA_K(1,SLOTB);
  bf16x8 qr[4];
  #pragma unroll
  for(int d0=0;d0<4;++d0)qr[d0]=*reinterpret_cast<const bf16x8*>(&Qw[(long)r32*PQ+d0*16+hi*8]);
  float mhat=0.f,l_reg=0.f;f32x16 o[2];o[0]=f32x16{};o[1]=f32x16{};f32x16 negm=f32x16{};asm volatile("":"+v"(negm));
  const int qrel=wid*QBLK+r32;
  #define CMASK(P0,P1,t) do{}while(0)
  bool resc=false;
  #define START(P0,P1) do{ const float rm=rowmax(P0,P1); resc=false; \
    { const float dl=rm; mhat=fadd_s(mhat,dl); \
      _Pragma("unroll") for(int r=0;r<16;++r){P0[r]=fsub_s(P0[r],dl);P1[r]=fsub_s(P1[r],dl);} \
      _Pragma("unroll") for(int r=0;r<16;++r)negm[r]=-mhat; asm volatile("":"+v"(negm)); } \
    _Pragma("unroll") for(int r=0;r<16;++r)P0[r]=__builtin_amdgcn_exp2f(P0[r]); }while(0)
  #define RESC() do{ if(resc){ asm volatile("s_waitcnt lgkmcnt(0)":::"memory"); \
      _Pragma("unroll") for(int d_=0;d_<2;++d_) _Pragma("unroll") for(int r=0;r<16;++r)o[d_][r]*=wsf[crow(r,hi)]; } }while(0)
  f32x16 pA0,pA1,pB0,pB1;
  int sl_prev=0,sl_cur=0,sl_next=SLOTB;
  #define ROT() do{sl_prev=sl_cur;sl_cur=sl_next;sl_next=(sl_next==(NSLOT-1)*SLOTB)?0:sl_next+SLOTB;}while(0)
  DMA_K(2,2*SLOTB);
  WAIT_BAR(3);
  qkt(pA0,pA1,Kbase,qr,negm,r32,hi);asm volatile("s_nop 15\n\ts_nop 7":"+v"(pA0),"+v"(pA1));CMASK(pA0,pA1,0);
  START(pA0,pA1);
  _Pragma("unroll") for(int r=0;r<16;++r)pA1[r]=__builtin_amdgcn_exp2f(pA1[r]);
  WAIT_BAR(0);
  DMA_K(3,0);DMA_V(1,SLOTB);
  ROT();
  kload8(kf,kp0+sl_cur);
  WAIT_BAR(2);
  s16x4 vlo[8],vhi[8]; u32x4 pw0,pw1,pw2,pw3;
  #define PKW(P,B) cvtpk_s(P[B],P[B+1])
  #define PAF(k) __builtin_bit_cast(bf16x8,pw##k)
  #define VFR(i) (bf16x8){vlo[i][0],vlo[i][1],vlo[i][2],vlo[i][3],vhi[i][0],vhi[i][1],vhi[i][2],vhi[i][3]}
  #define PIN(x) asm volatile("":"+v"(x))
  #define MX3(a,b,c) __builtin_fmaxf(__builtin_fmaxf((a),(b)),(c))
  #define GAPA(MF,A0,A1,A2,A3,W0,W1,PW) do{ MF; sacc+=A0; sacc+=A1; sacc+=A2; sacc+=A3; PIN(sacc); W0; W1; PIN(PW); SBAR(); }while(0)
  #define EX(v) __builtin_amdgcn_exp2f(v)
  #define GAPB(MF,X,B) do{ MF; X[B]=EX(X[B]); X[B+1]=EX(X[B+1]); X[B+2]=EX(X[B+2]); X[B+3]=EX(X[B+3]); PIN(X); SBAR(); }while(0)
  #define VRD(i) do{ vlo[i]=vtr(vp_+(((i)>>2)*4096+((i)&3)*1024)); vhi[i]=vtr(vp_+(((i)>>2)*4096+((i)&3)*1024+512)); }while(0)
  #define KRD(G,j) do{ if(G){ kload2(kf,kp0+sl_next,j); SBAR(); } }while(0)
  #define STEP(C0,C1,P0,P1,t,GK,GV,GL) do{ SBAR(); \
    const lds_cptr vp_=vp0+sl_prev; \
    VRD(0); SBAR(); float sacc=(P0[0]+P0[1]); \
    GAPA(C0=__builtin_amdgcn_mfma_f32_32x32x16_bf16(kf[0],qr[0],negm,0,0,0), P0[2],P0[3],P0[4],P0[5],     pw0[0]=PKW(P0,0), pw0[1]=PKW(P0,2), pw0); \
    VRD(4); SBAR(); GAPA(C1=__builtin_amdgcn_mfma_f32_32x32x16_bf16(kf[1],qr[0],negm,0,0,0), P0[6],P0[7],P0[8],P0[9],     pw0[2]=PKW(P0,4), pw0[3]=PKW(P0,6), pw0); \
    VRD(1); SBAR(); GAPA(C0=__builtin_amdgcn_mfma_f32_32x32x16_bf16(kf[2],qr[1],C0,0,0,0),   P0[10],P0[11],P0[12],P0[13], pw1[0]=PKW(P0,8), pw1[1]=PKW(P0,10), pw1); \
    VRD(5); SBAR(); GAPA(C1=__builtin_amdgcn_mfma_f32_32x32x16_bf16(kf[3],qr[1],C1,0,0,0),   P0[14],P0[15],P1[0],P1[1],   pw1[2]=PKW(P0,12),pw1[3]=PKW(P0,14), pw1); \
    VRD(2); SBAR(); GAPA(C0=__builtin_amdgcn_mfma_f32_32x32x16_bf16(kf[4],qr[2],C0,0,0,0),   P1[2],P1[3],P1[4],P1[5],     pw2[0]=PKW(P1,0), pw2[1]=PKW(P1,2), pw2); \
    VRD(6); SBAR(); GAPA(C1=__builtin_amdgcn_mfma_f32_32x32x16_bf16(kf[5],qr[2],C1,0,0,0),   P1[6],P1[7],P1[8],P1[9],     pw2[2]=PKW(P1,4), pw2[3]=PKW(P1,6), pw2); \
    VRD(3); SBAR(); GAPA(C0=__builtin_amdgcn_mfma_f32_32x32x16_bf16(kf[6],qr[3],C0,0,0,0),   P1[10],P1[11],P1[12],P1[13], pw3[0]=PKW(P1,8), pw3[1]=PKW(P1,10), pw3); \
    VRD(7); SBAR(); GAPA(C1=__builtin_amdgcn_mfma_f32_32x32x16_bf16(kf[7],qr[3],C1,0,0,0),   P1[14],P1[15],0.f,0.f,       pw3[2]=PKW(P1,12),pw3[3]=PKW(P1,14), pw3); \
    l_reg+=sacc; \
    if(GK){DMA_K((t)+3,sl_cur);} if(GV){DMA_V((t)+1,sl_next);} \
    CMASK(C0,C1,t); \
    { float a=MX3(C0[0],C0[1],C1[0]),b=MX3(C0[2],C0[3],C1[1]); a=MX3(a,C1[2],C1[3]); \
      _Pragma("unroll") for(int r=4;r<16;r+=4){a=MX3(a,C0[r],C0[r+1]);b=MX3(b,C0[r+2],C0[r+3]);a=MX3(a,C1[r],C1[r+1]);b=MX3(b,C1[r+2],C1[r+3]);} \
      float rm=__builtin_fmaxf(a,b); { auto rr=__builtin_amdgcn_permlane32_swap(__float_as_uint(rm),__float_as_uint(rm),false,false); rm=__builtin_fmaxf(__uint_as_float(rr[0]),__uint_as_float(rr[1])); } \
      resc=false; \
      if(__builtin_expect(__any(rm>(float)THRL),0)){ const float dl=__builtin_fmaxf(rm,0.f); mhat+=dl; \
        _Pragma("unroll") for(int r=0;r<16;++r){C0[r]-=dl;C1[r]-=dl;} \
        _Pragma("unroll") for(int r=0;r<16;++r)negm[r]=-mhat; asm volatile("":"+v"(negm)); \
        const float f=__builtin_amdgcn_exp2f(-dl); l_reg*=f; if(hi==0)wsf[r32]=f; resc=true; } } \
    SBAR(); \
    GAPB(o[0]=__builtin_amdgcn_mfma_f32_32x32x16_bf16(PAF(0),VFR(0),o[0],0,0,0), C0,0); \
    GAPB(o[1]=__builtin_amdgcn_mfma_f32_32x32x16_bf16(PAF(0),VFR(4),o[1],0,0,0), C0,4); \
    KRD(GL,0); GAPB(o[0]=__builtin_amdgcn_mfma_f32_32x32x16_bf16(PAF(1),VFR(1),o[0],0,0,0), C0,8); \
    KRD(GL,1); GAPB(o[1]=__builtin_amdgcn_mfma_f32_32x32x16_bf16(PAF(1),VFR(5),o[1],0,0,0), C0,12); \
    KRD(GL,2); GAPB(o[0]=__builtin_amdgcn_mfma_f32_32x32x16_bf16(PAF(2),VFR(2),o[0],0,0,0), C1,0); \
    KRD(GL,3); GAPB(o[1]=__builtin_amdgcn_mfma_f32_32x32x16_bf16(PAF(2),VFR(6),o[1],0,0,0), C1,4); \
    GAPB(o[0]=__builtin_amdgcn_mfma_f32_32x32x16_bf16(PAF(3),VFR(3),o[0],0,0,0), C1,8); \
    GAPB(o[1]=__builtin_amdgcn_mfma_f32_32x32x16_bf16(PAF(3),VFR(7),o[1],0,0,0), C1,12); \
    }while(0)
  int t=1;
  #undef CMASK
  #define CMASK(P0,P1,t) do{}while(0)
  for(;t+5<NT;t+=2){
    STEP(pB0,pB1,pA0,pA1,t,true,true,true);     WAIT_BAR(2); RESC(); ROT();
    STEP(pA0,pA1,pB0,pB1,t+1,true,true,true);   WAIT_BAR(2); RESC(); ROT();
  }
  #undef CMASK
  #define CMASK(P0,P1,t) do{}while(0)
  #define ENDW(tt) do{ if((tt)+3<NT){WAIT_BAR(2);} else if((tt)+2<NT){WAIT_BAR(1);} else {WAIT_BAR(0);} }while(0)
  for(;t+1<NT;t+=2){
    STEP(pB0,pB1,pA0,pA1,t,(t+3<NT),(t+1<NT),(t+1<NT));       ENDW(t);   RESC(); ROT();
    STEP(pA0,pA1,pB0,pB1,t+1,(t+4<NT),(t+2<NT),(t+2<NT));     ENDW(t+1); RESC(); ROT();
  }
  STEP(pB0,pB1,pA0,pA1,NT-1,false,false,false); RESC();
  { float sacc=pB0[0]+pB0[1]; _Pragma("unroll") for(int r=2;r<16;++r)sacc+=pB0[r]; _Pragma("unroll") for(int r=0;r<16;++r)sacc+=pB1[r]; l_reg+=sacc;
    pw0=(u32x4){PKW(pB0,0),PKW(pB0,2),PKW(pB0,4),PKW(pB0,6)};pw1=(u32x4){PKW(pB0,8),PKW(pB0,10),PKW(pB0,12),PKW(pB0,14)};pw2=(u32x4){PKW(pB1,0),PKW(pB1,2),PKW(pB1,4),PKW(pB1,6)};pw3=(u32x4){PKW(pB1,8),PKW(pB1,10),PKW(pB1,12),PKW(pB1,14)};
    SBAR(); pv(o,vb0+sl_cur,PAF(0),PAF(1),PAF(2),PAF(3)); }
  #undef PKW
  #undef PAF
  #undef VFR
  #undef PIN
  #undef MX3
  #undef GAPA
  #undef GAPB
  #undef EX
  #undef VRD
  #undef KRD
  #undef STEP
  #undef ENDW
  {auto rr=__builtin_amdgcn_permlane32_swap(__float_as_uint(l_reg),__float_as_uint(l_reg),false,false);l_reg=__uint_as_float(rr[0])+__uint_as_float(rr[1]);}
  if(hi==0)wsf[32+r32]=l_reg;asm volatile("s_waitcnt lgkmcnt(0)":::"memory");
  float rli[16];
  #pragma unroll
  for(int r=0;r<16;++r)rli[r]=__builtin_amdgcn_rcpf(wsf[32+crow(r,hi)]);
  bf16*Ow=O+(rowbase+q0+wid*QBLK)*PO+h*D;
  { bf16*stg=(bf16*)(shm+LDS_OST)+wid*2048;
    #pragma unroll
    for(int r=0;r<16;++r){const int orow=crow(r,hi);
      #pragma unroll
      for(int d0=0;d0<2;++d0)stg[orow*64+d0*32+r32]=__float2bfloat16(o[d0][r]*rli[r]);}
    asm volatile("s_waitcnt lgkmcnt(0)":::"memory");
    #pragma unroll
    for(int i=0;i<4;++i){const int row=i*8+(lane>>3),ch=lane&7; const u32x4 v=*(const u32x4*)(stg+row*64+ch*8); ATTN_STORE16(Ow+(long)row*PO+ch*8,v);} }
  asm volatile("s_waitcnt lgkmcnt(0)\n\ts_barrier":::"memory");
  #undef DMA_K
  #undef DMA_V
  #undef CMASK
  #undef START
  #undef RESC
  #undef ROT
}
constexpr int ATTN_LDS_BYTES=LDS_BYTES;
struct AttnTensors { const bf16* Q; const bf16* K; const bf16* V; bf16* O; };
struct AttnUnit { int b; int h; int qb; };
struct StaticOrder {
  int vcu, G;
  __device__ __forceinline__ explicit StaticOrder(int grid,int block):vcu((grid%8==0)?(block%8)*(grid/8)+block/8:block),G(grid){}
  __device__ __forceinline__ bool next(int i,AttnUnit&u)const{ const int L=i*G+vcu; if(L>=BATCH*NHEAD*(SEQ/QB))return false; const int grp=L>>5,r=L&31; u.b=grp>>1; u.h=(grp&1)*4+(r>>3); u.qb=r&7; return true; }
  __device__ __forceinline__ void a_ready(const AttnUnit&)const{}
  __device__ __forceinline__ void done(const AttnUnit&)const{}
};
template<class Sched,int THRL=8> __device__ __forceinline__ void attn_phase(char*lds,const AttnTensors&T,const Sched&S){
  AttnUnit u;
  for(int i=0;S.next(i,u);++i){ S.a_ready(u); attn_unit<THRL>(u.b,u.h,u.qb,T.Q,T.K,T.V,T.O,lds); S.done(u); }
}
#undef SBAR
#undef WAIT_BAR
}


#define GAS __attribute__((address_space(1)))
#define LAS __attribute__((address_space(3)))
typedef unsigned short bf16;
typedef unsigned v4u __attribute__((ext_vector_type(4)));
typedef float f32x4 __attribute__((ext_vector_type(4)));
typedef short bf16x8 __attribute__((ext_vector_type(8)));
typedef GAS unsigned gu32;
typedef GAS unsigned long long gu64;
#define RLX_AGENT __ATOMIC_RELAXED, __HIP_MEMORY_SCOPE_AGENT
#define LDS_WAIT() asm volatile("s_waitcnt lgkmcnt(0)" ::: "memory")
#define VM_WAIT() asm volatile("s_waitcnt vmcnt(0)" ::: "memory")
__device__ __forceinline__ unsigned long long rt() { return __builtin_amdgcn_s_memrealtime(); }
__device__ __forceinline__ unsigned pk2(float lo, float hi) { typedef float f2_ __attribute__((ext_vector_type(2))); typedef __bf16 b2_ __attribute__((ext_vector_type(2))); const f2_ v = {lo, hi}; return __builtin_bit_cast(unsigned, __builtin_convertvector(v, b2_)); }
__device__ __forceinline__ unsigned f2bf(float f) { return pk2(f, 0.f) & 0xffffu; }

#define XB_TMO      128
#define XB_XCNT(j)  (256  + 64 * (j))
#define XB_XSUB(j)  (1280 + 64 * (j))
#define XB_XGEN(j)  (2304 + 64 * (j))
#define XB_TOP      3328
#define XB_TOPGEN   3392
#define XCD_BAR_WORDS 3456
#define XB_SPIN_CAP (1u << 18)

__device__ __forceinline__ unsigned xb_ld(unsigned* p)              { return __hip_atomic_load(p, __ATOMIC_RELAXED, __HIP_MEMORY_SCOPE_AGENT); }
__device__ __forceinline__ unsigned xb_add(unsigned* p, unsigned v) { return __hip_atomic_fetch_add(p, v, __ATOMIC_RELAXED, __HIP_MEMORY_SCOPE_AGENT); }
__device__ __forceinline__ unsigned xb_xcc_id() { return (unsigned)__builtin_amdgcn_s_getreg((3 << 11) | 20) & 0xFu; }
#define XB_SPIN(cond, bar) do { unsigned _sp = 0; while (cond) { __builtin_amdgcn_s_sleep(1); \
    if ((++_sp & 255u) == 0u) { if (xb_ld(&(bar)[XB_TMO])) break; if (_sp > XB_SPIN_CAP) { atomicAdd(&(bar)[XB_TMO], 1u); break; } } } } while (0)

struct XcdBarrier {
    unsigned* bar; unsigned x;
    volatile LAS unsigned* st;
};

__device__ __forceinline__ XcdBarrier xcd_barrier_post(unsigned* bar, volatile LAS unsigned* st) {
    XcdBarrier b; b.bar = bar; b.x = xb_xcc_id(); b.st = st;
    if (threadIdx.x == 0) (void)xb_add(&bar[XB_XCNT(b.x)], 1u);
    return b;
}
__device__ __forceinline__ void xcd_barrier_complete(unsigned* bar, unsigned x, unsigned& nloc, unsigned& nx) {
    const unsigned G = gridDim.x * gridDim.y * gridDim.z;
    unsigned sum, cnt, mine, sp = 0u;
    for (;;) {
        sum = 0u; cnt = 0u; mine = 0u;
        unsigned cj[16];
#pragma unroll
        for (unsigned j = 0; j < 16; ++j) cj[j] = xb_ld(&bar[XB_XCNT(j)]);
#pragma unroll
        for (unsigned j = 0; j < 16; ++j) { const unsigned c = cj[j]; sum += c; cnt += (c > 0u) ? 1u : 0u; mine = (j == x) ? c : mine; }
        if (sum == G) break;
        __builtin_amdgcn_s_sleep(1);
        if ((++sp & 255u) == 0u) { if (xb_ld(&bar[XB_TMO])) break; if (sp > XB_SPIN_CAP) { atomicAdd(&bar[XB_TMO], 1u); break; } }
    }
    nloc = mine > 0u ? mine : 1u; nx = cnt > 0u ? cnt : 1u;
}

__device__ __forceinline__ void xcd_barrier(const XcdBarrier& b) {
    asm volatile("s_waitcnt vmcnt(0)" ::: "memory");
    __syncthreads();
    if (threadIdx.x == 0) {
        unsigned* bar = b.bar;
        __builtin_amdgcn_s_waitcnt(0);
        unsigned nloc = b.st[0], nx = b.st[1];
        if (nloc == 0u) { xcd_barrier_complete(bar, b.x, nloc, nx); b.st[0] = nloc; b.st[1] = nx; }
        const unsigned old = xb_add(&bar[XB_XSUB(b.x)], 1u);
        const unsigned gen = old / nloc;
        if (old + 1u == (gen + 1u) * nloc) {
            __builtin_amdgcn_fence(__ATOMIC_RELEASE, "agent");
            asm volatile("s_waitcnt vmcnt(0)" ::: "memory");
            const unsigned og = xb_add(&bar[XB_TOP], 1u);
            const unsigned tg = og / nx;
            if (og + 1u == (tg + 1u) * nx) xb_add(&bar[XB_TOPGEN], 1u);
            else XB_SPIN(xb_ld(&bar[XB_TOPGEN]) == tg, bar);
            __builtin_amdgcn_fence(__ATOMIC_ACQUIRE, "agent");
            xb_add(&bar[XB_XGEN(b.x)], 1u);
            asm volatile("s_waitcnt vmcnt(0)" ::: "memory");
        } else {
            XB_SPIN(xb_ld(&bar[XB_XGEN(b.x)]) == gen, bar);
            __builtin_amdgcn_fence(__ATOMIC_ACQUIRE, "agent");
            asm volatile("s_waitcnt vmcnt(0)" ::: "memory");
        }
    }
    __syncthreads();
}

#ifndef MK_PER_PHASE
#define MK_PER_PHASE 0
#endif
constexpr int NWAVES = 8, NTHR = 512;
constexpr int DM = 1024, NB = 8, SEQ = 2048, DEPTH = 4, M = NB * SEQ;
constexpr int DIN = 2320, NPROJ = 2304;
constexpr int C_Q = 0, C_K = 512, C_V = 640, C_LX = 768, C_LG = 1024, C_MQ = 1280, C_MK = 1536, C_MV = 1792, C_MO = 2048;
constexpr int NE = 16, CAP = 256, DE = 2048, NSLOT = NB * CAP;
constexpr float EPS = 1e-6f;
constexpr int NPH = 1 + 10 * DEPTH;

constexpr size_t MiB = 1u << 20;
constexpr size_t WS_CTL = 0, CTL_ZERO_BYTES = 1 * MiB;
constexpr size_t WS_ROPE = 1 * MiB;
constexpr size_t WS_LRUW = 2 * MiB;
constexpr size_t WS_WIN = 4 * MiB;
constexpr size_t WS_WOUT = 22 * MiB;
constexpr size_t WS_WGU = 32 * MiB;
constexpr size_t WS_WDN = 544 * MiB;
constexpr size_t WS_H = 800 * MiB;
constexpr size_t WS_PROJ = 832 * MiB;
constexpr size_t WS_Y = 904 * MiB;
constexpr size_t WS_MG = 936 * MiB;
constexpr size_t WS_AFF = 937 * MiB;
constexpr size_t WS_SEL = 938 * MiB;
constexpr size_t WS_IDX = 939 * MiB;
constexpr size_t WS_GATE = WS_IDX + 128 * 1024;
constexpr size_t WS_LH = 940 * MiB;
constexpr size_t WS_CP = 956 * MiB;
constexpr size_t WS_CARRY = 972 * MiB;
constexpr size_t WS_CLOC = 974 * MiB;
constexpr size_t WS_NLOC = 990 * MiB;
constexpr size_t WS_MLOC = WS_NLOC + 512 * 1024;
constexpr size_t WS_XG = 992 * MiB;
constexpr size_t WS_HID = 1056 * MiB;
constexpr size_t WS_YE = 1184 * MiB;
constexpr size_t WS_CPREV = 1280 * MiB;
constexpr size_t WS_NPREV = 1288 * MiB;
constexpr size_t WS_MPREV = WS_NPREV + 512 * 1024;
constexpr size_t WS_XB = 1248 * MiB;
constexpr size_t WS_END = 1290 * MiB;
constexpr int CW_BAR = 4096;

constexpr int RING_OFF = 0, RING_BYTES = 143360;
constexpr int MISC_OFF = RING_BYTES;
constexpr int LDS_BYTES = 147456;

typedef unsigned u32x2 __attribute__((ext_vector_type(2)));
__device__ __forceinline__ float bf2f(unsigned short v) { return __uint_as_float(((unsigned)v) << 16); }
__device__ __forceinline__ float bflo(unsigned v) { return __uint_as_float(v << 16); }
__device__ __forceinline__ float bfhi(unsigned v) { return __uint_as_float(v & 0xffff0000u); }
template <int CTRL> __device__ __forceinline__ float dppf(float v) { return __uint_as_float((unsigned)__builtin_amdgcn_update_dpp(0, (int)__float_as_uint(v), CTRL, 0xF, 0xF, true)); }
__device__ __forceinline__ float row16_sum(float v) { v += dppf<0xB1>(v); v += dppf<0x4E>(v); v += dppf<0x141>(v); v += dppf<0x140>(v); return v; }
__device__ __forceinline__ float xor16_sum(float v) { const auto r = __builtin_amdgcn_permlane16_swap(__float_as_uint(v), __float_as_uint(v), false, false); return __uint_as_float(r[0]) + __uint_as_float(r[1]); }
__device__ __forceinline__ float xor32_sum(float v) { const auto r = __builtin_amdgcn_permlane32_swap(__float_as_uint(v), __float_as_uint(v), false, false); return __uint_as_float(r[0]) + __uint_as_float(r[1]); }
__device__ __forceinline__ float half_sum(float v) { return xor16_sum(row16_sum(v)); }
__device__ __forceinline__ float wave_sum(float v) { return xor32_sum(xor16_sum(row16_sum(v))); }
__device__ __forceinline__ void reduce16(const float (&p)[16], float (&r)[4]) {
    float q[8];
#pragma unroll
    for (int j = 0; j < 8; ++j) { const auto t = __builtin_amdgcn_permlane32_swap(__float_as_uint(p[j]), __float_as_uint(p[j + 8]), false, false); q[j] = __uint_as_float(t[0]) + __uint_as_float(t[1]); }
#pragma unroll
    for (int j = 0; j < 4; ++j) { const auto t = __builtin_amdgcn_permlane16_swap(__float_as_uint(q[j]), __float_as_uint(q[j + 4]), false, false); r[j] = row16_sum(__uint_as_float(t[0]) + __uint_as_float(t[1])); }
}
__device__ __forceinline__ float wave_max(float v) {
#pragma unroll
    for (int o = 1; o < 64; o <<= 1) v = fmaxf(v, __shfl_xor(v, o));
    return v;
}
__device__ __forceinline__ float fexp(float x) { return __builtin_amdgcn_exp2f(1.4426950408889634f * x); }
__device__ __forceinline__ float frcp(float x) { return __builtin_amdgcn_rcpf(x); }
__device__ __forceinline__ float frsq(float x) { return __builtin_amdgcn_rsqf(x); }
__device__ __forceinline__ float sigmoid_f(float x) { return frcp(1.0f + fexp(-x)); }
__device__ __forceinline__ float one_minus_exp(float x) {
    const float p = -x * (1.0f + 0.5f * x * (1.0f + (1.0f / 3.0f) * x * (1.0f + 0.25f * x * (1.0f + 0.2f * x))));
    return (x > -0.25f) ? p : 1.0f - fexp(x); }
__device__ __forceinline__ float logsig_f(float x) { return fminf(x, 0.f) - log1pf(expf(-fabsf(x))); }
__device__ __forceinline__ float gelu_tanh_f(float x) { const float u = 0.7978845608028654f * (x + 0.044715f * x * x * x); return x * (1.0f - frcp(1.0f + fexp(2.0f * u))); }
template <bool MAXOP, bool REV> __device__ __forceinline__ void wave_scan128(const LAS float* in, LAS float* out, int lane) {
    const int j0 = REV ? 127 - 2 * lane : 2 * lane, j1 = REV ? 126 - 2 * lane : 2 * lane + 1;
    const float a = in[j0], b = in[j1];
    const float s1 = MAXOP ? fmaxf(a, b) : a + b;
    float incl = s1;
#pragma unroll
    for (int o = 1; o < 64; o <<= 1) { const float t = __shfl_up(incl, o); if (lane >= o) incl = MAXOP ? fmaxf(incl, t) : incl + t; }
    const float ex = __shfl_up(incl, 1);
    const float e = (lane == 0) ? (MAXOP ? -INFINITY : 0.f) : ex;
    out[j0] = MAXOP ? fmaxf(e, a) : e + a; out[j1] = MAXOP ? fmaxf(e, s1) : e + s1;
}
#define WAVE_LDS_FENCE() asm volatile("s_waitcnt lgkmcnt(0)" ::: "memory")
#define MFMA16(a, b, c) __builtin_amdgcn_mfma_f32_16x16x32_bf16((a), (b), (c), 0, 0, 0)
#define WG_SYNC() __syncthreads()

struct Args { const float* in[22]; float* out; unsigned char* ws; int ph_lo, ph_hi, li, pad; };
enum { I_X = 0, I_N1G, I_WIN, I_QG, I_KG, I_CW, I_CB, I_WA, I_BA, I_WX, I_BX, I_LAM, I_FB, I_MNG, I_AOG, I_LOG, I_WOUT, I_N2G, I_WR, I_WG, I_WU, I_WD };

__device__ __forceinline__ void cvt_item(const float* __restrict__ src, int N, int k0, int n0, bf16* dst, int Kd, LAS float* scr, int lane) {
    { const int r4 = lane >> 4, c4 = lane & 15; f32x4 t[16];
#pragma unroll
      for (int i = 0; i < 16; ++i) t[i] = __builtin_nontemporal_load((const f32x4*)(src + (size_t)(k0 + 4 * i + r4) * N + n0 + 4 * c4));
#pragma unroll
      for (int i = 0; i < 16; ++i) { LAS float* d = scr + (4 * i + r4) * 65 + 4 * c4; d[0] = t[i][0]; d[1] = t[i][1]; d[2] = t[i][2]; d[3] = t[i][3]; } }
    LDS_WAIT(); asm volatile("" ::: "memory");
    const int c = lane >> 3, nn = lane & 7;
#pragma unroll
    for (int j = 0; j < 8; ++j) { const int n = nn + 8 * j; const LAS float* s = scr + (8 * c) * 65 + n;
        v4u o; o.x = pk2(s[0], s[65]); o.y = pk2(s[130], s[195]); o.z = pk2(s[260], s[325]); o.w = pk2(s[390], s[455]);
        *(GAS v4u*)(dst + (size_t)n * Kd + 8 * c) = o; }
    LDS_WAIT(); asm volatile("" ::: "memory");
}
__device__ __forceinline__ void cvt_item8(const float* __restrict__ src, int N, int k0, int n0, unsigned char* dst, int Kd, LAS float* scr, int lane) {
    { const int r8 = lane >> 3, c8 = lane & 7; f32x4 t[16];
#pragma unroll
      for (int i = 0; i < 16; ++i) t[i] = __builtin_nontemporal_load((const f32x4*)(src + (size_t)(k0 + 8 * i + r8) * N + n0 + 4 * c8));
#pragma unroll
      for (int i = 0; i < 16; ++i) { LAS float* d = scr + (8 * i + r8) * 33 + 4 * c8; d[0] = t[i][0]; d[1] = t[i][1]; d[2] = t[i][2]; d[3] = t[i][3]; } }
    LDS_WAIT(); asm volatile("" ::: "memory");
    const int c = lane >> 3, nn = lane & 7; constexpr float sc = pg8::WSCALE;
#pragma unroll
    for (int j = 0; j < 4; ++j) { const int n = nn + 8 * j; const LAS float* s = scr + (16 * c) * 33 + n;
        v4u o; o.x = pg8::pk4_fp8(s[0] * sc, s[33] * sc, s[66] * sc, s[99] * sc); o.y = pg8::pk4_fp8(s[132] * sc, s[165] * sc, s[198] * sc, s[231] * sc);
        o.z = pg8::pk4_fp8(s[264] * sc, s[297] * sc, s[330] * sc, s[363] * sc); o.w = pg8::pk4_fp8(s[396] * sc, s[429] * sc, s[462] * sc, s[495] * sc);
        *(GAS v4u*)(dst + (size_t)n * Kd + 16 * c) = o; }
    LDS_WAIT(); asm volatile("" ::: "memory");
}
__device__ __forceinline__ void p0_weights(const Args& a, LAS unsigned char* lds, int tid, int lane, int wave, int G, int bid) {
    unsigned char* ws = a.ws;
    LAS float* scr = (LAS float*)(lds + RING_OFF + wave * 16896);
    const int gw = bid * NWAVES + wave, NGW = G * NWAVES;
    constexpr int I_IN = 16 * 36, I_OUT = 16 * 16, I_EXP = 1536, PER_LAYER = I_IN + I_OUT + NE * I_EXP, NITEMS = DEPTH * PER_LAYER;
    for (int it = gw; it < NITEMS; it += NGW) {
        const int l = it / PER_LAYER; int r = it - l * PER_LAYER;
        if (r < I_IN) { const int kb = r / 36, nb = r - kb * 36;
            cvt_item(a.in[I_WIN] + (size_t)l * DM * DIN, DIN, 64 * kb, 64 * nb, (bf16*)(ws + WS_WIN) + ((size_t)l * NPROJ + 64 * nb) * DM + 64 * kb, DM, scr, lane); continue; }
        r -= I_IN;
        if (r < I_OUT) { const int kb = r >> 4, nb = r & 15;
            cvt_item(a.in[I_WOUT] + (size_t)l * DM * DM, DM, 64 * kb, 64 * nb, (bf16*)(ws + WS_WOUT) + ((size_t)l * DM + 64 * nb) * DM + 64 * kb, DM, scr, lane); continue; }
        r -= I_OUT;
        const int e = r / I_EXP; int r2 = r - e * I_EXP; const size_t le = (size_t)l * NE + e;
        LAS float* scr8 = (LAS float*)(lds + RING_OFF + wave * 16896);
        if (r2 < 1024) { const int up = r2 >> 9; r2 &= 511; const int kb = r2 >> 6, nb = r2 & 63, n0 = 32 * nb, drow = 256 * (n0 >> 7) + (n0 & 127) + 128 * up;
            cvt_item8(a.in[up ? I_WU : I_WG] + le * DM * DE, DE, 128 * kb, n0, ws + WS_WGU + (le * 4096 + drow) * DM + 128 * kb, DM, scr8, lane); continue; }
        r2 -= 1024; { const int kb = r2 >> 5, nb = r2 & 31;
            cvt_item8(a.in[I_WD] + le * DE * DM, DM, 128 * kb, 32 * nb, ws + WS_WDN + (le * DM + 32 * nb) * DE + 128 * kb, DE, scr8, lane); }
    }
    const int gt = bid * NTHR + tid, GT = G * NTHR;
    bf16* lw = (bf16*)(ws + WS_LRUW);
    for (int i = gt; i < DEPTH * 2 * 2 * 4 * 4096; i += GT) { const int d = i & 63, e = (i >> 6) & 63, n = (i >> 12) & 3, gate = (i >> 14) & 1, dir = (i >> 15) & 1, l = i >> 16;
        const float* src = a.in[gate ? I_WX : I_WA]; lw[i] = (bf16)f2bf(src[((((size_t)l * 2 + dir) * 4 + n) * 64 + d) * 64 + e]); }
    float* rc = (float*)(ws + WS_ROPE); float* rs = rc + SEQ * 32;
    for (int i = gt; i < SEQ * 32; i += GT) { const int s = i >> 5, j = i & 31, f = j & 15; const float pos = (float)((j < 16) ? (s >> 6) : (s & 63));
        const float inv = 1.0f / powf(10000.0f, (float)f * (1.0f / 16.0f)); const float ang = pos * inv; rc[i] = cosf(ang); rs[i] = sinf(ang); }
}

__device__ __forceinline__ void stage_w16(const float* WT, int sk, LAS unsigned char* lds, int tid) {
    constexpr int WLS = 1028; LAS float* wl = (LAS float*)(lds + RING_OFF); float wv[32];
#pragma unroll
    for (int q = 0; q < 32; ++q) { const int i = tid + q * NTHR; wv[q] = WT[(size_t)(i >> 4) * sk + (i & 15)]; }
#pragma unroll
    for (int q = 0; q < 32; ++q) { const int i = tid + q * NTHR; wl[(i & 15) * WLS + (i >> 4)] = wv[q]; }
}
template <int MODE, bool XB16, bool PRESTAGED = false>
__device__ __forceinline__ void row_pass(const void* xin_, void* xout_, const float* gain, const float* WT  , int sk, bf16* H, float* O16, const int* SEL, const bf16* YE,
                                         LAS unsigned char* lds, int tid, int lane, int wave, int G, int bid) {
    constexpr int WLS = 1028;
    LAS float* wl = (LAS float*)(lds + RING_OFF);
    if (MODE != 3 && !(PRESTAGED && !MK_PER_PHASE)) stage_w16(WT, sk, lds, tid);
    WG_SYNC();
    const int gw = bid * NWAVES + wave, NGW = G * NWAVES;
    f32x4 gq4[4];
#pragma unroll
    for (int j = 0; j < 4; ++j) gq4[j] = (MODE != 3) ? *((const f32x4*)gain + 64 * j + lane) : (f32x4){0.f, 0.f, 0.f, 0.f};
    constexpr int R = 4;
    for (int m0 = R * gw; m0 < M; m0 += R * NGW) {
        asm volatile("" ::: "memory");
        f32x4 v[R][4];
#pragma unroll
        for (int r = 0; r < R; ++r)
#pragma unroll
            for (int j = 0; j < 4; ++j) {
                if (XB16) { const u32x2 q = *((const u32x2*)((const bf16*)xin_ + (size_t)(m0 + r) * DM) + 64 * j + lane); v[r][j] = (f32x4){bflo(q.x), bfhi(q.x), bflo(q.y), bfhi(q.y)}; }
                else v[r][j] = *((const f32x4*)((const float*)xin_ + (size_t)(m0 + r) * DM) + 64 * j + lane); }
        if (MODE >= 2) {
            const int b = m0 >> 11; int selv[R]; unsigned long long mk[R];
#pragma unroll
            for (int r = 0; r < R; ++r) { selv[r] = (lane < NE) ? SEL[(size_t)(m0 + r) * NE + lane] : -1; }
#pragma unroll
            for (int r = 0; r < R; ++r) mk[r] = __ballot(selv[r] >= 0);
            while (mk[0] | mk[1] | mk[2] | mk[3]) {
                u32x2 q[R][2][4]; float wt[R][2];
#pragma unroll
                for (int r = 0; r < R; ++r)
#pragma unroll
                    for (int i = 0; i < 2; ++i) { const bf16* yr = YE; wt[r][i] = 0.f;
                        if (mk[r]) { const int e = __builtin_ctzll(mk[r]); mk[r] &= mk[r] - 1ull; const int sl = __builtin_amdgcn_readlane(selv[r], e);
                            yr = YE + ((size_t)e * NSLOT + b * CAP + sl) * DM; wt[r][i] = 1.f; }
#pragma unroll
                        for (int j = 0; j < 4; ++j) q[r][i][j] = *((const u32x2*)yr + 64 * j + lane); }
#pragma unroll
                for (int r = 0; r < R; ++r)
#pragma unroll
                    for (int i = 0; i < 2; ++i)
#pragma unroll
                        for (int j = 0; j < 4; ++j) { const u32x2 w = q[r][i][j]; const float t = wt[r][i];
                            v[r][j][0] += t * bflo(w.x); v[r][j][1] += t * bfhi(w.x); v[r][j][2] += t * bflo(w.y); v[r][j][3] += t * bfhi(w.y); }
            }
#pragma unroll
            for (int r = 0; r < R; ++r)
#pragma unroll
                for (int j = 0; j < 4; ++j) {
                    if (MODE == 3) *((f32x4*)((float*)xout_ + (size_t)(m0 + r) * DM) + 64 * j + lane) = v[r][j];
                    else { u32x2 o; o.x = pk2(v[r][j][0], v[r][j][1]); o.y = pk2(v[r][j][2], v[r][j][3]); *((u32x2*)((bf16*)xout_ + (size_t)(m0 + r) * DM) + 64 * j + lane) = o;
                        v[r][j] = (f32x4){bflo(o.x), bfhi(o.x), bflo(o.y), bfhi(o.y)}; } }
        }
        if (MODE == 3) continue;
        float ss[R];
#pragma unroll
        for (int r = 0; r < R; ++r) { float a = 0.f;
#pragma unroll
            for (int j = 0; j < 4; ++j) a += (v[r][j][0] * v[r][j][0] + v[r][j][1] * v[r][j][1]) + (v[r][j][2] * v[r][j][2] + v[r][j][3] * v[r][j][3]);
            ss[r] = wave_sum(a); }
#pragma unroll
        for (int r = 0; r < R; ++r) { const float rstd = frsq(ss[r] * (1.0f / DM) + EPS);
#pragma unroll
            for (int j = 0; j < 4; ++j) { v[r][j] = v[r][j] * rstd * gq4[j];
                if (MODE == 1) { *((unsigned*)((unsigned char*)H + (size_t)(m0 + r) * DM) + 64 * j + lane) = pg8::pk4_fp8(v[r][j][0], v[r][j][1], v[r][j][2], v[r][j][3]); }
                else { u32x2 o; o.x = pk2(v[r][j][0], v[r][j][1]); o.y = pk2(v[r][j][2], v[r][j][3]); *((u32x2*)(H + (size_t)(m0 + r) * DM) + 64 * j + lane) = o; } } }
        typedef float f32x2_ __attribute__((ext_vector_type(2)));
        float t4[R][4];
#pragma unroll
        for (int j4 = 0; j4 < 4; ++j4) { float pp[4][R];
#pragma unroll
            for (int h = 0; h < 4; ++h) { const int jj = j4 + 4 * h; f32x2_ a2[R];
#pragma unroll
                for (int r = 0; r < R; ++r) a2[r] = (f32x2_){0.f, 0.f};
#pragma unroll
                for (int j = 0; j < 4; ++j) { const f32x4 w = *((LAS f32x4*)(wl + jj * WLS) + 64 * j + lane); const f32x2_ wlo = (f32x2_){w[0], w[1]}, whi = (f32x2_){w[2], w[3]};
#pragma unroll
                    for (int r = 0; r < R; ++r) { a2[r] += (f32x2_){v[r][j][0], v[r][j][1]} * wlo; a2[r] += (f32x2_){v[r][j][2], v[r][j][3]} * whi; } }
#pragma unroll
                for (int r = 0; r < R; ++r) pp[h][r] = a2[r][0] + a2[r][1]; }
#pragma unroll
            for (int r = 0; r < R; ++r) {
                const auto ta = __builtin_amdgcn_permlane32_swap(__float_as_uint(pp[0][r]), __float_as_uint(pp[2][r]), false, false); const float qa = __uint_as_float(ta[0]) + __uint_as_float(ta[1]);
                const auto tb = __builtin_amdgcn_permlane32_swap(__float_as_uint(pp[1][r]), __float_as_uint(pp[3][r]), false, false); const float qb = __uint_as_float(tb[0]) + __uint_as_float(tb[1]);
                const auto tc = __builtin_amdgcn_permlane16_swap(__float_as_uint(qa), __float_as_uint(qb), false, false); t4[r][j4] = row16_sum(__uint_as_float(tc[0]) + __uint_as_float(tc[1])); }
            __builtin_amdgcn_sched_barrier(0); }
#pragma unroll
        for (int r = 0; r < R; ++r) { const int m = m0 + r;
            const int li = lane & 15, rho = lane >> 4, jj = (li & 3) + 4 * (rho & 1) + 8 * (rho >> 1);
            if (MODE == 1) {
                const float lm = fmaxf(fmaxf(t4[r][0], t4[r][1]), fmaxf(t4[r][2], t4[r][3]));
                const auto ta = __builtin_amdgcn_permlane16_swap(__float_as_uint(lm), __float_as_uint(lm), false, false); const float m1 = fmaxf(__uint_as_float(ta[0]), __uint_as_float(ta[1]));
                const auto tb = __builtin_amdgcn_permlane32_swap(__float_as_uint(m1), __float_as_uint(m1), false, false); const float mx = fmaxf(__uint_as_float(tb[0]), __uint_as_float(tb[1]));
                const float e0 = fexp(t4[r][0] - mx), e1 = fexp(t4[r][1] - mx), e2 = fexp(t4[r][2] - mx), e3 = fexp(t4[r][3] - mx);
                const float sum = xor32_sum(xor16_sum((e0 + e1) + (e2 + e3)));
                const float mine = (li & 3) == 0 ? e0 : (li & 3) == 1 ? e1 : (li & 3) == 2 ? e2 : e3;
                if (li < 4) O16[(((size_t)(m >> 11) * NE + jj) << 11) + (m & 2047)] = mine / sum;
            } else {
#pragma unroll
                for (int j = 0; j < 4; ++j) if (li == j) O16[(size_t)m * 16 + jj] = t4[r][j];
            } }
    }
}

__device__ __forceinline__ void rope_pass(const Args& a, int l, int lane, int wave, int G, int bid, bf16* DST) {
    const bf16* PROJ = (const bf16*)(a.ws + WS_PROJ); const float* rc = (const float*)(a.ws + WS_ROPE); const float* rs = rc + SEQ * 32;
    const float* qg = a.in[I_QG] + l * 64; const float* kg = a.in[I_KG] + l * 64;
    const int gw = bid * NWAVES + wave, NGW = G * NWAVES, hslot = lane >> 3, l8 = lane & 7;
    const f32x4 gq1 = *(const f32x4*)(qg + 4 * l8) * attn_body::C2, gq2 = *(const f32x4*)(qg + 32 + 4 * l8) * attn_body::C2;
    const f32x4 gk1 = *(const f32x4*)(kg + 4 * l8), gk2 = *(const f32x4*)(kg + 32 + 4 * l8);
    for (int mb = 4 * gw; mb < M; mb += 4 * NGW) {
        u32x2 xa[5], xb[5]; f32x4 cs[5], sn[5];
#pragma unroll
        for (int it = 0; it < 5; ++it) { const int hh = 8 * it + hslot, tok = (hh * 205) >> 11, head = hh - 10 * tok; const size_t m = (size_t)(mb + tok); const int s = (int)(m & 2047);
            const bf16* row = PROJ + m * NPROJ + head * 64 + 4 * l8; xa[it] = *(const u32x2*)row; xb[it] = *(const u32x2*)(row + 32);
            cs[it] = *(const f32x4*)(rc + s * 32 + 4 * l8); sn[it] = *(const f32x4*)(rs + s * 32 + 4 * l8); }
#pragma unroll
        for (int it = 0; it < 5; ++it) { const int hh = 8 * it + hslot, tok = (hh * 205) >> 11, head = hh - 10 * tok; const size_t m = (size_t)(mb + tok);
            const f32x4 x1 = (f32x4){bflo(xa[it].x), bfhi(xa[it].x), bflo(xa[it].y), bfhi(xa[it].y)}, x2 = (f32x4){bflo(xb[it].x), bfhi(xb[it].x), bflo(xb[it].y), bfhi(xb[it].y)};
            float ss = ((x1[0] * x1[0] + x1[1] * x1[1]) + (x1[2] * x1[2] + x1[3] * x1[3])) + ((x2[0] * x2[0] + x2[1] * x2[1]) + (x2[2] * x2[2] + x2[3] * x2[3]));
            ss += dppf<0xB1>(ss); ss += dppf<0x4E>(ss); ss += dppf<0x141>(ss);
            const float rstd = frsq(ss * (1.0f / 64.0f) + EPS);
            const bool isk = head >= 8; const f32x4 g1 = isk ? gk1 : gq1, g2 = isk ? gk2 : gq2;
            const f32x4 n1 = x1 * rstd * g1, n2 = x2 * rstd * g2;
            const f32x4 o1 = n1 * cs[it] - n2 * sn[it], o2 = n2 * cs[it] + n1 * sn[it];
            bf16* orow = DST + m * NPROJ + head * 64 + 4 * l8;
            u32x2 w1, w2; w1.x = pk2(o1[0], o1[1]); w1.y = pk2(o1[2], o1[3]); w2.x = pk2(o2[0], o2[1]); w2.y = pk2(o2[2], o2[3]);
            *(u32x2*)orow = w1; *(u32x2*)(orow + 32) = w2; }
    }
}

constexpr int XS = 260;
constexpr int XSB = 264;
__device__ __forceinline__ void lru_a_unit(const Args& a, int l, int unit, LAS unsigned char* lds, int tid, int lane, int wave) {
    const int b = unit >> 6, c32 = unit & 63, t0 = c32 * 32; const size_t m0 = (size_t)b * SEQ + t0;
    LAS bf16* XCb = (LAS bf16*)(lds + RING_OFF);
    LAS float* AA = (LAS float*)(lds + RING_OFF + 32 * XSB * 2);
    LAS bf16* UUb = (LAS bf16*)(AA + 2 * 32 * XS);
    const bf16* PROJ = (const bf16*)(a.ws + WS_PROJ);
    const int n = wave >> 1, hh = wave & 1, li = lane & 15, g = lane >> 4;
    bf16x8 wfr[2][2][2][2];
#pragma unroll
    for (int dir = 0; dir < 2; ++dir)
#pragma unroll
        for (int gate = 0; gate < 2; ++gate) { const bf16* W = (const bf16*)(a.ws + WS_LRUW) + ((((size_t)l * 2 + dir) * 2 + gate) * 4 + n) * 4096;
#pragma unroll
            for (int nt = 0; nt < 2; ++nt)
#pragma unroll
                for (int ks = 0; ks < 2; ++ks) wfr[dir][gate][nt][ks] = *(const bf16x8*)(W + (32 * hh + 16 * nt + li) * 64 + 32 * ks + 8 * g); }
    float bav[2][2], bxv[2][2], lamv[2][2];
#pragma unroll
    for (int dir = 0; dir < 2; ++dir)
#pragma unroll
        for (int nt = 0; nt < 2; ++nt) { const size_t pi = ((size_t)l * 2 + dir) * 256 + 64 * n + 32 * hh + 16 * nt + li; bav[dir][nt] = a.in[I_BA][pi]; bxv[dir][nt] = a.in[I_BX][pi]; lamv[dir][nt] = a.in[I_LAM][pi]; }
    {
        const int ch2 = tid & 127, rg = tid >> 7, ch = 2 * ch2;
        float x0[11], x1[11];
#pragma unroll
        for (int i = 0; i < 11; ++i) { const int s = t0 + rg * 8 - 2 + i; unsigned v = 0u;
            if (s >= 0 && s < SEQ) v = *(const unsigned*)(PROJ + ((size_t)b * SEQ + s) * NPROJ + C_LX + ch);
            x0[i] = bflo(v); x1[i] = bfhi(v); }
        const float* cw = a.in[I_CW] + (size_t)l * 4 * 256; const float* cb = a.in[I_CB] + (size_t)l * 256;
        float w0[4], w1[4];
#pragma unroll
        for (int j = 0; j < 4; ++j) { w0[j] = cw[j * 256 + ch]; w1[j] = cw[j * 256 + ch + 1]; }
        const float b0 = cb[ch], b1 = cb[ch + 1];
#pragma unroll
        for (int r = 0; r < 8; ++r) { float y0 = b0, y1 = b1;
#pragma unroll
            for (int j = 0; j < 4; ++j) { y0 += x0[r + j] * w0[j]; y1 += x1[r + j] * w1[j]; }
            *(LAS unsigned*)(XCb + (rg * 8 + r) * XSB + ch) = pk2(y0, y1); }
    }
    WG_SYNC();
    bf16x8 af[2][2];
#pragma unroll
    for (int mt = 0; mt < 2; ++mt)
#pragma unroll
        for (int ks = 0; ks < 2; ++ks) af[mt][ks] = *(const LAS bf16x8*)(XCb + (16 * mt + li) * XSB + 64 * n + 32 * ks + 8 * g);
#pragma unroll
    for (int dir = 0; dir < 2; ++dir) {
        f32x4 accA[2][2], accX[2][2];
#pragma unroll
        for (int i = 0; i < 2; ++i)
#pragma unroll
            for (int j = 0; j < 2; ++j) { accA[i][j] = (f32x4){0.f, 0.f, 0.f, 0.f}; accX[i][j] = (f32x4){0.f, 0.f, 0.f, 0.f}; }
#pragma unroll
        for (int ks = 0; ks < 2; ++ks)
#pragma unroll
            for (int nt = 0; nt < 2; ++nt)
#pragma unroll
                for (int mt = 0; mt < 2; ++mt) { accA[mt][nt] = MFMA16(af[mt][ks], wfr[dir][0][nt][ks], accA[mt][nt]); accX[mt][nt] = MFMA16(af[mt][ks], wfr[dir][1][nt][ks], accX[mt][nt]); }
#pragma unroll
        for (int nt = 0; nt < 2; ++nt) { const int ch = 64 * n + 32 * hh + 16 * nt + li; const float lam = lamv[dir][nt];
            const float ex_ = fexp(-fabsf(lam)); const float l1p = (ex_ < 0.25f) ? ex_ * (1.0f - ex_ * (0.5f - ex_ * ((1.0f / 3.0f) - 0.25f * ex_))) : log1pf(ex_);
            const float sp = fmaxf(-lam, 0.f) + l1p;
            const float k8 = -8.0f * sp;
#pragma unroll
            for (int mt = 0; mt < 2; ++mt) {
                constexpr float L2E = 1.4426950408889634f;
                const f32x4 za = (accA[mt][nt] + bav[dir][nt]) * (-L2E), zx = (accX[mt][nt] + bxv[dir][nt]) * (-L2E);
                f32x4 ea, ex;
#pragma unroll
                for (int r = 0; r < 4; ++r) { ea[r] = __builtin_amdgcn_exp2f(za[r]); ex[r] = __builtin_amdgcn_exp2f(zx[r]); }
                ea = ea + 1.0f; ex = ex + 1.0f;
                f32x4 rg_, ig_;
#pragma unroll
                for (int r = 0; r < 4; ++r) { rg_[r] = __builtin_amdgcn_rcpf(ea[r]); ig_[r] = __builtin_amdgcn_rcpf(ex[r]); }
                const f32x4 la = rg_ * k8, lal = la * L2E, x2 = la * 2.0f;
                f32x4 av, om;
#pragma unroll
                for (int r = 0; r < 4; ++r) av[r] = __builtin_amdgcn_exp2f(lal[r]);
                const f32x4 ser = -x2 * (1.0f + 0.5f * x2 * (1.0f + (1.0f / 3.0f) * x2 * (1.0f + 0.25f * x2)));
#pragma unroll
                for (int r = 0; r < 4; ++r) om[r] = (x2[r] > -0.25f) ? ser[r] : 1.0f - av[r] * av[r];
                f32x4 xc4, sq;
#pragma unroll
                for (int r = 0; r < 4; ++r) { xc4[r] = bf2f(XCb[(16 * mt + 4 * g + r) * XSB + ch]); sq[r] = __builtin_amdgcn_sqrtf(om[r]); }
                const f32x4 uv = sq * (ig_ * xc4);
#pragma unroll
                for (int r = 0; r < 4; ++r) { const int t = 16 * mt + 4 * g + r; AA[(dir * 32 + t) * XS + ch] = av[r]; UUb[(dir * 32 + t) * XSB + ch] = (bf16)f2bf(uv[r]); } } }
    }
    WG_SYNC();
    { const int dir = tid >> 8, ch = tid & 255; float h = 0.f, cp = 1.f;
      bf16* lh = (bf16*)(a.ws + WS_LH) + ((size_t)dir * M + m0) * 256 + ch; bf16* cpo = (bf16*)(a.ws + WS_CP) + ((size_t)dir * M + m0) * 256 + ch;
      float av[32], uv[32];
#pragma unroll
      for (int q = 0; q < 32; ++q) { av[q] = AA[(dir * 32 + q) * XS + ch]; uv[q] = bf2f(UUb[(dir * 32 + q) * XSB + ch]); }
      if (dir == 0) {
#pragma unroll
          for (int q = 0; q < 32; ++q) { h = av[q] * h + uv[q]; cp *= av[q]; lh[(size_t)q * 256] = (bf16)f2bf(h); cpo[(size_t)q * 256] = (bf16)f2bf(cp); }
      } else {
#pragma unroll
          for (int q = 31; q >= 0; --q) { h = av[q] * h + uv[q]; cp *= av[q]; lh[(size_t)q * 256] = (bf16)f2bf(h); cpo[(size_t)q * 256] = (bf16)f2bf(cp); }
      }
      float* cr = (float*)(a.ws + WS_CARRY) + ((((size_t)dir * NB + b) * 64 + c32) * 2) * 256 + ch; cr[0] = cp; cr[256] = h; }
    WG_SYNC();
}

constexpr int CIN_OFF = 122880;
__device__ __forceinline__ void p4_carry(const Args& a, int unit, LAS unsigned char* lds, int tid) {
    const int b = unit >> 5, c0 = 2 * (unit & 31);
    LAS float* CIN = (LAS float*)(lds + CIN_OFF);
    const float* CARRY = (const float*)(a.ws + WS_CARRY);
    { const int dir = tid >> 8, ch = tid & 255; const float* cr = CARRY + (((size_t)dir * NB + b) * 64) * 512 + ch; float cin = 0.f;
      const int cs = dir ? c0 + 1 : c0;
      const int n = dir ? 63 - cs : cs;
      for (int base = 0; base < n; base += 16) { float P[16], Hh[16];
#pragma unroll
          for (int i = 0; i < 16; ++i) { const int q = base + i; const bool v = q < n; const int k = v ? (dir ? 63 - q : q) : cs;
              const float p = cr[(size_t)k * 512], h = cr[(size_t)k * 512 + 256]; P[i] = v ? p : 1.f; Hh[i] = v ? h : 0.f; }
#pragma unroll
          for (int i = 0; i < 16; ++i) cin = P[i] * cin + Hh[i]; }
      const float cin2 = cr[(size_t)cs * 512] * cin + cr[(size_t)cs * 512 + 256];
      CIN[((cs - c0) * 2 + dir) * 256 + ch] = cin; CIN[((1 - (cs - c0)) * 2 + dir) * 256 + ch] = cin2; }
}
__device__ __forceinline__ void p4_rows_unit(const Args& a, int l, int unit, LAS unsigned char* lds, int tid, int lane, int wave, bool have_carry) {
    const int b = unit >> 5, c0 = 2 * (unit & 31); const size_t m0 = (size_t)b * SEQ + c0 * 32;
    LAS float* CIN = (LAS float*)(lds + CIN_OFF);
    if (!have_carry) p4_carry(a, unit, lds, tid);
    WG_SYNC();
    const bf16* LH = (const bf16*)(a.ws + WS_LH); const bf16* CPb = (const bf16*)(a.ws + WS_CP); const bf16* PROJ = (const bf16*)(a.ws + WS_PROJ); bf16* Y = (bf16*)(a.ws + WS_Y);
    const f32x4 og = *(const f32x4*)(a.in[I_LOG] + (size_t)l * 256 + 4 * lane);
    const float* gq = a.in[I_AOG] + (size_t)l * 512 + 8 * lane; const f32x4 g0 = *(const f32x4*)gq, g1 = *(const f32x4*)(gq + 4);
#pragma unroll
    for (int it = 0; it < 2; ++it) { const int tl = wave * 8 + it * 4;
        const LAS float* ci = CIN + (tl >> 5) * 512; const f32x4 cf = *(const LAS f32x4*)(ci + 4 * lane), cb = *(const LAS f32x4*)(ci + 256 + 4 * lane);
        v4u ya[4]; u32x2 lf[4], pf[4], lb[4], pb[4], gt[4];
#pragma unroll
        for (int r = 0; r < 4; ++r) { const size_t m = m0 + tl + r;
            ya[r] = *(const v4u*)(Y + m * DM + 8 * lane);
            lf[r] = *(const u32x2*)(LH + m * 256 + 4 * lane); pf[r] = *(const u32x2*)(CPb + m * 256 + 4 * lane);
            lb[r] = *(const u32x2*)(LH + ((size_t)M + m) * 256 + 4 * lane); pb[r] = *(const u32x2*)(CPb + ((size_t)M + m) * 256 + 4 * lane);
            gt[r] = *(const u32x2*)(PROJ + m * NPROJ + C_LG + 4 * lane); }
#pragma unroll
        for (int r = 0; r < 4; ++r) { const size_t m = m0 + tl + r;
            {
                const float x[8] = {bflo(ya[r].x), bfhi(ya[r].x), bflo(ya[r].y), bfhi(ya[r].y), bflo(ya[r].z), bfhi(ya[r].z), bflo(ya[r].w), bfhi(ya[r].w)}; float ss = 0.f;
#pragma unroll
                for (int i = 0; i < 8; ++i) ss += x[i] * x[i];
                const float rstd = frsq(wave_sum(ss) * (1.0f / 512.0f) + EPS);
                v4u o; o.x = pk2(x[0] * rstd * g0[0], x[1] * rstd * g0[1]); o.y = pk2(x[2] * rstd * g0[2], x[3] * rstd * g0[3]);
                o.z = pk2(x[4] * rstd * g1[0], x[5] * rstd * g1[1]); o.w = pk2(x[6] * rstd * g1[2], x[7] * rstd * g1[3]); *(v4u*)(Y + m * DM + 8 * lane) = o; }
            {
                f32x4 h;
                h[0] = (bflo(lf[r].x) + bflo(pf[r].x) * cf[0]) + (bflo(lb[r].x) + bflo(pb[r].x) * cb[0]);
                h[1] = (bfhi(lf[r].x) + bfhi(pf[r].x) * cf[1]) + (bfhi(lb[r].x) + bfhi(pb[r].x) * cb[1]);
                h[2] = (bflo(lf[r].y) + bflo(pf[r].y) * cf[2]) + (bflo(lb[r].y) + bflo(pb[r].y) * cb[2]);
                h[3] = (bfhi(lf[r].y) + bfhi(pf[r].y) * cf[3]) + (bfhi(lb[r].y) + bfhi(pb[r].y) * cb[3]);
                h[0] *= gelu_tanh_f(bflo(gt[r].x)); h[1] *= gelu_tanh_f(bfhi(gt[r].x)); h[2] *= gelu_tanh_f(bflo(gt[r].y)); h[3] *= gelu_tanh_f(bfhi(gt[r].y));
                const float ss = wave_sum((h[0] * h[0] + h[1] * h[1]) + (h[2] * h[2] + h[3] * h[3]));
                const float rstd = frsq(ss * (1.0f / 256.0f) + EPS);
                u32x2 o; o.x = pk2(h[0] * rstd * og[0], h[1] * rstd * og[1]); o.y = pk2(h[2] * rstd * og[2], h[3] * rstd * og[3]);
                *(u32x2*)(Y + m * DM + 512 + 4 * lane) = o; } } }
    WG_SYNC();
}

struct MlsGateRaw { float i_f, f_f, i_b, f_b; };
__device__ __forceinline__ MlsGateRaw mls_gates_load(const Args& a, int l, size_t m0, int hd, int tid) {
    MlsGateRaw r{0.f, 0.f, 0.f, 0.f};
    if (tid < 128) { const float* p = (const float*)(a.ws + WS_MG) + (m0 + tid) * 16; const float* fb = a.in[I_FB] + (size_t)l * 8;
        r.i_f = p[hd]; r.f_f = p[4 + hd] + fb[hd]; r.i_b = p[8 + hd]; r.f_b = p[12 + hd] + fb[4 + hd]; }
    return r;
}
__device__ __forceinline__ void mls_gates_store(const MlsGateRaw& r, LAS float* GL, int tid) {
    if (tid < 128) { GL[tid] = logsig_f(r.f_f); GL[128 + tid] = logsig_f(r.f_b); GL[256 + tid] = r.i_f; GL[384 + tid] = r.i_b; }
}
__device__ __forceinline__ void mls_gates_scan(LAS float* GL, int wave, int lane) {
    if (wave == 0) wave_scan128<false, false>(GL, GL + 512, lane);
    else if (wave == 1) wave_scan128<false, true>(GL + 128, GL + 640, lane);
}
constexpr int TS = 136;
constexpr int QS_ = 72;

__device__ __forceinline__ void mls_a_unit(const Args& a, int l, int unit, LAS unsigned char* lds, int tid, int lane, int wave) {
    const int c = unit & 15, hd = (unit >> 4) & 3, b = unit >> 6; const size_t m0 = (size_t)b * SEQ + c * 128;
    LAS float* GL = (LAS float*)(lds + RING_OFF);
    LAS float* WW = GL + 768;
    LAS bf16* VT = (LAS bf16*)(lds + RING_OFF + 4096); LAS bf16* KF = VT + 64 * TS; LAS bf16* KB = KF + 64 * TS;
    const MlsGateRaw graw = mls_gates_load(a, l, m0, hd, tid);
    const int j = tid & 127, part = tid >> 7; const bf16* PROJ = (const bf16*)(a.ws + WS_PROJ);
    const bf16* kp = PROJ + (m0 + j) * NPROJ + C_MK + hd * 64 + 16 * part; const bf16* vp = PROJ + (m0 + j) * NPROJ + C_MV + hd * 64 + 16 * part;
    const v4u k0 = *(const v4u*)kp, k1 = *(const v4u*)(kp + 8), v0 = *(const v4u*)vp, v1 = *(const v4u*)(vp + 8);
    mls_gates_store(graw, GL, tid);
    WG_SYNC();
    float* MLOC = (float*)(a.ws + WS_MLOC); float* NLOC = (float*)(a.ws + WS_NLOC); float* CLOC = (float*)(a.ws + WS_CLOC);
    const size_t sbase = ((size_t)b * 4 + hd) * 2;
    mls_gates_scan(GL, wave, lane);
    if (wave < 2) { WAVE_LDS_FENCE(); const int dir = wave; const float gtot = dir ? GL[640] : GL[512 + 127]; const LAS float* Bc = GL + 512 + 128 * dir; const LAS float* IG = GL + 256 + 128 * dir;
        const float lw0 = gtot - Bc[lane] + IG[lane], lw1 = gtot - Bc[lane + 64] + IG[lane + 64];
        const float mx = wave_max(fmaxf(lw0, lw1));
        WW[dir * 128 + lane] = fexp(lw0 - mx); WW[dir * 128 + lane + 64] = fexp(lw1 - mx);
        if (lane == 0) { float* o = MLOC + ((sbase + dir) * 16 + c) * 2; o[0] = mx; o[1] = gtot; } }
    WG_SYNC();
    { const float wf = WW[j] * 0.125f, wb = WW[128 + j] * 0.125f;
      const unsigned kk[8] = {k0.x, k0.y, k0.z, k0.w, k1.x, k1.y, k1.z, k1.w}; const unsigned vv[8] = {v0.x, v0.y, v0.z, v0.w, v1.x, v1.y, v1.z, v1.w};
#pragma unroll
      for (int q = 0; q < 8; ++q) { const int e0 = 16 * part + 2 * q; const float ka = bflo(kk[q]), kb = bfhi(kk[q]);
          KF[e0 * TS + j] = (bf16)f2bf(ka * wf); KF[(e0 + 1) * TS + j] = (bf16)f2bf(kb * wf);
          KB[e0 * TS + j] = (bf16)f2bf(ka * wb); KB[(e0 + 1) * TS + j] = (bf16)f2bf(kb * wb);
          VT[e0 * TS + j] = (bf16)(vv[q] & 0xffffu); VT[(e0 + 1) * TS + j] = (bf16)(vv[q] >> 16); } }
    WG_SYNC();
    if (tid < 128) { const int dir = tid >> 6, e = tid & 63; const LAS bf16* kr = (dir ? KB : KF) + e * TS; float s = 0.f;
#pragma unroll
        for (int q = 0; q < 16; ++q) { const v4u w = *(const LAS v4u*)(kr + 8 * q); s += ((bflo(w.x) + bfhi(w.x)) + (bflo(w.y) + bfhi(w.y))) + ((bflo(w.z) + bfhi(w.z)) + (bflo(w.w) + bfhi(w.w))); }
        NLOC[((sbase + dir) * 16 + c) * 64 + e] = s; }
    { const int dir = wave >> 2, mt = wave & 3, li = lane & 15, g = lane >> 4; const LAS bf16* KD = dir ? KB : KF;
      f32x4 acc[4];
#pragma unroll
      for (int nt = 0; nt < 4; ++nt) acc[nt] = (f32x4){0.f, 0.f, 0.f, 0.f};
#pragma unroll
      for (int ks = 0; ks < 4; ++ks) { const bf16x8 af = *(const LAS bf16x8*)(VT + (16 * mt + li) * TS + 32 * ks + 8 * g);
#pragma unroll
          for (int nt = 0; nt < 4; ++nt) { const bf16x8 bfv = *(const LAS bf16x8*)(KD + (16 * nt + li) * TS + 32 * ks + 8 * g); acc[nt] = MFMA16(af, bfv, acc[nt]); } }
      float* co = CLOC + ((sbase + dir) * 16 + c) * 4096;
#pragma unroll
      for (int nt = 0; nt < 4; ++nt)
#pragma unroll
          for (int r = 0; r < 4; ++r) co[(16 * mt + 4 * g + r) * 64 + 16 * nt + li] = acc[nt][r]; }
    WG_SYNC();
}

__device__ __forceinline__ void mls_scan_unit(const Args& a, int unit, LAS unsigned char* lds, int tid, int lane, int wave) {
    const int qtr = unit & 3, bhd = unit >> 2, dir = bhd & 1;
    LAS float* SM = (LAS float*)(lds + RING_OFF);
    const float* CLOC = (const float*)(a.ws + WS_CLOC) + (size_t)bhd * 16 * 4096 + 1024 * qtr + 2 * tid;
    const float* NLOC = (const float*)(a.ws + WS_NLOC) + (size_t)bhd * 16 * 64;
    typedef float f32x2 __attribute__((ext_vector_type(2)));
    f32x2 cl[16]; float nl[16];
#pragma unroll
    for (int k = 0; k < 16; ++k) cl[k] = *(const f32x2*)(CLOC + (size_t)k * 4096);
    const bool do_n = (qtr == 0) && (tid < 64);
#pragma unroll
    for (int k = 0; k < 16; ++k) nl[k] = do_n ? NLOC[k * 64 + tid] : 0.f;
    if (tid < 32) SM[tid] = ((const float*)(a.ws + WS_MLOC))[(size_t)bhd * 32 + tid];
    WG_SYNC();
    bf16* CP = (bf16*)(a.ws + WS_CPREV) + (size_t)bhd * 16 * 4096 + 1024 * qtr + 2 * tid;
    float* NP = (float*)(a.ws + WS_NPREV) + (size_t)bhd * 16 * 64; float* MP = (float*)(a.ws + WS_MPREV) + (size_t)bhd * 16;
    float m = 0.f; f32x2 C = (f32x2){0.f, 0.f}; float n = 0.f;
#pragma unroll
    for (int q = 0; q < 16; ++q) { const int k = dir ? 15 - q : q;
        *(unsigned*)(CP + (size_t)k * 4096) = pk2(C[0], C[1]);
        if (do_n) NP[k * 64 + tid] = n;
        if (qtr == 0 && tid == 64) MP[k] = m;
        const float mlk = SM[2 * k], gk = SM[2 * k + 1]; const float mn = fmaxf(gk + m, mlk); const float fa = fexp(gk + m - mn), fb = fexp(mlk - mn);
        C = fa * C + fb * (dir ? cl[15 - q] : cl[q]); n = fa * n + fb * (dir ? nl[15 - q] : nl[q]); m = mn; }
    WG_SYNC();
}

template <int DIR>
__device__ __forceinline__ void mls_dir(f32x4 (&hacc)[4], const LAS bf16* QS, const LAS bf16* KS, const LAS bf16* VT, const LAS bf16* CP, const LAS float* AJ, const LAS float* MM,
                                        const LAS float* INTER, const LAS float* FLOOR, const LAS float* NP, LAS float* rowbuf, int w, int lane) {
    const int li = lane & 15, g = lane >> 4, i = 16 * w + li;
    bf16x8 qf[2];
#pragma unroll
    for (int ks = 0; ks < 2; ++ks) qf[ks] = *(const LAS bf16x8*)(QS + i * QS_ + 32 * ks + 8 * g);
    const float mmi = MM[i];
    float den = 0.f;
    f32x4 out[4];
#pragma unroll
    for (int dt = 0; dt < 4; ++dt) out[dt] = (f32x4){0.f, 0.f, 0.f, 0.f};
#pragma unroll
    for (int kp = 0; kp < 4; ++kp) {
        const bool need = (DIR == 0) ? (2 * kp <= w) : (2 * kp + 1 >= w);
        if (need) {
            f32x4 s0 = (f32x4){0.f, 0.f, 0.f, 0.f}, s1 = (f32x4){0.f, 0.f, 0.f, 0.f};
#pragma unroll
            for (int ks = 0; ks < 2; ++ks) { const bf16x8 k0 = *(const LAS bf16x8*)(KS + (32 * kp + li) * QS_ + 32 * ks + 8 * g), k1 = *(const LAS bf16x8*)(KS + (32 * kp + 16 + li) * QS_ + 32 * ks + 8 * g);
                s0 = MFMA16(k0, qf[ks], s0); s1 = MFMA16(k1, qf[ks], s1); }
            constexpr float L2E = 1.4426950408889634f;
            const int jb = 32 * kp + 4 * g;
            const f32x4 aj0 = *(const LAS f32x4*)(AJ + jb), aj1 = *(const LAS f32x4*)(AJ + jb + 16);
            f32x4 e0 = (aj0 - mmi) * L2E - 3.0f, e1 = (aj1 - mmi) * L2E - 3.0f;
#pragma unroll
            for (int r = 0; r < 4; ++r) { const bool v0 = (DIR == 0) ? (jb + r <= i) : (jb + r >= i), v1 = (DIR == 0) ? (jb + 16 + r <= i) : (jb + 16 + r >= i);
                e0[r] = __builtin_amdgcn_exp2f(v0 ? e0[r] : -INFINITY); e1[r] = __builtin_amdgcn_exp2f(v1 ? e1[r] : -INFINITY); }
            const f32x4 p0 = s0 * e0, p1 = s1 * e1;
            den += ((p0[0] + p0[1]) + (p0[2] + p0[3])) + ((p1[0] + p1[1]) + (p1[2] + p1[3]));
            const float p[8] = {p0[0], p0[1], p0[2], p0[3], p1[0], p1[1], p1[2], p1[3]};
            v4u pk; pk.x = pk2(p[0], p[1]); pk.y = pk2(p[2], p[3]); pk.z = pk2(p[4], p[5]); pk.w = pk2(p[6], p[7]);
            const bf16x8 pf = __builtin_bit_cast(bf16x8, pk);
#pragma unroll
            for (int dt = 0; dt < 4; ++dt) { const LAS bf16* vr = VT + (16 * dt + li) * TS + 32 * kp + 4 * g;
                const u32x2 lo = *(const LAS u32x2*)vr, hi = *(const LAS u32x2*)(vr + 16);
                v4u vk; vk.x = lo.x; vk.y = lo.y; vk.z = hi.x; vk.w = hi.y;
                out[dt] = MFMA16(pf, __builtin_bit_cast(bf16x8, vk), out[dt]); }
        }
    }
    f32x4 qc[4];
#pragma unroll
    for (int dt = 0; dt < 4; ++dt) { qc[dt] = (f32x4){0.f, 0.f, 0.f, 0.f};
#pragma unroll
        for (int ks = 0; ks < 2; ++ks) { const bf16x8 cf = *(const LAS bf16x8*)(CP + (16 * dt + li) * QS_ + 32 * ks + 8 * g); qc[dt] = MFMA16(qf[ks], cf, qc[dt]); } }
    float nq = 0.f;
    { const v4u qa = *(const LAS v4u*)(QS + i * QS_ + 16 * g), qb = *(const LAS v4u*)(QS + i * QS_ + 16 * g + 8);
      const unsigned qq[8] = {qa.x, qa.y, qa.z, qa.w, qb.x, qb.y, qb.z, qb.w};
#pragma unroll
      for (int q = 0; q < 4; ++q) { const f32x4 nv = *(const LAS f32x4*)(NP + 16 * g + 4 * q);
          nq += (nv[0] * bflo(qq[2 * q]) + nv[1] * bfhi(qq[2 * q])) + (nv[2] * bflo(qq[2 * q + 1]) + nv[3] * bfhi(qq[2 * q + 1])); } }
    den = xor32_sum(xor16_sum(den)); nq = xor32_sum(xor16_sum(nq));
    const float inter = INTER[i]; const float dn = fmaxf(fabsf(den + inter * nq), FLOOR[i]);
    asm volatile("s_waitcnt lgkmcnt(0)" ::: "memory");
    if (g == 0) { rowbuf[li] = inter; rowbuf[16 + li] = frcp(dn); }
    asm volatile("s_waitcnt lgkmcnt(0)" ::: "memory");
#pragma unroll
    for (int r = 0; r < 4; ++r) { const float it = rowbuf[4 * g + r], inv = rowbuf[16 + 4 * g + r];
#pragma unroll
        for (int dt = 0; dt < 4; ++dt) hacc[dt][r] += (out[dt][r] + it * qc[dt][r]) * inv; }
    asm volatile("s_waitcnt lgkmcnt(0)" ::: "memory");
}
__device__ __forceinline__ void mls_b_unit(const Args& a, int l, int unit, LAS unsigned char* lds, int tid, int lane, int wave) {
    const int c = unit & 15, hd = (unit >> 4) & 3, b = unit >> 6; const size_t m0 = (size_t)b * SEQ + c * 128;
    LAS float* GL = (LAS float*)(lds + RING_OFF);
    LAS float* AJ = GL + 768;
    LAS float* MMx = AJ + 256;
    LAS float* INT_ = MMx + 256;
    LAS float* FLR = INT_ + 256;
    LAS float* NP = FLR + 256;
    LAS float* COEF = NP + 128;
    LAS float* ROWB = COEF + 32;
    LAS bf16* QS = (LAS bf16*)(lds + RING_OFF + 16384); LAS bf16* KS = QS + 128 * QS_; LAS bf16* VT = KS + 128 * QS_; LAS bf16* CF = VT + 64 * TS; LAS bf16* CB = CF + 64 * QS_;
    const size_t sbase = ((size_t)b * 4 + hd) * 2;
    const MlsGateRaw graw = mls_gates_load(a, l, m0, hd, tid);
    const float mprev = ((const float*)(a.ws + WS_MPREV))[(sbase + (wave & 1)) * 16 + c];
    const bf16* PROJ = (const bf16*)(a.ws + WS_PROJ);
    const int sj = tid >> 2, q4 = tid & 3; const bf16* rp = PROJ + (m0 + sj) * NPROJ + hd * 64 + 16 * q4;
    const v4u q0 = *(const v4u*)(rp + C_MQ), q1 = *(const v4u*)(rp + C_MQ + 8), k0 = *(const v4u*)(rp + C_MK), k1 = *(const v4u*)(rp + C_MK + 8), v0 = *(const v4u*)(rp + C_MV), v1 = *(const v4u*)(rp + C_MV + 8);
    const int idx = tid * 8; const bf16* CPV = (const bf16*)(a.ws + WS_CPREV);
    const v4u cfv = *(const v4u*)(CPV + ((sbase + 0) * 16 + c) * 4096 + idx), cbv = *(const v4u*)(CPV + ((sbase + 1) * 16 + c) * 4096 + idx);
    float npv = 0.f; if (tid < 128) npv = ((const float*)(a.ws + WS_NPREV))[((sbase + (tid >> 6)) * 16 + c) * 64 + (tid & 63)];
    const int li_ = lane & 15, g_ = lane >> 4; const float* hg = a.in[I_MNG] + ((size_t)l * 4 + hd) * 64;
    unsigned short ogv[4][4]; float hgv[4];
#pragma unroll
    for (int dt = 0; dt < 4; ++dt) { hgv[dt] = hg[16 * dt + li_];
#pragma unroll
        for (int r = 0; r < 4; ++r) ogv[r][dt] = PROJ[(m0 + 16 * wave + 4 * g_ + r) * NPROJ + C_MO + hd * 64 + 16 * dt + li_]; }
    mls_gates_store(graw, GL, tid);
    *(LAS v4u*)(QS + sj * QS_ + 16 * q4) = q0; *(LAS v4u*)(QS + sj * QS_ + 16 * q4 + 8) = q1;
    *(LAS v4u*)(KS + sj * QS_ + 16 * q4) = k0; *(LAS v4u*)(KS + sj * QS_ + 16 * q4 + 8) = k1;
    { const unsigned vv[8] = {v0.x, v0.y, v0.z, v0.w, v1.x, v1.y, v1.z, v1.w};
#pragma unroll
      for (int q = 0; q < 8; ++q) { const int d0 = 16 * q4 + 2 * q; VT[d0 * TS + sj] = (bf16)(vv[q] & 0xffffu); VT[(d0 + 1) * TS + sj] = (bf16)(vv[q] >> 16); } }
    *(LAS v4u*)(CF + (idx >> 6) * QS_ + (idx & 63)) = cfv; *(LAS v4u*)(CB + (idx >> 6) * QS_ + (idx & 63)) = cbv;
    if (tid < 128) NP[tid] = npv;
    WG_SYNC();
    mls_gates_scan(GL, wave, lane);
    if (wave < 2) {
        WAVE_LDS_FENCE();
        const int dir = wave; const float m = mprev;
        const LAS float* IG = GL + 256 + 128 * dir; const LAS float* Bc = GL + 512 + 128 * dir;
        LAS float* aj = AJ + 128 * dir; LAS float* mmx = MMx + 128 * dir;
        aj[lane] = IG[lane] - Bc[lane]; aj[lane + 64] = IG[lane + 64] - Bc[lane + 64];
        WAVE_LDS_FENCE();
        if (dir == 0) wave_scan128<true, false>(aj, mmx, lane); else wave_scan128<true, true>(aj, mmx, lane);
        WAVE_LDS_FENCE();
#pragma unroll
        for (int q = 0; q < 2; ++q) { const int j = lane + 64 * q; const float mm = fmaxf(mmx[j], m);
            mmx[j] = mm; INT_[128 * dir + j] = fexp(m - mm); FLR[128 * dir + j] = fexp(-(Bc[j] + mm)); }
    }
    WG_SYNC();
    f32x4 hacc[4];
#pragma unroll
    for (int dt = 0; dt < 4; ++dt) hacc[dt] = (f32x4){0.f, 0.f, 0.f, 0.f};
    mls_dir<0>(hacc, QS, KS, VT, CF, AJ, MMx, INT_, FLR, NP, ROWB + wave * 32, wave, lane);
    mls_dir<1>(hacc, QS, KS, VT, CB, AJ + 128, MMx + 128, INT_ + 128, FLR + 128, NP + 64, ROWB + wave * 32, wave, lane);
    {
        bf16* Y = (bf16*)(a.ws + WS_Y);
#pragma unroll
        for (int r = 0; r < 4; ++r) { float ss = (hacc[0][r] * hacc[0][r] + hacc[1][r] * hacc[1][r]) + (hacc[2][r] * hacc[2][r] + hacc[3][r] * hacc[3][r]);
            ss = row16_sum(ss);
            const float rstd = frsq(ss * (1.0f / 64.0f) + EPS); const size_t m = m0 + 16 * wave + 4 * g_ + r;
#pragma unroll
            for (int dt = 0; dt < 4; ++dt) Y[m * DM + 768 + hd * 64 + 16 * dt + li_] = (bf16)f2bf(hacc[dt][r] * rstd * hgv[dt] * sigmoid_f(bf2f(ogv[r][dt]))); }
    }
    WG_SYNC();
}

__device__ __forceinline__ void attnorm_pass(const Args& a, int l, int lane, int wave, int G, int bid, bf16* DST) {
    bf16* Y = (bf16*)(a.ws + WS_Y); const float* gq = a.in[I_AOG] + (size_t)l * 512 + 8 * lane;
    const f32x4 g0 = *(const f32x4*)gq, g1 = *(const f32x4*)(gq + 4);
    const int gw = bid * NWAVES + wave, NGW = G * NWAVES;
    for (int mb = 4 * gw; mb < M; mb += 4 * NGW) { v4u q[4];
#pragma unroll
        for (int r = 0; r < 4; ++r) q[r] = *(const v4u*)(Y + (size_t)(mb + r) * DM + 8 * lane);
        float ss[4];
#pragma unroll
        for (int r = 0; r < 4; ++r) { const float x[8] = {bflo(q[r].x), bfhi(q[r].x), bflo(q[r].y), bfhi(q[r].y), bflo(q[r].z), bfhi(q[r].z), bflo(q[r].w), bfhi(q[r].w)}; float a = 0.f;
#pragma unroll
            for (int i = 0; i < 8; ++i) a += x[i] * x[i];
            ss[r] = a; }
#pragma unroll
        for (int r = 0; r < 4; ++r) ss[r] = wave_sum(ss[r]);
#pragma unroll
        for (int r = 0; r < 4; ++r) { const float rstd = frsq(ss[r] * (1.0f / 512.0f) + EPS);
            const float x[8] = {bflo(q[r].x), bfhi(q[r].x), bflo(q[r].y), bfhi(q[r].y), bflo(q[r].z), bfhi(q[r].z), bflo(q[r].w), bfhi(q[r].w)};
            v4u o; o.x = pk2(x[0] * rstd * g0[0], x[1] * rstd * g0[1]); o.y = pk2(x[2] * rstd * g0[2], x[3] * rstd * g0[3]);
            o.z = pk2(x[4] * rstd * g1[0], x[5] * rstd * g1[1]); o.w = pk2(x[6] * rstd * g1[2], x[7] * rstd * g1[3]); *(v4u*)(DST + (size_t)(mb + r) * DM + 8 * lane) = o; } }
}

__device__ __forceinline__ unsigned mbcnt64(unsigned long long m) { return __builtin_amdgcn_mbcnt_hi((unsigned)(m >> 32), __builtin_amdgcn_mbcnt_lo((unsigned)m, 0u)); }
__device__ __forceinline__ void topk_item(const Args& a, int item, LAS unsigned char* lds, int tid, int lane, int wave) {
    const int unit = item & 127, half = item >> 7, b = unit >> 4, e = unit & 15;
    LAS unsigned* CNT = (LAS unsigned*)(lds + RING_OFF);
    LAS unsigned* SEG = CNT + 16;
    LAS int* TOK = (LAS int*)(SEG + 64);
    LAS float* GV = (LAS float*)(TOK + 256);
    const float* aff = (const float*)(a.ws + WS_AFF) + ((size_t)b * NE + e) * SEQ;
    float av[4]; unsigned key[4];
#pragma unroll
    for (int q = 0; q < 4; ++q) av[q] = aff[tid + q * NTHR];
#pragma unroll
    for (int q = 0; q < 4; ++q) key[q] = __float_as_uint(av[q]);
    unsigned lo = 0u, hi = 0x7F800000u; int par = 0;
    while (hi - lo > 1u) { const unsigned mid = lo + ((hi - lo) >> 1);
        unsigned c = 0u;
#pragma unroll
        for (int q = 0; q < 4; ++q) c += (unsigned)__popcll(__ballot(key[q] >= mid));
        if (lane == 0) CNT[par * 8 + wave] = c;
        WG_SYNC();
        const v4u c0 = *(const LAS v4u*)(CNT + par * 8), c1 = *(const LAS v4u*)(CNT + par * 8 + 4);
        const unsigned tot = (c0.x + c0.y) + (c0.z + c0.w) + (c1.x + c1.y) + (c1.z + c1.w);
        if (tot >= (unsigned)CAP) lo = mid; else hi = mid;
        par ^= 1; }
    const unsigned T = lo;
    unsigned long long mgt[4], meq[4];
#pragma unroll
    for (int q = 0; q < 4; ++q) { mgt[q] = __ballot(key[q] > T); meq[q] = __ballot(key[q] == T);
        if (lane == 0) { SEG[q * 8 + wave] = (unsigned)__popcll(mgt[q]); SEG[32 + q * 8 + wave] = (unsigned)__popcll(meq[q]); } }
    WG_SYNC();
    unsigned ngt = 0u;
#pragma unroll
    for (int g = 0; g < 32; ++g) ngt += SEG[g];
    const unsigned need = (unsigned)CAP - ngt;
    unsigned eqb = 0u, selb = 0u, my_eqb[4], my_selb[4];
#pragma unroll
    for (int g = 0; g < 32; ++g) { if ((g & 7) == wave) { my_eqb[g >> 3] = eqb; my_selb[g >> 3] = selb; }
        const unsigned cg = SEG[g], ce = SEG[32 + g]; const unsigned room = need > eqb ? need - eqb : 0u; selb += cg + (room < ce ? room : ce); eqb += ce; }
    int* SEL = (int*)(a.ws + WS_SEL);
#pragma unroll
    for (int q = 0; q < 4; ++q) { const bool gt = key[q] > T, eq = key[q] == T;
        const bool sel = gt || (eq && (my_eqb[q] + mbcnt64(meq[q])) < need);
        const unsigned long long ms = __ballot(sel); const int slot = (int)(my_selb[q] + mbcnt64(ms)); const int sidx = tid + q * NTHR;
        if (sel) { TOK[slot] = sidx; GV[slot] = av[q]; }
        if ((q >> 1) == half) SEL[((size_t)b * SEQ + sidx) * NE + e] = sel ? slot : -1; }
    WG_SYNC();
    int* IDX = (int*)(a.ws + WS_IDX); float* GATE = (float*)(a.ws + WS_GATE);
    if (tid < 128) { const int t = half * 128 + tid; IDX[e * NSLOT + b * CAP + t] = b * SEQ + TOK[t]; GATE[e * NSLOT + b * CAP + t] = GV[t]; }
    const unsigned char* H8 = a.ws + WS_H; unsigned char* XG8 = a.ws + WS_XG;
    { v4u r0[16];
#pragma unroll
      for (int q = 0; q < 16; ++q) { const int t = half * 128 + wave * 16 + q; r0[q] = *((const v4u*)(H8 + ((size_t)b * SEQ + TOK[t]) * DM) + lane); }
#pragma unroll
      for (int q = 0; q < 16; ++q) { const int t = half * 128 + wave * 16 + q; *((v4u*)(XG8 + ((size_t)e * NSLOT + b * CAP + t) * DM) + lane) = r0[q]; } }
    WG_SYNC();
}

__global__ void __launch_bounds__(NTHR, 2) hybrid_fwd(Args args) {
    extern __shared__ __attribute__((aligned(16))) unsigned char lds_raw[];
    LAS unsigned char* lds = (LAS unsigned char*)lds_raw;
    volatile LAS unsigned* MISC = (volatile LAS unsigned*)(lds + MISC_OFF);
    const int tid0 = threadIdx.x, G = gridDim.x;
    unsigned char* ws = args.ws;
#define PHASE_IDS() const int tid = ltid(), lane = tid & 63, wave = __builtin_amdgcn_readfirstlane(tid >> 6), bid = lbid(); (void)lane; (void)wave; (void)bid
    gu32* ctl = (gu32*)(ws + WS_CTL);
    for (int u = tid0; u < (LDS_BYTES - MISC_OFF) / 4; u += NTHR) ((LAS unsigned*)(lds + MISC_OFF))[u] = 0u;
    __syncthreads();
    XcdBarrier bar; bar.bar = (unsigned*)(ctl + CW_BAR); bar.x = 0; bar.st = nullptr;
    if (!MK_PER_PHASE) bar = xcd_barrier_post((unsigned*)(ctl + CW_BAR), MISC + 8);
#define GRID_BAR() do { if (!MK_PER_PHASE) { xcd_barrier(bar); if (REP_MASK & (1 << 11)) xcd_barrier(bar); } } while (0)
    const int lo = args.ph_lo, hi = args.ph_hi;
#ifndef PT_MASK
#define PT_MASK 0x7ff
#endif
#define PT_ON(j) (((PT_MASK) >> (j)) & 1)
#ifndef REP_MASK
#define REP_MASK 0
#endif
#define REPS(j) for (int rep_ = 0; rep_ < 1 + (((REP_MASK) >> (j)) & 1); ++rep_)
#define IN(k) (lo <= (k) && (k) < hi)
#define BOTH(k) (IN(k) && IN((k) + 1))

    bf16* Hb = (bf16*)(ws + WS_H); bf16* PROJ = (bf16*)(ws + WS_PROJ); bf16* Yb = (bf16*)(ws + WS_Y);
    float* MG = (float*)(ws + WS_MG); float* AFF = (float*)(ws + WS_AFF); int* SEL = (int*)(ws + WS_SEL);
    bf16* XG = (bf16*)(ws + WS_XG); bf16* HID = (bf16*)(ws + WS_HID); bf16* YE = (bf16*)(ws + WS_YE); bf16* XB = (bf16*)(ws + WS_XB);

    if (PT_ON(0) && IN(0)) { PHASE_IDS();
        REPS(0) p0_weights(args, lds, tid, lane, wave, G, bid);
        WG_SYNC();
        REPS(16) row_pass<0, false>(args.in[I_X], nullptr, args.in[I_N1G], args.in[I_WIN] + NPROJ, DIN, Hb, MG, nullptr, nullptr, lds, tid, lane, wave, G, bid);
        if (BOTH(0)) GRID_BAR();
    }
    for (int l = 0; l < DEPTH; ++l) {
        const int pb = 1 + 10 * l;
        if (PT_ON(1) && IN(pb + 0)) { PHASE_IDS();
            pg8::Gemm g{Hb, (const bf16*)(ws + WS_WIN) + (size_t)l * NPROJ * DM, M, NPROJ, DM}; pg8::StaticOrder S; S.init(M, NPROJ - 256, G, bid);
            pg8::EpiBf16<0> E{PROJ, NPROJ, nullptr, 0, 0, 1.f};
            REPS(1) pg8::gemm_phase<pg8::EpiBf16<0>, pg8::StaticOrder, true, true>(lds + RING_OFF, g, S, E);
            if (BOTH(pb + 0)) GRID_BAR();
        }
        if (PT_ON(2) && IN(pb + 1)) { PHASE_IDS();
            const bool split = (G == 256);
            if (bid < 64 || !split) { pg8::Gemm g{Hb, (const bf16*)(ws + WS_WIN) + (size_t)l * NPROJ * DM, M, NPROJ, DM}; pg8::TailOrder S{G, bid, 8}; pg8::EpiBf16<0> E{PROJ, NPROJ, nullptr, 0, 0, 1.f};
                pg8::gemm_phase<pg8::EpiBf16<0>, pg8::TailOrder, false, true>(lds + RING_OFF, g, S, E); WG_SYNC(); }
            if (!split) rope_pass(args, l, lane, wave, G, bid, PROJ);
            else if (bid >= 64) rope_pass(args, l, lane, wave, 192, bid - 64, PROJ);
            REPS(2) for (int u = bid; u < 512; u += G) lru_a_unit(args, l, u, lds, tid, lane, wave);
            if (!split) { for (int u = bid; u < 512; u += G) mls_a_unit(args, l, u, lds, tid, lane, wave); }
            else if (bid >= 64) { for (int u = bid - 64; u < 512; u += 192) mls_a_unit(args, l, u, lds, tid, lane, wave); }
            if (BOTH(pb + 1)) GRID_BAR();
        }
        if (PT_ON(3) && IN(pb + 2)) { PHASE_IDS();
            const attn_body::AttnTensors AT{(const attn_body::bf16*)(PROJ + C_Q), (const attn_body::bf16*)(PROJ + C_K), (const attn_body::bf16*)(PROJ + C_V), (attn_body::bf16*)Yb};
            const attn_body::StaticOrder S(G, bid);
#ifndef P3_PARTS
#define P3_PARTS 7
#endif
            for (int u = bid; u < 256; u += G) mls_scan_unit(args, u, lds, tid, lane, wave);
            WG_SYNC();
            REPS(4) attn_body::attn_phase<attn_body::StaticOrder>((char*)lds_raw + RING_OFF, AT, S);
            if (!MK_PER_PHASE && G == 256) p4_carry(args, bid, lds, tid);
            if (BOTH(pb + 2)) GRID_BAR();
        }
        if (PT_ON(4) && IN(pb + 3)) { PHASE_IDS();
            REPS(5) for (int u = bid; u < 512; u += G) mls_b_unit(args, l, u, lds, tid, lane, wave);
            for (int u = bid; u < 256; u += G) p4_rows_unit(args, l, u, lds, tid, lane, wave, !MK_PER_PHASE && G == 256);
            if (BOTH(pb + 3)) GRID_BAR();
        }
        if (PT_ON(5) && IN(pb + 4)) { PHASE_IDS();
            pg8::Gemm g{Yb, (const bf16*)(ws + WS_WOUT) + (size_t)l * DM * DM, M, DM, DM}; pg8::StaticOrder S; S.init(M, DM, G, bid);
            pg8::EpiResid E{l == 0 ? args.in[I_X] : nullptr, XB, XB, DM};
            if (REP_MASK & (1 << 14)) { pg8::EpiResid E2{l == 0 ? args.in[I_X] : nullptr, XB, HID, DM}; pg8::gemm_phase<pg8::EpiResid, pg8::StaticOrder, false, true>(lds + RING_OFF, g, S, E2); }
            pg8::gemm_phase<pg8::EpiResid, pg8::StaticOrder, false, true>(lds + RING_OFF, g, S, E);
            stage_w16(args.in[I_WR] + (size_t)l * DM * NE, NE, lds, tid);
            if (BOTH(pb + 4)) GRID_BAR();
        }
        if (PT_ON(6) && IN(pb + 5)) { PHASE_IDS();
            REPS(7) row_pass<1, true, true>(XB, nullptr, args.in[I_N2G] + (size_t)l * DM, args.in[I_WR] + (size_t)l * DM * NE, NE, Hb, AFF, nullptr, nullptr, lds, tid, lane, wave, G, bid);
            if (BOTH(pb + 5)) GRID_BAR();
        }
        if (PT_ON(7) && IN(pb + 6)) { PHASE_IDS(); REPS(8) for (int it = bid; it < 256; it += G) topk_item(args, it, lds, tid, lane, wave); if (BOTH(pb + 6)) GRID_BAR(); }
        if (PT_ON(8) && IN(pb + 7)) { PHASE_IDS();
            pg8::Gemm g{XG, (const bf16*)(ws + WS_WGU + (size_t)l * NE * 4096 * DM), NE * NSLOT, NE * 4096, DM / 2}; pg8::Moe1Order S{G, bid};
            pg8::EpiSwiGLU E{(unsigned char*)HID, DE};
            if (REP_MASK & (1 << 17)) { pg8::EpiNull E0; pg8::gemm_phase<pg8::EpiNull, pg8::Moe1Order, true, true, true>(lds + RING_OFF, g, S, E0); }
            REPS(9) pg8::gemm_phase<pg8::EpiSwiGLU, pg8::Moe1Order, true, true, true>(lds + RING_OFF, g, S, E);
            if (BOTH(pb + 7)) GRID_BAR();
        }
        if (PT_ON(9) && IN(pb + 8)) { PHASE_IDS();
            pg8::Gemm g{HID, (const bf16*)(ws + WS_WDN + (size_t)l * NE * DM * DE), NE * NSLOT, NE * DM, DE / 2}; pg8::Moe2Order S{G, bid};
            pg8::EpiScaleBf16 E{YE, DM, (const float*)(ws + WS_GATE)};
            REPS(10) pg8::gemm_phase<pg8::EpiScaleBf16, pg8::Moe2Order, true, true, true>(lds + RING_OFF, g, S, E);
            if (l + 1 < DEPTH) stage_w16(args.in[I_WIN] + (size_t)(l + 1) * DM * DIN + NPROJ, DIN, lds, tid);
            if (BOTH(pb + 8)) GRID_BAR();
        }
        if (PT_ON(10) && IN(pb + 9)) { PHASE_IDS();
            if (REP_MASK & (1 << 15)) { if (l + 1 < DEPTH) row_pass<2, true>(XB, HID, args.in[I_N1G] + (size_t)(l + 1) * DM, args.in[I_WIN] + (size_t)(l + 1) * DM * DIN + NPROJ, DIN, Hb, MG, SEL, YE, lds, tid, lane, wave, G, bid); else row_pass<3, true>(XB, HID, nullptr, nullptr, 0, nullptr, nullptr, SEL, YE, lds, tid, lane, wave, G, bid); WG_SYNC(); }
            if (l + 1 < DEPTH) row_pass<2, true, true>(XB, XB, args.in[I_N1G] + (size_t)(l + 1) * DM, args.in[I_WIN] + (size_t)(l + 1) * DM * DIN + NPROJ, DIN, Hb, MG, SEL, YE, lds, tid, lane, wave, G, bid);
            else row_pass<3, true>(XB, args.out, nullptr, nullptr, 0, nullptr, nullptr, SEL, YE, lds, tid, lane, wave, G, bid);
            if (BOTH(pb + 9)) GRID_BAR();
        }
    }
#undef IN
#undef BOTH
#undef GRID_BAR
}

extern "C" void kernel_launch(void* const* d_in, const int* in_sizes, int n_in, void* d_out, int out_size, void* d_ws, size_t ws_size, hipStream_t stream) {
    static int grid = 0;
    if (grid == 0) {
        if (n_in != 22 || in_sizes[0] != M * DM || out_size != M * DM || ws_size < WS_END) { fprintf(stderr, "kernel_launch: unexpected shapes (n_in %d, in0 %d, out %d, ws %zu); nothing launched\n", n_in, n_in > 0 ? in_sizes[0] : -1, out_size, ws_size); grid = -1; return; }
        int dev = 0, cus = 0, per_cu = 0;
        if (hipGetDevice(&dev) != hipSuccess || hipDeviceGetAttribute(&cus, hipDeviceAttributeMultiprocessorCount, dev) != hipSuccess) { grid = -1; return; }
        if (hipFuncSetAttribute((const void*)hybrid_fwd, hipFuncAttributeMaxDynamicSharedMemorySize, LDS_BYTES) != hipSuccess) { fprintf(stderr, "kernel_launch: hipFuncSetAttribute failed\n"); grid = -1; return; }
        if (hipOccupancyMaxActiveBlocksPerMultiprocessor(&per_cu, (const void*)hybrid_fwd, NTHR, LDS_BYTES) != hipSuccess || per_cu < 1) { fprintf(stderr, "kernel_launch: occupancy query says %d\n", per_cu); }
        (void)hipGetLastError();
        grid = cus;
    }
    if (grid < 0) return;
    if (hipMemsetAsync((char*)d_ws + WS_CTL, 0, CTL_ZERO_BYTES, stream) != hipSuccess) return;
    Args a{};
    for (int i = 0; i < 22; ++i) a.in[i] = (const float*)d_in[i];
    a.out = (float*)d_out; a.ws = (unsigned char*)d_ws; a.pad = 0;
#if MK_PER_PHASE
    for (int p = 0; p < NPH; ++p) { a.ph_lo = p; a.ph_hi = p + 1; a.li = p; hipLaunchKernelGGL(hybrid_fwd, dim3(grid), dim3(NTHR), LDS_BYTES, stream, a); }
#else
    a.ph_lo = 0; a.ph_hi = NPH; a.li = 0;
    hipLaunchKernelGGL(hybrid_fwd, dim3(grid), dim3(NTHR), LDS_BYTES, stream, a);
#endif
    const hipError_t le = hipPeekAtLastError();
    if (le != hipSuccess) fprintf(stderr, "kernel_launch: launch failed: %s\n", hipGetErrorName(le));
}
```

```cpp
#include <hip/hip_runtime.h>
#include <hip/hip_bf16.h>
#include <cstdio>
#include <cstdint>
#include <cmath>
__device__ __forceinline__ int ltid() { int t = threadIdx.x; asm volatile("" : "+v"(t)); return t; }
__device__ __forceinline__ int lbid() { int t = blockIdx.x; asm volatile("" : "+s"(t)); return t; }
namespace pg8 {
#define PG8_LAS __attribute__((address_space(3)))
typedef unsigned short bf16_t;
typedef short bf16x8 __attribute__((ext_vector_type(8)));
typedef float f32x4 __attribute__((ext_vector_type(4)));
typedef unsigned u32x4 __attribute__((ext_vector_type(4)));
typedef unsigned u32x2 __attribute__((ext_vector_type(2)));
constexpr int BM = 256, BK = 64, HALF = 128, HTB = HALF * BK * 2  , STAGE_BYTES = 8 * HTB, NXCD = 8, WGM = 8;

__host__ __device__ __forceinline__ int lds_byte(int r, int c) { const int st = (r >> 4) * 2 + (c >> 5), rr = r & 15, cc = c & 31, ob = rr * 64 + cc * 2; return st * 1024 + (ob ^ (((ob >> 9) & 1) << 5)); }
__host__ __device__ __forceinline__ void stage_rc(int b, int& R, int& C) { const int st = b / 1024, sb = b % 1024, swz = sb ^ (((sb >> 9) & 1) << 5); R = (st >> 1) * 16 + swz / 64; C = (st & 1) * 32 + (swz % 64) / 2; }
__host__ __device__ __forceinline__ int perm32(int rho) { const int n = rho >> 4, i = rho & 15; return 8 * (i >> 2) + 4 * n + (i & 3); }

struct Unit { int pm, pn; };
struct Gemm { const bf16_t* A; const bf16_t* Bt; int M, N, K; };

struct StaticOrder {
    int nM, nN, nwg, G, c;
    __host__ __device__ void init(int M, int N, int G_, int c_) { nM = M / BM; nN = N / BM; nwg = nM * nN; G = G_; c = c_; }
    __host__ __device__ bool next(int i, Unit& u) const {
        const long L = (long)i * G + c; if (L >= nwg) return false;
        int wgid = (int)L; { const int q = nwg / NXCD, r = nwg % NXCD, xcd = wgid % NXCD, off = wgid / NXCD; wgid = (xcd < r ? xcd * (q + 1) : r * (q + 1) + (xcd - r) * q) + off; }
        const int nig = WGM * nN, gid = wgid / nig, fm = gid * WGM, gsz = (nM - fm) < WGM ? (nM - fm) : WGM;
        u.pm = fm + ((wgid % nig) % gsz); u.pn = (wgid % nig) / gsz; return true;
    }
    __device__ __forceinline__ void a_ready(const Unit&) const {}
    __device__ __forceinline__ void done(const Unit&) const {}
};

__device__ __forceinline__ unsigned cvt_pk_bf16(float lo, float hi) { unsigned r; asm volatile("v_cvt_pk_bf16_f32 %0, %1, %2" : "=v"(r) : "v"(lo), "v"(hi)); return r; }
typedef int i32x4 __attribute__((ext_vector_type(4)));
typedef int i32x8 __attribute__((ext_vector_type(8)));
__device__ __forceinline__ i32x8 cat8(bf16x8 lo, bf16x8 hi) { return __builtin_shufflevector(__builtin_bit_cast(i32x4, lo), __builtin_bit_cast(i32x4, hi), 0, 1, 2, 3, 4, 5, 6, 7); }
__device__ __forceinline__ float clamp448(float v) { return __builtin_amdgcn_fmed3f(v, -448.f, 448.f); }
__device__ __forceinline__ unsigned pk4_fp8(float a, float b, float c, float d) { unsigned r = 0u; r = (unsigned)__builtin_amdgcn_cvt_pk_fp8_f32(a, b, (int)r, false); r = (unsigned)__builtin_amdgcn_cvt_pk_fp8_f32(c, d, (int)r, true); return r; }
typedef float f32x2 __attribute__((ext_vector_type(2)));
__device__ __forceinline__ f32x2 gelu_pk(f32x2 v) {
    const f32x2 av = __builtin_elementwise_abs(v), d = av * 0.2316418882f + 1.0f;
    f32x2 t; t.x = __builtin_amdgcn_rcpf(d.x); t.y = __builtin_amdgcn_rcpf(d.y);
    f32x2 q = t * 0.5307027145f + (-0.7265760135f); q = q * t + 0.7107068705f; q = q * t + (-0.142248368f); q = q * t + 0.127414796f; q = q * t;
    const f32x2 s = (v * v) * (-0.72134752044f);
    f32x2 e; e.x = __builtin_amdgcn_exp2f(s.x); e.y = __builtin_amdgcn_exp2f(s.y);
    const f32x2 m = v * (q * e), r = v - m;
    f32x2 o; o.x = v.x < 0.f ? m.x : r.x; o.y = v.y < 0.f ? m.y : r.y; return o;
}

template <int ACT  > struct EpiBf16 {
    static constexpr bool PERM = true, AFTER_DRAIN = false; static_assert(ACT == 0 || ACT == 1, "EpiBf16: ACT is 0 (none) or 1 (gelu_pk)");
    bf16_t* O; int ldc; const float* bias; int split_cols; size_t split_stride; float scale0;
    __device__ __forceinline__ void operator()(const f32x4 (&acc)[2][2][4][2], const Unit& u, int wr, int wc, int fr, int fq) const {
        const int row0 = u.pm * BM + wr * 64 + fr; int colt = u.pn * BM; bf16_t* base = O;
        float sc = 1.f; if (split_cols) { const int t = colt / split_cols; base += (size_t)t * split_stride; colt -= t * split_cols; if (t == 0) sc = scale0; }
        const int col0 = colt + wc * 32 + 8 * fq, bcol0 = u.pn * BM + wc * 32 + 8 * fq;
        f32x4 bv[2][2];
#pragma unroll
        for (int bj = 0; bj < 2; ++bj)
#pragma unroll
            for (int n = 0; n < 2; ++n) bv[bj][n] = bias ? *(const f32x4*)(bias + bcol0 + bj * HALF + 4 * n) : (f32x4){0.f, 0.f, 0.f, 0.f};
#pragma unroll
        for (int ai = 0; ai < 2; ++ai)
#pragma unroll
            for (int m = 0; m < 4; ++m) { bf16_t* rowp = base + (size_t)(row0 + ai * HALF + m * 16) * ldc + col0;
#pragma unroll
                for (int bj = 0; bj < 2; ++bj) { f32x4 v0 = acc[ai][bj][m][0] + bv[bj][0], v1 = acc[ai][bj][m][1] + bv[bj][1];
                    if (ACT == 1) { f32x2 a = gelu_pk((f32x2){v0[0], v0[1]}), b = gelu_pk((f32x2){v0[2], v0[3]}), c = gelu_pk((f32x2){v1[0], v1[1]}), d = gelu_pk((f32x2){v1[2], v1[3]});
                        v0 = (f32x4){a.x, a.y, b.x, b.y}; v1 = (f32x4){c.x, c.y, d.x, d.y}; }
                    v0 = v0 * sc; v1 = v1 * sc; u32x4 w; w.x = cvt_pk_bf16(v0[0], v0[1]); w.y = cvt_pk_bf16(v0[2], v0[3]); w.z = cvt_pk_bf16(v1[0], v1[1]); w.w = cvt_pk_bf16(v1[2], v1[3]);
                    *(u32x4*)(rowp + bj * HALF) = w; } }
    }
};

struct EpiResid {
    static constexpr bool PERM = true, AFTER_DRAIN = false;
    const float* base32; const bf16_t* base16; bf16_t* C; int ldc;
    __device__ __forceinline__ void operator()(const f32x4 (&acc)[2][2][4][2], const Unit& u, int wr, int wc, int fr, int fq) const {
        const int row0 = u.pm * BM + wr * 64 + fr, col0 = u.pn * BM + wc * 32 + 8 * fq;
#pragma unroll
        for (int ai = 0; ai < 2; ++ai)
#pragma unroll
            for (int m = 0; m < 4; ++m) { const size_t off = (size_t)(row0 + ai * HALF + m * 16) * ldc + col0;
#pragma unroll
                for (int bj = 0; bj < 2; ++bj) { f32x4 b0, b1;
                    if (base32) { b0 = *(const f32x4*)(base32 + off + bj * HALF); b1 = *(const f32x4*)(base32 + off + bj * HALF + 4); }
                    else { const u32x4 q = *(const u32x4*)(base16 + off + bj * HALF);
                        b0 = (f32x4){__uint_as_float(q.x << 16), __uint_as_float(q.x & 0xffff0000u), __uint_as_float(q.y << 16), __uint_as_float(q.y & 0xffff0000u)};
                        b1 = (f32x4){__uint_as_float(q.z << 16), __uint_as_float(q.z & 0xffff0000u), __uint_as_float(q.w << 16), __uint_as_float(q.w & 0xffff0000u)}; }
                    const f32x4 v0 = acc[ai][bj][m][0] + b0, v1 = acc[ai][bj][m][1] + b1;
                    u32x4 w; w.x = cvt_pk_bf16(v0[0], v0[1]); w.y = cvt_pk_bf16(v0[2], v0[3]); w.z = cvt_pk_bf16(v1[0], v1[1]); w.w = cvt_pk_bf16(v1[2], v1[3]);
                    *(u32x4*)(C + off + bj * HALF) = w; } }
    }
};
__device__ __forceinline__ float silu_f(float x) { return x * __builtin_amdgcn_rcpf(1.0f + __builtin_amdgcn_exp2f(-1.4426950408889634f * x)); }
constexpr float WSCALE = 64.f, HSCALE = 4.f;
struct EpiSwiGLU {
    static constexpr bool PERM = true, AFTER_DRAIN = false;
    unsigned char* O; int ldc;
    __device__ __forceinline__ static f32x2 sw2(f32x2 g, f32x2 u) {
        constexpr float c1 = -1.4426950408889634f / WSCALE, c2 = HSCALE / (WSCALE * WSCALE);
        const f32x2 t = g * c1; f32x2 d; d.x = __builtin_amdgcn_exp2f(t.x); d.y = __builtin_amdgcn_exp2f(t.y); d = d + 1.0f;
        f32x2 r; r.x = __builtin_amdgcn_rcpf(d.x); r.y = __builtin_amdgcn_rcpf(d.y);
        f32x2 p = (g * u) * (r * c2); p.x = clamp448(p.x); p.y = clamp448(p.y); return p; }
    __device__ __forceinline__ void operator()(const f32x4 (&acc)[2][2][4][2], const Unit& u, int wr, int wc, int fr, int fq) const {
        const int row0 = u.pm * BM + wr * 64 + fr, col0 = (u.pn & 15) * HALF + wc * 32 + 8 * fq;
#pragma unroll
        for (int ai = 0; ai < 2; ++ai)
#pragma unroll
            for (int m = 0; m < 4; ++m) { unsigned char* rowp = O + (size_t)(row0 + ai * HALF + m * 16) * ldc + col0;
                const f32x4 g0 = acc[ai][0][m][0], g1 = acc[ai][0][m][1], u0 = acc[ai][1][m][0], u1 = acc[ai][1][m][1];
                const f32x2 a = sw2((f32x2){g0[0], g0[1]}, (f32x2){u0[0], u0[1]}), b = sw2((f32x2){g0[2], g0[3]}, (f32x2){u0[2], u0[3]});
                const f32x2 c = sw2((f32x2){g1[0], g1[1]}, (f32x2){u1[0], u1[1]}), d = sw2((f32x2){g1[2], g1[3]}, (f32x2){u1[2], u1[3]});
                u32x2 w; w.x = pk4_fp8(a.x, a.y, b.x, b.y); w.y = pk4_fp8(c.x, c.y, d.x, d.y);
                *(u32x2*)rowp = w; }
    }
};
struct EpiScaleBf16 {
    static constexpr bool PERM = true, AFTER_DRAIN = false;
    bf16_t* O; int ldc; const float* rowscale;
    __device__ __forceinline__ void operator()(const f32x4 (&acc)[2][2][4][2], const Unit& u, int wr, int wc, int fr, int fq) const {
        const int row0 = u.pm * BM + wr * 64 + fr, col0 = (u.pn & 3) * BM + wc * 32 + 8 * fq;
#pragma unroll
        for (int ai = 0; ai < 2; ++ai)
#pragma unroll
            for (int m = 0; m < 4; ++m) { const int row = row0 + ai * HALF + m * 16; const float s = rowscale[row] * (1.0f / (WSCALE * HSCALE)); bf16_t* rowp = O + (size_t)row * ldc + col0;
#pragma unroll
                for (int bj = 0; bj < 2; ++bj) { const f32x4 v0 = acc[ai][bj][m][0] * s, v1 = acc[ai][bj][m][1] * s;
                    u32x4 w; w.x = cvt_pk_bf16(v0[0], v0[1]); w.y = cvt_pk_bf16(v0[2], v0[3]); w.z = cvt_pk_bf16(v1[0], v1[1]); w.w = cvt_pk_bf16(v1[2], v1[3]);
                    *(u32x4*)(rowp + bj * HALF) = w; } }
    }
};
struct EpiNull { static constexpr bool PERM = true, AFTER_DRAIN = false; __device__ __forceinline__ void operator()(const f32x4 (&)[2][2][4][2], const Unit&, int, int, int, int) const {} };
struct TailOrder {
    int G, c, pn;
    __device__ __forceinline__ bool next(int i, Unit& u) const { const int L = i * G + c; if (L >= 64) return false; u.pm = L; u.pn = pn; return true; }
    __device__ __forceinline__ void a_ready(const Unit&) const {}
    __device__ __forceinline__ void done(const Unit&) const {}
};
struct Moe1Order {
    int G, c;
    __device__ __forceinline__ bool next(int i, Unit& u) const {
        const int L = i * G + c; if (L >= 2048) return false;
        const int e = L >> 7, r = L & 127; u.pm = e * 8 + ((r >> 3) & 7); u.pn = e * 16 + 2 * (r & 7) + (r >> 6); return true;
    }
    __device__ __forceinline__ void a_ready(const Unit&) const {}
    __device__ __forceinline__ void done(const Unit&) const {}
};
struct Moe2Order {
    int G, c;
    __device__ __forceinline__ bool next(int i, Unit& u) const {
        const int L = i * G + c; if (L >= 512) return false;
        const int q = L & 7, Lp = L >> 3, e = 8 * (Lp >> 5) + q, k = Lp & 31; u.pm = e * 8 + (k & 7); u.pn = e * 4 + (k >> 3); return true;
    }
    __device__ __forceinline__ void a_ready(const Unit&) const {}
    __device__ __forceinline__ void done(const Unit&) const {}
};
template <class Epi, class Sched, bool ALIGN_EPI = false, bool SP2 = false, bool F8 = false>
__device__ __forceinline__ void gemm_phase(PG8_LAS unsigned char* lds, const Gemm g, const Sched& S, const Epi& E) {
    const int tid = ltid(), wid = __builtin_amdgcn_readfirstlane(tid >> 6), lane = tid & 63, wr = wid >> 2, wc = wid & 3, fr = lane & 15, fq = lane >> 4;
    const int K = g.K, nt = K / BK;
    unsigned voffA[2], voffB[2];
#pragma unroll
    for (int i = 0; i < 2; ++i) { int R, C; stage_rc(tid * 16 + i * 8192, R, C); const int Rb = Epi::PERM ? ((R & ~31) + perm32(R & 31)) : R;
        voffA[i] = (unsigned)(R * K + C) * 2u; voffB[i] = (unsigned)(Rb * K + C) * 2u; }
    const size_t kstep = (size_t)(BK * 2);
    const size_t hstep = (size_t)HALF * K * 2;
    const size_t tstep = 2 * hstep;
    const unsigned ldsw = (unsigned)wid * 1024u;
    const int aoff = lds_byte(wr * 64 + fr, fq * 8), boff = lds_byte(wc * 32 + fr, fq * 8);
#define PG8_SA(b, h) (((b) * 2 + (h)) * HTB)
#define PG8_SB(b, h) ((4 + (b) * 2 + (h)) * HTB)
#define PG8_STAGE(bufoff, gbase, voff) do { _Pragma("unroll") for (int _i = 0; _i < 2; ++_i) \
        __builtin_amdgcn_global_load_lds((const unsigned*)((const char*)(gbase) + (voff)[_i]), (PG8_LAS unsigned*)(lds + (bufoff) + ldsw + _i * 8192), 16, 0, 0); } while (0)
#define PG8_LDA(dst, b, h) do { _Pragma("unroll") for (int m = 0; m < 4; ++m) { if constexpr (F8) { dst##8[m] = cat8(*(const PG8_LAS bf16x8*)(lds + PG8_SA(b, h) + aoff + m * 2048), *(const PG8_LAS bf16x8*)(lds + PG8_SA(b, h) + aoff + m * 2048 + 1024)); } \
        else { _Pragma("unroll") for (int k = 0; k < 2; ++k) dst[m][k] = *(const PG8_LAS bf16x8*)(lds + PG8_SA(b, h) + aoff + m * 2048 + k * 1024); } } } while (0)
#define PG8_LDB(dst, b, h) do { _Pragma("unroll") for (int n = 0; n < 2; ++n) { if constexpr (F8) { dst##8[n] = cat8(*(const PG8_LAS bf16x8*)(lds + PG8_SB(b, h) + boff + n * 2048), *(const PG8_LAS bf16x8*)(lds + PG8_SB(b, h) + boff + n * 2048 + 1024)); } \
        else { _Pragma("unroll") for (int k = 0; k < 2; ++k) dst[n][k] = *(const PG8_LAS bf16x8*)(lds + PG8_SB(b, h) + boff + n * 2048 + k * 1024); } } } while (0)
#define PG8_MMA(ai, bj, At, Bt) do { __builtin_amdgcn_s_setprio(1); _Pragma("unroll") for (int m = 0; m < 4; ++m) _Pragma("unroll") for (int n = 0; n < 2; ++n) { \
        if constexpr (F8) { asm volatile("v_mfma_scale_f32_16x16x128_f8f6f4 %0, %1, %2, %0, %3, %3 op_sel_hi:[0,0,0]" : "+v"(acc[ai][bj][m][n]) : "v"(Bt##8[n]), "v"(At##8[m]), "v"(sc1)); } \
        else { _Pragma("unroll") for (int k = 0; k < 2; ++k) acc[ai][bj][m][n] = __builtin_amdgcn_mfma_f32_16x16x32_bf16(Bt[n][k], At[m][k], acc[ai][bj][m][n], 0, 0, 0); } } __builtin_amdgcn_s_setprio(0); } while (0)
#define PG8_WAIT_V(n) asm volatile("s_waitcnt vmcnt(" #n ")" ::: "memory")
#define PG8_WAIT_L(n) asm volatile("s_waitcnt lgkmcnt(" #n ")" ::: "memory")
#define PG8_BAR __builtin_amdgcn_s_barrier()
#define PG8_SCHED __builtin_amdgcn_sched_barrier(0)
    Unit cur, nxt; int ui = 0;
    if (!S.next(0, cur)) return;
    f32x4 acc[2][2][4][2];
#pragma unroll
    for (int a = 0; a < 2; ++a)
#pragma unroll
        for (int b = 0; b < 2; ++b)
#pragma unroll
            for (int m = 0; m < 4; ++m)
#pragma unroll
                for (int n = 0; n < 2; ++n) acc[a][b][m][n] = (f32x4){0.f, 0.f, 0.f, 0.f};
    bf16x8 At[4][2], B0[2][2], B1[2][2]; i32x8 At8[4], B08[2], B18[2];
    const int sc1 = 0x7F7F7F7F;
    const char* cA = (const char*)g.A + (size_t)cur.pm * tstep; const char* cB = (const char*)g.Bt + (size_t)cur.pn * tstep;
    S.a_ready(cur);
    if constexpr (SP2) {
        PG8_STAGE(PG8_SB(0, 0), cB, voffB); PG8_STAGE(PG8_SB(0, 1), cB + hstep, voffB); PG8_STAGE(PG8_SA(0, 0), cA, voffA); PG8_STAGE(PG8_SA(0, 1), cA + hstep, voffA);
        if (wr == 1) PG8_BAR;
        PG8_WAIT_V(2); PG8_BAR;
        PG8_STAGE(PG8_SB(1, 0), cB + kstep, voffB); PG8_STAGE(PG8_SA(1, 0), cA + kstep, voffA); PG8_STAGE(PG8_SB(1, 1), cB + hstep + kstep, voffB);
        PG8_WAIT_V(6); PG8_BAR;
    } else {
        PG8_STAGE(PG8_SB(0, 0), cB, voffB); PG8_STAGE(PG8_SA(0, 0), cA, voffA); PG8_STAGE(PG8_SB(0, 1), cB + hstep, voffB); PG8_STAGE(PG8_SA(0, 1), cA + hstep, voffA);
        if (wr == 1) PG8_BAR;
        PG8_WAIT_V(4); PG8_BAR;
        PG8_STAGE(PG8_SB(1, 0), cB + kstep, voffB); PG8_STAGE(PG8_SA(1, 0), cA + kstep, voffA); PG8_STAGE(PG8_SB(1, 1), cB + hstep + kstep, voffB);
        PG8_WAIT_V(6); PG8_BAR;
    }
    for (;;) {
        const bool has_next = S.next(ui + 1, nxt);
        const char* nA = has_next ? (const char*)g.A + (size_t)nxt.pm * tstep : cA; const char* nB = has_next ? (const char*)g.Bt + (size_t)nxt.pn * tstep : cB;
        for (int t = 0; t < nt; t += 2) {
            const bool last = (t == nt - 2);
            const char* a1 = cA + (size_t)(t + 1) * kstep;
            const char* a2 = last ? nA : cA + (size_t)(t + 2) * kstep; const char* b2 = last ? nB : cB + (size_t)(t + 2) * kstep;
            const char* a3 = a2 + kstep; const char* b3 = b2 + kstep;
            if (last && has_next) S.a_ready(nxt);
            if constexpr (SP2) {
            PG8_LDB(B0, 0, 0); PG8_LDB(B1, 0, 1); PG8_SCHED; PG8_LDA(At, 0, 0); PG8_STAGE(PG8_SA(1, 1), a1 + hstep, voffA);
            PG8_WAIT_V(8); PG8_WAIT_L(0); PG8_BAR; PG8_MMA(0, 0, At, B0); PG8_MMA(0, 1, At, B1); PG8_BAR; PG8_SCHED;
            PG8_LDA(At, 0, 1); PG8_STAGE(PG8_SB(0, 0), b2, voffB); PG8_STAGE(PG8_SB(0, 1), b2 + hstep, voffB); PG8_STAGE(PG8_SA(0, 0), a2, voffA);
            PG8_WAIT_V(8); PG8_WAIT_L(0); PG8_BAR; PG8_MMA(1, 0, At, B0); PG8_MMA(1, 1, At, B1); PG8_BAR; PG8_SCHED;
            PG8_LDB(B0, 1, 0); PG8_LDB(B1, 1, 1); PG8_SCHED; PG8_LDA(At, 1, 0); PG8_STAGE(PG8_SA(0, 1), a2 + hstep, voffA);
            PG8_WAIT_V(8); PG8_WAIT_L(0); PG8_BAR; PG8_MMA(0, 0, At, B0); PG8_MMA(0, 1, At, B1); PG8_BAR; PG8_SCHED;
            PG8_LDA(At, 1, 1); PG8_STAGE(PG8_SB(1, 0), b3, voffB); PG8_STAGE(PG8_SB(1, 1), b3 + hstep, voffB); PG8_STAGE(PG8_SA(1, 0), a3, voffA);
            PG8_WAIT_V(8); PG8_WAIT_L(0); PG8_BAR; PG8_MMA(1, 0, At, B0); PG8_MMA(1, 1, At, B1); PG8_BAR; PG8_SCHED;
            } else {
            PG8_LDB(B0, 0, 0); PG8_SCHED; PG8_LDA(At, 0, 0); PG8_STAGE(PG8_SA(1, 1), a1 + hstep, voffA);
            PG8_WAIT_L(8); PG8_BAR; PG8_WAIT_L(0); PG8_MMA(0, 0, At, B0); PG8_BAR; PG8_SCHED;
            PG8_LDB(B1, 0, 1); PG8_STAGE(PG8_SB(0, 0), b2, voffB);
            PG8_BAR; PG8_WAIT_L(0); PG8_MMA(0, 1, At, B1); PG8_BAR;
            PG8_LDA(At, 0, 1); PG8_STAGE(PG8_SA(0, 0), a2, voffA);
            PG8_BAR; PG8_WAIT_L(0); PG8_MMA(1, 0, At, B0); PG8_BAR; PG8_SCHED;
            PG8_STAGE(PG8_SB(0, 1), b2 + hstep, voffB);
            PG8_WAIT_V(6); PG8_BAR; PG8_MMA(1, 1, At, B1); PG8_BAR;
            PG8_LDB(B0, 1, 0); PG8_SCHED; PG8_LDA(At, 1, 0); PG8_STAGE(PG8_SA(0, 1), a2 + hstep, voffA);
            PG8_WAIT_L(8); PG8_BAR; PG8_WAIT_L(0); PG8_MMA(0, 0, At, B0); PG8_BAR; PG8_SCHED;
            PG8_LDB(B1, 1, 1); PG8_STAGE(PG8_SB(1, 0), b3, voffB);
            PG8_BAR; PG8_WAIT_L(0); PG8_MMA(0, 1, At, B1); PG8_BAR;
            PG8_LDA(At, 1, 1); PG8_STAGE(PG8_SA(1, 0), a3, voffA);
            PG8_BAR; PG8_WAIT_L(0); PG8_MMA(1, 0, At, B0); PG8_BAR; PG8_SCHED;
            PG8_STAGE(PG8_SB(1, 1), b3 + hstep, voffB);
            PG8_WAIT_V(6); PG8_BAR; PG8_MMA(1, 1, At, B1); PG8_BAR;
            }
        }
        if constexpr (F8) { asm volatile("s_nop 15\n\ts_nop 15" ::: "memory"); }
        if constexpr (ALIGN_EPI) { if (wr == 0) PG8_BAR; }
        if constexpr (!Epi::AFTER_DRAIN) { E(acc, cur, wr, wc, fr, fq); S.done(cur); }
        if (!has_next) break;
#pragma unroll
        for (int a = 0; a < 2; ++a)
#pragma unroll
            for (int b = 0; b < 2; ++b)
#pragma unroll
                for (int m = 0; m < 4; ++m)
#pragma unroll
                    for (int n = 0; n < 2; ++n) acc[a][b][m][n] = (f32x4){0.f, 0.f, 0.f, 0.f};
        cur = nxt; cA = nA; cB = nB; ++ui;
        if constexpr (ALIGN_EPI) { if (wr == 1) PG8_BAR; }
    }
    PG8_WAIT_V(0);
    if constexpr (!ALIGN_EPI) { if (wr == 0) PG8_BAR; }
    PG8_BAR;
    if constexpr (Epi::AFTER_DRAIN) { E.fused(acc, cur, wr, wc, fr, fq, lds, wid, lane); S.done(cur); }
#undef PG8_SA
#undef PG8_SB
#undef PG8_STAGE
#undef PG8_LDA
#undef PG8_LDB
#undef PG8_MMA
#undef PG8_WAIT_V
#undef PG8_WAIT_L
#undef PG8_BAR
#undef PG8_SCHED
}
}

namespace attn_body {
using bf16=__hip_bfloat16;
using bf16x8=__attribute__((ext_vector_type(8)))short;
using s16x4=__attribute__((ext_vector_type(4)))short;
using f32x16=__attribute__((ext_vector_type(16)))float;
using u32x4=__attribute__((ext_vector_type(4)))unsigned;
constexpr int BATCH=8,NHEAD=8,NKV=2,SEQ=2048,D=64,PQ=2304,PO=1024;
constexpr int NW=8,QBLK=32,QB=QBLK*NW,KVBLK=64,NQB=SEQ/QB;
constexpr int ATTN_UNIT_ROWS=QB;
__device__ __forceinline__ int crow(int r,int hi){return (r&3)+8*(r>>2)+4*hi;}
#define SBAR() __builtin_amdgcn_sched_barrier(0)
__device__ __forceinline__ void cmask(f32x16&p0,f32x16&p1,int jb,int qrel,int hi){
  const float NEG=-INFINITY; int kb=64*jb+4*hi;
  #pragma unroll
  for(int r=0;r<16;++r){int kv=kb+(r&3)+8*(r>>2); if(kv>qrel)p0[r]=NEG; if(kv+32>qrel)p1[r]=NEG;}
}

constexpr int NSLOT=3, SLOTB=8192;
constexpr int LDS_K=0, LDS_V=NSLOT*SLOTB, LDS_WS=2*NSLOT*SLOTB, LDS_OST=LDS_WS+NW*64*4, LDS_BYTES=LDS_OST+NW*4096;
constexpr float C2=0.125f*1.4426950408889634f;
__device__ __forceinline__ void glds16(const void*gsrc,unsigned lds_dst){unsigned keep;
  asm volatile("s_mov_b32 %0, m0\n\ts_mov_b32 m0, %2\n\ts_nop 0\n\tglobal_load_lds_dwordx4 %1, off\n\ts_mov_b32 m0, %0":"=&s"(keep):"v"(gsrc),"s"(lds_dst):"memory");}
__device__ __forceinline__ float max3f(float a,float b,float c){float r;asm("v_max3_f32 %0, %1, %2, %3":"=v"(r):"v"(a),"v"(b),"v"(c));return r;}
__device__ __forceinline__ float max2f(float a,float b){float r;asm("v_max_f32_e32 %0, %1, %2":"=v"(r):"v"(a),"v"(b));return r;}
__device__ __forceinline__ float fadd_s(float a,float b){float r;asm("v_add_f32_e32 %0, %1, %2":"=v"(r):"v"(a),"v"(b));return r;}
__device__ __forceinline__ float fsub_s(float a,float b){float r;asm("v_sub_f32_e32 %0, %1, %2":"=v"(r):"v"(a),"v"(b));return r;}
typedef float f32x2_t __attribute__((ext_vector_type(2))); typedef __bf16 bf16x2_t __attribute__((ext_vector_type(2)));
__device__ __forceinline__ unsigned cvtpk_s(float lo,float hi){f32x2_t v={lo,hi};bf16x2_t b=__builtin_convertvector(v,bf16x2_t);return __builtin_bit_cast(unsigned,b);}
#define WAIT_BAR(N) asm volatile("s_waitcnt vmcnt(" #N ") lgkmcnt(0)\n\ts_barrier":::"memory")

__device__ __forceinline__ void qkt(f32x16&p0,f32x16&p1,const char*Kslot,const bf16x8*qr,const f32x16&negm,int r32,int hi){
  const char*kb=Kslot+hi*1024+r32*16;
  #pragma unroll
  for(int d0=0;d0<4;++d0){
    const bf16x8 b0=*reinterpret_cast<const bf16x8*>(kb+d0*2048);
    const bf16x8 b1=*reinterpret_cast<const bf16x8*>(kb+d0*2048+512);
    if(d0==0){p0=__builtin_amdgcn_mfma_f32_32x32x16_bf16(b0,qr[0],negm,0,0,0);p1=__builtin_amdgcn_mfma_f32_32x32x16_bf16(b1,qr[0],negm,0,0,0);}
    else{p0=__builtin_amdgcn_mfma_f32_32x32x16_bf16(b0,qr[d0],p0,0,0,0);p1=__builtin_amdgcn_mfma_f32_32x32x16_bf16(b1,qr[d0],p1,0,0,0);}}
}
typedef __attribute__((address_space(3))) const char* lds_cptr;
typedef short v4i16_t __attribute__((ext_vector_type(4)));
__device__ __forceinline__ void kload8(bf16x8*kf,lds_cptr kp){
  kf[0]=*(const __attribute__((address_space(3))) bf16x8*)(kp);      kf[1]=*(const __attribute__((address_space(3))) bf16x8*)(kp+512);
  kf[2]=*(const __attribute__((address_space(3))) bf16x8*)(kp+2048); kf[3]=*(const __attribute__((address_space(3))) bf16x8*)(kp+2560);
  kf[4]=*(const __attribute__((address_space(3))) bf16x8*)(kp+4096); kf[5]=*(const __attribute__((address_space(3))) bf16x8*)(kp+4608);
  kf[6]=*(const __attribute__((address_space(3))) bf16x8*)(kp+6144); kf[7]=*(const __attribute__((address_space(3))) bf16x8*)(kp+6656);
}
__device__ __forceinline__ void kload2(bf16x8*kf,lds_cptr kp,int j){ kf[2*j]=*(const __attribute__((address_space(3))) bf16x8*)(kp+j*2048); kf[2*j+1]=*(const __attribute__((address_space(3))) bf16x8*)(kp+j*2048+512); }
__device__ __forceinline__ s16x4 vtr(lds_cptr p){ return __builtin_bit_cast(s16x4,__builtin_amdgcn_ds_read_tr16_b64_v4i16((__attribute__((address_space(3))) v4i16_t*)p)); }
__device__ __forceinline__ float rowmax(const f32x16&p0,const f32x16&p1){
  float a=max3f(p0[0],p0[1],p1[0]),b=max3f(p0[2],p0[3],p1[1]);a=max3f(a,p1[2],p1[3]);
  #pragma unroll
  for(int r=4;r<16;r+=4){a=max3f(a,p0[r],p0[r+1]);b=max3f(b,p0[r+2],p0[r+3]);a=max3f(a,p1[r],p1[r+1]);b=max3f(b,p1[r+2],p1[r+3]);}
  const float m=max2f(a,b);
  auto rr=__builtin_amdgcn_permlane32_swap(__float_as_uint(m),__float_as_uint(m),false,false);
  return max2f(__uint_as_float(rr[0]),__uint_as_float(rr[1]));
}
__device__ __forceinline__ void pv(f32x16*o,int vb,bf16x8 pa0,bf16x8 pa1,bf16x8 pa2,bf16x8 pa3){
  #pragma unroll
  for(int d0=0;d0<2;++d0){s16x4 lo[4],hi[4];
    #pragma unroll
    for(int ks=0;ks<4;++ks){
      asm volatile("ds_read_b64_tr_b16 %0,%1 offset:%c2":"=&v"(lo[ks]):"v"(vb),"i"(d0*4096+ks*1024):"memory");
      asm volatile("ds_read_b64_tr_b16 %0,%1 offset:%c2":"=&v"(hi[ks]):"v"(vb),"i"(d0*4096+ks*1024+512):"memory");}
    asm volatile("s_waitcnt lgkmcnt(0)":::"memory");SBAR();
    #define PK(k) (bf16x8){lo[k][0],lo[k][1],lo[k][2],lo[k][3],hi[k][0],hi[k][1],hi[k][2],hi[k][3]}
    o[d0]=__builtin_amdgcn_mfma_f32_32x32x16_bf16(pa0,PK(0),o[d0],0,0,0);
    o[d0]=__builtin_amdgcn_mfma_f32_32x32x16_bf16(pa1,PK(1),o[d0],0,0,0);
    o[d0]=__builtin_amdgcn_mfma_f32_32x32x16_bf16(pa2,PK(2),o[d0],0,0,0);
    o[d0]=__builtin_amdgcn_mfma_f32_32x32x16_bf16(pa3,PK(3),o[d0],0,0,0);
    #undef PK
  }
}

#ifndef ATTN_STORE16
#define ATTN_STORE16(p,v) (*(u32x4*)(p)=(v))
#endif
template<int THRL> __device__ __forceinline__ void attn_unit(int b,int h,int qb,const bf16*Q,const bf16*__restrict__ K,const bf16*__restrict__ V,bf16*O,char*shm){
  const int tid=ltid(),lane=tid&63,r32=lane&31,hi=lane>>5; const int wid=__builtin_amdgcn_readfirstlane(tid>>6);
  const long rowbase=(long)b*SEQ; const int q0=qb*QB;
  const bf16*Qw=Q+(rowbase+q0+wid*QBLK)*PQ+h*D;
  const bf16*Kh=K+rowbase*PQ+(h>>2)*D,*Vh=V+rowbase*PQ+(h>>2)*D;
  const unsigned lds0=(unsigned)(uintptr_t)shm;
  float*wsf=(float*)(shm+LDS_WS)+wid*64;
  const bf16*ksrc=Kh+(long)lane*PQ+wid*8;
  const bf16*vsrc=Vh+(long)(16*(wid&3)+(lane>>2))*PQ+(wid>>2)*32+(lane&3)*8;
  const unsigned kdst=lds0+LDS_K+wid*1024, vdst=lds0+LDS_V+wid*1024;
  #define DMA_K(t,slot) glds16(ksrc+(long)(t)*KVBLK*PQ,(unsigned)__builtin_amdgcn_readfirstlane(kdst+(slot)))
  #define DMA_V(t,slot) glds16(vsrc+(long)(t)*KVBLK*PQ,(unsigned)__builtin_amdgcn_readfirstlane(vdst+(slot)))
  const int vb0=(int)(lds0+LDS_V)+((lane>>4)&1)*32+(lane&3)*8+(4*hi+((lane&15)>>2))*64;
  const char*Kbase=shm+LDS_K; bf16x8 kf[8];
  const lds_cptr shm3=(lds_cptr)shm; const lds_cptr kp0=shm3+LDS_K+hi*1024+r32*16; const lds_cptr vp0=shm3+LDS_V+((lane>>4)&1)*32+(lane&3)*8+(4*hi+((lane&15)>>2))*64;
  const int NT=SEQ/KVBLK;
  DMA_K(0,0);DMA_V(0,0);DMA_K(1,SLOTB);
  bf16x8 qr[4];
  #pragma unroll
  for(int d0=0;d0<4;++d0)qr[d0]=*reinterpret_cast<const bf16x8*>(&Qw[(long)r32*PQ+d0*16+hi*8]);
  float mhat=0.f,l_reg=0.f;f32x16 o[2];o[0]=f32x16{};o[1]=f32x16{};f32x16 negm=f32x16{};asm volatile("":"+v"(negm));
  const int qrel=wid*QBLK+r32;
  #define CMASK(P0,P1,t) do{}while(0)
  bool resc=false;
  #define START(P0,P1) do{ const float rm=rowmax(P0,P1); resc=false; \
    { const float dl=rm; mhat=fadd_s(mhat,dl); \
      _Pragma("unroll") for(int r=0;r<16;++r){P0[r]=fsub_s(P0[r],dl);P1[r]=fsub_s(P1[r],dl);} \
      _Pragma("unroll") for(int r=0;r<16;++r)negm[r]=-mhat; asm volatile("":"+v"(negm)); } \
    _Pragma("unroll") for(int r=0;r<16;++r)P0[r]=__builtin_amdgcn_exp2f(P0[r]); }while(0)
  #define RESC() do{ if(resc){ asm volatile("s_waitcnt lgkmcnt(0)":::"memory"); \
      _Pragma("unroll") for(int d_=0;d_<2;++d_) _Pragma("unroll") for(int r=0;r<16;++r)o[d_][r]*=wsf[crow(r,hi)]; } }while(0)
  f32x16 pA0,pA1,pB0,pB1;
  int sl_prev=0,sl_cur=0,sl_next=SLOTB;
  #define ROT() do{sl_prev=sl_cur;sl_cur=sl_next;sl_next=(sl_next==(NSLOT-1)*SLOTB)?0:sl_next+SLOTB;}while(0)
  DMA_K(2,2*SLOTB);
  WAIT_BAR(3);
  qkt(pA0,pA1,Kbase,qr,negm,r32,hi);asm volatile("s_nop 15\n\ts_nop 7":"+v"(pA0),"+v"(pA1));CMASK(pA0,pA1,0);
  START(pA0,pA1);
  _Pragma("unroll") for(int r=0;r<16;++r)pA1[r]=__builtin_amdgcn_exp2f(pA1[r]);
  WAIT_BAR(0);
  DMA_K(3,0);DMA_V(1,SLOTB);
  ROT();
  kload8(kf,kp0+sl_cur);
  WAIT_BAR(2);
  s16x4 vlo[8],vhi[8]; u32x4 pw0,pw1,pw2,pw3;
  #define PKW(P,B) cvtpk_s(P[B],P[B+1])
  #define PAF(k) __builtin_bit_cast(bf16x8,pw##k)
  #define VFR(i) (bf16x8){vlo[i][0],vlo[i][1],vlo[i][2],vlo[i][3],vhi[i][0],vhi[i][1],vhi[i][2],vhi[i][3]}
  #define PIN(x) asm volatile("":"+v"(x))
  #define MX3(a,b,c) __builtin_fmaxf(__builtin_fmaxf((a),(b)),(c))
  #define GAPA(MF,A0,A1,A2,A3,W0,W1,PW) do{ MF; sacc+=A0; sacc+=A1; sacc+=A2; sacc+=A3; PIN(sacc); W0; W1; PIN(PW); SBAR(); }while(0)
  #define EX(v) __builtin_amdgcn_exp2f(v)
  #define GAPB(MF,X,B) do{ MF; X[B]=EX(X[B]); X[B+1]=EX(X[B+1]); X[B+2]=EX(X[B+2]); X[B+3]=EX(X[B+3]); PIN(X); SBAR(); }while(0)
  #define VRD(i) do{ vlo[i]=vtr(vp_+(((i)>>2)*4096+((i)&3)*1024)); vhi[i]=vtr(vp_+(((i)>>2)*4096+((i)&3)*1024+512)); }while(0)
  #define KRD(G,j) do{ if(G){ kload2(kf,kp0+sl_next,j); SBAR(); } }while(0)
  #define STEP(C0,C1,P0,P1,t,GK,GV,GL) do{ SBAR(); \
    const lds_cptr vp_=vp0+sl_prev; \
    VRD(0); SBAR(); float sacc=(P0[0]+P0[1]); \
    GAPA(C0=__builtin_amdgcn_mfma_f32_32x32x16_bf16(kf[0],qr[0],negm,0,0,0), P0[2],P0[3],P0[4],P0[5],     pw0[0]=PKW(P0,0), pw0[1]=PKW(P0,2), pw0); \
    VRD(4); SBAR(); GAPA(C1=__builtin_amdgcn_mfma_f32_32x32x16_bf16(kf[1],qr[0],negm,0,0,0), P0[6],P0[7],P0[8],P0[9],     pw0[2]=PKW(P0,4), pw0[3]=PKW(P0,6), pw0); \
    VRD(1); SBAR(); GAPA(C0=__builtin_amdgcn_mfma_f32_32x32x16_bf16(kf[2],qr[1],C0,0,0,0),   P0[10],P0[11],P0[12],P0[13], pw1[0]=PKW(P0,8), pw1[1]=PKW(P0,10), pw1); \
    VRD(5); SBAR(); GAPA(C1=__builtin_amdgcn_mfma_f32_32x32x16_bf16(kf[3],qr[1],C1,0,0,0),   P0[14],P0[15],P1[0],P1[1],   pw1[2]=PKW(P0,12),pw1[3]=PKW(P0,14), pw1); \
    VRD(2); SBAR(); GAPA(C0=__builtin_amdgcn_mfma_f32_32x32x16_bf16(kf[4],qr[2],C0,0,0,0),   P1[2],P1[3],P1[4],P1[5],     pw2[0]=PKW(P1,0), pw2[1]=PKW(P1,2), pw2); \
    VRD(6); SBAR(); GAPA(C1=__builtin_amdgcn_mfma_f32_32x32x16_bf16(kf[5],qr[2],C1,0,0,0),   P1[6],P1[7],P1[8],P1[9],     pw2[2]=PKW(P1,4), pw2[3]=PKW(P1,6), pw2); \
    VRD(3); SBAR(); GAPA(C0=__builtin_amdgcn_mfma_f32_32x32x16_bf16(kf[6],qr[3],C0,0,0,0),   P1[10],P1[11],P1[12],P1[13], pw3[0]=PKW(P1,8), pw3[1]=PKW(P1,10), pw3); \
    VRD(7); SBAR(); GAPA(C1=__builtin_amdgcn_mfma_f32_32x32x16_bf16(kf[7],qr[3],C1,0,0,0),   P1[14],P1[15],0.f,0.f,       pw3[2]=PKW(P1,12),pw3[3]=PKW(P1,14), pw3); \
    l_reg+=sacc; \
    if(GK){DMA_K((t)+3,sl_cur);} if(GV){DMA_V((t)+1,sl_next);} \
    CMASK(C0,C1,t); \
    { float a=MX3(C0[0],C0[1],C1[0]),b=MX3(C0[2],C0[3],C1[1]); a=MX3(a,C1[2],C1[3]); \
      _Pragma("unroll") for(int r=4;r<16;r+=4){a=MX3(a,C0[r],C0[r+1]);b=MX3(b,C0[r+2],C0[r+3]);a=MX3(a,C1[r],C1[r+1]);b=MX3(b,C1[r+2],C1[r+3]);} \
      float rm=__builtin_fmaxf(a,b); { auto rr=__builtin_amdgcn_permlane32_swap(__float_as_uint(rm),__float_as_uint(rm),false,false); rm=__builtin_fmaxf(__uint_as_float(rr[0]),__uint_as_float(rr[1])); } \
      resc=false; \
      if(__builtin_expect(__any(rm>(float)THRL),0)){ const float dl=__builtin_fmaxf(rm,0.f); mhat+=dl; \
        _Pragma("unroll") for(int r=0;r<16;++r){C0[r]-=dl;C1[r]-=dl;} \
        _Pragma("unroll") for(int r=0;r<16;++r)negm[r]=-mhat; asm volatile("":"+v"(negm)); \
        const float f=__builtin_amdgcn_exp2f(-dl); l_reg*=f; if(hi==0)wsf[r32]=f; resc=true; } } \
    SBAR(); \
    GAPB(o[0]=__builtin_amdgcn_mfma_f32_32x32x16_bf16(PAF(0),VFR(0),o[0],0,0,0), C0,0); \
    GAPB(o[1]=__builtin_amdgcn_mfma_f32_32x32x16_bf16(PAF(0),VFR(4),o[1],0,0,0), C0,4); \
    KRD(GL,0); GAPB(o[0]=__builtin_amdgcn_mfma_f32_32x32x16_bf16(PAF(1),VFR(1),o[0],0,0,0), C0,8); \
    KRD(GL,1); GAPB(o[1]=__builtin_amdgcn_mfma_f32_32x32x16_bf16(PAF(1),VFR(5),o[1],0,0,0), C0,12); \
    KRD(GL,2); GAPB(o[0]=__builtin_amdgcn_mfma_f32_32x32x16_bf16(PAF(2),VFR(2),o[0],0,0,0), C1,0); \
    KRD(GL,3); GAPB(o[1]=__builtin_amdgcn_mfma_f32_32x32x16_bf16(PAF(2),VFR(6),o[1],0,0,0), C1,4); \
    GAPB(o[0]=__builtin_amdgcn_mfma_f32_32x32x16_bf16(PAF(3),VFR(3),o[0],0,0,0), C1,8); \
    GAPB(o[1]=__builtin_amdgcn_mfma_f32_32x32x16_bf16(PAF(3),VFR(7),o[1],0,0,0), C1,12); \
    }while(0)
  int t=1;
  #undef CMASK
  #define CMASK(P0,P1,t) do{}while(0)
  for(;t+5<NT;t+=2){
    STEP(pB0,pB1,pA0,pA1,t,true,true,true);     WAIT_BAR(2); RESC(); ROT();
    STEP(pA0,pA1,pB0,pB1,t+1,true,true,true);   WAIT_BAR(2); RESC(); ROT();
  }
  #undef CMASK
  #define CMASK(P0,P1,t) do{}while(0)
  #define ENDW(tt) do{ if((tt)+3<NT){WAIT_BAR(2);} else if((tt)+2<NT){WAIT_BAR(1);} else {WAIT_BAR(0);} }while(0)
  for(;t+1<NT;t+=2){
    STEP(pB0,pB1,pA0,pA1,t,(t+3<NT),(t+1<NT),(t+1<NT));       ENDW(t);   RESC(); ROT();
    STEP(pA0,pA1,pB0,pB1,t+1,(t+4<NT),(t+2<NT),(t+2<NT));     ENDW(t+1); RESC(); ROT();
  }
  STEP(pB0,pB1,pA0,pA1,NT-1,false,false,false); RESC();
  { float sacc=pB0[0]+pB0[1]; _Pragma("unroll") for(int r=2;r<16;++r)sacc+=pB0[r]; _Pragma("unroll") for(int r=0;r<16;++r)sacc+=pB1[r]; l_reg+=sacc;
    pw0=(u32x4){PKW(pB0,0),PKW(pB0,2),PKW(pB0,4),PKW(pB0,6)};pw1=(u32x4){PKW(pB0,8),PKW(pB0,10),PKW(pB0,12),PKW(pB0,14)};pw2=(u32x4){PKW(pB1,0),PKW(pB1,2),PKW(pB1,4),PKW(pB1,6)};pw3=(u32x4){PKW(pB1,8),PKW(pB1,10),PKW(pB1,12),PKW(pB1,14)};
    SBAR(); pv(o,vb0+sl_cur,PAF(0),PAF(1),PAF(2),PAF(3)); }
  #undef PKW
  #undef PAF
  #undef VFR
  #undef PIN
  #undef MX3
  #undef GAPA
  #undef GAPB
  #undef EX
  #undef VRD
  #undef KRD
  #undef STEP
  #undef ENDW
  {auto rr=__builtin_amdgcn_permlane32_swap(__float_as_uint(l_reg),__float_as_uint(l_reg),false,false);l_reg=__uint_as_float(rr[0])+__uint_as_float(rr[1]);}
  if(hi==0)wsf[32+r32]=l_reg;asm volatile("s_waitcnt lgkmcnt(0)":::"memory");
  float rli[16];
  #pragma unroll
  for(int r=0;r<16;++r)rli[r]=__builtin_amdgcn_rcpf(wsf[32+crow(r,hi)]);
  bf16*Ow=O+(rowbase+q0+wid*QBLK)*PO+h*D;
  { bf16*stg=(bf16*)(shm+LDS_OST)+wid*2048;
    #pragma unroll
    for(int r=0;r<16;++r){const int orow=crow(r,hi);
      #pragma unroll
      for(int d0=0;d0<2;++d0)stg[orow*64+d0*32+r32]=__float2bfloat16(o[d0][r]*rli[r]);}
    asm volatile("s_waitcnt lgkmcnt(0)":::"memory");
    #pragma unroll
    for(int i=0;i<4;++i){const int row=i*8+(lane>>3),ch=lane&7; const u32x4 v=*(const u32x4*)(stg+row*64+ch*8); ATTN_STORE16(Ow+(long)row*PO+ch*8,v);} }
  asm volatile("s_waitcnt lgkmcnt(0)\n\ts_barrier":::"memory");
  #undef DMA_K
  #undef DMA_V
  #undef CMASK
  #undef START
  #undef RESC
  #undef ROT
}
constexpr int ATTN_LDS_BYTES=LDS_BYTES;
struct AttnTensors { const bf16* Q; const bf16* K; const bf16* V; bf16* O; };
struct AttnUnit { int b; int h; int qb; };
struct StaticOrder {
  int vcu, G;
  __device__ __forceinline__ explicit StaticOrder(int grid,int block):vcu((grid%8==0)?(block%8)*(grid/8)+block/8:block),G(grid){}
  __device__ __forceinline__ bool next(int i,AttnUnit&u)const{ const int L=i*G+vcu; if(L>=BATCH*NHEAD*(SEQ/QB))return false; const int grp=L>>5,r=L&31; u.b=grp>>1; u.h=(grp&1)*4+(r>>3); u.qb=r&7; return true; }
  __device__ __forceinline__ void a_ready(const AttnUnit&)const{}
  __device__ __forceinline__ void done(const AttnUnit&)const{}
};
template<class Sched,int THRL=8> __device__ __forceinline__ void attn_phase(char*lds,const AttnTensors&T,const Sched&S){
  AttnUnit u;
  for(int i=0;S.next(i,u);++i){ S.a_ready(u); attn_unit<THRL>(u.b,u.h,u.qb,T.Q,T.K,T.V,T.O,lds); S.done(u); }
}
#undef SBAR
#undef WAIT_BAR
}


#define GAS __attribute__((address_space(1)))
#define LAS __attribute__((address_space(3)))
typedef unsigned short bf16;
typedef unsigned v4u __attribute__((ext_vector_type(4)));
typedef float f32x4 __attribute__((ext_vector_type(4)));
typedef short bf16x8 __attribute__((ext_vector_type(8)));
typedef GAS unsigned gu32;
typedef GAS unsigned long long gu64;
#define RLX_AGENT __ATOMIC_RELAXED, __HIP_MEMORY_SCOPE_AGENT
#define LDS_WAIT() asm volatile("s_waitcnt lgkmcnt(0)" ::: "memory")
#define VM_WAIT() asm volatile("s_waitcnt vmcnt(0)" ::: "memory")
__device__ __forceinline__ unsigned long long rt() { return __builtin_amdgcn_s_memrealtime(); }
__device__ __forceinline__ unsigned pk2(float lo, float hi) { typedef float f2_ __attribute__((ext_vector_type(2))); typedef __bf16 b2_ __attribute__((ext_vector_type(2))); const f2_ v = {lo, hi}; return __builtin_bit_cast(unsigned, __builtin_convertvector(v, b2_)); }
__device__ __forceinline__ unsigned f2bf(float f) { return pk2(f, 0.f) & 0xffffu; }

#define XB_TMO      128
#define XB_XCNT(j)  (256  + 64 * (j))
#define XB_XSUB(j)  (1280 + 64 * (j))
#define XB_XGEN(j)  (2304 + 64 * (j))
#define XB_TOP      3328
#define XB_TOPGEN   3392
#define XCD_BAR_WORDS 3456
#define XB_SPIN_CAP (1u << 18)

__device__ __forceinline__ unsigned xb_ld(unsigned* p)              { return __hip_atomic_load(p, __ATOMIC_RELAXED, __HIP_MEMORY_SCOPE_AGENT); }
__device__ __forceinline__ unsigned xb_add(unsigned* p, unsigned v) { return __hip_atomic_fetch_add(p, v, __ATOMIC_RELAXED, __HIP_MEMORY_SCOPE_AGENT); }
__device__ __forceinline__ unsigned xb_xcc_id() { return (unsigned)__builtin_amdgcn_s_getreg((3 << 11) | 20) & 0xFu; }
#define XB_SPIN(cond, bar) do { unsigned _sp = 0; while (cond) { __builtin_amdgcn_s_sleep(1); \
    if ((++_sp & 255u) == 0u) { if (xb_ld(&(bar)[XB_TMO])) break; if (_sp > XB_SPIN_CAP) { atomicAdd(&(bar)[XB_TMO], 1u); break; } } } } while (0)

struct XcdBarrier {
    unsigned* bar; unsigned x;
    volatile LAS unsigned* st;
};

__device__ __forceinline__ XcdBarrier xcd_barrier_post(unsigned* bar, volatile LAS unsigned* st) {
    XcdBarrier b; b.bar = bar; b.x = xb_xcc_id(); b.st = st;
    if (threadIdx.x == 0) (void)xb_add(&bar[XB_XCNT(b.x)], 1u);
    return b;
}
__device__ __forceinline__ void xcd_barrier_complete(unsigned* bar, unsigned x, unsigned& nloc, unsigned& nx) {
    const unsigned G = gridDim.x * gridDim.y * gridDim.z;
    unsigned sum, cnt, mine, sp = 0u;
    for (;;) {
        sum = 0u; cnt = 0u; mine = 0u;
        unsigned cj[16];
#pragma unroll
        for (unsigned j = 0; j < 16; ++j) cj[j] = xb_ld(&bar[XB_XCNT(j)]);
#pragma unroll
        for (unsigned j = 0; j < 16; ++j) { const unsigned c = cj[j]; sum += c; cnt += (c > 0u) ? 1u : 0u; mine = (j == x) ? c : mine; }
        if (sum == G) break;
        __builtin_amdgcn_s_sleep(1);
        if ((++sp & 255u) == 0u) { if (xb_ld(&bar[XB_TMO])) break; if (sp > XB_SPIN_CAP) { atomicAdd(&bar[XB_TMO], 1u); break; } }
    }
    nloc = mine > 0u ? mine : 1u; nx = cnt > 0u ? cnt : 1u;
}

__device__ __forceinline__ void xcd_barrier(const XcdBarrier& b) {
    asm volatile("s_waitcnt vmcnt(0)" ::: "memory");
    __syncthreads();
    if (threadIdx.x == 0) {
        unsigned* bar = b.bar;
        __builtin_amdgcn_s_waitcnt(0);
        unsigned nloc = b.st[0], nx = b.st[1];
        if (nloc == 0u) { xcd_barrier_complete(bar, b.x, nloc, nx); b.st[0] = nloc; b.st[1] = nx; }
        const unsigned old = xb_add(&bar[XB_XSUB(b.x)], 1u);
        const unsigned gen = old / nloc;
        if (old + 1u == (gen + 1u) * nloc) {
            __builtin_amdgcn_fence(__ATOMIC_RELEASE, "agent");
            asm volatile("s_waitcnt vmcnt(0)" ::: "memory");
            const unsigned og = xb_add(&bar[XB_TOP], 1u);
            const unsigned tg = og / nx;
            if (og + 1u == (tg + 1u) * nx) xb_add(&bar[XB_TOPGEN], 1u);
            else XB_SPIN(xb_ld(&bar[XB_TOPGEN]) == tg, bar);
            __builtin_amdgcn_fence(__ATOMIC_ACQUIRE, "agent");
            xb_add(&bar[XB_XGEN(b.x)], 1u);
            asm volatile("s_waitcnt vmcnt(0)" ::: "memory");
        } else {
            XB_SPIN(xb_ld(&bar[XB_XGEN(b.x)]) == gen, bar);
            __builtin_amdgcn_fence(__ATOMIC_ACQUIRE, "agent");
            asm volatile("s_waitcnt vmcnt(0)" ::: "memory");
        }
    }
    __syncthreads();
}

#ifndef MK_PER_PHASE
#define MK_PER_PHASE 0
#endif
constexpr int NWAVES = 8, NTHR = 512;
constexpr int DM = 1024, NB = 8, SEQ = 2048, DEPTH = 4, M = NB * SEQ;
constexpr int DIN = 2320, NPROJ = 2304;
constexpr int C_Q = 0, C_K = 512, C_V = 640, C_LX = 768, C_LG = 1024, C_MQ = 1280, C_MK = 1536, C_MV = 1792, C_MO = 2048;
constexpr int NE = 16, CAP = 256, DE = 2048, NSLOT = NB * CAP;
constexpr float EPS = 1e-6f;
constexpr int NPH = 1 + 10 * DEPTH;

constexpr size_t MiB = 1u << 20;
constexpr size_t WS_CTL = 0, CTL_ZERO_BYTES = 64 * 1024;
constexpr size_t WS_ROPE = 1 * MiB;
constexpr size_t WS_LRUW = 2 * MiB;
constexpr size_t WS_WIN = 4 * MiB;
constexpr size_t WS_WOUT = 22 * MiB;
constexpr size_t WS_WGU = 32 * MiB;
constexpr size_t WS_WDN = 544 * MiB;
constexpr size_t WS_H = 800 * MiB;
constexpr size_t WS_PROJ = 832 * MiB;
constexpr size_t WS_Y = 904 * MiB;
constexpr size_t WS_MG = 936 * MiB;
constexpr size_t WS_AFF = 937 * MiB;
constexpr size_t WS_SEL = 938 * MiB;
constexpr size_t WS_IDX = 939 * MiB;
constexpr size_t WS_GATE = WS_IDX + 128 * 1024;
constexpr size_t WS_LH = 940 * MiB;
constexpr size_t WS_CP = 956 * MiB;
constexpr size_t WS_CARRY = 972 * MiB;
constexpr size_t WS_CLOC = 974 * MiB;
constexpr size_t WS_NLOC = 990 * MiB;
constexpr size_t WS_MLOC = WS_NLOC + 512 * 1024;
constexpr size_t WS_XG = 992 * MiB;
constexpr size_t WS_HID = 1056 * MiB;
constexpr size_t WS_YE = 1184 * MiB;
constexpr size_t WS_CPREV = 1280 * MiB;
constexpr size_t WS_NPREV = 1288 * MiB;
constexpr size_t WS_MPREV = WS_NPREV + 512 * 1024;
constexpr size_t WS_XB = 1248 * MiB;
constexpr size_t WS_END = 1290 * MiB;
constexpr int CW_BAR = 4096;

constexpr int RING_OFF = 0, RING_BYTES = 143360;
constexpr int MISC_OFF = RING_BYTES;
constexpr int LDS_BYTES = 147456;

typedef unsigned u32x2 __attribute__((ext_vector_type(2)));
__device__ __forceinline__ float bf2f(unsigned short v) { return __uint_as_float(((unsigned)v) << 16); }
__device__ __forceinline__ float bflo(unsigned v) { return __uint_as_float(v << 16); }
__device__ __forceinline__ float bfhi(unsigned v) { return __uint_as_float(v & 0xffff0000u); }
template <int CTRL> __device__ __forceinline__ float dppf(float v) { return __uint_as_float((unsigned)__builtin_amdgcn_update_dpp(0, (int)__float_as_uint(v), CTRL, 0xF, 0xF, true)); }
__device__ __forceinline__ float row16_sum(float v) { v += dppf<0xB1>(v); v += dppf<0x4E>(v); v += dppf<0x141>(v); v += dppf<0x140>(v); return v; }
__device__ __forceinline__ float xor16_sum(float v) { const auto r = __builtin_amdgcn_permlane16_swap(__float_as_uint(v), __float_as_uint(v), false, false); return __uint_as_float(r[0]) + __uint_as_float(r[1]); }
__device__ __forceinline__ float xor32_sum(float v) { const auto r = __builtin_amdgcn_permlane32_swap(__float_as_uint(v), __float_as_uint(v), false, false); return __uint_as_float(r[0]) + __uint_as_float(r[1]); }
__device__ __forceinline__ float half_sum(float v) { return xor16_sum(row16_sum(v)); }
__device__ __forceinline__ float wave_sum(float v) { return xor32_sum(xor16_sum(row16_sum(v))); }
__device__ __forceinline__ void reduce16(const float (&p)[16], float (&r)[4]) {
    float q[8];
#pragma unroll
    for (int j = 0; j < 8; ++j) { const auto t = __builtin_amdgcn_permlane32_swap(__float_as_uint(p[j]), __float_as_uint(p[j + 8]), false, false); q[j] = __uint_as_float(t[0]) + __uint_as_float(t[1]); }
#pragma unroll
    for (int j = 0; j < 4; ++j) { const auto t = __builtin_amdgcn_permlane16_swap(__float_as_uint(q[j]), __float_as_uint(q[j + 4]), false, false); r[j] = row16_sum(__uint_as_float(t[0]) + __uint_as_float(t[1])); }
}
__device__ __forceinline__ float wave_max(float v) {
#pragma unroll
    for (int o = 1; o < 64; o <<= 1) v = fmaxf(v, __shfl_xor(v, o));
    return v;
}
__device__ __forceinline__ float fexp(float x) { return __builtin_amdgcn_exp2f(1.4426950408889634f * x); }
__device__ __forceinline__ float frcp(float x) { return __builtin_amdgcn_rcpf(x); }
__device__ __forceinline__ float frsq(float x) { return __builtin_amdgcn_rsqf(x); }
__device__ __forceinline__ float sigmoid_f(float x) { return frcp(1.0f + fexp(-x)); }
__device__ __forceinline__ float one_minus_exp(float x) {
    const float p = -x * (1.0f + 0.5f * x * (1.0f + (1.0f / 3.0f) * x * (1.0f + 0.25f * x * (1.0f + 0.2f * x))));
    return (x > -0.25f) ? p : 1.0f - fexp(x); }
__device__ __forceinline__ float logsig_f(float x) { return fminf(x, 0.f) - log1pf(expf(-fabsf(x))); }
__device__ __forceinline__ float gelu_tanh_f(float x) { const float u = 0.7978845608028654f * (x + 0.044715f * x * x * x); return x * (1.0f - frcp(1.0f + fexp(2.0f * u))); }
template <bool MAXOP, bool REV> __device__ __forceinline__ void wave_scan128(const LAS float* in, LAS float* out, int lane) {
    const int j0 = REV ? 127 - 2 * lane : 2 * lane, j1 = REV ? 126 - 2 * lane : 2 * lane + 1;
    const float a = in[j0], b = in[j1];
    const float s1 = MAXOP ? fmaxf(a, b) : a + b;
    float incl = s1;
#pragma unroll
    for (int o = 1; o < 64; o <<= 1) { const float t = __shfl_up(incl, o); if (lane >= o) incl = MAXOP ? fmaxf(incl, t) : incl + t; }
    const float ex = __shfl_up(incl, 1);
    const float e = (lane == 0) ? (MAXOP ? -INFINITY : 0.f) : ex;
    out[j0] = MAXOP ? fmaxf(e, a) : e + a; out[j1] = MAXOP ? fmaxf(e, s1) : e + s1;
}
#define WAVE_LDS_FENCE() asm volatile("s_waitcnt lgkmcnt(0)" ::: "memory")
#define MFMA16(a, b, c) __builtin_amdgcn_mfma_f32_16x16x32_bf16((a), (b), (c), 0, 0, 0)
#define WG_SYNC() __syncthreads()

struct Args { const float* in[22]; float* out; unsigned char* ws; int ph_lo, ph_hi, li, pad; };
enum { I_X = 0, I_N1G, I_WIN, I_QG, I_KG, I_CW, I_CB, I_WA, I_BA, I_WX, I_BX, I_LAM, I_FB, I_MNG, I_AOG, I_LOG, I_WOUT, I_N2G, I_WR, I_WG, I_WU, I_WD };

__device__ __forceinline__ void cvt_item(const float* __restrict__ src, int N, int k0, int n0, bf16* dst, int Kd, LAS float* scr, int lane) {
    { const int r4 = lane >> 4, c4 = lane & 15; f32x4 t[16];
#pragma unroll
      for (int i = 0; i < 16; ++i) t[i] = __builtin_nontemporal_load((const f32x4*)(src + (size_t)(k0 + 4 * i + r4) * N + n0 + 4 * c4));
#pragma unroll
      for (int i = 0; i < 16; ++i) { LAS float* d = scr + (4 * i + r4) * 65 + 4 * c4; d[0] = t[i][0]; d[1] = t[i][1]; d[2] = t[i][2]; d[3] = t[i][3]; } }
    LDS_WAIT(); asm volatile("" ::: "memory");
    const int c = lane >> 3, nn = lane & 7;
#pragma unroll
    for (int j = 0; j < 8; ++j) { const int n = nn + 8 * j; const LAS float* s = scr + (8 * c) * 65 + n;
        v4u o; o.x = pk2(s[0], s[65]); o.y = pk2(s[130], s[195]); o.z = pk2(s[260], s[325]); o.w = pk2(s[390], s[455]);
        *(GAS v4u*)(dst + (size_t)n * Kd + 8 * c) = o; }
    LDS_WAIT(); asm volatile("" ::: "memory");
}
__device__ __forceinline__ void cvt_item8(const float* __restrict__ src, int N, int k0, int n0, unsigned char* dst, int Kd, LAS float* scr, int lane) {
    { const int r8 = lane >> 3, c8 = lane & 7; f32x4 t[16];
#pragma unroll
      for (int i = 0; i < 16; ++i) t[i] = __builtin_nontemporal_load((const f32x4*)(src + (size_t)(k0 + 8 * i + r8) * N + n0 + 4 * c8));
#pragma unroll
      for (int i = 0; i < 16; ++i) { LAS float* d = scr + (8 * i + r8) * 33 + 4 * c8; d[0] = t[i][0]; d[1] = t[i][1]; d[2] = t[i][2]; d[3] = t[i][3]; } }
    LDS_WAIT(); asm volatile("" ::: "memory");
    const int c = lane >> 3, nn = lane & 7; constexpr float sc = pg8::WSCALE;
#pragma unroll
    for (int j = 0; j < 4; ++j) { const int n = nn + 8 * j; const LAS float* s = scr + (16 * c) * 33 + n;
        v4u o; o.x = pg8::pk4_fp8(s[0] * sc, s[33] * sc, s[66] * sc, s[99] * sc); o.y = pg8::pk4_fp8(s[132] * sc, s[165] * sc, s[198] * sc, s[231] * sc);
        o.z = pg8::pk4_fp8(s[264] * sc, s[297] * sc, s[330] * sc, s[363] * sc); o.w = pg8::pk4_fp8(s[396] * sc, s[429] * sc, s[462] * sc, s[495] * sc);
        *(GAS v4u*)(dst + (size_t)n * Kd + 16 * c) = o; }
    LDS_WAIT(); asm volatile("" ::: "memory");
}
__device__ __forceinline__ void p0_weights(const Args& a, LAS unsigned char* lds, int tid, int lane, int wave, int G, int bid) {
    unsigned char* ws = a.ws;
    LAS float* scr = (LAS float*)(lds + RING_OFF + wave * 16896);
    const int gw = bid * NWAVES + wave, NGW = G * NWAVES;
    constexpr int I_IN = 16 * 36, I_OUT = 16 * 16, I_EXP = 1536, PER_LAYER = I_IN + I_OUT + NE * I_EXP, NITEMS = DEPTH * PER_LAYER;
    for (int it = gw; it < NITEMS; it += NGW) {
        const int l = it / PER_LAYER; int r = it - l * PER_LAYER;
        if (r < I_IN) { const int kb = r / 36, nb = r - kb * 36;
            cvt_item(a.in[I_WIN] + (size_t)l * DM * DIN, DIN, 64 * kb, 64 * nb, (bf16*)(ws + WS_WIN) + ((size_t)l * NPROJ + 64 * nb) * DM + 64 * kb, DM, scr, lane); continue; }
        r -= I_IN;
        if (r < I_OUT) { const int kb = r >> 4, nb = r & 15;
            cvt_item(a.in[I_WOUT] + (size_t)l * DM * DM, DM, 64 * kb, 64 * nb, (bf16*)(ws + WS_WOUT) + ((size_t)l * DM + 64 * nb) * DM + 64 * kb, DM, scr, lane); continue; }
        r -= I_OUT;
        const int e = r / I_EXP; int r2 = r - e * I_EXP; const size_t le = (size_t)l * NE + e;
        LAS float* scr8 = (LAS float*)(lds + RING_OFF + wave * 16896);
        if (r2 < 1024) { const int up = r2 >> 9; r2 &= 511; const int kb = r2 >> 6, nb = r2 & 63, n0 = 32 * nb, drow = 256 * (n0 >> 7) + (n0 & 127) + 128 * up;
            cvt_item8(a.in[up ? I_WU : I_WG] + le * DM * DE, DE, 128 * kb, n0, ws + WS_WGU + (le * 4096 + drow) * DM + 128 * kb, DM, scr8, lane); continue; }
        r2 -= 1024; { const int kb = r2 >> 5, nb = r2 & 31;
            cvt_item8(a.in[I_WD] + le * DE * DM, DM, 128 * kb, 32 * nb, ws + WS_WDN + (le * DM + 32 * nb) * DE + 128 * kb, DE, scr8, lane); }
    }
    const int gt = bid * NTHR + tid, GT = G * NTHR;
    bf16* lw = (bf16*)(ws + WS_LRUW);
    for (int i = gt; i < DEPTH * 2 * 2 * 4 * 4096; i += GT) { const int d = i & 63, e = (i >> 6) & 63, n = (i >> 12) & 3, gate = (i >> 14) & 1, dir = (i >> 15) & 1, l = i >> 16;
        const float* src = a.in[gate ? I_WX : I_WA]; lw[i] = (bf16)f2bf(src[((((size_t)l * 2 + dir) * 4 + n) * 64 + d) * 64 + e]); }
    float* rc = (float*)(ws + WS_ROPE); float* rs = rc + SEQ * 32;
    for (int i = gt; i < SEQ * 32; i += GT) { const int s = i >> 5, j = i & 31, f = j & 15; const float pos = (float)((j < 16) ? (s >> 6) : (s & 63));
        const float inv = 1.0f / powf(10000.0f, (float)f * (1.0f / 16.0f)); const float ang = pos * inv; rc[i] = cosf(ang); rs[i] = sinf(ang); }
}

__device__ __forceinline__ void stage_w16(const float* WT, int sk, LAS unsigned char* lds, int tid) {
    constexpr int WLS = 1028; LAS float* wl = (LAS float*)(lds + RING_OFF); float wv[32];
#pragma unroll
    for (int q = 0; q < 32; ++q) { const int i = tid + q * NTHR; wv[q] = WT[(size_t)(i >> 4) * sk + (i & 15)]; }
#pragma unroll
    for (int q = 0; q < 32; ++q) { const int i = tid + q * NTHR; wl[(i & 15) * WLS + (i >> 4)] = wv[q]; }
}
template <int MODE, bool XB16, bool PRESTAGED = false>
__device__ __forceinline__ void row_pass(const void* xin_, void* xout_, const float* gain, const float* WT  , int sk, bf16* H, float* O16, const int* SEL, const bf16* YE,
                                         LAS unsigned char* lds, int tid, int lane, int wave, int G, int bid) {
    constexpr int WLS = 1028;
    LAS float* wl = (LAS float*)(lds + RING_OFF);
    if (MODE != 3 && !(PRESTAGED && !MK_PER_PHASE)) stage_w16(WT, sk, lds, tid);
    WG_SYNC();
    const int gw = bid * NWAVES + wave, NGW = G * NWAVES;
    f32x4 gq4[4];
#pragma unroll
    for (int j = 0; j < 4; ++j) gq4[j] = (MODE != 3) ? *((const f32x4*)gain + 64 * j + lane) : (f32x4){0.f, 0.f, 0.f, 0.f};
    constexpr int R = 4;
    for (int m0 = R * gw; m0 < M; m0 += R * NGW) {
        asm volatile("" ::: "memory");
        f32x4 v[R][4];
#pragma unroll
        for (int r = 0; r < R; ++r)
#pragma unroll
            for (int j = 0; j < 4; ++j) {
                if (XB16) { const u32x2 q = *((const u32x2*)((const bf16*)xin_ + (size_t)(m0 + r) * DM) + 64 * j + lane); v[r][j] = (f32x4){bflo(q.x), bfhi(q.x), bflo(q.y), bfhi(q.y)}; }
                else v[r][j] = *((const f32x4*)((const float*)xin_ + (size_t)(m0 + r) * DM) + 64 * j + lane); }
        if (MODE >= 2) {
            const int b = m0 >> 11; int selv[R]; unsigned long long mk[R];
#pragma unroll
            for (int r = 0; r < R; ++r) { selv[r] = (lane < NE) ? SEL[(size_t)(m0 + r) * NE + lane] : -1; }
#pragma unroll
            for (int r = 0; r < R; ++r) mk[r] = __ballot(selv[r] >= 0);
            while (mk[0] | mk[1] | mk[2] | mk[3]) {
                u32x2 q[R][2][4]; float wt[R][2];
#pragma unroll
                for (int r = 0; r < R; ++r)
#pragma unroll
                    for (int i = 0; i < 2; ++i) { const bf16* yr = YE; wt[r][i] = 0.f;
                        if (mk[r]) { const int e = __builtin_ctzll(mk[r]); mk[r] &= mk[r] - 1ull; const int sl = __builtin_amdgcn_readlane(selv[r], e);
                            yr = YE + ((size_t)e * NSLOT + b * CAP + sl) * DM; wt[r][i] = 1.f; }
#pragma unroll
                        for (int j = 0; j < 4; ++j) q[r][i][j] = *((const u32x2*)yr + 64 * j + lane); }
#pragma unroll
                for (int r = 0; r < R; ++r)
#pragma unroll
                    for (int i = 0; i < 2; ++i)
#pragma unroll
                        for (int j = 0; j < 4; ++j) { const u32x2 w = q[r][i][j]; const float t = wt[r][i];
                            v[r][j][0] += t * bflo(w.x); v[r][j][1] += t * bfhi(w.x); v[r][j][2] += t * bflo(w.y); v[r][j][3] += t * bfhi(w.y); }
            }
#pragma unroll
            for (int r = 0; r < R; ++r)
#pragma unroll
                for (int j = 0; j < 4; ++j) {
                    if (MODE == 3) *((f32x4*)((float*)xout_ + (size_t)(m0 + r) * DM) + 64 * j + lane) = v[r][j];
                    else { u32x2 o; o.x = pk2(v[r][j][0], v[r][j][1]); o.y = pk2(v[r][j][2], v[r][j][3]); *((u32x2*)((bf16*)xout_ + (size_t)(m0 + r) * DM) + 64 * j + lane) = o;
                        v[r][j] = (f32x4){bflo(o.x), bfhi(o.x), bflo(o.y), bfhi(o.y)}; } }
        }
        if (MODE == 3) continue;
        float ss[R];
#pragma unroll
        for (int r = 0; r < R; ++r) { float a = 0.f;
#pragma unroll
            for (int j = 0; j < 4; ++j) a += (v[r][j][0] * v[r][j][0] + v[r][j][1] * v[r][j][1]) + (v[r][j][2] * v[r][j][2] + v[r][j][3] * v[r][j][3]);
            ss[r] = wave_sum(a); }
#pragma unroll
        for (int r = 0; r < R; ++r) { const float rstd = frsq(ss[r] * (1.0f / DM) + EPS);
#pragma unroll
            for (int j = 0; j < 4; ++j) { v[r][j] = v[r][j] * rstd * gq4[j];
                if (MODE == 1) { *((unsigned*)((unsigned char*)H + (size_t)(m0 + r) * DM) + 64 * j + lane) = pg8::pk4_fp8(v[r][j][0], v[r][j][1], v[r][j][2], v[r][j][3]); }
                else { u32x2 o; o.x = pk2(v[r][j][0], v[r][j][1]); o.y = pk2(v[r][j][2], v[r][j][3]); *((u32x2*)(H + (size_t)(m0 + r) * DM) + 64 * j + lane) = o; } } }
        typedef float f32x2_ __attribute__((ext_vector_type(2)));
        float t4[R][4];
#pragma unroll
        for (int j4 = 0; j4 < 4; ++j4) { float pp[4][R];
#pragma unroll
            for (int h = 0; h < 4; ++h) { const int jj = j4 + 4 * h; f32x2_ a2[R];
#pragma unroll
                for (int r = 0; r < R; ++r) a2[r] = (f32x2_){0.f, 0.f};
#pragma unroll
                for (int j = 0; j < 4; ++j) { const f32x4 w = *((LAS f32x4*)(wl + jj * WLS) + 64 * j + lane); const f32x2_ wlo = (f32x2_){w[0], w[1]}, whi = (f32x2_){w[2], w[3]};
#pragma unroll
                    for (int r = 0; r < R; ++r) { a2[r] += (f32x2_){v[r][j][0], v[r][j][1]} * wlo; a2[r] += (f32x2_){v[r][j][2], v[r][j][3]} * whi; } }
#pragma unroll
                for (int r = 0; r < R; ++r) pp[h][r] = a2[r][0] + a2[r][1]; }
#pragma unroll
            for (int r = 0; r < R; ++r) {
                const auto ta = __builtin_amdgcn_permlane32_swap(__float_as_uint(pp[0][r]), __float_as_uint(pp[2][r]), false, false); const float qa = __uint_as_float(ta[0]) + __uint_as_float(ta[1]);
                const auto tb = __builtin_amdgcn_permlane32_swap(__float_as_uint(pp[1][r]), __float_as_uint(pp[3][r]), false, false); const float qb = __uint_as_float(tb[0]) + __uint_as_float(tb[1]);
                const auto tc = __builtin_amdgcn_permlane16_swap(__float_as_uint(qa), __float_as_uint(qb), false, false); t4[r][j4] = row16_sum(__uint_as_float(tc[0]) + __uint_as_float(tc[1])); }
            __builtin_amdgcn_sched_barrier(0); }
#pragma unroll
        for (int r = 0; r < R; ++r) { const int m = m0 + r;
            const int li = lane & 15, rho = lane >> 4, jj = (li & 3) + 4 * (rho & 1) + 8 * (rho >> 1);
            if (MODE == 1) {
                const float lm = fmaxf(fmaxf(t4[r][0], t4[r][1]), fmaxf(t4[r][2], t4[r][3]));
                const auto ta = __builtin_amdgcn_permlane16_swap(__float_as_uint(lm), __float_as_uint(lm), false, false); const float m1 = fmaxf(__uint_as_float(ta[0]), __uint_as_float(ta[1]));
                const auto tb = __builtin_amdgcn_permlane32_swap(__float_as_uint(m1), __float_as_uint(m1), false, false); const float mx = fmaxf(__uint_as_float(tb[0]), __uint_as_float(tb[1]));
                const float e0 = fexp(t4[r][0] - mx), e1 = fexp(t4[r][1] - mx), e2 = fexp(t4[r][2] - mx), e3 = fexp(t4[r][3] - mx);
                const float sum = xor32_sum(xor16_sum((e0 + e1) + (e2 + e3)));
                const float mine = (li & 3) == 0 ? e0 : (li & 3) == 1 ? e1 : (li & 3) == 2 ? e2 : e3;
                if (li < 4) O16[(((size_t)(m >> 11) * NE + jj) << 11) + (m & 2047)] = mine / sum;
            } else {
#pragma unroll
                for (int j = 0; j < 4; ++j) if (li == j) O16[(size_t)m * 16 + jj] = t4[r][j];
            } }
    }
}

__device__ __forceinline__ void rope_pass(const Args& a, int l, int lane, int wave, int G, int bid, bf16* DST) {
    const bf16* PROJ = (const bf16*)(a.ws + WS_PROJ); const float* rc = (const float*)(a.ws + WS_ROPE); const float* rs = rc + SEQ * 32;
    const float* qg = a.in[I_QG] + l * 64; const float* kg = a.in[I_KG] + l * 64;
    const int gw = bid * NWAVES + wave, NGW = G * NWAVES, hslot = lane >> 3, l8 = lane & 7;
    const f32x4 gq1 = *(const f32x4*)(qg + 4 * l8) * attn_body::C2, gq2 = *(const f32x4*)(qg + 32 + 4 * l8) * attn_body::C2;
    const f32x4 gk1 = *(const f32x4*)(kg + 4 * l8), gk2 = *(const f32x4*)(kg + 32 + 4 * l8);
    for (int mb = 4 * gw; mb < M; mb += 4 * NGW) {
        u32x2 xa[5], xb[5]; f32x4 cs[5], sn[5];
#pragma unroll
        for (int it = 0; it < 5; ++it) { const int hh = 8 * it + hslot, tok = (hh * 205) >> 11, head = hh - 10 * tok; const size_t m = (size_t)(mb + tok); const int s = (int)(m & 2047);
            const bf16* row = PROJ + m * NPROJ + head * 64 + 4 * l8; xa[it] = *(const u32x2*)row; xb[it] = *(const u32x2*)(row + 32);
            cs[it] = *(const f32x4*)(rc + s * 32 + 4 * l8); sn[it] = *(const f32x4*)(rs + s * 32 + 4 * l8); }
#pragma unroll
        for (int it = 0; it < 5; ++it) { const int hh = 8 * it + hslot, tok = (hh * 205) >> 11, head = hh - 10 * tok; const size_t m = (size_t)(mb + tok);
            const f32x4 x1 = (f32x4){bflo(xa[it].x), bfhi(xa[it].x), bflo(xa[it].y), bfhi(xa[it].y)}, x2 = (f32x4){bflo(xb[it].x), bfhi(xb[it].x), bflo(xb[it].y), bfhi(xb[it].y)};
            float ss = ((x1[0] * x1[0] + x1[1] * x1[1]) + (x1[2] * x1[2] + x1[3] * x1[3])) + ((x2[0] * x2[0] + x2[1] * x2[1]) + (x2[2] * x2[2] + x2[3] * x2[3]));
            ss += dppf<0xB1>(ss); ss += dppf<0x4E>(ss); ss += dppf<0x141>(ss);
            const float rstd = frsq(ss * (1.0f / 64.0f) + EPS);
            const bool isk = head >= 8; const f32x4 g1 = isk ? gk1 : gq1, g2 = isk ? gk2 : gq2;
            const f32x4 n1 = x1 * rstd * g1, n2 = x2 * rstd * g2;
            const f32x4 o1 = n1 * cs[it] - n2 * sn[it], o2 = n2 * cs[it] + n1 * sn[it];
            bf16* orow = DST + m * NPROJ + head * 64 + 4 * l8;
            u32x2 w1, w2; w1.x = pk2(o1[0], o1[1]); w1.y = pk2(o1[2], o1[3]); w2.x = pk2(o2[0], o2[1]); w2.y = pk2(o2[2], o2[3]);
            *(u32x2*)orow = w1; *(u32x2*)(orow + 32) = w2; }
    }
}

constexpr int XS = 260;
constexpr int XSB = 264;
__device__ __forceinline__ void lru_a_unit(const Args& a, int l, int unit, LAS unsigned char* lds, int tid, int lane, int wave) {
    const int b = unit >> 6, c32 = unit & 63, t0 = c32 * 32; const size_t m0 = (size_t)b * SEQ + t0;
    LAS bf16* XCb = (LAS bf16*)(lds + RING_OFF);
    LAS float* AA = (LAS float*)(lds + RING_OFF + 32 * XSB * 2);
    LAS bf16* UUb = (LAS bf16*)(AA + 2 * 32 * XS);
    const bf16* PROJ = (const bf16*)(a.ws + WS_PROJ);
    const int n = wave >> 1, hh = wave & 1, li = lane & 15, g = lane >> 4;
    bf16x8 wfr[2][2][2][2];
#pragma unroll
    for (int dir = 0; dir < 2; ++dir)
#pragma unroll
        for (int gate = 0; gate < 2; ++gate) { const bf16* W = (const bf16*)(a.ws + WS_LRUW) + ((((size_t)l * 2 + dir) * 2 + gate) * 4 + n) * 4096;
#pragma unroll
            for (int nt = 0; nt < 2; ++nt)
#pragma unroll
                for (int ks = 0; ks < 2; ++ks) wfr[dir][gate][nt][ks] = *(const bf16x8*)(W + (32 * hh + 16 * nt + li) * 64 + 32 * ks + 8 * g); }
    float bav[2][2], bxv[2][2], lamv[2][2];
#pragma unroll
    for (int dir = 0; dir < 2; ++dir)
#pragma unroll
        for (int nt = 0; nt < 2; ++nt) { const size_t pi = ((size_t)l * 2 + dir) * 256 + 64 * n + 32 * hh + 16 * nt + li; bav[dir][nt] = a.in[I_BA][pi]; bxv[dir][nt] = a.in[I_BX][pi]; lamv[dir][nt] = a.in[I_LAM][pi]; }
    {
        const int ch2 = tid & 127, rg = tid >> 7, ch = 2 * ch2;
        float x0[11], x1[11];
#pragma unroll
        for (int i = 0; i < 11; ++i) { const int s = t0 + rg * 8 - 2 + i; unsigned v = 0u;
            if (s >= 0 && s < SEQ) v = *(const unsigned*)(PROJ + ((size_t)b * SEQ + s) * NPROJ + C_LX + ch);
            x0[i] = bflo(v); x1[i] = bfhi(v); }
        const float* cw = a.in[I_CW] + (size_t)l * 4 * 256; const float* cb = a.in[I_CB] + (size_t)l * 256;
        float w0[4], w1[4];
#pragma unroll
        for (int j = 0; j < 4; ++j) { w0[j] = cw[j * 256 + ch]; w1[j] = cw[j * 256 + ch + 1]; }
        const float b0 = cb[ch], b1 = cb[ch + 1];
#pragma unroll
        for (int r = 0; r < 8; ++r) { float y0 = b0, y1 = b1;
#pragma unroll
            for (int j = 0; j < 4; ++j) { y0 += x0[r + j] * w0[j]; y1 += x1[r + j] * w1[j]; }
            *(LAS unsigned*)(XCb + (rg * 8 + r) * XSB + ch) = pk2(y0, y1); }
    }
    WG_SYNC();
    bf16x8 af[2][2];
#pragma unroll
    for (int mt = 0; mt < 2; ++mt)
#pragma unroll
        for (int ks = 0; ks < 2; ++ks) af[mt][ks] = *(const LAS bf16x8*)(XCb + (16 * mt + li) * XSB + 64 * n + 32 * ks + 8 * g);
#pragma unroll
    for (int dir = 0; dir < 2; ++dir) {
        f32x4 accA[2][2], accX[2][2];
#pragma unroll
        for (int i = 0; i < 2; ++i)
#pragma unroll
            for (int j = 0; j < 2; ++j) { accA[i][j] = (f32x4){0.f, 0.f, 0.f, 0.f}; accX[i][j] = (f32x4){0.f, 0.f, 0.f, 0.f}; }
#pragma unroll
        for (int ks = 0; ks < 2; ++ks)
#pragma unroll
            for (int nt = 0; nt < 2; ++nt)
#pragma unroll
                for (int mt = 0; mt < 2; ++mt) { accA[mt][nt] = MFMA16(af[mt][ks], wfr[dir][0][nt][ks], accA[mt][nt]); accX[mt][nt] = MFMA16(af[mt][ks], wfr[dir][1][nt][ks], accX[mt][nt]); }
#pragma unroll
        for (int nt = 0; nt < 2; ++nt) { const int ch = 64 * n + 32 * hh + 16 * nt + li; const float lam = lamv[dir][nt];
            const float ex_ = fexp(-fabsf(lam)); const float l1p = (ex_ < 0.25f) ? ex_ * (1.0f - ex_ * (0.5f - ex_ * ((1.0f / 3.0f) - 0.25f * ex_))) : log1pf(ex_);
            const float sp = fmaxf(-lam, 0.f) + l1p;
            const float k8 = -8.0f * sp;
#pragma unroll
            for (int mt = 0; mt < 2; ++mt) {
                constexpr float L2E = 1.4426950408889634f;
                const f32x4 za = (accA[mt][nt] + bav[dir][nt]) * (-L2E), zx = (accX[mt][nt] + bxv[dir][nt]) * (-L2E);
                f32x4 ea, ex;
#pragma unroll
                for (int r = 0; r < 4; ++r) { ea[r] = __builtin_amdgcn_exp2f(za[r]); ex[r] = __builtin_amdgcn_exp2f(zx[r]); }
                ea = ea + 1.0f; ex = ex + 1.0f;
                f32x4 rg_, ig_;
#pragma unroll
                for (int r = 0; r < 4; ++r) { rg_[r] = __builtin_amdgcn_rcpf(ea[r]); ig_[r] = __builtin_amdgcn_rcpf(ex[r]); }
                const f32x4 la = rg_ * k8, lal = la * L2E, x2 = la * 2.0f;
                f32x4 av, om;
#pragma unroll
                for (int r = 0; r < 4; ++r) av[r] = __builtin_amdgcn_exp2f(lal[r]);
                const f32x4 ser = -x2 * (1.0f + 0.5f * x2 * (1.0f + (1.0f / 3.0f) * x2 * (1.0f + 0.25f * x2)));
#pragma unroll
                for (int r = 0; r < 4; ++r) om[r] = (x2[r] > -0.25f) ? ser[r] : 1.0f - av[r] * av[r];
                f32x4 xc4, sq;
#pragma unroll
                for (int r = 0; r < 4; ++r) { xc4[r] = bf2f(XCb[(16 * mt + 4 * g + r) * XSB + ch]); sq[r] = __builtin_amdgcn_sqrtf(om[r]); }
                const f32x4 uv = sq * (ig_ * xc4);
#pragma unroll
                for (int r = 0; r < 4; ++r) { const int t = 16 * mt + 4 * g + r; AA[(dir * 32 + t) * XS + ch] = av[r]; UUb[(dir * 32 + t) * XSB + ch] = (bf16)f2bf(uv[r]); } } }
    }
    WG_SYNC();
    { const int dir = tid >> 8, ch = tid & 255; float h = 0.f, cp = 1.f;
      bf16* lh = (bf16*)(a.ws + WS_LH) + ((size_t)dir * M + m0) * 256 + ch; bf16* cpo = (bf16*)(a.ws + WS_CP) + ((size_t)dir * M + m0) * 256 + ch;
      float av[32], uv[32];
#pragma unroll
      for (int q = 0; q < 32; ++q) { av[q] = AA[(dir * 32 + q) * XS + ch]; uv[q] = bf2f(UUb[(dir * 32 + q) * XSB + ch]); }
      if (dir == 0) {
#pragma unroll
          for (int q = 0; q < 32; ++q) { h = av[q] * h + uv[q]; cp *= av[q]; lh[(size_t)q * 256] = (bf16)f2bf(h); cpo[(size_t)q * 256] = (bf16)f2bf(cp); }
      } else {
#pragma unroll
          for (int q = 31; q >= 0; --q) { h = av[q] * h + uv[q]; cp *= av[q]; lh[(size_t)q * 256] = (bf16)f2bf(h); cpo[(size_t)q * 256] = (bf16)f2bf(cp); }
      }
      float* cr = (float*)(a.ws + WS_CARRY) + ((((size_t)dir * NB + b) * 64 + c32) * 2) * 256 + ch; cr[0] = cp; cr[256] = h; }
    WG_SYNC();
}

constexpr int CIN_OFF = 122880;
__device__ __forceinline__ void p4_carry(const Args& a, int unit, LAS unsigned char* lds, int tid) {
    const int b = unit >> 5, c0 = 2 * (unit & 31);
    LAS float* CIN = (LAS float*)(lds + CIN_OFF);
    const float* CARRY = (const float*)(a.ws + WS_CARRY);
    { const int dir = tid >> 8, ch = tid & 255; const float* cr = CARRY + (((size_t)dir * NB + b) * 64) * 512 + ch; float cin = 0.f;
      const int cs = dir ? c0 + 1 : c0;
      const int n = dir ? 63 - cs : cs;
      for (int base = 0; base < n; base += 16) { float P[16], Hh[16];
#pragma unroll
          for (int i = 0; i < 16; ++i) { const int q = base + i; const bool v = q < n; const int k = v ? (dir ? 63 - q : q) : cs;
              const float p = cr[(size_t)k * 512], h = cr[(size_t)k * 512 + 256]; P[i] = v ? p : 1.f; Hh[i] = v ? h : 0.f; }
#pragma unroll
          for (int i = 0; i < 16; ++i) cin = P[i] * cin + Hh[i]; }
      const float cin2 = cr[(size_t)cs * 512] * cin + cr[(size_t)cs * 512 + 256];
      CIN[((cs - c0) * 2 + dir) * 256 + ch] = cin; CIN[((1 - (cs - c0)) * 2 + dir) * 256 + ch] = cin2; }
}
__device__ __forceinline__ void p4_rows_unit(const Args& a, int l, int unit, LAS unsigned char* lds, int tid, int lane, int wave, bool have_carry) {
    const int b = unit >> 5, c0 = 2 * (unit & 31); const size_t m0 = (size_t)b * SEQ + c0 * 32;
    LAS float* CIN = (LAS float*)(lds + CIN_OFF);
    if (!have_carry) p4_carry(a, unit, lds, tid);
    WG_SYNC();
    const bf16* LH = (const bf16*)(a.ws + WS_LH); const bf16* CPb = (const bf16*)(a.ws + WS_CP); const bf16* PROJ = (const bf16*)(a.ws + WS_PROJ); bf16* Y = (bf16*)(a.ws + WS_Y);
    const f32x4 og = *(const f32x4*)(a.in[I_LOG] + (size_t)l * 256 + 4 * lane);
    const float* gq = a.in[I_AOG] + (size_t)l * 512 + 8 * lane; const f32x4 g0 = *(const f32x4*)gq, g1 = *(const f32x4*)(gq + 4);
#pragma unroll
    for (int it = 0; it < 2; ++it) { const int tl = wave * 8 + it * 4;
        const LAS float* ci = CIN + (tl >> 5) * 512; const f32x4 cf = *(const LAS f32x4*)(ci + 4 * lane), cb = *(const LAS f32x4*)(ci + 256 + 4 * lane);
        v4u ya[4]; u32x2 lf[4], pf[4], lb[4], pb[4], gt[4];
#pragma unroll
        for (int r = 0; r < 4; ++r) { const size_t m = m0 + tl + r;
            ya[r] = *(const v4u*)(Y + m * DM + 8 * lane);
            lf[r] = *(const u32x2*)(LH + m * 256 + 4 * lane); pf[r] = *(const u32x2*)(CPb + m * 256 + 4 * lane);
            lb[r] = *(const u32x2*)(LH + ((size_t)M + m) * 256 + 4 * lane); pb[r] = *(const u32x2*)(CPb + ((size_t)M + m) * 256 + 4 * lane);
            gt[r] = *(const u32x2*)(PROJ + m * NPROJ + C_LG + 4 * lane); }
#pragma unroll
        for (int r = 0; r < 4; ++r) { const size_t m = m0 + tl + r;
            {
                const float x[8] = {bflo(ya[r].x), bfhi(ya[r].x), bflo(ya[r].y), bfhi(ya[r].y), bflo(ya[r].z), bfhi(ya[r].z), bflo(ya[r].w), bfhi(ya[r].w)}; float ss = 0.f;
#pragma unroll
                for (int i = 0; i < 8; ++i) ss += x[i] * x[i];
                const float rstd = frsq(wave_sum(ss) * (1.0f / 512.0f) + EPS);
                v4u o; o.x = pk2(x[0] * rstd * g0[0], x[1] * rstd * g0[1]); o.y = pk2(x[2] * rstd * g0[2], x[3] * rstd * g0[3]);
                o.z = pk2(x[4] * rstd * g1[0], x[5] * rstd * g1[1]); o.w = pk2(x[6] * rstd * g1[2], x[7] * rstd * g1[3]); *(v4u*)(Y + m * DM + 8 * lane) = o; }
            {
                f32x4 h;
                h[0] = (bflo(lf[r].x) + bflo(pf[r].x) * cf[0]) + (bflo(lb[r].x) + bflo(pb[r].x) * cb[0]);
                h[1] = (bfhi(lf[r].x) + bfhi(pf[r].x) * cf[1]) + (bfhi(lb[r].x) + bfhi(pb[r].x) * cb[1]);
                h[2] = (bflo(lf[r].y) + bflo(pf[r].y) * cf[2]) + (bflo(lb[r].y) + bflo(pb[r].y) * cb[2]);
                h[3] = (bfhi(lf[r].y) + bfhi(pf[r].y) * cf[3]) + (bfhi(lb[r].y) + bfhi(pb[r].y) * cb[3]);
                h[0] *= gelu_tanh_f(bflo(gt[r].x)); h[1] *= gelu_tanh_f(bfhi(gt[r].x)); h[2] *= gelu_tanh_f(bflo(gt[r].y)); h[3] *= gelu_tanh_f(bfhi(gt[r].y));
                const float ss = wave_sum((h[0] * h[0] + h[1] * h[1]) + (h[2] * h[2] + h[3] * h[3]));
                const float rstd = frsq(ss * (1.0f / 256.0f) + EPS);
                u32x2 o; o.x = pk2(h[0] * rstd * og[0], h[1] * rstd * og[1]); o.y = pk2(h[2] * rstd * og[2], h[3] * rstd * og[3]);
                *(u32x2*)(Y + m * DM + 512 + 4 * lane) = o; } } }
    WG_SYNC();
}

struct MlsGateRaw { float i_f, f_f, i_b, f_b; };
__device__ __forceinline__ MlsGateRaw mls_gates_load(const Args& a, int l, size_t m0, int hd, int tid) {
    MlsGateRaw r{0.f, 0.f, 0.f, 0.f};
    if (tid < 128) { const float* p = (const float*)(a.ws + WS_MG) + (m0 + tid) * 16; const float* fb = a.in[I_FB] + (size_t)l * 8;
        r.i_f = p[hd]; r.f_f = p[4 + hd] + fb[hd]; r.i_b = p[8 + hd]; r.f_b = p[12 + hd] + fb[4 + hd]; }
    return r;
}
__device__ __forceinline__ void mls_gates_store(const MlsGateRaw& r, LAS float* GL, int tid) {
    if (tid < 128) { GL[tid] = logsig_f(r.f_f); GL[128 + tid] = logsig_f(r.f_b); GL[256 + tid] = r.i_f; GL[384 + tid] = r.i_b; }
}
__device__ __forceinline__ void mls_gates_scan(LAS float* GL, int wave, int lane) {
    if (wave == 0) wave_scan128<false, false>(GL, GL + 512, lane);
    else if (wave == 1) wave_scan128<false, true>(GL + 128, GL + 640, lane);
}
constexpr int TS = 136;
constexpr int QS_ = 72;

__device__ __forceinline__ void mls_a_unit(const Args& a, int l, int unit, LAS unsigned char* lds, int tid, int lane, int wave) {
    const int c = unit & 15, hd = (unit >> 4) & 3, b = unit >> 6; const size_t m0 = (size_t)b * SEQ + c * 128;
    LAS float* GL = (LAS float*)(lds + RING_OFF);
    LAS float* WW = GL + 768;
    LAS bf16* VT = (LAS bf16*)(lds + RING_OFF + 4096); LAS bf16* KF = VT + 64 * TS; LAS bf16* KB = KF + 64 * TS;
    const MlsGateRaw graw = mls_gates_load(a, l, m0, hd, tid);
    const int j = tid & 127, part = tid >> 7; const bf16* PROJ = (const bf16*)(a.ws + WS_PROJ);
    const bf16* kp = PROJ + (m0 + j) * NPROJ + C_MK + hd * 64 + 16 * part; const bf16* vp = PROJ + (m0 + j) * NPROJ + C_MV + hd * 64 + 16 * part;
    const v4u k0 = *(const v4u*)kp, k1 = *(const v4u*)(kp + 8), v0 = *(const v4u*)vp, v1 = *(const v4u*)(vp + 8);
    mls_gates_store(graw, GL, tid);
    WG_SYNC();
    float* MLOC = (float*)(a.ws + WS_MLOC); float* NLOC = (float*)(a.ws + WS_NLOC); float* CLOC = (float*)(a.ws + WS_CLOC);
    const size_t sbase = ((size_t)b * 4 + hd) * 2;
    mls_gates_scan(GL, wave, lane);
    if (wave < 2) { WAVE_LDS_FENCE(); const int dir = wave; const float gtot = dir ? GL[640] : GL[512 + 127]; const LAS float* Bc = GL + 512 + 128 * dir; const LAS float* IG = GL + 256 + 128 * dir;
        const float lw0 = gtot - Bc[lane] + IG[lane], lw1 = gtot - Bc[lane + 64] + IG[lane + 64];
        const float mx = wave_max(fmaxf(lw0, lw1));
        WW[dir * 128 + lane] = fexp(lw0 - mx); WW[dir * 128 + lane + 64] = fexp(lw1 - mx);
        if (lane == 0) { float* o = MLOC + ((sbase + dir) * 16 + c) * 2; o[0] = mx; o[1] = gtot; } }
    WG_SYNC();
    { const float wf = WW[j] * 0.125f, wb = WW[128 + j] * 0.125f;
      const unsigned kk[8] = {k0.x, k0.y, k0.z, k0.w, k1.x, k1.y, k1.z, k1.w}; const unsigned vv[8] = {v0.x, v0.y, v0.z, v0.w, v1.x, v1.y, v1.z, v1.w};
#pragma unroll
      for (int q = 0; q < 8; ++q) { const int e0 = 16 * part + 2 * q; const float ka = bflo(kk[q]), kb = bfhi(kk[q]);
          KF[e0 * TS + j] = (bf16)f2bf(ka * wf); KF[(e0 + 1) * TS + j] = (bf16)f2bf(kb * wf);
          KB[e0 * TS + j] = (bf16)f2bf(ka * wb); KB[(e0 + 1) * TS + j] = (bf16)f2bf(kb * wb);
          VT[e0 * TS + j] = (bf16)(vv[q] & 0xffffu); VT[(e0 + 1) * TS + j] = (bf16)(vv[q] >> 16); } }
    WG_SYNC();
    if (tid < 128) { const int dir = tid >> 6, e = tid & 63; const LAS bf16* kr = (dir ? KB : KF) + e * TS; float s = 0.f;
#pragma unroll
        for (int q = 0; q < 16; ++q) { const v4u w = *(const LAS v4u*)(kr + 8 * q); s += ((bflo(w.x) + bfhi(w.x)) + (bflo(w.y) + bfhi(w.y))) + ((bflo(w.z) + bfhi(w.z)) + (bflo(w.w) + bfhi(w.w))); }
        NLOC[((sbase + dir) * 16 + c) * 64 + e] = s; }
    { const int dir = wave >> 2, mt = wave & 3, li = lane & 15, g = lane >> 4; const LAS bf16* KD = dir ? KB : KF;
      f32x4 acc[4];
#pragma unroll
      for (int nt = 0; nt < 4; ++nt) acc[nt] = (f32x4){0.f, 0.f, 0.f, 0.f};
#pragma unroll
      for (int ks = 0; ks < 4; ++ks) { const bf16x8 af = *(const LAS bf16x8*)(VT + (16 * mt + li) * TS + 32 * ks + 8 * g);
#pragma unroll
          for (int nt = 0; nt < 4; ++nt) { const bf16x8 bfv = *(const LAS bf16x8*)(KD + (16 * nt + li) * TS + 32 * ks + 8 * g); acc[nt] = MFMA16(af, bfv, acc[nt]); } }
      float* co = CLOC + ((sbase + dir) * 16 + c) * 4096;
#pragma unroll
      for (int nt = 0; nt < 4; ++nt)
#pragma unroll
          for (int r = 0; r < 4; ++r) co[(16 * mt + 4 * g + r) * 64 + 16 * nt + li] = acc[nt][r]; }
    WG_SYNC();
}

__device__ __forceinline__ void mls_scan_unit(const Args& a, int unit, LAS unsigned char* lds, int tid, int lane, int wave) {
    const int qtr = unit & 3, bhd = unit >> 2, dir = bhd & 1;
    LAS float* SM = (LAS float*)(lds + RING_OFF);
    const float* CLOC = (const float*)(a.ws + WS_CLOC) + (size_t)bhd * 16 * 4096 + 1024 * qtr + 2 * tid;
    const float* NLOC = (const float*)(a.ws + WS_NLOC) + (size_t)bhd * 16 * 64;
    typedef float f32x2 __attribute__((ext_vector_type(2)));
    f32x2 cl[16]; float nl[16];
#pragma unroll
    for (int k = 0; k < 16; ++k) cl[k] = *(const f32x2*)(CLOC + (size_t)k * 4096);
    const bool do_n = (qtr == 0) && (tid < 64);
#pragma unroll
    for (int k = 0; k < 16; ++k) nl[k] = do_n ? NLOC[k * 64 + tid] : 0.f;
    if (tid < 32) SM[tid] = ((const float*)(a.ws + WS_MLOC))[(size_t)bhd * 32 + tid];
    WG_SYNC();
    bf16* CP = (bf16*)(a.ws + WS_CPREV) + (size_t)bhd * 16 * 4096 + 1024 * qtr + 2 * tid;
    float* NP = (float*)(a.ws + WS_NPREV) + (size_t)bhd * 16 * 64; float* MP = (float*)(a.ws + WS_MPREV) + (size_t)bhd * 16;
    float m = 0.f; f32x2 C = (f32x2){0.f, 0.f}; float n = 0.f;
#pragma unroll
    for (int q = 0; q < 16; ++q) { const int k = dir ? 15 - q : q;
        *(unsigned*)(CP + (size_t)k * 4096) = pk2(C[0], C[1]);
        if (do_n) NP[k * 64 + tid] = n;
        if (qtr == 0 && tid == 64) MP[k] = m;
        const float mlk = SM[2 * k], gk = SM[2 * k + 1]; const float mn = fmaxf(gk + m, mlk); const float fa = fexp(gk + m - mn), fb = fexp(mlk - mn);
        C = fa * C + fb * (dir ? cl[15 - q] : cl[q]); n = fa * n + fb * (dir ? nl[15 - q] : nl[q]); m = mn; }
    WG_SYNC();
}

template <int DIR>
__device__ __forceinline__ void mls_dir(f32x4 (&hacc)[4], const LAS bf16* QS, const LAS bf16* KS, const LAS bf16* VT, const LAS bf16* CP, const LAS float* AJ, const LAS float* MM,
                                        const LAS float* INTER, const LAS float* FLOOR, const LAS float* NP, LAS float* rowbuf, int w, int lane) {
    const int li = lane & 15, g = lane >> 4, i = 16 * w + li;
    bf16x8 qf[2];
#pragma unroll
    for (int ks = 0; ks < 2; ++ks) qf[ks] = *(const LAS bf16x8*)(QS + i * QS_ + 32 * ks + 8 * g);
    const float mmi = MM[i];
    float den = 0.f;
    f32x4 out[4];
#pragma unroll
    for (int dt = 0; dt < 4; ++dt) out[dt] = (f32x4){0.f, 0.f, 0.f, 0.f};
#pragma unroll
    for (int kp = 0; kp < 4; ++kp) {
        const bool need = (DIR == 0) ? (2 * kp <= w) : (2 * kp + 1 >= w);
        if (need) {
            f32x4 s0 = (f32x4){0.f, 0.f, 0.f, 0.f}, s1 = (f32x4){0.f, 0.f, 0.f, 0.f};
#pragma unroll
            for (int ks = 0; ks < 2; ++ks) { const bf16x8 k0 = *(const LAS bf16x8*)(KS + (32 * kp + li) * QS_ + 32 * ks + 8 * g), k1 = *(const LAS bf16x8*)(KS + (32 * kp + 16 + li) * QS_ + 32 * ks + 8 * g);
                s0 = MFMA16(k0, qf[ks], s0); s1 = MFMA16(k1, qf[ks], s1); }
            constexpr float L2E = 1.4426950408889634f;
            const int jb = 32 * kp + 4 * g;
            const f32x4 aj0 = *(const LAS f32x4*)(AJ + jb), aj1 = *(const LAS f32x4*)(AJ + jb + 16);
            f32x4 e0 = (aj0 - mmi) * L2E - 3.0f, e1 = (aj1 - mmi) * L2E - 3.0f;
#pragma unroll
            for (int r = 0; r < 4; ++r) { const bool v0 = (DIR == 0) ? (jb + r <= i) : (jb + r >= i), v1 = (DIR == 0) ? (jb + 16 + r <= i) : (jb + 16 + r >= i);
                e0[r] = __builtin_amdgcn_exp2f(v0 ? e0[r] : -INFINITY); e1[r] = __builtin_amdgcn_exp2f(v1 ? e1[r] : -INFINITY); }
            const f32x4 p0 = s0 * e0, p1 = s1 * e1;
            den += ((p0[0] + p0[1]) + (p0[2] + p0[3])) + ((p1[0] + p1[1]) + (p1[2] + p1[3]));
            const float p[8] = {p0[0], p0[1], p0[2], p0[3], p1[0], p1[1], p1[2], p1[3]};
            v4u pk; pk.x = pk2(p[0], p[1]); pk.y = pk2(p[2], p[3]); pk.z = pk2(p[4], p[5]); pk.w = pk2(p[6], p[7]);
            const bf16x8 pf = __builtin_bit_cast(bf16x8, pk);
#pragma unroll
            for (int dt = 0; dt < 4; ++dt) { const LAS bf16* vr = VT + (16 * dt + li) * TS + 32 * kp + 4 * g;
                const u32x2 lo = *(const LAS u32x2*)vr, hi = *(const LAS u32x2*)(vr + 16);
                v4u vk; vk.x = lo.x; vk.y = lo.y; vk.z = hi.x; vk.w = hi.y;
                out[dt] = MFMA16(pf, __builtin_bit_cast(bf16x8, vk), out[dt]); }
        }
    }
    f32x4 qc[4];
#pragma unroll
    for (int dt = 0; dt < 4; ++dt) { qc[dt] = (f32x4){0.f, 0.f, 0.f, 0.f};
#pragma unroll
        for (int ks = 0; ks < 2; ++ks) { const bf16x8 cf = *(const LAS bf16x8*)(CP + (16 * dt + li) * QS_ + 32 * ks + 8 * g); qc[dt] = MFMA16(qf[ks], cf, qc[dt]); } }
    float nq = 0.f;
    { const v4u qa = *(const LAS v4u*)(QS + i * QS_ + 16 * g), qb = *(const LAS v4u*)(QS + i * QS_ + 16 * g + 8);
      const unsigned qq[8] = {qa.x, qa.y, qa.z, qa.w, qb.x, qb.y, qb.z, qb.w};
#pragma unroll
      for (int q = 0; q < 4; ++q) { const f32x4 nv = *(const LAS f32x4*)(NP + 16 * g + 4 * q);
          nq += (nv[0] * bflo(qq[2 * q]) + nv[1] * bfhi(qq[2 * q])) + (nv[2] * bflo(qq[2 * q + 1]) + nv[3] * bfhi(qq[2 * q + 1])); } }
    den = xor32_sum(xor16_sum(den)); nq = xor32_sum(xor16_sum(nq));
    const float inter = INTER[i]; const float dn = fmaxf(fabsf(den + inter * nq), FLOOR[i]);
    asm volatile("s_waitcnt lgkmcnt(0)" ::: "memory");
    if (g == 0) { rowbuf[li] = inter; rowbuf[16 + li] = frcp(dn); }
    asm volatile("s_waitcnt lgkmcnt(0)" ::: "memory");
#pragma unroll
    for (int r = 0; r < 4; ++r) { const float it = rowbuf[4 * g + r], inv = rowbuf[16 + 4 * g + r];
#pragma unroll
        for (int dt = 0; dt < 4; ++dt) hacc[dt][r] += (out[dt][r] + it * qc[dt][r]) * inv; }
    asm volatile("s_waitcnt lgkmcnt(0)" ::: "memory");
}
__device__ __forceinline__ void mls_b_unit(const Args& a, int l, int unit, LAS unsigned char* lds, int tid, int lane, int wave) {
    const int c = unit & 15, hd = (unit >> 4) & 3, b = unit >> 6; const size_t m0 = (size_t)b * SEQ + c * 128;
    LAS float* GL = (LAS float*)(lds + RING_OFF);
    LAS float* AJ = GL + 768;
    LAS float* MMx = AJ + 256;
    LAS float* INT_ = MMx + 256;
    LAS float* FLR = INT_ + 256;
    LAS float* NP = FLR + 256;
    LAS float* COEF = NP + 128;
    LAS float* ROWB = COEF + 32;
    LAS bf16* QS = (LAS bf16*)(lds + RING_OFF + 16384); LAS bf16* KS = QS + 128 * QS_; LAS bf16* VT = KS + 128 * QS_; LAS bf16* CF = VT + 64 * TS; LAS bf16* CB = CF + 64 * QS_;
    const size_t sbase = ((size_t)b * 4 + hd) * 2;
    const MlsGateRaw graw = mls_gates_load(a, l, m0, hd, tid);
    const float mprev = ((const float*)(a.ws + WS_MPREV))[(sbase + (wave & 1)) * 16 + c];
    const bf16* PROJ = (const bf16*)(a.ws + WS_PROJ);
    const int sj = tid >> 2, q4 = tid & 3; const bf16* rp = PROJ + (m0 + sj) * NPROJ + hd * 64 + 16 * q4;
    const v4u q0 = *(const v4u*)(rp + C_MQ), q1 = *(const v4u*)(rp + C_MQ + 8), k0 = *(const v4u*)(rp + C_MK), k1 = *(const v4u*)(rp + C_MK + 8), v0 = *(const v4u*)(rp + C_MV), v1 = *(const v4u*)(rp + C_MV + 8);
    const int idx = tid * 8; const bf16* CPV = (const bf16*)(a.ws + WS_CPREV);
    const v4u cfv = *(const v4u*)(CPV + ((sbase + 0) * 16 + c) * 4096 + idx), cbv = *(const v4u*)(CPV + ((sbase + 1) * 16 + c) * 4096 + idx);
    float npv = 0.f; if (tid < 128) npv = ((const float*)(a.ws + WS_NPREV))[((sbase + (tid >> 6)) * 16 + c) * 64 + (tid & 63)];
    const int li_ = lane & 15, g_ = lane >> 4; const float* hg = a.in[I_MNG] + ((size_t)l * 4 + hd) * 64;
    unsigned short ogv[4][4]; float hgv[4];
#pragma unroll
    for (int dt = 0; dt < 4; ++dt) { hgv[dt] = hg[16 * dt + li_];
#pragma unroll
        for (int r = 0; r < 4; ++r) ogv[r][dt] = PROJ[(m0 + 16 * wave + 4 * g_ + r) * NPROJ + C_MO + hd * 64 + 16 * dt + li_]; }
    mls_gates_store(graw, GL, tid);
    *(LAS v4u*)(QS + sj * QS_ + 16 * q4) = q0; *(LAS v4u*)(QS + sj * QS_ + 16 * q4 + 8) = q1;
    *(LAS v4u*)(KS + sj * QS_ + 16 * q4) = k0; *(LAS v4u*)(KS + sj * QS_ + 16 * q4 + 8) = k1;
    { const unsigned vv[8] = {v0.x, v0.y, v0.z, v0.w, v1.x, v1.y, v1.z, v1.w};
#pragma unroll
      for (int q = 0; q < 8; ++q) { const int d0 = 16 * q4 + 2 * q; VT[d0 * TS + sj] = (bf16)(vv[q] & 0xffffu); VT[(d0 + 1) * TS + sj] = (bf16)(vv[q] >> 16); } }
    *(LAS v4u*)(CF + (idx >> 6) * QS_ + (idx & 63)) = cfv; *(LAS v4u*)(CB + (idx >> 6) * QS_ + (idx & 63)) = cbv;
    if (tid < 128) NP[tid] = npv;
    WG_SYNC();
    mls_gates_scan(GL, wave, lane);
    if (wave < 2) {
        WAVE_LDS_FENCE();
        const int dir = wave; const float m = mprev;
        const LAS float* IG = GL + 256 + 128 * dir; const LAS float* Bc = GL + 512 + 128 * dir;
        LAS float* aj = AJ + 128 * dir; LAS float* mmx = MMx + 128 * dir;
        aj[lane] = IG[lane] - Bc[lane]; aj[lane + 64] = IG[lane + 64] - Bc[lane + 64];
        WAVE_LDS_FENCE();
        if (dir == 0) wave_scan128<true, false>(aj, mmx, lane); else wave_scan128<true, true>(aj, mmx, lane);
        WAVE_LDS_FENCE();
#pragma unroll
        for (int q = 0; q < 2; ++q) { const int j = lane + 64 * q; const float mm = fmaxf(mmx[j], m);
            mmx[j] = mm; INT_[128 * dir + j] = fexp(m - mm); FLR[128 * dir + j] = fexp(-(Bc[j] + mm)); }
    }
    WG_SYNC();
    f32x4 hacc[4];
#pragma unroll
    for (int dt = 0; dt < 4; ++dt) hacc[dt] = (f32x4){0.f, 0.f, 0.f, 0.f};
    mls_dir<0>(hacc, QS, KS, VT, CF, AJ, MMx, INT_, FLR, NP, ROWB + wave * 32, wave, lane);
    mls_dir<1>(hacc, QS, KS, VT, CB, AJ + 128, MMx + 128, INT_ + 128, FLR + 128, NP + 64, ROWB + wave * 32, wave, lane);
    {
        bf16* Y = (bf16*)(a.ws + WS_Y);
#pragma unroll
        for (int r = 0; r < 4; ++r) { float ss = (hacc[0][r] * hacc[0][r] + hacc[1][r] * hacc[1][r]) + (hacc[2][r] * hacc[2][r] + hacc[3][r] * hacc[3][r]);
            ss = row16_sum(ss);
            const float rstd = frsq(ss * (1.0f / 64.0f) + EPS); const size_t m = m0 + 16 * wave + 4 * g_ + r;
#pragma unroll
            for (int dt = 0; dt < 4; ++dt) Y[m * DM + 768 + hd * 64 + 16 * dt + li_] = (bf16)f2bf(hacc[dt][r] * rstd * hgv[dt] * sigmoid_f(bf2f(ogv[r][dt]))); }
    }
    WG_SYNC();
}

__device__ __forceinline__ void attnorm_pass(const Args& a, int l, int lane, int wave, int G, int bid, bf16* DST) {
    bf16* Y = (bf16*)(a.ws + WS_Y); const float* gq = a.in[I_AOG] + (size_t)l * 512 + 8 * lane;
    const f32x4 g0 = *(const f32x4*)gq, g1 = *(const f32x4*)(gq + 4);
    const int gw = bid * NWAVES + wave, NGW = G * NWAVES;
    for (int mb = 4 * gw; mb < M; mb += 4 * NGW) { v4u q[4];
#pragma unroll
        for (int r = 0; r < 4; ++r) q[r] = *(const v4u*)(Y + (size_t)(mb + r) * DM + 8 * lane);
        float ss[4];
#pragma unroll
        for (int r = 0; r < 4; ++r) { const float x[8] = {bflo(q[r].x), bfhi(q[r].x), bflo(q[r].y), bfhi(q[r].y), bflo(q[r].z), bfhi(q[r].z), bflo(q[r].w), bfhi(q[r].w)}; float a = 0.f;
#pragma unroll
            for (int i = 0; i < 8; ++i) a += x[i] * x[i];
            ss[r] = a; }
#pragma unroll
        for (int r = 0; r < 4; ++r) ss[r] = wave_sum(ss[r]);
#pragma unroll
        for (int r = 0; r < 4; ++r) { const float rstd = frsq(ss[r] * (1.0f / 512.0f) + EPS);
            const float x[8] = {bflo(q[r].x), bfhi(q[r].x), bflo(q[r].y), bfhi(q[r].y), bflo(q[r].z), bfhi(q[r].z), bflo(q[r].w), bfhi(q[r].w)};
            v4u o; o.x = pk2(x[0] * rstd * g0[0], x[1] * rstd * g0[1]); o.y = pk2(x[2] * rstd * g0[2], x[3] * rstd * g0[3]);
            o.z = pk2(x[4] * rstd * g1[0], x[5] * rstd * g1[1]); o.w = pk2(x[6] * rstd * g1[2], x[7] * rstd * g1[3]); *(v4u*)(DST + (size_t)(mb + r) * DM + 8 * lane) = o; } }
}

__device__ __forceinline__ unsigned mbcnt64(unsigned long long m) { return __builtin_amdgcn_mbcnt_hi((unsigned)(m >> 32), __builtin_amdgcn_mbcnt_lo((unsigned)m, 0u)); }
__device__ __forceinline__ void topk_item(const Args& a, int item, LAS unsigned char* lds, int tid, int lane, int wave) {
    const int unit = item & 127, half = item >> 7, b = unit >> 4, e = unit & 15;
    LAS unsigned* CNT = (LAS unsigned*)(lds + RING_OFF);
    LAS unsigned* SEG = CNT + 16;
    LAS int* TOK = (LAS int*)(SEG + 64);
    LAS float* GV = (LAS float*)(TOK + 256);
    const float* aff = (const float*)(a.ws + WS_AFF) + ((size_t)b * NE + e) * SEQ;
    float av[4]; unsigned key[4];
#pragma unroll
    for (int q = 0; q < 4; ++q) av[q] = aff[tid + q * NTHR];
#pragma unroll
    for (int q = 0; q < 4; ++q) key[q] = __float_as_uint(av[q]);
    unsigned lo = 0u, hi = 0x7F800000u; int par = 0;
    while (hi - lo > 1u) { const unsigned mid = lo + ((hi - lo) >> 1);
        unsigned c = 0u;
#pragma unroll
        for (int q = 0; q < 4; ++q) c += (unsigned)__popcll(__ballot(key[q] >= mid));
        if (lane == 0) CNT[par * 8 + wave] = c;
        WG_SYNC();
        const v4u c0 = *(const LAS v4u*)(CNT + par * 8), c1 = *(const LAS v4u*)(CNT + par * 8 + 4);
        const unsigned tot = (c0.x + c0.y) + (c0.z + c0.w) + (c1.x + c1.y) + (c1.z + c1.w);
        if (tot >= (unsigned)CAP) lo = mid; else hi = mid;
        par ^= 1; }
    const unsigned T = lo;
    unsigned long long mgt[4], meq[4];
#pragma unroll
    for (int q = 0; q < 4; ++q) { mgt[q] = __ballot(key[q] > T); meq[q] = __ballot(key[q] == T);
        if (lane == 0) { SEG[q * 8 + wave] = (unsigned)__popcll(mgt[q]); SEG[32 + q * 8 + wave] = (unsigned)__popcll(meq[q]); } }
    WG_SYNC();
    unsigned ngt = 0u;
#pragma unroll
    for (int g = 0; g < 32; ++g) ngt += SEG[g];
    const unsigned need = (unsigned)CAP - ngt;
    unsigned eqb = 0u, selb = 0u, my_eqb[4], my_selb[4];
#pragma unroll
    for (int g = 0; g < 32; ++g) { if ((g & 7) == wave) { my_eqb[g >> 3] = eqb; my_selb[g >> 3] = selb; }
        const unsigned cg = SEG[g], ce = SEG[32 + g]; const unsigned room = need > eqb ? need - eqb : 0u; selb += cg + (room < ce ? room : ce); eqb += ce; }
    int* SEL = (int*)(a.ws + WS_SEL);
#pragma unroll
    for (int q = 0; q < 4; ++q) { const bool gt = key[q] > T, eq = key[q] == T;
        const bool sel = gt || (eq && (my_eqb[q] + mbcnt64(meq[q])) < need);
        const unsigned long long ms = __ballot(sel); const int slot = (int)(my_selb[q] + mbcnt64(ms)); const int sidx = tid + q * NTHR;
        if (sel) { TOK[slot] = sidx; GV[slot] = av[q]; }
        if ((q >> 1) == half) SEL[((size_t)b * SEQ + sidx) * NE + e] = sel ? slot : -1; }
    WG_SYNC();
    int* IDX = (int*)(a.ws + WS_IDX); float* GATE = (float*)(a.ws + WS_GATE);
    if (tid < 128) { const int t = half * 128 + tid; IDX[e * NSLOT + b * CAP + t] = b * SEQ + TOK[t]; GATE[e * NSLOT + b * CAP + t] = GV[t]; }
    const unsigned char* H8 = a.ws + WS_H; unsigned char* XG8 = a.ws + WS_XG;
    { v4u r0[16];
#pragma unroll
      for (int q = 0; q < 16; ++q) { const int t = half * 128 + wave * 16 + q; r0[q] = *((const v4u*)(H8 + ((size_t)b * SEQ + TOK[t]) * DM) + lane); }
#pragma unroll
      for (int q = 0; q < 16; ++q) { const int t = half * 128 + wave * 16 + q; *((v4u*)(XG8 + ((size_t)e * NSLOT + b * CAP + t) * DM) + lane) = r0[q]; } }
    WG_SYNC();
}

__global__ void __launch_bounds__(NTHR, 2) hybrid_fwd(Args args) {
    extern __shared__ __attribute__((aligned(16))) unsigned char lds_raw[];
    LAS unsigned char* lds = (LAS unsigned char*)lds_raw;
    volatile LAS unsigned* MISC = (volatile LAS unsigned*)(lds + MISC_OFF);
    const int tid0 = threadIdx.x, G = gridDim.x;
    unsigned char* ws = args.ws;
#define PHASE_IDS() const int tid = ltid(), lane = tid & 63, wave = __builtin_amdgcn_readfirstlane(tid >> 6), bid = lbid(); (void)lane; (void)wave; (void)bid
    gu32* ctl = (gu32*)(ws + WS_CTL);
    for (int u = tid0; u < (LDS_BYTES - MISC_OFF) / 4; u += NTHR) ((LAS unsigned*)(lds + MISC_OFF))[u] = 0u;
    __syncthreads();
    XcdBarrier bar; bar.bar = (unsigned*)(ctl + CW_BAR); bar.x = 0; bar.st = nullptr;
    if (!MK_PER_PHASE) bar = xcd_barrier_post((unsigned*)(ctl + CW_BAR), MISC + 8);
#define GRID_BAR() do { if (!MK_PER_PHASE) { xcd_barrier(bar); if (REP_MASK & (1 << 11)) xcd_barrier(bar); } } while (0)
    const int lo = args.ph_lo, hi = args.ph_hi;
#ifndef PT_MASK
#define PT_MASK 0x7ff
#endif
#define PT_ON(j) (((PT_MASK) >> (j)) & 1)
#ifndef REP_MASK
#define REP_MASK 0
#endif
#define REPS(j) for (int rep_ = 0; rep_ < 1 + (((REP_MASK) >> (j)) & 1); ++rep_)
#define IN(k) (lo <= (k) && (k) < hi)
#define BOTH(k) (IN(k) && IN((k) + 1))

    bf16* Hb = (bf16*)(ws + WS_H); bf16* PROJ = (bf16*)(ws + WS_PROJ); bf16* Yb = (bf16*)(ws + WS_Y);
    float* MG = (float*)(ws + WS_MG); float* AFF = (float*)(ws + WS_AFF); int* SEL = (int*)(ws + WS_SEL);
    bf16* XG = (bf16*)(ws + WS_XG); bf16* HID = (bf16*)(ws + WS_HID); bf16* YE = (bf16*)(ws + WS_YE); bf16* XB = (bf16*)(ws + WS_XB);

    if (PT_ON(0) && IN(0)) { PHASE_IDS();
        REPS(0) p0_weights(args, lds, tid, lane, wave, G, bid);
        WG_SYNC();
        REPS(16) row_pass<0, false>(args.in[I_X], nullptr, args.in[I_N1G], args.in[I_WIN] + NPROJ, DIN, Hb, MG, nullptr, nullptr, lds, tid, lane, wave, G, bid);
        if (BOTH(0)) GRID_BAR();
    }
    for (int l = 0; l < DEPTH; ++l) {
        const int pb = 1 + 10 * l;
        if (PT_ON(1) && IN(pb + 0)) { PHASE_IDS();
            pg8::Gemm g{Hb, (const bf16*)(ws + WS_WIN) + (size_t)l * NPROJ * DM, M, NPROJ, DM}; pg8::StaticOrder S; S.init(M, NPROJ - 256, G, bid);
            pg8::EpiBf16<0> E{PROJ, NPROJ, nullptr, 0, 0, 1.f};
            REPS(1) pg8::gemm_phase<pg8::EpiBf16<0>, pg8::StaticOrder, true, true>(lds + RING_OFF, g, S, E);
            if (BOTH(pb + 0)) GRID_BAR();
        }
        if (PT_ON(2) && IN(pb + 1)) { PHASE_IDS();
            const bool split = (G == 256);
            if (bid < 64 || !split) { pg8::Gemm g{Hb, (const bf16*)(ws + WS_WIN) + (size_t)l * NPROJ * DM, M, NPROJ, DM}; pg8::TailOrder S{G, bid, 8}; pg8::EpiBf16<0> E{PROJ, NPROJ, nullptr, 0, 0, 1.f};
                pg8::gemm_phase<pg8::EpiBf16<0>, pg8::TailOrder, false, true>(lds + RING_OFF, g, S, E); WG_SYNC(); }
            if (!split) rope_pass(args, l, lane, wave, G, bid, PROJ);
            else if (bid >= 64) rope_pass(args, l, lane, wave, 192, bid - 64, PROJ);
            REPS(2) for (int u = bid; u < 512; u += G) lru_a_unit(args, l, u, lds, tid, lane, wave);
            if (!split) { for (int u = bid; u < 512; u += G) mls_a_unit(args, l, u, lds, tid, lane, wave); }
            else if (bid >= 64) { for (int u = bid - 64; u < 512; u += 192) mls_a_unit(args, l, u, lds, tid, lane, wave); }
            if (BOTH(pb + 1)) GRID_BAR();
        }
        if (PT_ON(3) && IN(pb + 2)) { PHASE_IDS();
            const attn_body::AttnTensors AT{(const attn_body::bf16*)(PROJ + C_Q), (const attn_body::bf16*)(PROJ + C_K), (const attn_body::bf16*)(PROJ + C_V), (attn_body::bf16*)Yb};
            const attn_body::StaticOrder S(G, bid);
#ifndef P3_PARTS
#define P3_PARTS 7
#endif
            for (int u = bid; u < 256; u += G) mls_scan_unit(args, u, lds, tid, lane, wave);
            WG_SYNC();
            REPS(4) attn_body::attn_phase<attn_body::StaticOrder>((char*)lds_raw + RING_OFF, AT, S);
            if (!MK_PER_PHASE && G == 256) p4_carry(args, bid, lds, tid);
            if (BOTH(pb + 2)) GRID_BAR();
        }
        if (PT_ON(4) && IN(pb + 3)) { PHASE_IDS();
            REPS(5) for (int u = bid; u < 512; u += G) mls_b_unit(args, l, u, lds, tid, lane, wave);
            for (int u = bid; u < 256; u += G) p4_rows_unit(args, l, u, lds, tid, lane, wave, !MK_PER_PHASE && G == 256);
            if (BOTH(pb + 3)) GRID_BAR();
        }
        if (PT_ON(5) && IN(pb + 4)) { PHASE_IDS();
            pg8::Gemm g{Yb, (const bf16*)(ws + WS_WOUT) + (size_t)l * DM * DM, M, DM, DM}; pg8::StaticOrder S; S.init(M, DM, G, bid);
            pg8::EpiResid E{l == 0 ? args.in[I_X] : nullptr, XB, XB, DM};
            if (REP_MASK & (1 << 14)) { pg8::EpiResid E2{l == 0 ? args.in[I_X] : nullptr, XB, HID, DM}; pg8::gemm_phase<pg8::EpiResid, pg8::StaticOrder, false, true>(lds + RING_OFF, g, S, E2); }
            pg8::gemm_phase<pg8::EpiResid, pg8::StaticOrder, false, true>(lds + RING_OFF, g, S, E);
            stage_w16(args.in[I_WR] + (size_t)l * DM * NE, NE, lds, tid);
            if (BOTH(pb + 4)) GRID_BAR();
        }
        if (PT_ON(6) && IN(pb + 5)) { PHASE_IDS();
            REPS(7) row_pass<1, true, true>(XB, nullptr, args.in[I_N2G] + (size_t)l * DM, args.in[I_WR] + (size_t)l * DM * NE, NE, Hb, AFF, nullptr, nullptr, lds, tid, lane, wave, G, bid);
            if (BOTH(pb + 5)) GRID_BAR();
        }
        if (PT_ON(7) && IN(pb + 6)) { PHASE_IDS(); REPS(8) for (int it = bid; it < 256; it += G) topk_item(args, it, lds, tid, lane, wave); if (BOTH(pb + 6)) GRID_BAR(); }
        if (PT_ON(8) && IN(pb + 7)) { PHASE_IDS();
            pg8::Gemm g{XG, (const bf16*)(ws + WS_WGU + (size_t)l * NE * 4096 * DM), NE * NSLOT, NE * 4096, DM / 2}; pg8::Moe1Order S{G, bid};
            pg8::EpiSwiGLU E{(unsigned char*)HID, DE};
            if (REP_MASK & (1 << 17)) { pg8::EpiNull E0; pg8::gemm_phase<pg8::EpiNull, pg8::Moe1Order, true, true, true>(lds + RING_OFF, g, S, E0); }
            REPS(9) pg8::gemm_phase<pg8::EpiSwiGLU, pg8::Moe1Order, true, true, true>(lds + RING_OFF, g, S, E);
            if (BOTH(pb + 7)) GRID_BAR();
        }
        if (PT_ON(9) && IN(pb + 8)) { PHASE_IDS();
            pg8::Gemm g{HID, (const bf16*)(ws + WS_WDN + (size_t)l * NE * DM * DE), NE * NSLOT, NE * DM, DE / 2}; pg8::Moe2Order S{G, bid};
            pg8::EpiScaleBf16 E{YE, DM, (const float*)(ws + WS_GATE)};
            REPS(10) pg8::gemm_phase<pg8::EpiScaleBf16, pg8::Moe2Order, true, true, true>(lds + RING_OFF, g, S, E);
            if (l + 1 < DEPTH) stage_w16(args.in[I_WIN] + (size_t)(l + 1) * DM * DIN + NPROJ, DIN, lds, tid);
            if (BOTH(pb + 8)) GRID_BAR();
        }
        if (PT_ON(10) && IN(pb + 9)) { PHASE_IDS();
            if (REP_MASK & (1 << 15)) { if (l + 1 < DEPTH) row_pass<2, true>(XB, HID, args.in[I_N1G] + (size_t)(l + 1) * DM, args.in[I_WIN] + (size_t)(l + 1) * DM * DIN + NPROJ, DIN, Hb, MG, SEL, YE, lds, tid, lane, wave, G, bid); else row_pass<3, true>(XB, HID, nullptr, nullptr, 0, nullptr, nullptr, SEL, YE, lds, tid, lane, wave, G, bid); WG_SYNC(); }
            if (l + 1 < DEPTH) row_pass<2, true, true>(XB, XB, args.in[I_N1G] + (size_t)(l + 1) * DM, args.in[I_WIN] + (size_t)(l + 1) * DM * DIN + NPROJ, DIN, Hb, MG, SEL, YE, lds, tid, lane, wave, G, bid);
            else row_pass<3, true>(XB, args.out, nullptr, nullptr, 0, nullptr, nullptr, SEL, YE, lds, tid, lane, wave, G, bid);
            if (BOTH(pb + 9)) GRID_BAR();
        }
    }
#undef IN
#undef BOTH
#undef GRID_BAR
}

extern "C" void kernel_launch(void* const* d_in, const int* in_sizes, int n_in, void* d_out, int out_size, void* d_ws, size_t ws_size, hipStream_t stream) {
    static int grid = 0;
    if (grid == 0) {
        if (n_in != 22 || in_sizes[0] != M * DM || out_size != M * DM || ws_size < WS_END) { fprintf(stderr, "kernel_launch: unexpected shapes (n_in %d, in0 %d, out %d, ws %zu); nothing launched\n", n_in, n_in > 0 ? in_sizes[0] : -1, out_size, ws_size); grid = -1; return; }
        int dev = 0, cus = 0, per_cu = 0;
        if (hipGetDevice(&dev) != hipSuccess || hipDeviceGetAttribute(&cus, hipDeviceAttributeMultiprocessorCount, dev) != hipSuccess) { grid = -1; return; }
        if (hipFuncSetAttribute((const void*)hybrid_fwd, hipFuncAttributeMaxDynamicSharedMemorySize, LDS_BYTES) != hipSuccess) { fprintf(stderr, "kernel_launch: hipFuncSetAttribute failed\n"); grid = -1; return; }
        if (hipOccupancyMaxActiveBlocksPerMultiprocessor(&per_cu, (const void*)hybrid_fwd, NTHR, LDS_BYTES) != hipSuccess || per_cu < 1) { fprintf(stderr, "kernel_launch: occupancy query says %d\n", per_cu); }
        (void)hipGetLastError();
        grid = cus;
    }
    if (grid < 0) return;
    if (hipMemsetAsync((char*)d_ws + WS_CTL, 0, CTL_ZERO_BYTES, stream) != hipSuccess) return;
    Args a{};
    for (int i = 0; i < 22; ++i) a.in[i] = (const float*)d_in[i];
    a.out = (float*)d_out; a.ws = (unsigned char*)d_ws; a.pad = 0;
#if MK_PER_PHASE
    for (int p = 0; p < NPH; ++p) { a.ph_lo = p; a.ph_hi = p + 1; a.li = p; hipLaunchKernelGGL(hybrid_fwd, dim3(grid), dim3(NTHR), LDS_BYTES, stream, a); }
#else
    a.ph_lo = 0; a.ph_hi = NPH; a.li = 0;
    hipLaunchKernelGGL(hybrid_fwd, dim3(grid), dim3(NTHR), LDS_BYTES, stream, a);
#endif
    const hipError_t le = hipPeekAtLastError();
    if (le != hipSuccess) fprintf(stderr, "kernel_launch: launch failed: %s\n", hipGetErrorName(le));
}
```
